# Optimizing an MI355X kernel written in HIP

```python
import math
import jax, jax.numpy as jnp
from jax import lax
import numpy as np

D_MODEL = 1024
BATCH = 8
SEQ = 4096
DEPTH = 1

HEAD_DIM = 64
N_HEADS_A = 8
N_IDX_HEADS = 8
IDX_DIM = 32
TOPK_TOKENS = 256
N_HEADS_B = 8
N_KV_GROUPS_B = 2
HEADS_PER_GROUP = N_HEADS_B // N_KV_GROUPS_B
CMP_BLOCK = 32
CMP_STRIDE = 16
CMP_HIDDEN = 128
SLC_BLOCK = 64
N_SLC_BLOCKS = 16
WINDOW = 512
FORCED_SCORE = 1.0e4
N_BUCKETS = 32
MAX_DISTANCE = 128
D_FF = 4 * D_MODEL
Q_BLOCK_A = 128
Q_BLOCK_B = 64
EPS = 1e-6

W_QA = N_HEADS_A * HEAD_DIM
W_KA = HEAD_DIM
W_VA = HEAD_DIM
W_QI = N_IDX_HEADS * IDX_DIM
W_KI = IDX_DIM
W_WI = N_IDX_HEADS
W_QB = N_HEADS_B * HEAD_DIM
W_KVB = 6 * N_KV_GROUPS_B * HEAD_DIM
W_GB = 3 * N_HEADS_B
W_GATE = 2 * D_MODEL
D_IN = W_QA + W_KA + W_VA + W_QI + W_KI + W_WI + W_QB + W_KVB + W_GB + W_GATE

kernel_name = "hybrid_dsa_nsa_gated_block"


def rmsnorm(x, g):
    xf = x.astype(jnp.float32)
    y = xf * lax.rsqrt(jnp.mean(xf * xf, axis=-1, keepdims=True) + EPS)
    return (y * g.astype(jnp.float32)).astype(x.dtype)


def t5_bucket(dist):
    n = jnp.maximum(dist, 0)
    max_exact = N_BUCKETS // 2
    nf = jnp.maximum(n, 1).astype(jnp.float32)
    large = max_exact + (jnp.log(nf / max_exact) / math.log(MAX_DISTANCE / max_exact)
                         * (N_BUCKETS - max_exact)).astype(jnp.int32)
    large = jnp.minimum(large, N_BUCKETS - 1)
    return jnp.where(n < max_exact, n, large)


def masked_softmax(logits, mask):
    lf = jnp.where(mask, logits.astype(jnp.float32), -jnp.inf)
    m = jnp.max(lf, axis=-1, keepdims=True)
    m = jnp.where(jnp.isfinite(m), m, 0.0)
    e = jnp.where(mask, jnp.exp(lf - m), 0.0)
    return e / jnp.maximum(jnp.sum(e, axis=-1, keepdims=True), 1e-30)


def dsa_mixer(q_a, k_a, v_a, q_i, k_i, w_i, table_a):
    B, S = q_a.shape[:2]
    k_top = min(TOPK_TOKENS, S // 4)
    n_blk = S // Q_BLOCK_A
    scale = HEAD_DIM ** -0.5
    w_scale = (N_IDX_HEADS ** -0.5) * (IDX_DIM ** -0.5)
    key_pos = jnp.arange(S)
    gather = jax.vmap(lambda kb, ib: kb[ib])

    def block(i):
        q0 = i * Q_BLOCK_A
        t = q0 + jnp.arange(Q_BLOCK_A)
        qi = lax.dynamic_slice_in_dim(q_i, q0, Q_BLOCK_A, axis=1)
        wi = lax.dynamic_slice_in_dim(w_i, q0, Q_BLOCK_A, axis=1).astype(jnp.float32) * w_scale
        s_h = jnp.einsum('bqhd,bsd->bqhs', qi, k_i).astype(jnp.float32)
        score = jnp.einsum('bqh,bqhs->bqs', wi, jax.nn.relu(s_h))
        causal = key_pos[None, :] <= t[:, None]
        score = jnp.where(causal[None], score, -jnp.inf)
        _, idx = lax.top_k(score, k_top)
        k_sel = gather(k_a, idx)
        v_sel = gather(v_a, idx)
        qa = lax.dynamic_slice_in_dim(q_a, q0, Q_BLOCK_A, axis=1)
        dist = t[None, :, None] - idx
        bias = table_a[t5_bucket(dist)].transpose(0, 1, 3, 2)
        logits = jnp.einsum('bqhd,bqkd->bqhk', qa, k_sel) * scale + bias
        p = masked_softmax(logits, (dist >= 0)[:, :, None, :])
        o = jnp.einsum('bqhk,bqkd->bqhd', p.astype(v_sel.dtype), v_sel)
        return o.reshape(B, Q_BLOCK_A, N_HEADS_A * HEAD_DIM)

    out = lax.map(block, jnp.arange(n_blk))
    return out.transpose(1, 0, 2, 3).reshape(B, S, N_HEADS_A * HEAD_DIM)


def compress_blocks(kv, pe, w1, w2):
    B, S, G, D = kv.shape
    n_c = (S - CMP_BLOCK) // CMP_STRIDE + 1
    idx = jnp.arange(n_c)[:, None] * CMP_STRIDE + jnp.arange(CMP_BLOCK)[None, :]
    blk = kv[:, idx] + pe[None, None, :, None, :]
    blk = blk.transpose(0, 1, 3, 2, 4).reshape(B, n_c, G, CMP_BLOCK * D)
    return jax.nn.gelu(blk @ w1) @ w2


def nsa_mixer(q, kc, vc, ks, vs, kw, vw, gates, pe_k, w1_k, w2_k, pe_v, w1_v, w2_v, table_b):
    B, S = q.shape[:2]
    G, R, D = N_KV_GROUPS_B, HEADS_PER_GROUP, HEAD_DIM
    QB = Q_BLOCK_B
    scale = D ** -0.5
    q = q.reshape(B, S, G, R, D)
    gates = jax.nn.sigmoid(gates.astype(jnp.float32)).reshape(B, S, 3, G, R)
    kc_cmp = compress_blocks(kc, pe_k, w1_k, w2_k)
    vc_cmp = compress_blocks(vc, pe_v, w1_v, w2_v)
    n_c = kc_cmp.shape[1]
    n_s = S // SLC_BLOCK
    n_sel = min(N_SLC_BLOCKS, n_s)
    cmp_start = jnp.arange(n_c) * CMP_STRIDE
    cmp_end = cmp_start + CMP_BLOCK - 1
    slc_start = jnp.arange(n_s) * SLC_BLOCK
    overlap = jnp.clip(jnp.minimum(cmp_start[:, None] + CMP_BLOCK, slc_start[None, :] + SLC_BLOCK)
                       - jnp.maximum(cmp_start[:, None], slc_start[None, :]), 0, None
                       ).astype(jnp.float32) / CMP_BLOCK
    ks_blk = ks.reshape(B, n_s, SLC_BLOCK, G, D).transpose(0, 3, 1, 2, 4)
    vs_blk = vs.reshape(B, n_s, SLC_BLOCK, G, D).transpose(0, 3, 1, 2, 4)
    gather = jax.vmap(jax.vmap(lambda kb, ib: kb[ib]))
    pad = ((0, 0), (WINDOW, 0), (0, 0), (0, 0))
    kw_p = jnp.pad(kw, pad)
    vw_p = jnp.pad(vw, pad)
    tg = table_b.reshape(N_BUCKETS, G, R).transpose(1, 0, 2)
    g_idx = jnp.arange(G)[None, :, None, None]
    blk_id = jnp.arange(n_s)
    KW = WINDOW + QB

    def block(i):
        q0 = i * QB
        t = q0 + jnp.arange(QB)
        qb = lax.dynamic_slice_in_dim(q, q0, QB, axis=1)
        gb = lax.dynamic_slice_in_dim(gates, q0, QB, axis=1)
        dist_c = t[:, None] - cmp_end[None, :]
        bias_c = table_b[t5_bucket(dist_c)].reshape(QB, n_c, G, R).transpose(0, 2, 3, 1)
        logit_c = jnp.einsum('bqgrd,bcgd->bqgrc', qb, kc_cmp) * scale + bias_c
        p_c = masked_softmax(logit_c, (dist_c >= 0)[:, None, None, :])
        o_c = jnp.einsum('bqgrc,bcgd->bqgrd', p_c.astype(vc_cmp.dtype), vc_cmp)
        imp = jnp.einsum('bqgrc,cn->bqgn', p_c, overlap)
        cur = t // SLC_BLOCK
        valid = blk_id[None, :] <= cur[:, None]
        forced = ((blk_id[None, :] == 0) | (blk_id[None, :] == cur[:, None])
                  | (blk_id[None, :] == cur[:, None] - 1))
        score = jnp.where(valid[None, :, None, :],
                          jnp.where(forced[None, :, None, :], FORCED_SCORE, imp), -jnp.inf)
        _, sel = lax.top_k(score, n_sel)
        sel_t = sel.transpose(0, 2, 1, 3)
        k_sel = gather(ks_blk, sel_t).reshape(B, G, QB, n_sel * SLC_BLOCK, D)
        v_sel = gather(vs_blk, sel_t).reshape(B, G, QB, n_sel * SLC_BLOCK, D)
        pos_s = (sel_t[..., None] * SLC_BLOCK + jnp.arange(SLC_BLOCK)).reshape(B, G, QB, n_sel * SLC_BLOCK)
        dist_s = t[None, None, :, None] - pos_s
        bias_s = tg[g_idx, t5_bucket(dist_s)].transpose(0, 1, 2, 4, 3)
        logit_s = jnp.einsum('bqgrd,bgqkd->bgqrk', qb, k_sel) * scale + bias_s
        p_s = masked_softmax(logit_s, (dist_s >= 0)[:, :, :, None, :])
        o_s = jnp.einsum('bgqrk,bgqkd->bqgrd', p_s.astype(v_sel.dtype), v_sel)
        kwb = lax.dynamic_slice_in_dim(kw_p, q0, KW, axis=1)
        vwb = lax.dynamic_slice_in_dim(vw_p, q0, KW, axis=1)
        pos_w = q0 - WINDOW + jnp.arange(KW)
        dist_w = t[:, None] - pos_w[None, :]
        mask_w = (dist_w >= 0) & (dist_w < WINDOW) & (pos_w[None, :] >= 0)
        bias_w = table_b[t5_bucket(dist_w)].reshape(QB, KW, G, R).transpose(0, 2, 3, 1)
        logit_w = jnp.einsum('bqgrd,bkgd->bqgrk', qb, kwb) * scale + bias_w
        p_w = masked_softmax(logit_w, mask_w[:, None, None, :])
        o_w = jnp.einsum('bqgrk,bkgd->bqgrd', p_w.astype(vwb.dtype), vwb)
        o = (gb[:, :, 0, :, :, None] * o_c + gb[:, :, 1, :, :, None] * o_s
             + gb[:, :, 2, :, :, None] * o_w)
        return o.astype(q.dtype).reshape(B, QB, G * R * D)

    out = lax.map(block, jnp.arange(S // QB))
    return out.transpose(1, 0, 2, 3).reshape(B, S, N_HEADS_B * HEAD_DIM)


def setup_inputs(seed: int = 0) -> dict:
    key = jax.random.key(seed)
    ks = jax.random.split(key, 20)
    f32 = jnp.float32
    nrm = lambda k, shape, s: jax.random.normal(k, shape, f32) * s
    L, D = CMP_BLOCK, HEAD_DIM
    return {
        "x": nrm(ks[0], (BATCH, SEQ, D_MODEL), 1.0),
        "norm_mix": 1.0 + nrm(ks[1], (DEPTH, D_MODEL), 0.02),
        "w_in": nrm(ks[2], (DEPTH, D_MODEL, D_IN), D_MODEL ** -0.5),
        "cmp_pe_k": nrm(ks[3], (DEPTH, L, D), 0.1),
        "cmp_w1_k": nrm(ks[4], (DEPTH, L * D, CMP_HIDDEN), (L * D) ** -0.5),
        "cmp_w2_k": nrm(ks[5], (DEPTH, CMP_HIDDEN, D), CMP_HIDDEN ** -0.5),
        "cmp_pe_v": nrm(ks[6], (DEPTH, L, D), 0.1),
        "cmp_w1_v": nrm(ks[7], (DEPTH, L * D, CMP_HIDDEN), (L * D) ** -0.5),
        "cmp_w2_v": nrm(ks[8], (DEPTH, CMP_HIDDEN, D), CMP_HIDDEN ** -0.5),
        "rel_bias": nrm(ks[9], (N_BUCKETS, N_HEADS_A + N_HEADS_B), 0.5),
        "w_branch_a": nrm(ks[10], (DEPTH, W_QA, D_MODEL), W_QA ** -0.5),
        "w_branch_b": nrm(ks[11], (DEPTH, W_QB, D_MODEL), W_QB ** -0.5),
        "w_out": nrm(ks[12], (DEPTH, D_MODEL, D_MODEL), D_MODEL ** -0.5),
        "norm_mlp": 1.0 + nrm(ks[13], (DEPTH, D_MODEL), 0.02),
        "w_mlp_in": nrm(ks[14], (DEPTH, D_MODEL, D_FF), D_MODEL ** -0.5),
        "w_mlp_out": nrm(ks[15], (DEPTH, D_FF, D_MODEL), D_FF ** -0.5),
        "norm_final": 1.0 + nrm(ks[16], (D_MODEL,), 0.02),
    }


def reference(x, norm_mix, w_in, cmp_pe_k, cmp_w1_k, cmp_w2_k, cmp_pe_v, cmp_w1_v, cmp_w2_v,
              rel_bias, w_branch_a, w_branch_b, w_out, norm_mlp, w_mlp_in, w_mlp_out, norm_final):
    B, S, _ = x.shape
    G, D = N_KV_GROUPS_B, HEAD_DIM
    widths = [W_QA, W_KA, W_VA, W_QI, W_KI, W_WI, W_QB, W_KVB, W_GB, W_GATE]
    split_pts = [int(v) for v in np.cumsum(widths)[:-1]]
    table_a = rel_bias[:, :N_HEADS_A]
    table_b = rel_bias[:, N_HEADS_A:]
    for l in range(DEPTH):
        h = rmsnorm(x, norm_mix[l])
        proj = h @ w_in[l]
        q_a, k_a, v_a, q_i, k_i, w_i, q_b, kv_b, g_b, g_br = jnp.split(proj, split_pts, axis=-1)
        o_a = dsa_mixer(q_a.reshape(B, S, N_HEADS_A, D), k_a, v_a,
                        q_i.reshape(B, S, N_IDX_HEADS, IDX_DIM), k_i, w_i, table_a)
        kv_b = kv_b.reshape(B, S, 6, G, D)
        o_b = nsa_mixer(q_b.reshape(B, S, N_HEADS_B, D), kv_b[:, :, 0], kv_b[:, :, 1],
                        kv_b[:, :, 2], kv_b[:, :, 3], kv_b[:, :, 4], kv_b[:, :, 5], g_b,
                        cmp_pe_k[l], cmp_w1_k[l], cmp_w2_k[l], cmp_pe_v[l], cmp_w1_v[l],
                        cmp_w2_v[l], table_b)
        gate_a, gate_b = jnp.split(g_br, 2, axis=-1)
        mix = (jax.nn.sigmoid(gate_a) * (o_a @ w_branch_a[l])
               + jax.nn.sigmoid(gate_b) * (o_b @ w_branch_b[l]))
        x = x + mix @ w_out[l]
        h = rmsnorm(x, norm_mlp[l])
        x = x + jnp.square(jax.nn.relu(h @ w_mlp_in[l])) @ w_mlp_out[l]
    return rmsnorm(x, norm_final)
```

```cpp
#include <hip/hip_runtime.h>
#include <hip/hip_fp16.h>
#include <cstdint>
#include <cstdio>

namespace {
constexpr int B_ = 8, S_ = 4096, M_ = B_ * S_, D_ = 1024, DIN = 4288, DFF = 4096;
constexpr int C_QA = 0, C_KA = 512, C_VA = 576, C_QI = 640, C_KI = 896, C_WI = 928, C_QB = 936, C_KVB = 1448, C_GB = 2216, C_GATE = 2240;
constexpr int NC = 255;
constexpr float EPS = 1e-6f;

__device__ __forceinline__ int t5_bucket(int n) {
    if (n < 16) return n < 0 ? 0 : n;
    float nf = (float)n;
    int large = 16 + (int)(logf(nf / 16.f) / logf(8.f) * 16.f);
    return large < 31 ? large : 31;
}
__device__ __forceinline__ float sigmoidf_(float v) { return 1.f / (1.f + expf(-v)); }

template <typename TO>
__global__ __launch_bounds__(256) void rmsnorm_k(const float* __restrict__ x, const float* __restrict__ g, TO* __restrict__ out) {
    __shared__ float red[4];
    const int row = blockIdx.x, tid = threadIdx.x;
    const float* xr = x + (size_t)row * D_;
    float v[4]; float ss = 0.f;
#pragma unroll
    for (int i = 0; i < 4; ++i) { v[i] = xr[tid + i * 256]; ss += v[i] * v[i]; }
#pragma unroll
    for (int o = 32; o > 0; o >>= 1) ss += __shfl_xor(ss, o);
    if ((tid & 63) == 0) red[tid >> 6] = ss;
    __syncthreads();
    const float tot = red[0] + red[1] + red[2] + red[3];
    const float rs = rsqrtf(tot / D_ + EPS);
#pragma unroll
    for (int i = 0; i < 4; ++i) out[(size_t)row * D_ + tid + i * 256] = (TO)(v[i] * rs * g[tid + i * 256]);
}

template <typename TA, typename Epi>
__global__ __launch_bounds__(256) void gemm_naive(const TA* __restrict__ A, const float* __restrict__ Bm, Epi epi, int lda, int ldb, int K, int pad_) {
    __shared__ float As[16][68];
    __shared__ float Bs[16][68];
    const int tid = threadIdx.x, tx = tid & 15, ty = tid >> 4;
    const int m0 = blockIdx.y * 64, n0 = blockIdx.x * 64;
    float acc[4][4];
#pragma unroll
    for (int i = 0; i < 4; ++i)
#pragma unroll
        for (int j = 0; j < 4; ++j) acc[i][j] = 0.f;
    for (int k0 = 0; k0 < K; k0 += 16) {
#pragma unroll
        for (int i = 0; i < 4; ++i) { const int e = tid + i * 256; const int m = e >> 4, k = e & 15; As[k][m] = (float)A[(size_t)(m0 + m) * lda + k0 + k]; }
#pragma unroll
        for (int i = 0; i < 4; ++i) { const int e = tid + i * 256; const int k = e >> 6, n = e & 63; Bs[k][n] = Bm[(size_t)(k0 + k) * ldb + n0 + n]; }
        __syncthreads();
#pragma unroll
        for (int k = 0; k < 16; ++k) {
            float a[4], b[4];
#pragma unroll
            for (int i = 0; i < 4; ++i) { a[i] = As[k][ty * 4 + i]; b[i] = Bs[k][tx * 4 + i]; }
#pragma unroll
            for (int i = 0; i < 4; ++i)
#pragma unroll
                for (int j = 0; j < 4; ++j) acc[i][j] += a[i] * b[j];
        }
        __syncthreads();
    }
#pragma unroll
    for (int i = 0; i < 4; ++i)
#pragma unroll
        for (int j = 0; j < 4; ++j) epi(m0 + ty * 4 + i, n0 + tx * 4 + j, acc[i][j]);
}

struct EpiHalf { __half* C; __device__ void operator()(int r, int c, float v) const { C[(size_t)r * DIN + c] = __float2half(v); } };
struct EpiMixA { __half* mix; const __half* proj; __device__ void operator()(int r, int c, float v) const {
    const float g = sigmoidf_(__half2float(proj[(size_t)r * DIN + C_GATE + c])); mix[(size_t)r * D_ + c] = __float2half(g * v); } };
struct EpiMixB { __half* mix; const __half* proj; __device__ void operator()(int r, int c, float v) const {
    const float g = sigmoidf_(__half2float(proj[(size_t)r * DIN + C_GATE + 1024 + c])); mix[(size_t)r * D_ + c] = __float2half(__half2float(mix[(size_t)r * D_ + c]) + g * v); } };
struct EpiResid { const float* x; float* out; __device__ void operator()(int r, int c, float v) const { out[(size_t)r * D_ + c] = x[(size_t)r * D_ + c] + v; } };
struct EpiRelu2 { __half* u; __device__ void operator()(int r, int c, float v) const { const float t = v > 0.f ? v : 0.f; u[(size_t)r * DFF + c] = __float2half(t * t); } };
struct EpiAcc { float* out; __device__ void operator()(int r, int c, float v) const { out[(size_t)r * D_ + c] += v; } };

__global__ __launch_bounds__(256) void dsa_naive(const __half* __restrict__ proj, const float* __restrict__ rel_bias, __half* __restrict__ o_a) {
    __shared__ float qs[8][32];
    __shared__ float wv[8];
    __shared__ unsigned keys[4096];
    __shared__ int sel[256];
    __shared__ int nsel_s;
    __shared__ unsigned hist[256];
    __shared__ unsigned sel_prefix, sel_k;
    __shared__ float qa[8][64];
    __shared__ float p[8][256];
    const int row = blockIdx.x, tid = threadIdx.x, b = row / S_, t = row % S_;
    const __half* pr = proj + (size_t)row * DIN;
    { const int h = tid >> 5, d = tid & 31; qs[h][d] = __half2float(pr[C_QI + h * 32 + d]); }
    if (tid < 8) wv[tid] = __half2float(pr[C_WI + tid]) * (1.f / 16.f);
    for (int i = tid; i < 512; i += 256) qa[i >> 6][i & 63] = __half2float(pr[C_QA + i]);
    if (tid == 0) nsel_s = 0;
    __syncthreads();
    const int n = t + 1;
    for (int s = tid; s < n; s += 256) {
        const __half* kr = proj + (size_t)(b * S_ + s) * DIN + C_KI;
        float a8[8];
#pragma unroll
        for (int h = 0; h < 8; ++h) a8[h] = 0.f;
#pragma unroll 4
        for (int d = 0; d < 32; ++d) { const float kvd = __half2float(kr[d]);
#pragma unroll
            for (int h = 0; h < 8; ++h) a8[h] += qs[h][d] * kvd; }
        float sc = 0.f;
#pragma unroll
        for (int h = 0; h < 8; ++h) sc += wv[h] * (a8[h] > 0.f ? a8[h] : 0.f);
        unsigned u = __float_as_uint(sc);
        keys[s] = (u & 0x80000000u) ? ~u : (u | 0x80000000u);
    }
    __syncthreads();
    if (n <= 256) {
        if (tid < n) sel[tid] = tid;
        if (tid == 0) nsel_s = n;
        __syncthreads();
    } else {
        unsigned prefix = 0, mask = 0, kk = 256;
        for (int shift = 24; shift >= 0; shift -= 8) {
            hist[tid] = 0;
            __syncthreads();
            for (int s = tid; s < n; s += 256) { const unsigned k = keys[s]; if ((k & mask) == prefix) atomicAdd(&hist[(k >> shift) & 255u], 1u); }
            __syncthreads();
            if (tid == 0) { unsigned cum = 0; int d = 255; for (; d > 0; --d) { if (cum + hist[d] >= kk) break; cum += hist[d]; } sel_prefix = prefix | ((unsigned)d << shift); sel_k = kk - cum; }
            __syncthreads();
            prefix = sel_prefix; kk = sel_k; mask |= 0xFFu << shift;
            __syncthreads();
        }
        const unsigned T = prefix;
        for (int s = tid; s < n; s += 256) if (keys[s] > T) { const int pos = atomicAdd(&nsel_s, 1); sel[pos] = s; }
        __syncthreads();
        if (tid == 0) { int pos = nsel_s; unsigned need = kk; for (int s = 0; s < n && need > 0; ++s) if (keys[s] == T) { sel[pos++] = s; --need; } nsel_s = pos; }
        __syncthreads();
    }
    const int ns = nsel_s;
    {
        const int j = tid;
        if (j < ns) {
            const int idx = sel[j];
            const __half* kr = proj + (size_t)(b * S_ + idx) * DIN + C_KA;
            float a8[8];
#pragma unroll
            for (int h = 0; h < 8; ++h) a8[h] = 0.f;
#pragma unroll 4
            for (int d = 0; d < 64; ++d) { const float kvd = __half2float(kr[d]);
#pragma unroll
                for (int h = 0; h < 8; ++h) a8[h] += qa[h][d] * kvd; }
            const int bk = t5_bucket(t - idx);
#pragma unroll
            for (int h = 0; h < 8; ++h) p[h][j] = a8[h] * 0.125f + rel_bias[bk * 16 + h];
        } else {
#pragma unroll
            for (int h = 0; h < 8; ++h) p[h][j] = -INFINITY;
        }
    }
    __syncthreads();
    {
        const int w = tid >> 6, lane = tid & 63;
        for (int hh = 0; hh < 2; ++hh) { const int h = w * 2 + hh;
            float v[4], mx = -INFINITY;
#pragma unroll
            for (int i = 0; i < 4; ++i) { v[i] = p[h][lane + 64 * i]; mx = fmaxf(mx, v[i]); }
#pragma unroll
            for (int o = 32; o > 0; o >>= 1) mx = fmaxf(mx, __shfl_xor(mx, o));
            float sm = 0.f;
#pragma unroll
            for (int i = 0; i < 4; ++i) { v[i] = (v[i] == -INFINITY) ? 0.f : expf(v[i] - mx); sm += v[i]; }
#pragma unroll
            for (int o = 32; o > 0; o >>= 1) sm += __shfl_xor(sm, o);
            const float inv = 1.f / fmaxf(sm, 1e-30f);
#pragma unroll
            for (int i = 0; i < 4; ++i) p[h][lane + 64 * i] = v[i] * inv; }
    }
    __syncthreads();
    for (int o = tid; o < 512; o += 256) { const int h = o >> 6, d = o & 63; float a = 0.f;
        for (int j = 0; j < ns; ++j) a += p[h][j] * __half2float(proj[(size_t)(b * S_ + sel[j]) * DIN + C_VA + d]);
        o_a[(size_t)row * 512 + o] = __float2half(a); }
}

__global__ __launch_bounds__(128) void compress_naive(const __half* __restrict__ proj, const float* __restrict__ pe_k, const float* __restrict__ w1_k, const float* __restrict__ w2_k,
                                                      const float* __restrict__ pe_v, const float* __restrict__ w1_v, const float* __restrict__ w2_v, float* __restrict__ kcmp, float* __restrict__ vcmp) {
    __shared__ float blk[2048];
    __shared__ float hid[128];
    int id = blockIdx.x; const int kv = id & 1; id >>= 1; const int g = id & 1; id >>= 1; const int c = id % NC, b = id / NC;
    const float* pe = kv ? pe_v : pe_k; const float* w1 = kv ? w1_v : w1_k; const float* w2 = kv ? w2_v : w2_k;
    const int tid = threadIdx.x;
    for (int i = tid; i < 2048; i += 128) { const int l = i >> 6, d = i & 63;
        blk[i] = __half2float(proj[(size_t)(b * S_ + 16 * c + l) * DIN + C_KVB + kv * 128 + g * 64 + d]) + pe[i]; }
    __syncthreads();
    { float a = 0.f; for (int k = 0; k < 2048; ++k) a += blk[k] * w1[k * 128 + tid];
      const float x3 = a * a * a; hid[tid] = 0.5f * a * (1.f + tanhf(0.7978845608028654f * (a + 0.044715f * x3))); }
    __syncthreads();
    if (tid < 64) { float a = 0.f; for (int k = 0; k < 128; ++k) a += hid[k] * w2[k * 64 + tid];
        (kv ? vcmp : kcmp)[((size_t)(b * NC + c) * 2 + g) * 64 + tid] = a; }
}

__device__ __forceinline__ void softmax_row(float* pr, int n, int lane) {
    float mx = -INFINITY;
    for (int i = lane; i < n; i += 64) mx = fmaxf(mx, pr[i]);
#pragma unroll
    for (int o = 32; o > 0; o >>= 1) mx = fmaxf(mx, __shfl_xor(mx, o));
    float sm = 0.f;
    for (int i = lane; i < n; i += 64) { const float v = pr[i]; const float e = (v == -INFINITY) ? 0.f : expf(v - mx); pr[i] = e; sm += e; }
#pragma unroll
    for (int o = 32; o > 0; o >>= 1) sm += __shfl_xor(sm, o);
    const float inv = 1.f / fmaxf(sm, 1e-30f);
    for (int i = lane; i < n; i += 64) pr[i] *= inv;
}

__global__ __launch_bounds__(256) void nsa_naive(const __half* __restrict__ proj, const float* __restrict__ rel_bias, const float* __restrict__ kcmp, const float* __restrict__ vcmp, __half* __restrict__ o_b) {
    __shared__ float q[4][64];
    __shared__ float lg[4][1024];
    __shared__ float score[64];
    __shared__ int sb[16];
    __shared__ int nsb;
    const int id = blockIdx.x, g = id & 1, row = id >> 1, b = row / S_, t = row % S_, tid = threadIdx.x;
    const int w = tid >> 6, lane = tid & 63;
    const __half* pr = proj + (size_t)row * DIN;
    q[tid >> 6][tid & 63] = __half2float(pr[C_QB + g * 256 + tid]);
    if (tid == 0) nsb = 0;
    __syncthreads();
    const int cur = t >> 6;
    const int nv = t >= 31 ? (t - 31) / 16 + 1 : 0;
    const int r_ = tid >> 6, d_ = tid & 63;
    float oc = 0.f, os = 0.f, ow = 0.f;
    for (int i = tid; i < 4 * nv; i += 256) { const int r = i / nv, c = i % nv;
        const float* kr = kcmp + ((size_t)(b * NC + c) * 2 + g) * 64; float a = 0.f;
        for (int d = 0; d < 64; ++d) a += q[r][d] * kr[d];
        lg[r][c] = a * 0.125f + rel_bias[t5_bucket(t - (16 * c + 31)) * 16 + 8 + g * 4 + r]; }
    __syncthreads();
    if (nv > 0) softmax_row(lg[w], nv, lane);
    __syncthreads();
    for (int c = 0; c < nv; ++c) oc += lg[r_][c] * vcmp[((size_t)(b * NC + c) * 2 + g) * 64 + d_];
    if (tid < 64) { const int nb = tid; float imp = 0.f;
        for (int r = 0; r < 4; ++r) for (int c = 4 * nb - 1; c <= 4 * nb + 3; ++c) if (c >= 0 && c < nv) imp += lg[r][c] * ((c == 4 * nb - 1 || c == 4 * nb + 3) ? 0.5f : 1.f);
        const bool valid = nb <= cur; const bool forced = nb == 0 || nb == cur || nb == cur - 1;
        score[nb] = valid ? (forced ? 1.0e4f : imp) : -INFINITY; }
    __syncthreads();
    if (tid < 64) { bool selq = false;
        if (tid <= cur) { const float sc = score[tid]; int rank = 0;
            for (int m = 0; m <= cur; ++m) { const float sm = score[m]; rank += (sm > sc || (sm == sc && m < tid)) ? 1 : 0; }
            selq = rank < 16; }
        const unsigned long long bm = __ballot(selq);
        if (selq) sb[__popcll(bm & ((1ull << tid) - 1ull))] = tid;
        if (tid == 0) nsb = __popcll(bm); }
    __syncthreads();
    const int ns = nsb;
    for (int i = tid; i < 4 * ns * 64; i += 256) { const int r = i / (ns * 64), j = i % (ns * 64); const int pos = sb[j >> 6] * 64 + (j & 63);
        float v = -INFINITY;
        if (pos <= t) { const __half* kr = proj + (size_t)(b * S_ + pos) * DIN + C_KVB + 2 * 128 + g * 64; float a = 0.f;
            for (int d = 0; d < 64; ++d) a += q[r][d] * __half2float(kr[d]);
            v = a * 0.125f + rel_bias[t5_bucket(t - pos) * 16 + 8 + g * 4 + r]; }
        lg[r][j] = v; }
    __syncthreads();
    softmax_row(lg[w], ns * 64, lane);
    __syncthreads();
    for (int j = 0; j < ns * 64; ++j) { const float pj = lg[r_][j]; if (pj != 0.f) { const int pos = sb[j >> 6] * 64 + (j & 63);
        os += pj * __half2float(proj[(size_t)(b * S_ + pos) * DIN + C_KVB + 3 * 128 + g * 64 + d_]); } }
    __syncthreads();
    const int p0 = t - 511 > 0 ? t - 511 : 0; const int nw = t - p0 + 1;
    for (int i = tid; i < 4 * nw; i += 256) { const int r = i / nw, j = i % nw; const int pos = p0 + j;
        const __half* kr = proj + (size_t)(b * S_ + pos) * DIN + C_KVB + 4 * 128 + g * 64; float a = 0.f;
        for (int d = 0; d < 64; ++d) a += q[r][d] * __half2float(kr[d]);
        lg[r][j] = a * 0.125f + rel_bias[t5_bucket(t - pos) * 16 + 8 + g * 4 + r]; }
    __syncthreads();
    softmax_row(lg[w], nw, lane);
    __syncthreads();
    for (int j = 0; j < nw; ++j) ow += lg[r_][j] * __half2float(proj[(size_t)(b * S_ + p0 + j) * DIN + C_KVB + 5 * 128 + g * 64 + d_]);
    const float g0 = sigmoidf_(__half2float(pr[C_GB + 0 * 8 + g * 4 + r_])), g1 = sigmoidf_(__half2float(pr[C_GB + 1 * 8 + g * 4 + r_])), g2 = sigmoidf_(__half2float(pr[C_GB + 2 * 8 + g * 4 + r_]));
    o_b[(size_t)row * 512 + (g * 4 + r_) * 64 + d_] = __float2half(g0 * oc + g1 * os + g2 * ow);
}

__global__ __launch_bounds__(256) void final_norm_k(float* __restrict__ xio, const float* __restrict__ g) {
    __shared__ float red[4];
    const int row = blockIdx.x, tid = threadIdx.x;
    float* xr = xio + (size_t)row * D_;
    float v[4]; float ss = 0.f;
#pragma unroll
    for (int i = 0; i < 4; ++i) { v[i] = xr[tid + i * 256]; ss += v[i] * v[i]; }
#pragma unroll
    for (int o = 32; o > 0; o >>= 1) ss += __shfl_xor(ss, o);
    if ((tid & 63) == 0) red[tid >> 6] = ss;
    __syncthreads();
    const float rs = rsqrtf((red[0] + red[1] + red[2] + red[3]) / D_ + EPS);
#pragma unroll
    for (int i = 0; i < 4; ++i) xr[tid + i * 256] = v[i] * rs * g[tid + i * 256];
}
}

extern "C" void kernel_launch(void* const* d_in, const int* in_sizes, int n_in, void* d_out, int out_size, void* d_ws, size_t ws_size, hipStream_t stream) {
    const float* x = (const float*)d_in[0]; const float* norm_mix = (const float*)d_in[1]; const float* w_in = (const float*)d_in[2];
    const float* pe_k = (const float*)d_in[3]; const float* w1_k = (const float*)d_in[4]; const float* w2_k = (const float*)d_in[5];
    const float* pe_v = (const float*)d_in[6]; const float* w1_v = (const float*)d_in[7]; const float* w2_v = (const float*)d_in[8];
    const float* rel_bias = (const float*)d_in[9]; const float* w_ba = (const float*)d_in[10]; const float* w_bb = (const float*)d_in[11];
    const float* w_out = (const float*)d_in[12]; const float* norm_mlp = (const float*)d_in[13]; const float* w_mi = (const float*)d_in[14];
    const float* w_mo = (const float*)d_in[15]; const float* norm_final = (const float*)d_in[16];
    float* out = (float*)d_out;
    unsigned char* ws = (unsigned char*)d_ws;
    constexpr size_t MiB = 1u << 20;
    __half* h = (__half*)(ws);
    __half* o_a = (__half*)(ws); __half* o_b = (__half*)(ws + 32 * MiB);
    __half* proj = (__half*)(ws + 64 * MiB);
    __half* u = proj;
    __half* mix = (__half*)(ws + 346 * MiB);
    float* kcmp = (float*)(ws + 410 * MiB); float* vcmp = (float*)(ws + 412 * MiB);
    if (ws_size < 416 * MiB) { fprintf(stderr, "ws too small: %zu\n", ws_size); return; }

    rmsnorm_k<__half><<<M_, 256, 0, stream>>>(x, norm_mix, h);
    gemm_naive<__half, EpiHalf><<<dim3(DIN / 64, M_ / 64), 256, 0, stream>>>(h, w_in, EpiHalf{proj}, D_, DIN, D_, 0);
    dsa_naive<<<M_, 256, 0, stream>>>(proj, rel_bias, o_a);
    compress_naive<<<B_ * NC * 2 * 2, 128, 0, stream>>>(proj, pe_k, w1_k, w2_k, pe_v, w1_v, w2_v, kcmp, vcmp);
    nsa_naive<<<M_ * 2, 256, 0, stream>>>(proj, rel_bias, kcmp, vcmp, o_b);
    gemm_naive<__half, EpiMixA><<<dim3(D_ / 64, M_ / 64), 256, 0, stream>>>(o_a, w_ba, EpiMixA{mix, proj}, 512, D_, 512, 0);
    gemm_naive<__half, EpiMixB><<<dim3(D_ / 64, M_ / 64), 256, 0, stream>>>(o_b, w_bb, EpiMixB{mix, proj}, 512, D_, 512, 0);
    gemm_naive<__half, EpiResid><<<dim3(D_ / 64, M_ / 64), 256, 0, stream>>>(mix, w_out, EpiResid{x, out}, D_, D_, D_, 0);
    rmsnorm_k<__half><<<M_, 256, 0, stream>>>(out, norm_mlp, h);
    gemm_naive<__half, EpiRelu2><<<dim3(DFF / 64, M_ / 64), 256, 0, stream>>>(h, w_mi, EpiRelu2{u}, D_, DFF, D_, 0);
    gemm_naive<__half, EpiAcc><<<dim3(D_ / 64, M_ / 64), 256, 0, stream>>>(u, w_mo, EpiAcc{out}, DFF, D_, DFF, 0);
    final_norm_k<<<M_, 256, 0, stream>>>(out, norm_final);
}
```

```cpp
#include <hip/hip_runtime.h>
#include <hip/hip_fp16.h>
#include <cstdint>
#include <cstdio>

namespace {
constexpr int B_ = 8, S_ = 4096, M_ = B_ * S_, D_ = 1024, DIN = 4288, DFF = 4096;
constexpr int C_QA = 0, C_KA = 512, C_VA = 576, C_QI = 640, C_KI = 896, C_WI = 928, C_QB = 936, C_KVB = 1448, C_GB = 2216, C_GATE = 2240;
constexpr int NC = 255;
constexpr float EPS = 1e-6f;

__device__ __forceinline__ int t5_bucket(int n) {
    if (n < 16) return n < 0 ? 0 : n;
    float nf = (float)n;
    int large = 16 + (int)(logf(nf / 16.f) / logf(8.f) * 16.f);
    return large < 31 ? large : 31;
}
__device__ __forceinline__ float sigmoidf_(float v) { return 1.f / (1.f + expf(-v)); }

template <typename TO>
__device__ __forceinline__ void rmsnorm_k(char* smem, int vb, const float* __restrict__ x, const float* __restrict__ g, TO* __restrict__ out) {
    float* red = (float*)smem;
    const int row = vb, tid = threadIdx.x;
    const float* xr = x + (size_t)row * D_;
    float v[4]; float ss = 0.f;
#pragma unroll
    for (int i = 0; i < 4; ++i) { v[i] = xr[tid + i * 256]; ss += v[i] * v[i]; }
#pragma unroll
    for (int o = 32; o > 0; o >>= 1) ss += __shfl_xor(ss, o);
    if ((tid & 63) == 0) red[tid >> 6] = ss;
    __syncthreads();
    const float tot = red[0] + red[1] + red[2] + red[3];
    const float rs = rsqrtf(tot / D_ + EPS);
#pragma unroll
    for (int i = 0; i < 4; ++i) out[(size_t)row * D_ + tid + i * 256] = (TO)(v[i] * rs * g[tid + i * 256]);
}

template <typename TA, typename Epi>
__device__ __forceinline__ void gemm_naive(char* smem, int vb, int nbx, const TA* __restrict__ A, const float* __restrict__ Bm, Epi epi, int lda, int ldb, int K) {
    float (*As)[68] = (float (*)[68])smem;
    float (*Bs)[68] = (float (*)[68])(smem + 16 * 68 * 4);
    const int tid = threadIdx.x, tx = tid & 15, ty = tid >> 4;
    const int m0 = (vb / nbx) * 64, n0 = (vb % nbx) * 64;
    float acc[4][4];
#pragma unroll
    for (int i = 0; i < 4; ++i)
#pragma unroll
        for (int j = 0; j < 4; ++j) acc[i][j] = 0.f;
    for (int k0 = 0; k0 < K; k0 += 16) {
#pragma unroll
        for (int i = 0; i < 4; ++i) { const int e = tid + i * 256; const int m = e >> 4, k = e & 15; As[k][m] = (float)A[(size_t)(m0 + m) * lda + k0 + k]; }
#pragma unroll
        for (int i = 0; i < 4; ++i) { const int e = tid + i * 256; const int k = e >> 6, n = e & 63; Bs[k][n] = Bm[(size_t)(k0 + k) * ldb + n0 + n]; }
        __syncthreads();
#pragma unroll
        for (int k = 0; k < 16; ++k) {
            float a[4], b[4];
#pragma unroll
            for (int i = 0; i < 4; ++i) { a[i] = As[k][ty * 4 + i]; b[i] = Bs[k][tx * 4 + i]; }
#pragma unroll
            for (int i = 0; i < 4; ++i)
#pragma unroll
                for (int j = 0; j < 4; ++j) acc[i][j] += a[i] * b[j];
        }
        __syncthreads();
    }
#pragma unroll
    for (int i = 0; i < 4; ++i)
#pragma unroll
        for (int j = 0; j < 4; ++j) epi(m0 + ty * 4 + i, n0 + tx * 4 + j, acc[i][j]);
}

struct EpiHalf { __half* C; __device__ void operator()(int r, int c, float v) const { C[(size_t)r * DIN + c] = __float2half(v); } };
struct EpiMixA { __half* mix; const __half* proj; __device__ void operator()(int r, int c, float v) const {
    const float g = sigmoidf_(__half2float(proj[(size_t)r * DIN + C_GATE + c])); mix[(size_t)r * D_ + c] = __float2half(g * v); } };
struct EpiMixB { __half* mix; const __half* proj; __device__ void operator()(int r, int c, float v) const {
    const float g = sigmoidf_(__half2float(proj[(size_t)r * DIN + C_GATE + 1024 + c])); mix[(size_t)r * D_ + c] = __float2half(__half2float(mix[(size_t)r * D_ + c]) + g * v); } };
struct EpiResid { const float* x; float* out; __device__ void operator()(int r, int c, float v) const { out[(size_t)r * D_ + c] = x[(size_t)r * D_ + c] + v; } };
struct EpiRelu2 { __half* u; __device__ void operator()(int r, int c, float v) const { const float t = v > 0.f ? v : 0.f; u[(size_t)r * DFF + c] = __float2half(t * t); } };
struct EpiAcc { float* out; __device__ void operator()(int r, int c, float v) const { out[(size_t)r * D_ + c] += v; } };

__device__ __forceinline__ void dsa_naive(char* smem, int vb, const __half* __restrict__ proj, const float* __restrict__ rel_bias, __half* __restrict__ o_a) {
    float (*qs)[32] = (float (*)[32])smem;
    float* wv = (float*)(smem + 1024);
    unsigned* keys = (unsigned*)(smem + 1088);
    int* sel = (int*)(smem + 1088 + 16384);
    unsigned* hist = (unsigned*)(smem + 1088 + 16384 + 1024);
    float (*qa)[64] = (float (*)[64])(smem + 1088 + 16384 + 2048);
    float (*p)[256] = (float (*)[256])(smem + 1088 + 16384 + 4096);
    int& nsel_s = *(int*)(smem + 1088 + 16384 + 4096 + 8192);
    unsigned& sel_prefix = *(unsigned*)(smem + 1088 + 16384 + 4096 + 8192 + 4);
    unsigned& sel_k = *(unsigned*)(smem + 1088 + 16384 + 4096 + 8192 + 8);
    const int row = vb, tid = threadIdx.x, b = row / S_, t = row % S_;
    const __half* pr = proj + (size_t)row * DIN;
    { const int h = tid >> 5, d = tid & 31; qs[h][d] = __half2float(pr[C_QI + h * 32 + d]); }
    if (tid < 8) wv[tid] = __half2float(pr[C_WI + tid]) * (1.f / 16.f);
    for (int i = tid; i < 512; i += 256) qa[i >> 6][i & 63] = __half2float(pr[C_QA + i]);
    if (tid == 0) nsel_s = 0;
    __syncthreads();
    const int n = t + 1;
    for (int s = tid; s < n; s += 256) {
        const __half* kr = proj + (size_t)(b * S_ + s) * DIN + C_KI;
        float a8[8];
#pragma unroll
        for (int h = 0; h < 8; ++h) a8[h] = 0.f;
#pragma unroll 4
        for (int d = 0; d < 32; ++d) { const float kvd = __half2float(kr[d]);
#pragma unroll
            for (int h = 0; h < 8; ++h) a8[h] += qs[h][d] * kvd; }
        float sc = 0.f;
#pragma unroll
        for (int h = 0; h < 8; ++h) sc += wv[h] * (a8[h] > 0.f ? a8[h] : 0.f);
        unsigned u = __float_as_uint(sc);
        keys[s] = (u & 0x80000000u) ? ~u : (u | 0x80000000u);
    }
    __syncthreads();
    if (n <= 256) {
        if (tid < n) sel[tid] = tid;
        if (tid == 0) nsel_s = n;
        __syncthreads();
    } else {
        unsigned prefix = 0, mask = 0, kk = 256;
        for (int shift = 24; shift >= 0; shift -= 8) {
            hist[tid] = 0;
            __syncthreads();
            for (int s = tid; s < n; s += 256) { const unsigned k = keys[s]; if ((k & mask) == prefix) atomicAdd(&hist[(k >> shift) & 255u], 1u); }
            __syncthreads();
            if (tid == 0) { unsigned cum = 0; int d = 255; for (; d > 0; --d) { if (cum + hist[d] >= kk) break; cum += hist[d]; } sel_prefix = prefix | ((unsigned)d << shift); sel_k = kk - cum; }
            __syncthreads();
            prefix = sel_prefix; kk = sel_k; mask |= 0xFFu << shift;
            __syncthreads();
        }
        const unsigned T = prefix;
        for (int s = tid; s < n; s += 256) if (keys[s] > T) { const int pos = atomicAdd(&nsel_s, 1); sel[pos] = s; }
        __syncthreads();
        if (tid == 0) { int pos = nsel_s; unsigned need = kk; for (int s = 0; s < n && need > 0; ++s) if (keys[s] == T) { sel[pos++] = s; --need; } nsel_s = pos; }
        __syncthreads();
    }
    const int ns = nsel_s;
    {
        const int j = tid;
        if (j < ns) {
            const int idx = sel[j];
            const __half* kr = proj + (size_t)(b * S_ + idx) * DIN + C_KA;
            float a8[8];
#pragma unroll
            for (int h = 0; h < 8; ++h) a8[h] = 0.f;
#pragma unroll 4
            for (int d = 0; d < 64; ++d) { const float kvd = __half2float(kr[d]);
#pragma unroll
                for (int h = 0; h < 8; ++h) a8[h] += qa[h][d] * kvd; }
            const int bk = t5_bucket(t - idx);
#pragma unroll
            for (int h = 0; h < 8; ++h) p[h][j] = a8[h] * 0.125f + rel_bias[bk * 16 + h];
        } else {
#pragma unroll
            for (int h = 0; h < 8; ++h) p[h][j] = -INFINITY;
        }
    }
    __syncthreads();
    {
        const int w = tid >> 6, lane = tid & 63;
        for (int hh = 0; hh < 2; ++hh) { const int h = w * 2 + hh;
            float v[4], mx = -INFINITY;
#pragma unroll
            for (int i = 0; i < 4; ++i) { v[i] = p[h][lane + 64 * i]; mx = fmaxf(mx, v[i]); }
#pragma unroll
            for (int o = 32; o > 0; o >>= 1) mx = fmaxf(mx, __shfl_xor(mx, o));
            float sm = 0.f;
#pragma unroll
            for (int i = 0; i < 4; ++i) { v[i] = (v[i] == -INFINITY) ? 0.f : expf(v[i] - mx); sm += v[i]; }
#pragma unroll
            for (int o = 32; o > 0; o >>= 1) sm += __shfl_xor(sm, o);
            const float inv = 1.f / fmaxf(sm, 1e-30f);
#pragma unroll
            for (int i = 0; i < 4; ++i) p[h][lane + 64 * i] = v[i] * inv; }
    }
    __syncthreads();
    for (int o = tid; o < 512; o += 256) { const int h = o >> 6, d = o & 63; float a = 0.f;
        for (int j = 0; j < ns; ++j) a += p[h][j] * __half2float(proj[(size_t)(b * S_ + sel[j]) * DIN + C_VA + d]);
        o_a[(size_t)row * 512 + o] = __float2half(a); }
}

__device__ __forceinline__ void compress_naive(char* smem, int vb, const __half* __restrict__ proj, const float* __restrict__ pe_k, const float* __restrict__ w1_k, const float* __restrict__ w2_k,
                                                      const float* __restrict__ pe_v, const float* __restrict__ w1_v, const float* __restrict__ w2_v, float* __restrict__ kcmp, float* __restrict__ vcmp) {
    float* blk = (float*)smem;
    float* hid = (float*)(smem + 8192);
    int id = vb; const int kv = id & 1; id >>= 1; const int g = id & 1; id >>= 1; const int c = id % NC, b = id / NC;
    const float* pe = kv ? pe_v : pe_k; const float* w1 = kv ? w1_v : w1_k; const float* w2 = kv ? w2_v : w2_k;
    const int tid = threadIdx.x;
    for (int i = tid; i < 2048; i += 256) { const int l = i >> 6, d = i & 63;
        blk[i] = __half2float(proj[(size_t)(b * S_ + 16 * c + l) * DIN + C_KVB + kv * 128 + g * 64 + d]) + pe[i]; }
    __syncthreads();
    if (tid < 128) { float a = 0.f; for (int k = 0; k < 2048; ++k) a += blk[k] * w1[k * 128 + tid];
      const float x3 = a * a * a; hid[tid] = 0.5f * a * (1.f + tanhf(0.7978845608028654f * (a + 0.044715f * x3))); }
    __syncthreads();
    if (tid < 64) { float a = 0.f; for (int k = 0; k < 128; ++k) a += hid[k] * w2[k * 64 + tid];
        (kv ? vcmp : kcmp)[((size_t)(b * NC + c) * 2 + g) * 64 + tid] = a; }
}

__device__ __forceinline__ void softmax_row(float* pr, int n, int lane) {
    float mx = -INFINITY;
    for (int i = lane; i < n; i += 64) mx = fmaxf(mx, pr[i]);
#pragma unroll
    for (int o = 32; o > 0; o >>= 1) mx = fmaxf(mx, __shfl_xor(mx, o));
    float sm = 0.f;
    for (int i = lane; i < n; i += 64) { const float v = pr[i]; const float e = (v == -INFINITY) ? 0.f : expf(v - mx); pr[i] = e; sm += e; }
#pragma unroll
    for (int o = 32; o > 0; o >>= 1) sm += __shfl_xor(sm, o);
    const float inv = 1.f / fmaxf(sm, 1e-30f);
    for (int i = lane; i < n; i += 64) pr[i] *= inv;
}

__device__ __forceinline__ void nsa_naive(char* smem, int vb, const __half* __restrict__ proj, const float* __restrict__ rel_bias, const float* __restrict__ kcmp, const float* __restrict__ vcmp, __half* __restrict__ o_b) {
    float (*q)[64] = (float (*)[64])smem;
    float (*lg)[1024] = (float (*)[1024])(smem + 1024);
    float* score = (float*)(smem + 1024 + 16384);
    int* sb = (int*)(smem + 1024 + 16384 + 256);
    int& nsb = *(int*)(smem + 1024 + 16384 + 256 + 64);
    const int id = vb, g = id & 1, row = id >> 1, b = row / S_, t = row % S_, tid = threadIdx.x;
    const int w = tid >> 6, lane = tid & 63;
    const __half* pr = proj + (size_t)row * DIN;
    q[tid >> 6][tid & 63] = __half2float(pr[C_QB + g * 256 + tid]);
    if (tid == 0) nsb = 0;
    __syncthreads();
    const int cur = t >> 6;
    const int nv = t >= 31 ? (t - 31) / 16 + 1 : 0;
    const int r_ = tid >> 6, d_ = tid & 63;
    float oc = 0.f, os = 0.f, ow = 0.f;
    for (int i = tid; i < 4 * nv; i += 256) { const int r = i / nv, c = i % nv;
        const float* kr = kcmp + ((size_t)(b * NC + c) * 2 + g) * 64; float a = 0.f;
        for (int d = 0; d < 64; ++d) a += q[r][d] * kr[d];
        lg[r][c] = a * 0.125f + rel_bias[t5_bucket(t - (16 * c + 31)) * 16 + 8 + g * 4 + r]; }
    __syncthreads();
    if (nv > 0) softmax_row(lg[w], nv, lane);
    __syncthreads();
    for (int c = 0; c < nv; ++c) oc += lg[r_][c] * vcmp[((size_t)(b * NC + c) * 2 + g) * 64 + d_];
    if (tid < 64) { const int nb = tid; float imp = 0.f;
        for (int r = 0; r < 4; ++r) for (int c = 4 * nb - 1; c <= 4 * nb + 3; ++c) if (c >= 0 && c < nv) imp += lg[r][c] * ((c == 4 * nb - 1 || c == 4 * nb + 3) ? 0.5f : 1.f);
        const bool valid = nb <= cur; const bool forced = nb == 0 || nb == cur || nb == cur - 1;
        score[nb] = valid ? (forced ? 1.0e4f : imp) : -INFINITY; }
    __syncthreads();
    if (tid < 64) { bool selq = false;
        if (tid <= cur) { const float sc = score[tid]; int rank = 0;
            for (int m = 0; m <= cur; ++m) { const float sm = score[m]; rank += (sm > sc || (sm == sc && m < tid)) ? 1 : 0; }
            selq = rank < 16; }
        const unsigned long long bm = __ballot(selq);
        if (selq) sb[__popcll(bm & ((1ull << tid) - 1ull))] = tid;
        if (tid == 0) nsb = __popcll(bm); }
    __syncthreads();
    const int ns = nsb;
    for (int i = tid; i < 4 * ns * 64; i += 256) { const int r = i / (ns * 64), j = i % (ns * 64); const int pos = sb[j >> 6] * 64 + (j & 63);
        float v = -INFINITY;
        if (pos <= t) { const __half* kr = proj + (size_t)(b * S_ + pos) * DIN + C_KVB + 2 * 128 + g * 64; float a = 0.f;
            for (int d = 0; d < 64; ++d) a += q[r][d] * __half2float(kr[d]);
            v = a * 0.125f + rel_bias[t5_bucket(t - pos) * 16 + 8 + g * 4 + r]; }
        lg[r][j] = v; }
    __syncthreads();
    softmax_row(lg[w], ns * 64, lane);
    __syncthreads();
    for (int j = 0; j < ns * 64; ++j) { const float pj = lg[r_][j]; if (pj != 0.f) { const int pos = sb[j >> 6] * 64 + (j & 63);
        os += pj * __half2float(proj[(size_t)(b * S_ + pos) * DIN + C_KVB + 3 * 128 + g * 64 + d_]); } }
    __syncthreads();
    const int p0 = t - 511 > 0 ? t - 511 : 0; const int nw = t - p0 + 1;
    for (int i = tid; i < 4 * nw; i += 256) { const int r = i / nw, j = i % nw; const int pos = p0 + j;
        const __half* kr = proj + (size_t)(b * S_ + pos) * DIN + C_KVB + 4 * 128 + g * 64; float a = 0.f;
        for (int d = 0; d < 64; ++d) a += q[r][d] * __half2float(kr[d]);
        lg[r][j] = a * 0.125f + rel_bias[t5_bucket(t - pos) * 16 + 8 + g * 4 + r]; }
    __syncthreads();
    softmax_row(lg[w], nw, lane);
    __syncthreads();
    for (int j = 0; j < nw; ++j) ow += lg[r_][j] * __half2float(proj[(size_t)(b * S_ + p0 + j) * DIN + C_KVB + 5 * 128 + g * 64 + d_]);
    const float g0 = sigmoidf_(__half2float(pr[C_GB + 0 * 8 + g * 4 + r_])), g1 = sigmoidf_(__half2float(pr[C_GB + 1 * 8 + g * 4 + r_])), g2 = sigmoidf_(__half2float(pr[C_GB + 2 * 8 + g * 4 + r_]));
    o_b[(size_t)row * 512 + (g * 4 + r_) * 64 + d_] = __float2half(g0 * oc + g1 * os + g2 * ow);
}

__device__ __forceinline__ void final_norm_k(char* smem, int vb, float* __restrict__ xio, const float* __restrict__ g) {
    float* red = (float*)smem;
    const int row = vb, tid = threadIdx.x;
    float* xr = xio + (size_t)row * D_;
    float v[4]; float ss = 0.f;
#pragma unroll
    for (int i = 0; i < 4; ++i) { v[i] = xr[tid + i * 256]; ss += v[i] * v[i]; }
#pragma unroll
    for (int o = 32; o > 0; o >>= 1) ss += __shfl_xor(ss, o);
    if ((tid & 63) == 0) red[tid >> 6] = ss;
    __syncthreads();
    const float rs = rsqrtf((red[0] + red[1] + red[2] + red[3]) / D_ + EPS);
#pragma unroll
    for (int i = 0; i < 4; ++i) xr[tid + i * 256] = v[i] * rs * g[tid + i * 256];
}

#define XB_TMO      128
#define XB_XCNT(j)  (256  + 64 * (j))
#define XB_XSUB(j)  (1280 + 64 * (j))
#define XB_XGEN(j)  (2304 + 64 * (j))
#define XB_TOP      3328
#define XB_TOPGEN   3392
#define XCD_BAR_WORDS 3456
#define XB_SPIN_CAP (1u << 18)
#define LAS __attribute__((address_space(3)))

__device__ __forceinline__ unsigned xb_ld(unsigned* p)              { return __hip_atomic_load(p, __ATOMIC_RELAXED, __HIP_MEMORY_SCOPE_AGENT); }
__device__ __forceinline__ unsigned xb_add(unsigned* p, unsigned v) { return __hip_atomic_fetch_add(p, v, __ATOMIC_RELAXED, __HIP_MEMORY_SCOPE_AGENT); }
__device__ __forceinline__ unsigned xb_xcc_id() { return (unsigned)__builtin_amdgcn_s_getreg((3 << 11) | 20) & 0xFu; }
#define XB_SPIN(cond, bar) do { unsigned _sp = 0; while (cond) { __builtin_amdgcn_s_sleep(1); \
    if ((++_sp & 255u) == 0u) { if (xb_ld(&(bar)[XB_TMO])) break; if (_sp > XB_SPIN_CAP) { atomicAdd(&(bar)[XB_TMO], 1u); break; } } } } while (0)

struct XcdBarrier {
    unsigned* bar; unsigned x;
    volatile LAS unsigned* st;
};
__device__ __forceinline__ XcdBarrier xcd_barrier_post(unsigned* bar, volatile LAS unsigned* st) {
    XcdBarrier b; b.bar = bar; b.x = xb_xcc_id(); b.st = st;
    if (threadIdx.x == 0) (void)xb_add(&bar[XB_XCNT(b.x)], 1u);
    return b;
}
__device__ __forceinline__ void xcd_barrier_complete(unsigned* bar, unsigned x, unsigned& nloc, unsigned& nx) {
    const unsigned G = gridDim.x * gridDim.y * gridDim.z;
    unsigned sum, cnt, mine, sp = 0u;
    for (;;) {
        sum = 0u; cnt = 0u; mine = 0u;
#pragma unroll
        for (unsigned j = 0; j < 16; ++j) { const unsigned c = xb_ld(&bar[XB_XCNT(j)]); sum += c; cnt += (c > 0u) ? 1u : 0u; mine = (j == x) ? c : mine; }
        if (sum == G) break;
        __builtin_amdgcn_s_sleep(1);
        if ((++sp & 255u) == 0u) { if (xb_ld(&bar[XB_TMO])) break; if (sp > XB_SPIN_CAP) { atomicAdd(&bar[XB_TMO], 1u); break; } }
    }
    nloc = mine > 0u ? mine : 1u; nx = cnt > 0u ? cnt : 1u;
}
__device__ __forceinline__ void xcd_barrier(const XcdBarrier& b) {
    asm volatile("s_waitcnt vmcnt(0)" ::: "memory");
    __syncthreads();
    if (threadIdx.x == 0) {
        unsigned* bar = b.bar;
        __builtin_amdgcn_s_waitcnt(0);
        unsigned nloc = b.st[0], nx = b.st[1];
        if (nloc == 0u) { xcd_barrier_complete(bar, b.x, nloc, nx); b.st[0] = nloc; b.st[1] = nx; }
        const unsigned old = xb_add(&bar[XB_XSUB(b.x)], 1u);
        const unsigned gen = old / nloc;
        if (old + 1u == (gen + 1u) * nloc) {
            __builtin_amdgcn_fence(__ATOMIC_RELEASE, "agent");
            asm volatile("s_waitcnt vmcnt(0)" ::: "memory");
            const unsigned og = xb_add(&bar[XB_TOP], 1u);
            const unsigned tg = og / nx;
            if (og + 1u == (tg + 1u) * nx) xb_add(&bar[XB_TOPGEN], 1u);
            else XB_SPIN(xb_ld(&bar[XB_TOPGEN]) == tg, bar);
            __builtin_amdgcn_fence(__ATOMIC_ACQUIRE, "agent");
            xb_add(&bar[XB_XGEN(b.x)], 1u);
            asm volatile("s_waitcnt vmcnt(0)" ::: "memory");
        } else {
            XB_SPIN(xb_ld(&bar[XB_XGEN(b.x)]) == gen, bar);
            __builtin_amdgcn_fence(__ATOMIC_ACQUIRE, "agent");
            asm volatile("s_waitcnt vmcnt(0)" ::: "memory");
        }
    }
    __syncthreads();
}

struct Args {
    const float* x; const float* norm_mix; const float* w_in; const float* pe_k; const float* w1_k; const float* w2_k; const float* pe_v; const float* w1_v; const float* w2_v;
    const float* rel_bias; const float* w_ba; const float* w_bb; const float* w_out; const float* norm_mlp; const float* w_mi; const float* w_mo; const float* norm_final;
    float* out; unsigned char* ws;
};
constexpr size_t MiB = 1u << 20;
constexpr size_t WS_BAR = 0, WS_H = 1 * MiB, WS_PROJ = 65 * MiB, WS_MIX = 347 * MiB, WS_KCMP = 411 * MiB, WS_VCMP = 413 * MiB, WS_END = 416 * MiB;
constexpr int SMEM_BYTES = 32768;

#define PHASE_LOOP(nb, body) do { for (int vb = blockIdx.x; vb < (nb); vb += gridDim.x) { body; __syncthreads(); } } while (0)

__global__ void __launch_bounds__(256, 2) mega_naive(Args a) {
    extern __shared__ __attribute__((aligned(16))) char smem_all[];
    char* smem = smem_all + 16;
    if (threadIdx.x == 0) *(uint4*)smem_all = make_uint4(0u, 0u, 0u, 0u);
    __syncthreads();
    XcdBarrier bar = xcd_barrier_post((unsigned*)(a.ws + WS_BAR), (volatile LAS unsigned*)smem_all);
    __half* h = (__half*)(a.ws + WS_H); __half* o_a = h; __half* o_b = (__half*)(a.ws + WS_H + 32 * MiB);
    __half* proj = (__half*)(a.ws + WS_PROJ); __half* u = proj; __half* mix = (__half*)(a.ws + WS_MIX);
    float* kcmp = (float*)(a.ws + WS_KCMP); float* vcmp = (float*)(a.ws + WS_VCMP);
    float* out = a.out;

    PHASE_LOOP(M_, rmsnorm_k<__half>(smem, vb, a.x, a.norm_mix, h));
    xcd_barrier(bar);
    PHASE_LOOP((DIN / 64) * (M_ / 64), (gemm_naive<__half, EpiHalf>(smem, vb, DIN / 64, h, a.w_in, EpiHalf{proj}, D_, DIN, D_)));
    xcd_barrier(bar);
    PHASE_LOOP(B_ * NC * 2 * 2, compress_naive(smem, vb, proj, a.pe_k, a.w1_k, a.w2_k, a.pe_v, a.w1_v, a.w2_v, kcmp, vcmp));
    PHASE_LOOP(M_, dsa_naive(smem, vb, proj, a.rel_bias, o_a));
    xcd_barrier(bar);
    PHASE_LOOP(M_ * 2, nsa_naive(smem, vb, proj, a.rel_bias, kcmp, vcmp, o_b));
    xcd_barrier(bar);
    PHASE_LOOP((D_ / 64) * (M_ / 64), (gemm_naive<__half, EpiMixA>(smem, vb, D_ / 64, o_a, a.w_ba, EpiMixA{mix, proj}, 512, D_, 512)));
    PHASE_LOOP((D_ / 64) * (M_ / 64), (gemm_naive<__half, EpiMixB>(smem, vb, D_ / 64, o_b, a.w_bb, EpiMixB{mix, proj}, 512, D_, 512)));
    xcd_barrier(bar);
    PHASE_LOOP((D_ / 64) * (M_ / 64), (gemm_naive<__half, EpiResid>(smem, vb, D_ / 64, mix, a.w_out, EpiResid{a.x, out}, D_, D_, D_)));
    xcd_barrier(bar);
    PHASE_LOOP(M_, rmsnorm_k<__half>(smem, vb, out, a.norm_mlp, h));
    xcd_barrier(bar);
    PHASE_LOOP((DFF / 64) * (M_ / 64), (gemm_naive<__half, EpiRelu2>(smem, vb, DFF / 64, h, a.w_mi, EpiRelu2{u}, D_, DFF, D_)));
    xcd_barrier(bar);
    PHASE_LOOP((D_ / 64) * (M_ / 64), (gemm_naive<__half, EpiAcc>(smem, vb, D_ / 64, u, a.w_mo, EpiAcc{out}, DFF, D_, DFF)));
    xcd_barrier(bar);
    PHASE_LOOP(M_, final_norm_k(smem, vb, out, a.norm_final));
}
}

extern "C" void kernel_launch(void* const* d_in, const int* in_sizes, int n_in, void* d_out, int out_size, void* d_ws, size_t ws_size, hipStream_t stream) {
    if (ws_size < WS_END) { fprintf(stderr, "ws too small: %zu\n", ws_size); return; }
    static int grid = 0;
    constexpr size_t kDynLds = SMEM_BYTES + 16;
    if (!grid) {
        int dev = 0, cus = 0, per_cu = 0;
        hipGetDevice(&dev);
        hipDeviceGetAttribute(&cus, hipDeviceAttributeMultiprocessorCount, dev);
        hipOccupancyMaxActiveBlocksPerMultiprocessor(&per_cu, mega_naive, 256, kDynLds);
        if (per_cu < 1) per_cu = 1;
        grid = cus * (per_cu < 2 ? per_cu : 2);
    }
    hipMemsetAsync(d_ws, 0, XCD_BAR_WORDS * sizeof(unsigned), stream);
    Args a{};
    a.x = (const float*)d_in[0]; a.norm_mix = (const float*)d_in[1]; a.w_in = (const float*)d_in[2];
    a.pe_k = (const float*)d_in[3]; a.w1_k = (const float*)d_in[4]; a.w2_k = (const float*)d_in[5];
    a.pe_v = (const float*)d_in[6]; a.w1_v = (const float*)d_in[7]; a.w2_v = (const float*)d_in[8];
    a.rel_bias = (const float*)d_in[9]; a.w_ba = (const float*)d_in[10]; a.w_bb = (const float*)d_in[11];
    a.w_out = (const float*)d_in[12]; a.norm_mlp = (const float*)d_in[13]; a.w_mi = (const float*)d_in[14];
    a.w_mo = (const float*)d_in[15]; a.norm_final = (const float*)d_in[16];
    a.out = (float*)d_out; a.ws = (unsigned char*)d_ws;
    hipLaunchKernelGGL(mega_naive, dim3(grid), dim3(256), kDynLds, stream, a);
}
```

```cpp
#include <hip/hip_runtime.h>
#include <hip/hip_fp16.h>
#include <cstdint>
#include <cstdio>

namespace pg8 {
#define PG8_LAS __attribute__((address_space(3)))
typedef unsigned short bf16_t;
typedef _Float16 bf16x8 __attribute__((ext_vector_type(8)));
typedef float f32x4 __attribute__((ext_vector_type(4)));
typedef unsigned u32x4 __attribute__((ext_vector_type(4)));
constexpr int BM = 256, BK = 64, HALF = 128, HTB = HALF * BK * 2  , STAGE_BYTES = 8 * HTB, NXCD = 8, WGM = 8;

__host__ __device__ __forceinline__ int lds_byte(int r, int c) { const int st = (r >> 4) * 2 + (c >> 5), rr = r & 15, cc = c & 31, ob = rr * 64 + cc * 2; return st * 1024 + (ob ^ (((ob >> 9) & 1) << 5)); }
__host__ __device__ __forceinline__ void stage_rc(int b, int& R, int& C) { const int st = b / 1024, sb = b % 1024, swz = sb ^ (((sb >> 9) & 1) << 5); R = (st >> 1) * 16 + swz / 64; C = (st & 1) * 32 + (swz % 64) / 2; }
__host__ __device__ __forceinline__ int perm32(int rho) { const int n = rho >> 4, i = rho & 15; return 8 * (i >> 2) + 4 * n + (i & 3); }

struct Unit { int pm, pn; };
struct Gemm { const bf16_t* A; const bf16_t* Bt; int M, N, K; };

struct StaticOrder {
    int nM, nN, nwg, G, c;
    __host__ __device__ void init(int M, int N, int G_, int c_) { nM = M / BM; nN = N / BM; nwg = nM * nN; G = G_; c = c_; }
    __host__ __device__ bool next(int i, Unit& u) const {
        const long L = (long)i * G + c; if (L >= nwg) return false;
        int wgid = (int)L; { const int q = nwg / NXCD, r = nwg % NXCD, xcd = wgid % NXCD, off = wgid / NXCD; wgid = (xcd < r ? xcd * (q + 1) : r * (q + 1) + (xcd - r) * q) + off; }
        const int nig = WGM * nN, gid = wgid / nig, fm = gid * WGM, gsz = (nM - fm) < WGM ? (nM - fm) : WGM;
        u.pm = fm + ((wgid % nig) % gsz); u.pn = (wgid % nig) / gsz; return true;
    }
    __device__ __forceinline__ void a_ready(const Unit&) const {}
    __device__ __forceinline__ void done(const Unit&) const {}
};


typedef float f32x2 __attribute__((ext_vector_type(2)));
typedef _Float16 f16x2 __attribute__((ext_vector_type(2)));
constexpr int PW = 4352;
__device__ __forceinline__ unsigned pkh(float a, float b) { f32x2 v = {a, b}; f16x2 h = __builtin_convertvector(v, f16x2); return __builtin_bit_cast(unsigned, h); }
__device__ __forceinline__ float sigm(float v) { return __builtin_amdgcn_rcpf(1.f + __expf(-v)); }
__device__ __forceinline__ void unpk8(const u32x4 w, float (&f)[8]) {
#pragma unroll
    for (int i = 0; i < 4; ++i) { const unsigned wi = (i == 0) ? w.x : (i == 1) ? w.y : (i == 2) ? w.z : w.w; const f16x2 h = __builtin_bit_cast(f16x2, wi); f[2 * i] = (float)h.x; f[2 * i + 1] = (float)h.y; } }

struct EpiProj {
    static constexpr bool PERM = true, AFTER_DRAIN = false;
    _Float16* O;
    __device__ __forceinline__ void operator()(const f32x4 (&acc)[2][2][4][2], const Unit& u, int wr, int wc, int fr, int fq) const {
        const int row0 = u.pm * BM + wr * 64 + fr, col0 = u.pn * BM + wc * 32 + 8 * fq; const bool sg = u.pn >= 9;
#pragma unroll
        for (int ai = 0; ai < 2; ++ai)
#pragma unroll
            for (int m = 0; m < 4; ++m) { _Float16* rowp = O + (size_t)(row0 + ai * HALF + m * 16) * PW + col0;
#pragma unroll
                for (int bj = 0; bj < 2; ++bj) { f32x4 v0 = acc[ai][bj][m][0], v1 = acc[ai][bj][m][1];
                    if (sg) {
#pragma unroll
                        for (int i = 0; i < 4; ++i) { v0[i] = sigm(v0[i]); v1[i] = sigm(v1[i]); } }
                    u32x4 w; w.x = pkh(v0[0], v0[1]); w.y = pkh(v0[2], v0[3]); w.z = pkh(v1[0], v1[1]); w.w = pkh(v1[2], v1[3]);
                    *(u32x4*)(rowp + bj * HALF) = w; } }
    }
};
template <int SECOND> struct EpiMix {
    static constexpr bool PERM = true, AFTER_DRAIN = false;
    _Float16* mix; const _Float16* proj;
    __device__ __forceinline__ void operator()(const f32x4 (&acc)[2][2][4][2], const Unit& u, int wr, int wc, int fr, int fq) const {
        const int row0 = u.pm * BM + wr * 64 + fr, col0 = u.pn * BM + wc * 32 + 8 * fq;
#pragma unroll
        for (int ai = 0; ai < 2; ++ai)
#pragma unroll
            for (int m = 0; m < 4; ++m) { const size_t r = (size_t)(row0 + ai * HALF + m * 16);
#pragma unroll
                for (int bj = 0; bj < 2; ++bj) { const int c = col0 + bj * HALF;
                    float g[8]; unpk8(*(const u32x4*)(proj + r * PW + 2304 + SECOND * 1024 + c), g);
                    const f32x4 v0 = acc[ai][bj][m][0], v1 = acc[ai][bj][m][1];
                    float o[8] = {g[0] * v0[0], g[1] * v0[1], g[2] * v0[2], g[3] * v0[3], g[4] * v1[0], g[5] * v1[1], g[6] * v1[2], g[7] * v1[3]};
                    if (SECOND) { float p[8]; unpk8(*(const u32x4*)(mix + r * 1024 + c), p);
#pragma unroll
                        for (int i = 0; i < 8; ++i) o[i] += p[i]; }
                    u32x4 w; w.x = pkh(o[0], o[1]); w.y = pkh(o[2], o[3]); w.z = pkh(o[4], o[5]); w.w = pkh(o[6], o[7]);
                    *(u32x4*)(mix + r * 1024 + c) = w; } }
    }
};
struct EpiPlain {
    static constexpr bool PERM = true, AFTER_DRAIN = false;
    _Float16* U;
    __device__ __forceinline__ void operator()(const f32x4 (&acc)[2][2][4][2], const Unit& u, int wr, int wc, int fr, int fq) const {
        const int row0 = u.pm * BM + wr * 64 + fr, col0 = u.pn * BM + wc * 32 + 8 * fq;
#pragma unroll
        for (int ai = 0; ai < 2; ++ai)
#pragma unroll
            for (int m = 0; m < 4; ++m) { _Float16* rowp = U + (size_t)(row0 + ai * HALF + m * 16) * 1024 + col0;
#pragma unroll
                for (int bj = 0; bj < 2; ++bj) { f32x4 v0 = acc[ai][bj][m][0], v1 = acc[ai][bj][m][1];
                    u32x4 w; w.x = pkh(v0[0], v0[1]); w.y = pkh(v0[2], v0[3]); w.z = pkh(v1[0], v1[1]); w.w = pkh(v1[2], v1[3]);
                    *(u32x4*)(rowp + bj * HALF) = w; } }
    }
};
struct EpiResid {
    static constexpr bool PERM = true, AFTER_DRAIN = false;
    const float* x; float* out;
    __device__ __forceinline__ void operator()(const f32x4 (&acc)[2][2][4][2], const Unit& u, int wr, int wc, int fr, int fq) const {
        const int row0 = u.pm * BM + wr * 64 + fr, col0 = u.pn * BM + wc * 32 + 8 * fq;
#pragma unroll
        for (int ai = 0; ai < 2; ++ai)
#pragma unroll
            for (int m = 0; m < 4; ++m) { const size_t r = (size_t)(row0 + ai * HALF + m * 16);
#pragma unroll
                for (int bj = 0; bj < 2; ++bj) { const size_t o = r * 1024 + col0 + bj * HALF;
                    const f32x4 a0 = *(const f32x4*)(x + o), a1 = *(const f32x4*)(x + o + 4);
                    *(f32x4*)(out + o) = a0 + acc[ai][bj][m][0]; *(f32x4*)(out + o + 4) = a1 + acc[ai][bj][m][1]; } }
    }
};
struct EpiRelu2 {
    static constexpr bool PERM = true, AFTER_DRAIN = false;
    _Float16* U;
    __device__ __forceinline__ void operator()(const f32x4 (&acc)[2][2][4][2], const Unit& u, int wr, int wc, int fr, int fq) const {
        const int row0 = u.pm * BM + wr * 64 + fr, col0 = u.pn * BM + wc * 32 + 8 * fq;
#pragma unroll
        for (int ai = 0; ai < 2; ++ai)
#pragma unroll
            for (int m = 0; m < 4; ++m) { _Float16* rowp = U + (size_t)(row0 + ai * HALF + m * 16) * 4096 + col0;
#pragma unroll
                for (int bj = 0; bj < 2; ++bj) { f32x4 v0 = acc[ai][bj][m][0], v1 = acc[ai][bj][m][1];
#pragma unroll
                    for (int i = 0; i < 4; ++i) { const float a = fmaxf(v0[i], 0.f), b = fmaxf(v1[i], 0.f); v0[i] = a * a; v1[i] = b * b; }
                    u32x4 w; w.x = pkh(v0[0], v0[1]); w.y = pkh(v0[2], v0[3]); w.z = pkh(v1[0], v1[1]); w.w = pkh(v1[2], v1[3]);
                    *(u32x4*)(rowp + bj * HALF) = w; } }
    }
};
template <class Epi, class Sched, bool ALIGN_EPI = false, bool SP2 = false>
__device__ __forceinline__ void gemm_phase(PG8_LAS unsigned char* lds, const Gemm g, const Sched& S, const Epi& E) {
    const int tid = threadIdx.x, wid = __builtin_amdgcn_readfirstlane(tid >> 6), lane = tid & 63, wr = wid >> 2, wc = wid & 3, fr = lane & 15, fq = lane >> 4;
    const int K = g.K, nt = K / BK;
    unsigned voffA[2], voffB[2];
#pragma unroll
    for (int i = 0; i < 2; ++i) { int R, C; stage_rc(tid * 16 + i * 8192, R, C); const int Rb = Epi::PERM ? ((R & ~31) + perm32(R & 31)) : R;
        voffA[i] = (unsigned)(R * K + C) * 2u; voffB[i] = (unsigned)(Rb * K + C) * 2u; }
    const size_t kstep = (size_t)(BK * 2);
    const size_t hstep = (size_t)HALF * K * 2;
    const size_t tstep = 2 * hstep;
    const unsigned ldsw = (unsigned)wid * 1024u;
    const int aoff = lds_byte(wr * 64 + fr, fq * 8), boff = lds_byte(wc * 32 + fr, fq * 8);
#define PG8_SA(b, h) (((b) * 2 + (h)) * HTB)
#define PG8_SB(b, h) ((4 + (b) * 2 + (h)) * HTB)
#define PG8_STAGE(bufoff, gbase, voff) do { _Pragma("unroll") for (int _i = 0; _i < 2; ++_i) \
        __builtin_amdgcn_global_load_lds((const unsigned*)((const char*)(gbase) + (voff)[_i]), (PG8_LAS unsigned*)(lds + (bufoff) + ldsw + _i * 8192), 16, 0, 0); } while (0)
#define PG8_LDA(dst, b, h) do { _Pragma("unroll") for (int m = 0; m < 4; ++m) _Pragma("unroll") for (int k = 0; k < 2; ++k) dst[m][k] = *(const PG8_LAS bf16x8*)(lds + PG8_SA(b, h) + aoff + m * 2048 + k * 1024); } while (0)
#define PG8_LDB(dst, b, h) do { _Pragma("unroll") for (int n = 0; n < 2; ++n) _Pragma("unroll") for (int k = 0; k < 2; ++k) dst[n][k] = *(const PG8_LAS bf16x8*)(lds + PG8_SB(b, h) + boff + n * 2048 + k * 1024); } while (0)
#define PG8_MMA(ai, bj, At, Bt) do { __builtin_amdgcn_s_setprio(1); _Pragma("unroll") for (int m = 0; m < 4; ++m) _Pragma("unroll") for (int n = 0; n < 2; ++n) _Pragma("unroll") for (int k = 0; k < 2; ++k) \
        acc[ai][bj][m][n] = __builtin_amdgcn_mfma_f32_16x16x32_f16(Bt[n][k], At[m][k], acc[ai][bj][m][n], 0, 0, 0); __builtin_amdgcn_s_setprio(0); } while (0)
#define PG8_WAIT_V(n) asm volatile("s_waitcnt vmcnt(" #n ")" ::: "memory")
#define PG8_WAIT_L(n) asm volatile("s_waitcnt lgkmcnt(" #n ")" ::: "memory")
#define PG8_BAR __builtin_amdgcn_s_barrier()
#define PG8_SCHED __builtin_amdgcn_sched_barrier(0)
    Unit cur, nxt; int ui = 0;
    if (!S.next(0, cur)) return;
    f32x4 acc[2][2][4][2];
#pragma unroll
    for (int a = 0; a < 2; ++a)
#pragma unroll
        for (int b = 0; b < 2; ++b)
#pragma unroll
            for (int m = 0; m < 4; ++m)
#pragma unroll
                for (int n = 0; n < 2; ++n) acc[a][b][m][n] = (f32x4){0.f, 0.f, 0.f, 0.f};
    bf16x8 At[4][2], B0[2][2], B1[2][2];
    const char* cA = (const char*)g.A + (size_t)cur.pm * tstep; const char* cB = (const char*)g.Bt + (size_t)cur.pn * tstep;
    S.a_ready(cur);
    if constexpr (SP2) {
        PG8_STAGE(PG8_SB(0, 0), cB, voffB); PG8_STAGE(PG8_SB(0, 1), cB + hstep, voffB); PG8_STAGE(PG8_SA(0, 0), cA, voffA); PG8_STAGE(PG8_SA(0, 1), cA + hstep, voffA);
        if (wr == 1) PG8_BAR;
        PG8_WAIT_V(2); PG8_BAR;
        PG8_STAGE(PG8_SB(1, 0), cB + kstep, voffB); PG8_STAGE(PG8_SA(1, 0), cA + kstep, voffA); PG8_STAGE(PG8_SB(1, 1), cB + hstep + kstep, voffB);
        PG8_WAIT_V(6); PG8_BAR;
    } else {
        PG8_STAGE(PG8_SB(0, 0), cB, voffB); PG8_STAGE(PG8_SA(0, 0), cA, voffA); PG8_STAGE(PG8_SB(0, 1), cB + hstep, voffB); PG8_STAGE(PG8_SA(0, 1), cA + hstep, voffA);
        if (wr == 1) PG8_BAR;
        PG8_WAIT_V(4); PG8_BAR;
        PG8_STAGE(PG8_SB(1, 0), cB + kstep, voffB); PG8_STAGE(PG8_SA(1, 0), cA + kstep, voffA); PG8_STAGE(PG8_SB(1, 1), cB + hstep + kstep, voffB);
        PG8_WAIT_V(6); PG8_BAR;
    }
    for (;;) {
        const bool has_next = S.next(ui + 1, nxt);
        const char* nA = has_next ? (const char*)g.A + (size_t)nxt.pm * tstep : cA; const char* nB = has_next ? (const char*)g.Bt + (size_t)nxt.pn * tstep : cB;
        for (int t = 0; t < nt; t += 2) {
            const bool last = (t == nt - 2);
            const char* a1 = cA + (size_t)(t + 1) * kstep;
            const char* a2 = last ? nA : cA + (size_t)(t + 2) * kstep; const char* b2 = last ? nB : cB + (size_t)(t + 2) * kstep;
            const char* a3 = a2 + kstep; const char* b3 = b2 + kstep;
            if (last && has_next) S.a_ready(nxt);
            if constexpr (SP2) {
            PG8_LDB(B0, 0, 0); PG8_LDB(B1, 0, 1); PG8_SCHED; PG8_LDA(At, 0, 0); PG8_STAGE(PG8_SA(1, 1), a1 + hstep, voffA);
            PG8_WAIT_V(8); PG8_WAIT_L(0); PG8_BAR; PG8_MMA(0, 0, At, B0); PG8_MMA(0, 1, At, B1); PG8_BAR; PG8_SCHED;
            PG8_LDA(At, 0, 1); PG8_STAGE(PG8_SB(0, 0), b2, voffB); PG8_STAGE(PG8_SB(0, 1), b2 + hstep, voffB); PG8_STAGE(PG8_SA(0, 0), a2, voffA);
            PG8_WAIT_V(8); PG8_WAIT_L(0); PG8_BAR; PG8_MMA(1, 0, At, B0); PG8_MMA(1, 1, At, B1); PG8_BAR; PG8_SCHED;
            PG8_LDB(B0, 1, 0); PG8_LDB(B1, 1, 1); PG8_SCHED; PG8_LDA(At, 1, 0); PG8_STAGE(PG8_SA(0, 1), a2 + hstep, voffA);
            PG8_WAIT_V(8); PG8_WAIT_L(0); PG8_BAR; PG8_MMA(0, 0, At, B0); PG8_MMA(0, 1, At, B1); PG8_BAR; PG8_SCHED;
            PG8_LDA(At, 1, 1); PG8_STAGE(PG8_SB(1, 0), b3, voffB); PG8_STAGE(PG8_SB(1, 1), b3 + hstep, voffB); PG8_STAGE(PG8_SA(1, 0), a3, voffA);
            PG8_WAIT_V(8); PG8_WAIT_L(0); PG8_BAR; PG8_MMA(1, 0, At, B0); PG8_MMA(1, 1, At, B1); PG8_BAR; PG8_SCHED;
            } else {
            PG8_LDB(B0, 0, 0); PG8_SCHED; PG8_LDA(At, 0, 0); PG8_STAGE(PG8_SA(1, 1), a1 + hstep, voffA);
            PG8_WAIT_L(8); PG8_BAR; PG8_WAIT_L(0); PG8_MMA(0, 0, At, B0); PG8_BAR; PG8_SCHED;
            PG8_LDB(B1, 0, 1); PG8_STAGE(PG8_SB(0, 0), b2, voffB);
            PG8_BAR; PG8_WAIT_L(0); PG8_MMA(0, 1, At, B1); PG8_BAR;
            PG8_LDA(At, 0, 1); PG8_STAGE(PG8_SA(0, 0), a2, voffA);
            PG8_BAR; PG8_WAIT_L(0); PG8_MMA(1, 0, At, B0); PG8_BAR; PG8_SCHED;
            PG8_STAGE(PG8_SB(0, 1), b2 + hstep, voffB);
            PG8_WAIT_V(6); PG8_BAR; PG8_MMA(1, 1, At, B1); PG8_BAR;
            PG8_LDB(B0, 1, 0); PG8_SCHED; PG8_LDA(At, 1, 0); PG8_STAGE(PG8_SA(0, 1), a2 + hstep, voffA);
            PG8_WAIT_L(8); PG8_BAR; PG8_WAIT_L(0); PG8_MMA(0, 0, At, B0); PG8_BAR; PG8_SCHED;
            PG8_LDB(B1, 1, 1); PG8_STAGE(PG8_SB(1, 0), b3, voffB);
            PG8_BAR; PG8_WAIT_L(0); PG8_MMA(0, 1, At, B1); PG8_BAR;
            PG8_LDA(At, 1, 1); PG8_STAGE(PG8_SA(1, 0), a3, voffA);
            PG8_BAR; PG8_WAIT_L(0); PG8_MMA(1, 0, At, B0); PG8_BAR; PG8_SCHED;
            PG8_STAGE(PG8_SB(1, 1), b3 + hstep, voffB);
            PG8_WAIT_V(6); PG8_BAR; PG8_MMA(1, 1, At, B1); PG8_BAR;
            }
        }
        if constexpr (ALIGN_EPI) { if (wr == 0) PG8_BAR; }
        if constexpr (!Epi::AFTER_DRAIN) { E(acc, cur, wr, wc, fr, fq); S.done(cur); }
        if (!has_next) break;
#pragma unroll
        for (int a = 0; a < 2; ++a)
#pragma unroll
            for (int b = 0; b < 2; ++b)
#pragma unroll
                for (int m = 0; m < 4; ++m)
#pragma unroll
                    for (int n = 0; n < 2; ++n) acc[a][b][m][n] = (f32x4){0.f, 0.f, 0.f, 0.f};
        cur = nxt; cA = nA; cB = nB; ++ui;
        if constexpr (ALIGN_EPI) { if (wr == 1) PG8_BAR; }
    }
    PG8_WAIT_V(0);
    if constexpr (!ALIGN_EPI) { if (wr == 0) PG8_BAR; }
    PG8_BAR;
    if constexpr (Epi::AFTER_DRAIN) { E.fused(acc, cur, wr, wc, fr, fq, lds, wid, lane); S.done(cur); }
#undef PG8_SA
#undef PG8_SB
#undef PG8_STAGE
#undef PG8_LDA
#undef PG8_LDB
#undef PG8_MMA
#undef PG8_WAIT_V
#undef PG8_WAIT_L
#undef PG8_BAR
#undef PG8_SCHED
}
}


namespace {
constexpr int B_ = 8, S_ = 4096, M_ = B_ * S_, D_ = 1024, DIN = 4288, DFF = 4096;
constexpr int C_QA = 0, C_QB = 512, C_QI = 1024, C_KVB = 1280, C_KA = 2048, C_VA = 2112, C_KI = 2176, C_WI = 2208, C_GB = 2216, C_GATE = 2304;
constexpr int NC = 255;
constexpr float EPS = 1e-6f;
using pg8::PW;
#define GAS __attribute__((address_space(1)))
#define LAS __attribute__((address_space(3)))
typedef unsigned v4u __attribute__((ext_vector_type(4)));
typedef float f32x4 __attribute__((ext_vector_type(4)));

__device__ __forceinline__ int t5_bucket(int n) {
    if (n < 16) return n < 0 ? 0 : n;
    float nf = (float)n;
    int large = 16 + (int)(logf(nf / 16.f) / logf(8.f) * 16.f);
    return large < 31 ? large : 31;
}
__device__ __forceinline__ float sigmoidf_(float v) { return 1.f / (1.f + expf(-v)); }


__device__ __forceinline__ int win_src_col(int n) {
    if (n < 512) return n;
    if (n < 1024) return 936 + (n - 512);
    if (n < 1280) return 640 + (n - 1024);
    if (n < 2048) return 1448 + (n - 1280);
    if (n < 2112) return 512 + (n - 2048);
    if (n < 2176) return 576 + (n - 2112);
    if (n < 2208) return 896 + (n - 2176);
    if (n < 2216) return 928 + (n - 2208);
    if (n < 2240) return n;
    if (n < 2304) return -1;
    return 2240 + (n - 2304);
}
__device__ __forceinline__ float wave_sum(float v) {
#pragma unroll
    for (int o = 1; o < 64; o <<= 1) v += __shfl_xor(v, o);
    return v;
}
template <bool MAP>
__device__ __forceinline__ void transpose_item(const float* __restrict__ W, int K, int Nsrc, int Ndst, _Float16* __restrict__ WT, const float* __restrict__ gain, float* scr, int item, int lane) {
    const int nblk = Ndst / 32, kb = item / nblk, nb = item % nblk, k0 = 64 * kb, n0 = 32 * nb;
    const int nd = n0 + (lane & 31); const int ns = MAP ? win_src_col(nd) : nd;
#pragma unroll 8
    for (int i = 0; i < 32; ++i) { const int kk = 2 * i + (lane >> 5); float v = 0.f;
        if (ns >= 0) { v = W[(size_t)(k0 + kk) * Nsrc + ns]; if (gain) v *= gain[k0 + kk]; }
        scr[kk * 33 + (lane & 31)] = v; }
    __builtin_amdgcn_s_waitcnt(0xc07f); asm volatile("" ::: "memory");
    const int c = lane & 7;
#pragma unroll
    for (int j = 0; j < 4; ++j) { const int n = (lane >> 3) + 8 * j; const float* s = scr + (8 * c) * 33 + n;
        v4u o; o.x = pg8::pkh(s[0 * 33], s[1 * 33]); o.y = pg8::pkh(s[2 * 33], s[3 * 33]); o.z = pg8::pkh(s[4 * 33], s[5 * 33]); o.w = pg8::pkh(s[6 * 33], s[7 * 33]);
        *(v4u*)(WT + (size_t)(n0 + n) * K + k0 + 8 * c) = o; }
    __builtin_amdgcn_s_waitcnt(0xc07f); asm volatile("" ::: "memory");
}
__device__ __forceinline__ void rms_row_to_f16(const float* __restrict__ xrow, _Float16* __restrict__ orow, int lane) {
    const f32x4* xr = (const f32x4*)xrow + lane;
    f32x4 v[4]; float s = 0.f;
#pragma unroll
    for (int j = 0; j < 4; ++j) { v[j] = xr[64 * j]; s += (v[j].x * v[j].x + v[j].y * v[j].y) + (v[j].z * v[j].z + v[j].w * v[j].w); }
    const float rstd = rsqrtf(wave_sum(s) * (1.f / D_) + EPS);
    unsigned long long* o8 = (unsigned long long*)orow + lane;
#pragma unroll
    for (int j = 0; j < 4; ++j) o8[64 * j] = (unsigned long long)pg8::pkh(v[j].x * rstd, v[j].y * rstd) | ((unsigned long long)pg8::pkh(v[j].z * rstd, v[j].w * rstd) << 32);
}

struct Args {
    const float* x; const float* norm_mix; const float* w_in; const float* pe_k; const float* w1_k; const float* w2_k; const float* pe_v; const float* w1_v; const float* w2_v;
    const float* rel_bias; const float* w_ba; const float* w_bb; const float* w_out; const float* norm_mlp; const float* w_mi; const float* w_mo; const float* norm_final;
    float* out; unsigned char* ws;
};
constexpr size_t MiB = 1u << 20;
constexpr size_t WS_CTL = 0, WS_WIN = 1 * MiB, WS_WBA = 10 * MiB, WS_WBB = 11 * MiB, WS_WOUT = 12 * MiB, WS_WMI = 14 * MiB, WS_WMO = 22 * MiB, WS_CW = 30 * MiB,
                 WS_KCMP = 32 * MiB, WS_VCMP = 33 * MiB, WS_H = 34 * MiB, WS_PROJ = 98 * MiB, WS_MIX = 370 * MiB, WS_END = 434 * MiB;

__global__ void __launch_bounds__(512, 2) k_prologue(Args a) {
    extern __shared__ __attribute__((aligned(16))) unsigned char lds[];
    const int tid = threadIdx.x, lane = tid & 63, wave = tid >> 6;
    float* scr = (float*)(lds + wave * 8704);
    const int gw = blockIdx.x * 8 + wave, NGW = gridDim.x * 8;
    constexpr int I_IN = (D_ / 64) * (PW / 32), I_BA = (512 / 64) * (D_ / 32), I_OUT = (D_ / 64) * (D_ / 32), I_MI = (D_ / 64) * (DFF / 32), I_MO = (DFF / 64) * (D_ / 32);
    constexpr int NITEMS = I_IN + 2 * I_BA + I_OUT + I_MI + I_MO;
    for (int it = gw; it < NITEMS; it += NGW) {
        int r = it;
        if (r < I_IN) { transpose_item<true>(a.w_in, D_, DIN, PW, (_Float16*)(a.ws + WS_WIN), a.norm_mix, scr, r, lane); continue; } r -= I_IN;
        if (r < I_BA) { transpose_item<false>(a.w_ba, 512, D_, D_, (_Float16*)(a.ws + WS_WBA), nullptr, scr, r, lane); continue; } r -= I_BA;
        if (r < I_BA) { transpose_item<false>(a.w_bb, 512, D_, D_, (_Float16*)(a.ws + WS_WBB), nullptr, scr, r, lane); continue; } r -= I_BA;
        if (r < I_OUT) { transpose_item<false>(a.w_out, D_, D_, D_, (_Float16*)(a.ws + WS_WOUT), nullptr, scr, r, lane); continue; } r -= I_OUT;
        if (r < I_MI) { transpose_item<false>(a.w_mi, D_, DFF, DFF, (_Float16*)(a.ws + WS_WMI), a.norm_mlp, scr, r, lane); continue; } r -= I_MI;
        transpose_item<false>(a.w_mo, DFF, D_, D_, (_Float16*)(a.ws + WS_WMO), nullptr, scr, r, lane);
    }
    for (int m = gw; m < M_; m += NGW) rms_row_to_f16(a.x + (size_t)m * D_, (_Float16*)(a.ws + WS_H) + (size_t)m * D_, lane);
}
__global__ void __launch_bounds__(512, 2) k_rows_norm(const float* __restrict__ src, _Float16* __restrict__ dst) {
    const int lane = threadIdx.x & 63, gw = blockIdx.x * 8 + (threadIdx.x >> 6), NGW = gridDim.x * 8;
    for (int m = gw; m < M_; m += NGW) rms_row_to_f16(src + (size_t)m * D_, dst + (size_t)m * D_, lane);
}
template <class Epi>
__global__ void __launch_bounds__(512, 2) k_gemm(const void* A, const void* Bt, Epi E, int M, int N, int K, int pad_) {
    extern __shared__ __attribute__((aligned(16))) unsigned char lds[];
    pg8::Gemm g{(const pg8::bf16_t*)A, (const pg8::bf16_t*)Bt, M, N, K};
    pg8::StaticOrder S; S.init(M, N, (int)gridDim.x, (int)blockIdx.x);
    pg8::gemm_phase<Epi, pg8::StaticOrder, true, true>((PG8_LAS unsigned char*)lds, g, S, E);
}
struct EpiAccOut {
    static constexpr bool PERM = true, AFTER_DRAIN = false;
    float* out;
    __device__ __forceinline__ void operator()(const f32x4 (&acc)[2][2][4][2], const pg8::Unit& u, int wr, int wc, int fr, int fq) const {
        const int row0 = u.pm * 256 + wr * 64 + fr, col0 = u.pn * 256 + wc * 32 + 8 * fq;
#pragma unroll
        for (int ai = 0; ai < 2; ++ai)
#pragma unroll
            for (int m = 0; m < 4; ++m) { const size_t r = (size_t)(row0 + ai * 128 + m * 16);
#pragma unroll
                for (int bj = 0; bj < 2; ++bj) { const size_t o = r * 1024 + col0 + bj * 128;
                    const f32x4 a0 = *(const f32x4*)(out + o), a1 = *(const f32x4*)(out + o + 4);
                    *(f32x4*)(out + o) = a0 + acc[ai][bj][m][0]; *(f32x4*)(out + o + 4) = a1 + acc[ai][bj][m][1]; } }
    }
};

template <typename TA, typename Epi>
__global__ __launch_bounds__(256) void gemm_naive(const TA* __restrict__ A, const float* __restrict__ Bm, Epi epi, int lda, int ldb, int K, int pad_) {
    __shared__ float As[16][68];
    __shared__ float Bs[16][68];
    const int tid = threadIdx.x, tx = tid & 15, ty = tid >> 4;
    const int m0 = blockIdx.y * 64, n0 = blockIdx.x * 64;
    float acc[4][4];
#pragma unroll
    for (int i = 0; i < 4; ++i)
#pragma unroll
        for (int j = 0; j < 4; ++j) acc[i][j] = 0.f;
    for (int k0 = 0; k0 < K; k0 += 16) {
#pragma unroll
        for (int i = 0; i < 4; ++i) { const int e = tid + i * 256; const int m = e >> 4, k = e & 15; As[k][m] = (float)A[(size_t)(m0 + m) * lda + k0 + k]; }
#pragma unroll
        for (int i = 0; i < 4; ++i) { const int e = tid + i * 256; const int k = e >> 6, n = e & 63; Bs[k][n] = Bm[(size_t)(k0 + k) * ldb + n0 + n]; }
        __syncthreads();
#pragma unroll
        for (int k = 0; k < 16; ++k) {
            float a[4], b[4];
#pragma unroll
            for (int i = 0; i < 4; ++i) { a[i] = As[k][ty * 4 + i]; b[i] = Bs[k][tx * 4 + i]; }
#pragma unroll
            for (int i = 0; i < 4; ++i)
#pragma unroll
                for (int j = 0; j < 4; ++j) acc[i][j] += a[i] * b[j];
        }
        __syncthreads();
    }
#pragma unroll
    for (int i = 0; i < 4; ++i)
#pragma unroll
        for (int j = 0; j < 4; ++j) epi(m0 + ty * 4 + i, n0 + tx * 4 + j, acc[i][j]);
}


struct NEpiMixA { __half* mix; const __half* proj; __device__ void operator()(int r, int c, float v) const {
    const float g = __half2float(proj[(size_t)r * PW + C_GATE + c]); mix[(size_t)r * D_ + c] = __float2half(g * v); } };
struct NEpiMixB { __half* mix; const __half* proj; __device__ void operator()(int r, int c, float v) const {
    const float g = __half2float(proj[(size_t)r * PW + C_GATE + 1024 + c]); mix[(size_t)r * D_ + c] = __float2half(__half2float(mix[(size_t)r * D_ + c]) + g * v); } };
__global__ void k_gate(const __half* __restrict__ tmp, const __half* __restrict__ proj, __half* __restrict__ mix) {
    const size_t i = (size_t)blockIdx.x * 256 + threadIdx.x; const size_t r = i >> 10; const int c = (int)(i & 1023);
    mix[i] = __float2half(__half2float(tmp[i]) * __half2float(proj[r * PW + C_GATE + c]));
}
__global__ __launch_bounds__(256) void dsa_naive(const __half* __restrict__ proj, const float* __restrict__ rel_bias, __half* __restrict__ o_a) {
    __shared__ float qs[8][32];
    __shared__ float wv[8];
    __shared__ unsigned keys[4096];
    __shared__ int sel[256];
    __shared__ int nsel_s;
    __shared__ unsigned hist[256];
    __shared__ unsigned sel_prefix, sel_k;
    __shared__ float qa[8][64];
    __shared__ float p[8][256];
    const int row = blockIdx.x, tid = threadIdx.x, b = row / S_, t = row % S_;
    const __half* pr = proj + (size_t)row * PW;
    { const int h = tid >> 5, d = tid & 31; qs[h][d] = __half2float(pr[C_QI + h * 32 + d]); }
    if (tid < 8) wv[tid] = __half2float(pr[C_WI + tid]) * (1.f / 16.f);
    for (int i = tid; i < 512; i += 256) qa[i >> 6][i & 63] = __half2float(pr[C_QA + i]);
    if (tid == 0) nsel_s = 0;
    __syncthreads();
    const int n = t + 1;
    for (int s = tid; s < n; s += 256) {
        const __half* kr = proj + (size_t)(b * S_ + s) * PW + C_KI;
        float a8[8];
#pragma unroll
        for (int h = 0; h < 8; ++h) a8[h] = 0.f;
#pragma unroll 4
        for (int d = 0; d < 32; ++d) { const float kvd = __half2float(kr[d]);
#pragma unroll
            for (int h = 0; h < 8; ++h) a8[h] += qs[h][d] * kvd; }
        float sc = 0.f;
#pragma unroll
        for (int h = 0; h < 8; ++h) sc += wv[h] * (a8[h] > 0.f ? a8[h] : 0.f);
        unsigned u = __float_as_uint(sc);
        keys[s] = (u & 0x80000000u) ? ~u : (u | 0x80000000u);
    }
    __syncthreads();
    if (n <= 256) {
        if (tid < n) sel[tid] = tid;
        if (tid == 0) nsel_s = n;
        __syncthreads();
    } else {
        unsigned prefix = 0, mask = 0, kk = 256;
        for (int shift = 24; shift >= 0; shift -= 8) {
            hist[tid] = 0;
            __syncthreads();
            for (int s = tid; s < n; s += 256) { const unsigned k = keys[s]; if ((k & mask) == prefix) atomicAdd(&hist[(k >> shift) & 255u], 1u); }
            __syncthreads();
            if (tid == 0) { unsigned cum = 0; int d = 255; for (; d > 0; --d) { if (cum + hist[d] >= kk) break; cum += hist[d]; } sel_prefix = prefix | ((unsigned)d << shift); sel_k = kk - cum; }
            __syncthreads();
            prefix = sel_prefix; kk = sel_k; mask |= 0xFFu << shift;
            __syncthreads();
        }
        const unsigned T = prefix;
        for (int s = tid; s < n; s += 256) if (keys[s] > T) { const int pos = atomicAdd(&nsel_s, 1); sel[pos] = s; }
        __syncthreads();
        if (tid == 0) { int pos = nsel_s; unsigned need = kk; for (int s = 0; s < n && need > 0; ++s) if (keys[s] == T) { sel[pos++] = s; --need; } nsel_s = pos; }
        __syncthreads();
    }
    const int ns = nsel_s;
    {
        const int j = tid;
        if (j < ns) {
            const int idx = sel[j];
            const __half* kr = proj + (size_t)(b * S_ + idx) * PW + C_KA;
            float a8[8];
#pragma unroll
            for (int h = 0; h < 8; ++h) a8[h] = 0.f;
#pragma unroll 4
            for (int d = 0; d < 64; ++d) { const float kvd = __half2float(kr[d]);
#pragma unroll
                for (int h = 0; h < 8; ++h) a8[h] += qa[h][d] * kvd; }
            const int bk = t5_bucket(t - idx);
#pragma unroll
            for (int h = 0; h < 8; ++h) p[h][j] = a8[h] * 0.125f + rel_bias[bk * 16 + h];
        } else {
#pragma unroll
            for (int h = 0; h < 8; ++h) p[h][j] = -INFINITY;
        }
    }
    __syncthreads();
    {
        const int w = tid >> 6, lane = tid & 63;
        for (int hh = 0; hh < 2; ++hh) { const int h = w * 2 + hh;
            float v[4], mx = -INFINITY;
#pragma unroll
            for (int i = 0; i < 4; ++i) { v[i] = p[h][lane + 64 * i]; mx = fmaxf(mx, v[i]); }
#pragma unroll
            for (int o = 32; o > 0; o >>= 1) mx = fmaxf(mx, __shfl_xor(mx, o));
            float sm = 0.f;
#pragma unroll
            for (int i = 0; i < 4; ++i) { v[i] = (v[i] == -INFINITY) ? 0.f : expf(v[i] - mx); sm += v[i]; }
#pragma unroll
            for (int o = 32; o > 0; o >>= 1) sm += __shfl_xor(sm, o);
            const float inv = 1.f / fmaxf(sm, 1e-30f);
#pragma unroll
            for (int i = 0; i < 4; ++i) p[h][lane + 64 * i] = v[i] * inv; }
    }
    __syncthreads();
    for (int o = tid; o < 512; o += 256) { const int h = o >> 6, d = o & 63; float a = 0.f;
        for (int j = 0; j < ns; ++j) a += p[h][j] * __half2float(proj[(size_t)(b * S_ + sel[j]) * PW + C_VA + d]);
        o_a[(size_t)row * 512 + o] = __float2half(a); }
}

__global__ __launch_bounds__(128) void compress_naive(const __half* __restrict__ proj, const float* __restrict__ pe_k, const float* __restrict__ w1_k, const float* __restrict__ w2_k,
                                                      const float* __restrict__ pe_v, const float* __restrict__ w1_v, const float* __restrict__ w2_v, float* __restrict__ kcmp, float* __restrict__ vcmp) {
    __shared__ float blk[2048];
    __shared__ float hid[128];
    int id = blockIdx.x; const int kv = id & 1; id >>= 1; const int g = id & 1; id >>= 1; const int c = id % NC, b = id / NC;
    const float* pe = kv ? pe_v : pe_k; const float* w1 = kv ? w1_v : w1_k; const float* w2 = kv ? w2_v : w2_k;
    const int tid = threadIdx.x;
    for (int i = tid; i < 2048; i += 128) { const int l = i >> 6, d = i & 63;
        blk[i] = __half2float(proj[(size_t)(b * S_ + 16 * c + l) * PW + C_KVB + kv * 128 + g * 64 + d]) + pe[i]; }
    __syncthreads();
    { float a = 0.f; for (int k = 0; k < 2048; ++k) a += blk[k] * w1[k * 128 + tid];
      const float x3 = a * a * a; hid[tid] = 0.5f * a * (1.f + tanhf(0.7978845608028654f * (a + 0.044715f * x3))); }
    __syncthreads();
    if (tid < 64) { float a = 0.f; for (int k = 0; k < 128; ++k) a += hid[k] * w2[k * 64 + tid];
        (kv ? vcmp : kcmp)[((size_t)(b * NC + c) * 2 + g) * 64 + tid] = a; }
}

__device__ __forceinline__ void softmax_row(float* pr, int n, int lane) {
    float mx = -INFINITY;
    for (int i = lane; i < n; i += 64) mx = fmaxf(mx, pr[i]);
#pragma unroll
    for (int o = 32; o > 0; o >>= 1) mx = fmaxf(mx, __shfl_xor(mx, o));
    float sm = 0.f;
    for (int i = lane; i < n; i += 64) { const float v = pr[i]; const float e = (v == -INFINITY) ? 0.f : expf(v - mx); pr[i] = e; sm += e; }
#pragma unroll
    for (int o = 32; o > 0; o >>= 1) sm += __shfl_xor(sm, o);
    const float inv = 1.f / fmaxf(sm, 1e-30f);
    for (int i = lane; i < n; i += 64) pr[i] *= inv;
}

__global__ __launch_bounds__(256) void nsa_naive(const __half* __restrict__ proj, const float* __restrict__ rel_bias, const float* __restrict__ kcmp, const float* __restrict__ vcmp, __half* __restrict__ o_b) {
    __shared__ float q[4][64];
    __shared__ float lg[4][1024];
    __shared__ float score[64];
    __shared__ int sb[16];
    __shared__ int nsb;
    const int id = blockIdx.x, g = id & 1, row = id >> 1, b = row / S_, t = row % S_, tid = threadIdx.x;
    const int w = tid >> 6, lane = tid & 63;
    const __half* pr = proj + (size_t)row * PW;
    q[tid >> 6][tid & 63] = __half2float(pr[C_QB + g * 256 + tid]);
    if (tid == 0) nsb = 0;
    __syncthreads();
    const int cur = t >> 6;
    const int nv = t >= 31 ? (t - 31) / 16 + 1 : 0;
    const int r_ = tid >> 6, d_ = tid & 63;
    float oc = 0.f, os = 0.f, ow = 0.f;
    for (int i = tid; i < 4 * nv; i += 256) { const int r = i / nv, c = i % nv;
        const float* kr = kcmp + ((size_t)(b * NC + c) * 2 + g) * 64; float a = 0.f;
        for (int d = 0; d < 64; ++d) a += q[r][d] * kr[d];
        lg[r][c] = a * 0.125f + rel_bias[t5_bucket(t - (16 * c + 31)) * 16 + 8 + g * 4 + r]; }
    __syncthreads();
    if (nv > 0) softmax_row(lg[w], nv, lane);
    __syncthreads();
    for (int c = 0; c < nv; ++c) oc += lg[r_][c] * vcmp[((size_t)(b * NC + c) * 2 + g) * 64 + d_];
    if (tid < 64) { const int nb = tid; float imp = 0.f;
        for (int r = 0; r < 4; ++r) for (int c = 4 * nb - 1; c <= 4 * nb + 3; ++c) if (c >= 0 && c < nv) imp += lg[r][c] * ((c == 4 * nb - 1 || c == 4 * nb + 3) ? 0.5f : 1.f);
        const bool valid = nb <= cur; const bool forced = nb == 0 || nb == cur || nb == cur - 1;
        score[nb] = valid ? (forced ? 1.0e4f : imp) : -INFINITY; }
    __syncthreads();
    if (tid < 64) { bool selq = false;
        if (tid <= cur) { const float sc = score[tid]; int rank = 0;
            for (int m = 0; m <= cur; ++m) { const float sm = score[m]; rank += (sm > sc || (sm == sc && m < tid)) ? 1 : 0; }
            selq = rank < 16; }
        const unsigned long long bm = __ballot(selq);
        if (selq) sb[__popcll(bm & ((1ull << tid) - 1ull))] = tid;
        if (tid == 0) nsb = __popcll(bm); }
    __syncthreads();
    const int ns = nsb;
    for (int i = tid; i < 4 * ns * 64; i += 256) { const int r = i / (ns * 64), j = i % (ns * 64); const int pos = sb[j >> 6] * 64 + (j & 63);
        float v = -INFINITY;
        if (pos <= t) { const __half* kr = proj + (size_t)(b * S_ + pos) * PW + C_KVB + 2 * 128 + g * 64; float a = 0.f;
            for (int d = 0; d < 64; ++d) a += q[r][d] * __half2float(kr[d]);
            v = a * 0.125f + rel_bias[t5_bucket(t - pos) * 16 + 8 + g * 4 + r]; }
        lg[r][j] = v; }
    __syncthreads();
    softmax_row(lg[w], ns * 64, lane);
    __syncthreads();
    for (int j = 0; j < ns * 64; ++j) { const float pj = lg[r_][j]; if (pj != 0.f) { const int pos = sb[j >> 6] * 64 + (j & 63);
        os += pj * __half2float(proj[(size_t)(b * S_ + pos) * PW + C_KVB + 3 * 128 + g * 64 + d_]); } }
    __syncthreads();
    const int p0 = t - 511 > 0 ? t - 511 : 0; const int nw = t - p0 + 1;
    for (int i = tid; i < 4 * nw; i += 256) { const int r = i / nw, j = i % nw; const int pos = p0 + j;
        const __half* kr = proj + (size_t)(b * S_ + pos) * PW + C_KVB + 4 * 128 + g * 64; float a = 0.f;
        for (int d = 0; d < 64; ++d) a += q[r][d] * __half2float(kr[d]);
        lg[r][j] = a * 0.125f + rel_bias[t5_bucket(t - pos) * 16 + 8 + g * 4 + r]; }
    __syncthreads();
    softmax_row(lg[w], nw, lane);
    __syncthreads();
    for (int j = 0; j < nw; ++j) ow += lg[r_][j] * __half2float(proj[(size_t)(b * S_ + p0 + j) * PW + C_KVB + 5 * 128 + g * 64 + d_]);
    const float g0 = sigmoidf_(__half2float(pr[C_GB + 0 * 8 + g * 4 + r_])), g1 = sigmoidf_(__half2float(pr[C_GB + 1 * 8 + g * 4 + r_])), g2 = sigmoidf_(__half2float(pr[C_GB + 2 * 8 + g * 4 + r_]));
    o_b[(size_t)row * 512 + (g * 4 + r_) * 64 + d_] = __float2half(g0 * oc + g1 * os + g2 * ow);
}

__global__ __launch_bounds__(256) void final_norm_k(float* __restrict__ xio, const float* __restrict__ g) {
    __shared__ float red[4];
    const int row = blockIdx.x, tid = threadIdx.x;
    float* xr = xio + (size_t)row * D_;
    float v[4]; float ss = 0.f;
#pragma unroll
    for (int i = 0; i < 4; ++i) { v[i] = xr[tid + i * 256]; ss += v[i] * v[i]; }
#pragma unroll
    for (int o = 32; o > 0; o >>= 1) ss += __shfl_xor(ss, o);
    if ((tid & 63) == 0) red[tid >> 6] = ss;
    __syncthreads();
    const float rs = rsqrtf((red[0] + red[1] + red[2] + red[3]) / D_ + EPS);
#pragma unroll
    for (int i = 0; i < 4; ++i) xr[tid + i * 256] = v[i] * rs * g[tid + i * 256];
}

}

extern "C" void kernel_launch(void* const* d_in, const int* in_sizes, int n_in, void* d_out, int out_size, void* d_ws, size_t ws_size, hipStream_t stream) {
    if (ws_size < 500 * MiB) { fprintf(stderr, "ws too small: %zu\n", ws_size); return; }
    constexpr int GLDS = 131072 + 256;
    static int inited = 0;
    if (!inited) {
        inited = 1;
        (void)hipFuncSetAttribute((const void*)k_prologue, hipFuncAttributeMaxDynamicSharedMemorySize, 8 * 8704);
        (void)hipFuncSetAttribute((const void*)k_gemm<pg8::EpiProj>, hipFuncAttributeMaxDynamicSharedMemorySize, GLDS);
        (void)hipFuncSetAttribute((const void*)k_gemm<pg8::EpiMix<0>>, hipFuncAttributeMaxDynamicSharedMemorySize, GLDS); (void)hipFuncSetAttribute((const void*)k_gemm<pg8::EpiPlain>, hipFuncAttributeMaxDynamicSharedMemorySize, GLDS);
        (void)hipFuncSetAttribute((const void*)k_gemm<pg8::EpiMix<1>>, hipFuncAttributeMaxDynamicSharedMemorySize, GLDS);
        (void)hipFuncSetAttribute((const void*)k_gemm<pg8::EpiResid>, hipFuncAttributeMaxDynamicSharedMemorySize, GLDS);
        (void)hipFuncSetAttribute((const void*)k_gemm<pg8::EpiRelu2>, hipFuncAttributeMaxDynamicSharedMemorySize, GLDS);
        (void)hipFuncSetAttribute((const void*)k_gemm<EpiAccOut>, hipFuncAttributeMaxDynamicSharedMemorySize, GLDS);
    }
    Args a{};
    a.x = (const float*)d_in[0]; a.norm_mix = (const float*)d_in[1]; a.w_in = (const float*)d_in[2];
    a.pe_k = (const float*)d_in[3]; a.w1_k = (const float*)d_in[4]; a.w2_k = (const float*)d_in[5];
    a.pe_v = (const float*)d_in[6]; a.w1_v = (const float*)d_in[7]; a.w2_v = (const float*)d_in[8];
    a.rel_bias = (const float*)d_in[9]; a.w_ba = (const float*)d_in[10]; a.w_bb = (const float*)d_in[11];
    a.w_out = (const float*)d_in[12]; a.norm_mlp = (const float*)d_in[13]; a.w_mi = (const float*)d_in[14];
    a.w_mo = (const float*)d_in[15]; a.norm_final = (const float*)d_in[16];
    a.out = (float*)d_out; a.ws = (unsigned char*)d_ws;
    unsigned char* ws = a.ws; float* out = a.out;
    __half* proj = (__half*)(ws + WS_PROJ); __half* o_a = (__half*)(ws + WS_H); __half* o_b = (__half*)(ws + WS_H + 32 * MiB);
    float* kcmp = (float*)(ws + WS_KCMP); float* vcmp = (float*)(ws + WS_VCMP);
    const int G = 256;
    k_prologue<<<G, 512, 8 * 8704, stream>>>(a);
    k_gemm<pg8::EpiProj><<<G, 512, GLDS, stream>>>(ws + WS_H, ws + WS_WIN, pg8::EpiProj{(_Float16*)(ws + WS_PROJ)}, M_, PW, D_, 0);
    dsa_naive<<<M_, 256, 0, stream>>>(proj, a.rel_bias, o_a);
    compress_naive<<<B_ * NC * 2 * 2, 128, 0, stream>>>(proj, a.pe_k, a.w1_k, a.w2_k, a.pe_v, a.w1_v, a.w2_v, kcmp, vcmp);
    nsa_naive<<<M_ * 2, 256, 0, stream>>>(proj, a.rel_bias, kcmp, vcmp, o_b);
    k_gemm<pg8::EpiMix<0>><<<G, 512, GLDS, stream>>>(ws + WS_H, ws + WS_WBA, pg8::EpiMix<0>{(_Float16*)(ws + WS_MIX), (const _Float16*)(ws + WS_PROJ)}, M_, D_, 512, 0);
    k_gemm<pg8::EpiMix<1>><<<G, 512, GLDS, stream>>>(ws + WS_H + 32 * MiB, ws + WS_WBB, pg8::EpiMix<1>{(_Float16*)(ws + WS_MIX), (const _Float16*)(ws + WS_PROJ)}, M_, D_, 512, 0);
    k_gemm<pg8::EpiResid><<<G, 512, GLDS, stream>>>(ws + WS_MIX, ws + WS_WOUT, pg8::EpiResid{a.x, out}, M_, D_, D_, 0);
    k_rows_norm<<<G, 512, 0, stream>>>(out, (_Float16*)(ws + WS_H));
    k_gemm<pg8::EpiRelu2><<<G, 512, GLDS, stream>>>(ws + WS_H, ws + WS_WMI, pg8::EpiRelu2{(_Float16*)(ws + WS_PROJ)}, M_, DFF, D_, 0);
    k_gemm<EpiAccOut><<<G, 512, GLDS, stream>>>(ws + WS_PROJ, ws + WS_WMO, EpiAccOut{out}, M_, D_, DFF, 0);
    final_norm_k<<<M_, 256, 0, stream>>>(out, a.norm_final);
}
```

```cpp
#include <hip/hip_runtime.h>
#include <hip/hip_fp16.h>
#include <cstdint>
#include <cstdio>
#ifndef DBGSEL
#define DBGSEL 8
#endif

namespace pg8 {
#define PG8_LAS __attribute__((address_space(3)))
typedef unsigned short bf16_t;
typedef _Float16 bf16x8 __attribute__((ext_vector_type(8)));
typedef float f32x4 __attribute__((ext_vector_type(4)));
typedef unsigned u32x4 __attribute__((ext_vector_type(4)));
constexpr int BM = 256, BK = 64, HALF = 128, HTB = HALF * BK * 2  , STAGE_BYTES = 8 * HTB, NXCD = 8, WGM = 8;

__host__ __device__ __forceinline__ int lds_byte(int r, int c) { const int st = (r >> 4) * 2 + (c >> 5), rr = r & 15, cc = c & 31, ob = rr * 64 + cc * 2; return st * 1024 + (ob ^ (((ob >> 9) & 1) << 5)); }
__host__ __device__ __forceinline__ void stage_rc(int b, int& R, int& C) { const int st = b / 1024, sb = b % 1024, swz = sb ^ (((sb >> 9) & 1) << 5); R = (st >> 1) * 16 + swz / 64; C = (st & 1) * 32 + (swz % 64) / 2; }
__host__ __device__ __forceinline__ int perm32(int rho) { const int n = rho >> 4, i = rho & 15; return 8 * (i >> 2) + 4 * n + (i & 3); }

struct Unit { int pm, pn; };
struct Gemm { const bf16_t* A; const bf16_t* Bt; int M, N, K; };

struct StaticOrder {
    int nM, nN, nwg, G, c;
    __host__ __device__ void init(int M, int N, int G_, int c_) { nM = M / BM; nN = N / BM; nwg = nM * nN; G = G_; c = c_; }
    __host__ __device__ bool next(int i, Unit& u) const {
        const long L = (long)i * G + c; if (L >= nwg) return false;
        int wgid = (int)L; { const int q = nwg / NXCD, r = nwg % NXCD, xcd = wgid % NXCD, off = wgid / NXCD; wgid = (xcd < r ? xcd * (q + 1) : r * (q + 1) + (xcd - r) * q) + off; }
        const int nig = WGM * nN, gid = wgid / nig, fm = gid * WGM, gsz = (nM - fm) < WGM ? (nM - fm) : WGM;
        u.pm = fm + ((wgid % nig) % gsz); u.pn = (wgid % nig) / gsz; return true;
    }
    __device__ __forceinline__ void a_ready(const Unit&) const {}
    __device__ __forceinline__ void done(const Unit&) const {}
};


typedef float f32x2 __attribute__((ext_vector_type(2)));
typedef _Float16 f16x2 __attribute__((ext_vector_type(2)));
constexpr int PW = 4352;
__device__ __forceinline__ unsigned pkh(float a, float b) { f32x2 v = {a, b}; f16x2 h = __builtin_convertvector(v, f16x2); return __builtin_bit_cast(unsigned, h); }
__device__ __forceinline__ float sigm(float v) { return __builtin_amdgcn_rcpf(1.f + __expf(-v)); }
__device__ __forceinline__ void unpk8(const u32x4 w, float (&f)[8]) {
#pragma unroll
    for (int i = 0; i < 4; ++i) { const unsigned wi = (i == 0) ? w.x : (i == 1) ? w.y : (i == 2) ? w.z : w.w; const f16x2 h = __builtin_bit_cast(f16x2, wi); f[2 * i] = (float)h.x; f[2 * i + 1] = (float)h.y; } }

struct EpiProj {
    static constexpr bool PERM = true, AFTER_DRAIN = false;
    _Float16* O;
    __device__ __forceinline__ void operator()(const f32x4 (&acc)[2][2][4][2], const Unit& u, int wr, int wc, int fr, int fq) const {
        const int row0 = u.pm * BM + wr * 64 + fr, col0 = u.pn * BM + wc * 32 + 8 * fq; const bool sg = u.pn >= 9;
#pragma unroll
        for (int ai = 0; ai < 2; ++ai)
#pragma unroll
            for (int m = 0; m < 4; ++m) { _Float16* rowp = O + (size_t)(row0 + ai * HALF + m * 16) * PW + col0;
#pragma unroll
                for (int bj = 0; bj < 2; ++bj) { f32x4 v0 = acc[ai][bj][m][0], v1 = acc[ai][bj][m][1];
                    if (sg) {
#pragma unroll
                        for (int i = 0; i < 4; ++i) { v0[i] = sigm(v0[i]); v1[i] = sigm(v1[i]); } }
                    u32x4 w; w.x = pkh(v0[0], v0[1]); w.y = pkh(v0[2], v0[3]); w.z = pkh(v1[0], v1[1]); w.w = pkh(v1[2], v1[3]);
                    *(u32x4*)(rowp + bj * HALF) = w; } }
    }
};
template <int SECOND> struct EpiMix {
    static constexpr bool PERM = true, AFTER_DRAIN = false;
    _Float16* mix; const _Float16* proj;
    __device__ __forceinline__ void operator()(const f32x4 (&acc)[2][2][4][2], const Unit& u, int wr, int wc, int fr, int fq) const {
        const int row0 = u.pm * BM + wr * 64 + fr, col0 = u.pn * BM + wc * 32 + 8 * fq;
#pragma unroll
        for (int ai = 0; ai < 2; ++ai)
#pragma unroll
            for (int m = 0; m < 4; ++m) { const size_t r = (size_t)(row0 + ai * HALF + m * 16);
#pragma unroll
                for (int bj = 0; bj < 2; ++bj) { const int c = col0 + bj * HALF;
                    float g[8]; unpk8(*(const u32x4*)(proj + r * PW + 2304 + SECOND * 1024 + c), g);
                    const f32x4 v0 = acc[ai][bj][m][0], v1 = acc[ai][bj][m][1];
                    float o[8] = {g[0] * v0[0], g[1] * v0[1], g[2] * v0[2], g[3] * v0[3], g[4] * v1[0], g[5] * v1[1], g[6] * v1[2], g[7] * v1[3]};
                    if (SECOND) { float p[8]; unpk8(*(const u32x4*)(mix + r * 1024 + c), p);
#pragma unroll
                        for (int i = 0; i < 8; ++i) o[i] += p[i]; }
                    u32x4 w; w.x = pkh(o[0], o[1]); w.y = pkh(o[2], o[3]); w.z = pkh(o[4], o[5]); w.w = pkh(o[6], o[7]);
                    *(u32x4*)(mix + r * 1024 + c) = w; } }
    }
};
struct EpiPlain {
    static constexpr bool PERM = true, AFTER_DRAIN = false;
    _Float16* U;
    __device__ __forceinline__ void operator()(const f32x4 (&acc)[2][2][4][2], const Unit& u, int wr, int wc, int fr, int fq) const {
        const int row0 = u.pm * BM + wr * 64 + fr, col0 = u.pn * BM + wc * 32 + 8 * fq;
#pragma unroll
        for (int ai = 0; ai < 2; ++ai)
#pragma unroll
            for (int m = 0; m < 4; ++m) { _Float16* rowp = U + (size_t)(row0 + ai * HALF + m * 16) * 1024 + col0;
#pragma unroll
                for (int bj = 0; bj < 2; ++bj) { f32x4 v0 = acc[ai][bj][m][0], v1 = acc[ai][bj][m][1];
                    u32x4 w; w.x = pkh(v0[0], v0[1]); w.y = pkh(v0[2], v0[3]); w.z = pkh(v1[0], v1[1]); w.w = pkh(v1[2], v1[3]);
                    *(u32x4*)(rowp + bj * HALF) = w; } }
    }
};
struct EpiResid {
    static constexpr bool PERM = true, AFTER_DRAIN = false;
    const float* x; float* out;
    __device__ __forceinline__ void operator()(const f32x4 (&acc)[2][2][4][2], const Unit& u, int wr, int wc, int fr, int fq) const {
        const int row0 = u.pm * BM + wr * 64 + fr, col0 = u.pn * BM + wc * 32 + 8 * fq;
#pragma unroll
        for (int ai = 0; ai < 2; ++ai)
#pragma unroll
            for (int m = 0; m < 4; ++m) { const size_t r = (size_t)(row0 + ai * HALF + m * 16);
#pragma unroll
                for (int bj = 0; bj < 2; ++bj) { const size_t o = r * 1024 + col0 + bj * HALF;
                    const f32x4 a0 = *(const f32x4*)(x + o), a1 = *(const f32x4*)(x + o + 4);
                    *(f32x4*)(out + o) = a0 + acc[ai][bj][m][0]; *(f32x4*)(out + o + 4) = a1 + acc[ai][bj][m][1]; } }
    }
};
struct EpiRelu2 {
    static constexpr bool PERM = true, AFTER_DRAIN = false;
    _Float16* U;
    __device__ __forceinline__ void operator()(const f32x4 (&acc)[2][2][4][2], const Unit& u, int wr, int wc, int fr, int fq) const {
        const int row0 = u.pm * BM + wr * 64 + fr, col0 = u.pn * BM + wc * 32 + 8 * fq;
#pragma unroll
        for (int ai = 0; ai < 2; ++ai)
#pragma unroll
            for (int m = 0; m < 4; ++m) { _Float16* rowp = U + (size_t)(row0 + ai * HALF + m * 16) * 4096 + col0;
#pragma unroll
                for (int bj = 0; bj < 2; ++bj) { f32x4 v0 = acc[ai][bj][m][0], v1 = acc[ai][bj][m][1];
#pragma unroll
                    for (int i = 0; i < 4; ++i) { const float a = fmaxf(v0[i], 0.f), b = fmaxf(v1[i], 0.f); v0[i] = a * a; v1[i] = b * b; }
                    u32x4 w; w.x = pkh(v0[0], v0[1]); w.y = pkh(v0[2], v0[3]); w.z = pkh(v1[0], v1[1]); w.w = pkh(v1[2], v1[3]);
                    *(u32x4*)(rowp + bj * HALF) = w; } }
    }
};
template <class Epi, class Sched, bool ALIGN_EPI = false, bool SP2 = false>
__device__ __forceinline__ void gemm_phase(PG8_LAS unsigned char* lds, const Gemm g, const Sched& S, const Epi& E) {
    const int tid = threadIdx.x, wid = __builtin_amdgcn_readfirstlane(tid >> 6), lane = tid & 63, wr = wid >> 2, wc = wid & 3, fr = lane & 15, fq = lane >> 4;
    const int K = g.K, nt = K / BK;
    unsigned voffA[2], voffB[2];
#pragma unroll
    for (int i = 0; i < 2; ++i) { int R, C; stage_rc(tid * 16 + i * 8192, R, C); const int Rb = Epi::PERM ? ((R & ~31) + perm32(R & 31)) : R;
        voffA[i] = (unsigned)(R * K + C) * 2u; voffB[i] = (unsigned)(Rb * K + C) * 2u; }
    const size_t kstep = (size_t)(BK * 2);
    const size_t hstep = (size_t)HALF * K * 2;
    const size_t tstep = 2 * hstep;
    const unsigned ldsw = (unsigned)wid * 1024u;
    const int aoff = lds_byte(wr * 64 + fr, fq * 8), boff = lds_byte(wc * 32 + fr, fq * 8);
#define PG8_SA(b, h) (((b) * 2 + (h)) * HTB)
#define PG8_SB(b, h) ((4 + (b) * 2 + (h)) * HTB)
#define PG8_STAGE(bufoff, gbase, voff) do { _Pragma("unroll") for (int _i = 0; _i < 2; ++_i) \
        __builtin_amdgcn_global_load_lds((const unsigned*)((const char*)(gbase) + (voff)[_i]), (PG8_LAS unsigned*)(lds + (bufoff) + ldsw + _i * 8192), 16, 0, 0); } while (0)
#define PG8_LDA(dst, b, h) do { _Pragma("unroll") for (int m = 0; m < 4; ++m) _Pragma("unroll") for (int k = 0; k < 2; ++k) dst[m][k] = *(const PG8_LAS bf16x8*)(lds + PG8_SA(b, h) + aoff + m * 2048 + k * 1024); } while (0)
#define PG8_LDB(dst, b, h) do { _Pragma("unroll") for (int n = 0; n < 2; ++n) _Pragma("unroll") for (int k = 0; k < 2; ++k) dst[n][k] = *(const PG8_LAS bf16x8*)(lds + PG8_SB(b, h) + boff + n * 2048 + k * 1024); } while (0)
#define PG8_MMA(ai, bj, At, Bt) do { __builtin_amdgcn_s_setprio(1); _Pragma("unroll") for (int m = 0; m < 4; ++m) _Pragma("unroll") for (int n = 0; n < 2; ++n) _Pragma("unroll") for (int k = 0; k < 2; ++k) \
        acc[ai][bj][m][n] = __builtin_amdgcn_mfma_f32_16x16x32_f16(Bt[n][k], At[m][k], acc[ai][bj][m][n], 0, 0, 0); __builtin_amdgcn_s_setprio(0); } while (0)
#define PG8_WAIT_V(n) asm volatile("s_waitcnt vmcnt(" #n ")" ::: "memory")
#define PG8_WAIT_L(n) asm volatile("s_waitcnt lgkmcnt(" #n ")" ::: "memory")
#define PG8_BAR __builtin_amdgcn_s_barrier()
#define PG8_SCHED __builtin_amdgcn_sched_barrier(0)
    Unit cur, nxt; int ui = 0;
    if (!S.next(0, cur)) return;
    f32x4 acc[2][2][4][2];
#pragma unroll
    for (int a = 0; a < 2; ++a)
#pragma unroll
        for (int b = 0; b < 2; ++b)
#pragma unroll
            for (int m = 0; m < 4; ++m)
#pragma unroll
                for (int n = 0; n < 2; ++n) acc[a][b][m][n] = (f32x4){0.f, 0.f, 0.f, 0.f};
    bf16x8 At[4][2], B0[2][2], B1[2][2];
    const char* cA = (const char*)g.A + (size_t)cur.pm * tstep; const char* cB = (const char*)g.Bt + (size_t)cur.pn * tstep;
    S.a_ready(cur);
    if constexpr (SP2) {
        PG8_STAGE(PG8_SB(0, 0), cB, voffB); PG8_STAGE(PG8_SB(0, 1), cB + hstep, voffB); PG8_STAGE(PG8_SA(0, 0), cA, voffA); PG8_STAGE(PG8_SA(0, 1), cA + hstep, voffA);
        if (wr == 1) PG8_BAR;
        PG8_WAIT_V(2); PG8_BAR;
        PG8_STAGE(PG8_SB(1, 0), cB + kstep, voffB); PG8_STAGE(PG8_SA(1, 0), cA + kstep, voffA); PG8_STAGE(PG8_SB(1, 1), cB + hstep + kstep, voffB);
        PG8_WAIT_V(6); PG8_BAR;
    } else {
        PG8_STAGE(PG8_SB(0, 0), cB, voffB); PG8_STAGE(PG8_SA(0, 0), cA, voffA); PG8_STAGE(PG8_SB(0, 1), cB + hstep, voffB); PG8_STAGE(PG8_SA(0, 1), cA + hstep, voffA);
        if (wr == 1) PG8_BAR;
        PG8_WAIT_V(4); PG8_BAR;
        PG8_STAGE(PG8_SB(1, 0), cB + kstep, voffB); PG8_STAGE(PG8_SA(1, 0), cA + kstep, voffA); PG8_STAGE(PG8_SB(1, 1), cB + hstep + kstep, voffB);
        PG8_WAIT_V(6); PG8_BAR;
    }
    for (;;) {
        const bool has_next = S.next(ui + 1, nxt);
        const char* nA = has_next ? (const char*)g.A + (size_t)nxt.pm * tstep : cA; const char* nB = has_next ? (const char*)g.Bt + (size_t)nxt.pn * tstep : cB;
        for (int t = 0; t < nt; t += 2) {
            const bool last = (t == nt - 2);
            const char* a1 = cA + (size_t)(t + 1) * kstep;
            const char* a2 = last ? nA : cA + (size_t)(t + 2) * kstep; const char* b2 = last ? nB : cB + (size_t)(t + 2) * kstep;
            const char* a3 = a2 + kstep; const char* b3 = b2 + kstep;
            if (last && has_next) S.a_ready(nxt);
            if constexpr (SP2) {
            PG8_LDB(B0, 0, 0); PG8_LDB(B1, 0, 1); PG8_SCHED; PG8_LDA(At, 0, 0); PG8_STAGE(PG8_SA(1, 1), a1 + hstep, voffA);
            PG8_WAIT_V(8); PG8_WAIT_L(0); PG8_BAR; PG8_MMA(0, 0, At, B0); PG8_MMA(0, 1, At, B1); PG8_BAR; PG8_SCHED;
            PG8_LDA(At, 0, 1); PG8_STAGE(PG8_SB(0, 0), b2, voffB); PG8_STAGE(PG8_SB(0, 1), b2 + hstep, voffB); PG8_STAGE(PG8_SA(0, 0), a2, voffA);
            PG8_WAIT_V(8); PG8_WAIT_L(0); PG8_BAR; PG8_MMA(1, 0, At, B0); PG8_MMA(1, 1, At, B1); PG8_BAR; PG8_SCHED;
            PG8_LDB(B0, 1, 0); PG8_LDB(B1, 1, 1); PG8_SCHED; PG8_LDA(At, 1, 0); PG8_STAGE(PG8_SA(0, 1), a2 + hstep, voffA);
            PG8_WAIT_V(8); PG8_WAIT_L(0); PG8_BAR; PG8_MMA(0, 0, At, B0); PG8_MMA(0, 1, At, B1); PG8_BAR; PG8_SCHED;
            PG8_LDA(At, 1, 1); PG8_STAGE(PG8_SB(1, 0), b3, voffB); PG8_STAGE(PG8_SB(1, 1), b3 + hstep, voffB); PG8_STAGE(PG8_SA(1, 0), a3, voffA);
            PG8_WAIT_V(8); PG8_WAIT_L(0); PG8_BAR; PG8_MMA(1, 0, At, B0); PG8_MMA(1, 1, At, B1); PG8_BAR; PG8_SCHED;
            } else {
            PG8_LDB(B0, 0, 0); PG8_SCHED; PG8_LDA(At, 0, 0); PG8_STAGE(PG8_SA(1, 1), a1 + hstep, voffA);
            PG8_WAIT_L(8); PG8_BAR; PG8_WAIT_L(0); PG8_MMA(0, 0, At, B0); PG8_BAR; PG8_SCHED;
            PG8_LDB(B1, 0, 1); PG8_STAGE(PG8_SB(0, 0), b2, voffB);
            PG8_BAR; PG8_WAIT_L(0); PG8_MMA(0, 1, At, B1); PG8_BAR;
            PG8_LDA(At, 0, 1); PG8_STAGE(PG8_SA(0, 0), a2, voffA);
            PG8_BAR; PG8_WAIT_L(0); PG8_MMA(1, 0, At, B0); PG8_BAR; PG8_SCHED;
            PG8_STAGE(PG8_SB(0, 1), b2 + hstep, voffB);
            PG8_WAIT_V(6); PG8_BAR; PG8_MMA(1, 1, At, B1); PG8_BAR;
            PG8_LDB(B0, 1, 0); PG8_SCHED; PG8_LDA(At, 1, 0); PG8_STAGE(PG8_SA(0, 1), a2 + hstep, voffA);
            PG8_WAIT_L(8); PG8_BAR; PG8_WAIT_L(0); PG8_MMA(0, 0, At, B0); PG8_BAR; PG8_SCHED;
            PG8_LDB(B1, 1, 1); PG8_STAGE(PG8_SB(1, 0), b3, voffB);
            PG8_BAR; PG8_WAIT_L(0); PG8_MMA(0, 1, At, B1); PG8_BAR;
            PG8_LDA(At, 1, 1); PG8_STAGE(PG8_SA(1, 0), a3, voffA);
            PG8_BAR; PG8_WAIT_L(0); PG8_MMA(1, 0, At, B0); PG8_BAR; PG8_SCHED;
            PG8_STAGE(PG8_SB(1, 1), b3 + hstep, voffB);
            PG8_WAIT_V(6); PG8_BAR; PG8_MMA(1, 1, At, B1); PG8_BAR;
            }
        }
        if constexpr (ALIGN_EPI) { if (wr == 0) PG8_BAR; }
        if constexpr (!Epi::AFTER_DRAIN) { E(acc, cur, wr, wc, fr, fq); S.done(cur); }
        if (!has_next) break;
#pragma unroll
        for (int a = 0; a < 2; ++a)
#pragma unroll
            for (int b = 0; b < 2; ++b)
#pragma unroll
                for (int m = 0; m < 4; ++m)
#pragma unroll
                    for (int n = 0; n < 2; ++n) acc[a][b][m][n] = (f32x4){0.f, 0.f, 0.f, 0.f};
        cur = nxt; cA = nA; cB = nB; ++ui;
        if constexpr (ALIGN_EPI) { if (wr == 1) PG8_BAR; }
    }
    PG8_WAIT_V(0);
    if constexpr (!ALIGN_EPI) { if (wr == 0) PG8_BAR; }
    PG8_BAR;
    if constexpr (Epi::AFTER_DRAIN) { E.fused(acc, cur, wr, wc, fr, fq, lds, wid, lane); S.done(cur); }
#undef PG8_SA
#undef PG8_SB
#undef PG8_STAGE
#undef PG8_LDA
#undef PG8_LDB
#undef PG8_MMA
#undef PG8_WAIT_V
#undef PG8_WAIT_L
#undef PG8_BAR
#undef PG8_SCHED
}
}


namespace {
constexpr int B_ = 8, S_ = 4096, M_ = B_ * S_, D_ = 1024, DIN = 4288, DFF = 4096;
constexpr int C_QA = 0, C_QB = 512, C_QI = 1024, C_KVB = 1280, C_KA = 2048, C_VA = 2112, C_KI = 2176, C_WI = 2208, C_GB = 2216, C_GATE = 2304;
constexpr int NC = 255;
constexpr float EPS = 1e-6f;
using pg8::PW;
#define GAS __attribute__((address_space(1)))
#define LAS __attribute__((address_space(3)))
typedef unsigned v4u __attribute__((ext_vector_type(4)));
typedef float f32x4 __attribute__((ext_vector_type(4)));

__device__ __forceinline__ int t5_bucket(int n) {
    if (n < 16) return n < 0 ? 0 : n;
    float nf = (float)n;
    int large = 16 + (int)(logf(nf / 16.f) / logf(8.f) * 16.f);
    return large < 31 ? large : 31;
}
__device__ __forceinline__ float sigmoidf_(float v) { return 1.f / (1.f + expf(-v)); }


__device__ __forceinline__ int win_src_col(int n) {
    if (n < 512) return n;
    if (n < 1024) return 936 + (n - 512);
    if (n < 1280) return 640 + (n - 1024);
    if (n < 2048) return 1448 + (n - 1280);
    if (n < 2112) return 512 + (n - 2048);
    if (n < 2176) return 576 + (n - 2112);
    if (n < 2208) return 896 + (n - 2176);
    if (n < 2216) return 928 + (n - 2208);
    if (n < 2240) return n;
    if (n < 2304) return -1;
    return 2240 + (n - 2304);
}
__device__ __forceinline__ float wave_sum(float v) {
#pragma unroll
    for (int o = 1; o < 64; o <<= 1) v += __shfl_xor(v, o);
    return v;
}
template <bool MAP>
__device__ __forceinline__ void transpose_item(const float* __restrict__ W, int K, int Nsrc, int Ndst, _Float16* __restrict__ WT, const float* __restrict__ gain, float* scr, int item, int lane) {
    const int nblk = Ndst / 32, kb = item / nblk, nb = item % nblk, k0 = 64 * kb, n0 = 32 * nb;
    const int nd = n0 + (lane & 31); const int ns = MAP ? win_src_col(nd) : nd;
#pragma unroll 8
    for (int i = 0; i < 32; ++i) { const int kk = 2 * i + (lane >> 5); float v = 0.f;
        if (ns >= 0) { v = W[(size_t)(k0 + kk) * Nsrc + ns]; if (gain) v *= gain[k0 + kk]; }
        scr[kk * 33 + (lane & 31)] = v; }
    __builtin_amdgcn_s_waitcnt(0xc07f); asm volatile("" ::: "memory");
    const int c = lane & 7;
#pragma unroll
    for (int j = 0; j < 4; ++j) { const int n = (lane >> 3) + 8 * j; const float* s = scr + (8 * c) * 33 + n;
        v4u o; o.x = pg8::pkh(s[0 * 33], s[1 * 33]); o.y = pg8::pkh(s[2 * 33], s[3 * 33]); o.z = pg8::pkh(s[4 * 33], s[5 * 33]); o.w = pg8::pkh(s[6 * 33], s[7 * 33]);
        *(v4u*)(WT + (size_t)(n0 + n) * K + k0 + 8 * c) = o; }
    __builtin_amdgcn_s_waitcnt(0xc07f); asm volatile("" ::: "memory");
}
__device__ __forceinline__ void rms_row_to_f16(const float* __restrict__ xrow, _Float16* __restrict__ orow, int lane) {
    const f32x4* xr = (const f32x4*)xrow + lane;
    f32x4 v[4]; float s = 0.f;
#pragma unroll
    for (int j = 0; j < 4; ++j) { v[j] = xr[64 * j]; s += (v[j].x * v[j].x + v[j].y * v[j].y) + (v[j].z * v[j].z + v[j].w * v[j].w); }
    const float rstd = rsqrtf(wave_sum(s) * (1.f / D_) + EPS);
    unsigned long long* o8 = (unsigned long long*)orow + lane;
#pragma unroll
    for (int j = 0; j < 4; ++j) o8[64 * j] = (unsigned long long)pg8::pkh(v[j].x * rstd, v[j].y * rstd) | ((unsigned long long)pg8::pkh(v[j].z * rstd, v[j].w * rstd) << 32);
}

struct Args {
    const float* x; const float* norm_mix; const float* w_in; const float* pe_k; const float* w1_k; const float* w2_k; const float* pe_v; const float* w1_v; const float* w2_v;
    const float* rel_bias; const float* w_ba; const float* w_bb; const float* w_out; const float* norm_mlp; const float* w_mi; const float* w_mo; const float* norm_final;
    float* out; unsigned char* ws;
};
constexpr size_t MiB = 1u << 20;
constexpr size_t WS_CTL = 0, WS_WIN = 1 * MiB, WS_WBA = 10 * MiB, WS_WBB = 11 * MiB, WS_WOUT = 12 * MiB, WS_WMI = 14 * MiB, WS_WMO = 22 * MiB, WS_CW = 30 * MiB,
                 WS_KCMP = 32 * MiB, WS_VCMP = 33 * MiB, WS_H = 34 * MiB, WS_PROJ = 98 * MiB, WS_MIX = 370 * MiB, WS_END = 434 * MiB;

__global__ void __launch_bounds__(512, 2) k_prologue(Args a) {
    extern __shared__ __attribute__((aligned(16))) unsigned char lds[];
    const int tid = threadIdx.x, lane = tid & 63, wave = tid >> 6;
    float* scr = (float*)(lds + wave * 8704);
    const int gw = blockIdx.x * 8 + wave, NGW = gridDim.x * 8;
    constexpr int I_IN = (D_ / 64) * (PW / 32), I_BA = (512 / 64) * (D_ / 32), I_OUT = (D_ / 64) * (D_ / 32), I_MI = (D_ / 64) * (DFF / 32), I_MO = (DFF / 64) * (D_ / 32);
    constexpr int NITEMS = I_IN + 2 * I_BA + I_OUT + I_MI + I_MO;
    for (int it = gw; it < NITEMS; it += NGW) {
        int r = it;
        if (r < I_IN) { transpose_item<true>(a.w_in, D_, DIN, PW, (_Float16*)(a.ws + WS_WIN), a.norm_mix, scr, r, lane); continue; } r -= I_IN;
        if (r < I_BA) { transpose_item<false>(a.w_ba, 512, D_, D_, (_Float16*)(a.ws + WS_WBA), nullptr, scr, r, lane); continue; } r -= I_BA;
        if (r < I_BA) { transpose_item<false>(a.w_bb, 512, D_, D_, (_Float16*)(a.ws + WS_WBB), nullptr, scr, r, lane); continue; } r -= I_BA;
        if (r < I_OUT) { transpose_item<false>(a.w_out, D_, D_, D_, (_Float16*)(a.ws + WS_WOUT), nullptr, scr, r, lane); continue; } r -= I_OUT;
        if (r < I_MI) { transpose_item<false>(a.w_mi, D_, DFF, DFF, (_Float16*)(a.ws + WS_WMI), a.norm_mlp, scr, r, lane); continue; } r -= I_MI;
        transpose_item<false>(a.w_mo, DFF, D_, D_, (_Float16*)(a.ws + WS_WMO), nullptr, scr, r, lane);
    }
    for (int m = gw; m < M_; m += NGW) rms_row_to_f16(a.x + (size_t)m * D_, (_Float16*)(a.ws + WS_H) + (size_t)m * D_, lane);
}
__global__ void __launch_bounds__(512, 2) k_rows_norm(const float* __restrict__ src, _Float16* __restrict__ dst) {
    const int lane = threadIdx.x & 63, gw = blockIdx.x * 8 + (threadIdx.x >> 6), NGW = gridDim.x * 8;
    for (int m = gw; m < M_; m += NGW) rms_row_to_f16(src + (size_t)m * D_, dst + (size_t)m * D_, lane);
}
template <class Epi>
__global__ void __launch_bounds__(512, 2) k_gemm(const void* A, const void* Bt, Epi E, int M, int N, int K, int pad_) {
    extern __shared__ __attribute__((aligned(16))) unsigned char lds[];
    pg8::Gemm g{(const pg8::bf16_t*)A, (const pg8::bf16_t*)Bt, M, N, K};
    pg8::StaticOrder S; S.init(M, N, (int)gridDim.x, (int)blockIdx.x);
    pg8::gemm_phase<Epi, pg8::StaticOrder, true, true>((PG8_LAS unsigned char*)lds, g, S, E);
}
struct EpiAccOut {
    static constexpr bool PERM = true, AFTER_DRAIN = false;
    float* out;
    __device__ __forceinline__ void operator()(const f32x4 (&acc)[2][2][4][2], const pg8::Unit& u, int wr, int wc, int fr, int fq) const {
        const int row0 = u.pm * 256 + wr * 64 + fr, col0 = u.pn * 256 + wc * 32 + 8 * fq;
#pragma unroll
        for (int ai = 0; ai < 2; ++ai)
#pragma unroll
            for (int m = 0; m < 4; ++m) { const size_t r = (size_t)(row0 + ai * 128 + m * 16);
#pragma unroll
                for (int bj = 0; bj < 2; ++bj) { const size_t o = r * 1024 + col0 + bj * 128;
                    const f32x4 a0 = *(const f32x4*)(out + o), a1 = *(const f32x4*)(out + o + 4);
                    *(f32x4*)(out + o) = a0 + acc[ai][bj][m][0]; *(f32x4*)(out + o + 4) = a1 + acc[ai][bj][m][1]; } }
    }
};


namespace dsa {
typedef _Float16 f16x8 __attribute__((ext_vector_type(8)));
typedef _Float16 f16x4 __attribute__((ext_vector_type(4)));
typedef short s16x4 __attribute__((ext_vector_type(4)));
typedef float f32x4 __attribute__((ext_vector_type(4)));
typedef unsigned u32x4 __attribute__((ext_vector_type(4)));
typedef unsigned u32x2 __attribute__((ext_vector_type(2)));
constexpr int TQ = 16, NBIN = 2048, CANDCAP = 512, VPITCH = 144;
constexpr int L_HIST = 0, L_SEL = 65536, L_CTL = L_SEL + 8192, L_BIAS = L_CTL + 512, L_VST = L_BIAS + 4096, L_END = L_VST + 8 * 32 * VPITCH;
static_assert(L_END <= 131072, "dsa LDS");

__device__ __forceinline__ float idx_score(const f32x4 a1, const f32x4 a2, const float (&w)[8]) {
    float s = w[0] * fmaxf(a1.x, 0.f);
    s = fmaf(w[1], fmaxf(a1.y, 0.f), s); s = fmaf(w[2], fmaxf(a1.z, 0.f), s); s = fmaf(w[3], fmaxf(a1.w, 0.f), s);
    s = fmaf(w[4], fmaxf(a2.x, 0.f), s); s = fmaf(w[5], fmaxf(a2.y, 0.f), s); s = fmaf(w[6], fmaxf(a2.z, 0.f), s); s = fmaf(w[7], fmaxf(a2.w, 0.f), s);
    return s;
}
__device__ __forceinline__ int score_bin(float sc, float inv) { int b = (int)(fmaf(sc, inv, 1024.f)); b = b < 0 ? 0 : b; return b > NBIN - 1 ? NBIN - 1 : b; }

template <int PASS>
__device__ __forceinline__ void score_pass(LAS unsigned char* lds, const _Float16* __restrict__ proj, int b, int t0, int nkb, int wave, int lane,
                                           const f16x8 (&afr)[4][2], const float (&wq)[4][8], const float (&binv)[4]) {
    LAS unsigned* hist = (LAS unsigned*)(lds + L_HIST);
    LAS unsigned short* sel = (LAS unsigned short*)(lds + L_SEL);
    LAS u32x2* cand = (LAS u32x2*)(lds + L_HIST);
    LAS int* ctl = (LAS int*)(lds + L_CTL);
    const int kc = lane >> 4, n16 = lane & 15;
    int bst[4];
#pragma unroll
    for (int grp = 0; grp < 4; ++grp) bst[grp] = (PASS == 2) ? ctl[(4 * grp + kc) * 8 + 2] : 0;
    const f32x4 zero = {0.f, 0.f, 0.f, 0.f};
    for (int kb = wave; kb < nkb; kb += 8) {
        const f16x8 bfr = *(const f16x8*)(proj + (size_t)(b * S_ + 16 * kb + n16) * PW + C_KI + 8 * kc);
        const int s = 16 * kb + n16;
#pragma unroll
        for (int grp = 0; grp < 4; ++grp) {
            const f32x4 a1 = __builtin_amdgcn_mfma_f32_16x16x32_f16(afr[grp][0], bfr, zero, 0, 0, 0);
            const f32x4 a2 = __builtin_amdgcn_mfma_f32_16x16x32_f16(afr[grp][1], bfr, zero, 0, 0, 0);
            const float sc = idx_score(a1, a2, wq[grp]);
            const int row = 4 * grp + kc, t = t0 + row;
            if (s <= t) {
                const int bin = score_bin(sc, binv[grp]);
                if (PASS == 1) { __hip_atomic_fetch_add(hist + row * 1024 + (bin >> 1), (bin & 1) ? 0x10000u : 1u, __ATOMIC_RELAXED, __HIP_MEMORY_SCOPE_WORKGROUP); }
                else {
                    if (bin > bst[grp]) { const int pos = __hip_atomic_fetch_add(ctl + row * 8 + 0, 1, __ATOMIC_RELAXED, __HIP_MEMORY_SCOPE_WORKGROUP); sel[row * 256 + (pos & 255)] = (unsigned short)s; }
                    else if (bin == bst[grp]) { const int pos = __hip_atomic_fetch_add(ctl + row * 8 + 1, 1, __ATOMIC_RELAXED, __HIP_MEMORY_SCOPE_WORKGROUP);
                        if (pos < CANDCAP) { u32x2 e; e.x = __float_as_uint(sc); e.y = (unsigned)s; cand[row * CANDCAP + pos] = e; } }
                }
            }
        }
    }
}

__device__ __forceinline__ void dsa_tile(LAS unsigned char* lds, const _Float16* __restrict__ proj, _Float16* __restrict__ o_a, int b, int qt, unsigned* dbg) {
    const int tid = threadIdx.x, lane = tid & 63, wave = __builtin_amdgcn_readfirstlane(tid >> 6);
    const int kc = lane >> 4, n16 = lane & 15;
    const int t0 = qt * TQ, nkb = qt + 1;
    LAS unsigned* hist = (LAS unsigned*)(lds + L_HIST);
    LAS unsigned short* sel = (LAS unsigned short*)(lds + L_SEL);
    LAS u32x2* cand = (LAS u32x2*)(lds + L_HIST);
    LAS int* ctl = (LAS int*)(lds + L_CTL);
    LAS float* biaslut = (LAS float*)(lds + L_BIAS);
    for (int i = tid; i < TQ * 1024 / 4; i += 512) ((LAS u32x4*)hist)[i] = (u32x4){0u, 0u, 0u, 0u};
    if (tid < TQ * 8) ctl[tid] = 0;
    f16x8 afr[4][2]; float wq[4][8]; float binv[4];
    { const int g = n16 >> 2, r = n16 & 3;
#pragma unroll
      for (int grp = 0; grp < 4; ++grp) {
          const _Float16* qrow = proj + (size_t)(b * S_ + t0 + 4 * grp + g) * PW + C_QI;
          afr[grp][0] = *(const f16x8*)(qrow + r * 32 + 8 * kc);
          afr[grp][1] = *(const f16x8*)(qrow + (4 + r) * 32 + 8 * kc);
          const f16x8 wv = *(const f16x8*)(proj + (size_t)(b * S_ + t0 + 4 * grp + kc) * PW + C_WI);
          float ss = 0.f;
#pragma unroll
          for (int h = 0; h < 8; ++h) { wq[grp][h] = (float)wv[h] * (1.f / 16.f); ss = fmaf(wq[grp][h], wq[grp][h], ss); }
          binv[grp] = 32.f * rsqrtf(ss + 1e-12f);
      } }
    __syncthreads();
    score_pass<1>(lds, proj, b, t0, nkb, wave, lane, afr, wq, binv);
    __syncthreads();
#pragma unroll 1
    for (int i = 0; i < 2; ++i) {
        const int row = 2 * wave + i, n = t0 + row + 1;
        if (n <= 256) { if (lane == 0) { ctl[row * 8 + 2] = -1; ctl[row * 8 + 3] = 0; } }
        else {
            const LAS u32x4* hp = (const LAS u32x4*)(hist + row * 1024 + 16 * lane);
            unsigned tot = 0;
#pragma unroll
            for (int q4 = 0; q4 < 4; ++q4) { const u32x4 hv = hp[q4];
                tot += (hv.x & 0xffffu) + (hv.x >> 16) + (hv.y & 0xffffu) + (hv.y >> 16) + (hv.z & 0xffffu) + (hv.z >> 16) + (hv.w & 0xffffu) + (hv.w >> 16); }
            unsigned suf = tot;
#pragma unroll
            for (int o = 1; o < 64; o <<= 1) { const unsigned v = __shfl_down(suf, o); if (lane + o < 64) suf += v; }
            const unsigned above_lane = suf - tot;
            if (above_lane < 256u && suf >= 256u) {
                const LAS unsigned short* h16 = (const LAS unsigned short*)hist + row * 2048 + 32 * lane;
                unsigned cum = above_lane; int bs = 32 * lane;
#pragma unroll 1
                for (int j = 31; j >= 0; --j) { const unsigned c = h16[j]; if (cum + c >= 256u) { bs = 32 * lane + j; break; } cum += c; }
                ctl[row * 8 + 2] = bs; ctl[row * 8 + 3] = 256 - (int)cum;
            }
        }
    }
    __syncthreads();
    score_pass<2>(lds, proj, b, t0, nkb, wave, lane, afr, wq, binv);
    __syncthreads();
#pragma unroll 1
    for (int i = 0; i < 2; ++i) {
        const int row = 2 * wave + i, n = t0 + row + 1;
        const int need = ctl[row * 8 + 3], base = ctl[row * 8 + 0];
        int nc = ctl[row * 8 + 1];
        if (lane == 0 && dbg) { if (nc > CANDCAP) atomicAdd(dbg + 5, 1u); if (need > nc) atomicAdd(dbg + 4, 1u); if (n > 256 && base + need != 256) atomicAdd(dbg + 6, 1u); atomicMax(dbg + 8, (unsigned)nc); }
        nc = nc < CANDCAP ? nc : CANDCAP;
        if (lane == 0) { const int nf = base + (need < nc ? need : nc); ctl[row * 8 + 4] = n <= 256 ? n : (nf < 256 ? nf : 256); }
        if (need > 0) {
            for (int c0 = 0; c0 < nc; c0 += 64) {
                const int ci = c0 + lane; const bool act = ci < nc;
                const u32x2 me = cand[row * CANDCAP + (act ? ci : 0)];
                const float msc = __uint_as_float(me.x); int rank = 0;
                for (int j = 0; j < nc; ++j) { const u32x2 ot = cand[row * CANDCAP + j]; const float osc = __uint_as_float(ot.x);
                    rank += (osc > msc || (osc == msc && ot.y < me.y)) ? 1 : 0; }
                if (act && rank < need) sel[row * 256 + ((base + rank) & 255)] = (unsigned short)me.y;
            }
        }
    }
    __syncthreads();
    LAS unsigned char* vst = lds + L_VST + wave * (32 * VPITCH);
#pragma unroll 1
    for (int i = 0; i < 2; ++i) {
        const int row = 2 * wave + i, t = t0 + row; const int nvalid = ctl[row * 8 + 4];
        const _Float16* qrow = proj + (size_t)(b * S_ + t) * PW + C_QA;
        const int head = n16, hm = head & 7;
        f16x8 qb0, qb1;
        { const f16x8 z = {0, 0, 0, 0, 0, 0, 0, 0}; qb0 = z; qb1 = z;
          if (head < 8) { qb0 = *(const f16x8*)(qrow + head * 64 + 8 * kc); qb1 = *(const f16x8*)(qrow + head * 64 + 32 + 8 * kc); } }
        f32x4 st[16];
#pragma unroll
        for (int kb = 0; kb < 16; ++kb) {
            const int pos = kb * 16 + n16; const int idx = pos < nvalid ? (int)sel[row * 256 + pos] : 0;
            const _Float16* krow = proj + (size_t)(b * S_ + idx) * PW + C_KA;
            const f16x8 k0 = *(const f16x8*)(krow + 8 * kc), k1 = *(const f16x8*)(krow + 32 + 8 * kc);
            f32x4 acc = {0.f, 0.f, 0.f, 0.f};
            acc = __builtin_amdgcn_mfma_f32_16x16x32_f16(k0, qb0, acc, 0, 0, 0);
            acc = __builtin_amdgcn_mfma_f32_16x16x32_f16(k1, qb1, acc, 0, 0, 0);
            st[kb] = acc;
            if ((kb & 3) == 3) __builtin_amdgcn_sched_barrier(0);
        }
        float mx = -INFINITY;
#pragma unroll
        for (int kb = 0; kb < 16; ++kb) {
            const int p0 = kb * 16 + 4 * kc;
            const u32x2 iw = *(LAS u32x2*)(sel + row * 256 + p0);
            const int id[4] = {(int)(iw.x & 0xffffu), (int)(iw.x >> 16), (int)(iw.y & 0xffffu), (int)(iw.y >> 16)};
            float v[4] = {st[kb].x, st[kb].y, st[kb].z, st[kb].w};
#pragma unroll
            for (int e = 0; e < 4; ++e) {
                const bool ok = (p0 + e) < nvalid;
                int d = t - id[e]; d = d < 0 ? 0 : d; d = d > 127 ? 127 : d; d = ok ? d : 0;
                const float lg = v[e] * 0.125f + biaslut[d * 8 + hm];
                v[e] = ok ? lg : -INFINITY; mx = fmaxf(mx, v[e]);
            }
            st[kb] = (f32x4){v[0], v[1], v[2], v[3]};
        }
        mx = fmaxf(mx, __shfl_xor(mx, 16)); mx = fmaxf(mx, __shfl_xor(mx, 32));
        float sum = 0.f;
#pragma unroll
        for (int kb = 0; kb < 16; ++kb) {
            f32x4 v = st[kb];
            v.x = __expf(v.x - mx); v.y = __expf(v.y - mx); v.z = __expf(v.z - mx); v.w = __expf(v.w - mx);
            sum += (v.x + v.y) + (v.z + v.w); st[kb] = v;
        }
        sum += __shfl_xor(sum, 16); sum += __shfl_xor(sum, 32);
        const float inv = 1.f / fmaxf(sum, 1e-30f);
        f32x4 ot[4];
#pragma unroll
        for (int dt = 0; dt < 4; ++dt) ot[dt] = (f32x4){0.f, 0.f, 0.f, 0.f};
#pragma unroll
        for (int j = 0; j < 8; ++j) {
            { const int ki = lane >> 1, hf = lane & 1; const int pos = 32 * j + ki; const int idx = pos < nvalid ? (int)sel[row * 256 + pos] : 0;
              const _Float16* vrow = proj + (size_t)(b * S_ + idx) * PW + C_VA + hf * 32;
              const u32x4 v0 = *(const u32x4*)(vrow), v1 = *(const u32x4*)(vrow + 8), v2 = *(const u32x4*)(vrow + 16), v3 = *(const u32x4*)(vrow + 24);
              LAS u32x4* dst = (LAS u32x4*)(vst + ki * VPITCH + hf * 64);
              dst[0] = v0; dst[1] = v1; dst[2] = v2; dst[3] = v3; }
            asm volatile("s_waitcnt lgkmcnt(0)" ::: "memory");
            const f32x4 pa = st[2 * j], pb = st[2 * j + 1];
            const f16x8 pfr = {(_Float16)pa.x, (_Float16)pa.y, (_Float16)pa.z, (_Float16)pa.w, (_Float16)pb.x, (_Float16)pb.y, (_Float16)pb.z, (_Float16)pb.w};
            const int q = n16 >> 2, p = n16 & 3;
#pragma unroll
            for (int dt = 0; dt < 4; ++dt) {
                const s16x4 ta = __builtin_amdgcn_ds_read_tr16_b64_v4i16((LAS s16x4*)(vst + (4 * kc + q) * VPITCH + (16 * dt + 4 * p) * 2));
                const s16x4 tb = __builtin_amdgcn_ds_read_tr16_b64_v4i16((LAS s16x4*)(vst + (16 + 4 * kc + q) * VPITCH + (16 * dt + 4 * p) * 2));
                const f16x4 fa = __builtin_bit_cast(f16x4, ta), fb = __builtin_bit_cast(f16x4, tb);
                const f16x8 vfr = {fa.x, fa.y, fa.z, fa.w, fb.x, fb.y, fb.z, fb.w};
                ot[dt] = __builtin_amdgcn_mfma_f32_16x16x32_f16(vfr, pfr, ot[dt], 0, 0, 0);
            }
            asm volatile("s_waitcnt lgkmcnt(0)" ::: "memory");
        }
        if (head < 8) {
            _Float16* orow = o_a + (size_t)(b * S_ + t) * 512 + head * 64 + 4 * kc;
#pragma unroll
            for (int dt = 0; dt < 4; ++dt) { u32x2 w; w.x = pg8::pkh(ot[dt].x * inv, ot[dt].y * inv); w.y = pg8::pkh(ot[dt].z * inv, ot[dt].w * inv); *(u32x2*)(orow + 16 * dt) = w; }
        }
    }
    __syncthreads();
}
}

__global__ void __launch_bounds__(512, 2) k_dsa(const _Float16* __restrict__ proj, const float* __restrict__ rel_bias, _Float16* __restrict__ o_a, unsigned* dbg) {
    extern __shared__ __attribute__((aligned(16))) unsigned char lds_raw[];
    LAS unsigned char* lds = (LAS unsigned char*)lds_raw;
    { LAS float* biaslut = (LAS float*)(lds + dsa::L_BIAS);
      for (int i = threadIdx.x; i < 1024; i += 512) { const int d = i >> 3, h = i & 7; biaslut[i] = rel_bias[t5_bucket(d) * 16 + h]; } }
    __syncthreads();
    for (int p = blockIdx.x; p < 1024; p += gridDim.x) { const int b = p >> 7, j = p & 127;
        dsa::dsa_tile(lds, proj, o_a, b, 255 - j, dbg);
        dsa::dsa_tile(lds, proj, o_a, b, j, dbg); }
}


namespace nsa {
typedef _Float16 f16x8 __attribute__((ext_vector_type(8)));
typedef _Float16 f16x4 __attribute__((ext_vector_type(4)));
typedef short s16x4 __attribute__((ext_vector_type(4)));
typedef float f32x4 __attribute__((ext_vector_type(4)));
typedef float f32x16 __attribute__((ext_vector_type(16)));
typedef unsigned u32x4 __attribute__((ext_vector_type(4)));
typedef unsigned u32x2 __attribute__((ext_vector_type(2)));
constexpr int KP = 144, VP = 192;
constexpr int TILE_B = 64 * KP + 64 * VP;
constexpr int L_T0 = 0, L_BIAS = 2 * TILE_B, L_IMPA = L_BIAS + 4096, L_IMPC = L_IMPA + 16384, L_MASK = L_IMPC + 16384, L_END = L_MASK + 512;
static_assert(L_END <= 131072, "nsa LDS");
constexpr float LOG2E = 1.4426950408889634f;
constexpr float SC = 0.125f * LOG2E;

struct Src { const _Float16* k; const _Float16* v; int pitch; };

struct Stage { u32x4 kr, vr; };
__device__ __forceinline__ void stage_load(Stage& st, const Src& s, int row0, int tid, bool need_v) {
    const int r = tid >> 3, c = tid & 7;
    st.kr = *(const u32x4*)(s.k + (size_t)(row0 + r) * s.pitch + 8 * c);
    if (need_v) st.vr = *(const u32x4*)(s.v + (size_t)(row0 + r) * s.pitch + 8 * c);
}
__device__ __forceinline__ void stage_store(const Stage& st, LAS unsigned char* tb, int tid, bool need_v) {
    const int r = tid >> 3, c = tid & 7;
    *(LAS u32x4*)(tb + r * KP + 16 * c) = st.kr;
    if (need_v) *(LAS u32x4*)(tb + 64 * KP + r * VP + 16 * c) = st.vr;
}

struct RowState { float m, l; f32x16 o0, o1; };

__device__ __forceinline__ void qk_tile(const LAS unsigned char* kt, const f16x8 (&qf)[4], int rho, int hi, f32x16& s0, f32x16& s1) {
#pragma unroll
    for (int i = 0; i < 16; ++i) { s0[i] = 0.f; s1[i] = 0.f; }
#pragma unroll
    for (int ks = 0; ks < 4; ++ks) {
        const f16x8 a0 = *(const LAS f16x8*)(kt + rho * KP + 32 * ks + 16 * hi);
        const f16x8 a1 = *(const LAS f16x8*)(kt + (32 + rho) * KP + 32 * ks + 16 * hi);
        s0 = __builtin_amdgcn_mfma_f32_32x32x16_f16(a0, qf[ks], s0, 0, 0, 0);
        s1 = __builtin_amdgcn_mfma_f32_32x32x16_f16(a1, qf[ks], s1, 0, 0, 0);
    }
}
template <bool NEAR>
__device__ __forceinline__ void logits(f32x16& s0, f32x16& s1, const LAS float* lut, int hb, int hi, int dbase, int dstep, int dlim, bool bit, float bias_far) {
#pragma unroll
    for (int kh = 0; kh < 2; ++kh)
#pragma unroll
        for (int rg = 0; rg < 16; ++rg) {
            const int kl = 32 * kh + (rg & 3) + 8 * (rg >> 2) + 4 * hi;
            const int d = dbase - dstep * kl;
            float bias = bias_far;
            if (NEAR) { int dc = d < 0 ? 0 : d; dc = dc > 127 ? 127 : dc; bias = lut[dc * 8 + hb]; }
            const bool ok = bit && d >= 0 && d < dlim;
            const float sv = kh ? s1[rg] : s0[rg];
            const float x = ok ? fmaf(sv, SC, bias) : -INFINITY;
            if (kh) s1[rg] = x; else s0[rg] = x;
            if (NEAR && (rg & 7) == 7) __builtin_amdgcn_sched_barrier(0);
        }
}
__device__ __forceinline__ void softmax_pv(RowState& rs, f32x16& s0, f32x16& s1, const LAS unsigned char* vt, int rho, int hi) {
    float tm = -INFINITY;
#pragma unroll
    for (int i = 0; i < 16; ++i) tm = fmaxf(tm, fmaxf(s0[i], s1[i]));
    tm = fmaxf(tm, __shfl_xor(tm, 32));
    const float mn = fmaxf(rs.m, tm);
    const float mu = (mn == -INFINITY) ? 0.f : mn;
    const float alpha = __builtin_amdgcn_exp2f(rs.m - mu);
    float ps = 0.f;
#pragma unroll
    for (int i = 0; i < 16; ++i) { s0[i] = __builtin_amdgcn_exp2f(s0[i] - mu); s1[i] = __builtin_amdgcn_exp2f(s1[i] - mu); ps += s0[i] + s1[i]; }
    rs.l = rs.l * alpha + ps; rs.m = mn;
#pragma unroll
    for (int i = 0; i < 16; ++i) { rs.o0[i] *= alpha; rs.o1[i] *= alpha; }
    const int l16 = rho & 15, g16 = rho >> 4, q = l16 >> 2, p = l16 & 3;
#pragma unroll
    for (int kh = 0; kh < 2; ++kh)
#pragma unroll
        for (int sx = 0; sx < 2; ++sx) {
            f16x8 pfr;
#pragma unroll
            for (int j = 0; j < 8; ++j) pfr[j] = (_Float16)(kh ? s1[8 * sx + j] : s0[8 * sx + j]);
            const int kbase = 32 * kh + 16 * sx + 4 * hi + q;
#pragma unroll
            for (int dt = 0; dt < 2; ++dt) {
                const int cb = (32 * dt + 16 * g16 + 4 * p) * 2;
                const s16x4 ta = __builtin_amdgcn_ds_read_tr16_b64_v4i16((LAS s16x4*)(vt + kbase * VP + cb));
                const s16x4 tb = __builtin_amdgcn_ds_read_tr16_b64_v4i16((LAS s16x4*)(vt + (kbase + 8) * VP + cb));
                const f16x4 fa = __builtin_bit_cast(f16x4, ta), fb = __builtin_bit_cast(f16x4, tb);
                const f16x8 vfr = {fa.x, fa.y, fa.z, fa.w, fb.x, fb.y, fb.z, fb.w};
                if (dt == 0) rs.o0 = __builtin_amdgcn_mfma_f32_32x32x16_f16(vfr, pfr, rs.o0, 0, 0, 0);
                else rs.o1 = __builtin_amdgcn_mfma_f32_32x32x16_f16(vfr, pfr, rs.o1, 0, 0, 0);
            }
        }
}
__device__ __forceinline__ void rs_init(RowState& rs) { rs.m = -INFINITY; rs.l = 0.f;
#pragma unroll
    for (int i = 0; i < 16; ++i) { rs.o0[i] = 0.f; rs.o1[i] = 0.f; } }
__device__ __forceinline__ void rs_flush(RowState& rs, float gate, _Float16* orow, bool first) {
    const float lt = rs.l + __shfl_xor(rs.l, 32);
    const float w = gate / fmaxf(lt, 1e-30f);
#pragma unroll
    for (int i = 0; i < 4; ++i) {
        float a[8] = {w * rs.o0[4 * i], w * rs.o0[4 * i + 1], w * rs.o0[4 * i + 2], w * rs.o0[4 * i + 3], w * rs.o1[4 * i], w * rs.o1[4 * i + 1], w * rs.o1[4 * i + 2], w * rs.o1[4 * i + 3]};
        if (!first) { const u32x2 p0 = *(const u32x2*)(orow + 8 * i), p1 = *(const u32x2*)(orow + 32 + 8 * i);
            const unsigned u0 = p0.x, u1 = p0.y, u2 = p1.x, u3 = p1.y; const pg8::f16x2 h0 = __builtin_bit_cast(pg8::f16x2, u0), h1 = __builtin_bit_cast(pg8::f16x2, u1), h2 = __builtin_bit_cast(pg8::f16x2, u2), h3 = __builtin_bit_cast(pg8::f16x2, u3);
            a[0] += (float)h0.x; a[1] += (float)h0.y; a[2] += (float)h1.x; a[3] += (float)h1.y; a[4] += (float)h2.x; a[5] += (float)h2.y; a[6] += (float)h3.x; a[7] += (float)h3.y; }
        u32x2 w0; w0.x = pg8::pkh(a[0], a[1]); w0.y = pg8::pkh(a[2], a[3]); *(u32x2*)(orow + 8 * i) = w0;
        u32x2 w1; w1.x = pg8::pkh(a[4], a[5]); w1.y = pg8::pkh(a[6], a[7]); *(u32x2*)(orow + 32 + 8 * i) = w1;
    }
}

__device__ __forceinline__ void nsa_unit(LAS unsigned char* lds, const _Float16* __restrict__ proj, const _Float16* __restrict__ kcmp, const _Float16* __restrict__ vcmp,
                                         _Float16* __restrict__ o_b, int b, int g, int qb) {
    const int tid = threadIdx.x, lane = tid & 63, wave = __builtin_amdgcn_readfirstlane(tid >> 6);
    const int rho = lane & 31, hi = lane >> 5, ql = rho >> 2, r = rho & 3, hb = g * 4 + r;
    const int t = 64 * qb + 8 * wave + ql;
    const _Float16* prow = proj + (size_t)(b * S_ + t) * PW;
    f16x8 qf[4];
#pragma unroll
    for (int ks = 0; ks < 4; ++ks) qf[ks] = *(const f16x8*)(prow + C_QB + hb * 64 + 16 * ks + 8 * hi);
    for (int i = tid; i < 2048; i += 512) ((LAS u32x4*)(lds + L_IMPA))[i] = (u32x4){0u, 0u, 0u, 0u};
    RowState rs; rs_init(rs);
    const LAS float* lut = (const LAS float*)(lds + L_BIAS);
    const float bias31 = lut[127 * 8 + hb];
    const _Float16* kc = kcmp + (size_t)(b * 2 + g) * 256 * 64;
    const long vcoff = (vcmp + (size_t)(b * 2 + g) * 256 * 64) - kc;
    const _Float16* pb = proj + (size_t)(b * S_) * PW + C_KVB + g * 64;
    const int ncmp = (4 * qb + 3 + 63) / 64;
    const int wlo = qb - 8 > 0 ? qb - 8 : 0;
    const int e0 = ncmp, e1 = 2 * ncmp, e2 = e1 + qb + 1, NT = e2 + (qb - wlo + 1);
    const int sr = tid >> 3, scq = tid & 7;
    float mc = 0.f, invl = 0.f; unsigned mlo = 0u, mhi = 0u;
    Stage stg;
#define NSA_DECODE(i, br, n) do { if ((i) < e0) { br = 0; n = (i); } else if ((i) < e1) { br = 1; n = (i) - e0; } else if ((i) < e2) { br = 2; n = (i) - e1; } else { br = 3; n = wlo + (i) - e2; } } while (0)
#define NSA_LOAD(i) do { int br_, n_; NSA_DECODE(i, br_, n_); const _Float16* kp_ = (br_ < 2) ? kc : (br_ == 2 ? pb + 2 * 128 : pb + 4 * 128); const int pitch_ = (br_ < 2) ? 64 : PW; \
        const long vo_ = (br_ < 2) ? vcoff : 128; const _Float16* rp_ = kp_ + (size_t)(64 * n_ + sr) * pitch_ + 8 * scq; stg.kr = *(const u32x4*)rp_; stg.vr = *(const u32x4*)(rp_ + vo_); } while (0)
#define NSA_STORE(buf) do { LAS unsigned char* tb_ = lds + L_T0 + (buf) * TILE_B; *(LAS u32x4*)(tb_ + sr * KP + 16 * scq) = stg.kr; *(LAS u32x4*)(tb_ + 64 * KP + sr * VP + 16 * scq) = stg.vr; } while (0)
    __syncthreads();
    NSA_LOAD(0); NSA_STORE(0);
    __syncthreads();
#pragma unroll 1
    for (int i = 0; i < NT; ++i) {
        int br, n; NSA_DECODE(i, br, n);
        const LAS unsigned char* tb = lds + L_T0 + (i & 1) * TILE_B;
        const bool more = i + 1 < NT;
        if (more) NSA_LOAD(i + 1);
        f32x16 s0, s1;
        qk_tile(tb, qf, rho, hi, s0, s1);
        bool bit = true; int dbase, dstep = 1, dlim = 1 << 30; bool near = true;
        if (br < 2) { dbase = t - 31 - 1024 * n; dstep = 16; }
        else { dbase = t - 64 * n; near = n >= qb - 2; if (br == 2) bit = (n < 32) ? ((mlo >> n) & 1u) : ((mhi >> (n - 32)) & 1u); else dlim = 512; }
        if (near) logits<true>(s0, s1, lut, hb, hi, dbase, dstep, dlim, bit, 0.f);
        else logits<false>(s0, s1, lut, hb, hi, dbase, dstep, dlim, bit, bias31);
        if (br != 1) softmax_pv(rs, s0, s1, tb + 64 * KP, rho, hi);
        else {
            LAS float* impA = (LAS float*)(lds + L_IMPA) + (wave * 8 + ql) * 64;
            LAS float* impC = (LAS float*)(lds + L_IMPC) + (wave * 8 + ql) * 64;
            const float mu = (mc == -INFINITY) ? 0.f : mc;
#pragma unroll
            for (int kh = 0; kh < 2; ++kh)
#pragma unroll
                for (int ii = 0; ii < 4; ++ii) {
                    float pv[4];
#pragma unroll
                    for (int e = 0; e < 4; ++e) pv[e] = __builtin_amdgcn_exp2f((kh ? s1[4 * ii + e] : s0[4 * ii + e]) - mu) * invl;
                    float a = (pv[0] + pv[1]) + (pv[2] + 0.5f * pv[3]), c = 0.5f * pv[3];
                    a += __shfl_xor(a, 1); a += __shfl_xor(a, 2); c += __shfl_xor(c, 1); c += __shfl_xor(c, 2);
                    const int nb = 16 * n + 8 * kh + 2 * ii + hi;
                    if (r == 0) { impA[nb] = a; if (nb + 1 < 64) impC[nb + 1] = c; }
                }
        }
        if (i + 1 == e0) {
            mc = rs.m; const float lc = rs.l + __shfl_xor(rs.l, 32); invl = 1.f / fmaxf(lc, 1e-30f);
            rs_flush(rs, pg8::sigm((float)prow[C_GB + 0 * 8 + hb]), o_b + (size_t)(b * S_ + t) * 512 + hb * 64 + 4 * hi, true); rs_init(rs);
        } else if (i + 1 == e1) {
            asm volatile("s_waitcnt lgkmcnt(0)" ::: "memory");
            const int qs = lane >> 3, j = lane & 7;
            LAS float* sA = (LAS float*)(lds + L_IMPA) + (wave * 8 + qs) * 64;
            const LAS float* sC = (const LAS float*)(lds + L_IMPC) + (wave * 8 + qs) * 64;
            float sc[8];
#pragma unroll
            for (int e = 0; e < 8; ++e) { const int nn = 8 * j + e; const bool forced = (nn == 0) || (nn == qb) || (nn == qb - 1);
                sc[e] = (nn <= qb) ? (forced ? 1.0e4f : (sA[nn] + sC[nn])) : -INFINITY; }
            asm volatile("s_waitcnt lgkmcnt(0)" ::: "memory");
#pragma unroll
            for (int e = 0; e < 8; ++e) sA[8 * j + e] = sc[e];
            asm volatile("s_waitcnt lgkmcnt(0)" ::: "memory");
            int rank[8];
#pragma unroll
            for (int e = 0; e < 8; ++e) rank[e] = 0;
            for (int m = 0; m <= qb; ++m) { const float sm = sA[m];
#pragma unroll
                for (int e = 0; e < 8; ++e) rank[e] += (sm > sc[e] || (sm == sc[e] && m < 8 * j + e)) ? 1 : 0; }
            unsigned bits = 0;
#pragma unroll
            for (int e = 0; e < 8; ++e) bits |= ((8 * j + e <= qb) && rank[e] < 16) ? (1u << e) : 0u;
            ((LAS unsigned char*)(lds + L_MASK))[(wave * 8 + qs) * 8 + j] = (unsigned char)bits;
            asm volatile("s_waitcnt lgkmcnt(0)" ::: "memory");
            const u32x2 mk = *(const LAS u32x2*)(lds + L_MASK + (wave * 8 + ql) * 8);
            mlo = mk.x; mhi = mk.y;
        } else if (i + 1 == e2) {
            rs_flush(rs, pg8::sigm((float)prow[C_GB + 1 * 8 + hb]), o_b + (size_t)(b * S_ + t) * 512 + hb * 64 + 4 * hi, false); rs_init(rs);
        } else if (i + 1 == NT) {
            rs_flush(rs, pg8::sigm((float)prow[C_GB + 2 * 8 + hb]), o_b + (size_t)(b * S_ + t) * 512 + hb * 64 + 4 * hi, false);
        }
        if (more) NSA_STORE((i + 1) & 1);
        __syncthreads();
    }
#undef NSA_DECODE
#undef NSA_LOAD
#undef NSA_STORE
}
}

__global__ void __launch_bounds__(512, 2) k_nsa(const _Float16* __restrict__ proj, const float* __restrict__ rel_bias, const _Float16* __restrict__ kcmp, const _Float16* __restrict__ vcmp, _Float16* __restrict__ o_b) {
    extern __shared__ __attribute__((aligned(16))) unsigned char lds_raw[];
    LAS unsigned char* lds = (LAS unsigned char*)lds_raw;
    { LAS float* lut = (LAS float*)(lds + nsa::L_BIAS);
      for (int i = threadIdx.x; i < 1024; i += 512) { const int d = i >> 3, h = i & 7; lut[i] = rel_bias[t5_bucket(d) * 16 + 8 + h] * nsa::LOG2E; } }
    __syncthreads();
#pragma unroll 1
    for (int u = blockIdx.x; u < 1024; u += gridDim.x) { const int p = u & 511, bg = p >> 5, j = p & 31;
        nsa::nsa_unit(lds, proj, kcmp, vcmp, o_b, bg >> 1, bg & 1, (u < 512) ? 63 - j : j);
        __syncthreads(); }
}
__global__ __launch_bounds__(128) void compress_h(const __half* __restrict__ proj, const float* __restrict__ pe_k, const float* __restrict__ w1_k, const float* __restrict__ w2_k,
                                                  const float* __restrict__ pe_v, const float* __restrict__ w1_v, const float* __restrict__ w2_v, __half* __restrict__ kcmp, __half* __restrict__ vcmp) {
    __shared__ float blk[2048];
    __shared__ float hid[128];
    int id = blockIdx.x; const int kv = id & 1; id >>= 1; const int g = id & 1; id >>= 1; const int c = id & 255, b = id >> 8;
    const float* pe = kv ? pe_v : pe_k; const float* w1 = kv ? w1_v : w1_k; const float* w2 = kv ? w2_v : w2_k;
    const int tid = threadIdx.x;
    __half* dst = (kv ? vcmp : kcmp) + ((size_t)(b * 2 + g) * 256 + c) * 64;
    if (c == 255) { if (tid < 64) dst[tid] = __float2half(0.f); return; }
    for (int i = tid; i < 2048; i += 128) { const int l = i >> 6, d = i & 63;
        blk[i] = __half2float(proj[(size_t)(b * S_ + 16 * c + l) * PW + C_KVB + kv * 128 + g * 64 + d]) + pe[i]; }
    __syncthreads();
    { float a = 0.f; for (int k = 0; k < 2048; ++k) a += blk[k] * w1[k * 128 + tid];
      const float x3 = a * a * a; hid[tid] = 0.5f * a * (1.f + tanhf(0.7978845608028654f * (a + 0.044715f * x3))); }
    __syncthreads();
    if (tid < 64) { float a = 0.f; for (int k = 0; k < 128; ++k) a += hid[k] * w2[k * 64 + tid]; dst[tid] = __float2half(a); }
}

__global__ void k_cmp_rows(const __half* __restrict__ a, const __half* __restrict__ ref, unsigned* __restrict__ dbg) {
    const int row = blockIdx.x * 4 + (threadIdx.x >> 6), lane = threadIdx.x & 63;
    float num = 0.f, den = 0.f; bool nan = false;
    for (int i = lane; i < 512; i += 64) { const float x = __half2float(a[(size_t)row * 512 + i]), y = __half2float(ref[(size_t)row * 512 + i]);
        nan |= !(x == x); num += (x - y) * (x - y); den += y * y; }
    for (int o = 32; o > 0; o >>= 1) { num += __shfl_xor(num, o); den += __shfl_xor(den, o); }
    const bool anynan = __any(nan);
    if (lane == 0) { if (anynan) atomicAdd(dbg + 1, 1u); else if (num > 0.0025f * den) atomicAdd(dbg + 0, 1u); }
}
__global__ void k_dbg_scale(float* __restrict__ out, const unsigned* __restrict__ dbg) {
    const unsigned nbad = dbg[0], nnan = dbg[1];
    int code = 0; if (dbg[5]) code = 30; else if (dbg[6]) code = 28; else if (nnan) code = 20 + (31 - __clz((int)nnan)) / 2; else if (nbad) code = 1 + (31 - __clz((int)nbad));
    const float sc = 1.f + 0.2f * code;
    const size_t i = (size_t)blockIdx.x * 256 + threadIdx.x; out[i] *= sc;
}
template <typename TA, typename Epi>
__global__ __launch_bounds__(256) void gemm_naive(const TA* __restrict__ A, const float* __restrict__ Bm, Epi epi, int lda, int ldb, int K, int pad_) {
    __shared__ float As[16][68];
    __shared__ float Bs[16][68];
    const int tid = threadIdx.x, tx = tid & 15, ty = tid >> 4;
    const int m0 = blockIdx.y * 64, n0 = blockIdx.x * 64;
    float acc[4][4];
#pragma unroll
    for (int i = 0; i < 4; ++i)
#pragma unroll
        for (int j = 0; j < 4; ++j) acc[i][j] = 0.f;
    for (int k0 = 0; k0 < K; k0 += 16) {
#pragma unroll
        for (int i = 0; i < 4; ++i) { const int e = tid + i * 256; const int m = e >> 4, k = e & 15; As[k][m] = (float)A[(size_t)(m0 + m) * lda + k0 + k]; }
#pragma unroll
        for (int i = 0; i < 4; ++i) { const int e = tid + i * 256; const int k = e >> 6, n = e & 63; Bs[k][n] = Bm[(size_t)(k0 + k) * ldb + n0 + n]; }
        __syncthreads();
#pragma unroll
        for (int k = 0; k < 16; ++k) {
            float a[4], b[4];
#pragma unroll
            for (int i = 0; i < 4; ++i) { a[i] = As[k][ty * 4 + i]; b[i] = Bs[k][tx * 4 + i]; }
#pragma unroll
            for (int i = 0; i < 4; ++i)
#pragma unroll
                for (int j = 0; j < 4; ++j) acc[i][j] += a[i] * b[j];
        }
        __syncthreads();
    }
#pragma unroll
    for (int i = 0; i < 4; ++i)
#pragma unroll
        for (int j = 0; j < 4; ++j) epi(m0 + ty * 4 + i, n0 + tx * 4 + j, acc[i][j]);
}


struct NEpiMixA { __half* mix; const __half* proj; __device__ void operator()(int r, int c, float v) const {
    const float g = __half2float(proj[(size_t)r * PW + C_GATE + c]); mix[(size_t)r * D_ + c] = __float2half(g * v); } };
struct NEpiMixB { __half* mix; const __half* proj; __device__ void operator()(int r, int c, float v) const {
    const float g = __half2float(proj[(size_t)r * PW + C_GATE + 1024 + c]); mix[(size_t)r * D_ + c] = __float2half(__half2float(mix[(size_t)r * D_ + c]) + g * v); } };
__global__ void k_gate(const __half* __restrict__ tmp, const __half* __restrict__ proj, __half* __restrict__ mix) {
    const size_t i = (size_t)blockIdx.x * 256 + threadIdx.x; const size_t r = i >> 10; const int c = (int)(i & 1023);
    mix[i] = __float2half(__half2float(tmp[i]) * __half2float(proj[r * PW + C_GATE + c]));
}
__global__ __launch_bounds__(256) void dsa_naive(const __half* __restrict__ proj, const float* __restrict__ rel_bias, __half* __restrict__ o_a) {
    __shared__ float qs[8][32];
    __shared__ float wv[8];
    __shared__ unsigned keys[4096];
    __shared__ int sel[256];
    __shared__ int nsel_s;
    __shared__ unsigned hist[256];
    __shared__ unsigned sel_prefix, sel_k;
    __shared__ float qa[8][64];
    __shared__ float p[8][256];
    const int row = blockIdx.x, tid = threadIdx.x, b = row / S_, t = row % S_;
    const __half* pr = proj + (size_t)row * PW;
    { const int h = tid >> 5, d = tid & 31; qs[h][d] = __half2float(pr[C_QI + h * 32 + d]); }
    if (tid < 8) wv[tid] = __half2float(pr[C_WI + tid]) * (1.f / 16.f);
    for (int i = tid; i < 512; i += 256) qa[i >> 6][i & 63] = __half2float(pr[C_QA + i]);
    if (tid == 0) nsel_s = 0;
    __syncthreads();
    const int n = t + 1;
    for (int s = tid; s < n; s += 256) {
        const __half* kr = proj + (size_t)(b * S_ + s) * PW + C_KI;
        float a8[8];
#pragma unroll
        for (int h = 0; h < 8; ++h) a8[h] = 0.f;
#pragma unroll 4
        for (int d = 0; d < 32; ++d) { const float kvd = __half2float(kr[d]);
#pragma unroll
            for (int h = 0; h < 8; ++h) a8[h] += qs[h][d] * kvd; }
        float sc = 0.f;
#pragma unroll
        for (int h = 0; h < 8; ++h) sc += wv[h] * (a8[h] > 0.f ? a8[h] : 0.f);
        unsigned u = __float_as_uint(sc);
        keys[s] = (u & 0x80000000u) ? ~u : (u | 0x80000000u);
    }
    __syncthreads();
    if (n <= 256) {
        if (tid < n) sel[tid] = tid;
        if (tid == 0) nsel_s = n;
        __syncthreads();
    } else {
        unsigned prefix = 0, mask = 0, kk = 256;
        for (int shift = 24; shift >= 0; shift -= 8) {
            hist[tid] = 0;
            __syncthreads();
            for (int s = tid; s < n; s += 256) { const unsigned k = keys[s]; if ((k & mask) == prefix) atomicAdd(&hist[(k >> shift) & 255u], 1u); }
            __syncthreads();
            if (tid == 0) { unsigned cum = 0; int d = 255; for (; d > 0; --d) { if (cum + hist[d] >= kk) break; cum += hist[d]; } sel_prefix = prefix | ((unsigned)d << shift); sel_k = kk - cum; }
            __syncthreads();
            prefix = sel_prefix; kk = sel_k; mask |= 0xFFu << shift;
            __syncthreads();
        }
        const unsigned T = prefix;
        for (int s = tid; s < n; s += 256) if (keys[s] > T) { const int pos = atomicAdd(&nsel_s, 1); sel[pos] = s; }
        __syncthreads();
        if (tid == 0) { int pos = nsel_s; unsigned need = kk; for (int s = 0; s < n && need > 0; ++s) if (keys[s] == T) { sel[pos++] = s; --need; } nsel_s = pos; }
        __syncthreads();
    }
    const int ns = nsel_s;
    {
        const int j = tid;
        if (j < ns) {
            const int idx = sel[j];
            const __half* kr = proj + (size_t)(b * S_ + idx) * PW + C_KA;
            float a8[8];
#pragma unroll
            for (int h = 0; h < 8; ++h) a8[h] = 0.f;
#pragma unroll 4
            for (int d = 0; d < 64; ++d) { const float kvd = __half2float(kr[d]);
#pragma unroll
                for (int h = 0; h < 8; ++h) a8[h] += qa[h][d] * kvd; }
            const int bk = t5_bucket(t - idx);
#pragma unroll
            for (int h = 0; h < 8; ++h) p[h][j] = a8[h] * 0.125f + rel_bias[bk * 16 + h];
        } else {
#pragma unroll
            for (int h = 0; h < 8; ++h) p[h][j] = -INFINITY;
        }
    }
    __syncthreads();
    {
        const int w = tid >> 6, lane = tid & 63;
        for (int hh = 0; hh < 2; ++hh) { const int h = w * 2 + hh;
            float v[4], mx = -INFINITY;
#pragma unroll
            for (int i = 0; i < 4; ++i) { v[i] = p[h][lane + 64 * i]; mx = fmaxf(mx, v[i]); }
#pragma unroll
            for (int o = 32; o > 0; o >>= 1) mx = fmaxf(mx, __shfl_xor(mx, o));
            float sm = 0.f;
#pragma unroll
            for (int i = 0; i < 4; ++i) { v[i] = (v[i] == -INFINITY) ? 0.f : expf(v[i] - mx); sm += v[i]; }
#pragma unroll
            for (int o = 32; o > 0; o >>= 1) sm += __shfl_xor(sm, o);
            const float inv = 1.f / fmaxf(sm, 1e-30f);
#pragma unroll
            for (int i = 0; i < 4; ++i) p[h][lane + 64 * i] = v[i] * inv; }
    }
    __syncthreads();
    for (int o = tid; o < 512; o += 256) { const int h = o >> 6, d = o & 63; float a = 0.f;
        for (int j = 0; j < ns; ++j) a += p[h][j] * __half2float(proj[(size_t)(b * S_ + sel[j]) * PW + C_VA + d]);
        o_a[(size_t)row * 512 + o] = __float2half(a); }
}

__global__ __launch_bounds__(128) void compress_naive(const __half* __restrict__ proj, const float* __restrict__ pe_k, const float* __restrict__ w1_k, const float* __restrict__ w2_k,
                                                      const float* __restrict__ pe_v, const float* __restrict__ w1_v, const float* __restrict__ w2_v, float* __restrict__ kcmp, float* __restrict__ vcmp) {
    __shared__ float blk[2048];
    __shared__ float hid[128];
    int id = blockIdx.x; const int kv = id & 1; id >>= 1; const int g = id & 1; id >>= 1; const int c = id % NC, b = id / NC;
    const float* pe = kv ? pe_v : pe_k; const float* w1 = kv ? w1_v : w1_k; const float* w2 = kv ? w2_v : w2_k;
    const int tid = threadIdx.x;
    for (int i = tid; i < 2048; i += 128) { const int l = i >> 6, d = i & 63;
        blk[i] = __half2float(proj[(size_t)(b * S_ + 16 * c + l) * PW + C_KVB + kv * 128 + g * 64 + d]) + pe[i]; }
    __syncthreads();
    { float a = 0.f; for (int k = 0; k < 2048; ++k) a += blk[k] * w1[k * 128 + tid];
      const float x3 = a * a * a; hid[tid] = 0.5f * a * (1.f + tanhf(0.7978845608028654f * (a + 0.044715f * x3))); }
    __syncthreads();
    if (tid < 64) { float a = 0.f; for (int k = 0; k < 128; ++k) a += hid[k] * w2[k * 64 + tid];
        (kv ? vcmp : kcmp)[((size_t)(b * NC + c) * 2 + g) * 64 + tid] = a; }
}

__device__ __forceinline__ void softmax_row(float* pr, int n, int lane) {
    float mx = -INFINITY;
    for (int i = lane; i < n; i += 64) mx = fmaxf(mx, pr[i]);
#pragma unroll
    for (int o = 32; o > 0; o >>= 1) mx = fmaxf(mx, __shfl_xor(mx, o));
    float sm = 0.f;
    for (int i = lane; i < n; i += 64) { const float v = pr[i]; const float e = (v == -INFINITY) ? 0.f : expf(v - mx); pr[i] = e; sm += e; }
#pragma unroll
    for (int o = 32; o > 0; o >>= 1) sm += __shfl_xor(sm, o);
    const float inv = 1.f / fmaxf(sm, 1e-30f);
    for (int i = lane; i < n; i += 64) pr[i] *= inv;
}

__global__ __launch_bounds__(256) void nsa_naive(const __half* __restrict__ proj, const float* __restrict__ rel_bias, const float* __restrict__ kcmp, const float* __restrict__ vcmp, __half* __restrict__ o_b) {
    __shared__ float q[4][64];
    __shared__ float lg[4][1024];
    __shared__ float score[64];
    __shared__ int sb[16];
    __shared__ int nsb;
    const int id = blockIdx.x, g = id & 1, row = id >> 1, b = row / S_, t = row % S_, tid = threadIdx.x;
    const int w = tid >> 6, lane = tid & 63;
    const __half* pr = proj + (size_t)row * PW;
    q[tid >> 6][tid & 63] = __half2float(pr[C_QB + g * 256 + tid]);
    if (tid == 0) nsb = 0;
    __syncthreads();
    const int cur = t >> 6;
    const int nv = t >= 31 ? (t - 31) / 16 + 1 : 0;
    const int r_ = tid >> 6, d_ = tid & 63;
    float oc = 0.f, os = 0.f, ow = 0.f;
    for (int i = tid; i < 4 * nv; i += 256) { const int r = i / nv, c = i % nv;
        const float* kr = kcmp + ((size_t)(b * NC + c) * 2 + g) * 64; float a = 0.f;
        for (int d = 0; d < 64; ++d) a += q[r][d] * kr[d];
        lg[r][c] = a * 0.125f + rel_bias[t5_bucket(t - (16 * c + 31)) * 16 + 8 + g * 4 + r]; }
    __syncthreads();
    if (nv > 0) softmax_row(lg[w], nv, lane);
    __syncthreads();
    for (int c = 0; c < nv; ++c) oc += lg[r_][c] * vcmp[((size_t)(b * NC + c) * 2 + g) * 64 + d_];
    if (tid < 64) { const int nb = tid; float imp = 0.f;
        for (int r = 0; r < 4; ++r) for (int c = 4 * nb - 1; c <= 4 * nb + 3; ++c) if (c >= 0 && c < nv) imp += lg[r][c] * ((c == 4 * nb - 1 || c == 4 * nb + 3) ? 0.5f : 1.f);
        const bool valid = nb <= cur; const bool forced = nb == 0 || nb == cur || nb == cur - 1;
        score[nb] = valid ? (forced ? 1.0e4f : imp) : -INFINITY; }
    __syncthreads();
    if (tid < 64) { bool selq = false;
        if (tid <= cur) { const float sc = score[tid]; int rank = 0;
            for (int m = 0; m <= cur; ++m) { const float sm = score[m]; rank += (sm > sc || (sm == sc && m < tid)) ? 1 : 0; }
            selq = rank < 16; }
        const unsigned long long bm = __ballot(selq);
        if (selq) sb[__popcll(bm & ((1ull << tid) - 1ull))] = tid;
        if (tid == 0) nsb = __popcll(bm); }
    __syncthreads();
    const int ns = nsb;
    for (int i = tid; i < 4 * ns * 64; i += 256) { const int r = i / (ns * 64), j = i % (ns * 64); const int pos = sb[j >> 6] * 64 + (j & 63);
        float v = -INFINITY;
        if (pos <= t) { const __half* kr = proj + (size_t)(b * S_ + pos) * PW + C_KVB + 2 * 128 + g * 64; float a = 0.f;
            for (int d = 0; d < 64; ++d) a += q[r][d] * __half2float(kr[d]);
            v = a * 0.125f + rel_bias[t5_bucket(t - pos) * 16 + 8 + g * 4 + r]; }
        lg[r][j] = v; }
    __syncthreads();
    softmax_row(lg[w], ns * 64, lane);
    __syncthreads();
    for (int j = 0; j < ns * 64; ++j) { const float pj = lg[r_][j]; if (pj != 0.f) { const int pos = sb[j >> 6] * 64 + (j & 63);
        os += pj * __half2float(proj[(size_t)(b * S_ + pos) * PW + C_KVB + 3 * 128 + g * 64 + d_]); } }
    __syncthreads();
    const int p0 = t - 511 > 0 ? t - 511 : 0; const int nw = t - p0 + 1;
    for (int i = tid; i < 4 * nw; i += 256) { const int r = i / nw, j = i % nw; const int pos = p0 + j;
        const __half* kr = proj + (size_t)(b * S_ + pos) * PW + C_KVB + 4 * 128 + g * 64; float a = 0.f;
        for (int d = 0; d < 64; ++d) a += q[r][d] * __half2float(kr[d]);
        lg[r][j] = a * 0.125f + rel_bias[t5_bucket(t - pos) * 16 + 8 + g * 4 + r]; }
    __syncthreads();
    softmax_row(lg[w], nw, lane);
    __syncthreads();
    for (int j = 0; j < nw; ++j) ow += lg[r_][j] * __half2float(proj[(size_t)(b * S_ + p0 + j) * PW + C_KVB + 5 * 128 + g * 64 + d_]);
    const float g0 = sigmoidf_(__half2float(pr[C_GB + 0 * 8 + g * 4 + r_])), g1 = sigmoidf_(__half2float(pr[C_GB + 1 * 8 + g * 4 + r_])), g2 = sigmoidf_(__half2float(pr[C_GB + 2 * 8 + g * 4 + r_]));
    o_b[(size_t)row * 512 + (g * 4 + r_) * 64 + d_] = __float2half(g0 * oc + g1 * os + g2 * ow);
}

__global__ __launch_bounds__(256) void final_norm_k(float* __restrict__ xio, const float* __restrict__ g) {
    __shared__ float red[4];
    const int row = blockIdx.x, tid = threadIdx.x;
    float* xr = xio + (size_t)row * D_;
    float v[4]; float ss = 0.f;
#pragma unroll
    for (int i = 0; i < 4; ++i) { v[i] = xr[tid + i * 256]; ss += v[i] * v[i]; }
#pragma unroll
    for (int o = 32; o > 0; o >>= 1) ss += __shfl_xor(ss, o);
    if ((tid & 63) == 0) red[tid >> 6] = ss;
    __syncthreads();
    const float rs = rsqrtf((red[0] + red[1] + red[2] + red[3]) / D_ + EPS);
#pragma unroll
    for (int i = 0; i < 4; ++i) xr[tid + i * 256] = v[i] * rs * g[tid + i * 256];
}

}

extern "C" void kernel_launch(void* const* d_in, const int* in_sizes, int n_in, void* d_out, int out_size, void* d_ws, size_t ws_size, hipStream_t stream) {
    if (ws_size < 500 * MiB) { fprintf(stderr, "ws too small: %zu\n", ws_size); return; }
    constexpr int GLDS = 131072 + 256;
    static int inited = 0;
    if (!inited) {
        inited = 1;
        (void)hipFuncSetAttribute((const void*)k_nsa, hipFuncAttributeMaxDynamicSharedMemorySize, nsa::L_END);
        (void)hipFuncSetAttribute((const void*)k_dsa, hipFuncAttributeMaxDynamicSharedMemorySize, dsa::L_END);
        (void)hipFuncSetAttribute((const void*)k_prologue, hipFuncAttributeMaxDynamicSharedMemorySize, 8 * 8704);
        (void)hipFuncSetAttribute((const void*)k_gemm<pg8::EpiProj>, hipFuncAttributeMaxDynamicSharedMemorySize, GLDS);
        (void)hipFuncSetAttribute((const void*)k_gemm<pg8::EpiMix<0>>, hipFuncAttributeMaxDynamicSharedMemorySize, GLDS); (void)hipFuncSetAttribute((const void*)k_gemm<pg8::EpiPlain>, hipFuncAttributeMaxDynamicSharedMemorySize, GLDS);
        (void)hipFuncSetAttribute((const void*)k_gemm<pg8::EpiMix<1>>, hipFuncAttributeMaxDynamicSharedMemorySize, GLDS);
        (void)hipFuncSetAttribute((const void*)k_gemm<pg8::EpiResid>, hipFuncAttributeMaxDynamicSharedMemorySize, GLDS);
        (void)hipFuncSetAttribute((const void*)k_gemm<pg8::EpiRelu2>, hipFuncAttributeMaxDynamicSharedMemorySize, GLDS);
        (void)hipFuncSetAttribute((const void*)k_gemm<EpiAccOut>, hipFuncAttributeMaxDynamicSharedMemorySize, GLDS);
    }
    Args a{};
    a.x = (const float*)d_in[0]; a.norm_mix = (const float*)d_in[1]; a.w_in = (const float*)d_in[2];
    a.pe_k = (const float*)d_in[3]; a.w1_k = (const float*)d_in[4]; a.w2_k = (const float*)d_in[5];
    a.pe_v = (const float*)d_in[6]; a.w1_v = (const float*)d_in[7]; a.w2_v = (const float*)d_in[8];
    a.rel_bias = (const float*)d_in[9]; a.w_ba = (const float*)d_in[10]; a.w_bb = (const float*)d_in[11];
    a.w_out = (const float*)d_in[12]; a.norm_mlp = (const float*)d_in[13]; a.w_mi = (const float*)d_in[14];
    a.w_mo = (const float*)d_in[15]; a.norm_final = (const float*)d_in[16];
    a.out = (float*)d_out; a.ws = (unsigned char*)d_ws;
    unsigned char* ws = a.ws; float* out = a.out;
    __half* proj = (__half*)(ws + WS_PROJ); __half* o_a = (__half*)(ws + WS_H); __half* o_b = (__half*)(ws + WS_H + 32 * MiB);
    float* kcmp = (float*)(ws + WS_KCMP); float* vcmp = (float*)(ws + WS_VCMP);
    const int G = 256;
    k_prologue<<<G, 512, 8 * 8704, stream>>>(a);
    k_gemm<pg8::EpiProj><<<G, 512, GLDS, stream>>>(ws + WS_H, ws + WS_WIN, pg8::EpiProj{(_Float16*)(ws + WS_PROJ)}, M_, PW, D_, 0);
    k_dsa<<<G, 512, dsa::L_END, stream>>>((const _Float16*)(ws + WS_PROJ), a.rel_bias, (_Float16*)(ws + WS_H), nullptr);
    compress_h<<<B_ * 256 * 2 * 2, 128, 0, stream>>>(proj, a.pe_k, a.w1_k, a.w2_k, a.pe_v, a.w1_v, a.w2_v, (__half*)(ws + WS_KCMP), (__half*)(ws + WS_VCMP));
    k_nsa<<<G, 512, nsa::L_END, stream>>>((const _Float16*)(ws + WS_PROJ), a.rel_bias, (const _Float16*)(ws + WS_KCMP), (const _Float16*)(ws + WS_VCMP), (_Float16*)(ws + WS_H + 32 * MiB));
    k_gemm<pg8::EpiMix<0>><<<G, 512, GLDS, stream>>>(ws + WS_H, ws + WS_WBA, pg8::EpiMix<0>{(_Float16*)(ws + WS_MIX), (const _Float16*)(ws + WS_PROJ)}, M_, D_, 512, 0);
    k_gemm<pg8::EpiMix<1>><<<G, 512, GLDS, stream>>>(ws + WS_H + 32 * MiB, ws + WS_WBB, pg8::EpiMix<1>{(_Float16*)(ws + WS_MIX), (const _Float16*)(ws + WS_PROJ)}, M_, D_, 512, 0);
    k_gemm<pg8::EpiResid><<<G, 512, GLDS, stream>>>(ws + WS_MIX, ws + WS_WOUT, pg8::EpiResid{a.x, out}, M_, D_, D_, 0);
    k_rows_norm<<<G, 512, 0, stream>>>(out, (_Float16*)(ws + WS_H));
    k_gemm<pg8::EpiRelu2><<<G, 512, GLDS, stream>>>(ws + WS_H, ws + WS_WMI, pg8::EpiRelu2{(_Float16*)(ws + WS_PROJ)}, M_, DFF, D_, 0);
    k_gemm<EpiAccOut><<<G, 512, GLDS, stream>>>(ws + WS_PROJ, ws + WS_WMO, EpiAccOut{out}, M_, D_, DFF, 0);
    final_norm_k<<<M_, 256, 0, stream>>>(out, a.norm_final);
}
```

```cpp
#include <hip/hip_runtime.h>
#include <hip/hip_fp16.h>
#include <cstdint>
#include <cstdio>
#ifndef DBGSEL
#define DBGSEL 8
#endif

namespace pg8 {
#define PG8_LAS __attribute__((address_space(3)))
typedef unsigned short bf16_t;
typedef _Float16 bf16x8 __attribute__((ext_vector_type(8)));
typedef float f32x4 __attribute__((ext_vector_type(4)));
typedef unsigned u32x4 __attribute__((ext_vector_type(4)));
constexpr int BM = 256, BK = 64, HALF = 128, HTB = HALF * BK * 2  , STAGE_BYTES = 8 * HTB, NXCD = 8, WGM = 8;

__host__ __device__ __forceinline__ int lds_byte(int r, int c) { const int st = (r >> 4) * 2 + (c >> 5), rr = r & 15, cc = c & 31, ob = rr * 64 + cc * 2; return st * 1024 + (ob ^ (((ob >> 9) & 1) << 5)); }
__host__ __device__ __forceinline__ void stage_rc(int b, int& R, int& C) { const int st = b / 1024, sb = b % 1024, swz = sb ^ (((sb >> 9) & 1) << 5); R = (st >> 1) * 16 + swz / 64; C = (st & 1) * 32 + (swz % 64) / 2; }
__host__ __device__ __forceinline__ int perm32(int rho) { const int n = rho >> 4, i = rho & 15; return 8 * (i >> 2) + 4 * n + (i & 3); }

struct Unit { int pm, pn; };
struct Gemm { const bf16_t* A; const bf16_t* Bt; int M, N, K; };

struct StaticOrder {
    int nM, nN, nwg, G, c;
    __host__ __device__ void init(int M, int N, int G_, int c_) { nM = M / BM; nN = N / BM; nwg = nM * nN; G = G_; c = c_; }
    __host__ __device__ bool next(int i, Unit& u) const {
        const long L = (long)i * G + c; if (L >= nwg) return false;
        int wgid = (int)L; { const int q = nwg / NXCD, r = nwg % NXCD, xcd = wgid % NXCD, off = wgid / NXCD; wgid = (xcd < r ? xcd * (q + 1) : r * (q + 1) + (xcd - r) * q) + off; }
        const int nig = WGM * nN, gid = wgid / nig, fm = gid * WGM, gsz = (nM - fm) < WGM ? (nM - fm) : WGM;
        u.pm = fm + ((wgid % nig) % gsz); u.pn = (wgid % nig) / gsz; return true;
    }
    __device__ __forceinline__ void a_ready(const Unit&) const {}
    __device__ __forceinline__ void done(const Unit&) const {}
};


typedef float f32x2 __attribute__((ext_vector_type(2)));
typedef _Float16 f16x2 __attribute__((ext_vector_type(2)));
constexpr int PW = 4352;
__device__ __forceinline__ unsigned pkh(float a, float b) { f32x2 v = {a, b}; f16x2 h = __builtin_convertvector(v, f16x2); return __builtin_bit_cast(unsigned, h); }
__device__ __forceinline__ float sigm(float v) { return __builtin_amdgcn_rcpf(1.f + __expf(-v)); }
__device__ __forceinline__ void unpk8(const u32x4 w, float (&f)[8]) {
#pragma unroll
    for (int i = 0; i < 4; ++i) { const unsigned wi = (i == 0) ? w.x : (i == 1) ? w.y : (i == 2) ? w.z : w.w; const f16x2 h = __builtin_bit_cast(f16x2, wi); f[2 * i] = (float)h.x; f[2 * i + 1] = (float)h.y; } }

struct EpiProj {
    static constexpr bool PERM = true, AFTER_DRAIN = false;
    _Float16* O;
    __device__ __forceinline__ void operator()(const f32x4 (&acc)[2][2][4][2], const Unit& u, int wr, int wc, int fr, int fq) const {
        const int row0 = u.pm * BM + wr * 64 + fr, col0 = u.pn * BM + wc * 32 + 8 * fq; const bool sg = u.pn >= 9;
#pragma unroll
        for (int ai = 0; ai < 2; ++ai)
#pragma unroll
            for (int m = 0; m < 4; ++m) { _Float16* rowp = O + (size_t)(row0 + ai * HALF + m * 16) * PW + col0;
#pragma unroll
                for (int bj = 0; bj < 2; ++bj) { f32x4 v0 = acc[ai][bj][m][0], v1 = acc[ai][bj][m][1];
                    if (sg) {
#pragma unroll
                        for (int i = 0; i < 4; ++i) { v0[i] = sigm(v0[i]); v1[i] = sigm(v1[i]); } }
                    u32x4 w; w.x = pkh(v0[0], v0[1]); w.y = pkh(v0[2], v0[3]); w.z = pkh(v1[0], v1[1]); w.w = pkh(v1[2], v1[3]);
                    *(u32x4*)(rowp + bj * HALF) = w; } }
    }
};
template <int SECOND> struct EpiMix {
    static constexpr bool PERM = true, AFTER_DRAIN = false;
    _Float16* mix; const _Float16* proj;
    __device__ __forceinline__ void operator()(const f32x4 (&acc)[2][2][4][2], const Unit& u, int wr, int wc, int fr, int fq) const {
        const int row0 = u.pm * BM + wr * 64 + fr, col0 = u.pn * BM + wc * 32 + 8 * fq;
#pragma unroll
        for (int ai = 0; ai < 2; ++ai)
#pragma unroll
            for (int m = 0; m < 4; ++m) { const size_t r = (size_t)(row0 + ai * HALF + m * 16);
#pragma unroll
                for (int bj = 0; bj < 2; ++bj) { const int c = col0 + bj * HALF;
                    float g[8]; unpk8(*(const u32x4*)(proj + r * PW + 2304 + SECOND * 1024 + c), g);
                    const f32x4 v0 = acc[ai][bj][m][0], v1 = acc[ai][bj][m][1];
                    float o[8] = {g[0] * v0[0], g[1] * v0[1], g[2] * v0[2], g[3] * v0[3], g[4] * v1[0], g[5] * v1[1], g[6] * v1[2], g[7] * v1[3]};
                    if (SECOND) { float p[8]; unpk8(*(const u32x4*)(mix + r * 1024 + c), p);
#pragma unroll
                        for (int i = 0; i < 8; ++i) o[i] += p[i]; }
                    u32x4 w; w.x = pkh(o[0], o[1]); w.y = pkh(o[2], o[3]); w.z = pkh(o[4], o[5]); w.w = pkh(o[6], o[7]);
                    *(u32x4*)(mix + r * 1024 + c) = w; } }
    }
};
struct EpiPlain {
    static constexpr bool PERM = true, AFTER_DRAIN = false;
    _Float16* U;
    __device__ __forceinline__ void operator()(const f32x4 (&acc)[2][2][4][2], const Unit& u, int wr, int wc, int fr, int fq) const {
        const int row0 = u.pm * BM + wr * 64 + fr, col0 = u.pn * BM + wc * 32 + 8 * fq;
#pragma unroll
        for (int ai = 0; ai < 2; ++ai)
#pragma unroll
            for (int m = 0; m < 4; ++m) { _Float16* rowp = U + (size_t)(row0 + ai * HALF + m * 16) * 1024 + col0;
#pragma unroll
                for (int bj = 0; bj < 2; ++bj) { f32x4 v0 = acc[ai][bj][m][0], v1 = acc[ai][bj][m][1];
                    u32x4 w; w.x = pkh(v0[0], v0[1]); w.y = pkh(v0[2], v0[3]); w.z = pkh(v1[0], v1[1]); w.w = pkh(v1[2], v1[3]);
                    *(u32x4*)(rowp + bj * HALF) = w; } }
    }
};
struct EpiResid {
    static constexpr bool PERM = true, AFTER_DRAIN = false;
    const float* x; float* out;
    __device__ __forceinline__ void operator()(const f32x4 (&acc)[2][2][4][2], const Unit& u, int wr, int wc, int fr, int fq) const {
        const int row0 = u.pm * BM + wr * 64 + fr, col0 = u.pn * BM + wc * 32 + 8 * fq;
#pragma unroll
        for (int ai = 0; ai < 2; ++ai)
#pragma unroll
            for (int m = 0; m < 4; ++m) { const size_t r = (size_t)(row0 + ai * HALF + m * 16);
#pragma unroll
                for (int bj = 0; bj < 2; ++bj) { const size_t o = r * 1024 + col0 + bj * HALF;
                    const f32x4 a0 = *(const f32x4*)(x + o), a1 = *(const f32x4*)(x + o + 4);
                    *(f32x4*)(out + o) = a0 + acc[ai][bj][m][0]; *(f32x4*)(out + o + 4) = a1 + acc[ai][bj][m][1]; } }
    }
};
struct EpiRelu2 {
    static constexpr bool PERM = true, AFTER_DRAIN = false;
    _Float16* U;
    __device__ __forceinline__ void operator()(const f32x4 (&acc)[2][2][4][2], const Unit& u, int wr, int wc, int fr, int fq) const {
        const int row0 = u.pm * BM + wr * 64 + fr, col0 = u.pn * BM + wc * 32 + 8 * fq;
#pragma unroll
        for (int ai = 0; ai < 2; ++ai)
#pragma unroll
            for (int m = 0; m < 4; ++m) { _Float16* rowp = U + (size_t)(row0 + ai * HALF + m * 16) * 4096 + col0;
#pragma unroll
                for (int bj = 0; bj < 2; ++bj) { f32x4 v0 = acc[ai][bj][m][0], v1 = acc[ai][bj][m][1];
#pragma unroll
                    for (int i = 0; i < 4; ++i) { const float a = fmaxf(v0[i], 0.f), b = fmaxf(v1[i], 0.f); v0[i] = a * a; v1[i] = b * b; }
                    u32x4 w; w.x = pkh(v0[0], v0[1]); w.y = pkh(v0[2], v0[3]); w.z = pkh(v1[0], v1[1]); w.w = pkh(v1[2], v1[3]);
                    *(u32x4*)(rowp + bj * HALF) = w; } }
    }
};
template <class Epi, class Sched, bool ALIGN_EPI = false, bool SP2 = false>
__device__ __forceinline__ void gemm_phase(PG8_LAS unsigned char* lds, const Gemm g, const Sched& S, const Epi& E) {
    int tid_ = threadIdx.x; asm volatile("" : "+v"(tid_));
    const int tid = tid_, wid = __builtin_amdgcn_readfirstlane(tid >> 6), lane = tid & 63, wr = wid >> 2, wc = wid & 3, fr = lane & 15, fq = lane >> 4;
    const int K = g.K, nt = K / BK;
    unsigned voffA[2], voffB[2];
#pragma unroll
    for (int i = 0; i < 2; ++i) { int R, C; stage_rc(tid * 16 + i * 8192, R, C); const int Rb = Epi::PERM ? ((R & ~31) + perm32(R & 31)) : R;
        voffA[i] = (unsigned)(R * K + C) * 2u; voffB[i] = (unsigned)(Rb * K + C) * 2u; }
    const size_t kstep = (size_t)(BK * 2);
    const size_t hstep = (size_t)HALF * K * 2;
    const size_t tstep = 2 * hstep;
    const unsigned ldsw = (unsigned)wid * 1024u;
    const int aoff = lds_byte(wr * 64 + fr, fq * 8), boff = lds_byte(wc * 32 + fr, fq * 8);
#define PG8_SA(b, h) (((b) * 2 + (h)) * HTB)
#define PG8_SB(b, h) ((4 + (b) * 2 + (h)) * HTB)
#define PG8_STAGE(bufoff, gbase, voff) do { _Pragma("unroll") for (int _i = 0; _i < 2; ++_i) \
        __builtin_amdgcn_global_load_lds((const unsigned*)((const char*)(gbase) + (voff)[_i]), (PG8_LAS unsigned*)(lds + (bufoff) + ldsw + _i * 8192), 16, 0, 0); } while (0)
#define PG8_LDA(dst, b, h) do { _Pragma("unroll") for (int m = 0; m < 4; ++m) _Pragma("unroll") for (int k = 0; k < 2; ++k) dst[m][k] = *(const PG8_LAS bf16x8*)(lds + PG8_SA(b, h) + aoff + m * 2048 + k * 1024); } while (0)
#define PG8_LDB(dst, b, h) do { _Pragma("unroll") for (int n = 0; n < 2; ++n) _Pragma("unroll") for (int k = 0; k < 2; ++k) dst[n][k] = *(const PG8_LAS bf16x8*)(lds + PG8_SB(b, h) + boff + n * 2048 + k * 1024); } while (0)
#define PG8_MMA(ai, bj, At, Bt) do { __builtin_amdgcn_s_setprio(1); _Pragma("unroll") for (int m = 0; m < 4; ++m) _Pragma("unroll") for (int n = 0; n < 2; ++n) _Pragma("unroll") for (int k = 0; k < 2; ++k) \
        acc[ai][bj][m][n] = __builtin_amdgcn_mfma_f32_16x16x32_f16(Bt[n][k], At[m][k], acc[ai][bj][m][n], 0, 0, 0); __builtin_amdgcn_s_setprio(0); } while (0)
#define PG8_WAIT_V(n) asm volatile("s_waitcnt vmcnt(" #n ")" ::: "memory")
#define PG8_WAIT_L(n) asm volatile("s_waitcnt lgkmcnt(" #n ")" ::: "memory")
#define PG8_BAR __builtin_amdgcn_s_barrier()
#define PG8_SCHED __builtin_amdgcn_sched_barrier(0)
    Unit cur, nxt; int ui = 0;
    if (!S.next(0, cur)) return;
    f32x4 acc[2][2][4][2];
#pragma unroll
    for (int a = 0; a < 2; ++a)
#pragma unroll
        for (int b = 0; b < 2; ++b)
#pragma unroll
            for (int m = 0; m < 4; ++m)
#pragma unroll
                for (int n = 0; n < 2; ++n) acc[a][b][m][n] = (f32x4){0.f, 0.f, 0.f, 0.f};
    bf16x8 At[4][2], B0[2][2], B1[2][2];
    const char* cA = (const char*)g.A + (size_t)cur.pm * tstep; const char* cB = (const char*)g.Bt + (size_t)cur.pn * tstep;
    S.a_ready(cur);
    if constexpr (SP2) {
        PG8_STAGE(PG8_SB(0, 0), cB, voffB); PG8_STAGE(PG8_SB(0, 1), cB + hstep, voffB); PG8_STAGE(PG8_SA(0, 0), cA, voffA); PG8_STAGE(PG8_SA(0, 1), cA + hstep, voffA);
        if (wr == 1) PG8_BAR;
        PG8_WAIT_V(2); PG8_BAR;
        PG8_STAGE(PG8_SB(1, 0), cB + kstep, voffB); PG8_STAGE(PG8_SA(1, 0), cA + kstep, voffA); PG8_STAGE(PG8_SB(1, 1), cB + hstep + kstep, voffB);
        PG8_WAIT_V(6); PG8_BAR;
    } else {
        PG8_STAGE(PG8_SB(0, 0), cB, voffB); PG8_STAGE(PG8_SA(0, 0), cA, voffA); PG8_STAGE(PG8_SB(0, 1), cB + hstep, voffB); PG8_STAGE(PG8_SA(0, 1), cA + hstep, voffA);
        if (wr == 1) PG8_BAR;
        PG8_WAIT_V(4); PG8_BAR;
        PG8_STAGE(PG8_SB(1, 0), cB + kstep, voffB); PG8_STAGE(PG8_SA(1, 0), cA + kstep, voffA); PG8_STAGE(PG8_SB(1, 1), cB + hstep + kstep, voffB);
        PG8_WAIT_V(6); PG8_BAR;
    }
    for (;;) {
        const bool has_next = S.next(ui + 1, nxt);
        const char* nA = has_next ? (const char*)g.A + (size_t)nxt.pm * tstep : cA; const char* nB = has_next ? (const char*)g.Bt + (size_t)nxt.pn * tstep : cB;
        for (int t = 0; t < nt; t += 2) {
            const bool last = (t == nt - 2);
            const char* a1 = cA + (size_t)(t + 1) * kstep;
            const char* a2 = last ? nA : cA + (size_t)(t + 2) * kstep; const char* b2 = last ? nB : cB + (size_t)(t + 2) * kstep;
            const char* a3 = a2 + kstep; const char* b3 = b2 + kstep;
            if (last && has_next) S.a_ready(nxt);
            if constexpr (SP2) {
            PG8_LDB(B0, 0, 0); PG8_LDB(B1, 0, 1); PG8_SCHED; PG8_LDA(At, 0, 0); PG8_STAGE(PG8_SA(1, 1), a1 + hstep, voffA);
            PG8_WAIT_V(8); PG8_WAIT_L(0); PG8_BAR; PG8_MMA(0, 0, At, B0); PG8_MMA(0, 1, At, B1); PG8_BAR; PG8_SCHED;
            PG8_LDA(At, 0, 1); PG8_STAGE(PG8_SB(0, 0), b2, voffB); PG8_STAGE(PG8_SB(0, 1), b2 + hstep, voffB); PG8_STAGE(PG8_SA(0, 0), a2, voffA);
            PG8_WAIT_V(8); PG8_WAIT_L(0); PG8_BAR; PG8_MMA(1, 0, At, B0); PG8_MMA(1, 1, At, B1); PG8_BAR; PG8_SCHED;
            PG8_LDB(B0, 1, 0); PG8_LDB(B1, 1, 1); PG8_SCHED; PG8_LDA(At, 1, 0); PG8_STAGE(PG8_SA(0, 1), a2 + hstep, voffA);
            PG8_WAIT_V(8); PG8_WAIT_L(0); PG8_BAR; PG8_MMA(0, 0, At, B0); PG8_MMA(0, 1, At, B1); PG8_BAR; PG8_SCHED;
            PG8_LDA(At, 1, 1); PG8_STAGE(PG8_SB(1, 0), b3, voffB); PG8_STAGE(PG8_SB(1, 1), b3 + hstep, voffB); PG8_STAGE(PG8_SA(1, 0), a3, voffA);
            PG8_WAIT_V(8); PG8_WAIT_L(0); PG8_BAR; PG8_MMA(1, 0, At, B0); PG8_MMA(1, 1, At, B1); PG8_BAR; PG8_SCHED;
            } else {
            PG8_LDB(B0, 0, 0); PG8_SCHED; PG8_LDA(At, 0, 0); PG8_STAGE(PG8_SA(1, 1), a1 + hstep, voffA);
            PG8_WAIT_L(8); PG8_BAR; PG8_WAIT_L(0); PG8_MMA(0, 0, At, B0); PG8_BAR; PG8_SCHED;
            PG8_LDB(B1, 0, 1); PG8_STAGE(PG8_SB(0, 0), b2, voffB);
            PG8_BAR; PG8_WAIT_L(0); PG8_MMA(0, 1, At, B1); PG8_BAR;
            PG8_LDA(At, 0, 1); PG8_STAGE(PG8_SA(0, 0), a2, voffA);
            PG8_BAR; PG8_WAIT_L(0); PG8_MMA(1, 0, At, B0); PG8_BAR; PG8_SCHED;
            PG8_STAGE(PG8_SB(0, 1), b2 + hstep, voffB);
            PG8_WAIT_V(6); PG8_BAR; PG8_MMA(1, 1, At, B1); PG8_BAR;
            PG8_LDB(B0, 1, 0); PG8_SCHED; PG8_LDA(At, 1, 0); PG8_STAGE(PG8_SA(0, 1), a2 + hstep, voffA);
            PG8_WAIT_L(8); PG8_BAR; PG8_WAIT_L(0); PG8_MMA(0, 0, At, B0); PG8_BAR; PG8_SCHED;
            PG8_LDB(B1, 1, 1); PG8_STAGE(PG8_SB(1, 0), b3, voffB);
            PG8_BAR; PG8_WAIT_L(0); PG8_MMA(0, 1, At, B1); PG8_BAR;
            PG8_LDA(At, 1, 1); PG8_STAGE(PG8_SA(1, 0), a3, voffA);
            PG8_BAR; PG8_WAIT_L(0); PG8_MMA(1, 0, At, B0); PG8_BAR; PG8_SCHED;
            PG8_STAGE(PG8_SB(1, 1), b3 + hstep, voffB);
            PG8_WAIT_V(6); PG8_BAR; PG8_MMA(1, 1, At, B1); PG8_BAR;
            }
        }
        if constexpr (ALIGN_EPI) { if (wr == 0) PG8_BAR; }
        if constexpr (!Epi::AFTER_DRAIN) { E(acc, cur, wr, wc, fr, fq); S.done(cur); }
        if (!has_next) break;
#pragma unroll
        for (int a = 0; a < 2; ++a)
#pragma unroll
            for (int b = 0; b < 2; ++b)
#pragma unroll
                for (int m = 0; m < 4; ++m)
#pragma unroll
                    for (int n = 0; n < 2; ++n) acc[a][b][m][n] = (f32x4){0.f, 0.f, 0.f, 0.f};
        cur = nxt; cA = nA; cB = nB; ++ui;
        if constexpr (ALIGN_EPI) { if (wr == 1) PG8_BAR; }
    }
    PG8_WAIT_V(0);
    if constexpr (!ALIGN_EPI) { if (wr == 0) PG8_BAR; }
    PG8_BAR;
    if constexpr (Epi::AFTER_DRAIN) { E.fused(acc, cur, wr, wc, fr, fq, lds, wid, lane); S.done(cur); }
#undef PG8_SA
#undef PG8_SB
#undef PG8_STAGE
#undef PG8_LDA
#undef PG8_LDB
#undef PG8_MMA
#undef PG8_WAIT_V
#undef PG8_WAIT_L
#undef PG8_BAR
#undef PG8_SCHED
}
}


namespace {
constexpr int B_ = 8, S_ = 4096, M_ = B_ * S_, D_ = 1024, DIN = 4288, DFF = 4096;
constexpr int C_QA = 0, C_QB = 512, C_QI = 1024, C_KVB = 1280, C_KA = 2048, C_VA = 2112, C_KI = 2176, C_WI = 2208, C_GB = 2216, C_GATE = 2304;
constexpr int NC = 255;
constexpr float EPS = 1e-6f;
using pg8::PW;
#define GAS __attribute__((address_space(1)))
#define LAS __attribute__((address_space(3)))
typedef unsigned v4u __attribute__((ext_vector_type(4)));
typedef float f32x4 __attribute__((ext_vector_type(4)));

__device__ __forceinline__ int t5_bucket(int n) {
    if (n < 16) return n < 0 ? 0 : n;
    float nf = (float)n;
    int large = 16 + (int)(logf(nf / 16.f) / logf(8.f) * 16.f);
    return large < 31 ? large : 31;
}
__device__ __forceinline__ float sigmoidf_(float v) { return 1.f / (1.f + expf(-v)); }


__device__ __forceinline__ int win_src_col(int n) {
    if (n < 512) return n;
    if (n < 1024) return 936 + (n - 512);
    if (n < 1280) return 640 + (n - 1024);
    if (n < 2048) return 1448 + (n - 1280);
    if (n < 2112) return 512 + (n - 2048);
    if (n < 2176) return 576 + (n - 2112);
    if (n < 2208) return 896 + (n - 2176);
    if (n < 2216) return 928 + (n - 2208);
    if (n < 2240) return n;
    if (n < 2304) return -1;
    return 2240 + (n - 2304);
}
__device__ __forceinline__ float wave_sum(float v) {
#pragma unroll
    for (int o = 1; o < 64; o <<= 1) v += __shfl_xor(v, o);
    return v;
}
template <bool MAP>
__device__ __forceinline__ void transpose_item(const float* __restrict__ W, int K, int Nsrc, int Ndst, _Float16* __restrict__ WT, const float* __restrict__ gain, float* scr, int item, int lane) {
    const int nblk = Ndst / 32, kb = item / nblk, nb = item % nblk, k0 = 64 * kb, n0 = 32 * nb;
    const int nd = n0 + (lane & 31); const int ns = MAP ? win_src_col(nd) : nd;
#pragma unroll 8
    for (int i = 0; i < 32; ++i) { const int kk = 2 * i + (lane >> 5); float v = 0.f;
        if (ns >= 0) { v = W[(size_t)(k0 + kk) * Nsrc + ns]; if (gain) v *= gain[k0 + kk]; }
        scr[kk * 33 + (lane & 31)] = v; }
    __builtin_amdgcn_s_waitcnt(0xc07f); asm volatile("" ::: "memory");
    const int c = lane & 7;
#pragma unroll
    for (int j = 0; j < 4; ++j) { const int n = (lane >> 3) + 8 * j; const float* s = scr + (8 * c) * 33 + n;
        v4u o; o.x = pg8::pkh(s[0 * 33], s[1 * 33]); o.y = pg8::pkh(s[2 * 33], s[3 * 33]); o.z = pg8::pkh(s[4 * 33], s[5 * 33]); o.w = pg8::pkh(s[6 * 33], s[7 * 33]);
        *(v4u*)(WT + (size_t)(n0 + n) * K + k0 + 8 * c) = o; }
    __builtin_amdgcn_s_waitcnt(0xc07f); asm volatile("" ::: "memory");
}
__device__ __forceinline__ void rms_row_to_f16(const float* __restrict__ xrow, _Float16* __restrict__ orow, int lane) {
    const f32x4* xr = (const f32x4*)xrow + lane;
    f32x4 v[4]; float s = 0.f;
#pragma unroll
    for (int j = 0; j < 4; ++j) { v[j] = xr[64 * j]; s += (v[j].x * v[j].x + v[j].y * v[j].y) + (v[j].z * v[j].z + v[j].w * v[j].w); }
    const float rstd = rsqrtf(wave_sum(s) * (1.f / D_) + EPS);
    unsigned long long* o8 = (unsigned long long*)orow + lane;
#pragma unroll
    for (int j = 0; j < 4; ++j) o8[64 * j] = (unsigned long long)pg8::pkh(v[j].x * rstd, v[j].y * rstd) | ((unsigned long long)pg8::pkh(v[j].z * rstd, v[j].w * rstd) << 32);
}

struct Args {
    const float* x; const float* norm_mix; const float* w_in; const float* pe_k; const float* w1_k; const float* w2_k; const float* pe_v; const float* w1_v; const float* w2_v;
    const float* rel_bias; const float* w_ba; const float* w_bb; const float* w_out; const float* norm_mlp; const float* w_mi; const float* w_mo; const float* norm_final;
    float* out; unsigned char* ws;
};
constexpr size_t MiB = 1u << 20;
constexpr size_t WS_CTL = 0, WS_WIN = 1 * MiB, WS_WBA = 10 * MiB, WS_WBB = 11 * MiB, WS_WOUT = 12 * MiB, WS_WMI = 14 * MiB, WS_WMO = 22 * MiB, WS_CW = 30 * MiB,
                 WS_KCMP = 32 * MiB, WS_VCMP = 33 * MiB, WS_H = 34 * MiB, WS_PROJ = 98 * MiB, WS_MIX = 370 * MiB, WS_END = 434 * MiB;

__device__ __forceinline__ void prologue_body(const Args& a, unsigned char* lds) {
    const int tid = threadIdx.x, lane = tid & 63, wave = tid >> 6;
    float* scr = (float*)(lds + wave * 8704);
    const int gw = blockIdx.x * 8 + wave, NGW = gridDim.x * 8;
    constexpr int I_IN = (D_ / 64) * (PW / 32), I_BA = (512 / 64) * (D_ / 32), I_OUT = (D_ / 64) * (D_ / 32), I_MI = (D_ / 64) * (DFF / 32), I_MO = (DFF / 64) * (D_ / 32);
    constexpr int I_C1 = (2048 / 64) * (128 / 32), I_C2 = (128 / 64) * (64 / 32);
    constexpr int NITEMS = I_IN + 2 * I_BA + I_OUT + I_MI + I_MO + 2 * I_C1 + 2 * I_C2;
    for (int it = gw; it < NITEMS; it += NGW) {
        int r = it;
        if (r < I_IN) { transpose_item<true>(a.w_in, D_, DIN, PW, (_Float16*)(a.ws + WS_WIN), a.norm_mix, scr, r, lane); continue; } r -= I_IN;
        if (r < I_BA) { transpose_item<false>(a.w_ba, 512, D_, D_, (_Float16*)(a.ws + WS_WBA), nullptr, scr, r, lane); continue; } r -= I_BA;
        if (r < I_BA) { transpose_item<false>(a.w_bb, 512, D_, D_, (_Float16*)(a.ws + WS_WBB), nullptr, scr, r, lane); continue; } r -= I_BA;
        if (r < I_OUT) { transpose_item<false>(a.w_out, D_, D_, D_, (_Float16*)(a.ws + WS_WOUT), nullptr, scr, r, lane); continue; } r -= I_OUT;
        if (r < I_MI) { transpose_item<false>(a.w_mi, D_, DFF, DFF, (_Float16*)(a.ws + WS_WMI), a.norm_mlp, scr, r, lane); continue; } r -= I_MI;
        if (r < I_MO) { transpose_item<false>(a.w_mo, DFF, D_, D_, (_Float16*)(a.ws + WS_WMO), nullptr, scr, r, lane); continue; } r -= I_MO;
        if (r < I_C1) { transpose_item<false>(a.w1_k, 2048, 128, 128, (_Float16*)(a.ws + WS_CW), nullptr, scr, r, lane); continue; } r -= I_C1;
        if (r < I_C1) { transpose_item<false>(a.w1_v, 2048, 128, 128, (_Float16*)(a.ws + WS_CW + 512 * 1024), nullptr, scr, r, lane); continue; } r -= I_C1;
        if (r < I_C2) { transpose_item<false>(a.w2_k, 128, 64, 64, (_Float16*)(a.ws + WS_CW + 1024 * 1024), nullptr, scr, r, lane); continue; } r -= I_C2;
        transpose_item<false>(a.w2_v, 128, 64, 64, (_Float16*)(a.ws + WS_CW + 1024 * 1024 + 16384), nullptr, scr, r, lane);
    }
    for (int m = gw; m < M_; m += NGW) rms_row_to_f16(a.x + (size_t)m * D_, (_Float16*)(a.ws + WS_H) + (size_t)m * D_, lane);
}
__global__ void __launch_bounds__(512, 2) k_prologue(Args a) {
    extern __shared__ __attribute__((aligned(16))) unsigned char lds[];
    prologue_body(a, lds);
}
__device__ __forceinline__ void final_norm_row(float* __restrict__ xrow, const float* __restrict__ g, int lane) {
    f32x4* xr = (f32x4*)xrow + lane; const f32x4* gr = (const f32x4*)g + lane;
    f32x4 v[4]; float s = 0.f;
#pragma unroll
    for (int j = 0; j < 4; ++j) { v[j] = xr[64 * j]; s += (v[j].x * v[j].x + v[j].y * v[j].y) + (v[j].z * v[j].z + v[j].w * v[j].w); }
    const float rstd = rsqrtf(wave_sum(s) * (1.f / D_) + EPS);
#pragma unroll
    for (int j = 0; j < 4; ++j) { const f32x4 gg = gr[64 * j]; xr[64 * j] = v[j] * rstd * gg; }
}
__global__ void __launch_bounds__(512, 2) k_rows_norm(const float* __restrict__ src, _Float16* __restrict__ dst) {
    const int lane = threadIdx.x & 63, gw = blockIdx.x * 8 + (threadIdx.x >> 6), NGW = gridDim.x * 8;
    for (int m = gw; m < M_; m += NGW) rms_row_to_f16(src + (size_t)m * D_, dst + (size_t)m * D_, lane);
}
template <class Epi>
__global__ void __launch_bounds__(512, 2) k_gemm(const void* A, const void* Bt, Epi E, int M, int N, int K, int pad_) {
    extern __shared__ __attribute__((aligned(16))) unsigned char lds[];
    pg8::Gemm g{(const pg8::bf16_t*)A, (const pg8::bf16_t*)Bt, M, N, K};
    pg8::StaticOrder S; S.init(M, N, (int)gridDim.x, (int)blockIdx.x);
    pg8::gemm_phase<Epi, pg8::StaticOrder, true, true>((PG8_LAS unsigned char*)lds, g, S, E);
}
struct EpiAccOut {
    static constexpr bool PERM = true, AFTER_DRAIN = false;
    float* out;
    __device__ __forceinline__ void operator()(const f32x4 (&acc)[2][2][4][2], const pg8::Unit& u, int wr, int wc, int fr, int fq) const {
        const int row0 = u.pm * 256 + wr * 64 + fr, col0 = u.pn * 256 + wc * 32 + 8 * fq;
#pragma unroll
        for (int ai = 0; ai < 2; ++ai)
#pragma unroll
            for (int m = 0; m < 4; ++m) { const size_t r = (size_t)(row0 + ai * 128 + m * 16);
#pragma unroll
                for (int bj = 0; bj < 2; ++bj) { const size_t o = r * 1024 + col0 + bj * 128;
                    const f32x4 a0 = *(const f32x4*)(out + o), a1 = *(const f32x4*)(out + o + 4);
                    *(f32x4*)(out + o) = a0 + acc[ai][bj][m][0]; *(f32x4*)(out + o + 4) = a1 + acc[ai][bj][m][1]; } }
    }
};


namespace dsa {
typedef _Float16 f16x8 __attribute__((ext_vector_type(8)));
typedef _Float16 f16x4 __attribute__((ext_vector_type(4)));
typedef short s16x4 __attribute__((ext_vector_type(4)));
typedef float f32x4 __attribute__((ext_vector_type(4)));
typedef unsigned u32x4 __attribute__((ext_vector_type(4)));
typedef unsigned u32x2 __attribute__((ext_vector_type(2)));
constexpr int TQ = 16, NBIN = 2048, CANDCAP = 512, VPITCH = 144;
constexpr int L_HIST = 0, L_SEL = 65536, L_CTL = L_SEL + 8192, L_BIAS = L_CTL + 512, L_VST = L_BIAS + 4096, L_END = L_VST + 8 * 32 * VPITCH;
static_assert(L_END <= 131072, "dsa LDS");

__device__ __forceinline__ float idx_score(const f32x4 a1, const f32x4 a2, const float (&w)[8]) {
    float s = w[0] * fmaxf(a1.x, 0.f);
    s = fmaf(w[1], fmaxf(a1.y, 0.f), s); s = fmaf(w[2], fmaxf(a1.z, 0.f), s); s = fmaf(w[3], fmaxf(a1.w, 0.f), s);
    s = fmaf(w[4], fmaxf(a2.x, 0.f), s); s = fmaf(w[5], fmaxf(a2.y, 0.f), s); s = fmaf(w[6], fmaxf(a2.z, 0.f), s); s = fmaf(w[7], fmaxf(a2.w, 0.f), s);
    return s;
}
__device__ __forceinline__ int score_bin(float sc, float inv) { int b = (int)(fmaf(sc, inv, 1024.f)); b = b < 0 ? 0 : b; return b > NBIN - 1 ? NBIN - 1 : b; }

template <int PASS>
__device__ __forceinline__ void score_pass(LAS unsigned char* lds, const _Float16* __restrict__ proj, int b, int t0, int nkb, int wave, int lane,
                                           const f16x8 (&afr)[4][2], const float (&wq)[4][8], const float (&binv)[4]) {
    LAS unsigned* hist = (LAS unsigned*)(lds + L_HIST);
    LAS unsigned short* sel = (LAS unsigned short*)(lds + L_SEL);
    LAS u32x2* cand = (LAS u32x2*)(lds + L_HIST);
    LAS int* ctl = (LAS int*)(lds + L_CTL);
    const int kc = lane >> 4, n16 = lane & 15;
    int bst[4];
#pragma unroll
    for (int grp = 0; grp < 4; ++grp) bst[grp] = (PASS == 2) ? ctl[(4 * grp + kc) * 8 + 2] : 0;
    const f32x4 zero = {0.f, 0.f, 0.f, 0.f};
    for (int kb = wave; kb < nkb; kb += 8) {
        const f16x8 bfr = *(const f16x8*)(proj + (size_t)(b * S_ + 16 * kb + n16) * PW + C_KI + 8 * kc);
        const int s = 16 * kb + n16;
#pragma unroll
        for (int grp = 0; grp < 4; ++grp) {
            const f32x4 a1 = __builtin_amdgcn_mfma_f32_16x16x32_f16(afr[grp][0], bfr, zero, 0, 0, 0);
            const f32x4 a2 = __builtin_amdgcn_mfma_f32_16x16x32_f16(afr[grp][1], bfr, zero, 0, 0, 0);
            const float sc = idx_score(a1, a2, wq[grp]);
            const int row = 4 * grp + kc, t = t0 + row;
            if (s <= t) {
                const int bin = score_bin(sc, binv[grp]);
                if (PASS == 1) { __hip_atomic_fetch_add(hist + row * 1024 + (bin >> 1), (bin & 1) ? 0x10000u : 1u, __ATOMIC_RELAXED, __HIP_MEMORY_SCOPE_WORKGROUP); }
                else {
                    if (bin > bst[grp]) { const int pos = __hip_atomic_fetch_add(ctl + row * 8 + 0, 1, __ATOMIC_RELAXED, __HIP_MEMORY_SCOPE_WORKGROUP); sel[row * 256 + (pos & 255)] = (unsigned short)s; }
                    else if (bin == bst[grp]) { const int pos = __hip_atomic_fetch_add(ctl + row * 8 + 1, 1, __ATOMIC_RELAXED, __HIP_MEMORY_SCOPE_WORKGROUP);
                        if (pos < CANDCAP) { u32x2 e; e.x = __float_as_uint(sc); e.y = (unsigned)s; cand[row * CANDCAP + pos] = e; } }
                }
            }
        }
    }
}

__device__ __forceinline__ void dsa_tile(LAS unsigned char* lds, const _Float16* __restrict__ proj, _Float16* __restrict__ o_a, int b, int qt, unsigned* dbg) {
    const int tid = threadIdx.x, lane = tid & 63, wave = __builtin_amdgcn_readfirstlane(tid >> 6);
    const int kc = lane >> 4, n16 = lane & 15;
    const int t0 = qt * TQ, nkb = qt + 1;
    LAS unsigned* hist = (LAS unsigned*)(lds + L_HIST);
    LAS unsigned short* sel = (LAS unsigned short*)(lds + L_SEL);
    LAS u32x2* cand = (LAS u32x2*)(lds + L_HIST);
    LAS int* ctl = (LAS int*)(lds + L_CTL);
    LAS float* biaslut = (LAS float*)(lds + L_BIAS);
    for (int i = tid; i < TQ * 1024 / 4; i += 512) ((LAS u32x4*)hist)[i] = (u32x4){0u, 0u, 0u, 0u};
    if (tid < TQ * 8) ctl[tid] = 0;
    f16x8 afr[4][2]; float wq[4][8]; float binv[4];
    { const int g = n16 >> 2, r = n16 & 3;
#pragma unroll
      for (int grp = 0; grp < 4; ++grp) {
          const _Float16* qrow = proj + (size_t)(b * S_ + t0 + 4 * grp + g) * PW + C_QI;
          afr[grp][0] = *(const f16x8*)(qrow + r * 32 + 8 * kc);
          afr[grp][1] = *(const f16x8*)(qrow + (4 + r) * 32 + 8 * kc);
          const f16x8 wv = *(const f16x8*)(proj + (size_t)(b * S_ + t0 + 4 * grp + kc) * PW + C_WI);
          float ss = 0.f;
#pragma unroll
          for (int h = 0; h < 8; ++h) { wq[grp][h] = (float)wv[h] * (1.f / 16.f); ss = fmaf(wq[grp][h], wq[grp][h], ss); }
          binv[grp] = 32.f * rsqrtf(ss + 1e-12f);
      } }
    __syncthreads();
    score_pass<1>(lds, proj, b, t0, nkb, wave, lane, afr, wq, binv);
    __syncthreads();
#pragma unroll 1
    for (int i = 0; i < 2; ++i) {
        const int row = 2 * wave + i, n = t0 + row + 1;
        if (n <= 256) { if (lane == 0) { ctl[row * 8 + 2] = -1; ctl[row * 8 + 3] = 0; } }
        else {
            const LAS u32x4* hp = (const LAS u32x4*)(hist + row * 1024 + 16 * lane);
            unsigned tot = 0;
#pragma unroll
            for (int q4 = 0; q4 < 4; ++q4) { const u32x4 hv = hp[q4];
                tot += (hv.x & 0xffffu) + (hv.x >> 16) + (hv.y & 0xffffu) + (hv.y >> 16) + (hv.z & 0xffffu) + (hv.z >> 16) + (hv.w & 0xffffu) + (hv.w >> 16); }
            unsigned suf = tot;
#pragma unroll
            for (int o = 1; o < 64; o <<= 1) { const unsigned v = __shfl_down(suf, o); if (lane + o < 64) suf += v; }
            const unsigned above_lane = suf - tot;
            if (above_lane < 256u && suf >= 256u) {
                const LAS unsigned short* h16 = (const LAS unsigned short*)hist + row * 2048 + 32 * lane;
                unsigned cum = above_lane; int bs = 32 * lane;
#pragma unroll 1
                for (int j = 31; j >= 0; --j) { const unsigned c = h16[j]; if (cum + c >= 256u) { bs = 32 * lane + j; break; } cum += c; }
                ctl[row * 8 + 2] = bs; ctl[row * 8 + 3] = 256 - (int)cum;
            }
        }
    }
    __syncthreads();
    score_pass<2>(lds, proj, b, t0, nkb, wave, lane, afr, wq, binv);
    __syncthreads();
#pragma unroll 1
    for (int i = 0; i < 2; ++i) {
        const int row = 2 * wave + i, n = t0 + row + 1;
        const int need = ctl[row * 8 + 3], base = ctl[row * 8 + 0];
        int nc = ctl[row * 8 + 1];
        if (lane == 0 && dbg) { if (nc > CANDCAP) atomicAdd(dbg + 5, 1u); if (need > nc) atomicAdd(dbg + 4, 1u); if (n > 256 && base + need != 256) atomicAdd(dbg + 6, 1u); atomicMax(dbg + 8, (unsigned)nc); }
        nc = nc < CANDCAP ? nc : CANDCAP;
        if (lane == 0) { const int nf = base + (need < nc ? need : nc); ctl[row * 8 + 4] = n <= 256 ? n : (nf < 256 ? nf : 256); }
        if (need > 0) {
            for (int c0 = 0; c0 < nc; c0 += 64) {
                const int ci = c0 + lane; const bool act = ci < nc;
                const u32x2 me = cand[row * CANDCAP + (act ? ci : 0)];
                const float msc = __uint_as_float(me.x); int rank = 0;
                for (int j = 0; j < nc; ++j) { const u32x2 ot = cand[row * CANDCAP + j]; const float osc = __uint_as_float(ot.x);
                    rank += (osc > msc || (osc == msc && ot.y < me.y)) ? 1 : 0; }
                if (act && rank < need) sel[row * 256 + ((base + rank) & 255)] = (unsigned short)me.y;
            }
        }
    }
    __syncthreads();
    LAS unsigned char* vst = lds + L_VST + wave * (32 * VPITCH);
#pragma unroll 1
    for (int i = 0; i < 2; ++i) {
        const int row = 2 * wave + i, t = t0 + row; const int nvalid = ctl[row * 8 + 4];
        const _Float16* qrow = proj + (size_t)(b * S_ + t) * PW + C_QA;
        const int head = n16, hm = head & 7;
        f16x8 qb0, qb1;
        { const f16x8 z = {0, 0, 0, 0, 0, 0, 0, 0}; qb0 = z; qb1 = z;
          if (head < 8) { qb0 = *(const f16x8*)(qrow + head * 64 + 8 * kc); qb1 = *(const f16x8*)(qrow + head * 64 + 32 + 8 * kc); } }
        f32x4 ot[4];
#pragma unroll
        for (int dt = 0; dt < 4; ++dt) ot[dt] = (f32x4){0.f, 0.f, 0.f, 0.f};
        float mrun = -INFINITY, lrun = 0.f;
        const LAS unsigned short* selr = sel + row * 256;
#pragma unroll 1
        for (int j = 0; j < 8; ++j) {
            if (32 * j >= nvalid) break;
            const int pa = 32 * j + n16, pb = pa + 16;
            const int ia = pa < nvalid ? (int)selr[pa] : 0, ib = pb < nvalid ? (int)selr[pb] : 0;
            const _Float16* kra = proj + (size_t)(b * S_ + ia) * PW + C_KA; const _Float16* krb = proj + (size_t)(b * S_ + ib) * PW + C_KA;
            const f16x8 ka0 = *(const f16x8*)(kra + 8 * kc), ka1 = *(const f16x8*)(kra + 32 + 8 * kc), kb0 = *(const f16x8*)(krb + 8 * kc), kb1 = *(const f16x8*)(krb + 32 + 8 * kc);
            { const int ki = lane >> 1, hf = lane & 1; const int pos = 32 * j + ki; const int idx = pos < nvalid ? (int)selr[pos] : 0;
              const _Float16* vrow = proj + (size_t)(b * S_ + idx) * PW + C_VA + hf * 32;
              const u32x4 v0 = *(const u32x4*)(vrow), v1 = *(const u32x4*)(vrow + 8), v2 = *(const u32x4*)(vrow + 16), v3 = *(const u32x4*)(vrow + 24);
              LAS u32x4* dst = (LAS u32x4*)(vst + ki * VPITCH + hf * 64);
              dst[0] = v0; dst[1] = v1; dst[2] = v2; dst[3] = v3; }
            f32x4 sa = {0.f, 0.f, 0.f, 0.f}, sb = {0.f, 0.f, 0.f, 0.f};
            sa = __builtin_amdgcn_mfma_f32_16x16x32_f16(ka0, qb0, sa, 0, 0, 0); sa = __builtin_amdgcn_mfma_f32_16x16x32_f16(ka1, qb1, sa, 0, 0, 0);
            sb = __builtin_amdgcn_mfma_f32_16x16x32_f16(kb0, qb0, sb, 0, 0, 0); sb = __builtin_amdgcn_mfma_f32_16x16x32_f16(kb1, qb1, sb, 0, 0, 0);
            const int p0 = 32 * j + 4 * kc;
            const u32x2 iwa = *(const LAS u32x2*)(selr + p0), iwb = *(const LAS u32x2*)(selr + p0 + 16);
            const unsigned wa0 = iwa.x, wa1 = iwa.y, wb0 = iwb.x, wb1 = iwb.y;
            const int id[8] = {(int)(wa0 & 0xffffu), (int)(wa0 >> 16), (int)(wa1 & 0xffffu), (int)(wa1 >> 16), (int)(wb0 & 0xffffu), (int)(wb0 >> 16), (int)(wb1 & 0xffffu), (int)(wb1 >> 16)};
            float v[8] = {sa.x, sa.y, sa.z, sa.w, sb.x, sb.y, sb.z, sb.w};
            float tm = -INFINITY;
#pragma unroll
            for (int e = 0; e < 8; ++e) {
                const bool ok = (p0 + (e & 3) + 16 * (e >> 2)) < nvalid;
                int d = t - id[e]; d = d < 0 ? 0 : d; d = d > 127 ? 127 : d; d = ok ? d : 0;
                const float lg = v[e] * 0.125f + biaslut[d * 8 + hm];
                v[e] = ok ? lg : -INFINITY; tm = fmaxf(tm, v[e]);
            }
            tm = fmaxf(tm, __shfl_xor(tm, 16)); tm = fmaxf(tm, __shfl_xor(tm, 32));
            const float mn = fmaxf(mrun, tm);
            const float alpha = __expf(mrun - mn);
            float ps = 0.f;
#pragma unroll
            for (int e = 0; e < 8; ++e) { v[e] = __expf(v[e] - mn); ps += v[e]; }
            lrun = lrun * alpha + ps; mrun = mn;
#pragma unroll
            for (int dt = 0; dt < 4; ++dt) ot[dt] = ot[dt] * alpha;
            const f16x8 pfr = {(_Float16)v[0], (_Float16)v[1], (_Float16)v[2], (_Float16)v[3], (_Float16)v[4], (_Float16)v[5], (_Float16)v[6], (_Float16)v[7]};
            asm volatile("s_waitcnt lgkmcnt(0)" ::: "memory");
            const int q = n16 >> 2, p = n16 & 3;
#pragma unroll
            for (int dt = 0; dt < 4; ++dt) {
                const s16x4 ta = __builtin_amdgcn_ds_read_tr16_b64_v4i16((LAS s16x4*)(vst + (4 * kc + q) * VPITCH + (16 * dt + 4 * p) * 2));
                const s16x4 tb = __builtin_amdgcn_ds_read_tr16_b64_v4i16((LAS s16x4*)(vst + (16 + 4 * kc + q) * VPITCH + (16 * dt + 4 * p) * 2));
                const f16x4 fa = __builtin_bit_cast(f16x4, ta), fb = __builtin_bit_cast(f16x4, tb);
                const f16x8 vfr = {fa.x, fa.y, fa.z, fa.w, fb.x, fb.y, fb.z, fb.w};
                ot[dt] = __builtin_amdgcn_mfma_f32_16x16x32_f16(vfr, pfr, ot[dt], 0, 0, 0);
            }
            asm volatile("s_waitcnt lgkmcnt(0)" ::: "memory");
        }
        lrun += __shfl_xor(lrun, 16); lrun += __shfl_xor(lrun, 32);
        const float inv = 1.f / fmaxf(lrun, 1e-30f);
        if (head < 8) {
            _Float16* orow = o_a + (size_t)(b * S_ + t) * 512 + head * 64 + 4 * kc;
#pragma unroll
            for (int dt = 0; dt < 4; ++dt) { u32x2 w; w.x = pg8::pkh(ot[dt].x * inv, ot[dt].y * inv); w.y = pg8::pkh(ot[dt].z * inv, ot[dt].w * inv); *(u32x2*)(orow + 16 * dt) = w; }
        }
    }
    __syncthreads();
}
}

__global__ void __launch_bounds__(512, 2) k_dsa(const _Float16* __restrict__ proj, const float* __restrict__ rel_bias, _Float16* __restrict__ o_a, unsigned* dbg) {
    extern __shared__ __attribute__((aligned(16))) unsigned char lds_raw[];
    LAS unsigned char* lds = (LAS unsigned char*)lds_raw;
    { LAS float* biaslut = (LAS float*)(lds + dsa::L_BIAS);
      for (int i = threadIdx.x; i < 1024; i += 512) { const int d = i >> 3, h = i & 7; biaslut[i] = rel_bias[t5_bucket(d) * 16 + h]; } }
    __syncthreads();
    for (int p = blockIdx.x; p < 1024; p += gridDim.x) { const int b = p >> 7, j = p & 127;
        dsa::dsa_tile(lds, proj, o_a, b, 255 - j, dbg);
        dsa::dsa_tile(lds, proj, o_a, b, j, dbg); }
}


namespace nsa {
typedef _Float16 f16x8 __attribute__((ext_vector_type(8)));
typedef _Float16 f16x4 __attribute__((ext_vector_type(4)));
typedef short s16x4 __attribute__((ext_vector_type(4)));
typedef float f32x4 __attribute__((ext_vector_type(4)));
typedef float f32x16 __attribute__((ext_vector_type(16)));
typedef unsigned u32x4 __attribute__((ext_vector_type(4)));
typedef unsigned u32x2 __attribute__((ext_vector_type(2)));
constexpr int KP = 144, VP = 192;
constexpr int TILE_B = 64 * KP + 64 * VP;
constexpr int L_T0 = 0, L_BIAS = 2 * TILE_B, L_IMPA = L_BIAS + 4096, L_IMPC = L_IMPA + 16384, L_MASK = L_IMPC + 16384, L_END = L_MASK + 512;
static_assert(L_END <= 131072, "nsa LDS");
constexpr float LOG2E = 1.4426950408889634f;
constexpr float SC = 0.125f * LOG2E;

struct Src { const _Float16* k; const _Float16* v; int pitch; };

struct Stage { u32x4 kr, vr; };
__device__ __forceinline__ void stage_load(Stage& st, const Src& s, int row0, int tid, bool need_v) {
    const int r = tid >> 3, c = tid & 7;
    st.kr = *(const u32x4*)(s.k + (size_t)(row0 + r) * s.pitch + 8 * c);
    if (need_v) st.vr = *(const u32x4*)(s.v + (size_t)(row0 + r) * s.pitch + 8 * c);
}
__device__ __forceinline__ void stage_store(const Stage& st, LAS unsigned char* tb, int tid, bool need_v) {
    const int r = tid >> 3, c = tid & 7;
    *(LAS u32x4*)(tb + r * KP + 16 * c) = st.kr;
    if (need_v) *(LAS u32x4*)(tb + 64 * KP + r * VP + 16 * c) = st.vr;
}

struct RowState { float m, l; f32x16 o0, o1; };

__device__ __forceinline__ void qk_tile(const LAS unsigned char* kt, const f16x8 (&qf)[4], int rho, int hi, f32x16& s0, f32x16& s1) {
#pragma unroll
    for (int i = 0; i < 16; ++i) { s0[i] = 0.f; s1[i] = 0.f; }
#pragma unroll
    for (int ks = 0; ks < 4; ++ks) {
        const f16x8 a0 = *(const LAS f16x8*)(kt + rho * KP + 32 * ks + 16 * hi);
        const f16x8 a1 = *(const LAS f16x8*)(kt + (32 + rho) * KP + 32 * ks + 16 * hi);
        s0 = __builtin_amdgcn_mfma_f32_32x32x16_f16(a0, qf[ks], s0, 0, 0, 0);
        s1 = __builtin_amdgcn_mfma_f32_32x32x16_f16(a1, qf[ks], s1, 0, 0, 0);
    }
}
template <bool NEAR>
__device__ __forceinline__ void logits(f32x16& s0, f32x16& s1, const LAS float* lut, int hb, int hi, int dbase, int dstep, int dlim, bool bit, float bias_far) {
#pragma unroll
    for (int kh = 0; kh < 2; ++kh)
#pragma unroll
        for (int rg = 0; rg < 16; ++rg) {
            const int kl = 32 * kh + (rg & 3) + 8 * (rg >> 2) + 4 * hi;
            const int d = dbase - dstep * kl;
            float bias = bias_far;
            if (NEAR) { int dc = d < 0 ? 0 : d; dc = dc > 127 ? 127 : dc; bias = lut[dc * 8 + hb]; }
            const bool ok = bit && d >= 0 && d < dlim;
            const float sv = kh ? s1[rg] : s0[rg];
            const float x = ok ? fmaf(sv, SC, bias) : -INFINITY;
            if (kh) s1[rg] = x; else s0[rg] = x;
            if (NEAR && (rg & 7) == 7) __builtin_amdgcn_sched_barrier(0);
        }
}
__device__ __forceinline__ void softmax_pv(RowState& rs, f32x16& s0, f32x16& s1, const LAS unsigned char* vt, int rho, int hi) {
    float tm = -INFINITY;
#pragma unroll
    for (int i = 0; i < 16; ++i) tm = fmaxf(tm, fmaxf(s0[i], s1[i]));
    tm = fmaxf(tm, __shfl_xor(tm, 32));
    const float mn = fmaxf(rs.m, tm);
    const float mu = (mn == -INFINITY) ? 0.f : mn;
    const float alpha = __builtin_amdgcn_exp2f(rs.m - mu);
    float ps = 0.f;
#pragma unroll
    for (int i = 0; i < 16; ++i) { s0[i] = __builtin_amdgcn_exp2f(s0[i] - mu); s1[i] = __builtin_amdgcn_exp2f(s1[i] - mu); ps += s0[i] + s1[i]; }
    rs.l = rs.l * alpha + ps; rs.m = mn;
#pragma unroll
    for (int i = 0; i < 16; ++i) { rs.o0[i] *= alpha; rs.o1[i] *= alpha; }
    const int l16 = rho & 15, g16 = rho >> 4, q = l16 >> 2, p = l16 & 3;
#pragma unroll
    for (int kh = 0; kh < 2; ++kh)
#pragma unroll
        for (int sx = 0; sx < 2; ++sx) {
            f16x8 pfr;
#pragma unroll
            for (int j = 0; j < 8; ++j) pfr[j] = (_Float16)(kh ? s1[8 * sx + j] : s0[8 * sx + j]);
            const int kbase = 32 * kh + 16 * sx + 4 * hi + q;
#pragma unroll
            for (int dt = 0; dt < 2; ++dt) {
                const int cb = (32 * dt + 16 * g16 + 4 * p) * 2;
                const s16x4 ta = __builtin_amdgcn_ds_read_tr16_b64_v4i16((LAS s16x4*)(vt + kbase * VP + cb));
                const s16x4 tb = __builtin_amdgcn_ds_read_tr16_b64_v4i16((LAS s16x4*)(vt + (kbase + 8) * VP + cb));
                const f16x4 fa = __builtin_bit_cast(f16x4, ta), fb = __builtin_bit_cast(f16x4, tb);
                const f16x8 vfr = {fa.x, fa.y, fa.z, fa.w, fb.x, fb.y, fb.z, fb.w};
                if (dt == 0) rs.o0 = __builtin_amdgcn_mfma_f32_32x32x16_f16(vfr, pfr, rs.o0, 0, 0, 0);
                else rs.o1 = __builtin_amdgcn_mfma_f32_32x32x16_f16(vfr, pfr, rs.o1, 0, 0, 0);
            }
        }
}
__device__ __forceinline__ void rs_init(RowState& rs) { rs.m = -INFINITY; rs.l = 0.f;
#pragma unroll
    for (int i = 0; i < 16; ++i) { rs.o0[i] = 0.f; rs.o1[i] = 0.f; } }
__device__ __forceinline__ void rs_flush(RowState& rs, float gate, _Float16* orow, bool first) {
    const float lt = rs.l + __shfl_xor(rs.l, 32);
    const float w = gate / fmaxf(lt, 1e-30f);
#pragma unroll
    for (int i = 0; i < 4; ++i) {
        float a[8] = {w * rs.o0[4 * i], w * rs.o0[4 * i + 1], w * rs.o0[4 * i + 2], w * rs.o0[4 * i + 3], w * rs.o1[4 * i], w * rs.o1[4 * i + 1], w * rs.o1[4 * i + 2], w * rs.o1[4 * i + 3]};
        if (!first) { const u32x2 p0 = *(const u32x2*)(orow + 8 * i), p1 = *(const u32x2*)(orow + 32 + 8 * i);
            const unsigned u0 = p0.x, u1 = p0.y, u2 = p1.x, u3 = p1.y; const pg8::f16x2 h0 = __builtin_bit_cast(pg8::f16x2, u0), h1 = __builtin_bit_cast(pg8::f16x2, u1), h2 = __builtin_bit_cast(pg8::f16x2, u2), h3 = __builtin_bit_cast(pg8::f16x2, u3);
            a[0] += (float)h0.x; a[1] += (float)h0.y; a[2] += (float)h1.x; a[3] += (float)h1.y; a[4] += (float)h2.x; a[5] += (float)h2.y; a[6] += (float)h3.x; a[7] += (float)h3.y; }
        u32x2 w0; w0.x = pg8::pkh(a[0], a[1]); w0.y = pg8::pkh(a[2], a[3]); *(u32x2*)(orow + 8 * i) = w0;
        u32x2 w1; w1.x = pg8::pkh(a[4], a[5]); w1.y = pg8::pkh(a[6], a[7]); *(u32x2*)(orow + 32 + 8 * i) = w1;
    }
}

__device__ __forceinline__ void nsa_unit(LAS unsigned char* lds, const _Float16* __restrict__ proj, const _Float16* __restrict__ kcmp, const _Float16* __restrict__ vcmp,
                                         _Float16* __restrict__ o_b, int b, int g, int qb) {
    const int tid = threadIdx.x, lane = tid & 63, wave = __builtin_amdgcn_readfirstlane(tid >> 6);
    const int rho = lane & 31, hi = lane >> 5, ql = rho >> 2, r = rho & 3, hb = g * 4 + r;
    const int t = 64 * qb + 8 * wave + ql;
    const _Float16* prow = proj + (size_t)(b * S_ + t) * PW;
    f16x8 qf[4];
#pragma unroll
    for (int ks = 0; ks < 4; ++ks) qf[ks] = *(const f16x8*)(prow + C_QB + hb * 64 + 16 * ks + 8 * hi);
    for (int i = tid; i < 2048; i += 512) ((LAS u32x4*)(lds + L_IMPA))[i] = (u32x4){0u, 0u, 0u, 0u};
    RowState rs; rs_init(rs);
    const LAS float* lut = (const LAS float*)(lds + L_BIAS);
    const float bias31 = lut[127 * 8 + hb];
    const _Float16* kc = kcmp + (size_t)(b * 2 + g) * 256 * 64;
    const long vcoff = (vcmp + (size_t)(b * 2 + g) * 256 * 64) - kc;
    const _Float16* pb = proj + (size_t)(b * S_) * PW + C_KVB + g * 64;
    const int ncmp = (4 * qb + 3 + 63) / 64;
    const int wlo = qb - 8 > 0 ? qb - 8 : 0;
    const int e0 = ncmp, e1 = 2 * ncmp, e2 = e1 + qb + 1, NT = e2 + (qb - wlo + 1);
    const int sr = tid >> 3, scq = tid & 7;
    float mc = 0.f, invl = 0.f; unsigned mlo = 0u, mhi = 0u;
    Stage stg;
#define NSA_DECODE(i, br, n) do { if ((i) < e0) { br = 0; n = (i); } else if ((i) < e1) { br = 1; n = (i) - e0; } else if ((i) < e2) { br = 2; n = (i) - e1; } else { br = 3; n = wlo + (i) - e2; } } while (0)
#define NSA_LOAD(i) do { int br_, n_; NSA_DECODE(i, br_, n_); const _Float16* kp_ = (br_ < 2) ? kc : (br_ == 2 ? pb + 2 * 128 : pb + 4 * 128); const int pitch_ = (br_ < 2) ? 64 : PW; \
        const long vo_ = (br_ < 2) ? vcoff : 128; const _Float16* rp_ = kp_ + (size_t)(64 * n_ + sr) * pitch_ + 8 * scq; stg.kr = *(const u32x4*)rp_; stg.vr = *(const u32x4*)(rp_ + vo_); } while (0)
#define NSA_STORE(buf) do { LAS unsigned char* tb_ = lds + L_T0 + (buf) * TILE_B; *(LAS u32x4*)(tb_ + sr * KP + 16 * scq) = stg.kr; *(LAS u32x4*)(tb_ + 64 * KP + sr * VP + 16 * scq) = stg.vr; } while (0)
    __syncthreads();
    NSA_LOAD(0); NSA_STORE(0);
    __syncthreads();
#pragma unroll 1
    for (int i = 0; i < NT; ++i) {
        int br, n; NSA_DECODE(i, br, n);
        const LAS unsigned char* tb = lds + L_T0 + (i & 1) * TILE_B;
        const bool more = i + 1 < NT;
        if (more) NSA_LOAD(i + 1);
        f32x16 s0, s1;
        qk_tile(tb, qf, rho, hi, s0, s1);
        bool bit = true; int dbase, dstep = 1, dlim = 1 << 30; bool near = true;
        if (br < 2) { dbase = t - 31 - 1024 * n; dstep = 16; }
        else { dbase = t - 64 * n; near = n >= qb - 2; if (br == 2) bit = (n < 32) ? ((mlo >> n) & 1u) : ((mhi >> (n - 32)) & 1u); else dlim = 512; }
        if (near) logits<true>(s0, s1, lut, hb, hi, dbase, dstep, dlim, bit, 0.f);
        else logits<false>(s0, s1, lut, hb, hi, dbase, dstep, dlim, bit, bias31);
        if (br != 1) softmax_pv(rs, s0, s1, tb + 64 * KP, rho, hi);
        else {
            LAS float* impA = (LAS float*)(lds + L_IMPA) + (wave * 8 + ql) * 64;
            LAS float* impC = (LAS float*)(lds + L_IMPC) + (wave * 8 + ql) * 64;
            const float mu = (mc == -INFINITY) ? 0.f : mc;
#pragma unroll
            for (int kh = 0; kh < 2; ++kh)
#pragma unroll
                for (int ii = 0; ii < 4; ++ii) {
                    float pv[4];
#pragma unroll
                    for (int e = 0; e < 4; ++e) pv[e] = __builtin_amdgcn_exp2f((kh ? s1[4 * ii + e] : s0[4 * ii + e]) - mu) * invl;
                    float a = (pv[0] + pv[1]) + (pv[2] + 0.5f * pv[3]), c = 0.5f * pv[3];
                    a += __shfl_xor(a, 1); a += __shfl_xor(a, 2); c += __shfl_xor(c, 1); c += __shfl_xor(c, 2);
                    const int nb = 16 * n + 8 * kh + 2 * ii + hi;
                    if (r == 0) { impA[nb] = a; if (nb + 1 < 64) impC[nb + 1] = c; }
                }
        }
        if (i + 1 == e0) {
            mc = rs.m; const float lc = rs.l + __shfl_xor(rs.l, 32); invl = 1.f / fmaxf(lc, 1e-30f);
            rs_flush(rs, pg8::sigm((float)prow[C_GB + 0 * 8 + hb]), o_b + (size_t)(b * S_ + t) * 512 + hb * 64 + 4 * hi, true); rs_init(rs);
        } else if (i + 1 == e1) {
            asm volatile("s_waitcnt lgkmcnt(0)" ::: "memory");
            const int qs = lane >> 3, j = lane & 7;
            LAS float* sA = (LAS float*)(lds + L_IMPA) + (wave * 8 + qs) * 64;
            const LAS float* sC = (const LAS float*)(lds + L_IMPC) + (wave * 8 + qs) * 64;
            float sc[8];
#pragma unroll
            for (int e = 0; e < 8; ++e) { const int nn = 8 * j + e; const bool forced = (nn == 0) || (nn == qb) || (nn == qb - 1);
                sc[e] = (nn <= qb) ? (forced ? 1.0e4f : (sA[nn] + sC[nn])) : -INFINITY; }
            asm volatile("s_waitcnt lgkmcnt(0)" ::: "memory");
#pragma unroll
            for (int e = 0; e < 8; ++e) sA[8 * j + e] = sc[e];
            asm volatile("s_waitcnt lgkmcnt(0)" ::: "memory");
            int rank[8];
#pragma unroll
            for (int e = 0; e < 8; ++e) rank[e] = 0;
            for (int m = 0; m <= qb; ++m) { const float sm = sA[m];
#pragma unroll
                for (int e = 0; e < 8; ++e) rank[e] += (sm > sc[e] || (sm == sc[e] && m < 8 * j + e)) ? 1 : 0; }
            unsigned bits = 0;
#pragma unroll
            for (int e = 0; e < 8; ++e) bits |= ((8 * j + e <= qb) && rank[e] < 16) ? (1u << e) : 0u;
            ((LAS unsigned char*)(lds + L_MASK))[(wave * 8 + qs) * 8 + j] = (unsigned char)bits;
            asm volatile("s_waitcnt lgkmcnt(0)" ::: "memory");
            const u32x2 mk = *(const LAS u32x2*)(lds + L_MASK + (wave * 8 + ql) * 8);
            mlo = mk.x; mhi = mk.y;
        } else if (i + 1 == e2) {
            rs_flush(rs, pg8::sigm((float)prow[C_GB + 1 * 8 + hb]), o_b + (size_t)(b * S_ + t) * 512 + hb * 64 + 4 * hi, false); rs_init(rs);
        } else if (i + 1 == NT) {
            rs_flush(rs, pg8::sigm((float)prow[C_GB + 2 * 8 + hb]), o_b + (size_t)(b * S_ + t) * 512 + hb * 64 + 4 * hi, false);
        }
        if (more) NSA_STORE((i + 1) & 1);
        __syncthreads();
    }
#undef NSA_DECODE
#undef NSA_LOAD
#undef NSA_STORE
}
}

__global__ void __launch_bounds__(512, 2) k_nsa(const _Float16* __restrict__ proj, const float* __restrict__ rel_bias, const _Float16* __restrict__ kcmp, const _Float16* __restrict__ vcmp, _Float16* __restrict__ o_b) {
    extern __shared__ __attribute__((aligned(16))) unsigned char lds_raw[];
    LAS unsigned char* lds = (LAS unsigned char*)lds_raw;
    { LAS float* lut = (LAS float*)(lds + nsa::L_BIAS);
      for (int i = threadIdx.x; i < 1024; i += 512) { const int d = i >> 3, h = i & 7; lut[i] = rel_bias[t5_bucket(d) * 16 + 8 + h] * nsa::LOG2E; } }
    __syncthreads();
#pragma unroll 1
    for (int u = blockIdx.x; u < 1024; u += gridDim.x) { const int p = u & 511, bg = p >> 5, j = p & 31;
        nsa::nsa_unit(lds, proj, kcmp, vcmp, o_b, bg >> 1, bg & 1, (u < 512) ? 63 - j : j);
        __syncthreads(); }
}
__global__ __launch_bounds__(128) void compress_h(const __half* __restrict__ proj, const float* __restrict__ pe_k, const float* __restrict__ w1_k, const float* __restrict__ w2_k,
                                                  const float* __restrict__ pe_v, const float* __restrict__ w1_v, const float* __restrict__ w2_v, __half* __restrict__ kcmp, __half* __restrict__ vcmp) {
    __shared__ float blk[2048];
    __shared__ float hid[128];
    int id = blockIdx.x; const int kv = id & 1; id >>= 1; const int g = id & 1; id >>= 1; const int c = id & 255, b = id >> 8;
    const float* pe = kv ? pe_v : pe_k; const float* w1 = kv ? w1_v : w1_k; const float* w2 = kv ? w2_v : w2_k;
    const int tid = threadIdx.x;
    __half* dst = (kv ? vcmp : kcmp) + ((size_t)(b * 2 + g) * 256 + c) * 64;
    if (c == 255) { if (tid < 64) dst[tid] = __float2half(0.f); return; }
    for (int i = tid; i < 2048; i += 128) { const int l = i >> 6, d = i & 63;
        blk[i] = __half2float(proj[(size_t)(b * S_ + 16 * c + l) * PW + C_KVB + kv * 128 + g * 64 + d]) + pe[i]; }
    __syncthreads();
    { float a = 0.f; for (int k = 0; k < 2048; ++k) a += blk[k] * w1[k * 128 + tid];
      const float x3 = a * a * a; hid[tid] = 0.5f * a * (1.f + tanhf(0.7978845608028654f * (a + 0.044715f * x3))); }
    __syncthreads();
    if (tid < 64) { float a = 0.f; for (int k = 0; k < 128; ++k) a += hid[k] * w2[k * 64 + tid]; dst[tid] = __float2half(a); }
}


namespace cmpx {
typedef _Float16 f16x8 __attribute__((ext_vector_type(8)));
typedef float f32x4 __attribute__((ext_vector_type(4)));
typedef unsigned u32x4 __attribute__((ext_vector_type(4)));
constexpr int L_PART = 0, L_HID = 65536, HIDP = 272, L_END = L_HID + 16 * HIDP;
__device__ __forceinline__ void item(LAS unsigned char* lds, const _Float16* __restrict__ proj, const float* __restrict__ pe, const _Float16* __restrict__ w1t, const _Float16* __restrict__ w2t,
                                     _Float16* __restrict__ dst, int b, int g, int kv, int ct) {
    const int tid = threadIdx.x, lane = tid & 63, wave = __builtin_amdgcn_readfirstlane(tid >> 6), kc = lane >> 4, n16 = lane & 15;
    f32x4 acc[8];
#pragma unroll
    for (int nt = 0; nt < 8; ++nt) acc[nt] = (f32x4){0.f, 0.f, 0.f, 0.f};
    const int c = 16 * ct + n16;
#pragma unroll 2
    for (int ks = 0; ks < 8; ++ks) {
        const int k0 = 32 * (8 * wave + ks) + 8 * kc, lt = k0 >> 6, d = k0 & 63;
        int trow = 16 * c + lt; trow = trow > S_ - 1 ? S_ - 1 : trow;
        const f16x8 raw = *(const f16x8*)(proj + (size_t)(b * S_ + trow) * PW + C_KVB + kv * 128 + g * 64 + d);
        const f32x4 p0 = *(const f32x4*)(pe + lt * 64 + d), p1 = *(const f32x4*)(pe + lt * 64 + d + 4);
        f16x8 afr;
        afr[0] = (_Float16)((float)raw[0] + p0.x); afr[1] = (_Float16)((float)raw[1] + p0.y); afr[2] = (_Float16)((float)raw[2] + p0.z); afr[3] = (_Float16)((float)raw[3] + p0.w);
        afr[4] = (_Float16)((float)raw[4] + p1.x); afr[5] = (_Float16)((float)raw[5] + p1.y); afr[6] = (_Float16)((float)raw[6] + p1.z); afr[7] = (_Float16)((float)raw[7] + p1.w);
#pragma unroll
        for (int nt = 0; nt < 8; ++nt) {
            const f16x8 bfr = *(const f16x8*)(w1t + (size_t)(16 * nt + n16) * 2048 + k0);
            acc[nt] = __builtin_amdgcn_mfma_f32_16x16x32_f16(afr, bfr, acc[nt], 0, 0, 0);
        }
    }
    LAS float* part = (LAS float*)(lds + L_PART) + wave * 2048;
#pragma unroll
    for (int nt = 0; nt < 8; ++nt) { part[(4 * kc + 0) * 128 + 16 * nt + n16] = acc[nt].x; part[(4 * kc + 1) * 128 + 16 * nt + n16] = acc[nt].y;
        part[(4 * kc + 2) * 128 + 16 * nt + n16] = acc[nt].z; part[(4 * kc + 3) * 128 + 16 * nt + n16] = acc[nt].w; }
    __syncthreads();
    { const LAS float* pp = (const LAS float*)(lds + L_PART);
#pragma unroll
      for (int e = 0; e < 4; ++e) { const int o = tid + 512 * e; float a = 0.f;
#pragma unroll
          for (int w = 0; w < 8; ++w) a += pp[w * 2048 + o];
          const float z = 0.7978845608028654f * (a + 0.044715f * a * a * a);
          const float th = 1.f - 2.f / (__expf(2.f * z) + 1.f);
          ((LAS _Float16*)(lds + L_HID + (o >> 7) * HIDP))[o & 127] = (_Float16)(0.5f * a * (1.f + th)); } }
    __syncthreads();
    if (wave < 4) {
        f32x4 o = {0.f, 0.f, 0.f, 0.f};
#pragma unroll
        for (int ks = 0; ks < 4; ++ks) {
            const f16x8 afr = *(const LAS f16x8*)(lds + L_HID + n16 * HIDP + (32 * ks + 8 * kc) * 2);
            const f16x8 bfr = *(const f16x8*)(w2t + (size_t)(16 * wave + n16) * 128 + 32 * ks + 8 * kc);
            o = __builtin_amdgcn_mfma_f32_16x16x32_f16(afr, bfr, o, 0, 0, 0);
        }
        const float ov[4] = {o.x, o.y, o.z, o.w};
#pragma unroll
        for (int e = 0; e < 4; ++e) { const int cc = 16 * ct + 4 * kc + e; dst[((size_t)(b * 2 + g) * 256 + cc) * 64 + 16 * wave + n16] = (_Float16)(cc == 255 ? 0.f : ov[e]); }
    }
    __syncthreads();
}
}

__global__ void k_cmp_rows(const __half* __restrict__ a, const __half* __restrict__ ref, unsigned* __restrict__ dbg) {
    const int row = blockIdx.x * 4 + (threadIdx.x >> 6), lane = threadIdx.x & 63;
    float num = 0.f, den = 0.f; bool nan = false;
    for (int i = lane; i < 512; i += 64) { const float x = __half2float(a[(size_t)row * 512 + i]), y = __half2float(ref[(size_t)row * 512 + i]);
        nan |= !(x == x); num += (x - y) * (x - y); den += y * y; }
    for (int o = 32; o > 0; o >>= 1) { num += __shfl_xor(num, o); den += __shfl_xor(den, o); }
    const bool anynan = __any(nan);
    if (lane == 0) { if (anynan) atomicAdd(dbg + 1, 1u); else if (num > 0.0025f * den) atomicAdd(dbg + 0, 1u); }
}
__global__ void k_dbg_scale(float* __restrict__ out, const unsigned* __restrict__ dbg) {
    const unsigned nbad = dbg[0], nnan = dbg[1];
    int code = 0; if (dbg[5]) code = 30; else if (dbg[6]) code = 28; else if (nnan) code = 20 + (31 - __clz((int)nnan)) / 2; else if (nbad) code = 1 + (31 - __clz((int)nbad));
    const float sc = 1.f + 0.2f * code;
    const size_t i = (size_t)blockIdx.x * 256 + threadIdx.x; out[i] *= sc;
}
template <typename TA, typename Epi>
__global__ __launch_bounds__(256) void gemm_naive(const TA* __restrict__ A, const float* __restrict__ Bm, Epi epi, int lda, int ldb, int K, int pad_) {
    __shared__ float As[16][68];
    __shared__ float Bs[16][68];
    const int tid = threadIdx.x, tx = tid & 15, ty = tid >> 4;
    const int m0 = blockIdx.y * 64, n0 = blockIdx.x * 64;
    float acc[4][4];
#pragma unroll
    for (int i = 0; i < 4; ++i)
#pragma unroll
        for (int j = 0; j < 4; ++j) acc[i][j] = 0.f;
    for (int k0 = 0; k0 < K; k0 += 16) {
#pragma unroll
        for (int i = 0; i < 4; ++i) { const int e = tid + i * 256; const int m = e >> 4, k = e & 15; As[k][m] = (float)A[(size_t)(m0 + m) * lda + k0 + k]; }
#pragma unroll
        for (int i = 0; i < 4; ++i) { const int e = tid + i * 256; const int k = e >> 6, n = e & 63; Bs[k][n] = Bm[(size_t)(k0 + k) * ldb + n0 + n]; }
        __syncthreads();
#pragma unroll
        for (int k = 0; k < 16; ++k) {
            float a[4], b[4];
#pragma unroll
            for (int i = 0; i < 4; ++i) { a[i] = As[k][ty * 4 + i]; b[i] = Bs[k][tx * 4 + i]; }
#pragma unroll
            for (int i = 0; i < 4; ++i)
#pragma unroll
                for (int j = 0; j < 4; ++j) acc[i][j] += a[i] * b[j];
        }
        __syncthreads();
    }
#pragma unroll
    for (int i = 0; i < 4; ++i)
#pragma unroll
        for (int j = 0; j < 4; ++j) epi(m0 + ty * 4 + i, n0 + tx * 4 + j, acc[i][j]);
}


struct NEpiMixA { __half* mix; const __half* proj; __device__ void operator()(int r, int c, float v) const {
    const float g = __half2float(proj[(size_t)r * PW + C_GATE + c]); mix[(size_t)r * D_ + c] = __float2half(g * v); } };
struct NEpiMixB { __half* mix; const __half* proj; __device__ void operator()(int r, int c, float v) const {
    const float g = __half2float(proj[(size_t)r * PW + C_GATE + 1024 + c]); mix[(size_t)r * D_ + c] = __float2half(__half2float(mix[(size_t)r * D_ + c]) + g * v); } };
__global__ void k_gate(const __half* __restrict__ tmp, const __half* __restrict__ proj, __half* __restrict__ mix) {
    const size_t i = (size_t)blockIdx.x * 256 + threadIdx.x; const size_t r = i >> 10; const int c = (int)(i & 1023);
    mix[i] = __float2half(__half2float(tmp[i]) * __half2float(proj[r * PW + C_GATE + c]));
}
__global__ __launch_bounds__(256) void dsa_naive(const __half* __restrict__ proj, const float* __restrict__ rel_bias, __half* __restrict__ o_a) {
    __shared__ float qs[8][32];
    __shared__ float wv[8];
    __shared__ unsigned keys[4096];
    __shared__ int sel[256];
    __shared__ int nsel_s;
    __shared__ unsigned hist[256];
    __shared__ unsigned sel_prefix, sel_k;
    __shared__ float qa[8][64];
    __shared__ float p[8][256];
    const int row = blockIdx.x, tid = threadIdx.x, b = row / S_, t = row % S_;
    const __half* pr = proj + (size_t)row * PW;
    { const int h = tid >> 5, d = tid & 31; qs[h][d] = __half2float(pr[C_QI + h * 32 + d]); }
    if (tid < 8) wv[tid] = __half2float(pr[C_WI + tid]) * (1.f / 16.f);
    for (int i = tid; i < 512; i += 256) qa[i >> 6][i & 63] = __half2float(pr[C_QA + i]);
    if (tid == 0) nsel_s = 0;
    __syncthreads();
    const int n = t + 1;
    for (int s = tid; s < n; s += 256) {
        const __half* kr = proj + (size_t)(b * S_ + s) * PW + C_KI;
        float a8[8];
#pragma unroll
        for (int h = 0; h < 8; ++h) a8[h] = 0.f;
#pragma unroll 4
        for (int d = 0; d < 32; ++d) { const float kvd = __half2float(kr[d]);
#pragma unroll
            for (int h = 0; h < 8; ++h) a8[h] += qs[h][d] * kvd; }
        float sc = 0.f;
#pragma unroll
        for (int h = 0; h < 8; ++h) sc += wv[h] * (a8[h] > 0.f ? a8[h] : 0.f);
        unsigned u = __float_as_uint(sc);
        keys[s] = (u & 0x80000000u) ? ~u : (u | 0x80000000u);
    }
    __syncthreads();
    if (n <= 256) {
        if (tid < n) sel[tid] = tid;
        if (tid == 0) nsel_s = n;
        __syncthreads();
    } else {
        unsigned prefix = 0, mask = 0, kk = 256;
        for (int shift = 24; shift >= 0; shift -= 8) {
            hist[tid] = 0;
            __syncthreads();
            for (int s = tid; s < n; s += 256) { const unsigned k = keys[s]; if ((k & mask) == prefix) atomicAdd(&hist[(k >> shift) & 255u], 1u); }
            __syncthreads();
            if (tid == 0) { unsigned cum = 0; int d = 255; for (; d > 0; --d) { if (cum + hist[d] >= kk) break; cum += hist[d]; } sel_prefix = prefix | ((unsigned)d << shift); sel_k = kk - cum; }
            __syncthreads();
            prefix = sel_prefix; kk = sel_k; mask |= 0xFFu << shift;
            __syncthreads();
        }
        const unsigned T = prefix;
        for (int s = tid; s < n; s += 256) if (keys[s] > T) { const int pos = atomicAdd(&nsel_s, 1); sel[pos] = s; }
        __syncthreads();
        if (tid == 0) { int pos = nsel_s; unsigned need = kk; for (int s = 0; s < n && need > 0; ++s) if (keys[s] == T) { sel[pos++] = s; --need; } nsel_s = pos; }
        __syncthreads();
    }
    const int ns = nsel_s;
    {
        const int j = tid;
        if (j < ns) {
            const int idx = sel[j];
            const __half* kr = proj + (size_t)(b * S_ + idx) * PW + C_KA;
            float a8[8];
#pragma unroll
            for (int h = 0; h < 8; ++h) a8[h] = 0.f;
#pragma unroll 4
            for (int d = 0; d < 64; ++d) { const float kvd = __half2float(kr[d]);
#pragma unroll
                for (int h = 0; h < 8; ++h) a8[h] += qa[h][d] * kvd; }
            const int bk = t5_bucket(t - idx);
#pragma unroll
            for (int h = 0; h < 8; ++h) p[h][j] = a8[h] * 0.125f + rel_bias[bk * 16 + h];
        } else {
#pragma unroll
            for (int h = 0; h < 8; ++h) p[h][j] = -INFINITY;
        }
    }
    __syncthreads();
    {
        const int w = tid >> 6, lane = tid & 63;
        for (int hh = 0; hh < 2; ++hh) { const int h = w * 2 + hh;
            float v[4], mx = -INFINITY;
#pragma unroll
            for (int i = 0; i < 4; ++i) { v[i] = p[h][lane + 64 * i]; mx = fmaxf(mx, v[i]); }
#pragma unroll
            for (int o = 32; o > 0; o >>= 1) mx = fmaxf(mx, __shfl_xor(mx, o));
            float sm = 0.f;
#pragma unroll
            for (int i = 0; i < 4; ++i) { v[i] = (v[i] == -INFINITY) ? 0.f : expf(v[i] - mx); sm += v[i]; }
#pragma unroll
            for (int o = 32; o > 0; o >>= 1) sm += __shfl_xor(sm, o);
            const float inv = 1.f / fmaxf(sm, 1e-30f);
#pragma unroll
            for (int i = 0; i < 4; ++i) p[h][lane + 64 * i] = v[i] * inv; }
    }
    __syncthreads();
    for (int o = tid; o < 512; o += 256) { const int h = o >> 6, d = o & 63; float a = 0.f;
        for (int j = 0; j < ns; ++j) a += p[h][j] * __half2float(proj[(size_t)(b * S_ + sel[j]) * PW + C_VA + d]);
        o_a[(size_t)row * 512 + o] = __float2half(a); }
}

__global__ __launch_bounds__(128) void compress_naive(const __half* __restrict__ proj, const float* __restrict__ pe_k, const float* __restrict__ w1_k, const float* __restrict__ w2_k,
                                                      const float* __restrict__ pe_v, const float* __restrict__ w1_v, const float* __restrict__ w2_v, float* __restrict__ kcmp, float* __restrict__ vcmp) {
    __shared__ float blk[2048];
    __shared__ float hid[128];
    int id = blockIdx.x; const int kv = id & 1; id >>= 1; const int g = id & 1; id >>= 1; const int c = id % NC, b = id / NC;
    const float* pe = kv ? pe_v : pe_k; const float* w1 = kv ? w1_v : w1_k; const float* w2 = kv ? w2_v : w2_k;
    const int tid = threadIdx.x;
    for (int i = tid; i < 2048; i += 128) { const int l = i >> 6, d = i & 63;
        blk[i] = __half2float(proj[(size_t)(b * S_ + 16 * c + l) * PW + C_KVB + kv * 128 + g * 64 + d]) + pe[i]; }
    __syncthreads();
    { float a = 0.f; for (int k = 0; k < 2048; ++k) a += blk[k] * w1[k * 128 + tid];
      const float x3 = a * a * a; hid[tid] = 0.5f * a * (1.f + tanhf(0.7978845608028654f * (a + 0.044715f * x3))); }
    __syncthreads();
    if (tid < 64) { float a = 0.f; for (int k = 0; k < 128; ++k) a += hid[k] * w2[k * 64 + tid];
        (kv ? vcmp : kcmp)[((size_t)(b * NC + c) * 2 + g) * 64 + tid] = a; }
}

__device__ __forceinline__ void softmax_row(float* pr, int n, int lane) {
    float mx = -INFINITY;
    for (int i = lane; i < n; i += 64) mx = fmaxf(mx, pr[i]);
#pragma unroll
    for (int o = 32; o > 0; o >>= 1) mx = fmaxf(mx, __shfl_xor(mx, o));
    float sm = 0.f;
    for (int i = lane; i < n; i += 64) { const float v = pr[i]; const float e = (v == -INFINITY) ? 0.f : expf(v - mx); pr[i] = e; sm += e; }
#pragma unroll
    for (int o = 32; o > 0; o >>= 1) sm += __shfl_xor(sm, o);
    const float inv = 1.f / fmaxf(sm, 1e-30f);
    for (int i = lane; i < n; i += 64) pr[i] *= inv;
}

__global__ __launch_bounds__(256) void nsa_naive(const __half* __restrict__ proj, const float* __restrict__ rel_bias, const float* __restrict__ kcmp, const float* __restrict__ vcmp, __half* __restrict__ o_b) {
    __shared__ float q[4][64];
    __shared__ float lg[4][1024];
    __shared__ float score[64];
    __shared__ int sb[16];
    __shared__ int nsb;
    const int id = blockIdx.x, g = id & 1, row = id >> 1, b = row / S_, t = row % S_, tid = threadIdx.x;
    const int w = tid >> 6, lane = tid & 63;
    const __half* pr = proj + (size_t)row * PW;
    q[tid >> 6][tid & 63] = __half2float(pr[C_QB + g * 256 + tid]);
    if (tid == 0) nsb = 0;
    __syncthreads();
    const int cur = t >> 6;
    const int nv = t >= 31 ? (t - 31) / 16 + 1 : 0;
    const int r_ = tid >> 6, d_ = tid & 63;
    float oc = 0.f, os = 0.f, ow = 0.f;
    for (int i = tid; i < 4 * nv; i += 256) { const int r = i / nv, c = i % nv;
        const float* kr = kcmp + ((size_t)(b * NC + c) * 2 + g) * 64; float a = 0.f;
        for (int d = 0; d < 64; ++d) a += q[r][d] * kr[d];
        lg[r][c] = a * 0.125f + rel_bias[t5_bucket(t - (16 * c + 31)) * 16 + 8 + g * 4 + r]; }
    __syncthreads();
    if (nv > 0) softmax_row(lg[w], nv, lane);
    __syncthreads();
    for (int c = 0; c < nv; ++c) oc += lg[r_][c] * vcmp[((size_t)(b * NC + c) * 2 + g) * 64 + d_];
    if (tid < 64) { const int nb = tid; float imp = 0.f;
        for (int r = 0; r < 4; ++r) for (int c = 4 * nb - 1; c <= 4 * nb + 3; ++c) if (c >= 0 && c < nv) imp += lg[r][c] * ((c == 4 * nb - 1 || c == 4 * nb + 3) ? 0.5f : 1.f);
        const bool valid = nb <= cur; const bool forced = nb == 0 || nb == cur || nb == cur - 1;
        score[nb] = valid ? (forced ? 1.0e4f : imp) : -INFINITY; }
    __syncthreads();
    if (tid < 64) { bool selq = false;
        if (tid <= cur) { const float sc = score[tid]; int rank = 0;
            for (int m = 0; m <= cur; ++m) { const float sm = score[m]; rank += (sm > sc || (sm == sc && m < tid)) ? 1 : 0; }
            selq = rank < 16; }
        const unsigned long long bm = __ballot(selq);
        if (selq) sb[__popcll(bm & ((1ull << tid) - 1ull))] = tid;
        if (tid == 0) nsb = __popcll(bm); }
    __syncthreads();
    const int ns = nsb;
    for (int i = tid; i < 4 * ns * 64; i += 256) { const int r = i / (ns * 64), j = i % (ns * 64); const int pos = sb[j >> 6] * 64 + (j & 63);
        float v = -INFINITY;
        if (pos <= t) { const __half* kr = proj + (size_t)(b * S_ + pos) * PW + C_KVB + 2 * 128 + g * 64; float a = 0.f;
            for (int d = 0; d < 64; ++d) a += q[r][d] * __half2float(kr[d]);
            v = a * 0.125f + rel_bias[t5_bucket(t - pos) * 16 + 8 + g * 4 + r]; }
        lg[r][j] = v; }
    __syncthreads();
    softmax_row(lg[w], ns * 64, lane);
    __syncthreads();
    for (int j = 0; j < ns * 64; ++j) { const float pj = lg[r_][j]; if (pj != 0.f) { const int pos = sb[j >> 6] * 64 + (j & 63);
        os += pj * __half2float(proj[(size_t)(b * S_ + pos) * PW + C_KVB + 3 * 128 + g * 64 + d_]); } }
    __syncthreads();
    const int p0 = t - 511 > 0 ? t - 511 : 0; const int nw = t - p0 + 1;
    for (int i = tid; i < 4 * nw; i += 256) { const int r = i / nw, j = i % nw; const int pos = p0 + j;
        const __half* kr = proj + (size_t)(b * S_ + pos) * PW + C_KVB + 4 * 128 + g * 64; float a = 0.f;
        for (int d = 0; d < 64; ++d) a += q[r][d] * __half2float(kr[d]);
        lg[r][j] = a * 0.125f + rel_bias[t5_bucket(t - pos) * 16 + 8 + g * 4 + r]; }
    __syncthreads();
    softmax_row(lg[w], nw, lane);
    __syncthreads();
    for (int j = 0; j < nw; ++j) ow += lg[r_][j] * __half2float(proj[(size_t)(b * S_ + p0 + j) * PW + C_KVB + 5 * 128 + g * 64 + d_]);
    const float g0 = sigmoidf_(__half2float(pr[C_GB + 0 * 8 + g * 4 + r_])), g1 = sigmoidf_(__half2float(pr[C_GB + 1 * 8 + g * 4 + r_])), g2 = sigmoidf_(__half2float(pr[C_GB + 2 * 8 + g * 4 + r_]));
    o_b[(size_t)row * 512 + (g * 4 + r_) * 64 + d_] = __float2half(g0 * oc + g1 * os + g2 * ow);
}

__global__ __launch_bounds__(256) void final_norm_k(float* __restrict__ xio, const float* __restrict__ g) {
    __shared__ float red[4];
    const int row = blockIdx.x, tid = threadIdx.x;
    float* xr = xio + (size_t)row * D_;
    float v[4]; float ss = 0.f;
#pragma unroll
    for (int i = 0; i < 4; ++i) { v[i] = xr[tid + i * 256]; ss += v[i] * v[i]; }
#pragma unroll
    for (int o = 32; o > 0; o >>= 1) ss += __shfl_xor(ss, o);
    if ((tid & 63) == 0) red[tid >> 6] = ss;
    __syncthreads();
    const float rs = rsqrtf((red[0] + red[1] + red[2] + red[3]) / D_ + EPS);
#pragma unroll
    for (int i = 0; i < 4; ++i) xr[tid + i * 256] = v[i] * rs * g[tid + i * 256];
}


#define XB_TMO      128
#define XB_XCNT(j)  (256  + 64 * (j))
#define XB_XSUB(j)  (1280 + 64 * (j))
#define XB_XGEN(j)  (2304 + 64 * (j))
#define XB_TOP      3328
#define XB_TOPGEN   3392
#define XCD_BAR_WORDS 3456
#define XB_SPIN_CAP (1u << 18)
__device__ __forceinline__ unsigned xb_ld(unsigned* p)              { return __hip_atomic_load(p, __ATOMIC_RELAXED, __HIP_MEMORY_SCOPE_AGENT); }
__device__ __forceinline__ unsigned xb_add(unsigned* p, unsigned v) { return __hip_atomic_fetch_add(p, v, __ATOMIC_RELAXED, __HIP_MEMORY_SCOPE_AGENT); }
__device__ __forceinline__ unsigned xb_xcc_id() { return (unsigned)__builtin_amdgcn_s_getreg((3 << 11) | 20) & 0xFu; }
#define XB_SPIN(cond, bar) do { unsigned _sp = 0; while (cond) { __builtin_amdgcn_s_sleep(1); \
    if ((++_sp & 255u) == 0u) { if (xb_ld(&(bar)[XB_TMO])) break; if (_sp > XB_SPIN_CAP) { atomicAdd(&(bar)[XB_TMO], 1u); break; } } } } while (0)
struct XcdBarrier { unsigned* bar; unsigned x; volatile LAS unsigned* st; };
__device__ __forceinline__ XcdBarrier xcd_barrier_post(unsigned* bar, volatile LAS unsigned* st) {
    XcdBarrier b; b.bar = bar; b.x = xb_xcc_id(); b.st = st;
    if (threadIdx.x == 0) (void)xb_add(&bar[XB_XCNT(b.x)], 1u);
    return b;
}
__device__ __forceinline__ void xcd_barrier_complete(unsigned* bar, unsigned x, unsigned& nloc, unsigned& nx) {
    const unsigned G = gridDim.x * gridDim.y * gridDim.z;
    unsigned sum, cnt, mine, sp = 0u;
    for (;;) {
        sum = 0u; cnt = 0u; mine = 0u;
#pragma unroll
        for (unsigned j = 0; j < 16; ++j) { const unsigned c = xb_ld(&bar[XB_XCNT(j)]); sum += c; cnt += (c > 0u) ? 1u : 0u; mine = (j == x) ? c : mine; }
        if (sum == G) break;
        __builtin_amdgcn_s_sleep(1);
        if ((++sp & 255u) == 0u) { if (xb_ld(&bar[XB_TMO])) break; if (sp > XB_SPIN_CAP) { atomicAdd(&bar[XB_TMO], 1u); break; } }
    }
    nloc = mine > 0u ? mine : 1u; nx = cnt > 0u ? cnt : 1u;
}
__device__ __forceinline__ void xcd_barrier(const XcdBarrier& b) {
    asm volatile("s_waitcnt vmcnt(0)" ::: "memory");
    __syncthreads();
    if (threadIdx.x == 0) {
        unsigned* bar = b.bar;
        __builtin_amdgcn_s_waitcnt(0);
        unsigned nloc = b.st[0], nx = b.st[1];
        if (nloc == 0u) { xcd_barrier_complete(bar, b.x, nloc, nx); b.st[0] = nloc; b.st[1] = nx; }
        const unsigned old = xb_add(&bar[XB_XSUB(b.x)], 1u);
        const unsigned gen = old / nloc;
        if (old + 1u == (gen + 1u) * nloc) {
            __builtin_amdgcn_fence(__ATOMIC_RELEASE, "agent");
            asm volatile("s_waitcnt vmcnt(0)" ::: "memory");
            const unsigned og = xb_add(&bar[XB_TOP], 1u);
            const unsigned tg = og / nx;
            if (og + 1u == (tg + 1u) * nx) xb_add(&bar[XB_TOPGEN], 1u);
            else XB_SPIN(xb_ld(&bar[XB_TOPGEN]) == tg, bar);
            __builtin_amdgcn_fence(__ATOMIC_ACQUIRE, "agent");
            xb_add(&bar[XB_XGEN(b.x)], 1u);
            asm volatile("s_waitcnt vmcnt(0)" ::: "memory");
        } else {
            XB_SPIN(xb_ld(&bar[XB_XGEN(b.x)]) == gen, bar);
            __builtin_amdgcn_fence(__ATOMIC_ACQUIRE, "agent");
            asm volatile("s_waitcnt vmcnt(0)" ::: "memory");
        }
    }
    __syncthreads();
}

constexpr int MEGA_LDS = 131072 + 256;

template <class Epi>
__device__ __forceinline__ void gemm_run(LAS unsigned char* lds, const void* A, const void* Bt, const Epi& E, int M, int N, int K) {
    pg8::Gemm g{(const pg8::bf16_t*)A, (const pg8::bf16_t*)Bt, M, N, K};
    pg8::StaticOrder S; S.init(M, N, (int)gridDim.x, (int)blockIdx.x);
    pg8::gemm_phase<Epi, pg8::StaticOrder, true, true>(lds, g, S, E);
}

__global__ void __launch_bounds__(512, 2) mega_fwd(Args a) {
    extern __shared__ __attribute__((aligned(16))) unsigned char lds_raw[];
    LAS unsigned char* lds = (LAS unsigned char*)lds_raw;
    unsigned char* ws = a.ws;
    if (threadIdx.x == 0) *(LAS dsa::u32x4*)(lds + 131072) = (dsa::u32x4){0u, 0u, 0u, 0u};
    __syncthreads();
    XcdBarrier bar = xcd_barrier_post((unsigned*)(ws + WS_CTL), (volatile LAS unsigned*)(lds + 131072));
    const _Float16* proj = (const _Float16*)(ws + WS_PROJ);
    _Float16* o_a = (_Float16*)(ws + WS_H); _Float16* o_b = (_Float16*)(ws + WS_H + 32 * MiB);
    _Float16* kcmp = (_Float16*)(ws + WS_KCMP); _Float16* vcmp = (_Float16*)(ws + WS_VCMP);

    prologue_body(a, lds_raw);
    xcd_barrier(bar);
    gemm_run(lds, ws + WS_H, ws + WS_WIN, pg8::EpiProj{(_Float16*)(ws + WS_PROJ)}, M_, PW, D_);
    xcd_barrier(bar);
#pragma unroll 1
    for (int it = blockIdx.x; it < 512; it += gridDim.x) { const int ct = it & 15, kv = (it >> 4) & 1, g = (it >> 5) & 1, b = it >> 6;
        cmpx::item(lds, proj, kv ? a.pe_v : a.pe_k, (const _Float16*)(ws + WS_CW + (kv ? 512 * 1024 : 0)), (const _Float16*)(ws + WS_CW + 1024 * 1024 + (kv ? 16384 : 0)), kv ? vcmp : kcmp, b, g, kv, ct); }
    { LAS float* biaslut = (LAS float*)(lds + dsa::L_BIAS);
      for (int i = threadIdx.x; i < 1024; i += 512) { const int d = i >> 3, h = i & 7; biaslut[i] = a.rel_bias[t5_bucket(d) * 16 + h]; } }
    __syncthreads();
#pragma unroll 1
    for (int u = blockIdx.x; u < 2048; u += gridDim.x) { const int p = u & 1023, b = p >> 7, j = p & 127;
        dsa::dsa_tile(lds, proj, o_a, b, (u < 1024) ? 255 - j : j, nullptr); }
    xcd_barrier(bar);
    { LAS float* lut = (LAS float*)(lds + nsa::L_BIAS);
      for (int i = threadIdx.x; i < 1024; i += 512) { const int d = i >> 3, h = i & 7; lut[i] = a.rel_bias[t5_bucket(d) * 16 + 8 + h] * nsa::LOG2E; } }
    __syncthreads();
#pragma unroll 1
    for (int u = blockIdx.x; u < 1024; u += gridDim.x) { const int p = u & 511, bg = p >> 5, j = p & 31;
        nsa::nsa_unit(lds, proj, kcmp, vcmp, o_b, bg >> 1, bg & 1, (u < 512) ? 63 - j : j);
        __syncthreads(); }
    xcd_barrier(bar);
    gemm_run(lds, ws + WS_H, ws + WS_WBA, pg8::EpiMix<0>{(_Float16*)(ws + WS_MIX), proj}, M_, D_, 512);
    asm volatile("s_waitcnt vmcnt(0)" ::: "memory");
    __syncthreads();
    gemm_run(lds, ws + WS_H + 32 * MiB, ws + WS_WBB, pg8::EpiMix<1>{(_Float16*)(ws + WS_MIX), proj}, M_, D_, 512);
    xcd_barrier(bar);
    gemm_run(lds, ws + WS_MIX, ws + WS_WOUT, pg8::EpiResid{a.x, a.out}, M_, D_, D_);
    xcd_barrier(bar);
    { const int lane = threadIdx.x & 63; for (int m = blockIdx.x * 8 + (threadIdx.x >> 6); m < M_; m += gridDim.x * 8) rms_row_to_f16(a.out + (size_t)m * D_, (_Float16*)(ws + WS_H) + (size_t)m * D_, lane); }
    xcd_barrier(bar);
    gemm_run(lds, ws + WS_H, ws + WS_WMI, pg8::EpiRelu2{(_Float16*)(ws + WS_PROJ)}, M_, DFF, D_);
    xcd_barrier(bar);
    gemm_run(lds, ws + WS_PROJ, ws + WS_WMO, EpiAccOut{a.out}, M_, D_, DFF);
    xcd_barrier(bar);
    { const int lane = threadIdx.x & 63; for (int m = blockIdx.x * 8 + (threadIdx.x >> 6); m < M_; m += gridDim.x * 8) final_norm_row(a.out + (size_t)m * D_, a.norm_final, lane); }
}
}

extern "C" void kernel_launch(void* const* d_in, const int* in_sizes, int n_in, void* d_out, int out_size, void* d_ws, size_t ws_size, hipStream_t stream) {
    if (ws_size < WS_END) { fprintf(stderr, "ws too small: %zu\n", ws_size); return; }
    static int grid = 0;
    if (!grid) {
        int dev = 0, cus = 0, per_cu = 0;
        (void)hipGetDevice(&dev);
        (void)hipDeviceGetAttribute(&cus, hipDeviceAttributeMultiprocessorCount, dev);
        (void)hipFuncSetAttribute((const void*)mega_fwd, hipFuncAttributeMaxDynamicSharedMemorySize, MEGA_LDS);
        (void)hipOccupancyMaxActiveBlocksPerMultiprocessor(&per_cu, (const void*)mega_fwd, 512, MEGA_LDS);
        (void)hipGetLastError();
        grid = cus;
        if (per_cu < 1) fprintf(stderr, "occupancy query says %d blocks/CU\n", per_cu);
    }
    Args a{};
    a.x = (const float*)d_in[0]; a.norm_mix = (const float*)d_in[1]; a.w_in = (const float*)d_in[2];
    a.pe_k = (const float*)d_in[3]; a.w1_k = (const float*)d_in[4]; a.w2_k = (const float*)d_in[5];
    a.pe_v = (const float*)d_in[6]; a.w1_v = (const float*)d_in[7]; a.w2_v = (const float*)d_in[8];
    a.rel_bias = (const float*)d_in[9]; a.w_ba = (const float*)d_in[10]; a.w_bb = (const float*)d_in[11];
    a.w_out = (const float*)d_in[12]; a.norm_mlp = (const float*)d_in[13]; a.w_mi = (const float*)d_in[14];
    a.w_mo = (const float*)d_in[15]; a.norm_final = (const float*)d_in[16];
    a.out = (float*)d_out; a.ws = (unsigned char*)d_ws;
    (void)hipMemsetAsync(d_ws, 0, XCD_BAR_WORDS * sizeof(unsigned), stream);
    hipLaunchKernelGGL(mega_fwd, dim3(grid), dim3(512), MEGA_LDS, stream, a);
}
```

```cpp
#include <hip/hip_runtime.h>
#include <hip/hip_fp16.h>
#include <cstdint>
#include <cstdio>
#ifndef DBGSEL
#define DBGSEL 8
#endif

namespace pg8 {
#define PG8_LAS __attribute__((address_space(3)))
typedef unsigned short bf16_t;
typedef _Float16 bf16x8 __attribute__((ext_vector_type(8)));
typedef float f32x4 __attribute__((ext_vector_type(4)));
typedef unsigned u32x4 __attribute__((ext_vector_type(4)));
constexpr int BM = 256, BK = 64, HALF = 128, HTB = HALF * BK * 2  , STAGE_BYTES = 8 * HTB, NXCD = 8, WGM = 8;

__host__ __device__ __forceinline__ int lds_byte(int r, int c) { const int st = (r >> 4) * 2 + (c >> 5), rr = r & 15, cc = c & 31, ob = rr * 64 + cc * 2; return st * 1024 + (ob ^ (((ob >> 9) & 1) << 5)); }
__host__ __device__ __forceinline__ void stage_rc(int b, int& R, int& C) { const int st = b / 1024, sb = b % 1024, swz = sb ^ (((sb >> 9) & 1) << 5); R = (st >> 1) * 16 + swz / 64; C = (st & 1) * 32 + (swz % 64) / 2; }
__host__ __device__ __forceinline__ int perm32(int rho) { const int n = rho >> 4, i = rho & 15; return 8 * (i >> 2) + 4 * n + (i & 3); }

struct Unit { int pm, pn; };
struct Gemm { const bf16_t* A; const bf16_t* Bt; int M, N, K; };

struct StaticOrder {
    int nM, nN, nwg, G, c;
    __host__ __device__ void init(int M, int N, int G_, int c_) { nM = M / BM; nN = N / BM; nwg = nM * nN; G = G_; c = c_; }
    __host__ __device__ bool next(int i, Unit& u) const {
        const long L = (long)i * G + c; if (L >= nwg) return false;
        int wgid = (int)L; { const int q = nwg / NXCD, r = nwg % NXCD, xcd = wgid % NXCD, off = wgid / NXCD; wgid = (xcd < r ? xcd * (q + 1) : r * (q + 1) + (xcd - r) * q) + off; }
        const int nig = WGM * nN, gid = wgid / nig, fm = gid * WGM, gsz = (nM - fm) < WGM ? (nM - fm) : WGM;
        u.pm = fm + ((wgid % nig) % gsz); u.pn = (wgid % nig) / gsz; return true;
    }
    __device__ __forceinline__ void a_ready(const Unit&) const {}
    __device__ __forceinline__ void done(const Unit&) const {}
};


typedef float f32x2 __attribute__((ext_vector_type(2)));
typedef _Float16 f16x2 __attribute__((ext_vector_type(2)));
constexpr int PW = 4352;
__device__ __forceinline__ unsigned pkh(float a, float b) { f32x2 v = {a, b}; f16x2 h = __builtin_convertvector(v, f16x2); return __builtin_bit_cast(unsigned, h); }
__device__ __forceinline__ float sigm(float v) { return __builtin_amdgcn_rcpf(1.f + __expf(-v)); }
__device__ __forceinline__ void unpk8(const u32x4 w, float (&f)[8]) {
#pragma unroll
    for (int i = 0; i < 4; ++i) { const unsigned wi = (i == 0) ? w.x : (i == 1) ? w.y : (i == 2) ? w.z : w.w; const f16x2 h = __builtin_bit_cast(f16x2, wi); f[2 * i] = (float)h.x; f[2 * i + 1] = (float)h.y; } }

struct EpiProj {
    static constexpr bool PERM = true, AFTER_DRAIN = false;
    _Float16* O;
    __device__ __forceinline__ void operator()(const f32x4 (&acc)[2][2][4][2], const Unit& u, int wr, int wc, int fr, int fq) const {
        const int row0 = u.pm * BM + wr * 64 + fr, col0 = u.pn * BM + wc * 32 + 8 * fq; const bool sg = u.pn >= 9;
#pragma unroll
        for (int ai = 0; ai < 2; ++ai)
#pragma unroll
            for (int m = 0; m < 4; ++m) { _Float16* rowp = O + (size_t)(row0 + ai * HALF + m * 16) * PW + col0;
#pragma unroll
                for (int bj = 0; bj < 2; ++bj) { f32x4 v0 = acc[ai][bj][m][0], v1 = acc[ai][bj][m][1];
                    if (sg) {
#pragma unroll
                        for (int i = 0; i < 4; ++i) { v0[i] = sigm(v0[i]); v1[i] = sigm(v1[i]); } }
                    u32x4 w; w.x = pkh(v0[0], v0[1]); w.y = pkh(v0[2], v0[3]); w.z = pkh(v1[0], v1[1]); w.w = pkh(v1[2], v1[3]);
                    *(u32x4*)(rowp + bj * HALF) = w; } }
    }
};
template <int SECOND> struct EpiMix {
    static constexpr bool PERM = true, AFTER_DRAIN = false;
    _Float16* mix; const _Float16* proj;
    __device__ __forceinline__ void operator()(const f32x4 (&acc)[2][2][4][2], const Unit& u, int wr, int wc, int fr, int fq) const {
        const int row0 = u.pm * BM + wr * 64 + fr, col0 = u.pn * BM + wc * 32 + 8 * fq;
#pragma unroll
        for (int ai = 0; ai < 2; ++ai)
#pragma unroll
            for (int m = 0; m < 4; ++m) { const size_t r = (size_t)(row0 + ai * HALF + m * 16);
#pragma unroll
                for (int bj = 0; bj < 2; ++bj) { const int c = col0 + bj * HALF;
                    float g[8]; unpk8(*(const u32x4*)(proj + r * PW + 2304 + SECOND * 1024 + c), g);
                    const f32x4 v0 = acc[ai][bj][m][0], v1 = acc[ai][bj][m][1];
                    float o[8] = {g[0] * v0[0], g[1] * v0[1], g[2] * v0[2], g[3] * v0[3], g[4] * v1[0], g[5] * v1[1], g[6] * v1[2], g[7] * v1[3]};
                    if (SECOND) { float p[8]; unpk8(*(const u32x4*)(mix + r * 1024 + c), p);
#pragma unroll
                        for (int i = 0; i < 8; ++i) o[i] += p[i]; }
                    u32x4 w; w.x = pkh(o[0], o[1]); w.y = pkh(o[2], o[3]); w.z = pkh(o[4], o[5]); w.w = pkh(o[6], o[7]);
                    *(u32x4*)(mix + r * 1024 + c) = w; } }
    }
};
struct EpiPlain {
    static constexpr bool PERM = true, AFTER_DRAIN = false;
    _Float16* U;
    __device__ __forceinline__ void operator()(const f32x4 (&acc)[2][2][4][2], const Unit& u, int wr, int wc, int fr, int fq) const {
        const int row0 = u.pm * BM + wr * 64 + fr, col0 = u.pn * BM + wc * 32 + 8 * fq;
#pragma unroll
        for (int ai = 0; ai < 2; ++ai)
#pragma unroll
            for (int m = 0; m < 4; ++m) { _Float16* rowp = U + (size_t)(row0 + ai * HALF + m * 16) * 1024 + col0;
#pragma unroll
                for (int bj = 0; bj < 2; ++bj) { f32x4 v0 = acc[ai][bj][m][0], v1 = acc[ai][bj][m][1];
                    u32x4 w; w.x = pkh(v0[0], v0[1]); w.y = pkh(v0[2], v0[3]); w.z = pkh(v1[0], v1[1]); w.w = pkh(v1[2], v1[3]);
                    *(u32x4*)(rowp + bj * HALF) = w; } }
    }
};
struct EpiResid {
    static constexpr bool PERM = true, AFTER_DRAIN = false;
    const float* x; float* out;
    __device__ __forceinline__ void operator()(const f32x4 (&acc)[2][2][4][2], const Unit& u, int wr, int wc, int fr, int fq) const {
        const int row0 = u.pm * BM + wr * 64 + fr, col0 = u.pn * BM + wc * 32 + 8 * fq;
#pragma unroll
        for (int ai = 0; ai < 2; ++ai)
#pragma unroll
            for (int m = 0; m < 4; ++m) { const size_t r = (size_t)(row0 + ai * HALF + m * 16);
#pragma unroll
                for (int bj = 0; bj < 2; ++bj) { const size_t o = r * 1024 + col0 + bj * HALF;
                    const f32x4 a0 = *(const f32x4*)(x + o), a1 = *(const f32x4*)(x + o + 4);
                    *(f32x4*)(out + o) = a0 + acc[ai][bj][m][0]; *(f32x4*)(out + o + 4) = a1 + acc[ai][bj][m][1]; } }
    }
};
struct EpiRelu2 {
    static constexpr bool PERM = true, AFTER_DRAIN = false;
    _Float16* U;
    __device__ __forceinline__ void operator()(const f32x4 (&acc)[2][2][4][2], const Unit& u, int wr, int wc, int fr, int fq) const {
        const int row0 = u.pm * BM + wr * 64 + fr, col0 = u.pn * BM + wc * 32 + 8 * fq;
#pragma unroll
        for (int ai = 0; ai < 2; ++ai)
#pragma unroll
            for (int m = 0; m < 4; ++m) { _Float16* rowp = U + (size_t)(row0 + ai * HALF + m * 16) * 4096 + col0;
#pragma unroll
                for (int bj = 0; bj < 2; ++bj) { f32x4 v0 = acc[ai][bj][m][0], v1 = acc[ai][bj][m][1];
#pragma unroll
                    for (int i = 0; i < 4; ++i) { const float a = fmaxf(v0[i], 0.f), b = fmaxf(v1[i], 0.f); v0[i] = a * a; v1[i] = b * b; }
                    u32x4 w; w.x = pkh(v0[0], v0[1]); w.y = pkh(v0[2], v0[3]); w.z = pkh(v1[0], v1[1]); w.w = pkh(v1[2], v1[3]);
                    *(u32x4*)(rowp + bj * HALF) = w; } }
    }
};
template <class Epi, class Sched, bool ALIGN_EPI = false, bool SP2 = false>
__device__ __forceinline__ void gemm_phase(PG8_LAS unsigned char* lds, const Gemm g, const Sched& S, const Epi& E) {
    int tid_ = threadIdx.x; asm volatile("" : "+v"(tid_));
    const int tid = tid_, wid = __builtin_amdgcn_readfirstlane(tid >> 6), lane = tid & 63, wr = wid >> 2, wc = wid & 3, fr = lane & 15, fq = lane >> 4;
    const int K = g.K, nt = K / BK;
    unsigned voffA[2], voffB[2];
#pragma unroll
    for (int i = 0; i < 2; ++i) { int R, C; stage_rc(tid * 16 + i * 8192, R, C); const int Rb = Epi::PERM ? ((R & ~31) + perm32(R & 31)) : R;
        voffA[i] = (unsigned)(R * K + C) * 2u; voffB[i] = (unsigned)(Rb * K + C) * 2u; }
    const size_t kstep = (size_t)(BK * 2);
    const size_t hstep = (size_t)HALF * K * 2;
    const size_t tstep = 2 * hstep;
    const unsigned ldsw = (unsigned)wid * 1024u;
    const int aoff = lds_byte(wr * 64 + fr, fq * 8), boff = lds_byte(wc * 32 + fr, fq * 8);
#define PG8_SA(b, h) (((b) * 2 + (h)) * HTB)
#define PG8_SB(b, h) ((4 + (b) * 2 + (h)) * HTB)
#define PG8_STAGE(bufoff, gbase, voff) do { _Pragma("unroll") for (int _i = 0; _i < 2; ++_i) \
        __builtin_amdgcn_global_load_lds((const unsigned*)((const char*)(gbase) + (voff)[_i]), (PG8_LAS unsigned*)(lds + (bufoff) + ldsw + _i * 8192), 16, 0, 0); } while (0)
#define PG8_LDA(dst, b, h) do { _Pragma("unroll") for (int m = 0; m < 4; ++m) _Pragma("unroll") for (int k = 0; k < 2; ++k) dst[m][k] = *(const PG8_LAS bf16x8*)(lds + PG8_SA(b, h) + aoff + m * 2048 + k * 1024); } while (0)
#define PG8_LDB(dst, b, h) do { _Pragma("unroll") for (int n = 0; n < 2; ++n) _Pragma("unroll") for (int k = 0; k < 2; ++k) dst[n][k] = *(const PG8_LAS bf16x8*)(lds + PG8_SB(b, h) + boff + n * 2048 + k * 1024); } while (0)
#define PG8_MMA(ai, bj, At, Bt) do { __builtin_amdgcn_s_setprio(1); _Pragma("unroll") for (int m = 0; m < 4; ++m) _Pragma("unroll") for (int n = 0; n < 2; ++n) _Pragma("unroll") for (int k = 0; k < 2; ++k) \
        acc[ai][bj][m][n] = __builtin_amdgcn_mfma_f32_16x16x32_f16(Bt[n][k], At[m][k], acc[ai][bj][m][n], 0, 0, 0); __builtin_amdgcn_s_setprio(0); } while (0)
#define PG8_WAIT_V(n) asm volatile("s_waitcnt vmcnt(" #n ")" ::: "memory")
#define PG8_WAIT_L(n) asm volatile("s_waitcnt lgkmcnt(" #n ")" ::: "memory")
#define PG8_BAR __builtin_amdgcn_s_barrier()
#define PG8_SCHED __builtin_amdgcn_sched_barrier(0)
    Unit cur, nxt; int ui = 0;
    if (!S.next(0, cur)) return;
    f32x4 acc[2][2][4][2];
#pragma unroll
    for (int a = 0; a < 2; ++a)
#pragma unroll
        for (int b = 0; b < 2; ++b)
#pragma unroll
            for (int m = 0; m < 4; ++m)
#pragma unroll
                for (int n = 0; n < 2; ++n) acc[a][b][m][n] = (f32x4){0.f, 0.f, 0.f, 0.f};
    bf16x8 At[4][2], B0[2][2], B1[2][2];
    const char* cA = (const char*)g.A + (size_t)cur.pm * tstep; const char* cB = (const char*)g.Bt + (size_t)cur.pn * tstep;
    S.a_ready(cur);
    if constexpr (SP2) {
        PG8_STAGE(PG8_SB(0, 0), cB, voffB); PG8_STAGE(PG8_SB(0, 1), cB + hstep, voffB); PG8_STAGE(PG8_SA(0, 0), cA, voffA); PG8_STAGE(PG8_SA(0, 1), cA + hstep, voffA);
        if (wr == 1) PG8_BAR;
        PG8_WAIT_V(2); PG8_BAR;
        PG8_STAGE(PG8_SB(1, 0), cB + kstep, voffB); PG8_STAGE(PG8_SA(1, 0), cA + kstep, voffA); PG8_STAGE(PG8_SB(1, 1), cB + hstep + kstep, voffB);
        PG8_WAIT_V(6); PG8_BAR;
    } else {
        PG8_STAGE(PG8_SB(0, 0), cB, voffB); PG8_STAGE(PG8_SA(0, 0), cA, voffA); PG8_STAGE(PG8_SB(0, 1), cB + hstep, voffB); PG8_STAGE(PG8_SA(0, 1), cA + hstep, voffA);
        if (wr == 1) PG8_BAR;
        PG8_WAIT_V(4); PG8_BAR;
        PG8_STAGE(PG8_SB(1, 0), cB + kstep, voffB); PG8_STAGE(PG8_SA(1, 0), cA + kstep, voffA); PG8_STAGE(PG8_SB(1, 1), cB + hstep + kstep, voffB);
        PG8_WAIT_V(6); PG8_BAR;
    }
    for (;;) {
        const bool has_next = S.next(ui + 1, nxt);
        const char* nA = has_next ? (const char*)g.A + (size_t)nxt.pm * tstep : cA; const char* nB = has_next ? (const char*)g.Bt + (size_t)nxt.pn * tstep : cB;
        for (int t = 0; t < nt; t += 2) {
            const bool last = (t == nt - 2);
            const char* a1 = cA + (size_t)(t + 1) * kstep;
            const char* a2 = last ? nA : cA + (size_t)(t + 2) * kstep; const char* b2 = last ? nB : cB + (size_t)(t + 2) * kstep;
            const char* a3 = a2 + kstep; const char* b3 = b2 + kstep;
            if (last && has_next) S.a_ready(nxt);
            if constexpr (SP2) {
            PG8_LDB(B0, 0, 0); PG8_LDB(B1, 0, 1); PG8_SCHED; PG8_LDA(At, 0, 0); PG8_STAGE(PG8_SA(1, 1), a1 + hstep, voffA);
            PG8_WAIT_V(8); PG8_WAIT_L(0); PG8_BAR; PG8_MMA(0, 0, At, B0); PG8_MMA(0, 1, At, B1); PG8_BAR; PG8_SCHED;
            PG8_LDA(At, 0, 1); PG8_STAGE(PG8_SB(0, 0), b2, voffB); PG8_STAGE(PG8_SB(0, 1), b2 + hstep, voffB); PG8_STAGE(PG8_SA(0, 0), a2, voffA);
            PG8_WAIT_V(8); PG8_WAIT_L(0); PG8_BAR; PG8_MMA(1, 0, At, B0); PG8_MMA(1, 1, At, B1); PG8_BAR; PG8_SCHED;
            PG8_LDB(B0, 1, 0); PG8_LDB(B1, 1, 1); PG8_SCHED; PG8_LDA(At, 1, 0); PG8_STAGE(PG8_SA(0, 1), a2 + hstep, voffA);
            PG8_WAIT_V(8); PG8_WAIT_L(0); PG8_BAR; PG8_MMA(0, 0, At, B0); PG8_MMA(0, 1, At, B1); PG8_BAR; PG8_SCHED;
            PG8_LDA(At, 1, 1); PG8_STAGE(PG8_SB(1, 0), b3, voffB); PG8_STAGE(PG8_SB(1, 1), b3 + hstep, voffB); PG8_STAGE(PG8_SA(1, 0), a3, voffA);
            PG8_WAIT_V(8); PG8_WAIT_L(0); PG8_BAR; PG8_MMA(1, 0, At, B0); PG8_MMA(1, 1, At, B1); PG8_BAR; PG8_SCHED;
            } else {
            PG8_LDB(B0, 0, 0); PG8_SCHED; PG8_LDA(At, 0, 0); PG8_STAGE(PG8_SA(1, 1), a1 + hstep, voffA);
            PG8_WAIT_L(8); PG8_BAR; PG8_WAIT_L(0); PG8_MMA(0, 0, At, B0); PG8_BAR; PG8_SCHED;
            PG8_LDB(B1, 0, 1); PG8_STAGE(PG8_SB(0, 0), b2, voffB);
            PG8_BAR; PG8_WAIT_L(0); PG8_MMA(0, 1, At, B1); PG8_BAR;
            PG8_LDA(At, 0, 1); PG8_STAGE(PG8_SA(0, 0), a2, voffA);
            PG8_BAR; PG8_WAIT_L(0); PG8_MMA(1, 0, At, B0); PG8_BAR; PG8_SCHED;
            PG8_STAGE(PG8_SB(0, 1), b2 + hstep, voffB);
            PG8_WAIT_V(6); PG8_BAR; PG8_MMA(1, 1, At, B1); PG8_BAR;
            PG8_LDB(B0, 1, 0); PG8_SCHED; PG8_LDA(At, 1, 0); PG8_STAGE(PG8_SA(0, 1), a2 + hstep, voffA);
            PG8_WAIT_L(8); PG8_BAR; PG8_WAIT_L(0); PG8_MMA(0, 0, At, B0); PG8_BAR; PG8_SCHED;
            PG8_LDB(B1, 1, 1); PG8_STAGE(PG8_SB(1, 0), b3, voffB);
            PG8_BAR; PG8_WAIT_L(0); PG8_MMA(0, 1, At, B1); PG8_BAR;
            PG8_LDA(At, 1, 1); PG8_STAGE(PG8_SA(1, 0), a3, voffA);
            PG8_BAR; PG8_WAIT_L(0); PG8_MMA(1, 0, At, B0); PG8_BAR; PG8_SCHED;
            PG8_STAGE(PG8_SB(1, 1), b3 + hstep, voffB);
            PG8_WAIT_V(6); PG8_BAR; PG8_MMA(1, 1, At, B1); PG8_BAR;
            }
        }
        if constexpr (ALIGN_EPI) { if (wr == 0) PG8_BAR; }
        if constexpr (!Epi::AFTER_DRAIN) { E(acc, cur, wr, wc, fr, fq); S.done(cur); }
        if (!has_next) break;
#pragma unroll
        for (int a = 0; a < 2; ++a)
#pragma unroll
            for (int b = 0; b < 2; ++b)
#pragma unroll
                for (int m = 0; m < 4; ++m)
#pragma unroll
                    for (int n = 0; n < 2; ++n) acc[a][b][m][n] = (f32x4){0.f, 0.f, 0.f, 0.f};
        cur = nxt; cA = nA; cB = nB; ++ui;
        if constexpr (ALIGN_EPI) { if (wr == 1) PG8_BAR; }
    }
    PG8_WAIT_V(0);
    if constexpr (!ALIGN_EPI) { if (wr == 0) PG8_BAR; }
    PG8_BAR;
    if constexpr (Epi::AFTER_DRAIN) { E.fused(acc, cur, wr, wc, fr, fq, lds, wid, lane); S.done(cur); }
#undef PG8_SA
#undef PG8_SB
#undef PG8_STAGE
#undef PG8_LDA
#undef PG8_LDB
#undef PG8_MMA
#undef PG8_WAIT_V
#undef PG8_WAIT_L
#undef PG8_BAR
#undef PG8_SCHED
}
}


namespace {
constexpr int B_ = 8, S_ = 4096, M_ = B_ * S_, D_ = 1024, DIN = 4288, DFF = 4096;
constexpr int C_QA = 0, C_QB = 512, C_QI = 1024, C_KVB = 1280, C_KA = 2048, C_VA = 2112, C_KI = 2176, C_WI = 2208, C_GB = 2216, C_GATE = 2304;
constexpr int NC = 255;
constexpr float EPS = 1e-6f;
using pg8::PW;
#define GAS __attribute__((address_space(1)))
#define LAS __attribute__((address_space(3)))
typedef unsigned v4u __attribute__((ext_vector_type(4)));
typedef float f32x4 __attribute__((ext_vector_type(4)));

__device__ __forceinline__ int t5_bucket(int n) {
    if (n < 16) return n < 0 ? 0 : n;
    float nf = (float)n;
    int large = 16 + (int)(logf(nf / 16.f) / logf(8.f) * 16.f);
    return large < 31 ? large : 31;
}
__device__ __forceinline__ float sigmoidf_(float v) { return 1.f / (1.f + expf(-v)); }


__device__ __forceinline__ int win_src_col(int n) {
    if (n < 512) return n;
    if (n < 1024) return 936 + (n - 512);
    if (n < 1280) return 640 + (n - 1024);
    if (n < 2048) return 1448 + (n - 1280);
    if (n < 2112) return 512 + (n - 2048);
    if (n < 2176) return 576 + (n - 2112);
    if (n < 2208) return 896 + (n - 2176);
    if (n < 2216) return 928 + (n - 2208);
    if (n < 2240) return n;
    if (n < 2304) return -1;
    return 2240 + (n - 2304);
}
__device__ __forceinline__ float wave_sum(float v) {
#pragma unroll
    for (int o = 1; o < 64; o <<= 1) v += __shfl_xor(v, o);
    return v;
}
template <bool MAP>
__device__ __forceinline__ void transpose_item(const float* __restrict__ W, int K, int Nsrc, int Ndst, _Float16* __restrict__ WT, const float* __restrict__ gain, float* scr, int item, int lane) {
    const int nblk = Ndst / 32, kb = item / nblk, nb = item % nblk, k0 = 64 * kb, n0 = 32 * nb;
    const int nd = n0 + (lane & 31); const int ns = MAP ? win_src_col(nd) : nd;
#pragma unroll 8
    for (int i = 0; i < 32; ++i) { const int kk = 2 * i + (lane >> 5); float v = 0.f;
        if (ns >= 0) { v = W[(size_t)(k0 + kk) * Nsrc + ns]; if (gain) v *= gain[k0 + kk]; }
        scr[kk * 33 + (lane & 31)] = v; }
    __builtin_amdgcn_s_waitcnt(0xc07f); asm volatile("" ::: "memory");
    const int c = lane & 7;
#pragma unroll
    for (int j = 0; j < 4; ++j) { const int n = (lane >> 3) + 8 * j; const float* s = scr + (8 * c) * 33 + n;
        v4u o; o.x = pg8::pkh(s[0 * 33], s[1 * 33]); o.y = pg8::pkh(s[2 * 33], s[3 * 33]); o.z = pg8::pkh(s[4 * 33], s[5 * 33]); o.w = pg8::pkh(s[6 * 33], s[7 * 33]);
        *(v4u*)(WT + (size_t)(n0 + n) * K + k0 + 8 * c) = o; }
    __builtin_amdgcn_s_waitcnt(0xc07f); asm volatile("" ::: "memory");
}
__device__ __forceinline__ void rms_row_to_f16(const float* __restrict__ xrow, _Float16* __restrict__ orow, int lane) {
    const f32x4* xr = (const f32x4*)xrow + lane;
    f32x4 v[4]; float s = 0.f;
#pragma unroll
    for (int j = 0; j < 4; ++j) { v[j] = xr[64 * j]; s += (v[j].x * v[j].x + v[j].y * v[j].y) + (v[j].z * v[j].z + v[j].w * v[j].w); }
    const float rstd = rsqrtf(wave_sum(s) * (1.f / D_) + EPS);
    unsigned long long* o8 = (unsigned long long*)orow + lane;
#pragma unroll
    for (int j = 0; j < 4; ++j) o8[64 * j] = (unsigned long long)pg8::pkh(v[j].x * rstd, v[j].y * rstd) | ((unsigned long long)pg8::pkh(v[j].z * rstd, v[j].w * rstd) << 32);
}

struct Args {
    const float* x; const float* norm_mix; const float* w_in; const float* pe_k; const float* w1_k; const float* w2_k; const float* pe_v; const float* w1_v; const float* w2_v;
    const float* rel_bias; const float* w_ba; const float* w_bb; const float* w_out; const float* norm_mlp; const float* w_mi; const float* w_mo; const float* norm_final;
    float* out; unsigned char* ws;
};
constexpr size_t MiB = 1u << 20;
constexpr size_t WS_CTL = 0, WS_WIN = 1 * MiB, WS_WBA = 10 * MiB, WS_WBB = 11 * MiB, WS_WOUT = 12 * MiB, WS_WMI = 14 * MiB, WS_WMO = 22 * MiB, WS_CW = 30 * MiB,
                 WS_KCMP = 32 * MiB, WS_VCMP = 33 * MiB, WS_H = 34 * MiB, WS_PROJ = 98 * MiB, WS_MIX = 370 * MiB, WS_END = 434 * MiB;

__device__ __forceinline__ void prologue_body(const Args& a, unsigned char* lds) {
    const int tid = threadIdx.x, lane = tid & 63, wave = tid >> 6;
    float* scr = (float*)(lds + wave * 8704);
    const int gw = blockIdx.x * 8 + wave, NGW = gridDim.x * 8;
    constexpr int I_IN = (D_ / 64) * (PW / 32), I_BA = (512 / 64) * (D_ / 32), I_OUT = (D_ / 64) * (D_ / 32), I_MI = (D_ / 64) * (DFF / 32), I_MO = (DFF / 64) * (D_ / 32);
    constexpr int I_C1 = (2048 / 64) * (128 / 32), I_C2 = (128 / 64) * (64 / 32);
    constexpr int NITEMS = I_IN + 2 * I_BA + I_OUT + I_MI + I_MO + 2 * I_C1 + 2 * I_C2;
    for (int it = gw; it < NITEMS; it += NGW) {
        int r = it;
        if (r < I_IN) { transpose_item<true>(a.w_in, D_, DIN, PW, (_Float16*)(a.ws + WS_WIN), a.norm_mix, scr, r, lane); continue; } r -= I_IN;
        if (r < I_BA) { transpose_item<false>(a.w_ba, 512, D_, D_, (_Float16*)(a.ws + WS_WBA), nullptr, scr, r, lane); continue; } r -= I_BA;
        if (r < I_BA) { transpose_item<false>(a.w_bb, 512, D_, D_, (_Float16*)(a.ws + WS_WBB), nullptr, scr, r, lane); continue; } r -= I_BA;
        if (r < I_OUT) { transpose_item<false>(a.w_out, D_, D_, D_, (_Float16*)(a.ws + WS_WOUT), nullptr, scr, r, lane); continue; } r -= I_OUT;
        if (r < I_MI) { transpose_item<false>(a.w_mi, D_, DFF, DFF, (_Float16*)(a.ws + WS_WMI), a.norm_mlp, scr, r, lane); continue; } r -= I_MI;
        if (r < I_MO) { transpose_item<false>(a.w_mo, DFF, D_, D_, (_Float16*)(a.ws + WS_WMO), nullptr, scr, r, lane); continue; } r -= I_MO;
        if (r < I_C1) { transpose_item<false>(a.w1_k, 2048, 128, 128, (_Float16*)(a.ws + WS_CW), nullptr, scr, r, lane); continue; } r -= I_C1;
        if (r < I_C1) { transpose_item<false>(a.w1_v, 2048, 128, 128, (_Float16*)(a.ws + WS_CW + 512 * 1024), nullptr, scr, r, lane); continue; } r -= I_C1;
        if (r < I_C2) { transpose_item<false>(a.w2_k, 128, 64, 64, (_Float16*)(a.ws + WS_CW + 1024 * 1024), nullptr, scr, r, lane); continue; } r -= I_C2;
        transpose_item<false>(a.w2_v, 128, 64, 64, (_Float16*)(a.ws + WS_CW + 1024 * 1024 + 16384), nullptr, scr, r, lane);
    }
    for (int m = gw; m < M_; m += NGW) rms_row_to_f16(a.x + (size_t)m * D_, (_Float16*)(a.ws + WS_H) + (size_t)m * D_, lane);
}
__global__ void __launch_bounds__(512, 2) k_prologue(Args a) {
    extern __shared__ __attribute__((aligned(16))) unsigned char lds[];
    prologue_body(a, lds);
}
__device__ __forceinline__ void final_norm_row(float* __restrict__ xrow, const float* __restrict__ g, int lane) {
    f32x4* xr = (f32x4*)xrow + lane; const f32x4* gr = (const f32x4*)g + lane;
    f32x4 v[4]; float s = 0.f;
#pragma unroll
    for (int j = 0; j < 4; ++j) { v[j] = xr[64 * j]; s += (v[j].x * v[j].x + v[j].y * v[j].y) + (v[j].z * v[j].z + v[j].w * v[j].w); }
    const float rstd = rsqrtf(wave_sum(s) * (1.f / D_) + EPS);
#pragma unroll
    for (int j = 0; j < 4; ++j) { const f32x4 gg = gr[64 * j]; xr[64 * j] = v[j] * rstd * gg; }
}
__global__ void __launch_bounds__(512, 2) k_rows_norm(const float* __restrict__ src, _Float16* __restrict__ dst) {
    const int lane = threadIdx.x & 63, gw = blockIdx.x * 8 + (threadIdx.x >> 6), NGW = gridDim.x * 8;
    for (int m = gw; m < M_; m += NGW) rms_row_to_f16(src + (size_t)m * D_, dst + (size_t)m * D_, lane);
}
template <class Epi>
__global__ void __launch_bounds__(512, 2) k_gemm(const void* A, const void* Bt, Epi E, int M, int N, int K, int pad_) {
    extern __shared__ __attribute__((aligned(16))) unsigned char lds[];
    pg8::Gemm g{(const pg8::bf16_t*)A, (const pg8::bf16_t*)Bt, M, N, K};
    pg8::StaticOrder S; S.init(M, N, (int)gridDim.x, (int)blockIdx.x);
    pg8::gemm_phase<Epi, pg8::StaticOrder, true, true>((PG8_LAS unsigned char*)lds, g, S, E);
}
struct EpiAccOut {
    static constexpr bool PERM = true, AFTER_DRAIN = false;
    float* out;
    __device__ __forceinline__ void operator()(const f32x4 (&acc)[2][2][4][2], const pg8::Unit& u, int wr, int wc, int fr, int fq) const {
        const int row0 = u.pm * 256 + wr * 64 + fr, col0 = u.pn * 256 + wc * 32 + 8 * fq;
#pragma unroll
        for (int ai = 0; ai < 2; ++ai)
#pragma unroll
            for (int m = 0; m < 4; ++m) { const size_t r = (size_t)(row0 + ai * 128 + m * 16);
#pragma unroll
                for (int bj = 0; bj < 2; ++bj) { const size_t o = r * 1024 + col0 + bj * 128;
                    const f32x4 a0 = *(const f32x4*)(out + o), a1 = *(const f32x4*)(out + o + 4);
                    *(f32x4*)(out + o) = a0 + acc[ai][bj][m][0]; *(f32x4*)(out + o + 4) = a1 + acc[ai][bj][m][1]; } }
    }
};


namespace dsa {
typedef _Float16 f16x8 __attribute__((ext_vector_type(8)));
typedef _Float16 f16x4 __attribute__((ext_vector_type(4)));
typedef short s16x4 __attribute__((ext_vector_type(4)));
typedef float f32x4 __attribute__((ext_vector_type(4)));
typedef unsigned u32x4 __attribute__((ext_vector_type(4)));
typedef unsigned u32x2 __attribute__((ext_vector_type(2)));
constexpr int TQ = 16, NBIN = 2048, CANDCAP = 512, VPITCH = 144;
constexpr int L_HIST = 0, L_SEL = 65536, L_CTL = L_SEL + 8192, L_BIAS = L_CTL + 512, L_VST = L_BIAS + 4096, L_END = L_VST + 8 * 32 * VPITCH;
static_assert(L_END <= 131072, "dsa LDS");

__device__ __forceinline__ float idx_score(const f32x4 a1, const f32x4 a2, const float (&w)[8]) {
    float s = w[0] * fmaxf(a1.x, 0.f);
    s = fmaf(w[1], fmaxf(a1.y, 0.f), s); s = fmaf(w[2], fmaxf(a1.z, 0.f), s); s = fmaf(w[3], fmaxf(a1.w, 0.f), s);
    s = fmaf(w[4], fmaxf(a2.x, 0.f), s); s = fmaf(w[5], fmaxf(a2.y, 0.f), s); s = fmaf(w[6], fmaxf(a2.z, 0.f), s); s = fmaf(w[7], fmaxf(a2.w, 0.f), s);
    return s;
}
__device__ __forceinline__ int score_bin(float sc, float inv) { int b = (int)(fmaf(sc, inv, 1024.f)); b = b < 0 ? 0 : b; return b > NBIN - 1 ? NBIN - 1 : b; }

template <int PASS>
__device__ __forceinline__ void score_pass(LAS unsigned char* lds, const _Float16* __restrict__ proj, int b, int t0, int nkb, int wave, int lane,
                                           const f16x8 (&afr)[4][2], const float (&wq)[4][8], const float (&binv)[4]) {
    LAS unsigned* hist = (LAS unsigned*)(lds + L_HIST);
    LAS unsigned short* sel = (LAS unsigned short*)(lds + L_SEL);
    LAS u32x2* cand = (LAS u32x2*)(lds + L_HIST);
    LAS int* ctl = (LAS int*)(lds + L_CTL);
    const int kc = lane >> 4, n16 = lane & 15;
    int bst[4];
#pragma unroll
    for (int grp = 0; grp < 4; ++grp) bst[grp] = (PASS == 2) ? ctl[(4 * grp + kc) * 8 + 2] : 0;
    const f32x4 zero = {0.f, 0.f, 0.f, 0.f};
    const _Float16* kbase = proj + (size_t)(b * S_ + n16) * PW + C_KI + 8 * kc;
    f16x8 bnext = *(const f16x8*)(kbase + (size_t)(16 * (wave < nkb ? wave : 0)) * PW);
    for (int kb = wave; kb < nkb; kb += 8) {
        const f16x8 bfr = bnext;
        { const int kn = kb + 8 < nkb ? kb + 8 : kb; bnext = *(const f16x8*)(kbase + (size_t)(16 * kn) * PW); }
        const int s = 16 * kb + n16;
#pragma unroll
        for (int grp = 0; grp < 4; ++grp) {
            const f32x4 a1 = __builtin_amdgcn_mfma_f32_16x16x32_f16(afr[grp][0], bfr, zero, 0, 0, 0);
            const f32x4 a2 = __builtin_amdgcn_mfma_f32_16x16x32_f16(afr[grp][1], bfr, zero, 0, 0, 0);
            const float sc = idx_score(a1, a2, wq[grp]);
            const int row = 4 * grp + kc, t = t0 + row;
            if (s <= t) {
                const int bin = score_bin(sc, binv[grp]);
                if (PASS == 1) { __hip_atomic_fetch_add(hist + row * 1024 + (bin >> 1), (bin & 1) ? 0x10000u : 1u, __ATOMIC_RELAXED, __HIP_MEMORY_SCOPE_WORKGROUP); }
                else {
                    if (bin > bst[grp]) { const int pos = __hip_atomic_fetch_add(ctl + row * 8 + 0, 1, __ATOMIC_RELAXED, __HIP_MEMORY_SCOPE_WORKGROUP); sel[row * 256 + (pos & 255)] = (unsigned short)s; }
                    else if (bin == bst[grp]) { const int pos = __hip_atomic_fetch_add(ctl + row * 8 + 1, 1, __ATOMIC_RELAXED, __HIP_MEMORY_SCOPE_WORKGROUP);
                        if (pos < CANDCAP) { u32x2 e; e.x = __float_as_uint(sc); e.y = (unsigned)s; cand[row * CANDCAP + pos] = e; } }
                }
            }
        }
    }
}

__device__ __forceinline__ void dsa_tile(LAS unsigned char* lds, const _Float16* __restrict__ proj, _Float16* __restrict__ o_a, int b, int qt, unsigned* dbg) {
    const int tid = threadIdx.x, lane = tid & 63, wave = __builtin_amdgcn_readfirstlane(tid >> 6);
    const int kc = lane >> 4, n16 = lane & 15;
    const int t0 = qt * TQ, nkb = qt + 1;
    LAS unsigned* hist = (LAS unsigned*)(lds + L_HIST);
    LAS unsigned short* sel = (LAS unsigned short*)(lds + L_SEL);
    LAS u32x2* cand = (LAS u32x2*)(lds + L_HIST);
    LAS int* ctl = (LAS int*)(lds + L_CTL);
    LAS float* biaslut = (LAS float*)(lds + L_BIAS);
    for (int i = tid; i < TQ * 1024 / 4; i += 512) ((LAS u32x4*)hist)[i] = (u32x4){0u, 0u, 0u, 0u};
    if (tid < TQ * 8) ctl[tid] = 0;
    f16x8 afr[4][2]; float wq[4][8]; float binv[4];
    { const int g = n16 >> 2, r = n16 & 3;
#pragma unroll
      for (int grp = 0; grp < 4; ++grp) {
          const _Float16* qrow = proj + (size_t)(b * S_ + t0 + 4 * grp + g) * PW + C_QI;
          afr[grp][0] = *(const f16x8*)(qrow + r * 32 + 8 * kc);
          afr[grp][1] = *(const f16x8*)(qrow + (4 + r) * 32 + 8 * kc);
          const f16x8 wv = *(const f16x8*)(proj + (size_t)(b * S_ + t0 + 4 * grp + kc) * PW + C_WI);
          float ss = 0.f;
#pragma unroll
          for (int h = 0; h < 8; ++h) { wq[grp][h] = (float)wv[h] * (1.f / 16.f); ss = fmaf(wq[grp][h], wq[grp][h], ss); }
          binv[grp] = 32.f * rsqrtf(ss + 1e-12f);
      } }
    __syncthreads();
    score_pass<1>(lds, proj, b, t0, nkb, wave, lane, afr, wq, binv);
    __syncthreads();
#pragma unroll 1
    for (int i = 0; i < 2; ++i) {
        const int row = 2 * wave + i, n = t0 + row + 1;
        if (n <= 256) { if (lane == 0) { ctl[row * 8 + 2] = -1; ctl[row * 8 + 3] = 0; } }
        else {
            const LAS u32x4* hp = (const LAS u32x4*)(hist + row * 1024 + 16 * lane);
            unsigned tot = 0;
#pragma unroll
            for (int q4 = 0; q4 < 4; ++q4) { const u32x4 hv = hp[q4];
                tot += (hv.x & 0xffffu) + (hv.x >> 16) + (hv.y & 0xffffu) + (hv.y >> 16) + (hv.z & 0xffffu) + (hv.z >> 16) + (hv.w & 0xffffu) + (hv.w >> 16); }
            unsigned suf = tot;
#pragma unroll
            for (int o = 1; o < 64; o <<= 1) { const unsigned v = __shfl_down(suf, o); if (lane + o < 64) suf += v; }
            const unsigned above_lane = suf - tot;
            if (above_lane < 256u && suf >= 256u) {
                const LAS unsigned short* h16 = (const LAS unsigned short*)hist + row * 2048 + 32 * lane;
                unsigned cum = above_lane; int bs = 32 * lane;
#pragma unroll 1
                for (int j = 31; j >= 0; --j) { const unsigned c = h16[j]; if (cum + c >= 256u) { bs = 32 * lane + j; break; } cum += c; }
                ctl[row * 8 + 2] = bs; ctl[row * 8 + 3] = 256 - (int)cum;
            }
        }
    }
    __syncthreads();
    score_pass<2>(lds, proj, b, t0, nkb, wave, lane, afr, wq, binv);
    __syncthreads();
#pragma unroll 1
    for (int i = 0; i < 2; ++i) {
        const int row = 2 * wave + i, n = t0 + row + 1;
        const int need = ctl[row * 8 + 3], base = ctl[row * 8 + 0];
        int nc = ctl[row * 8 + 1];
        if (lane == 0 && dbg) { if (nc > CANDCAP) atomicAdd(dbg + 5, 1u); if (need > nc) atomicAdd(dbg + 4, 1u); if (n > 256 && base + need != 256) atomicAdd(dbg + 6, 1u); atomicMax(dbg + 8, (unsigned)nc); }
        nc = nc < CANDCAP ? nc : CANDCAP;
        if (lane == 0) { const int nf = base + (need < nc ? need : nc); ctl[row * 8 + 4] = n <= 256 ? n : (nf < 256 ? nf : 256); }
        if (need > 0) {
            for (int c0 = 0; c0 < nc; c0 += 64) {
                const int ci = c0 + lane; const bool act = ci < nc;
                const u32x2 me = cand[row * CANDCAP + (act ? ci : 0)];
                const float msc = __uint_as_float(me.x); int rank = 0;
                for (int j = 0; j < nc; ++j) { const u32x2 ot = cand[row * CANDCAP + j]; const float osc = __uint_as_float(ot.x);
                    rank += (osc > msc || (osc == msc && ot.y < me.y)) ? 1 : 0; }
                if (act && rank < need) sel[row * 256 + ((base + rank) & 255)] = (unsigned short)me.y;
            }
        }
    }
    __syncthreads();
    LAS unsigned char* vst = lds + L_VST + wave * (32 * VPITCH);
#pragma unroll 1
    for (int i = 0; i < 2; ++i) {
        const int row = 2 * wave + i, t = t0 + row; const int nvalid = ctl[row * 8 + 4];
        const _Float16* qrow = proj + (size_t)(b * S_ + t) * PW + C_QA;
        const int head = n16, hm = head & 7;
        f16x8 qb0, qb1;
        { const f16x8 z = {0, 0, 0, 0, 0, 0, 0, 0}; qb0 = z; qb1 = z;
          if (head < 8) { qb0 = *(const f16x8*)(qrow + head * 64 + 8 * kc); qb1 = *(const f16x8*)(qrow + head * 64 + 32 + 8 * kc); } }
        f32x4 ot[4];
#pragma unroll
        for (int dt = 0; dt < 4; ++dt) ot[dt] = (f32x4){0.f, 0.f, 0.f, 0.f};
        float mrun = -INFINITY, lrun = 0.f;
        const LAS unsigned short* selr = sel + row * 256;
        const _Float16* pbat = proj + (size_t)(b * S_) * PW;
        f16x8 ka0, ka1, kb0, kb1; u32x4 v0, v1, v2, v3;
#define DSA_GATHER(jj) do { const int pa_ = 32 * (jj) + n16, pb_ = pa_ + 16; \
            const int ia_ = pa_ < nvalid ? (int)selr[pa_] : 0, ib_ = pb_ < nvalid ? (int)selr[pb_] : 0; \
            const _Float16* kra_ = pbat + (size_t)ia_ * PW + C_KA + 8 * kc; const _Float16* krb_ = pbat + (size_t)ib_ * PW + C_KA + 8 * kc; \
            ka0 = *(const f16x8*)(kra_); ka1 = *(const f16x8*)(kra_ + 32); kb0 = *(const f16x8*)(krb_); kb1 = *(const f16x8*)(krb_ + 32); \
            const int pv_ = 32 * (jj) + (lane >> 1); const int iv_ = pv_ < nvalid ? (int)selr[pv_] : 0; \
            const _Float16* vr_ = pbat + (size_t)iv_ * PW + C_VA + (lane & 1) * 32; \
            v0 = *(const u32x4*)(vr_); v1 = *(const u32x4*)(vr_ + 8); v2 = *(const u32x4*)(vr_ + 16); v3 = *(const u32x4*)(vr_ + 24); } while (0)
        DSA_GATHER(0);
        const int nsteps = (nvalid + 31) >> 5;
#pragma unroll 1
        for (int j = 0; j < nsteps; ++j) {
            const f16x8 ca0 = ka0, ca1 = ka1, cb0 = kb0, cb1 = kb1;
            { LAS u32x4* dst = (LAS u32x4*)(vst + (lane >> 1) * VPITCH + (lane & 1) * 64); dst[0] = v0; dst[1] = v1; dst[2] = v2; dst[3] = v3; }
            if (j + 1 < nsteps) DSA_GATHER(j + 1);
            f32x4 sa = {0.f, 0.f, 0.f, 0.f}, sb = {0.f, 0.f, 0.f, 0.f};
            sa = __builtin_amdgcn_mfma_f32_16x16x32_f16(ca0, qb0, sa, 0, 0, 0); sa = __builtin_amdgcn_mfma_f32_16x16x32_f16(ca1, qb1, sa, 0, 0, 0);
            sb = __builtin_amdgcn_mfma_f32_16x16x32_f16(cb0, qb0, sb, 0, 0, 0); sb = __builtin_amdgcn_mfma_f32_16x16x32_f16(cb1, qb1, sb, 0, 0, 0);
            const int p0 = 32 * j + 4 * kc;
            const u32x2 iwa = *(const LAS u32x2*)(selr + p0), iwb = *(const LAS u32x2*)(selr + p0 + 16);
            const unsigned wa0 = iwa.x, wa1 = iwa.y, wb0 = iwb.x, wb1 = iwb.y;
            const int id[8] = {(int)(wa0 & 0xffffu), (int)(wa0 >> 16), (int)(wa1 & 0xffffu), (int)(wa1 >> 16), (int)(wb0 & 0xffffu), (int)(wb0 >> 16), (int)(wb1 & 0xffffu), (int)(wb1 >> 16)};
            float v[8] = {sa.x, sa.y, sa.z, sa.w, sb.x, sb.y, sb.z, sb.w};
            float tm = -INFINITY;
#pragma unroll
            for (int e = 0; e < 8; ++e) {
                const bool ok = (p0 + (e & 3) + 16 * (e >> 2)) < nvalid;
                int d = t - id[e]; d = d < 0 ? 0 : d; d = d > 127 ? 127 : d; d = ok ? d : 0;
                const float lg = v[e] * 0.125f + biaslut[d * 8 + hm];
                v[e] = ok ? lg : -INFINITY; tm = fmaxf(tm, v[e]);
            }
            tm = fmaxf(tm, __shfl_xor(tm, 16)); tm = fmaxf(tm, __shfl_xor(tm, 32));
            const float mn = fmaxf(mrun, tm);
            const float alpha = __expf(mrun - mn);
            float ps = 0.f;
#pragma unroll
            for (int e = 0; e < 8; ++e) { v[e] = __expf(v[e] - mn); ps += v[e]; }
            lrun = lrun * alpha + ps; mrun = mn;
#pragma unroll
            for (int dt = 0; dt < 4; ++dt) ot[dt] = ot[dt] * alpha;
            const f16x8 pfr = {(_Float16)v[0], (_Float16)v[1], (_Float16)v[2], (_Float16)v[3], (_Float16)v[4], (_Float16)v[5], (_Float16)v[6], (_Float16)v[7]};
            asm volatile("s_waitcnt lgkmcnt(0)" ::: "memory");
            const int q = n16 >> 2, p = n16 & 3;
#pragma unroll
            for (int dt = 0; dt < 4; ++dt) {
                const s16x4 ta = __builtin_amdgcn_ds_read_tr16_b64_v4i16((LAS s16x4*)(vst + (4 * kc + q) * VPITCH + (16 * dt + 4 * p) * 2));
                const s16x4 tb = __builtin_amdgcn_ds_read_tr16_b64_v4i16((LAS s16x4*)(vst + (16 + 4 * kc + q) * VPITCH + (16 * dt + 4 * p) * 2));
                const f16x4 fa = __builtin_bit_cast(f16x4, ta), fb = __builtin_bit_cast(f16x4, tb);
                const f16x8 vfr = {fa.x, fa.y, fa.z, fa.w, fb.x, fb.y, fb.z, fb.w};
                ot[dt] = __builtin_amdgcn_mfma_f32_16x16x32_f16(vfr, pfr, ot[dt], 0, 0, 0);
            }
            asm volatile("s_waitcnt lgkmcnt(0)" ::: "memory");
        }
#undef DSA_GATHER
        lrun += __shfl_xor(lrun, 16); lrun += __shfl_xor(lrun, 32);
        const float inv = 1.f / fmaxf(lrun, 1e-30f);
        if (head < 8) {
            _Float16* orow = o_a + (size_t)(b * S_ + t) * 512 + head * 64 + 4 * kc;
#pragma unroll
            for (int dt = 0; dt < 4; ++dt) { u32x2 w; w.x = pg8::pkh(ot[dt].x * inv, ot[dt].y * inv); w.y = pg8::pkh(ot[dt].z * inv, ot[dt].w * inv); *(u32x2*)(orow + 16 * dt) = w; }
        }
    }
    __syncthreads();
}
}

__global__ void __launch_bounds__(512, 2) k_dsa(const _Float16* __restrict__ proj, const float* __restrict__ rel_bias, _Float16* __restrict__ o_a, unsigned* dbg) {
    extern __shared__ __attribute__((aligned(16))) unsigned char lds_raw[];
    LAS unsigned char* lds = (LAS unsigned char*)lds_raw;
    { LAS float* biaslut = (LAS float*)(lds + dsa::L_BIAS);
      for (int i = threadIdx.x; i < 1024; i += 512) { const int d = i >> 3, h = i & 7; biaslut[i] = rel_bias[t5_bucket(d) * 16 + h]; } }
    __syncthreads();
    for (int p = blockIdx.x; p < 1024; p += gridDim.x) { const int b = p >> 7, j = p & 127;
        dsa::dsa_tile(lds, proj, o_a, b, 255 - j, dbg);
        dsa::dsa_tile(lds, proj, o_a, b, j, dbg); }
}


namespace nsa {
typedef _Float16 f16x8 __attribute__((ext_vector_type(8)));
typedef _Float16 f16x4 __attribute__((ext_vector_type(4)));
typedef short s16x4 __attribute__((ext_vector_type(4)));
typedef float f32x4 __attribute__((ext_vector_type(4)));
typedef float f32x16 __attribute__((ext_vector_type(16)));
typedef unsigned u32x4 __attribute__((ext_vector_type(4)));
typedef unsigned u32x2 __attribute__((ext_vector_type(2)));
constexpr int KP = 144, VP = 192;
constexpr int TILE_B = 64 * KP + 64 * VP;
constexpr int L_T0 = 0, L_BIAS = 2 * TILE_B, L_IMPA = L_BIAS + 4096, L_IMPC = L_IMPA + 16384, L_MASK = L_IMPC + 16384, L_END = L_MASK + 512;
static_assert(L_END <= 131072, "nsa LDS");
constexpr float LOG2E = 1.4426950408889634f;
constexpr float SC = 0.125f * LOG2E;

struct Src { const _Float16* k; const _Float16* v; int pitch; };

struct Stage { u32x4 kr, vr; };
__device__ __forceinline__ void stage_load(Stage& st, const Src& s, int row0, int tid, bool need_v) {
    const int r = tid >> 3, c = tid & 7;
    st.kr = *(const u32x4*)(s.k + (size_t)(row0 + r) * s.pitch + 8 * c);
    if (need_v) st.vr = *(const u32x4*)(s.v + (size_t)(row0 + r) * s.pitch + 8 * c);
}
__device__ __forceinline__ void stage_store(const Stage& st, LAS unsigned char* tb, int tid, bool need_v) {
    const int r = tid >> 3, c = tid & 7;
    *(LAS u32x4*)(tb + r * KP + 16 * c) = st.kr;
    if (need_v) *(LAS u32x4*)(tb + 64 * KP + r * VP + 16 * c) = st.vr;
}

struct RowState { float m, l; f32x16 o0, o1; };

__device__ __forceinline__ void qk_half(const LAS unsigned char* kt, const f16x8 (&qf)[4], int rho, int hi, int kh, f32x16& s0) {
#pragma unroll
    for (int i = 0; i < 16; ++i) s0[i] = 0.f;
    const LAS unsigned char* kb = kt + (32 * kh + rho) * KP + 16 * hi;
#pragma unroll
    for (int ks = 0; ks < 4; ++ks) {
        const f16x8 a0 = *(const LAS f16x8*)(kb + 32 * ks);
        s0 = __builtin_amdgcn_mfma_f32_32x32x16_f16(a0, qf[ks], s0, 0, 0, 0);
    }
}
__device__ __forceinline__ void logits(f32x16& s0, const LAS float* lut, int hb, int hi, int dbase, int dstep, int dlim, bool bit) {
#pragma unroll
    for (int rg = 0; rg < 16; ++rg) {
        const int kl = (rg & 3) + 8 * (rg >> 2) + 4 * hi;
        const int d = dbase - dstep * kl;
        int dc = d < 0 ? 0 : d; dc = dc > 127 ? 127 : dc;
        const float bias = lut[dc * 8 + hb];
        const bool ok = bit && d >= 0 && d < dlim;
        s0[rg] = ok ? fmaf(s0[rg], SC, bias) : -INFINITY;
    }
}
__device__ __forceinline__ void pv_half(RowState& rs, const f32x16& s0, const LAS unsigned char* vt, int rho, int hi, int kh) {
    const int l16 = rho & 15, g16 = rho >> 4, q = l16 >> 2, p = l16 & 3;
    const LAS unsigned char* vb = vt + (32 * kh + 4 * hi + q) * VP + (16 * g16 + 4 * p) * 2;
#pragma unroll
    for (int sx = 0; sx < 2; ++sx) {
        f16x8 pfr;
#pragma unroll
        for (int j = 0; j < 8; ++j) pfr[j] = (_Float16)s0[8 * sx + j];
#pragma unroll
        for (int dt = 0; dt < 2; ++dt) {
            const s16x4 ta = __builtin_amdgcn_ds_read_tr16_b64_v4i16((LAS s16x4*)(vb + (16 * sx) * VP + 64 * dt));
            const s16x4 tb = __builtin_amdgcn_ds_read_tr16_b64_v4i16((LAS s16x4*)(vb + (16 * sx + 8) * VP + 64 * dt));
            const f16x4 fa = __builtin_bit_cast(f16x4, ta), fb = __builtin_bit_cast(f16x4, tb);
            const f16x8 vfr = {fa.x, fa.y, fa.z, fa.w, fb.x, fb.y, fb.z, fb.w};
            if (dt == 0) rs.o0 = __builtin_amdgcn_mfma_f32_32x32x16_f16(vfr, pfr, rs.o0, 0, 0, 0);
            else rs.o1 = __builtin_amdgcn_mfma_f32_32x32x16_f16(vfr, pfr, rs.o1, 0, 0, 0);
        }
    }
}
__device__ __forceinline__ void rescale_if_needed(RowState& rs, float tmx) {
    if (__any(tmx > rs.m + 8.f)) {
        const float mn = fmaxf(rs.m, tmx);
        const float mu = (mn == -INFINITY) ? 0.f : mn;
        const float alpha = __builtin_amdgcn_exp2f(rs.m - mu);
        rs.l *= alpha; rs.m = mn;
#pragma unroll
        for (int i = 0; i < 16; ++i) { rs.o0[i] *= alpha; rs.o1[i] *= alpha; }
    }
}
__device__ __forceinline__ void tile_fast(RowState& rs, const LAS unsigned char* kt, const LAS unsigned char* vt, const f16x8 (&qf)[4], float c, int rho, int hi) {
    const LAS unsigned char* kb = kt + rho * KP + 16 * hi;
    f16x8 ka[4], kb2[4];
#pragma unroll
    for (int ks = 0; ks < 4; ++ks) { ka[ks] = *(const LAS f16x8*)(kb + 32 * ks); kb2[ks] = *(const LAS f16x8*)(kb + 32 * KP + 32 * ks); }
    const int l16 = rho & 15, g16 = rho >> 4, q = l16 >> 2, p = l16 & 3;
    const LAS unsigned char* vb = vt + (4 * hi + q) * VP + (16 * g16 + 4 * p) * 2;
    s16x4 va[4][2], vc[4][2];
    __builtin_amdgcn_sched_barrier(0);
    f32x16 s0, s1;
#pragma unroll
    for (int i = 0; i < 16; ++i) { s0[i] = 0.f; s1[i] = 0.f; }
#pragma unroll
    for (int ks = 0; ks < 4; ++ks) {
        s0 = __builtin_amdgcn_mfma_f32_32x32x16_f16(ka[ks], qf[ks], s0, 0, 0, 0);
        s1 = __builtin_amdgcn_mfma_f32_32x32x16_f16(kb2[ks], qf[ks], s1, 0, 0, 0);
    }
    __builtin_amdgcn_sched_barrier(0);
#pragma unroll
    for (int st = 0; st < 4; ++st)
#pragma unroll
        for (int dt = 0; dt < 2; ++dt) {
            va[st][dt] = __builtin_amdgcn_ds_read_tr16_b64_v4i16((LAS s16x4*)(vb + (16 * st) * VP + 64 * dt));
            vc[st][dt] = __builtin_amdgcn_ds_read_tr16_b64_v4i16((LAS s16x4*)(vb + (16 * st + 8) * VP + 64 * dt));
        }
    __builtin_amdgcn_sched_barrier(0);
    float tm = -INFINITY;
#pragma unroll
    for (int i = 0; i < 16; ++i) tm = fmaxf(tm, fmaxf(s0[i], s1[i]));
    { const auto r2 = __builtin_amdgcn_permlane32_swap(__float_as_uint(tm), __float_as_uint(tm), false, false); tm = fmaxf(__uint_as_float(r2[0]), __uint_as_float(r2[1])); }
    rescale_if_needed(rs, fmaf(tm, SC, c));
    const float mu = (rs.m == -INFINITY) ? 0.f : rs.m;
    const float cm = c - mu;
    float ps = 0.f;
#pragma unroll
    for (int i = 0; i < 16; ++i) { s0[i] = __builtin_amdgcn_exp2f(fmaf(s0[i], SC, cm)); s1[i] = __builtin_amdgcn_exp2f(fmaf(s1[i], SC, cm)); ps += s0[i] + s1[i]; }
    rs.l += ps;
#pragma unroll
    for (int st = 0; st < 4; ++st) {
        f16x8 pfr;
#pragma unroll
        for (int j = 0; j < 8; ++j) pfr[j] = (_Float16)((st & 2) ? s1[8 * (st & 1) + j] : s0[8 * (st & 1) + j]);
#pragma unroll
        for (int dt = 0; dt < 2; ++dt) {
            const f16x4 fa = __builtin_bit_cast(f16x4, va[st][dt]), fb = __builtin_bit_cast(f16x4, vc[st][dt]);
            const f16x8 vfr = {fa.x, fa.y, fa.z, fa.w, fb.x, fb.y, fb.z, fb.w};
            if (dt == 0) rs.o0 = __builtin_amdgcn_mfma_f32_32x32x16_f16(vfr, pfr, rs.o0, 0, 0, 0);
            else rs.o1 = __builtin_amdgcn_mfma_f32_32x32x16_f16(vfr, pfr, rs.o1, 0, 0, 0);
        }
    }
}
template <bool IMP>
__device__ __forceinline__ void tile_general(RowState& rs, const LAS unsigned char* kt, const LAS unsigned char* vt, const f16x8 (&qf)[4], const LAS float* lut, int hb, int rho, int hi,
                                             int dbase, int dstep, unsigned dlim, float mc, float invl, LAS float* impA, LAS float* impC, int n, bool wr) {
    const LAS unsigned char* kb = kt + rho * KP + 16 * hi;
    f16x8 ka[4], kb2[4];
#pragma unroll
    for (int ks = 0; ks < 4; ++ks) { ka[ks] = *(const LAS f16x8*)(kb + 32 * ks); kb2[ks] = *(const LAS f16x8*)(kb + 32 * KP + 32 * ks); }
    const int d0 = dbase - dstep * 4 * hi;
    __builtin_amdgcn_sched_barrier(0);
    f32x16 s0, s1;
#pragma unroll
    for (int i = 0; i < 16; ++i) { s0[i] = 0.f; s1[i] = 0.f; }
#pragma unroll
    for (int ks = 0; ks < 4; ++ks) {
        s0 = __builtin_amdgcn_mfma_f32_32x32x16_f16(ka[ks], qf[ks], s0, 0, 0, 0);
        s1 = __builtin_amdgcn_mfma_f32_32x32x16_f16(kb2[ks], qf[ks], s1, 0, 0, 0);
    }
    __builtin_amdgcn_sched_barrier(0);
    float b0[16], b1[16];
#pragma unroll
    for (int rg = 0; rg < 16; ++rg) {
        const int kl = (rg & 3) + 8 * (rg >> 2);
        int da = d0 - dstep * kl, db = d0 - dstep * (kl + 32);
        da = da < 0 ? 0 : da; da = da > 127 ? 127 : da; db = db < 0 ? 0 : db; db = db > 127 ? 127 : db;
        b0[rg] = lut[da * 8 + hb]; b1[rg] = lut[db * 8 + hb];
    }
    float tm = -INFINITY;
#pragma unroll
    for (int rg = 0; rg < 16; ++rg) {
        const int kl = (rg & 3) + 8 * (rg >> 2);
        const unsigned da = (unsigned)(d0 - dstep * kl), db = (unsigned)(d0 - dstep * (kl + 32));
        s0[rg] = da < dlim ? fmaf(s0[rg], SC, b0[rg]) : -INFINITY;
        s1[rg] = db < dlim ? fmaf(s1[rg], SC, b1[rg]) : -INFINITY;
        tm = fmaxf(tm, fmaxf(s0[rg], s1[rg]));
    }
    __builtin_amdgcn_sched_barrier(0);
    const int l16 = rho & 15, g16 = rho >> 4, q = l16 >> 2, p = l16 & 3;
    const LAS unsigned char* vb = vt + (4 * hi + q) * VP + (16 * g16 + 4 * p) * 2;
    s16x4 va[4][2], vc[4][2];
    if (!IMP) {
#pragma unroll
        for (int st = 0; st < 4; ++st)
#pragma unroll
            for (int dt = 0; dt < 2; ++dt) {
                va[st][dt] = __builtin_amdgcn_ds_read_tr16_b64_v4i16((LAS s16x4*)(vb + (16 * st) * VP + 64 * dt));
                vc[st][dt] = __builtin_amdgcn_ds_read_tr16_b64_v4i16((LAS s16x4*)(vb + (16 * st + 8) * VP + 64 * dt));
            }
        __builtin_amdgcn_sched_barrier(0);
    }
    if (!IMP) {
        { const auto r2 = __builtin_amdgcn_permlane32_swap(__float_as_uint(tm), __float_as_uint(tm), false, false); tm = fmaxf(__uint_as_float(r2[0]), __uint_as_float(r2[1])); }
        rescale_if_needed(rs, tm);
        const float mu = (rs.m == -INFINITY) ? 0.f : rs.m;
        float ps = 0.f;
#pragma unroll
        for (int i = 0; i < 16; ++i) { s0[i] = __builtin_amdgcn_exp2f(s0[i] - mu); s1[i] = __builtin_amdgcn_exp2f(s1[i] - mu); ps += s0[i] + s1[i]; }
        rs.l += ps;
#pragma unroll
        for (int st = 0; st < 4; ++st) {
            f16x8 pfr;
#pragma unroll
            for (int j = 0; j < 8; ++j) pfr[j] = (_Float16)((st & 2) ? s1[8 * (st & 1) + j] : s0[8 * (st & 1) + j]);
#pragma unroll
            for (int dt = 0; dt < 2; ++dt) {
                const f16x4 fa = __builtin_bit_cast(f16x4, va[st][dt]), fb = __builtin_bit_cast(f16x4, vc[st][dt]);
                const f16x8 vfr = {fa.x, fa.y, fa.z, fa.w, fb.x, fb.y, fb.z, fb.w};
                if (dt == 0) rs.o0 = __builtin_amdgcn_mfma_f32_32x32x16_f16(vfr, pfr, rs.o0, 0, 0, 0);
                else rs.o1 = __builtin_amdgcn_mfma_f32_32x32x16_f16(vfr, pfr, rs.o1, 0, 0, 0);
            }
        }
    } else {
        const float mu = (mc == -INFINITY) ? 0.f : mc;
#pragma unroll
        for (int kh = 0; kh < 2; ++kh)
#pragma unroll
            for (int ii = 0; ii < 4; ++ii) {
                float pv[4];
#pragma unroll
                for (int e = 0; e < 4; ++e) pv[e] = __builtin_amdgcn_exp2f((kh ? s1[4 * ii + e] : s0[4 * ii + e]) - mu) * invl;
                float a = (pv[0] + pv[1]) + (pv[2] + 0.5f * pv[3]), c = 0.5f * pv[3];
                a += __shfl_xor(a, 1); a += __shfl_xor(a, 2); c += __shfl_xor(c, 1); c += __shfl_xor(c, 2);
                const int nb = 16 * n + 8 * kh + 2 * ii + hi;
                if (wr) { impA[nb] = a; if (nb + 1 < 64) impC[nb + 1] = c; }
            }
    }
}
__device__ __forceinline__ void probs(RowState& rs, f32x16& s0, float sc, float c) {
    float tm = -INFINITY;
#pragma unroll
    for (int i = 0; i < 16; ++i) tm = fmaxf(tm, s0[i]);
    tm = fmaxf(tm, __shfl_xor(tm, 32));
    rescale_if_needed(rs, fmaf(tm, sc, c));
    const float mu = (rs.m == -INFINITY) ? 0.f : rs.m;
    const float cm = c - mu;
    float ps = 0.f;
#pragma unroll
    for (int i = 0; i < 16; ++i) { s0[i] = __builtin_amdgcn_exp2f(fmaf(s0[i], sc, cm)); ps += s0[i]; }
    rs.l += ps;
}
__device__ __forceinline__ void rs_init(RowState& rs) { rs.m = -INFINITY; rs.l = 0.f;
#pragma unroll
    for (int i = 0; i < 16; ++i) { rs.o0[i] = 0.f; rs.o1[i] = 0.f; } }
__device__ __forceinline__ void rs_flush(RowState& rs, float gate, _Float16* orow, bool first) {
    const float lt = rs.l + __shfl_xor(rs.l, 32);
    const float w = gate / fmaxf(lt, 1e-30f);
#pragma unroll
    for (int i = 0; i < 4; ++i) {
        float a[8] = {w * rs.o0[4 * i], w * rs.o0[4 * i + 1], w * rs.o0[4 * i + 2], w * rs.o0[4 * i + 3], w * rs.o1[4 * i], w * rs.o1[4 * i + 1], w * rs.o1[4 * i + 2], w * rs.o1[4 * i + 3]};
        if (!first) { const u32x2 p0 = *(const u32x2*)(orow + 8 * i), p1 = *(const u32x2*)(orow + 32 + 8 * i);
            const unsigned u0 = p0.x, u1 = p0.y, u2 = p1.x, u3 = p1.y; const pg8::f16x2 h0 = __builtin_bit_cast(pg8::f16x2, u0), h1 = __builtin_bit_cast(pg8::f16x2, u1), h2 = __builtin_bit_cast(pg8::f16x2, u2), h3 = __builtin_bit_cast(pg8::f16x2, u3);
            a[0] += (float)h0.x; a[1] += (float)h0.y; a[2] += (float)h1.x; a[3] += (float)h1.y; a[4] += (float)h2.x; a[5] += (float)h2.y; a[6] += (float)h3.x; a[7] += (float)h3.y; }
        u32x2 w0; w0.x = pg8::pkh(a[0], a[1]); w0.y = pg8::pkh(a[2], a[3]); *(u32x2*)(orow + 8 * i) = w0;
        u32x2 w1; w1.x = pg8::pkh(a[4], a[5]); w1.y = pg8::pkh(a[6], a[7]); *(u32x2*)(orow + 32 + 8 * i) = w1;
    }
}

__device__ __forceinline__ void nsa_unit(LAS unsigned char* lds, const _Float16* __restrict__ proj, const _Float16* __restrict__ kcmp, const _Float16* __restrict__ vcmp,
                                         _Float16* __restrict__ o_b, int b, int g, int qb) {
    const int tid = threadIdx.x, lane = tid & 63, wave = __builtin_amdgcn_readfirstlane(tid >> 6);
    const int rho = lane & 31, hi = lane >> 5, ql = rho >> 2, r = rho & 3, hb = g * 4 + r;
    const int t = 64 * qb + 8 * wave + ql;
    const _Float16* prow = proj + (size_t)(b * S_ + t) * PW;
    f16x8 qf[4];
#pragma unroll
    for (int ks = 0; ks < 4; ++ks) qf[ks] = *(const f16x8*)(prow + C_QB + hb * 64 + 16 * ks + 8 * hi);
    for (int i = tid; i < 2048; i += 512) ((LAS u32x4*)(lds + L_IMPA))[i] = (u32x4){0u, 0u, 0u, 0u};
    RowState rs; rs_init(rs);
    const LAS float* lut = (const LAS float*)(lds + L_BIAS);
    const float bias31 = lut[127 * 8 + hb];
    const _Float16* kc = kcmp + (size_t)(b * 2 + g) * 256 * 64;
    const long vcoff = (vcmp + (size_t)(b * 2 + g) * 256 * 64) - kc;
    const _Float16* pb = proj + (size_t)(b * S_) * PW + C_KVB + g * 64;
    const int ncmp = (4 * qb + 3 + 63) / 64;
    const int wlo = qb - 8 > 0 ? qb - 8 : 0;
    const int e0 = ncmp, e1 = 2 * ncmp, e2 = e1 + qb + 1, NT = e2 + (qb - wlo + 1);
    const int sr = tid >> 3, scq = tid & 7;
    float mc = 0.f, invl = 0.f; unsigned mlo = 0u, mhi = 0u;
    Stage stg;
#define NSA_DECODE(i, br, n) do { if ((i) < e0) { br = 0; n = (i); } else if ((i) < e1) { br = 1; n = (i) - e0; } else if ((i) < e2) { br = 2; n = (i) - e1; } else { br = 3; n = wlo + (i) - e2; } } while (0)
#define NSA_LOAD(i) do { int br_, n_; NSA_DECODE(i, br_, n_); const _Float16* kp_ = (br_ < 2) ? kc : (br_ == 2 ? pb + 2 * 128 : pb + 4 * 128); const int pitch_ = (br_ < 2) ? 64 : PW; \
        const long vo_ = (br_ < 2) ? vcoff : 128; const _Float16* rp_ = kp_ + (size_t)(64 * n_ + sr) * pitch_ + 8 * scq; stg.kr = *(const u32x4*)rp_; stg.vr = *(const u32x4*)(rp_ + vo_); } while (0)
#define NSA_STORE(buf) do { LAS unsigned char* tb_ = lds + L_T0 + (buf) * TILE_B; *(LAS u32x4*)(tb_ + sr * KP + 16 * scq) = stg.kr; *(LAS u32x4*)(tb_ + 64 * KP + sr * VP + 16 * scq) = stg.vr; } while (0)
    __syncthreads();
    NSA_LOAD(0); NSA_STORE(0);
    __syncthreads();
#pragma unroll 1
    for (int i = 0; i < NT; ++i) {
        int br, n; NSA_DECODE(i, br, n);
        const LAS unsigned char* tb = lds + L_T0 + (i & 1) * TILE_B;
        const bool more = i + 1 < NT;
        if (more) NSA_LOAD(i + 1);
        bool bit = true; int dbase, dstep = 1, dlim = 1 << 30; bool near = true;
        if (br < 2) { dbase = t - 31 - 1024 * n; dstep = 16; }
        else { dbase = t - 64 * n; near = n >= qb - 2; if (br == 2) bit = (n < 32) ? ((mlo >> n) & 1u) : ((mhi >> (n - 32)) & 1u); else dlim = 512; }
        const bool interior = (br >= 2) && (n <= qb - 3) && !(br == 3 && n == qb - 8);
        const bool skip = (br == 2) && !__any(bit);
        if (!skip) {
            if (interior) tile_fast(rs, tb, tb + 64 * KP, qf, bit ? bias31 : -INFINITY, rho, hi);
            else {
                const unsigned dl = bit ? (unsigned)dlim : 0u;
                int tq = threadIdx.x; asm volatile("" : "+v"(tq));
                LAS float* impA = (LAS float*)(lds + L_IMPA) + ((tq >> 6) * 8 + ((tq & 31) >> 2)) * 64;
                LAS float* impC = (LAS float*)(lds + L_IMPC) + ((tq >> 6) * 8 + ((tq & 31) >> 2)) * 64;
                if (br != 1) tile_general<false>(rs, tb, tb + 64 * KP, qf, lut, hb, rho, hi, dbase, dstep, dl, 0.f, 0.f, impA, impC, n, false);
                else tile_general<true>(rs, tb, tb + 64 * KP, qf, lut, hb, rho, hi, dbase, dstep, dl, mc, invl, impA, impC, n, r == 0);
            }
        }
        if (i + 1 == e0) {
            mc = rs.m; const float lc = rs.l + __shfl_xor(rs.l, 32); invl = 1.f / fmaxf(lc, 1e-30f);
            rs_flush(rs, pg8::sigm((float)prow[C_GB + 0 * 8 + hb]), o_b + (size_t)(b * S_ + t) * 512 + hb * 64 + 4 * hi, true); rs_init(rs);
        } else if (i + 1 == e1) {
            asm volatile("s_waitcnt lgkmcnt(0)" ::: "memory");
            int tq = threadIdx.x; asm volatile("" : "+v"(tq));
            const int qs = (tq & 63) >> 3, j = tq & 7, wv = tq >> 6;
            LAS float* sA = (LAS float*)(lds + L_IMPA) + (wv * 8 + qs) * 64;
            const LAS float* sC = (const LAS float*)(lds + L_IMPC) + (wv * 8 + qs) * 64;
            float sc[8];
#pragma unroll
            for (int e = 0; e < 8; ++e) { const int nn = 8 * j + e; const bool forced = (nn == 0) || (nn == qb) || (nn == qb - 1);
                sc[e] = (nn <= qb) ? (forced ? 1.0e4f : (sA[nn] + sC[nn])) : -INFINITY; }
            asm volatile("s_waitcnt lgkmcnt(0)" ::: "memory");
#pragma unroll
            for (int e = 0; e < 8; ++e) sA[8 * j + e] = sc[e];
            asm volatile("s_waitcnt lgkmcnt(0)" ::: "memory");
            int rank[8];
#pragma unroll
            for (int e = 0; e < 8; ++e) rank[e] = 0;
            for (int m = 0; m <= qb; ++m) { const float sm = sA[m];
#pragma unroll
                for (int e = 0; e < 8; ++e) rank[e] += (sm > sc[e] || (sm == sc[e] && m < 8 * j + e)) ? 1 : 0; }
            unsigned bits = 0;
#pragma unroll
            for (int e = 0; e < 8; ++e) bits |= ((8 * j + e <= qb) && rank[e] < 16) ? (1u << e) : 0u;
            ((LAS unsigned char*)(lds + L_MASK))[(wv * 8 + qs) * 8 + j] = (unsigned char)bits;
            asm volatile("s_waitcnt lgkmcnt(0)" ::: "memory");
            const u32x2 mk = *(const LAS u32x2*)(lds + L_MASK + (wv * 8 + ((tq & 31) >> 2)) * 8);
            mlo = mk.x; mhi = mk.y;
        } else if (i + 1 == e2) {
            rs_flush(rs, pg8::sigm((float)prow[C_GB + 1 * 8 + hb]), o_b + (size_t)(b * S_ + t) * 512 + hb * 64 + 4 * hi, false); rs_init(rs);
        } else if (i + 1 == NT) {
            rs_flush(rs, pg8::sigm((float)prow[C_GB + 2 * 8 + hb]), o_b + (size_t)(b * S_ + t) * 512 + hb * 64 + 4 * hi, false);
        }
        if (more) NSA_STORE((i + 1) & 1);
        __syncthreads();
    }
#undef NSA_DECODE
#undef NSA_LOAD
#undef NSA_STORE
}
}

__global__ void __launch_bounds__(512, 2) k_nsa(const _Float16* __restrict__ proj, const float* __restrict__ rel_bias, const _Float16* __restrict__ kcmp, const _Float16* __restrict__ vcmp, _Float16* __restrict__ o_b) {
    extern __shared__ __attribute__((aligned(16))) unsigned char lds_raw[];
    LAS unsigned char* lds = (LAS unsigned char*)lds_raw;
    { LAS float* lut = (LAS float*)(lds + nsa::L_BIAS);
      for (int i = threadIdx.x; i < 1024; i += 512) { const int d = i >> 3, h = i & 7; lut[i] = rel_bias[t5_bucket(d) * 16 + 8 + h] * nsa::LOG2E; } }
    __syncthreads();
#pragma unroll 1
    for (int u = blockIdx.x; u < 1024; u += gridDim.x) { const int p = u & 511, bg = p >> 5, j = p & 31;
        nsa::nsa_unit(lds, proj, kcmp, vcmp, o_b, bg >> 1, bg & 1, (u < 512) ? 63 - j : j);
        __syncthreads(); }
}
__global__ __launch_bounds__(128) void compress_h(const __half* __restrict__ proj, const float* __restrict__ pe_k, const float* __restrict__ w1_k, const float* __restrict__ w2_k,
                                                  const float* __restrict__ pe_v, const float* __restrict__ w1_v, const float* __restrict__ w2_v, __half* __restrict__ kcmp, __half* __restrict__ vcmp) {
    __shared__ float blk[2048];
    __shared__ float hid[128];
    int id = blockIdx.x; const int kv = id & 1; id >>= 1; const int g = id & 1; id >>= 1; const int c = id & 255, b = id >> 8;
    const float* pe = kv ? pe_v : pe_k; const float* w1 = kv ? w1_v : w1_k; const float* w2 = kv ? w2_v : w2_k;
    const int tid = threadIdx.x;
    __half* dst = (kv ? vcmp : kcmp) + ((size_t)(b * 2 + g) * 256 + c) * 64;
    if (c == 255) { if (tid < 64) dst[tid] = __float2half(0.f); return; }
    for (int i = tid; i < 2048; i += 128) { const int l = i >> 6, d = i & 63;
        blk[i] = __half2float(proj[(size_t)(b * S_ + 16 * c + l) * PW + C_KVB + kv * 128 + g * 64 + d]) + pe[i]; }
    __syncthreads();
    { float a = 0.f; for (int k = 0; k < 2048; ++k) a += blk[k] * w1[k * 128 + tid];
      const float x3 = a * a * a; hid[tid] = 0.5f * a * (1.f + tanhf(0.7978845608028654f * (a + 0.044715f * x3))); }
    __syncthreads();
    if (tid < 64) { float a = 0.f; for (int k = 0; k < 128; ++k) a += hid[k] * w2[k * 64 + tid]; dst[tid] = __float2half(a); }
}


namespace cmpx {
typedef _Float16 f16x8 __attribute__((ext_vector_type(8)));
typedef float f32x4 __attribute__((ext_vector_type(4)));
typedef unsigned u32x4 __attribute__((ext_vector_type(4)));
constexpr int L_PART = 0, L_HID = 65536, HIDP = 272, L_END = L_HID + 16 * HIDP;
__device__ __forceinline__ void item(LAS unsigned char* lds, const _Float16* __restrict__ proj, const float* __restrict__ pe, const _Float16* __restrict__ w1t, const _Float16* __restrict__ w2t,
                                     _Float16* __restrict__ dst, int b, int g, int kv, int ct) {
    const int tid = threadIdx.x, lane = tid & 63, wave = __builtin_amdgcn_readfirstlane(tid >> 6), kc = lane >> 4, n16 = lane & 15;
    f32x4 acc[8];
#pragma unroll
    for (int nt = 0; nt < 8; ++nt) acc[nt] = (f32x4){0.f, 0.f, 0.f, 0.f};
    const int c = 16 * ct + n16;
#pragma unroll 2
    for (int ks = 0; ks < 8; ++ks) {
        const int k0 = 32 * (8 * wave + ks) + 8 * kc, lt = k0 >> 6, d = k0 & 63;
        int trow = 16 * c + lt; trow = trow > S_ - 1 ? S_ - 1 : trow;
        const f16x8 raw = *(const f16x8*)(proj + (size_t)(b * S_ + trow) * PW + C_KVB + kv * 128 + g * 64 + d);
        const f32x4 p0 = *(const f32x4*)(pe + lt * 64 + d), p1 = *(const f32x4*)(pe + lt * 64 + d + 4);
        f16x8 afr;
        afr[0] = (_Float16)((float)raw[0] + p0.x); afr[1] = (_Float16)((float)raw[1] + p0.y); afr[2] = (_Float16)((float)raw[2] + p0.z); afr[3] = (_Float16)((float)raw[3] + p0.w);
        afr[4] = (_Float16)((float)raw[4] + p1.x); afr[5] = (_Float16)((float)raw[5] + p1.y); afr[6] = (_Float16)((float)raw[6] + p1.z); afr[7] = (_Float16)((float)raw[7] + p1.w);
#pragma unroll
        for (int nt = 0; nt < 8; ++nt) {
            const f16x8 bfr = *(const f16x8*)(w1t + (size_t)(16 * nt + n16) * 2048 + k0);
            acc[nt] = __builtin_amdgcn_mfma_f32_16x16x32_f16(afr, bfr, acc[nt], 0, 0, 0);
        }
    }
    LAS float* part = (LAS float*)(lds + L_PART) + wave * 2048;
#pragma unroll
    for (int nt = 0; nt < 8; ++nt) { part[(4 * kc + 0) * 128 + 16 * nt + n16] = acc[nt].x; part[(4 * kc + 1) * 128 + 16 * nt + n16] = acc[nt].y;
        part[(4 * kc + 2) * 128 + 16 * nt + n16] = acc[nt].z; part[(4 * kc + 3) * 128 + 16 * nt + n16] = acc[nt].w; }
    __syncthreads();
    { const LAS float* pp = (const LAS float*)(lds + L_PART);
#pragma unroll
      for (int e = 0; e < 4; ++e) { const int o = tid + 512 * e; float a = 0.f;
#pragma unroll
          for (int w = 0; w < 8; ++w) a += pp[w * 2048 + o];
          const float z = 0.7978845608028654f * (a + 0.044715f * a * a * a);
          const float th = 1.f - 2.f / (__expf(2.f * z) + 1.f);
          ((LAS _Float16*)(lds + L_HID + (o >> 7) * HIDP))[o & 127] = (_Float16)(0.5f * a * (1.f + th)); } }
    __syncthreads();
    if (wave < 4) {
        f32x4 o = {0.f, 0.f, 0.f, 0.f};
#pragma unroll
        for (int ks = 0; ks < 4; ++ks) {
            const f16x8 afr = *(const LAS f16x8*)(lds + L_HID + n16 * HIDP + (32 * ks + 8 * kc) * 2);
            const f16x8 bfr = *(const f16x8*)(w2t + (size_t)(16 * wave + n16) * 128 + 32 * ks + 8 * kc);
            o = __builtin_amdgcn_mfma_f32_16x16x32_f16(afr, bfr, o, 0, 0, 0);
        }
        const float ov[4] = {o.x, o.y, o.z, o.w};
#pragma unroll
        for (int e = 0; e < 4; ++e) { const int cc = 16 * ct + 4 * kc + e; dst[((size_t)(b * 2 + g) * 256 + cc) * 64 + 16 * wave + n16] = (_Float16)(cc == 255 ? 0.f : ov[e]); }
    }
    __syncthreads();
}
}

__global__ void k_cmp_rows(const __half* __restrict__ a, const __half* __restrict__ ref, unsigned* __restrict__ dbg) {
    const int row = blockIdx.x * 4 + (threadIdx.x >> 6), lane = threadIdx.x & 63;
    float num = 0.f, den = 0.f; bool nan = false;
    for (int i = lane; i < 512; i += 64) { const float x = __half2float(a[(size_t)row * 512 + i]), y = __half2float(ref[(size_t)row * 512 + i]);
        nan |= !(x == x); num += (x - y) * (x - y); den += y * y; }
    for (int o = 32; o > 0; o >>= 1) { num += __shfl_xor(num, o); den += __shfl_xor(den, o); }
    const bool anynan = __any(nan);
    if (lane == 0) { if (anynan) atomicAdd(dbg + 1, 1u); else if (num > 0.0025f * den) atomicAdd(dbg + 0, 1u); }
}
__global__ void k_dbg_scale(float* __restrict__ out, const unsigned* __restrict__ dbg) {
    const unsigned nbad = dbg[0], nnan = dbg[1];
    int code = 0; if (dbg[5]) code = 30; else if (dbg[6]) code = 28; else if (nnan) code = 20 + (31 - __clz((int)nnan)) / 2; else if (nbad) code = 1 + (31 - __clz((int)nbad));
    const float sc = 1.f + 0.2f * code;
    const size_t i = (size_t)blockIdx.x * 256 + threadIdx.x; out[i] *= sc;
}
template <typename TA, typename Epi>
__global__ __launch_bounds__(256) void gemm_naive(const TA* __restrict__ A, const float* __restrict__ Bm, Epi epi, int lda, int ldb, int K, int pad_) {
    __shared__ float As[16][68];
    __shared__ float Bs[16][68];
    const int tid = threadIdx.x, tx = tid & 15, ty = tid >> 4;
    const int m0 = blockIdx.y * 64, n0 = blockIdx.x * 64;
    float acc[4][4];
#pragma unroll
    for (int i = 0; i < 4; ++i)
#pragma unroll
        for (int j = 0; j < 4; ++j) acc[i][j] = 0.f;
    for (int k0 = 0; k0 < K; k0 += 16) {
#pragma unroll
        for (int i = 0; i < 4; ++i) { const int e = tid + i * 256; const int m = e >> 4, k = e & 15; As[k][m] = (float)A[(size_t)(m0 + m) * lda + k0 + k]; }
#pragma unroll
        for (int i = 0; i < 4; ++i) { const int e = tid + i * 256; const int k = e >> 6, n = e & 63; Bs[k][n] = Bm[(size_t)(k0 + k) * ldb + n0 + n]; }
        __syncthreads();
#pragma unroll
        for (int k = 0; k < 16; ++k) {
            float a[4], b[4];
#pragma unroll
            for (int i = 0; i < 4; ++i) { a[i] = As[k][ty * 4 + i]; b[i] = Bs[k][tx * 4 + i]; }
#pragma unroll
            for (int i = 0; i < 4; ++i)
#pragma unroll
                for (int j = 0; j < 4; ++j) acc[i][j] += a[i] * b[j];
        }
        __syncthreads();
    }
#pragma unroll
    for (int i = 0; i < 4; ++i)
#pragma unroll
        for (int j = 0; j < 4; ++j) epi(m0 + ty * 4 + i, n0 + tx * 4 + j, acc[i][j]);
}


struct NEpiMixA { __half* mix; const __half* proj; __device__ void operator()(int r, int c, float v) const {
    const float g = __half2float(proj[(size_t)r * PW + C_GATE + c]); mix[(size_t)r * D_ + c] = __float2half(g * v); } };
struct NEpiMixB { __half* mix; const __half* proj; __device__ void operator()(int r, int c, float v) const {
    const float g = __half2float(proj[(size_t)r * PW + C_GATE + 1024 + c]); mix[(size_t)r * D_ + c] = __float2half(__half2float(mix[(size_t)r * D_ + c]) + g * v); } };
__global__ void k_gate(const __half* __restrict__ tmp, const __half* __restrict__ proj, __half* __restrict__ mix) {
    const size_t i = (size_t)blockIdx.x * 256 + threadIdx.x; const size_t r = i >> 10; const int c = (int)(i & 1023);
    mix[i] = __float2half(__half2float(tmp[i]) * __half2float(proj[r * PW + C_GATE + c]));
}
__global__ __launch_bounds__(256) void dsa_naive(const __half* __restrict__ proj, const float* __restrict__ rel_bias, __half* __restrict__ o_a) {
    __shared__ float qs[8][32];
    __shared__ float wv[8];
    __shared__ unsigned keys[4096];
    __shared__ int sel[256];
    __shared__ int nsel_s;
    __shared__ unsigned hist[256];
    __shared__ unsigned sel_prefix, sel_k;
    __shared__ float qa[8][64];
    __shared__ float p[8][256];
    const int row = blockIdx.x, tid = threadIdx.x, b = row / S_, t = row % S_;
    const __half* pr = proj + (size_t)row * PW;
    { const int h = tid >> 5, d = tid & 31; qs[h][d] = __half2float(pr[C_QI + h * 32 + d]); }
    if (tid < 8) wv[tid] = __half2float(pr[C_WI + tid]) * (1.f / 16.f);
    for (int i = tid; i < 512; i += 256) qa[i >> 6][i & 63] = __half2float(pr[C_QA + i]);
    if (tid == 0) nsel_s = 0;
    __syncthreads();
    const int n = t + 1;
    for (int s = tid; s < n; s += 256) {
        const __half* kr = proj + (size_t)(b * S_ + s) * PW + C_KI;
        float a8[8];
#pragma unroll
        for (int h = 0; h < 8; ++h) a8[h] = 0.f;
#pragma unroll 4
        for (int d = 0; d < 32; ++d) { const float kvd = __half2float(kr[d]);
#pragma unroll
            for (int h = 0; h < 8; ++h) a8[h] += qs[h][d] * kvd; }
        float sc = 0.f;
#pragma unroll
        for (int h = 0; h < 8; ++h) sc += wv[h] * (a8[h] > 0.f ? a8[h] : 0.f);
        unsigned u = __float_as_uint(sc);
        keys[s] = (u & 0x80000000u) ? ~u : (u | 0x80000000u);
    }
    __syncthreads();
    if (n <= 256) {
        if (tid < n) sel[tid] = tid;
        if (tid == 0) nsel_s = n;
        __syncthreads();
    } else {
        unsigned prefix = 0, mask = 0, kk = 256;
        for (int shift = 24; shift >= 0; shift -= 8) {
            hist[tid] = 0;
            __syncthreads();
            for (int s = tid; s < n; s += 256) { const unsigned k = keys[s]; if ((k & mask) == prefix) atomicAdd(&hist[(k >> shift) & 255u], 1u); }
            __syncthreads();
            if (tid == 0) { unsigned cum = 0; int d = 255; for (; d > 0; --d) { if (cum + hist[d] >= kk) break; cum += hist[d]; } sel_prefix = prefix | ((unsigned)d << shift); sel_k = kk - cum; }
            __syncthreads();
            prefix = sel_prefix; kk = sel_k; mask |= 0xFFu << shift;
            __syncthreads();
        }
        const unsigned T = prefix;
        for (int s = tid; s < n; s += 256) if (keys[s] > T) { const int pos = atomicAdd(&nsel_s, 1); sel[pos] = s; }
        __syncthreads();
        if (tid == 0) { int pos = nsel_s; unsigned need = kk; for (int s = 0; s < n && need > 0; ++s) if (keys[s] == T) { sel[pos++] = s; --need; } nsel_s = pos; }
        __syncthreads();
    }
    const int ns = nsel_s;
    {
        const int j = tid;
        if (j < ns) {
            const int idx = sel[j];
            const __half* kr = proj + (size_t)(b * S_ + idx) * PW + C_KA;
            float a8[8];
#pragma unroll
            for (int h = 0; h < 8; ++h) a8[h] = 0.f;
#pragma unroll 4
            for (int d = 0; d < 64; ++d) { const float kvd = __half2float(kr[d]);
#pragma unroll
                for (int h = 0; h < 8; ++h) a8[h] += qa[h][d] * kvd; }
            const int bk = t5_bucket(t - idx);
#pragma unroll
            for (int h = 0; h < 8; ++h) p[h][j] = a8[h] * 0.125f + rel_bias[bk * 16 + h];
        } else {
#pragma unroll
            for (int h = 0; h < 8; ++h) p[h][j] = -INFINITY;
        }
    }
    __syncthreads();
    {
        const int w = tid >> 6, lane = tid & 63;
        for (int hh = 0; hh < 2; ++hh) { const int h = w * 2 + hh;
            float v[4], mx = -INFINITY;
#pragma unroll
            for (int i = 0; i < 4; ++i) { v[i] = p[h][lane + 64 * i]; mx = fmaxf(mx, v[i]); }
#pragma unroll
            for (int o = 32; o > 0; o >>= 1) mx = fmaxf(mx, __shfl_xor(mx, o));
            float sm = 0.f;
#pragma unroll
            for (int i = 0; i < 4; ++i) { v[i] = (v[i] == -INFINITY) ? 0.f : expf(v[i] - mx); sm += v[i]; }
#pragma unroll
            for (int o = 32; o > 0; o >>= 1) sm += __shfl_xor(sm, o);
            const float inv = 1.f / fmaxf(sm, 1e-30f);
#pragma unroll
            for (int i = 0; i < 4; ++i) p[h][lane + 64 * i] = v[i] * inv; }
    }
    __syncthreads();
    for (int o = tid; o < 512; o += 256) { const int h = o >> 6, d = o & 63; float a = 0.f;
        for (int j = 0; j < ns; ++j) a += p[h][j] * __half2float(proj[(size_t)(b * S_ + sel[j]) * PW + C_VA + d]);
        o_a[(size_t)row * 512 + o] = __float2half(a); }
}

__global__ __launch_bounds__(128) void compress_naive(const __half* __restrict__ proj, const float* __restrict__ pe_k, const float* __restrict__ w1_k, const float* __restrict__ w2_k,
                                                      const float* __restrict__ pe_v, const float* __restrict__ w1_v, const float* __restrict__ w2_v, float* __restrict__ kcmp, float* __restrict__ vcmp) {
    __shared__ float blk[2048];
    __shared__ float hid[128];
    int id = blockIdx.x; const int kv = id & 1; id >>= 1; const int g = id & 1; id >>= 1; const int c = id % NC, b = id / NC;
    const float* pe = kv ? pe_v : pe_k; const float* w1 = kv ? w1_v : w1_k; const float* w2 = kv ? w2_v : w2_k;
    const int tid = threadIdx.x;
    for (int i = tid; i < 2048; i += 128) { const int l = i >> 6, d = i & 63;
        blk[i] = __half2float(proj[(size_t)(b * S_ + 16 * c + l) * PW + C_KVB + kv * 128 + g * 64 + d]) + pe[i]; }
    __syncthreads();
    { float a = 0.f; for (int k = 0; k < 2048; ++k) a += blk[k] * w1[k * 128 + tid];
      const float x3 = a * a * a; hid[tid] = 0.5f * a * (1.f + tanhf(0.7978845608028654f * (a + 0.044715f * x3))); }
    __syncthreads();
    if (tid < 64) { float a = 0.f; for (int k = 0; k < 128; ++k) a += hid[k] * w2[k * 64 + tid];
        (kv ? vcmp : kcmp)[((size_t)(b * NC + c) * 2 + g) * 64 + tid] = a; }
}

__device__ __forceinline__ void softmax_row(float* pr, int n, int lane) {
    float mx = -INFINITY;
    for (int i = lane; i < n; i += 64) mx = fmaxf(mx, pr[i]);
#pragma unroll
    for (int o = 32; o > 0; o >>= 1) mx = fmaxf(mx, __shfl_xor(mx, o));
    float sm = 0.f;
    for (int i = lane; i < n; i += 64) { const float v = pr[i]; const float e = (v == -INFINITY) ? 0.f : expf(v - mx); pr[i] = e; sm += e; }
#pragma unroll
    for (int o = 32; o > 0; o >>= 1) sm += __shfl_xor(sm, o);
    const float inv = 1.f / fmaxf(sm, 1e-30f);
    for (int i = lane; i < n; i += 64) pr[i] *= inv;
}

__global__ __launch_bounds__(256) void nsa_naive(const __half* __restrict__ proj, const float* __restrict__ rel_bias, const float* __restrict__ kcmp, const float* __restrict__ vcmp, __half* __restrict__ o_b) {
    __shared__ float q[4][64];
    __shared__ float lg[4][1024];
    __shared__ float score[64];
    __shared__ int sb[16];
    __shared__ int nsb;
    const int id = blockIdx.x, g = id & 1, row = id >> 1, b = row / S_, t = row % S_, tid = threadIdx.x;
    const int w = tid >> 6, lane = tid & 63;
    const __half* pr = proj + (size_t)row * PW;
    q[tid >> 6][tid & 63] = __half2float(pr[C_QB + g * 256 + tid]);
    if (tid == 0) nsb = 0;
    __syncthreads();
    const int cur = t >> 6;
    const int nv = t >= 31 ? (t - 31) / 16 + 1 : 0;
    const int r_ = tid >> 6, d_ = tid & 63;
    float oc = 0.f, os = 0.f, ow = 0.f;
    for (int i = tid; i < 4 * nv; i += 256) { const int r = i / nv, c = i % nv;
        const float* kr = kcmp + ((size_t)(b * NC + c) * 2 + g) * 64; float a = 0.f;
        for (int d = 0; d < 64; ++d) a += q[r][d] * kr[d];
        lg[r][c] = a * 0.125f + rel_bias[t5_bucket(t - (16 * c + 31)) * 16 + 8 + g * 4 + r]; }
    __syncthreads();
    if (nv > 0) softmax_row(lg[w], nv, lane);
    __syncthreads();
    for (int c = 0; c < nv; ++c) oc += lg[r_][c] * vcmp[((size_t)(b * NC + c) * 2 + g) * 64 + d_];
    if (tid < 64) { const int nb = tid; float imp = 0.f;
        for (int r = 0; r < 4; ++r) for (int c = 4 * nb - 1; c <= 4 * nb + 3; ++c) if (c >= 0 && c < nv) imp += lg[r][c] * ((c == 4 * nb - 1 || c == 4 * nb + 3) ? 0.5f : 1.f);
        const bool valid = nb <= cur; const bool forced = nb == 0 || nb == cur || nb == cur - 1;
        score[nb] = valid ? (forced ? 1.0e4f : imp) : -INFINITY; }
    __syncthreads();
    if (tid < 64) { bool selq = false;
        if (tid <= cur) { const float sc = score[tid]; int rank = 0;
            for (int m = 0; m <= cur; ++m) { const float sm = score[m]; rank += (sm > sc || (sm == sc && m < tid)) ? 1 : 0; }
            selq = rank < 16; }
        const unsigned long long bm = __ballot(selq);
        if (selq) sb[__popcll(bm & ((1ull << tid) - 1ull))] = tid;
        if (tid == 0) nsb = __popcll(bm); }
    __syncthreads();
    const int ns = nsb;
    for (int i = tid; i < 4 * ns * 64; i += 256) { const int r = i / (ns * 64), j = i % (ns * 64); const int pos = sb[j >> 6] * 64 + (j & 63);
        float v = -INFINITY;
        if (pos <= t) { const __half* kr = proj + (size_t)(b * S_ + pos) * PW + C_KVB + 2 * 128 + g * 64; float a = 0.f;
            for (int d = 0; d < 64; ++d) a += q[r][d] * __half2float(kr[d]);
            v = a * 0.125f + rel_bias[t5_bucket(t - pos) * 16 + 8 + g * 4 + r]; }
        lg[r][j] = v; }
    __syncthreads();
    softmax_row(lg[w], ns * 64, lane);
    __syncthreads();
    for (int j = 0; j < ns * 64; ++j) { const float pj = lg[r_][j]; if (pj != 0.f) { const int pos = sb[j >> 6] * 64 + (j & 63);
        os += pj * __half2float(proj[(size_t)(b * S_ + pos) * PW + C_KVB + 3 * 128 + g * 64 + d_]); } }
    __syncthreads();
    const int p0 = t - 511 > 0 ? t - 511 : 0; const int nw = t - p0 + 1;
    for (int i = tid; i < 4 * nw; i += 256) { const int r = i / nw, j = i % nw; const int pos = p0 + j;
        const __half* kr = proj + (size_t)(b * S_ + pos) * PW + C_KVB + 4 * 128 + g * 64; float a = 0.f;
        for (int d = 0; d < 64; ++d) a += q[r][d] * __half2float(kr[d]);
        lg[r][j] = a * 0.125f + rel_bias[t5_bucket(t - pos) * 16 + 8 + g * 4 + r]; }
    __syncthreads();
    softmax_row(lg[w], nw, lane);
    __syncthreads();
    for (int j = 0; j < nw; ++j) ow += lg[r_][j] * __half2float(proj[(size_t)(b * S_ + p0 + j) * PW + C_KVB + 5 * 128 + g * 64 + d_]);
    const float g0 = sigmoidf_(__half2float(pr[C_GB + 0 * 8 + g * 4 + r_])), g1 = sigmoidf_(__half2float(pr[C_GB + 1 * 8 + g * 4 + r_])), g2 = sigmoidf_(__half2float(pr[C_GB + 2 * 8 + g * 4 + r_]));
    o_b[(size_t)row * 512 + (g * 4 + r_) * 64 + d_] = __float2half(g0 * oc + g1 * os + g2 * ow);
}

__global__ __launch_bounds__(256) void final_norm_k(float* __restrict__ xio, const float* __restrict__ g) {
    __shared__ float red[4];
    const int row = blockIdx.x, tid = threadIdx.x;
    float* xr = xio + (size_t)row * D_;
    float v[4]; float ss = 0.f;
#pragma unroll
    for (int i = 0; i < 4; ++i) { v[i] = xr[tid + i * 256]; ss += v[i] * v[i]; }
#pragma unroll
    for (int o = 32; o > 0; o >>= 1) ss += __shfl_xor(ss, o);
    if ((tid & 63) == 0) red[tid >> 6] = ss;
    __syncthreads();
    const float rs = rsqrtf((red[0] + red[1] + red[2] + red[3]) / D_ + EPS);
#pragma unroll
    for (int i = 0; i < 4; ++i) xr[tid + i * 256] = v[i] * rs * g[tid + i * 256];
}


#define XB_TMO      128
#define XB_XCNT(j)  (256  + 64 * (j))
#define XB_XSUB(j)  (1280 + 64 * (j))
#define XB_XGEN(j)  (2304 + 64 * (j))
#define XB_TOP      3328
#define XB_TOPGEN   3392
#define XCD_BAR_WORDS 3456
#define XB_SPIN_CAP (1u << 18)
__device__ __forceinline__ unsigned xb_ld(unsigned* p)              { return __hip_atomic_load(p, __ATOMIC_RELAXED, __HIP_MEMORY_SCOPE_AGENT); }
__device__ __forceinline__ unsigned xb_add(unsigned* p, unsigned v) { return __hip_atomic_fetch_add(p, v, __ATOMIC_RELAXED, __HIP_MEMORY_SCOPE_AGENT); }
__device__ __forceinline__ unsigned xb_xcc_id() { return (unsigned)__builtin_amdgcn_s_getreg((3 << 11) | 20) & 0xFu; }
#define XB_SPIN(cond, bar) do { unsigned _sp = 0; while (cond) { __builtin_amdgcn_s_sleep(1); \
    if ((++_sp & 255u) == 0u) { if (xb_ld(&(bar)[XB_TMO])) break; if (_sp > XB_SPIN_CAP) { atomicAdd(&(bar)[XB_TMO], 1u); break; } } } } while (0)
struct XcdBarrier { unsigned* bar; unsigned x; volatile LAS unsigned* st; };
__device__ __forceinline__ XcdBarrier xcd_barrier_post(unsigned* bar, volatile LAS unsigned* st) {
    XcdBarrier b; b.bar = bar; b.x = xb_xcc_id(); b.st = st;
    if (threadIdx.x == 0) (void)xb_add(&bar[XB_XCNT(b.x)], 1u);
    return b;
}
__device__ __forceinline__ void xcd_barrier_complete(unsigned* bar, unsigned x, unsigned& nloc, unsigned& nx) {
    const unsigned G = gridDim.x * gridDim.y * gridDim.z;
    unsigned sum, cnt, mine, sp = 0u;
    for (;;) {
        sum = 0u; cnt = 0u; mine = 0u;
#pragma unroll
        for (unsigned j = 0; j < 16; ++j) { const unsigned c = xb_ld(&bar[XB_XCNT(j)]); sum += c; cnt += (c > 0u) ? 1u : 0u; mine = (j == x) ? c : mine; }
        if (sum == G) break;
        __builtin_amdgcn_s_sleep(1);
        if ((++sp & 255u) == 0u) { if (xb_ld(&bar[XB_TMO])) break; if (sp > XB_SPIN_CAP) { atomicAdd(&bar[XB_TMO], 1u); break; } }
    }
    nloc = mine > 0u ? mine : 1u; nx = cnt > 0u ? cnt : 1u;
}
__device__ __forceinline__ void xcd_barrier(const XcdBarrier& b) {
    asm volatile("s_waitcnt vmcnt(0)" ::: "memory");
    __syncthreads();
    if (threadIdx.x == 0) {
        unsigned* bar = b.bar;
        __builtin_amdgcn_s_waitcnt(0);
        unsigned nloc = b.st[0], nx = b.st[1];
        if (nloc == 0u) { xcd_barrier_complete(bar, b.x, nloc, nx); b.st[0] = nloc; b.st[1] = nx; }
        const unsigned old = xb_add(&bar[XB_XSUB(b.x)], 1u);
        const unsigned gen = old / nloc;
        if (old + 1u == (gen + 1u) * nloc) {
            __builtin_amdgcn_fence(__ATOMIC_RELEASE, "agent");
            asm volatile("s_waitcnt vmcnt(0)" ::: "memory");
            const unsigned og = xb_add(&bar[XB_TOP], 1u);
            const unsigned tg = og / nx;
            if (og + 1u == (tg + 1u) * nx) xb_add(&bar[XB_TOPGEN], 1u);
            else XB_SPIN(xb_ld(&bar[XB_TOPGEN]) == tg, bar);
            __builtin_amdgcn_fence(__ATOMIC_ACQUIRE, "agent");
            xb_add(&bar[XB_XGEN(b.x)], 1u);
            asm volatile("s_waitcnt vmcnt(0)" ::: "memory");
        } else {
            XB_SPIN(xb_ld(&bar[XB_XGEN(b.x)]) == gen, bar);
            __builtin_amdgcn_fence(__ATOMIC_ACQUIRE, "agent");
            asm volatile("s_waitcnt vmcnt(0)" ::: "memory");
        }
    }
    __syncthreads();
}

constexpr int MEGA_LDS = 131072 + 256;

template <class Epi>
__device__ __forceinline__ void gemm_run(LAS unsigned char* lds, const void* A, const void* Bt, const Epi& E, int M, int N, int K) {
    pg8::Gemm g{(const pg8::bf16_t*)A, (const pg8::bf16_t*)Bt, M, N, K};
    pg8::StaticOrder S; S.init(M, N, (int)gridDim.x, (int)blockIdx.x);
    pg8::gemm_phase<Epi, pg8::StaticOrder, true, true>(lds, g, S, E);
}

__global__ void __launch_bounds__(512, 2) mega_fwd(Args a) {
    extern __shared__ __attribute__((aligned(16))) unsigned char lds_raw[];
    LAS unsigned char* lds = (LAS unsigned char*)lds_raw;
    unsigned char* ws = a.ws;
    if (threadIdx.x == 0) *(LAS dsa::u32x4*)(lds + 131072) = (dsa::u32x4){0u, 0u, 0u, 0u};
    __syncthreads();
    XcdBarrier bar = xcd_barrier_post((unsigned*)(ws + WS_CTL), (volatile LAS unsigned*)(lds + 131072));
    const _Float16* proj = (const _Float16*)(ws + WS_PROJ);
    _Float16* o_a = (_Float16*)(ws + WS_H); _Float16* o_b = (_Float16*)(ws + WS_H + 32 * MiB);
    _Float16* kcmp = (_Float16*)(ws + WS_KCMP); _Float16* vcmp = (_Float16*)(ws + WS_VCMP);

    prologue_body(a, lds_raw);
    xcd_barrier(bar);
    gemm_run(lds, ws + WS_H, ws + WS_WIN, pg8::EpiProj{(_Float16*)(ws + WS_PROJ)}, M_, PW, D_);
    xcd_barrier(bar);
#pragma unroll 1
    for (int it = blockIdx.x; it < 512; it += gridDim.x) { const int ct = it & 15, kv = (it >> 4) & 1, g = (it >> 5) & 1, b = it >> 6;
        cmpx::item(lds, proj, kv ? a.pe_v : a.pe_k, (const _Float16*)(ws + WS_CW + (kv ? 512 * 1024 : 0)), (const _Float16*)(ws + WS_CW + 1024 * 1024 + (kv ? 16384 : 0)), kv ? vcmp : kcmp, b, g, kv, ct); }
    { LAS float* biaslut = (LAS float*)(lds + dsa::L_BIAS);
      for (int i = threadIdx.x; i < 1024; i += 512) { const int d = i >> 3, h = i & 7; biaslut[i] = a.rel_bias[t5_bucket(d) * 16 + h]; } }
    __syncthreads();
#pragma unroll 1
    for (int v = blockIdx.x >> 3; v < 256; v += (gridDim.x >> 3)) { const int b = blockIdx.x & 7, j = v & 127;
        dsa::dsa_tile(lds, proj, o_a, b, (v < 128) ? 255 - j : j, nullptr); }
    xcd_barrier(bar);
    { LAS float* lut = (LAS float*)(lds + nsa::L_BIAS);
      for (int i = threadIdx.x; i < 1024; i += 512) { const int d = i >> 3, h = i & 7; lut[i] = a.rel_bias[t5_bucket(d) * 16 + 8 + h] * nsa::LOG2E; } }
    __syncthreads();
#pragma unroll 1
    for (int v = blockIdx.x >> 3; v < 128; v += (gridDim.x >> 3)) { const int bg = 2 * (blockIdx.x & 7) + (v >> 6), j = v & 31;
        nsa::nsa_unit(lds, proj, kcmp, vcmp, o_b, bg >> 1, bg & 1, (v & 32) ? j : 63 - j);
        __syncthreads(); }
    xcd_barrier(bar);
    gemm_run(lds, ws + WS_H, ws + WS_WBA, pg8::EpiMix<0>{(_Float16*)(ws + WS_MIX), proj}, M_, D_, 512);
    asm volatile("s_waitcnt vmcnt(0)" ::: "memory");
    __syncthreads();
    gemm_run(lds, ws + WS_H + 32 * MiB, ws + WS_WBB, pg8::EpiMix<1>{(_Float16*)(ws + WS_MIX), proj}, M_, D_, 512);
    xcd_barrier(bar);
    gemm_run(lds, ws + WS_MIX, ws + WS_WOUT, pg8::EpiResid{a.x, a.out}, M_, D_, D_);
    xcd_barrier(bar);
    { int tx = threadIdx.x; asm volatile("" : "+v"(tx)); const int lane = tx & 63; for (int m = blockIdx.x * 8 + (tx >> 6); m < M_; m += gridDim.x * 8) rms_row_to_f16(a.out + (size_t)m * D_, (_Float16*)(ws + WS_H) + (size_t)m * D_, lane); }
    xcd_barrier(bar);
    gemm_run(lds, ws + WS_H, ws + WS_WMI, pg8::EpiRelu2{(_Float16*)(ws + WS_PROJ)}, M_, DFF, D_);
    xcd_barrier(bar);
    gemm_run(lds, ws + WS_PROJ, ws + WS_WMO, EpiAccOut{a.out}, M_, D_, DFF);
    xcd_barrier(bar);
    { int tx = threadIdx.x; asm volatile("" : "+v"(tx)); const int lane = tx & 63; for (int m = blockIdx.x * 8 + (tx >> 6); m < M_; m += gridDim.x * 8) final_norm_row(a.out + (size_t)m * D_, a.norm_final, lane); }
}
}

extern "C" void kernel_launch(void* const* d_in, const int* in_sizes, int n_in, void* d_out, int out_size, void* d_ws, size_t ws_size, hipStream_t stream) {
    if (ws_size < WS_END) { fprintf(stderr, "ws too small: %zu\n", ws_size); return; }
    static int grid = 0;
    if (!grid) {
        int dev = 0, cus = 0, per_cu = 0;
        (void)hipGetDevice(&dev);
        (void)hipDeviceGetAttribute(&cus, hipDeviceAttributeMultiprocessorCount, dev);
        (void)hipFuncSetAttribute((const void*)mega_fwd, hipFuncAttributeMaxDynamicSharedMemorySize, MEGA_LDS);
        (void)hipOccupancyMaxActiveBlocksPerMultiprocessor(&per_cu, (const void*)mega_fwd, 512, MEGA_LDS);
        (void)hipGetLastError();
        grid = cus;
        if (per_cu < 1) fprintf(stderr, "occupancy query says %d blocks/CU\n", per_cu);
    }
    Args a{};
    a.x = (const float*)d_in[0]; a.norm_mix = (const float*)d_in[1]; a.w_in = (const float*)d_in[2];
    a.pe_k = (const float*)d_in[3]; a.w1_k = (const float*)d_in[4]; a.w2_k = (const float*)d_in[5];
    a.pe_v = (const float*)d_in[6]; a.w1_v = (const float*)d_in[7]; a.w2_v = (const float*)d_in[8];
    a.rel_bias = (const float*)d_in[9]; a.w_ba = (const float*)d_in[10]; a.w_bb = (const float*)d_in[11];
    a.w_out = (const float*)d_in[12]; a.norm_mlp = (const float*)d_in[13]; a.w_mi = (const float*)d_in[14];
    a.w_mo = (const float*)d_in[15]; a.norm_final = (const float*)d_in[16];
    a.out = (float*)d_out; a.ws = (unsigned char*)d_ws;
    (void)hipMemsetAsync(d_ws, 0, XCD_BAR_WORDS * sizeof(unsigned), stream);
    hipLaunchKernelGGL(mega_fwd, dim3(grid), dim3(512), MEGA_LDS, stream, a);
}
```

```cpp
#include <hip/hip_runtime.h>
#include <hip/hip_fp16.h>
#include <cstdint>
#include <cstdio>
#ifndef DBGSEL
#define DBGSEL 8
#endif

namespace pg8 {
#define PG8_LAS __attribute__((address_space(3)))
typedef unsigned short bf16_t;
typedef _Float16 bf16x8 __attribute__((ext_vector_type(8)));
typedef float f32x4 __attribute__((ext_vector_type(4)));
typedef unsigned u32x4 __attribute__((ext_vector_type(4)));
constexpr int BM = 256, BK = 64, HALF = 128, HTB = HALF * BK * 2  , STAGE_BYTES = 8 * HTB, NXCD = 8, WGM = 8;

__host__ __device__ __forceinline__ int lds_byte(int r, int c) { const int st = (r >> 4) * 2 + (c >> 5), rr = r & 15, cc = c & 31, ob = rr * 64 + cc * 2; return st * 1024 + (ob ^ (((ob >> 9) & 1) << 5)); }
__host__ __device__ __forceinline__ void stage_rc(int b, int& R, int& C) { const int st = b / 1024, sb = b % 1024, swz = sb ^ (((sb >> 9) & 1) << 5); R = (st >> 1) * 16 + swz / 64; C = (st & 1) * 32 + (swz % 64) / 2; }
__host__ __device__ __forceinline__ int perm32(int rho) { const int n = rho >> 4, i = rho & 15; return 8 * (i >> 2) + 4 * n + (i & 3); }

struct Unit { int pm, pn; };
struct Gemm { const bf16_t* A; const bf16_t* Bt; int M, N, K; };

struct StaticOrder {
    int nM, nN, nwg, G, c;
    __host__ __device__ void init(int M, int N, int G_, int c_) { nM = M / BM; nN = N / BM; nwg = nM * nN; G = G_; c = c_; }
    __host__ __device__ bool next(int i, Unit& u) const {
        const long L = (long)i * G + c; if (L >= nwg) return false;
        int wgid = (int)L; { const int q = nwg / NXCD, r = nwg % NXCD, xcd = wgid % NXCD, off = wgid / NXCD; wgid = (xcd < r ? xcd * (q + 1) : r * (q + 1) + (xcd - r) * q) + off; }
        const int nig = WGM * nN, gid = wgid / nig, fm = gid * WGM, gsz = (nM - fm) < WGM ? (nM - fm) : WGM;
        u.pm = fm + ((wgid % nig) % gsz); u.pn = (wgid % nig) / gsz; return true;
    }
    __device__ __forceinline__ void a_ready(const Unit&) const {}
    __device__ __forceinline__ void done(const Unit&) const {}
};


typedef float f32x2 __attribute__((ext_vector_type(2)));
typedef _Float16 f16x2 __attribute__((ext_vector_type(2)));
constexpr int PW = 4352;
__device__ __forceinline__ unsigned pkh(float a, float b) { f32x2 v = {a, b}; f16x2 h = __builtin_convertvector(v, f16x2); return __builtin_bit_cast(unsigned, h); }
__device__ __forceinline__ float sigm(float v) { return __builtin_amdgcn_rcpf(1.f + __expf(-v)); }
__device__ __forceinline__ void unpk8(const u32x4 w, float (&f)[8]) {
#pragma unroll
    for (int i = 0; i < 4; ++i) { const unsigned wi = (i == 0) ? w.x : (i == 1) ? w.y : (i == 2) ? w.z : w.w; const f16x2 h = __builtin_bit_cast(f16x2, wi); f[2 * i] = (float)h.x; f[2 * i + 1] = (float)h.y; } }

struct EpiProj {
    static constexpr bool PERM = true, AFTER_DRAIN = false;
    _Float16* O;
    __device__ __forceinline__ void operator()(const f32x4 (&acc)[2][2][4][2], const Unit& u, int wr, int wc, int fr, int fq) const {
        const int row0 = u.pm * BM + wr * 64 + fr, col0 = u.pn * BM + wc * 32 + 8 * fq; const bool sg = u.pn >= 9;
#pragma unroll
        for (int ai = 0; ai < 2; ++ai)
#pragma unroll
            for (int m = 0; m < 4; ++m) { _Float16* rowp = O + (size_t)(row0 + ai * HALF + m * 16) * PW + col0;
#pragma unroll
                for (int bj = 0; bj < 2; ++bj) { f32x4 v0 = acc[ai][bj][m][0], v1 = acc[ai][bj][m][1];
                    if (sg) {
#pragma unroll
                        for (int i = 0; i < 4; ++i) { v0[i] = sigm(v0[i]); v1[i] = sigm(v1[i]); } }
                    u32x4 w; w.x = pkh(v0[0], v0[1]); w.y = pkh(v0[2], v0[3]); w.z = pkh(v1[0], v1[1]); w.w = pkh(v1[2], v1[3]);
                    *(u32x4*)(rowp + bj * HALF) = w; } }
    }
};
template <int SECOND> struct EpiMix {
    static constexpr bool PERM = true, AFTER_DRAIN = false;
    _Float16* mix; const _Float16* proj;
    __device__ __forceinline__ void operator()(const f32x4 (&acc)[2][2][4][2], const Unit& u, int wr, int wc, int fr, int fq) const {
        const int row0 = u.pm * BM + wr * 64 + fr, col0 = u.pn * BM + wc * 32 + 8 * fq;
#pragma unroll
        for (int ai = 0; ai < 2; ++ai)
#pragma unroll
            for (int m = 0; m < 4; ++m) { const size_t r = (size_t)(row0 + ai * HALF + m * 16);
#pragma unroll
                for (int bj = 0; bj < 2; ++bj) { const int c = col0 + bj * HALF;
                    float g[8]; unpk8(*(const u32x4*)(proj + r * PW + 2304 + SECOND * 1024 + c), g);
                    const f32x4 v0 = acc[ai][bj][m][0], v1 = acc[ai][bj][m][1];
                    float o[8] = {g[0] * v0[0], g[1] * v0[1], g[2] * v0[2], g[3] * v0[3], g[4] * v1[0], g[5] * v1[1], g[6] * v1[2], g[7] * v1[3]};
                    if (SECOND) { float p[8]; unpk8(*(const u32x4*)(mix + r * 1024 + c), p);
#pragma unroll
                        for (int i = 0; i < 8; ++i) o[i] += p[i]; }
                    u32x4 w; w.x = pkh(o[0], o[1]); w.y = pkh(o[2], o[3]); w.z = pkh(o[4], o[5]); w.w = pkh(o[6], o[7]);
                    *(u32x4*)(mix + r * 1024 + c) = w; } }
    }
};
struct EpiPlain {
    static constexpr bool PERM = true, AFTER_DRAIN = false;
    _Float16* U;
    __device__ __forceinline__ void operator()(const f32x4 (&acc)[2][2][4][2], const Unit& u, int wr, int wc, int fr, int fq) const {
        const int row0 = u.pm * BM + wr * 64 + fr, col0 = u.pn * BM + wc * 32 + 8 * fq;
#pragma unroll
        for (int ai = 0; ai < 2; ++ai)
#pragma unroll
            for (int m = 0; m < 4; ++m) { _Float16* rowp = U + (size_t)(row0 + ai * HALF + m * 16) * 1024 + col0;
#pragma unroll
                for (int bj = 0; bj < 2; ++bj) { f32x4 v0 = acc[ai][bj][m][0], v1 = acc[ai][bj][m][1];
                    u32x4 w; w.x = pkh(v0[0], v0[1]); w.y = pkh(v0[2], v0[3]); w.z = pkh(v1[0], v1[1]); w.w = pkh(v1[2], v1[3]);
                    *(u32x4*)(rowp + bj * HALF) = w; } }
    }
};
struct EpiResid {
    static constexpr bool PERM = true, AFTER_DRAIN = false;
    const float* x; float* out;
    __device__ __forceinline__ void operator()(const f32x4 (&acc)[2][2][4][2], const Unit& u, int wr, int wc, int fr, int fq) const {
        const int row0 = u.pm * BM + wr * 64 + fr, col0 = u.pn * BM + wc * 32 + 8 * fq;
#pragma unroll
        for (int ai = 0; ai < 2; ++ai)
#pragma unroll
            for (int m = 0; m < 4; ++m) { const size_t r = (size_t)(row0 + ai * HALF + m * 16);
#pragma unroll
                for (int bj = 0; bj < 2; ++bj) { const size_t o = r * 1024 + col0 + bj * HALF;
                    const f32x4 a0 = *(const f32x4*)(x + o), a1 = *(const f32x4*)(x + o + 4);
                    *(f32x4*)(out + o) = a0 + acc[ai][bj][m][0]; *(f32x4*)(out + o + 4) = a1 + acc[ai][bj][m][1]; } }
    }
};
struct EpiResidSq {
    static constexpr bool PERM = true, AFTER_DRAIN = false;
    const float* x; float* out; _Float16* xh; float* rowsq;
    __device__ __forceinline__ void operator()(const f32x4 (&acc)[2][2][4][2], const Unit& u, int wr, int wc, int fr, int fq) const {
        const int row0 = u.pm * BM + wr * 64 + fr, col0 = u.pn * BM + wc * 32 + 8 * fq;
#pragma unroll
        for (int ai = 0; ai < 2; ++ai)
#pragma unroll
            for (int m = 0; m < 4; ++m) { const size_t r = (size_t)(row0 + ai * HALF + m * 16); float sq = 0.f;
#pragma unroll
                for (int bj = 0; bj < 2; ++bj) { const size_t o = r * 1024 + col0 + bj * HALF;
                    const f32x4 a0 = *(const f32x4*)(x + o) + acc[ai][bj][m][0], a1 = *(const f32x4*)(x + o + 4) + acc[ai][bj][m][1];
                    *(f32x4*)(out + o) = a0; *(f32x4*)(out + o + 4) = a1;
                    u32x4 w; w.x = pkh(a0[0], a0[1]); w.y = pkh(a0[2], a0[3]); w.z = pkh(a1[0], a1[1]); w.w = pkh(a1[2], a1[3]);
                    *(u32x4*)(xh + o) = w;
                    sq += (a0[0] * a0[0] + a0[1] * a0[1]) + (a0[2] * a0[2] + a0[3] * a0[3]) + (a1[0] * a1[0] + a1[1] * a1[1]) + (a1[2] * a1[2] + a1[3] * a1[3]); }
                sq += __shfl_xor(sq, 16); sq += __shfl_xor(sq, 32);
                if (fq == 0) atomicAdd(rowsq + r, sq); }
    }
};
struct EpiRelu2N {
    static constexpr bool PERM = true, AFTER_DRAIN = false;
    _Float16* U; const float* rowsq;
    __device__ __forceinline__ void operator()(const f32x4 (&acc)[2][2][4][2], const Unit& u, int wr, int wc, int fr, int fq) const {
        const int row0 = u.pm * BM + wr * 64 + fr, col0 = u.pn * BM + wc * 32 + 8 * fq;
#pragma unroll
        for (int ai = 0; ai < 2; ++ai)
#pragma unroll
            for (int m = 0; m < 4; ++m) { const int r = row0 + ai * HALF + m * 16; _Float16* rowp = U + (size_t)r * 4096 + col0;
                const float inv = 1.f / (rowsq[r] * (1.f / 1024.f) + 1e-6f);
#pragma unroll
                for (int bj = 0; bj < 2; ++bj) { f32x4 v0 = acc[ai][bj][m][0], v1 = acc[ai][bj][m][1];
#pragma unroll
                    for (int i = 0; i < 4; ++i) { const float a = fmaxf(v0[i], 0.f), b = fmaxf(v1[i], 0.f); v0[i] = a * a * inv; v1[i] = b * b * inv; }
                    u32x4 w; w.x = pkh(v0[0], v0[1]); w.y = pkh(v0[2], v0[3]); w.z = pkh(v1[0], v1[1]); w.w = pkh(v1[2], v1[3]);
                    *(u32x4*)(rowp + bj * HALF) = w; } }
    }
};
struct EpiRelu2 {
    static constexpr bool PERM = true, AFTER_DRAIN = false;
    _Float16* U;
    __device__ __forceinline__ void operator()(const f32x4 (&acc)[2][2][4][2], const Unit& u, int wr, int wc, int fr, int fq) const {
        const int row0 = u.pm * BM + wr * 64 + fr, col0 = u.pn * BM + wc * 32 + 8 * fq;
#pragma unroll
        for (int ai = 0; ai < 2; ++ai)
#pragma unroll
            for (int m = 0; m < 4; ++m) { _Float16* rowp = U + (size_t)(row0 + ai * HALF + m * 16) * 4096 + col0;
#pragma unroll
                for (int bj = 0; bj < 2; ++bj) { f32x4 v0 = acc[ai][bj][m][0], v1 = acc[ai][bj][m][1];
#pragma unroll
                    for (int i = 0; i < 4; ++i) { const float a = fmaxf(v0[i], 0.f), b = fmaxf(v1[i], 0.f); v0[i] = a * a; v1[i] = b * b; }
                    u32x4 w; w.x = pkh(v0[0], v0[1]); w.y = pkh(v0[2], v0[3]); w.z = pkh(v1[0], v1[1]); w.w = pkh(v1[2], v1[3]);
                    *(u32x4*)(rowp + bj * HALF) = w; } }
    }
};
template <class Epi, class Sched, bool ALIGN_EPI = false, bool SP2 = false>
__device__ __forceinline__ void gemm_phase(PG8_LAS unsigned char* lds, const Gemm g, const Sched& S, const Epi& E) {
    int tid_ = threadIdx.x; asm volatile("" : "+v"(tid_));
    const int tid = tid_, wid = __builtin_amdgcn_readfirstlane(tid >> 6), lane = tid & 63, wr = wid >> 2, wc = wid & 3, fr = lane & 15, fq = lane >> 4;
    const int K = g.K, nt = K / BK;
    unsigned voffA[2], voffB[2];
#pragma unroll
    for (int i = 0; i < 2; ++i) { int R, C; stage_rc(tid * 16 + i * 8192, R, C); const int Rb = Epi::PERM ? ((R & ~31) + perm32(R & 31)) : R;
        voffA[i] = (unsigned)(R * K + C) * 2u; voffB[i] = (unsigned)(Rb * K + C) * 2u; }
    const size_t kstep = (size_t)(BK * 2);
    const size_t hstep = (size_t)HALF * K * 2;
    const size_t tstep = 2 * hstep;
    const unsigned ldsw = (unsigned)wid * 1024u;
    const int aoff = lds_byte(wr * 64 + fr, fq * 8), boff = lds_byte(wc * 32 + fr, fq * 8);
#define PG8_SA(b, h) (((b) * 2 + (h)) * HTB)
#define PG8_SB(b, h) ((4 + (b) * 2 + (h)) * HTB)
#define PG8_STAGE(bufoff, gbase, voff) do { _Pragma("unroll") for (int _i = 0; _i < 2; ++_i) \
        __builtin_amdgcn_global_load_lds((const unsigned*)((const char*)(gbase) + (voff)[_i]), (PG8_LAS unsigned*)(lds + (bufoff) + ldsw + _i * 8192), 16, 0, 0); } while (0)
#define PG8_LDA(dst, b, h) do { _Pragma("unroll") for (int m = 0; m < 4; ++m) _Pragma("unroll") for (int k = 0; k < 2; ++k) dst[m][k] = *(const PG8_LAS bf16x8*)(lds + PG8_SA(b, h) + aoff + m * 2048 + k * 1024); } while (0)
#define PG8_LDB(dst, b, h) do { _Pragma("unroll") for (int n = 0; n < 2; ++n) _Pragma("unroll") for (int k = 0; k < 2; ++k) dst[n][k] = *(const PG8_LAS bf16x8*)(lds + PG8_SB(b, h) + boff + n * 2048 + k * 1024); } while (0)
#define PG8_MMA(ai, bj, At, Bt) do { __builtin_amdgcn_s_setprio(1); _Pragma("unroll") for (int m = 0; m < 4; ++m) _Pragma("unroll") for (int n = 0; n < 2; ++n) _Pragma("unroll") for (int k = 0; k < 2; ++k) \
        acc[ai][bj][m][n] = __builtin_amdgcn_mfma_f32_16x16x32_f16(Bt[n][k], At[m][k], acc[ai][bj][m][n], 0, 0, 0); __builtin_amdgcn_s_setprio(0); } while (0)
#define PG8_WAIT_V(n) asm volatile("s_waitcnt vmcnt(" #n ")" ::: "memory")
#define PG8_WAIT_L(n) asm volatile("s_waitcnt lgkmcnt(" #n ")" ::: "memory")
#define PG8_BAR __builtin_amdgcn_s_barrier()
#define PG8_SCHED __builtin_amdgcn_sched_barrier(0)
    Unit cur, nxt; int ui = 0;
    if (!S.next(0, cur)) return;
    f32x4 acc[2][2][4][2];
#pragma unroll
    for (int a = 0; a < 2; ++a)
#pragma unroll
        for (int b = 0; b < 2; ++b)
#pragma unroll
            for (int m = 0; m < 4; ++m)
#pragma unroll
                for (int n = 0; n < 2; ++n) acc[a][b][m][n] = (f32x4){0.f, 0.f, 0.f, 0.f};
    bf16x8 At[4][2], B0[2][2], B1[2][2];
    const char* cA = (const char*)g.A + (size_t)cur.pm * tstep; const char* cB = (const char*)g.Bt + (size_t)cur.pn * tstep;
    S.a_ready(cur);
    if constexpr (SP2) {
        PG8_STAGE(PG8_SB(0, 0), cB, voffB); PG8_STAGE(PG8_SB(0, 1), cB + hstep, voffB); PG8_STAGE(PG8_SA(0, 0), cA, voffA); PG8_STAGE(PG8_SA(0, 1), cA + hstep, voffA);
        if (wr == 1) PG8_BAR;
        PG8_WAIT_V(2); PG8_BAR;
        PG8_STAGE(PG8_SB(1, 0), cB + kstep, voffB); PG8_STAGE(PG8_SA(1, 0), cA + kstep, voffA); PG8_STAGE(PG8_SB(1, 1), cB + hstep + kstep, voffB);
        PG8_WAIT_V(6); PG8_BAR;
    } else {
        PG8_STAGE(PG8_SB(0, 0), cB, voffB); PG8_STAGE(PG8_SA(0, 0), cA, voffA); PG8_STAGE(PG8_SB(0, 1), cB + hstep, voffB); PG8_STAGE(PG8_SA(0, 1), cA + hstep, voffA);
        if (wr == 1) PG8_BAR;
        PG8_WAIT_V(4); PG8_BAR;
        PG8_STAGE(PG8_SB(1, 0), cB + kstep, voffB); PG8_STAGE(PG8_SA(1, 0), cA + kstep, voffA); PG8_STAGE(PG8_SB(1, 1), cB + hstep + kstep, voffB);
        PG8_WAIT_V(6); PG8_BAR;
    }
    for (;;) {
        const bool has_next = S.next(ui + 1, nxt);
        const char* nA = has_next ? (const char*)g.A + (size_t)nxt.pm * tstep : cA; const char* nB = has_next ? (const char*)g.Bt + (size_t)nxt.pn * tstep : cB;
        for (int t = 0; t < nt; t += 2) {
            const bool last = (t == nt - 2);
            const char* a1 = cA + (size_t)(t + 1) * kstep;
            const char* a2 = last ? nA : cA + (size_t)(t + 2) * kstep; const char* b2 = last ? nB : cB + (size_t)(t + 2) * kstep;
            const char* a3 = a2 + kstep; const char* b3 = b2 + kstep;
            if (last && has_next) S.a_ready(nxt);
            if constexpr (SP2) {
            PG8_LDB(B0, 0, 0); PG8_LDB(B1, 0, 1); PG8_SCHED; PG8_LDA(At, 0, 0); PG8_STAGE(PG8_SA(1, 1), a1 + hstep, voffA);
            PG8_WAIT_V(8); PG8_WAIT_L(0); PG8_BAR; PG8_MMA(0, 0, At, B0); PG8_MMA(0, 1, At, B1); PG8_BAR; PG8_SCHED;
            PG8_LDA(At, 0, 1); PG8_STAGE(PG8_SB(0, 0), b2, voffB); PG8_STAGE(PG8_SB(0, 1), b2 + hstep, voffB); PG8_STAGE(PG8_SA(0, 0), a2, voffA);
            PG8_WAIT_V(8); PG8_WAIT_L(0); PG8_BAR; PG8_MMA(1, 0, At, B0); PG8_MMA(1, 1, At, B1); PG8_BAR; PG8_SCHED;
            PG8_LDB(B0, 1, 0); PG8_LDB(B1, 1, 1); PG8_SCHED; PG8_LDA(At, 1, 0); PG8_STAGE(PG8_SA(0, 1), a2 + hstep, voffA);
            PG8_WAIT_V(8); PG8_WAIT_L(0); PG8_BAR; PG8_MMA(0, 0, At, B0); PG8_MMA(0, 1, At, B1); PG8_BAR; PG8_SCHED;
            PG8_LDA(At, 1, 1); PG8_STAGE(PG8_SB(1, 0), b3, voffB); PG8_STAGE(PG8_SB(1, 1), b3 + hstep, voffB); PG8_STAGE(PG8_SA(1, 0), a3, voffA);
            PG8_WAIT_V(8); PG8_WAIT_L(0); PG8_BAR; PG8_MMA(1, 0, At, B0); PG8_MMA(1, 1, At, B1); PG8_BAR; PG8_SCHED;
            } else {
            PG8_LDB(B0, 0, 0); PG8_SCHED; PG8_LDA(At, 0, 0); PG8_STAGE(PG8_SA(1, 1), a1 + hstep, voffA);
            PG8_WAIT_L(8); PG8_BAR; PG8_WAIT_L(0); PG8_MMA(0, 0, At, B0); PG8_BAR; PG8_SCHED;
            PG8_LDB(B1, 0, 1); PG8_STAGE(PG8_SB(0, 0), b2, voffB);
            PG8_BAR; PG8_WAIT_L(0); PG8_MMA(0, 1, At, B1); PG8_BAR;
            PG8_LDA(At, 0, 1); PG8_STAGE(PG8_SA(0, 0), a2, voffA);
            PG8_BAR; PG8_WAIT_L(0); PG8_MMA(1, 0, At, B0); PG8_BAR; PG8_SCHED;
            PG8_STAGE(PG8_SB(0, 1), b2 + hstep, voffB);
            PG8_WAIT_V(6); PG8_BAR; PG8_MMA(1, 1, At, B1); PG8_BAR;
            PG8_LDB(B0, 1, 0); PG8_SCHED; PG8_LDA(At, 1, 0); PG8_STAGE(PG8_SA(0, 1), a2 + hstep, voffA);
            PG8_WAIT_L(8); PG8_BAR; PG8_WAIT_L(0); PG8_MMA(0, 0, At, B0); PG8_BAR; PG8_SCHED;
            PG8_LDB(B1, 1, 1); PG8_STAGE(PG8_SB(1, 0), b3, voffB);
            PG8_BAR; PG8_WAIT_L(0); PG8_MMA(0, 1, At, B1); PG8_BAR;
            PG8_LDA(At, 1, 1); PG8_STAGE(PG8_SA(1, 0), a3, voffA);
            PG8_BAR; PG8_WAIT_L(0); PG8_MMA(1, 0, At, B0); PG8_BAR; PG8_SCHED;
            PG8_STAGE(PG8_SB(1, 1), b3 + hstep, voffB);
            PG8_WAIT_V(6); PG8_BAR; PG8_MMA(1, 1, At, B1); PG8_BAR;
            }
        }
        if constexpr (ALIGN_EPI) { if (wr == 0) PG8_BAR; }
        if constexpr (!Epi::AFTER_DRAIN) { E(acc, cur, wr, wc, fr, fq); S.done(cur); }
        if (!has_next) break;
#pragma unroll
        for (int a = 0; a < 2; ++a)
#pragma unroll
            for (int b = 0; b < 2; ++b)
#pragma unroll
                for (int m = 0; m < 4; ++m)
#pragma unroll
                    for (int n = 0; n < 2; ++n) acc[a][b][m][n] = (f32x4){0.f, 0.f, 0.f, 0.f};
        cur = nxt; cA = nA; cB = nB; ++ui;
        if constexpr (ALIGN_EPI) { if (wr == 1) PG8_BAR; }
    }
    PG8_WAIT_V(0);
    if constexpr (!ALIGN_EPI) { if (wr == 0) PG8_BAR; }
    PG8_BAR;
    if constexpr (Epi::AFTER_DRAIN) { E.fused(acc, cur, wr, wc, fr, fq, lds, wid, lane); S.done(cur); }
#undef PG8_SA
#undef PG8_SB
#undef PG8_STAGE
#undef PG8_LDA
#undef PG8_LDB
#undef PG8_MMA
#undef PG8_WAIT_V
#undef PG8_WAIT_L
#undef PG8_BAR
#undef PG8_SCHED
}
}


namespace {
constexpr int B_ = 8, S_ = 4096, M_ = B_ * S_, D_ = 1024, DIN = 4288, DFF = 4096;
constexpr int C_QA = 0, C_QB = 512, C_QI = 1024, C_KVB = 1280, C_KA = 2048, C_VA = 2112, C_KI = 2176, C_WI = 2208, C_GB = 2216, C_GATE = 2304;
constexpr int NC = 255;
constexpr float EPS = 1e-6f;
using pg8::PW;
#define GAS __attribute__((address_space(1)))
#define LAS __attribute__((address_space(3)))
typedef unsigned v4u __attribute__((ext_vector_type(4)));
typedef float f32x4 __attribute__((ext_vector_type(4)));

__device__ __forceinline__ int t5_bucket(int n) {
    if (n < 16) return n < 0 ? 0 : n;
    float nf = (float)n;
    int large = 16 + (int)(logf(nf / 16.f) / logf(8.f) * 16.f);
    return large < 31 ? large : 31;
}
__device__ __forceinline__ float sigmoidf_(float v) { return 1.f / (1.f + expf(-v)); }


__device__ __forceinline__ int win_src_col(int n) {
    if (n < 512) return n;
    if (n < 1024) return 936 + (n - 512);
    if (n < 1280) return 640 + (n - 1024);
    if (n < 2048) return 1448 + (n - 1280);
    if (n < 2112) return 512 + (n - 2048);
    if (n < 2176) return 576 + (n - 2112);
    if (n < 2208) return 896 + (n - 2176);
    if (n < 2216) return 928 + (n - 2208);
    if (n < 2240) return n;
    if (n < 2304) return -1;
    return 2240 + (n - 2304);
}
__device__ __forceinline__ float wave_sum(float v) {
#pragma unroll
    for (int o = 1; o < 64; o <<= 1) v += __shfl_xor(v, o);
    return v;
}
template <bool MAP>
__device__ __forceinline__ void transpose_item(const float* __restrict__ W, int K, int Nsrc, int Ndst, _Float16* __restrict__ WT, const float* __restrict__ gain, float* scr, int item, int lane) {
    const int nblk = Ndst / 32, kb = item / nblk, nb = item % nblk, k0 = 64 * kb, n0 = 32 * nb;
    const int nd = n0 + (lane & 31); const int ns = MAP ? win_src_col(nd) : nd;
#pragma unroll 8
    for (int i = 0; i < 32; ++i) { const int kk = 2 * i + (lane >> 5); float v = 0.f;
        if (ns >= 0) { v = W[(size_t)(k0 + kk) * Nsrc + ns]; if (gain) v *= gain[k0 + kk]; }
        scr[kk * 33 + (lane & 31)] = v; }
    __builtin_amdgcn_s_waitcnt(0xc07f); asm volatile("" ::: "memory");
    const int c = lane & 7;
#pragma unroll
    for (int j = 0; j < 4; ++j) { const int n = (lane >> 3) + 8 * j; const float* s = scr + (8 * c) * 33 + n;
        v4u o; o.x = pg8::pkh(s[0 * 33], s[1 * 33]); o.y = pg8::pkh(s[2 * 33], s[3 * 33]); o.z = pg8::pkh(s[4 * 33], s[5 * 33]); o.w = pg8::pkh(s[6 * 33], s[7 * 33]);
        *(v4u*)(WT + (size_t)(n0 + n) * K + k0 + 8 * c) = o; }
    __builtin_amdgcn_s_waitcnt(0xc07f); asm volatile("" ::: "memory");
}
__device__ __forceinline__ void rms_row_to_f16(const float* __restrict__ xrow, _Float16* __restrict__ orow, int lane) {
    const f32x4* xr = (const f32x4*)xrow + lane;
    f32x4 v[4]; float s = 0.f;
#pragma unroll
    for (int j = 0; j < 4; ++j) { v[j] = xr[64 * j]; s += (v[j].x * v[j].x + v[j].y * v[j].y) + (v[j].z * v[j].z + v[j].w * v[j].w); }
    const float rstd = rsqrtf(wave_sum(s) * (1.f / D_) + EPS);
    unsigned long long* o8 = (unsigned long long*)orow + lane;
#pragma unroll
    for (int j = 0; j < 4; ++j) o8[64 * j] = (unsigned long long)pg8::pkh(v[j].x * rstd, v[j].y * rstd) | ((unsigned long long)pg8::pkh(v[j].z * rstd, v[j].w * rstd) << 32);
}

struct Args {
    const float* x; const float* norm_mix; const float* w_in; const float* pe_k; const float* w1_k; const float* w2_k; const float* pe_v; const float* w1_v; const float* w2_v;
    const float* rel_bias; const float* w_ba; const float* w_bb; const float* w_out; const float* norm_mlp; const float* w_mi; const float* w_mo; const float* norm_final;
    float* out; unsigned char* ws;
};
constexpr size_t MiB = 1u << 20;
constexpr size_t WS_ROWSQ = 65536;
constexpr size_t WS_CTL = 0, WS_WIN = 1 * MiB, WS_WBA = 10 * MiB, WS_WBB = 11 * MiB, WS_WOUT = 12 * MiB, WS_WMI = 14 * MiB, WS_WMO = 22 * MiB, WS_CW = 30 * MiB,
                 WS_KCMP = 32 * MiB, WS_VCMP = 33 * MiB, WS_H = 34 * MiB, WS_PROJ = 98 * MiB, WS_MIX = 370 * MiB, WS_END = 434 * MiB;

__device__ __forceinline__ void prologue_body(const Args& a, unsigned char* lds) {
    const int tid = threadIdx.x, lane = tid & 63, wave = tid >> 6;
    float* scr = (float*)(lds + wave * 8704);
    const int gw = blockIdx.x * 8 + wave, NGW = gridDim.x * 8;
    constexpr int I_IN = (D_ / 64) * (PW / 32), I_BA = (512 / 64) * (D_ / 32), I_OUT = (D_ / 64) * (D_ / 32), I_MI = (D_ / 64) * (DFF / 32), I_MO = (DFF / 64) * (D_ / 32);
    constexpr int I_C1 = (2048 / 64) * (128 / 32), I_C2 = (128 / 64) * (64 / 32);
    constexpr int NITEMS = I_IN + 2 * I_BA + I_OUT + I_MI + I_MO + 2 * I_C1 + 2 * I_C2;
    for (int it = gw; it < NITEMS; it += NGW) {
        int r = it;
        if (r < I_IN) { transpose_item<true>(a.w_in, D_, DIN, PW, (_Float16*)(a.ws + WS_WIN), a.norm_mix, scr, r, lane); continue; } r -= I_IN;
        if (r < I_BA) { transpose_item<false>(a.w_ba, 512, D_, D_, (_Float16*)(a.ws + WS_WBA), nullptr, scr, r, lane); continue; } r -= I_BA;
        if (r < I_BA) { transpose_item<false>(a.w_bb, 512, D_, D_, (_Float16*)(a.ws + WS_WBB), nullptr, scr, r, lane); continue; } r -= I_BA;
        if (r < I_OUT) { transpose_item<false>(a.w_out, D_, D_, D_, (_Float16*)(a.ws + WS_WOUT), nullptr, scr, r, lane); continue; } r -= I_OUT;
        if (r < I_MI) { transpose_item<false>(a.w_mi, D_, DFF, DFF, (_Float16*)(a.ws + WS_WMI), a.norm_mlp, scr, r, lane); continue; } r -= I_MI;
        if (r < I_MO) { transpose_item<false>(a.w_mo, DFF, D_, D_, (_Float16*)(a.ws + WS_WMO), nullptr, scr, r, lane); continue; } r -= I_MO;
        if (r < I_C1) { transpose_item<false>(a.w1_k, 2048, 128, 128, (_Float16*)(a.ws + WS_CW), nullptr, scr, r, lane); continue; } r -= I_C1;
        if (r < I_C1) { transpose_item<false>(a.w1_v, 2048, 128, 128, (_Float16*)(a.ws + WS_CW + 512 * 1024), nullptr, scr, r, lane); continue; } r -= I_C1;
        if (r < I_C2) { transpose_item<false>(a.w2_k, 128, 64, 64, (_Float16*)(a.ws + WS_CW + 1024 * 1024), nullptr, scr, r, lane); continue; } r -= I_C2;
        transpose_item<false>(a.w2_v, 128, 64, 64, (_Float16*)(a.ws + WS_CW + 1024 * 1024 + 16384), nullptr, scr, r, lane);
    }
    for (int m = gw; m < M_; m += NGW) rms_row_to_f16(a.x + (size_t)m * D_, (_Float16*)(a.ws + WS_H) + (size_t)m * D_, lane);
}
__global__ void __launch_bounds__(512, 2) k_prologue(Args a) {
    extern __shared__ __attribute__((aligned(16))) unsigned char lds[];
    prologue_body(a, lds);
}
__device__ __forceinline__ void final_norm_row(float* __restrict__ xrow, const float* __restrict__ g, int lane) {
    f32x4* xr = (f32x4*)xrow + lane; const f32x4* gr = (const f32x4*)g + lane;
    f32x4 v[4]; float s = 0.f;
#pragma unroll
    for (int j = 0; j < 4; ++j) { v[j] = xr[64 * j]; s += (v[j].x * v[j].x + v[j].y * v[j].y) + (v[j].z * v[j].z + v[j].w * v[j].w); }
    const float rstd = rsqrtf(wave_sum(s) * (1.f / D_) + EPS);
#pragma unroll
    for (int j = 0; j < 4; ++j) { const f32x4 gg = gr[64 * j]; xr[64 * j] = v[j] * rstd * gg; }
}
__global__ void __launch_bounds__(512, 2) k_rows_norm(const float* __restrict__ src, _Float16* __restrict__ dst) {
    const int lane = threadIdx.x & 63, gw = blockIdx.x * 8 + (threadIdx.x >> 6), NGW = gridDim.x * 8;
    for (int m = gw; m < M_; m += NGW) rms_row_to_f16(src + (size_t)m * D_, dst + (size_t)m * D_, lane);
}
template <class Epi>
__global__ void __launch_bounds__(512, 2) k_gemm(const void* A, const void* Bt, Epi E, int M, int N, int K, int pad_) {
    extern __shared__ __attribute__((aligned(16))) unsigned char lds[];
    pg8::Gemm g{(const pg8::bf16_t*)A, (const pg8::bf16_t*)Bt, M, N, K};
    pg8::StaticOrder S; S.init(M, N, (int)gridDim.x, (int)blockIdx.x);
    pg8::gemm_phase<Epi, pg8::StaticOrder, true, true>((PG8_LAS unsigned char*)lds, g, S, E);
}
struct EpiAccOut {
    static constexpr bool PERM = true, AFTER_DRAIN = false;
    float* out;
    __device__ __forceinline__ void operator()(const f32x4 (&acc)[2][2][4][2], const pg8::Unit& u, int wr, int wc, int fr, int fq) const {
        const int row0 = u.pm * 256 + wr * 64 + fr, col0 = u.pn * 256 + wc * 32 + 8 * fq;
#pragma unroll
        for (int ai = 0; ai < 2; ++ai)
#pragma unroll
            for (int m = 0; m < 4; ++m) { const size_t r = (size_t)(row0 + ai * 128 + m * 16);
#pragma unroll
                for (int bj = 0; bj < 2; ++bj) { const size_t o = r * 1024 + col0 + bj * 128;
                    const f32x4 a0 = *(const f32x4*)(out + o), a1 = *(const f32x4*)(out + o + 4);
                    *(f32x4*)(out + o) = a0 + acc[ai][bj][m][0]; *(f32x4*)(out + o + 4) = a1 + acc[ai][bj][m][1]; } }
    }
};


namespace dsa {
typedef _Float16 f16x8 __attribute__((ext_vector_type(8)));
typedef _Float16 f16x4 __attribute__((ext_vector_type(4)));
typedef short s16x4 __attribute__((ext_vector_type(4)));
typedef float f32x4 __attribute__((ext_vector_type(4)));
typedef unsigned u32x4 __attribute__((ext_vector_type(4)));
typedef unsigned u32x2 __attribute__((ext_vector_type(2)));
constexpr int TQ = 16, NBIN = 2048, CANDCAP = 512, VPITCH = 144;
constexpr int L_HIST = 0, L_SEL = 65536, L_SELD = L_SEL + 8192, L_CTL = L_SELD + 8192, L_BIAS = L_CTL + 512, L_VST = L_BIAS + 4096, L_END = L_VST + 8 * 32 * VPITCH;
static_assert(L_END <= 131072, "dsa LDS");

__device__ __forceinline__ float idx_score(const f32x4 a1, const f32x4 a2, float lin, const float (&wh)[8]) {
    float s = fmaf(wh[0], fabsf(a1.x), lin);
    s = fmaf(wh[1], fabsf(a1.y), s); s = fmaf(wh[2], fabsf(a1.z), s); s = fmaf(wh[3], fabsf(a1.w), s);
    s = fmaf(wh[4], fabsf(a2.x), s); s = fmaf(wh[5], fabsf(a2.y), s); s = fmaf(wh[6], fabsf(a2.z), s); s = fmaf(wh[7], fabsf(a2.w), s);
    return s;
}
__device__ __forceinline__ int score_bin(float sc, float inv) { int b = (int)(fmaf(sc, inv, 1024.f)); b = b < 0 ? 0 : b; return b > NBIN - 1 ? NBIN - 1 : b; }

template <int PASS>
__device__ __forceinline__ void score_pass(LAS unsigned char* lds, const _Float16* __restrict__ proj, int b, int t0, int nkb, int wave, int lane,
                                           const f16x8 (&afr)[4][2], const f16x8 alin, const float (&wq)[4][8], const float (&binv)[4]) {
    LAS unsigned* hist = (LAS unsigned*)(lds + L_HIST);
    LAS unsigned short* sel = (LAS unsigned short*)(lds + L_SEL);
    LAS unsigned short* seld = (LAS unsigned short*)(lds + L_SELD);
    LAS u32x2* cand = (LAS u32x2*)(lds + L_HIST);
    LAS int* ctl = (LAS int*)(lds + L_CTL);
    const int kc = lane >> 4, n16 = lane & 15;
    int bst[4];
#pragma unroll
    for (int grp = 0; grp < 4; ++grp) bst[grp] = (PASS == 2) ? ctl[(4 * grp + kc) * 8 + 2] : 0;
    const f32x4 zero = {0.f, 0.f, 0.f, 0.f};
    const _Float16* kbase = proj + (size_t)(b * S_ + n16) * PW + C_KI + 8 * kc;
    f16x8 bnext = *(const f16x8*)(kbase + (size_t)(16 * (wave < nkb ? wave : 0)) * PW);
    for (int kb = wave; kb < nkb; kb += 8) {
        const f16x8 bfr = bnext;
        { const int kn = kb + 8 < nkb ? kb + 8 : kb; bnext = *(const f16x8*)(kbase + (size_t)(16 * kn) * PW); }
        const int s = 16 * kb + n16;
        const bool lastkb = kb == nkb - 1;
        const f32x4 a3 = __builtin_amdgcn_mfma_f32_16x16x32_f16(alin, bfr, zero, 0, 0, 0);
        const float lin4[4] = {a3.x, a3.y, a3.z, a3.w};
#pragma unroll
        for (int grp = 0; grp < 4; ++grp) {
            const f32x4 a1 = __builtin_amdgcn_mfma_f32_16x16x32_f16(afr[grp][0], bfr, zero, 0, 0, 0);
            const f32x4 a2 = __builtin_amdgcn_mfma_f32_16x16x32_f16(afr[grp][1], bfr, zero, 0, 0, 0);
            const float sc = idx_score(a1, a2, lin4[grp], wq[grp]);
            const int row = 4 * grp + kc, t = t0 + row;
            if (!lastkb || s <= t) {
                const int bin = score_bin(sc, binv[grp]);
                if (PASS == 1) { __hip_atomic_fetch_add(hist + row * 1024 + (bin >> 1), (bin & 1) ? 0x10000u : 1u, __ATOMIC_RELAXED, __HIP_MEMORY_SCOPE_WORKGROUP); }
                else {
                    if (bin > bst[grp]) { const int pos = __hip_atomic_fetch_add(ctl + row * 8 + 0, 1, __ATOMIC_RELAXED, __HIP_MEMORY_SCOPE_WORKGROUP); sel[row * 256 + (pos & 255)] = (unsigned short)s;
                        const int dd = t - s; seld[row * 256 + (pos & 255)] = (unsigned short)((dd > 127 ? 127 : dd) * 32); }
                    else if (bin == bst[grp]) { const int pos = __hip_atomic_fetch_add(ctl + row * 8 + 1, 1, __ATOMIC_RELAXED, __HIP_MEMORY_SCOPE_WORKGROUP);
                        if (pos < CANDCAP) { u32x2 e; e.x = __float_as_uint(sc); e.y = (unsigned)s; cand[row * CANDCAP + pos] = e; } }
                }
            }
        }
    }
}

__device__ __forceinline__ void dsa_tile(LAS unsigned char* lds, const _Float16* __restrict__ proj, _Float16* __restrict__ o_a, int b, int qt, unsigned* dbg) {
    int tid_ = threadIdx.x; asm volatile("" : "+v"(tid_));
    const int tid = tid_, lane = tid & 63, wave = __builtin_amdgcn_readfirstlane(tid >> 6);
    const int kc = lane >> 4, n16 = lane & 15;
    const int t0 = qt * TQ, nkb = qt + 1;
    LAS unsigned* hist = (LAS unsigned*)(lds + L_HIST);
    LAS unsigned short* sel = (LAS unsigned short*)(lds + L_SEL);
    LAS u32x2* cand = (LAS u32x2*)(lds + L_HIST);
    LAS int* ctl = (LAS int*)(lds + L_CTL);
    LAS float* biaslut = (LAS float*)(lds + L_BIAS);
    for (int i = tid; i < (TQ * 1024 + 4096) / 4; i += 512) ((LAS u32x4*)hist)[i] = (u32x4){0u, 0u, 0u, 0u};
    if (tid < TQ * 8) ctl[tid] = 0;
    f16x8 afr[4][2]; f16x8 alin; float wq[4][8]; float binv[4];
    { const int g = n16 >> 2, r = n16 & 3;
      { const int qq = 4 * r + g; const _Float16* qrow = proj + (size_t)(b * S_ + t0 + qq) * PW;
        const f16x8 wg = *(const f16x8*)(qrow + C_WI);
        float lin[8];
#pragma unroll
        for (int e = 0; e < 8; ++e) lin[e] = 0.f;
#pragma unroll
        for (int h = 0; h < 8; ++h) { const f16x8 qh = *(const f16x8*)(qrow + C_QI + h * 32 + 8 * kc); const float wh = (float)wg[h] * (0.5f / 16.f);
#pragma unroll
            for (int e = 0; e < 8; ++e) lin[e] = fmaf(wh, (float)qh[e], lin[e]); }
#pragma unroll
        for (int e = 0; e < 8; ++e) alin[e] = (_Float16)lin[e]; }
#pragma unroll
      for (int grp = 0; grp < 4; ++grp) {
          const _Float16* qrow = proj + (size_t)(b * S_ + t0 + 4 * grp + g) * PW + C_QI;
          afr[grp][0] = *(const f16x8*)(qrow + r * 32 + 8 * kc);
          afr[grp][1] = *(const f16x8*)(qrow + (4 + r) * 32 + 8 * kc);
          const f16x8 wv = *(const f16x8*)(proj + (size_t)(b * S_ + t0 + 4 * grp + kc) * PW + C_WI);
          float ss = 0.f;
#pragma unroll
          for (int h = 0; h < 8; ++h) { const float wfull = (float)wv[h] * (1.f / 16.f); wq[grp][h] = 0.5f * wfull; ss = fmaf(wfull, wfull, ss); }
          binv[grp] = 32.f * rsqrtf(ss + 1e-12f);
      } }
    __syncthreads();
    score_pass<1>(lds, proj, b, t0, nkb, wave, lane, afr, alin, wq, binv);
    __syncthreads();
#pragma unroll 1
    for (int i = 0; i < 2; ++i) {
        const int row = 2 * wave + i, n = t0 + row + 1;
        if (n <= 256) { if (lane == 0) { ctl[row * 8 + 2] = -1; ctl[row * 8 + 3] = 0; } }
        else {
            const LAS u32x4* hp = (const LAS u32x4*)(hist + row * 1024 + 16 * lane);
            unsigned tot = 0;
#pragma unroll
            for (int q4 = 0; q4 < 4; ++q4) { const u32x4 hv = hp[q4];
                tot += (hv.x & 0xffffu) + (hv.x >> 16) + (hv.y & 0xffffu) + (hv.y >> 16) + (hv.z & 0xffffu) + (hv.z >> 16) + (hv.w & 0xffffu) + (hv.w >> 16); }
            unsigned suf = tot;
#pragma unroll
            for (int o = 1; o < 64; o <<= 1) { const unsigned v = __shfl_down(suf, o); if (lane + o < 64) suf += v; }
            const unsigned above_lane = suf - tot;
            const unsigned long long cross = __ballot(above_lane < 256u && suf >= 256u);
            const int lx = __builtin_ctzll(cross);
            const unsigned abovex = __shfl(above_lane, lx);
            const unsigned c2 = lane < 32 ? (unsigned)((const LAS unsigned short*)hist)[row * 2048 + 32 * lx + lane] : 0u;
            unsigned suf2 = c2;
#pragma unroll
            for (int o = 1; o < 32; o <<= 1) { const unsigned v = __shfl_down(suf2, o); if (lane + o < 32) suf2 += v; }
            const unsigned above2 = abovex + suf2 - c2;
            if (lane < 32 && above2 < 256u && above2 + c2 >= 256u) {
                const int bs = 32 * lx + lane; const unsigned cum = above2;
                ctl[row * 8 + 2] = bs; ctl[row * 8 + 3] = 256 - (int)cum;
            }
        }
    }
    __syncthreads();
    score_pass<2>(lds, proj, b, t0, nkb, wave, lane, afr, alin, wq, binv);
    __syncthreads();
#pragma unroll 1
    for (int i = 0; i < 2; ++i) {
        const int row = 2 * wave + i, n = t0 + row + 1;
        const int need = ctl[row * 8 + 3], base = ctl[row * 8 + 0];
        int nc = ctl[row * 8 + 1];
        if (lane == 0 && dbg) { if (nc > CANDCAP) atomicAdd(dbg + 5, 1u); if (need > nc) atomicAdd(dbg + 4, 1u); if (n > 256 && base + need != 256) atomicAdd(dbg + 6, 1u); atomicMax(dbg + 8, (unsigned)nc); }
        nc = nc < CANDCAP ? nc : CANDCAP;
        if (lane == 0) { const int nf = base + (need < nc ? need : nc); ctl[row * 8 + 4] = n <= 256 ? n : (nf < 256 ? nf : 256); }
        if (need > 0) {
            for (int c0 = 0; c0 < nc; c0 += 64) {
                const int ci = c0 + lane; const bool act = ci < nc;
                const u32x2 me = cand[row * CANDCAP + (act ? ci : 0)];
                const float msc = __uint_as_float(me.x); int rank = 0;
                for (int j = 0; j < nc; ++j) { const u32x2 ot = cand[row * CANDCAP + j]; const float osc = __uint_as_float(ot.x);
                    rank += (osc > msc || (osc == msc && ot.y < me.y)) ? 1 : 0; }
                if (act && rank < need) { sel[row * 256 + ((base + rank) & 255)] = (unsigned short)me.y; const int dd = t0 + row - (int)me.y; ((LAS unsigned short*)(lds + L_SELD))[row * 256 + ((base + rank) & 255)] = (unsigned short)((dd > 127 ? 127 : dd) * 32); }
            }
        }
    }
    __syncthreads();
    int tq_ = threadIdx.x; asm volatile("" : "+v"(tq_));
    const int lane_a = tq_ & 63;
    LAS unsigned char* vst = lds + L_VST + wave * (32 * VPITCH);
#pragma unroll 1
    for (int i = 0; i < 2; ++i) { const int lane = lane_a, kc = lane >> 4, n16 = lane & 15;
        const int row = 2 * wave + i, t = t0 + row; const int nvalid = ctl[row * 8 + 4];
        const _Float16* qrow = proj + (size_t)(b * S_ + t) * PW + C_QA;
        const int head = n16, hm = head & 7;
        f16x8 qb0, qb1;
        { const f16x8 z = {0, 0, 0, 0, 0, 0, 0, 0}; qb0 = z; qb1 = z;
          if (head < 8) { qb0 = *(const f16x8*)(qrow + head * 64 + 8 * kc); qb1 = *(const f16x8*)(qrow + head * 64 + 32 + 8 * kc); } }
        f32x4 ot[4];
#pragma unroll
        for (int dt = 0; dt < 4; ++dt) ot[dt] = (f32x4){0.f, 0.f, 0.f, 0.f};
        float mrun = -INFINITY, lrun = 0.f;
        const LAS unsigned short* selr = sel + row * 256;
        const LAS unsigned short* seldr = (const LAS unsigned short*)(lds + L_SELD) + row * 256;
        const LAS unsigned char* biasb = lds + L_BIAS + hm * 4;
        const _Float16* pbat = proj + (size_t)(b * S_) * PW;
        LAS unsigned char* kst = lds + L_HIST + wave * (32 * VPITCH);
        u32x4 gk[4], gv[4];
        const char* pbyte = (const char*)pbat;
#define DSA_GATHER(jj) do { _Pragma("unroll") for (int i_ = 0; i_ < 4; ++i_) { const int pos_ = 32 * (jj) + 8 * i_ + (lane >> 3); \
            const unsigned idx_ = pos_ < nvalid ? (unsigned)selr[pos_] : 0u; const char* rp_ = pbyte + (size_t)(idx_ * (unsigned)(PW * 2) + (unsigned)(C_KA * 2 + 16 * (lane & 7))); \
            gk[i_] = *(const u32x4*)rp_; gv[i_] = *(const u32x4*)(rp_ + 128); } } while (0)
        DSA_GATHER(0);
        const int nsteps = (nvalid + 31) >> 5;
#pragma unroll 1
        for (int j = 0; j < nsteps; ++j) {
#pragma unroll
            for (int i_ = 0; i_ < 4; ++i_) { const int ro = (8 * i_ + (lane >> 3)) * VPITCH + 16 * (lane & 7);
                *(LAS u32x4*)(kst + ro) = gk[i_]; *(LAS u32x4*)(vst + ro) = gv[i_]; }
            if (j + 1 < nsteps) DSA_GATHER(j + 1);
            asm volatile("s_waitcnt lgkmcnt(0)" ::: "memory");
            const f16x8 ca0 = *(const LAS f16x8*)(kst + n16 * VPITCH + 16 * kc), ca1 = *(const LAS f16x8*)(kst + n16 * VPITCH + 64 + 16 * kc);
            const f16x8 cb0 = *(const LAS f16x8*)(kst + (16 + n16) * VPITCH + 16 * kc), cb1 = *(const LAS f16x8*)(kst + (16 + n16) * VPITCH + 64 + 16 * kc);
            f32x4 sa = {0.f, 0.f, 0.f, 0.f}, sb = {0.f, 0.f, 0.f, 0.f};
            sa = __builtin_amdgcn_mfma_f32_16x16x32_f16(ca0, qb0, sa, 0, 0, 0); sa = __builtin_amdgcn_mfma_f32_16x16x32_f16(ca1, qb1, sa, 0, 0, 0);
            sb = __builtin_amdgcn_mfma_f32_16x16x32_f16(cb0, qb0, sb, 0, 0, 0); sb = __builtin_amdgcn_mfma_f32_16x16x32_f16(cb1, qb1, sb, 0, 0, 0);
            const int p0 = 32 * j + 4 * kc;
            const u32x2 iwa = *(const LAS u32x2*)(seldr + p0), iwb = *(const LAS u32x2*)(seldr + p0 + 16);
            const unsigned wa0 = iwa.x, wa1 = iwa.y, wb0 = iwb.x, wb1 = iwb.y;
            const unsigned bo[8] = {wa0 & 0xffffu, wa0 >> 16, wa1 & 0xffffu, wa1 >> 16, wb0 & 0xffffu, wb0 >> 16, wb1 & 0xffffu, wb1 >> 16};
            float v[8] = {sa.x, sa.y, sa.z, sa.w, sb.x, sb.y, sb.z, sb.w};
            float tm = -INFINITY;
#pragma unroll
            for (int e = 0; e < 8; ++e) {
                const bool ok = (p0 + (e & 3) + 16 * (e >> 2)) < nvalid;
                const float lg = v[e] * 0.125f + *(const LAS float*)(biasb + bo[e]);
                v[e] = ok ? lg : -INFINITY; tm = fmaxf(tm, v[e]);
            }
            tm = fmaxf(tm, __shfl_xor(tm, 16)); tm = fmaxf(tm, __shfl_xor(tm, 32));
            const float mn = fmaxf(mrun, tm);
            const float alpha = __expf(mrun - mn);
            float ps = 0.f;
#pragma unroll
            for (int e = 0; e < 8; ++e) { v[e] = __expf(v[e] - mn); ps += v[e]; }
            lrun = lrun * alpha + ps; mrun = mn;
#pragma unroll
            for (int dt = 0; dt < 4; ++dt) ot[dt] = ot[dt] * alpha;
            const f16x8 pfr = {(_Float16)v[0], (_Float16)v[1], (_Float16)v[2], (_Float16)v[3], (_Float16)v[4], (_Float16)v[5], (_Float16)v[6], (_Float16)v[7]};
            asm volatile("s_waitcnt lgkmcnt(0)" ::: "memory");
            const int q = n16 >> 2, p = n16 & 3;
#pragma unroll
            for (int dt = 0; dt < 4; ++dt) {
                const s16x4 ta = __builtin_amdgcn_ds_read_tr16_b64_v4i16((LAS s16x4*)(vst + (4 * kc + q) * VPITCH + (16 * dt + 4 * p) * 2));
                const s16x4 tb = __builtin_amdgcn_ds_read_tr16_b64_v4i16((LAS s16x4*)(vst + (16 + 4 * kc + q) * VPITCH + (16 * dt + 4 * p) * 2));
                const f16x4 fa = __builtin_bit_cast(f16x4, ta), fb = __builtin_bit_cast(f16x4, tb);
                const f16x8 vfr = {fa.x, fa.y, fa.z, fa.w, fb.x, fb.y, fb.z, fb.w};
                ot[dt] = __builtin_amdgcn_mfma_f32_16x16x32_f16(vfr, pfr, ot[dt], 0, 0, 0);
            }
            asm volatile("s_waitcnt lgkmcnt(0)" ::: "memory");
        }
#undef DSA_GATHER
        lrun += __shfl_xor(lrun, 16); lrun += __shfl_xor(lrun, 32);
        const float inv = 1.f / fmaxf(lrun, 1e-30f);
        if (head < 8) {
            _Float16* orow = o_a + (size_t)(b * S_ + t) * 512 + head * 64 + 4 * kc;
#pragma unroll
            for (int dt = 0; dt < 4; ++dt) { u32x2 w; w.x = pg8::pkh(ot[dt].x * inv, ot[dt].y * inv); w.y = pg8::pkh(ot[dt].z * inv, ot[dt].w * inv); *(u32x2*)(orow + 16 * dt) = w; }
        }
    }
    __syncthreads();
}
}

__global__ void __launch_bounds__(512, 2) k_dsa(const _Float16* __restrict__ proj, const float* __restrict__ rel_bias, _Float16* __restrict__ o_a, unsigned* dbg) {
    extern __shared__ __attribute__((aligned(16))) unsigned char lds_raw[];
    LAS unsigned char* lds = (LAS unsigned char*)lds_raw;
    { LAS float* biaslut = (LAS float*)(lds + dsa::L_BIAS);
      for (int i = threadIdx.x; i < 1024; i += 512) { const int d = i >> 3, h = i & 7; biaslut[i] = rel_bias[t5_bucket(d) * 16 + h]; } }
    __syncthreads();
    for (int p = blockIdx.x; p < 1024; p += gridDim.x) { const int b = p >> 7, j = p & 127;
        dsa::dsa_tile(lds, proj, o_a, b, 255 - j, dbg);
        dsa::dsa_tile(lds, proj, o_a, b, j, dbg); }
}


namespace nsa {
typedef _Float16 f16x8 __attribute__((ext_vector_type(8)));
typedef _Float16 f16x4 __attribute__((ext_vector_type(4)));
typedef short s16x4 __attribute__((ext_vector_type(4)));
typedef float f32x4 __attribute__((ext_vector_type(4)));
typedef float f32x16 __attribute__((ext_vector_type(16)));
typedef unsigned u32x4 __attribute__((ext_vector_type(4)));
typedef unsigned u32x2 __attribute__((ext_vector_type(2)));
constexpr int KP = 144, VP = 192;
constexpr int TILE_B = 64 * KP + 64 * VP;
constexpr int L_T0 = 0, L_BIAS = 2 * TILE_B, L_IMPA = L_BIAS + 4096, L_IMPC = L_IMPA + 16384, L_MASK = L_IMPC + 16384, L_END = L_MASK + 512;
static_assert(L_END <= 131072, "nsa LDS");
constexpr float LOG2E = 1.4426950408889634f;
constexpr float SC = 0.125f * LOG2E;

struct Src { const _Float16* k; const _Float16* v; int pitch; };

struct Stage { u32x4 kr, vr; };
__device__ __forceinline__ void stage_load(Stage& st, const Src& s, int row0, int tid, bool need_v) {
    const int r = tid >> 3, c = tid & 7;
    st.kr = *(const u32x4*)(s.k + (size_t)(row0 + r) * s.pitch + 8 * c);
    if (need_v) st.vr = *(const u32x4*)(s.v + (size_t)(row0 + r) * s.pitch + 8 * c);
}
__device__ __forceinline__ void stage_store(const Stage& st, LAS unsigned char* tb, int tid, bool need_v) {
    const int r = tid >> 3, c = tid & 7;
    *(LAS u32x4*)(tb + r * KP + 16 * c) = st.kr;
    if (need_v) *(LAS u32x4*)(tb + 64 * KP + r * VP + 16 * c) = st.vr;
}

struct RowState { float m, l; f32x16 o0, o1; };

__device__ __forceinline__ void qk_half(const LAS unsigned char* kt, const f16x8 (&qf)[4], int rho, int hi, int kh, f32x16& s0) {
#pragma unroll
    for (int i = 0; i < 16; ++i) s0[i] = 0.f;
    const LAS unsigned char* kb = kt + (32 * kh + rho) * KP + 16 * hi;
#pragma unroll
    for (int ks = 0; ks < 4; ++ks) {
        const f16x8 a0 = *(const LAS f16x8*)(kb + 32 * ks);
        s0 = __builtin_amdgcn_mfma_f32_32x32x16_f16(a0, qf[ks], s0, 0, 0, 0);
    }
}
__device__ __forceinline__ void logits(f32x16& s0, const LAS float* lut, int hb, int hi, int dbase, int dstep, int dlim, bool bit) {
#pragma unroll
    for (int rg = 0; rg < 16; ++rg) {
        const int kl = (rg & 3) + 8 * (rg >> 2) + 4 * hi;
        const int d = dbase - dstep * kl;
        int dc = d < 0 ? 0 : d; dc = dc > 127 ? 127 : dc;
        const float bias = lut[dc * 8 + hb];
        const bool ok = bit && d >= 0 && d < dlim;
        s0[rg] = ok ? fmaf(s0[rg], SC, bias) : -INFINITY;
    }
}
__device__ __forceinline__ void pv_half(RowState& rs, const f32x16& s0, const LAS unsigned char* vt, int rho, int hi, int kh) {
    const int l16 = rho & 15, g16 = rho >> 4, q = l16 >> 2, p = l16 & 3;
    const LAS unsigned char* vb = vt + (32 * kh + 4 * hi + q) * VP + (16 * g16 + 4 * p) * 2;
#pragma unroll
    for (int sx = 0; sx < 2; ++sx) {
        f16x8 pfr;
#pragma unroll
        for (int j = 0; j < 8; ++j) pfr[j] = (_Float16)s0[8 * sx + j];
#pragma unroll
        for (int dt = 0; dt < 2; ++dt) {
            const s16x4 ta = __builtin_amdgcn_ds_read_tr16_b64_v4i16((LAS s16x4*)(vb + (16 * sx) * VP + 64 * dt));
            const s16x4 tb = __builtin_amdgcn_ds_read_tr16_b64_v4i16((LAS s16x4*)(vb + (16 * sx + 8) * VP + 64 * dt));
            const f16x4 fa = __builtin_bit_cast(f16x4, ta), fb = __builtin_bit_cast(f16x4, tb);
            const f16x8 vfr = {fa.x, fa.y, fa.z, fa.w, fb.x, fb.y, fb.z, fb.w};
            if (dt == 0) rs.o0 = __builtin_amdgcn_mfma_f32_32x32x16_f16(vfr, pfr, rs.o0, 0, 0, 0);
            else rs.o1 = __builtin_amdgcn_mfma_f32_32x32x16_f16(vfr, pfr, rs.o1, 0, 0, 0);
        }
    }
}
__device__ __forceinline__ void rescale_if_needed(RowState& rs, float tmx) {
    if (__any(tmx > rs.m + 8.f)) {
        const float mn = fmaxf(rs.m, tmx);
        const float mu = (mn == -INFINITY) ? 0.f : mn;
        const float alpha = __builtin_amdgcn_exp2f(rs.m - mu);
        rs.l *= alpha; rs.m = mn;
#pragma unroll
        for (int i = 0; i < 16; ++i) { rs.o0[i] *= alpha; rs.o1[i] *= alpha; }
    }
}
__device__ __forceinline__ void tile_fast(RowState& rs, const LAS unsigned char* kt, const LAS unsigned char* vt, const f16x8 (&qf)[4], float c, int rho, int hi) {
    const LAS unsigned char* kb = kt + rho * KP + 16 * hi;
    f16x8 ka[4], kb2[4];
#pragma unroll
    for (int ks = 0; ks < 4; ++ks) { ka[ks] = *(const LAS f16x8*)(kb + 32 * ks); kb2[ks] = *(const LAS f16x8*)(kb + 32 * KP + 32 * ks); }
    const int l16 = rho & 15, g16 = rho >> 4, q = l16 >> 2, p = l16 & 3;
    const LAS unsigned char* vb = vt + (4 * hi + q) * VP + (16 * g16 + 4 * p) * 2;
    s16x4 va[4][2], vc[4][2];
    __builtin_amdgcn_sched_barrier(0);
    f32x16 s0, s1;
#pragma unroll
    for (int i = 0; i < 16; ++i) { s0[i] = 0.f; s1[i] = 0.f; }
#pragma unroll
    for (int ks = 0; ks < 4; ++ks) {
        s0 = __builtin_amdgcn_mfma_f32_32x32x16_f16(ka[ks], qf[ks], s0, 0, 0, 0);
        s1 = __builtin_amdgcn_mfma_f32_32x32x16_f16(kb2[ks], qf[ks], s1, 0, 0, 0);
    }
    __builtin_amdgcn_sched_barrier(0);
#pragma unroll
    for (int st = 0; st < 4; ++st)
#pragma unroll
        for (int dt = 0; dt < 2; ++dt) {
            va[st][dt] = __builtin_amdgcn_ds_read_tr16_b64_v4i16((LAS s16x4*)(vb + (16 * st) * VP + 64 * dt));
            vc[st][dt] = __builtin_amdgcn_ds_read_tr16_b64_v4i16((LAS s16x4*)(vb + (16 * st + 8) * VP + 64 * dt));
        }
    __builtin_amdgcn_sched_barrier(0);
    float tm = -INFINITY;
#pragma unroll
    for (int i = 0; i < 16; ++i) tm = fmaxf(tm, fmaxf(s0[i], s1[i]));
    { const auto r2 = __builtin_amdgcn_permlane32_swap(__float_as_uint(tm), __float_as_uint(tm), false, false); tm = fmaxf(__uint_as_float(r2[0]), __uint_as_float(r2[1])); }
    rescale_if_needed(rs, fmaf(tm, SC, c));
    const float mu = (rs.m == -INFINITY) ? 0.f : rs.m;
    const float cm = c - mu;
    float ps = 0.f;
#pragma unroll
    for (int i = 0; i < 16; ++i) { s0[i] = __builtin_amdgcn_exp2f(fmaf(s0[i], SC, cm)); s1[i] = __builtin_amdgcn_exp2f(fmaf(s1[i], SC, cm)); ps += s0[i] + s1[i]; }
    rs.l += ps;
#pragma unroll
    for (int st = 0; st < 4; ++st) {
        f16x8 pfr;
#pragma unroll
        for (int j = 0; j < 8; ++j) pfr[j] = (_Float16)((st & 2) ? s1[8 * (st & 1) + j] : s0[8 * (st & 1) + j]);
#pragma unroll
        for (int dt = 0; dt < 2; ++dt) {
            const f16x4 fa = __builtin_bit_cast(f16x4, va[st][dt]), fb = __builtin_bit_cast(f16x4, vc[st][dt]);
            const f16x8 vfr = {fa.x, fa.y, fa.z, fa.w, fb.x, fb.y, fb.z, fb.w};
            if (dt == 0) rs.o0 = __builtin_amdgcn_mfma_f32_32x32x16_f16(vfr, pfr, rs.o0, 0, 0, 0);
            else rs.o1 = __builtin_amdgcn_mfma_f32_32x32x16_f16(vfr, pfr, rs.o1, 0, 0, 0);
        }
    }
}
template <bool IMP>
__device__ __forceinline__ void tile_general(RowState& rs, const LAS unsigned char* kt, const LAS unsigned char* vt, const f16x8 (&qf)[4], const LAS float* lut, int hb, int rho, int hi,
                                             int dbase, int dstep, unsigned dlim, float mc, float invl, LAS float* impA, LAS float* impC, int n, bool wr) {
    const LAS unsigned char* kb = kt + rho * KP + 16 * hi;
    f16x8 ka[4], kb2[4];
#pragma unroll
    for (int ks = 0; ks < 4; ++ks) { ka[ks] = *(const LAS f16x8*)(kb + 32 * ks); kb2[ks] = *(const LAS f16x8*)(kb + 32 * KP + 32 * ks); }
    const int d0 = dbase - dstep * 4 * hi;
    __builtin_amdgcn_sched_barrier(0);
    f32x16 s0, s1;
#pragma unroll
    for (int i = 0; i < 16; ++i) { s0[i] = 0.f; s1[i] = 0.f; }
#pragma unroll
    for (int ks = 0; ks < 4; ++ks) {
        s0 = __builtin_amdgcn_mfma_f32_32x32x16_f16(ka[ks], qf[ks], s0, 0, 0, 0);
        s1 = __builtin_amdgcn_mfma_f32_32x32x16_f16(kb2[ks], qf[ks], s1, 0, 0, 0);
    }
    __builtin_amdgcn_sched_barrier(0);
    float b0[16], b1[16];
#pragma unroll
    for (int rg = 0; rg < 16; ++rg) {
        const int kl = (rg & 3) + 8 * (rg >> 2);
        int da = d0 - dstep * kl, db = d0 - dstep * (kl + 32);
        da = da < 0 ? 0 : da; da = da > 127 ? 127 : da; db = db < 0 ? 0 : db; db = db > 127 ? 127 : db;
        b0[rg] = lut[da * 8 + hb]; b1[rg] = lut[db * 8 + hb];
    }
    float tm = -INFINITY;
#pragma unroll
    for (int rg = 0; rg < 16; ++rg) {
        const int kl = (rg & 3) + 8 * (rg >> 2);
        const unsigned da = (unsigned)(d0 - dstep * kl), db = (unsigned)(d0 - dstep * (kl + 32));
        s0[rg] = da < dlim ? fmaf(s0[rg], SC, b0[rg]) : -INFINITY;
        s1[rg] = db < dlim ? fmaf(s1[rg], SC, b1[rg]) : -INFINITY;
        tm = fmaxf(tm, fmaxf(s0[rg], s1[rg]));
    }
    __builtin_amdgcn_sched_barrier(0);
    const int l16 = rho & 15, g16 = rho >> 4, q = l16 >> 2, p = l16 & 3;
    const LAS unsigned char* vb = vt + (4 * hi + q) * VP + (16 * g16 + 4 * p) * 2;
    s16x4 va[4][2], vc[4][2];
    if (!IMP) {
#pragma unroll
        for (int st = 0; st < 4; ++st)
#pragma unroll
            for (int dt = 0; dt < 2; ++dt) {
                va[st][dt] = __builtin_amdgcn_ds_read_tr16_b64_v4i16((LAS s16x4*)(vb + (16 * st) * VP + 64 * dt));
                vc[st][dt] = __builtin_amdgcn_ds_read_tr16_b64_v4i16((LAS s16x4*)(vb + (16 * st + 8) * VP + 64 * dt));
            }
        __builtin_amdgcn_sched_barrier(0);
    }
    if (!IMP) {
        { const auto r2 = __builtin_amdgcn_permlane32_swap(__float_as_uint(tm), __float_as_uint(tm), false, false); tm = fmaxf(__uint_as_float(r2[0]), __uint_as_float(r2[1])); }
        rescale_if_needed(rs, tm);
        const float mu = (rs.m == -INFINITY) ? 0.f : rs.m;
        float ps = 0.f;
#pragma unroll
        for (int i = 0; i < 16; ++i) { s0[i] = __builtin_amdgcn_exp2f(s0[i] - mu); s1[i] = __builtin_amdgcn_exp2f(s1[i] - mu); ps += s0[i] + s1[i]; }
        rs.l += ps;
#pragma unroll
        for (int st = 0; st < 4; ++st) {
            f16x8 pfr;
#pragma unroll
            for (int j = 0; j < 8; ++j) pfr[j] = (_Float16)((st & 2) ? s1[8 * (st & 1) + j] : s0[8 * (st & 1) + j]);
#pragma unroll
            for (int dt = 0; dt < 2; ++dt) {
                const f16x4 fa = __builtin_bit_cast(f16x4, va[st][dt]), fb = __builtin_bit_cast(f16x4, vc[st][dt]);
                const f16x8 vfr = {fa.x, fa.y, fa.z, fa.w, fb.x, fb.y, fb.z, fb.w};
                if (dt == 0) rs.o0 = __builtin_amdgcn_mfma_f32_32x32x16_f16(vfr, pfr, rs.o0, 0, 0, 0);
                else rs.o1 = __builtin_amdgcn_mfma_f32_32x32x16_f16(vfr, pfr, rs.o1, 0, 0, 0);
            }
        }
    } else {
        const float mu = (mc == -INFINITY) ? 0.f : mc;
#pragma unroll
        for (int kh = 0; kh < 2; ++kh)
#pragma unroll
            for (int ii = 0; ii < 4; ++ii) {
                float pv[4];
#pragma unroll
                for (int e = 0; e < 4; ++e) pv[e] = __builtin_amdgcn_exp2f((kh ? s1[4 * ii + e] : s0[4 * ii + e]) - mu) * invl;
                float a = (pv[0] + pv[1]) + (pv[2] + 0.5f * pv[3]), c = 0.5f * pv[3];
                a += __shfl_xor(a, 1); a += __shfl_xor(a, 2); c += __shfl_xor(c, 1); c += __shfl_xor(c, 2);
                const int nb = 16 * n + 8 * kh + 2 * ii + hi;
                if (wr) { impA[nb] = a; if (nb + 1 < 64) impC[nb + 1] = c; }
            }
    }
}
__device__ __forceinline__ void probs(RowState& rs, f32x16& s0, float sc, float c) {
    float tm = -INFINITY;
#pragma unroll
    for (int i = 0; i < 16; ++i) tm = fmaxf(tm, s0[i]);
    tm = fmaxf(tm, __shfl_xor(tm, 32));
    rescale_if_needed(rs, fmaf(tm, sc, c));
    const float mu = (rs.m == -INFINITY) ? 0.f : rs.m;
    const float cm = c - mu;
    float ps = 0.f;
#pragma unroll
    for (int i = 0; i < 16; ++i) { s0[i] = __builtin_amdgcn_exp2f(fmaf(s0[i], sc, cm)); ps += s0[i]; }
    rs.l += ps;
}
__device__ __forceinline__ void rs_init(RowState& rs) { rs.m = -INFINITY; rs.l = 0.f;
#pragma unroll
    for (int i = 0; i < 16; ++i) { rs.o0[i] = 0.f; rs.o1[i] = 0.f; } }
__device__ __forceinline__ void rs_flush(RowState& rs, float gate, _Float16* orow, bool first) {
    const float lt = rs.l + __shfl_xor(rs.l, 32);
    const float w = gate / fmaxf(lt, 1e-30f);
#pragma unroll
    for (int i = 0; i < 4; ++i) {
        float a[8] = {w * rs.o0[4 * i], w * rs.o0[4 * i + 1], w * rs.o0[4 * i + 2], w * rs.o0[4 * i + 3], w * rs.o1[4 * i], w * rs.o1[4 * i + 1], w * rs.o1[4 * i + 2], w * rs.o1[4 * i + 3]};
        if (!first) { const u32x2 p0 = *(const u32x2*)(orow + 8 * i), p1 = *(const u32x2*)(orow + 32 + 8 * i);
            const unsigned u0 = p0.x, u1 = p0.y, u2 = p1.x, u3 = p1.y; const pg8::f16x2 h0 = __builtin_bit_cast(pg8::f16x2, u0), h1 = __builtin_bit_cast(pg8::f16x2, u1), h2 = __builtin_bit_cast(pg8::f16x2, u2), h3 = __builtin_bit_cast(pg8::f16x2, u3);
            a[0] += (float)h0.x; a[1] += (float)h0.y; a[2] += (float)h1.x; a[3] += (float)h1.y; a[4] += (float)h2.x; a[5] += (float)h2.y; a[6] += (float)h3.x; a[7] += (float)h3.y; }
        u32x2 w0; w0.x = pg8::pkh(a[0], a[1]); w0.y = pg8::pkh(a[2], a[3]); *(u32x2*)(orow + 8 * i) = w0;
        u32x2 w1; w1.x = pg8::pkh(a[4], a[5]); w1.y = pg8::pkh(a[6], a[7]); *(u32x2*)(orow + 32 + 8 * i) = w1;
    }
}

__device__ __forceinline__ void nsa_unit(LAS unsigned char* lds, const _Float16* __restrict__ proj, const _Float16* __restrict__ kcmp, const _Float16* __restrict__ vcmp,
                                         _Float16* __restrict__ o_b, int b, int g, int qb) {
    const int tid = threadIdx.x, lane = tid & 63, wave = __builtin_amdgcn_readfirstlane(tid >> 6);
    const int rho = lane & 31, hi = lane >> 5, ql = rho >> 2, r = rho & 3, hb = g * 4 + r;
    const int t = 64 * qb + 8 * wave + ql;
    const _Float16* prow = proj + (size_t)(b * S_ + t) * PW;
    f16x8 qf[4];
#pragma unroll
    for (int ks = 0; ks < 4; ++ks) qf[ks] = *(const f16x8*)(prow + C_QB + hb * 64 + 16 * ks + 8 * hi);
    for (int i = tid; i < 2048; i += 512) ((LAS u32x4*)(lds + L_IMPA))[i] = (u32x4){0u, 0u, 0u, 0u};
    RowState rs; rs_init(rs);
    const LAS float* lut = (const LAS float*)(lds + L_BIAS);
    const float bias31 = lut[127 * 8 + hb];
    const _Float16* kc = kcmp + (size_t)(b * 2 + g) * 256 * 64;
    const long vcoff = (vcmp + (size_t)(b * 2 + g) * 256 * 64) - kc;
    const _Float16* pb = proj + (size_t)(b * S_) * PW + C_KVB + g * 64;
    const int ncmp = (4 * qb + 3 + 63) / 64;
    const int wlo = qb - 8 > 0 ? qb - 8 : 0;
    const int e0 = ncmp, e1 = 2 * ncmp, e2 = e1 + qb + 1, NT = e2 + (qb - wlo + 1);
    const int sr = tid >> 3, scq = tid & 7;
    float mc = 0.f, invl = 0.f; unsigned mlo = 0u, mhi = 0u;
    Stage stg;
#define NSA_DECODE(i, br, n) do { if ((i) < e0) { br = 0; n = (i); } else if ((i) < e1) { br = 1; n = (i) - e0; } else if ((i) < e2) { br = 2; n = (i) - e1; } else { br = 3; n = wlo + (i) - e2; } } while (0)
#define NSA_LOAD(i) do { int br_, n_; NSA_DECODE(i, br_, n_); const _Float16* kp_ = (br_ < 2) ? kc : (br_ == 2 ? pb + 2 * 128 : pb + 4 * 128); const int pitch_ = (br_ < 2) ? 64 : PW; \
        const long vo_ = (br_ < 2) ? vcoff : 128; const _Float16* rp_ = kp_ + (size_t)(64 * n_ + sr) * pitch_ + 8 * scq; stg.kr = *(const u32x4*)rp_; stg.vr = *(const u32x4*)(rp_ + vo_); } while (0)
#define NSA_STORE(buf) do { LAS unsigned char* tb_ = lds + L_T0 + (buf) * TILE_B; *(LAS u32x4*)(tb_ + sr * KP + 16 * scq) = stg.kr; *(LAS u32x4*)(tb_ + 64 * KP + sr * VP + 16 * scq) = stg.vr; } while (0)
    __syncthreads();
    NSA_LOAD(0); NSA_STORE(0);
    __syncthreads();
#pragma unroll 1
    for (int i = 0; i < NT; ++i) {
        int br, n; NSA_DECODE(i, br, n);
        const LAS unsigned char* tb = lds + L_T0 + (i & 1) * TILE_B;
        const bool more = i + 1 < NT;
        if (more) NSA_LOAD(i + 1);
        bool bit = true; int dbase, dstep = 1, dlim = 1 << 30; bool near = true;
        if (br < 2) { dbase = t - 31 - 1024 * n; dstep = 16; }
        else { dbase = t - 64 * n; near = n >= qb - 2; if (br == 2) bit = (n < 32) ? ((mlo >> n) & 1u) : ((mhi >> (n - 32)) & 1u); else dlim = 512; }
        const bool interior = (br >= 2) && (n <= qb - 3) && !(br == 3 && n == qb - 8);
        const bool skip = (br == 2) && !__any(bit);
        if (!skip) {
            if (interior) tile_fast(rs, tb, tb + 64 * KP, qf, bit ? bias31 : -INFINITY, rho, hi);
            else {
                const unsigned dl = bit ? (unsigned)dlim : 0u;
                int tq = threadIdx.x; asm volatile("" : "+v"(tq));
                LAS float* impA = (LAS float*)(lds + L_IMPA) + ((tq >> 6) * 8 + ((tq & 31) >> 2)) * 64;
                LAS float* impC = (LAS float*)(lds + L_IMPC) + ((tq >> 6) * 8 + ((tq & 31) >> 2)) * 64;
                if (br != 1) tile_general<false>(rs, tb, tb + 64 * KP, qf, lut, hb, rho, hi, dbase, dstep, dl, 0.f, 0.f, impA, impC, n, false);
                else tile_general<true>(rs, tb, tb + 64 * KP, qf, lut, hb, rho, hi, dbase, dstep, dl, mc, invl, impA, impC, n, r == 0);
            }
        }
        if (i + 1 == e0) {
            mc = rs.m; const float lc = rs.l + __shfl_xor(rs.l, 32); invl = 1.f / fmaxf(lc, 1e-30f);
            rs_flush(rs, pg8::sigm((float)prow[C_GB + 0 * 8 + hb]), o_b + (size_t)(b * S_ + t) * 512 + hb * 64 + 4 * hi, true); rs_init(rs);
        } else if (i + 1 == e1) {
            asm volatile("s_waitcnt lgkmcnt(0)" ::: "memory");
            int tq = threadIdx.x; asm volatile("" : "+v"(tq));
            const int qs = (tq & 63) >> 3, j = tq & 7, wv = tq >> 6;
            LAS float* sA = (LAS float*)(lds + L_IMPA) + (wv * 8 + qs) * 64;
            const LAS float* sC = (const LAS float*)(lds + L_IMPC) + (wv * 8 + qs) * 64;
            float sc[8];
#pragma unroll
            for (int e = 0; e < 8; ++e) { const int nn = 8 * j + e; const bool forced = (nn == 0) || (nn == qb) || (nn == qb - 1);
                sc[e] = (nn <= qb) ? (forced ? 1.0e4f : (sA[nn] + sC[nn])) : -INFINITY; }
            asm volatile("s_waitcnt lgkmcnt(0)" ::: "memory");
#pragma unroll
            for (int e = 0; e < 8; ++e) sA[8 * j + e] = sc[e];
            asm volatile("s_waitcnt lgkmcnt(0)" ::: "memory");
            int rank[8];
#pragma unroll
            for (int e = 0; e < 8; ++e) rank[e] = 0;
            for (int m = 0; m <= qb; ++m) { const float sm = sA[m];
#pragma unroll
                for (int e = 0; e < 8; ++e) rank[e] += (sm > sc[e] || (sm == sc[e] && m < 8 * j + e)) ? 1 : 0; }
            unsigned bits = 0;
#pragma unroll
            for (int e = 0; e < 8; ++e) bits |= ((8 * j + e <= qb) && rank[e] < 16) ? (1u << e) : 0u;
            ((LAS unsigned char*)(lds + L_MASK))[(wv * 8 + qs) * 8 + j] = (unsigned char)bits;
            asm volatile("s_waitcnt lgkmcnt(0)" ::: "memory");
            const u32x2 mk = *(const LAS u32x2*)(lds + L_MASK + (wv * 8 + ((tq & 31) >> 2)) * 8);
            mlo = mk.x; mhi = mk.y;
        } else if (i + 1 == e2) {
            rs_flush(rs, pg8::sigm((float)prow[C_GB + 1 * 8 + hb]), o_b + (size_t)(b * S_ + t) * 512 + hb * 64 + 4 * hi, false); rs_init(rs);
        } else if (i + 1 == NT) {
            rs_flush(rs, pg8::sigm((float)prow[C_GB + 2 * 8 + hb]), o_b + (size_t)(b * S_ + t) * 512 + hb * 64 + 4 * hi, false);
        }
        if (more) NSA_STORE((i + 1) & 1);
        __syncthreads();
    }
#undef NSA_DECODE
#undef NSA_LOAD
#undef NSA_STORE
}
}

__global__ void __launch_bounds__(512, 2) k_nsa(const _Float16* __restrict__ proj, const float* __restrict__ rel_bias, const _Float16* __restrict__ kcmp, const _Float16* __restrict__ vcmp, _Float16* __restrict__ o_b) {
    extern __shared__ __attribute__((aligned(16))) unsigned char lds_raw[];
    LAS unsigned char* lds = (LAS unsigned char*)lds_raw;
    { LAS float* lut = (LAS float*)(lds + nsa::L_BIAS);
      for (int i = threadIdx.x; i < 1024; i += 512) { const int d = i >> 3, h = i & 7; lut[i] = rel_bias[t5_bucket(d) * 16 + 8 + h] * nsa::LOG2E; } }
    __syncthreads();
#pragma unroll 1
    for (int u = blockIdx.x; u < 1024; u += gridDim.x) { const int p = u & 511, bg = p >> 5, j = p & 31;
        nsa::nsa_unit(lds, proj, kcmp, vcmp, o_b, bg >> 1, bg & 1, (u < 512) ? 63 - j : j);
        __syncthreads(); }
}
__global__ __launch_bounds__(128) void compress_h(const __half* __restrict__ proj, const float* __restrict__ pe_k, const float* __restrict__ w1_k, const float* __restrict__ w2_k,
                                                  const float* __restrict__ pe_v, const float* __restrict__ w1_v, const float* __restrict__ w2_v, __half* __restrict__ kcmp, __half* __restrict__ vcmp) {
    __shared__ float blk[2048];
    __shared__ float hid[128];
    int id = blockIdx.x; const int kv = id & 1; id >>= 1; const int g = id & 1; id >>= 1; const int c = id & 255, b = id >> 8;
    const float* pe = kv ? pe_v : pe_k; const float* w1 = kv ? w1_v : w1_k; const float* w2 = kv ? w2_v : w2_k;
    const int tid = threadIdx.x;
    __half* dst = (kv ? vcmp : kcmp) + ((size_t)(b * 2 + g) * 256 + c) * 64;
    if (c == 255) { if (tid < 64) dst[tid] = __float2half(0.f); return; }
    for (int i = tid; i < 2048; i += 128) { const int l = i >> 6, d = i & 63;
        blk[i] = __half2float(proj[(size_t)(b * S_ + 16 * c + l) * PW + C_KVB + kv * 128 + g * 64 + d]) + pe[i]; }
    __syncthreads();
    { float a = 0.f; for (int k = 0; k < 2048; ++k) a += blk[k] * w1[k * 128 + tid];
      const float x3 = a * a * a; hid[tid] = 0.5f * a * (1.f + tanhf(0.7978845608028654f * (a + 0.044715f * x3))); }
    __syncthreads();
    if (tid < 64) { float a = 0.f; for (int k = 0; k < 128; ++k) a += hid[k] * w2[k * 64 + tid]; dst[tid] = __float2half(a); }
}


namespace cmpx {
typedef _Float16 f16x8 __attribute__((ext_vector_type(8)));
typedef float f32x4 __attribute__((ext_vector_type(4)));
typedef unsigned u32x4 __attribute__((ext_vector_type(4)));
constexpr int L_PART = 0, L_HID = 65536, HIDP = 272, L_END = L_HID + 16 * HIDP;
__device__ __forceinline__ void item(LAS unsigned char* lds, const _Float16* __restrict__ proj, const float* __restrict__ pe, const _Float16* __restrict__ w1t, const _Float16* __restrict__ w2t,
                                     _Float16* __restrict__ dst, int b, int g, int kv, int ct) {
    const int tid = threadIdx.x, lane = tid & 63, wave = __builtin_amdgcn_readfirstlane(tid >> 6), kc = lane >> 4, n16 = lane & 15;
    f32x4 acc[8];
#pragma unroll
    for (int nt = 0; nt < 8; ++nt) acc[nt] = (f32x4){0.f, 0.f, 0.f, 0.f};
    const int c = 16 * ct + n16;
#pragma unroll 2
    for (int ks = 0; ks < 8; ++ks) {
        const int k0 = 32 * (8 * wave + ks) + 8 * kc, lt = k0 >> 6, d = k0 & 63;
        int trow = 16 * c + lt; trow = trow > S_ - 1 ? S_ - 1 : trow;
        const f16x8 raw = *(const f16x8*)(proj + (size_t)(b * S_ + trow) * PW + C_KVB + kv * 128 + g * 64 + d);
        const f32x4 p0 = *(const f32x4*)(pe + lt * 64 + d), p1 = *(const f32x4*)(pe + lt * 64 + d + 4);
        f16x8 afr;
        afr[0] = (_Float16)((float)raw[0] + p0.x); afr[1] = (_Float16)((float)raw[1] + p0.y); afr[2] = (_Float16)((float)raw[2] + p0.z); afr[3] = (_Float16)((float)raw[3] + p0.w);
        afr[4] = (_Float16)((float)raw[4] + p1.x); afr[5] = (_Float16)((float)raw[5] + p1.y); afr[6] = (_Float16)((float)raw[6] + p1.z); afr[7] = (_Float16)((float)raw[7] + p1.w);
#pragma unroll
        for (int nt = 0; nt < 8; ++nt) {
            const f16x8 bfr = *(const f16x8*)(w1t + (size_t)(16 * nt + n16) * 2048 + k0);
            acc[nt] = __builtin_amdgcn_mfma_f32_16x16x32_f16(afr, bfr, acc[nt], 0, 0, 0);
        }
    }
    LAS float* part = (LAS float*)(lds + L_PART) + wave * 2048;
#pragma unroll
    for (int nt = 0; nt < 8; ++nt) { part[(4 * kc + 0) * 128 + 16 * nt + n16] = acc[nt].x; part[(4 * kc + 1) * 128 + 16 * nt + n16] = acc[nt].y;
        part[(4 * kc + 2) * 128 + 16 * nt + n16] = acc[nt].z; part[(4 * kc + 3) * 128 + 16 * nt + n16] = acc[nt].w; }
    __syncthreads();
    { const LAS float* pp = (const LAS float*)(lds + L_PART);
#pragma unroll
      for (int e = 0; e < 4; ++e) { const int o = tid + 512 * e; float a = 0.f;
#pragma unroll
          for (int w = 0; w < 8; ++w) a += pp[w * 2048 + o];
          const float z = 0.7978845608028654f * (a + 0.044715f * a * a * a);
          const float th = 1.f - 2.f / (__expf(2.f * z) + 1.f);
          ((LAS _Float16*)(lds + L_HID + (o >> 7) * HIDP))[o & 127] = (_Float16)(0.5f * a * (1.f + th)); } }
    __syncthreads();
    if (wave < 4) {
        f32x4 o = {0.f, 0.f, 0.f, 0.f};
#pragma unroll
        for (int ks = 0; ks < 4; ++ks) {
            const f16x8 afr = *(const LAS f16x8*)(lds + L_HID + n16 * HIDP + (32 * ks + 8 * kc) * 2);
            const f16x8 bfr = *(const f16x8*)(w2t + (size_t)(16 * wave + n16) * 128 + 32 * ks + 8 * kc);
            o = __builtin_amdgcn_mfma_f32_16x16x32_f16(afr, bfr, o, 0, 0, 0);
        }
        const float ov[4] = {o.x, o.y, o.z, o.w};
#pragma unroll
        for (int e = 0; e < 4; ++e) { const int cc = 16 * ct + 4 * kc + e; dst[((size_t)(b * 2 + g) * 256 + cc) * 64 + 16 * wave + n16] = (_Float16)(cc == 255 ? 0.f : ov[e]); }
    }
    __syncthreads();
}
}

__global__ void k_cmp_rows(const __half* __restrict__ a, const __half* __restrict__ ref, unsigned* __restrict__ dbg) {
    const int row = blockIdx.x * 4 + (threadIdx.x >> 6), lane = threadIdx.x & 63;
    float num = 0.f, den = 0.f; bool nan = false;
    for (int i = lane; i < 512; i += 64) { const float x = __half2float(a[(size_t)row * 512 + i]), y = __half2float(ref[(size_t)row * 512 + i]);
        nan |= !(x == x); num += (x - y) * (x - y); den += y * y; }
    for (int o = 32; o > 0; o >>= 1) { num += __shfl_xor(num, o); den += __shfl_xor(den, o); }
    const bool anynan = __any(nan);
    if (lane == 0) { if (anynan) atomicAdd(dbg + 1, 1u); else if (num > 0.0025f * den) atomicAdd(dbg + 0, 1u); }
}
__global__ void k_dbg_scale(float* __restrict__ out, const unsigned* __restrict__ dbg) {
    const unsigned nbad = dbg[0], nnan = dbg[1];
    int code = 0; if (dbg[5]) code = 30; else if (dbg[6]) code = 28; else if (nnan) code = 20 + (31 - __clz((int)nnan)) / 2; else if (nbad) code = 1 + (31 - __clz((int)nbad));
    const float sc = 1.f + 0.2f * code;
    const size_t i = (size_t)blockIdx.x * 256 + threadIdx.x; out[i] *= sc;
}
template <typename TA, typename Epi>
__global__ __launch_bounds__(256) void gemm_naive(const TA* __restrict__ A, const float* __restrict__ Bm, Epi epi, int lda, int ldb, int K, int pad_) {
    __shared__ float As[16][68];
    __shared__ float Bs[16][68];
    const int tid = threadIdx.x, tx = tid & 15, ty = tid >> 4;
    const int m0 = blockIdx.y * 64, n0 = blockIdx.x * 64;
    float acc[4][4];
#pragma unroll
    for (int i = 0; i < 4; ++i)
#pragma unroll
        for (int j = 0; j < 4; ++j) acc[i][j] = 0.f;
    for (int k0 = 0; k0 < K; k0 += 16) {
#pragma unroll
        for (int i = 0; i < 4; ++i) { const int e = tid + i * 256; const int m = e >> 4, k = e & 15; As[k][m] = (float)A[(size_t)(m0 + m) * lda + k0 + k]; }
#pragma unroll
        for (int i = 0; i < 4; ++i) { const int e = tid + i * 256; const int k = e >> 6, n = e & 63; Bs[k][n] = Bm[(size_t)(k0 + k) * ldb + n0 + n]; }
        __syncthreads();
#pragma unroll
        for (int k = 0; k < 16; ++k) {
            float a[4], b[4];
#pragma unroll
            for (int i = 0; i < 4; ++i) { a[i] = As[k][ty * 4 + i]; b[i] = Bs[k][tx * 4 + i]; }
#pragma unroll
            for (int i = 0; i < 4; ++i)
#pragma unroll
                for (int j = 0; j < 4; ++j) acc[i][j] += a[i] * b[j];
        }
        __syncthreads();
    }
#pragma unroll
    for (int i = 0; i < 4; ++i)
#pragma unroll
        for (int j = 0; j < 4; ++j) epi(m0 + ty * 4 + i, n0 + tx * 4 + j, acc[i][j]);
}


struct NEpiMixA { __half* mix; const __half* proj; __device__ void operator()(int r, int c, float v) const {
    const float g = __half2float(proj[(size_t)r * PW + C_GATE + c]); mix[(size_t)r * D_ + c] = __float2half(g * v); } };
struct NEpiMixB { __half* mix; const __half* proj; __device__ void operator()(int r, int c, float v) const {
    const float g = __half2float(proj[(size_t)r * PW + C_GATE + 1024 + c]); mix[(size_t)r * D_ + c] = __float2half(__half2float(mix[(size_t)r * D_ + c]) + g * v); } };
__global__ void k_gate(const __half* __restrict__ tmp, const __half* __restrict__ proj, __half* __restrict__ mix) {
    const size_t i = (size_t)blockIdx.x * 256 + threadIdx.x; const size_t r = i >> 10; const int c = (int)(i & 1023);
    mix[i] = __float2half(__half2float(tmp[i]) * __half2float(proj[r * PW + C_GATE + c]));
}
__global__ __launch_bounds__(256) void dsa_naive(const __half* __restrict__ proj, const float* __restrict__ rel_bias, __half* __restrict__ o_a) {
    __shared__ float qs[8][32];
    __shared__ float wv[8];
    __shared__ unsigned keys[4096];
    __shared__ int sel[256];
    __shared__ int nsel_s;
    __shared__ unsigned hist[256];
    __shared__ unsigned sel_prefix, sel_k;
    __shared__ float qa[8][64];
    __shared__ float p[8][256];
    const int row = blockIdx.x, tid = threadIdx.x, b = row / S_, t = row % S_;
    const __half* pr = proj + (size_t)row * PW;
    { const int h = tid >> 5, d = tid & 31; qs[h][d] = __half2float(pr[C_QI + h * 32 + d]); }
    if (tid < 8) wv[tid] = __half2float(pr[C_WI + tid]) * (1.f / 16.f);
    for (int i = tid; i < 512; i += 256) qa[i >> 6][i & 63] = __half2float(pr[C_QA + i]);
    if (tid == 0) nsel_s = 0;
    __syncthreads();
    const int n = t + 1;
    for (int s = tid; s < n; s += 256) {
        const __half* kr = proj + (size_t)(b * S_ + s) * PW + C_KI;
        float a8[8];
#pragma unroll
        for (int h = 0; h < 8; ++h) a8[h] = 0.f;
#pragma unroll 4
        for (int d = 0; d < 32; ++d) { const float kvd = __half2float(kr[d]);
#pragma unroll
            for (int h = 0; h < 8; ++h) a8[h] += qs[h][d] * kvd; }
        float sc = 0.f;
#pragma unroll
        for (int h = 0; h < 8; ++h) sc += wv[h] * (a8[h] > 0.f ? a8[h] : 0.f);
        unsigned u = __float_as_uint(sc);
        keys[s] = (u & 0x80000000u) ? ~u : (u | 0x80000000u);
    }
    __syncthreads();
    if (n <= 256) {
        if (tid < n) sel[tid] = tid;
        if (tid == 0) nsel_s = n;
        __syncthreads();
    } else {
        unsigned prefix = 0, mask = 0, kk = 256;
        for (int shift = 24; shift >= 0; shift -= 8) {
            hist[tid] = 0;
            __syncthreads();
            for (int s = tid; s < n; s += 256) { const unsigned k = keys[s]; if ((k & mask) == prefix) atomicAdd(&hist[(k >> shift) & 255u], 1u); }
            __syncthreads();
            if (tid == 0) { unsigned cum = 0; int d = 255; for (; d > 0; --d) { if (cum + hist[d] >= kk) break; cum += hist[d]; } sel_prefix = prefix | ((unsigned)d << shift); sel_k = kk - cum; }
            __syncthreads();
            prefix = sel_prefix; kk = sel_k; mask |= 0xFFu << shift;
            __syncthreads();
        }
        const unsigned T = prefix;
        for (int s = tid; s < n; s += 256) if (keys[s] > T) { const int pos = atomicAdd(&nsel_s, 1); sel[pos] = s; }
        __syncthreads();
        if (tid == 0) { int pos = nsel_s; unsigned need = kk; for (int s = 0; s < n && need > 0; ++s) if (keys[s] == T) { sel[pos++] = s; --need; } nsel_s = pos; }
        __syncthreads();
    }
    const int ns = nsel_s;
    {
        const int j = tid;
        if (j < ns) {
            const int idx = sel[j];
            const __half* kr = proj + (size_t)(b * S_ + idx) * PW + C_KA;
            float a8[8];
#pragma unroll
            for (int h = 0; h < 8; ++h) a8[h] = 0.f;
#pragma unroll 4
            for (int d = 0; d < 64; ++d) { const float kvd = __half2float(kr[d]);
#pragma unroll
                for (int h = 0; h < 8; ++h) a8[h] += qa[h][d] * kvd; }
            const int bk = t5_bucket(t - idx);
#pragma unroll
            for (int h = 0; h < 8; ++h) p[h][j] = a8[h] * 0.125f + rel_bias[bk * 16 + h];
        } else {
#pragma unroll
            for (int h = 0; h < 8; ++h) p[h][j] = -INFINITY;
        }
    }
    __syncthreads();
    {
        const int w = tid >> 6, lane = tid & 63;
        for (int hh = 0; hh < 2; ++hh) { const int h = w * 2 + hh;
            float v[4], mx = -INFINITY;
#pragma unroll
            for (int i = 0; i < 4; ++i) { v[i] = p[h][lane + 64 * i]; mx = fmaxf(mx, v[i]); }
#pragma unroll
            for (int o = 32; o > 0; o >>= 1) mx = fmaxf(mx, __shfl_xor(mx, o));
            float sm = 0.f;
#pragma unroll
            for (int i = 0; i < 4; ++i) { v[i] = (v[i] == -INFINITY) ? 0.f : expf(v[i] - mx); sm += v[i]; }
#pragma unroll
            for (int o = 32; o > 0; o >>= 1) sm += __shfl_xor(sm, o);
            const float inv = 1.f / fmaxf(sm, 1e-30f);
#pragma unroll
            for (int i = 0; i < 4; ++i) p[h][lane + 64 * i] = v[i] * inv; }
    }
    __syncthreads();
    for (int o = tid; o < 512; o += 256) { const int h = o >> 6, d = o & 63; float a = 0.f;
        for (int j = 0; j < ns; ++j) a += p[h][j] * __half2float(proj[(size_t)(b * S_ + sel[j]) * PW + C_VA + d]);
        o_a[(size_t)row * 512 + o] = __float2half(a); }
}

__global__ __launch_bounds__(128) void compress_naive(const __half* __restrict__ proj, const float* __restrict__ pe_k, const float* __restrict__ w1_k, const float* __restrict__ w2_k,
                                                      const float* __restrict__ pe_v, const float* __restrict__ w1_v, const float* __restrict__ w2_v, float* __restrict__ kcmp, float* __restrict__ vcmp) {
    __shared__ float blk[2048];
    __shared__ float hid[128];
    int id = blockIdx.x; const int kv = id & 1; id >>= 1; const int g = id & 1; id >>= 1; const int c = id % NC, b = id / NC;
    const float* pe = kv ? pe_v : pe_k; const float* w1 = kv ? w1_v : w1_k; const float* w2 = kv ? w2_v : w2_k;
    const int tid = threadIdx.x;
    for (int i = tid; i < 2048; i += 128) { const int l = i >> 6, d = i & 63;
        blk[i] = __half2float(proj[(size_t)(b * S_ + 16 * c + l) * PW + C_KVB + kv * 128 + g * 64 + d]) + pe[i]; }
    __syncthreads();
    { float a = 0.f; for (int k = 0; k < 2048; ++k) a += blk[k] * w1[k * 128 + tid];
      const float x3 = a * a * a; hid[tid] = 0.5f * a * (1.f + tanhf(0.7978845608028654f * (a + 0.044715f * x3))); }
    __syncthreads();
    if (tid < 64) { float a = 0.f; for (int k = 0; k < 128; ++k) a += hid[k] * w2[k * 64 + tid];
        (kv ? vcmp : kcmp)[((size_t)(b * NC + c) * 2 + g) * 64 + tid] = a; }
}

__device__ __forceinline__ void softmax_row(float* pr, int n, int lane) {
    float mx = -INFINITY;
    for (int i = lane; i < n; i += 64) mx = fmaxf(mx, pr[i]);
#pragma unroll
    for (int o = 32; o > 0; o >>= 1) mx = fmaxf(mx, __shfl_xor(mx, o));
    float sm = 0.f;
    for (int i = lane; i < n; i += 64) { const float v = pr[i]; const float e = (v == -INFINITY) ? 0.f : expf(v - mx); pr[i] = e; sm += e; }
#pragma unroll
    for (int o = 32; o > 0; o >>= 1) sm += __shfl_xor(sm, o);
    const float inv = 1.f / fmaxf(sm, 1e-30f);
    for (int i = lane; i < n; i += 64) pr[i] *= inv;
}

__global__ __launch_bounds__(256) void nsa_naive(const __half* __restrict__ proj, const float* __restrict__ rel_bias, const float* __restrict__ kcmp, const float* __restrict__ vcmp, __half* __restrict__ o_b) {
    __shared__ float q[4][64];
    __shared__ float lg[4][1024];
    __shared__ float score[64];
    __shared__ int sb[16];
    __shared__ int nsb;
    const int id = blockIdx.x, g = id & 1, row = id >> 1, b = row / S_, t = row % S_, tid = threadIdx.x;
    const int w = tid >> 6, lane = tid & 63;
    const __half* pr = proj + (size_t)row * PW;
    q[tid >> 6][tid & 63] = __half2float(pr[C_QB + g * 256 + tid]);
    if (tid == 0) nsb = 0;
    __syncthreads();
    const int cur = t >> 6;
    const int nv = t >= 31 ? (t - 31) / 16 + 1 : 0;
    const int r_ = tid >> 6, d_ = tid & 63;
    float oc = 0.f, os = 0.f, ow = 0.f;
    for (int i = tid; i < 4 * nv; i += 256) { const int r = i / nv, c = i % nv;
        const float* kr = kcmp + ((size_t)(b * NC + c) * 2 + g) * 64; float a = 0.f;
        for (int d = 0; d < 64; ++d) a += q[r][d] * kr[d];
        lg[r][c] = a * 0.125f + rel_bias[t5_bucket(t - (16 * c + 31)) * 16 + 8 + g * 4 + r]; }
    __syncthreads();
    if (nv > 0) softmax_row(lg[w], nv, lane);
    __syncthreads();
    for (int c = 0; c < nv; ++c) oc += lg[r_][c] * vcmp[((size_t)(b * NC + c) * 2 + g) * 64 + d_];
    if (tid < 64) { const int nb = tid; float imp = 0.f;
        for (int r = 0; r < 4; ++r) for (int c = 4 * nb - 1; c <= 4 * nb + 3; ++c) if (c >= 0 && c < nv) imp += lg[r][c] * ((c == 4 * nb - 1 || c == 4 * nb + 3) ? 0.5f : 1.f);
        const bool valid = nb <= cur; const bool forced = nb == 0 || nb == cur || nb == cur - 1;
        score[nb] = valid ? (forced ? 1.0e4f : imp) : -INFINITY; }
    __syncthreads();
    if (tid < 64) { bool selq = false;
        if (tid <= cur) { const float sc = score[tid]; int rank = 0;
            for (int m = 0; m <= cur; ++m) { const float sm = score[m]; rank += (sm > sc || (sm == sc && m < tid)) ? 1 : 0; }
            selq = rank < 16; }
        const unsigned long long bm = __ballot(selq);
        if (selq) sb[__popcll(bm & ((1ull << tid) - 1ull))] = tid;
        if (tid == 0) nsb = __popcll(bm); }
    __syncthreads();
    const int ns = nsb;
    for (int i = tid; i < 4 * ns * 64; i += 256) { const int r = i / (ns * 64), j = i % (ns * 64); const int pos = sb[j >> 6] * 64 + (j & 63);
        float v = -INFINITY;
        if (pos <= t) { const __half* kr = proj + (size_t)(b * S_ + pos) * PW + C_KVB + 2 * 128 + g * 64; float a = 0.f;
            for (int d = 0; d < 64; ++d) a += q[r][d] * __half2float(kr[d]);
            v = a * 0.125f + rel_bias[t5_bucket(t - pos) * 16 + 8 + g * 4 + r]; }
        lg[r][j] = v; }
    __syncthreads();
    softmax_row(lg[w], ns * 64, lane);
    __syncthreads();
    for (int j = 0; j < ns * 64; ++j) { const float pj = lg[r_][j]; if (pj != 0.f) { const int pos = sb[j >> 6] * 64 + (j & 63);
        os += pj * __half2float(proj[(size_t)(b * S_ + pos) * PW + C_KVB + 3 * 128 + g * 64 + d_]); } }
    __syncthreads();
    const int p0 = t - 511 > 0 ? t - 511 : 0; const int nw = t - p0 + 1;
    for (int i = tid; i < 4 * nw; i += 256) { const int r = i / nw, j = i % nw; const int pos = p0 + j;
        const __half* kr = proj + (size_t)(b * S_ + pos) * PW + C_KVB + 4 * 128 + g * 64; float a = 0.f;
        for (int d = 0; d < 64; ++d) a += q[r][d] * __half2float(kr[d]);
        lg[r][j] = a * 0.125f + rel_bias[t5_bucket(t - pos) * 16 + 8 + g * 4 + r]; }
    __syncthreads();
    softmax_row(lg[w], nw, lane);
    __syncthreads();
    for (int j = 0; j < nw; ++j) ow += lg[r_][j] * __half2float(proj[(size_t)(b * S_ + p0 + j) * PW + C_KVB + 5 * 128 + g * 64 + d_]);
    const float g0 = sigmoidf_(__half2float(pr[C_GB + 0 * 8 + g * 4 + r_])), g1 = sigmoidf_(__half2float(pr[C_GB + 1 * 8 + g * 4 + r_])), g2 = sigmoidf_(__half2float(pr[C_GB + 2 * 8 + g * 4 + r_]));
    o_b[(size_t)row * 512 + (g * 4 + r_) * 64 + d_] = __float2half(g0 * oc + g1 * os + g2 * ow);
}

__global__ __launch_bounds__(256) void final_norm_k(float* __restrict__ xio, const float* __restrict__ g) {
    __shared__ float red[4];
    const int row = blockIdx.x, tid = threadIdx.x;
    float* xr = xio + (size_t)row * D_;
    float v[4]; float ss = 0.f;
#pragma unroll
    for (int i = 0; i < 4; ++i) { v[i] = xr[tid + i * 256]; ss += v[i] * v[i]; }
#pragma unroll
    for (int o = 32; o > 0; o >>= 1) ss += __shfl_xor(ss, o);
    if ((tid & 63) == 0) red[tid >> 6] = ss;
    __syncthreads();
    const float rs = rsqrtf((red[0] + red[1] + red[2] + red[3]) / D_ + EPS);
#pragma unroll
    for (int i = 0; i < 4; ++i) xr[tid + i * 256] = v[i] * rs * g[tid + i * 256];
}


#define XB_TMO      128
#define XB_XCNT(j)  (256  + 64 * (j))
#define XB_XSUB(j)  (1280 + 64 * (j))
#define XB_XGEN(j)  (2304 + 64 * (j))
#define XB_TOP      3328
#define XB_TOPGEN   3392
#define XCD_BAR_WORDS 3456
#define XB_SPIN_CAP (1u << 18)
__device__ __forceinline__ unsigned xb_ld(unsigned* p)              { return __hip_atomic_load(p, __ATOMIC_RELAXED, __HIP_MEMORY_SCOPE_AGENT); }
__device__ __forceinline__ unsigned xb_add(unsigned* p, unsigned v) { return __hip_atomic_fetch_add(p, v, __ATOMIC_RELAXED, __HIP_MEMORY_SCOPE_AGENT); }
__device__ __forceinline__ unsigned xb_xcc_id() { return (unsigned)__builtin_amdgcn_s_getreg((3 << 11) | 20) & 0xFu; }
#define XB_SPIN(cond, bar) do { unsigned _sp = 0; while (cond) { __builtin_amdgcn_s_sleep(1); \
    if ((++_sp & 255u) == 0u) { if (xb_ld(&(bar)[XB_TMO])) break; if (_sp > XB_SPIN_CAP) { atomicAdd(&(bar)[XB_TMO], 1u); break; } } } } while (0)
struct XcdBarrier { unsigned* bar; unsigned x; volatile LAS unsigned* st; };
__device__ __forceinline__ XcdBarrier xcd_barrier_post(unsigned* bar, volatile LAS unsigned* st) {
    XcdBarrier b; b.bar = bar; b.x = xb_xcc_id(); b.st = st;
    if (threadIdx.x == 0) (void)xb_add(&bar[XB_XCNT(b.x)], 1u);
    return b;
}
__device__ __forceinline__ void xcd_barrier_complete(unsigned* bar, unsigned x, unsigned& nloc, unsigned& nx) {
    const unsigned G = gridDim.x * gridDim.y * gridDim.z;
    unsigned sum, cnt, mine, sp = 0u;
    for (;;) {
        sum = 0u; cnt = 0u; mine = 0u;
#pragma unroll
        for (unsigned j = 0; j < 16; ++j) { const unsigned c = xb_ld(&bar[XB_XCNT(j)]); sum += c; cnt += (c > 0u) ? 1u : 0u; mine = (j == x) ? c : mine; }
        if (sum == G) break;
        __builtin_amdgcn_s_sleep(1);
        if ((++sp & 255u) == 0u) { if (xb_ld(&bar[XB_TMO])) break; if (sp > XB_SPIN_CAP) { atomicAdd(&bar[XB_TMO], 1u); break; } }
    }
    nloc = mine > 0u ? mine : 1u; nx = cnt > 0u ? cnt : 1u;
}
__device__ __forceinline__ void xcd_barrier(const XcdBarrier& b) {
    asm volatile("s_waitcnt vmcnt(0)" ::: "memory");
    __syncthreads();
    if (threadIdx.x == 0) {
        unsigned* bar = b.bar;
        __builtin_amdgcn_s_waitcnt(0);
        unsigned nloc = b.st[0], nx = b.st[1];
        if (nloc == 0u) { xcd_barrier_complete(bar, b.x, nloc, nx); b.st[0] = nloc; b.st[1] = nx; }
        const unsigned old = xb_add(&bar[XB_XSUB(b.x)], 1u);
        const unsigned gen = old / nloc;
        if (old + 1u == (gen + 1u) * nloc) {
            __builtin_amdgcn_fence(__ATOMIC_RELEASE, "agent");
            asm volatile("s_waitcnt vmcnt(0)" ::: "memory");
            const unsigned og = xb_add(&bar[XB_TOP], 1u);
            const unsigned tg = og / nx;
            if (og + 1u == (tg + 1u) * nx) xb_add(&bar[XB_TOPGEN], 1u);
            else XB_SPIN(xb_ld(&bar[XB_TOPGEN]) == tg, bar);
            __builtin_amdgcn_fence(__ATOMIC_ACQUIRE, "agent");
            xb_add(&bar[XB_XGEN(b.x)], 1u);
            asm volatile("s_waitcnt vmcnt(0)" ::: "memory");
        } else {
            XB_SPIN(xb_ld(&bar[XB_XGEN(b.x)]) == gen, bar);
            __builtin_amdgcn_fence(__ATOMIC_ACQUIRE, "agent");
            asm volatile("s_waitcnt vmcnt(0)" ::: "memory");
        }
    }
    __syncthreads();
}

constexpr int MEGA_LDS = 131072 + 256;

template <class Epi>
__device__ __forceinline__ void gemm_run(LAS unsigned char* lds, const void* A, const void* Bt, const Epi& E, int M, int N, int K) {
    pg8::Gemm g{(const pg8::bf16_t*)A, (const pg8::bf16_t*)Bt, M, N, K};
    pg8::StaticOrder S; S.init(M, N, (int)gridDim.x, (int)blockIdx.x);
    pg8::gemm_phase<Epi, pg8::StaticOrder, true, true>(lds, g, S, E);
}

__global__ void __launch_bounds__(512, 2) mega_fwd(Args a) {
    extern __shared__ __attribute__((aligned(16))) unsigned char lds_raw[];
    LAS unsigned char* lds = (LAS unsigned char*)lds_raw;
    unsigned char* ws = a.ws;
    if (threadIdx.x == 0) *(LAS dsa::u32x4*)(lds + 131072) = (dsa::u32x4){0u, 0u, 0u, 0u};
    __syncthreads();
    XcdBarrier bar = xcd_barrier_post((unsigned*)(ws + WS_CTL), (volatile LAS unsigned*)(lds + 131072));
    const _Float16* proj = (const _Float16*)(ws + WS_PROJ);
    _Float16* o_a = (_Float16*)(ws + WS_H); _Float16* o_b = (_Float16*)(ws + WS_H + 32 * MiB);
    _Float16* kcmp = (_Float16*)(ws + WS_KCMP); _Float16* vcmp = (_Float16*)(ws + WS_VCMP);

    prologue_body(a, lds_raw);
    xcd_barrier(bar);
    gemm_run(lds, ws + WS_H, ws + WS_WIN, pg8::EpiProj{(_Float16*)(ws + WS_PROJ)}, M_, PW, D_);
    xcd_barrier(bar);
#pragma unroll 1
    for (int it = blockIdx.x; it < 512; it += gridDim.x) { const int ct = it & 15, kv = (it >> 4) & 1, g = (it >> 5) & 1, b = it >> 6;
        cmpx::item(lds, proj, kv ? a.pe_v : a.pe_k, (const _Float16*)(ws + WS_CW + (kv ? 512 * 1024 : 0)), (const _Float16*)(ws + WS_CW + 1024 * 1024 + (kv ? 16384 : 0)), kv ? vcmp : kcmp, b, g, kv, ct); }
    { LAS float* biaslut = (LAS float*)(lds + dsa::L_BIAS);
      for (int i = threadIdx.x; i < 1024; i += 512) { const int d = i >> 3, h = i & 7; biaslut[i] = a.rel_bias[t5_bucket(d) * 16 + h]; } }
    __syncthreads();
#pragma unroll 1
    for (int v = blockIdx.x >> 3; v < 256; v += (gridDim.x >> 3)) { const int b = blockIdx.x & 7, j = v & 127;
        dsa::dsa_tile(lds, proj, o_a, b, (v < 128) ? 255 - j : j, nullptr); }
    xcd_barrier(bar);
    { LAS float* lut = (LAS float*)(lds + nsa::L_BIAS);
      for (int i = threadIdx.x; i < 1024; i += 512) { const int d = i >> 3, h = i & 7; lut[i] = a.rel_bias[t5_bucket(d) * 16 + 8 + h] * nsa::LOG2E; } }
    __syncthreads();
#pragma unroll 1
    for (int v = blockIdx.x >> 3; v < 128; v += (gridDim.x >> 3)) { const int bg = 2 * (blockIdx.x & 7) + (v >> 6), j = v & 31;
        nsa::nsa_unit(lds, proj, kcmp, vcmp, o_b, bg >> 1, bg & 1, (v & 32) ? j : 63 - j);
        __syncthreads(); }
    xcd_barrier(bar);
    gemm_run(lds, ws + WS_H, ws + WS_WBA, pg8::EpiMix<0>{(_Float16*)(ws + WS_MIX), proj}, M_, D_, 512);
    asm volatile("s_waitcnt vmcnt(0)" ::: "memory");
    __syncthreads();
    gemm_run(lds, ws + WS_H + 32 * MiB, ws + WS_WBB, pg8::EpiMix<1>{(_Float16*)(ws + WS_MIX), proj}, M_, D_, 512);
    xcd_barrier(bar);
    gemm_run(lds, ws + WS_MIX, ws + WS_WOUT, pg8::EpiResidSq{a.x, a.out, (_Float16*)(ws + WS_H), (float*)(ws + WS_ROWSQ)}, M_, D_, D_);
    xcd_barrier(bar);
    gemm_run(lds, ws + WS_H, ws + WS_WMI, pg8::EpiRelu2N{(_Float16*)(ws + WS_PROJ), (const float*)(ws + WS_ROWSQ)}, M_, DFF, D_);
    xcd_barrier(bar);
    gemm_run(lds, ws + WS_PROJ, ws + WS_WMO, EpiAccOut{a.out}, M_, D_, DFF);
    xcd_barrier(bar);
    { int tx = threadIdx.x; asm volatile("" : "+v"(tx)); const int lane = tx & 63; for (int m = blockIdx.x * 8 + (tx >> 6); m < M_; m += gridDim.x * 8) final_norm_row(a.out + (size_t)m * D_, a.norm_final, lane); }
}
}

extern "C" void kernel_launch(void* const* d_in, const int* in_sizes, int n_in, void* d_out, int out_size, void* d_ws, size_t ws_size, hipStream_t stream) {
    if (ws_size < WS_END) { fprintf(stderr, "ws too small: %zu\n", ws_size); return; }
    static int grid = 0;
    if (!grid) {
        int dev = 0, cus = 0, per_cu = 0;
        (void)hipGetDevice(&dev);
        (void)hipDeviceGetAttribute(&cus, hipDeviceAttributeMultiprocessorCount, dev);
        (void)hipFuncSetAttribute((const void*)mega_fwd, hipFuncAttributeMaxDynamicSharedMemorySize, MEGA_LDS);
        (void)hipOccupancyMaxActiveBlocksPerMultiprocessor(&per_cu, (const void*)mega_fwd, 512, MEGA_LDS);
        (void)hipGetLastError();
        grid = cus;
        if (per_cu < 1) fprintf(stderr, "occupancy query says %d blocks/CU\n", per_cu);
    }
    Args a{};
    a.x = (const float*)d_in[0]; a.norm_mix = (const float*)d_in[1]; a.w_in = (const float*)d_in[2];
    a.pe_k = (const float*)d_in[3]; a.w1_k = (const float*)d_in[4]; a.w2_k = (const float*)d_in[5];
    a.pe_v = (const float*)d_in[6]; a.w1_v = (const float*)d_in[7]; a.w2_v = (const float*)d_in[8];
    a.rel_bias = (const float*)d_in[9]; a.w_ba = (const float*)d_in[10]; a.w_bb = (const float*)d_in[11];
    a.w_out = (const float*)d_in[12]; a.norm_mlp = (const float*)d_in[13]; a.w_mi = (const float*)d_in[14];
    a.w_mo = (const float*)d_in[15]; a.norm_final = (const float*)d_in[16];
    a.out = (float*)d_out; a.ws = (unsigned char*)d_ws;
    (void)hipMemsetAsync(d_ws, 0, 196608, stream);
    hipLaunchKernelGGL(mega_fwd, dim3(grid), dim3(512), MEGA_LDS, stream, a);
}
```

```cpp
#include <hip/hip_runtime.h>
#include <hip/hip_fp16.h>
#include <cstdint>
#include <cstdio>

namespace pg8 {
#define PG8_LAS __attribute__((address_space(3)))
typedef unsigned short bf16_t;
typedef _Float16 bf16x8 __attribute__((ext_vector_type(8)));
typedef float f32x4 __attribute__((ext_vector_type(4)));
typedef unsigned u32x4 __attribute__((ext_vector_type(4)));
constexpr int BM = 256, BK = 64, HALF = 128, HTB = HALF * BK * 2  , STAGE_BYTES = 8 * HTB, NXCD = 8, WGM = 8;

__host__ __device__ __forceinline__ int lds_byte(int r, int c) { const int st = (r >> 4) * 2 + (c >> 5), rr = r & 15, cc = c & 31, ob = rr * 64 + cc * 2; return st * 1024 + (ob ^ (((ob >> 9) & 1) << 5)); }
__host__ __device__ __forceinline__ void stage_rc(int b, int& R, int& C) { const int st = b / 1024, sb = b % 1024, swz = sb ^ (((sb >> 9) & 1) << 5); R = (st >> 1) * 16 + swz / 64; C = (st & 1) * 32 + (swz % 64) / 2; }
__host__ __device__ __forceinline__ int perm32(int rho) { const int n = rho >> 4, i = rho & 15; return 8 * (i >> 2) + 4 * n + (i & 3); }

struct Unit { int pm, pn; };
struct Gemm { const bf16_t* A; const bf16_t* Bt; int M, N, K; };

struct StaticOrder {
    int nM, nN, nwg, G, c;
    __host__ __device__ void init(int M, int N, int G_, int c_) { nM = M / BM; nN = N / BM; nwg = nM * nN; G = G_; c = c_; }
    __host__ __device__ bool next(int i, Unit& u) const {
        const long L = (long)i * G + c; if (L >= nwg) return false;
        int wgid = (int)L; { const int q = nwg / NXCD, r = nwg % NXCD, xcd = wgid % NXCD, off = wgid / NXCD; wgid = (xcd < r ? xcd * (q + 1) : r * (q + 1) + (xcd - r) * q) + off; }
        const int nig = WGM * nN, gid = wgid / nig, fm = gid * WGM, gsz = (nM - fm) < WGM ? (nM - fm) : WGM;
        u.pm = fm + ((wgid % nig) % gsz); u.pn = (wgid % nig) / gsz; return true;
    }
    __device__ __forceinline__ void a_ready(const Unit&) const {}
    __device__ __forceinline__ void done(const Unit&) const {}
};


typedef unsigned u32x2 __attribute__((ext_vector_type(2)));
typedef float f32x2 __attribute__((ext_vector_type(2)));
typedef _Float16 f16x2 __attribute__((ext_vector_type(2)));
constexpr int PW = 4352;
__device__ __forceinline__ unsigned pkh(float a, float b) { f32x2 v = {a, b}; f16x2 h = __builtin_convertvector(v, f16x2); return __builtin_bit_cast(unsigned, h); }
__device__ __forceinline__ float sigm(float v) { return __builtin_amdgcn_rcpf(1.f + __expf(-v)); }
__device__ __forceinline__ float sigm_gate(float v) { return fmaxf(sigm(v), 6.2e-5f); }
__device__ __forceinline__ void unpk8(const u32x4 w, float (&f)[8]) {
#pragma unroll
    for (int i = 0; i < 4; ++i) { const unsigned wi = (i == 0) ? w.x : (i == 1) ? w.y : (i == 2) ? w.z : w.w; const f16x2 h = __builtin_bit_cast(f16x2, wi); f[2 * i] = (float)h.x; f[2 * i + 1] = (float)h.y; } }

struct EpiProj {
    static constexpr bool PERM = true, AFTER_DRAIN = false, MID = false;
    _Float16* O;
    __device__ __forceinline__ void operator()(const f32x4 (&acc)[2][2][4][2], const Unit& u, int wr, int wc, int fr, int fq) const {
        const int row0 = u.pm * BM + wr * 64 + fr, col0 = u.pn * BM + wc * 32 + 8 * fq; const bool sg = u.pn >= 9;
#pragma unroll
        for (int ai = 0; ai < 2; ++ai)
#pragma unroll
            for (int m = 0; m < 4; ++m) { _Float16* rowp = O + (size_t)(row0 + ai * HALF + m * 16) * PW + col0;
#pragma unroll
                for (int bj = 0; bj < 2; ++bj) { f32x4 v0 = acc[ai][bj][m][0], v1 = acc[ai][bj][m][1];
                    if (sg) {
#pragma unroll
                        for (int i = 0; i < 4; ++i) { v0[i] = sigm_gate(v0[i]); v1[i] = sigm_gate(v1[i]); } }
                    u32x4 w; w.x = pkh(v0[0], v0[1]); w.y = pkh(v0[2], v0[3]); w.z = pkh(v1[0], v1[1]); w.w = pkh(v1[2], v1[3]);
                    *(u32x4*)(rowp + bj * HALF) = w; } }
    }
};
struct EpiMixF {
    static constexpr bool PERM = true, AFTER_DRAIN = false, MID = true;
    _Float16* mix; const _Float16* proj;
    __device__ __forceinline__ void mid(f32x4 (&acc)[2][2][4][2], const Unit& u, int wr, int wc, int fr, int fq) const {
        int row0 = u.pm * BM + wr * 64 + fr, col0 = u.pn * BM + wc * 32 + 8 * fq;
        asm volatile("" : "+v"(row0), "+v"(col0));
#pragma unroll
        for (int ai = 0; ai < 2; ++ai)
#pragma unroll
            for (int m = 0; m < 4; ++m) { const _Float16* gr = proj + (size_t)(row0 + ai * HALF + m * 16) * PW + 2304 + col0;
#pragma unroll
                for (int bj = 0; bj < 2; ++bj)
#pragma unroll
                    for (int n = 0; n < 2; ++n) {
                        const u32x2 wa = *(const u32x2*)(gr + bj * HALF + 4 * n), wb = *(const u32x2*)(gr + 1024 + bj * HALF + 4 * n);
                        const unsigned a0 = wa.x, a1 = wa.y, b0 = wb.x, b1 = wb.y;
                        const f16x2 ga0 = __builtin_bit_cast(f16x2, a0), ga1 = __builtin_bit_cast(f16x2, a1), gb0 = __builtin_bit_cast(f16x2, b0), gb1 = __builtin_bit_cast(f16x2, b1);
                        acc[ai][bj][m][n][0] *= (float)ga0.x * __builtin_amdgcn_rcpf((float)gb0.x); acc[ai][bj][m][n][1] *= (float)ga0.y * __builtin_amdgcn_rcpf((float)gb0.y);
                        acc[ai][bj][m][n][2] *= (float)ga1.x * __builtin_amdgcn_rcpf((float)gb1.x); acc[ai][bj][m][n][3] *= (float)ga1.y * __builtin_amdgcn_rcpf((float)gb1.y);
                        __builtin_amdgcn_sched_barrier(0);
                    } }
    }
    __device__ __forceinline__ void operator()(const f32x4 (&acc)[2][2][4][2], const Unit& u, int wr, int wc, int fr, int fq) const {
        const int row0 = u.pm * BM + wr * 64 + fr, col0 = u.pn * BM + wc * 32 + 8 * fq;
#pragma unroll
        for (int ai = 0; ai < 2; ++ai)
#pragma unroll
            for (int m = 0; m < 4; ++m) { const size_t r = (size_t)(row0 + ai * HALF + m * 16);
#pragma unroll
                for (int bj = 0; bj < 2; ++bj) { const int c = col0 + bj * HALF;
                    float gb[8]; unpk8(*(const u32x4*)(proj + r * PW + 3328 + c), gb);
                    const f32x4 v0 = acc[ai][bj][m][0], v1 = acc[ai][bj][m][1];
                    u32x4 w; w.x = pkh(gb[0] * v0[0], gb[1] * v0[1]); w.y = pkh(gb[2] * v0[2], gb[3] * v0[3]); w.z = pkh(gb[4] * v1[0], gb[5] * v1[1]); w.w = pkh(gb[6] * v1[2], gb[7] * v1[3]);
                    *(u32x4*)(mix + r * 1024 + c) = w; } }
    }
};
struct EpiResidSq {
    static constexpr bool PERM = true, AFTER_DRAIN = false, MID = false;
    const float* x; float* out; _Float16* xh; float* rowsq;
    __device__ __forceinline__ void operator()(const f32x4 (&acc)[2][2][4][2], const Unit& u, int wr, int wc, int fr, int fq) const {
        const int row0 = u.pm * BM + wr * 64 + fr, col0 = u.pn * BM + wc * 32 + 8 * fq;
#pragma unroll
        for (int ai = 0; ai < 2; ++ai)
#pragma unroll
            for (int m = 0; m < 4; ++m) { const size_t r = (size_t)(row0 + ai * HALF + m * 16); float sq = 0.f;
#pragma unroll
                for (int bj = 0; bj < 2; ++bj) { const size_t o = r * 1024 + col0 + bj * HALF;
                    const f32x4 a0 = *(const f32x4*)(x + o) + acc[ai][bj][m][0], a1 = *(const f32x4*)(x + o + 4) + acc[ai][bj][m][1];
                    u32x4 w; w.x = pkh(a0[0], a0[1]); w.y = pkh(a0[2], a0[3]); w.z = pkh(a1[0], a1[1]); w.w = pkh(a1[2], a1[3]);
                    *(u32x4*)(xh + o) = w;
                    sq += (a0[0] * a0[0] + a0[1] * a0[1]) + (a0[2] * a0[2] + a0[3] * a0[3]) + (a1[0] * a1[0] + a1[1] * a1[1]) + (a1[2] * a1[2] + a1[3] * a1[3]); }
                sq += __shfl_xor(sq, 16); sq += __shfl_xor(sq, 32);
                if (fq == 0) atomicAdd(rowsq + r, sq); }
    }
};
struct EpiRelu2N {
    static constexpr bool PERM = true, AFTER_DRAIN = false, MID = false;
    _Float16* U; const float* rowsq;
    __device__ __forceinline__ void operator()(const f32x4 (&acc)[2][2][4][2], const Unit& u, int wr, int wc, int fr, int fq) const {
        const int row0 = u.pm * BM + wr * 64 + fr, col0 = u.pn * BM + wc * 32 + 8 * fq;
#pragma unroll
        for (int ai = 0; ai < 2; ++ai)
#pragma unroll
            for (int m = 0; m < 4; ++m) { const int r = row0 + ai * HALF + m * 16; _Float16* rowp = U + (size_t)r * 4096 + col0;
                const float inv = 1.f / (rowsq[r] * (1.f / 1024.f) + 1e-6f);
#pragma unroll
                for (int bj = 0; bj < 2; ++bj) { f32x4 v0 = acc[ai][bj][m][0], v1 = acc[ai][bj][m][1];
#pragma unroll
                    for (int i = 0; i < 4; ++i) { const float a = fmaxf(v0[i], 0.f), b = fmaxf(v1[i], 0.f); v0[i] = a * a * inv; v1[i] = b * b * inv; }
                    u32x4 w; w.x = pkh(v0[0], v0[1]); w.y = pkh(v0[2], v0[3]); w.z = pkh(v1[0], v1[1]); w.w = pkh(v1[2], v1[3]);
                    *(u32x4*)(rowp + bj * HALF) = w; } }
    }
};
template <class Epi, class Sched, bool ALIGN_EPI = false, bool SP2 = false>
__device__ __forceinline__ void gemm_phase(PG8_LAS unsigned char* lds, const Gemm g, const Sched& S, const Epi& E) {
    int tid_ = threadIdx.x; asm volatile("" : "+v"(tid_));
    const int tid = tid_, wid = __builtin_amdgcn_readfirstlane(tid >> 6), lane = tid & 63, wr = wid >> 2, wc = wid & 3, fr = lane & 15, fq = lane >> 4;
    const int K = g.K, nt = K / BK;
    unsigned voffA[2], voffB[2];
#pragma unroll
    for (int i = 0; i < 2; ++i) { int R, C; stage_rc(tid * 16 + i * 8192, R, C); const int Rb = Epi::PERM ? ((R & ~31) + perm32(R & 31)) : R;
        voffA[i] = (unsigned)(R * K + C) * 2u; voffB[i] = (unsigned)(Rb * K + C) * 2u; }
    const size_t kstep = (size_t)(BK * 2);
    const size_t hstep = (size_t)HALF * K * 2;
    const size_t tstep = 2 * hstep;
    const unsigned ldsw = (unsigned)wid * 1024u;
    const int aoff = lds_byte(wr * 64 + fr, fq * 8), boff = lds_byte(wc * 32 + fr, fq * 8);
#define PG8_SA(b, h) (((b) * 2 + (h)) * HTB)
#define PG8_SB(b, h) ((4 + (b) * 2 + (h)) * HTB)
#define PG8_STAGE(bufoff, gbase, voff) do { _Pragma("unroll") for (int _i = 0; _i < 2; ++_i) \
        __builtin_amdgcn_global_load_lds((const unsigned*)((const char*)(gbase) + (voff)[_i]), (PG8_LAS unsigned*)(lds + (bufoff) + ldsw + _i * 8192), 16, 0, 0); } while (0)
#define PG8_LDA(dst, b, h) do { _Pragma("unroll") for (int m = 0; m < 4; ++m) _Pragma("unroll") for (int k = 0; k < 2; ++k) dst[m][k] = *(const PG8_LAS bf16x8*)(lds + PG8_SA(b, h) + aoff + m * 2048 + k * 1024); } while (0)
#define PG8_LDB(dst, b, h) do { _Pragma("unroll") for (int n = 0; n < 2; ++n) _Pragma("unroll") for (int k = 0; k < 2; ++k) dst[n][k] = *(const PG8_LAS bf16x8*)(lds + PG8_SB(b, h) + boff + n * 2048 + k * 1024); } while (0)
#define PG8_MMA(ai, bj, At, Bt) do { __builtin_amdgcn_s_setprio(1); _Pragma("unroll") for (int m = 0; m < 4; ++m) _Pragma("unroll") for (int n = 0; n < 2; ++n) _Pragma("unroll") for (int k = 0; k < 2; ++k) \
        acc[ai][bj][m][n] = __builtin_amdgcn_mfma_f32_16x16x32_f16(Bt[n][k], At[m][k], acc[ai][bj][m][n], 0, 0, 0); __builtin_amdgcn_s_setprio(0); } while (0)
#define PG8_WAIT_V(n) asm volatile("s_waitcnt vmcnt(" #n ")" ::: "memory")
#define PG8_WAIT_L(n) asm volatile("s_waitcnt lgkmcnt(" #n ")" ::: "memory")
#define PG8_BAR __builtin_amdgcn_s_barrier()
#define PG8_SCHED __builtin_amdgcn_sched_barrier(0)
    Unit cur, nxt; int ui = 0;
    if (!S.next(0, cur)) return;
    f32x4 acc[2][2][4][2];
#pragma unroll
    for (int a = 0; a < 2; ++a)
#pragma unroll
        for (int b = 0; b < 2; ++b)
#pragma unroll
            for (int m = 0; m < 4; ++m)
#pragma unroll
                for (int n = 0; n < 2; ++n) acc[a][b][m][n] = (f32x4){0.f, 0.f, 0.f, 0.f};
    bf16x8 At[4][2], B0[2][2], B1[2][2];
    const char* cA = (const char*)g.A + (size_t)cur.pm * tstep; const char* cB = (const char*)g.Bt + (size_t)cur.pn * tstep;
    S.a_ready(cur);
    if constexpr (SP2) {
        PG8_STAGE(PG8_SB(0, 0), cB, voffB); PG8_STAGE(PG8_SB(0, 1), cB + hstep, voffB); PG8_STAGE(PG8_SA(0, 0), cA, voffA); PG8_STAGE(PG8_SA(0, 1), cA + hstep, voffA);
        if (wr == 1) PG8_BAR;
        PG8_WAIT_V(2); PG8_BAR;
        PG8_STAGE(PG8_SB(1, 0), cB + kstep, voffB); PG8_STAGE(PG8_SA(1, 0), cA + kstep, voffA); PG8_STAGE(PG8_SB(1, 1), cB + hstep + kstep, voffB);
        PG8_WAIT_V(6); PG8_BAR;
    } else {
        PG8_STAGE(PG8_SB(0, 0), cB, voffB); PG8_STAGE(PG8_SA(0, 0), cA, voffA); PG8_STAGE(PG8_SB(0, 1), cB + hstep, voffB); PG8_STAGE(PG8_SA(0, 1), cA + hstep, voffA);
        if (wr == 1) PG8_BAR;
        PG8_WAIT_V(4); PG8_BAR;
        PG8_STAGE(PG8_SB(1, 0), cB + kstep, voffB); PG8_STAGE(PG8_SA(1, 0), cA + kstep, voffA); PG8_STAGE(PG8_SB(1, 1), cB + hstep + kstep, voffB);
        PG8_WAIT_V(6); PG8_BAR;
    }
    for (;;) {
        const bool has_next = S.next(ui + 1, nxt);
        const char* nA = has_next ? (const char*)g.A + (size_t)nxt.pm * tstep : cA; const char* nB = has_next ? (const char*)g.Bt + (size_t)nxt.pn * tstep : cB;
        for (int t = 0; t < nt; t += 2) {
            if constexpr (Epi::MID) { if (t == nt / 2) E.mid(acc, cur, wr, wc, fr, fq); }
            const bool last = (t == nt - 2);
            const char* a1 = cA + (size_t)(t + 1) * kstep;
            const char* a2 = last ? nA : cA + (size_t)(t + 2) * kstep; const char* b2 = last ? nB : cB + (size_t)(t + 2) * kstep;
            const char* a3 = a2 + kstep; const char* b3 = b2 + kstep;
            if (last && has_next) S.a_ready(nxt);
            if constexpr (SP2) {
            PG8_LDB(B0, 0, 0); PG8_LDB(B1, 0, 1); PG8_SCHED; PG8_LDA(At, 0, 0); PG8_STAGE(PG8_SA(1, 1), a1 + hstep, voffA);
            PG8_WAIT_V(8); PG8_WAIT_L(0); PG8_BAR; PG8_MMA(0, 0, At, B0); PG8_MMA(0, 1, At, B1); PG8_BAR; PG8_SCHED;
            PG8_LDA(At, 0, 1); PG8_STAGE(PG8_SB(0, 0), b2, voffB); PG8_STAGE(PG8_SB(0, 1), b2 + hstep, voffB); PG8_STAGE(PG8_SA(0, 0), a2, voffA);
            PG8_WAIT_V(8); PG8_WAIT_L(0); PG8_BAR; PG8_MMA(1, 0, At, B0); PG8_MMA(1, 1, At, B1); PG8_BAR; PG8_SCHED;
            PG8_LDB(B0, 1, 0); PG8_LDB(B1, 1, 1); PG8_SCHED; PG8_LDA(At, 1, 0); PG8_STAGE(PG8_SA(0, 1), a2 + hstep, voffA);
            PG8_WAIT_V(8); PG8_WAIT_L(0); PG8_BAR; PG8_MMA(0, 0, At, B0); PG8_MMA(0, 1, At, B1); PG8_BAR; PG8_SCHED;
            PG8_LDA(At, 1, 1); PG8_STAGE(PG8_SB(1, 0), b3, voffB); PG8_STAGE(PG8_SB(1, 1), b3 + hstep, voffB); PG8_STAGE(PG8_SA(1, 0), a3, voffA);
            PG8_WAIT_V(8); PG8_WAIT_L(0); PG8_BAR; PG8_MMA(1, 0, At, B0); PG8_MMA(1, 1, At, B1); PG8_BAR; PG8_SCHED;
            } else {
            PG8_LDB(B0, 0, 0); PG8_SCHED; PG8_LDA(At, 0, 0); PG8_STAGE(PG8_SA(1, 1), a1 + hstep, voffA);
            PG8_WAIT_L(8); PG8_BAR; PG8_WAIT_L(0); PG8_MMA(0, 0, At, B0); PG8_BAR; PG8_SCHED;
            PG8_LDB(B1, 0, 1); PG8_STAGE(PG8_SB(0, 0), b2, voffB);
            PG8_BAR; PG8_WAIT_L(0); PG8_MMA(0, 1, At, B1); PG8_BAR;
            PG8_LDA(At, 0, 1); PG8_STAGE(PG8_SA(0, 0), a2, voffA);
            PG8_BAR; PG8_WAIT_L(0); PG8_MMA(1, 0, At, B0); PG8_BAR; PG8_SCHED;
            PG8_STAGE(PG8_SB(0, 1), b2 + hstep, voffB);
            PG8_WAIT_V(6); PG8_BAR; PG8_MMA(1, 1, At, B1); PG8_BAR;
            PG8_LDB(B0, 1, 0); PG8_SCHED; PG8_LDA(At, 1, 0); PG8_STAGE(PG8_SA(0, 1), a2 + hstep, voffA);
            PG8_WAIT_L(8); PG8_BAR; PG8_WAIT_L(0); PG8_MMA(0, 0, At, B0); PG8_BAR; PG8_SCHED;
            PG8_LDB(B1, 1, 1); PG8_STAGE(PG8_SB(1, 0), b3, voffB);
            PG8_BAR; PG8_WAIT_L(0); PG8_MMA(0, 1, At, B1); PG8_BAR;
            PG8_LDA(At, 1, 1); PG8_STAGE(PG8_SA(1, 0), a3, voffA);
            PG8_BAR; PG8_WAIT_L(0); PG8_MMA(1, 0, At, B0); PG8_BAR; PG8_SCHED;
            PG8_STAGE(PG8_SB(1, 1), b3 + hstep, voffB);
            PG8_WAIT_V(6); PG8_BAR; PG8_MMA(1, 1, At, B1); PG8_BAR;
            }
        }
        if constexpr (ALIGN_EPI) { if (wr == 0) PG8_BAR; }
        if constexpr (!Epi::AFTER_DRAIN) { E(acc, cur, wr, wc, fr, fq); S.done(cur); }
        if (!has_next) break;
#pragma unroll
        for (int a = 0; a < 2; ++a)
#pragma unroll
            for (int b = 0; b < 2; ++b)
#pragma unroll
                for (int m = 0; m < 4; ++m)
#pragma unroll
                    for (int n = 0; n < 2; ++n) acc[a][b][m][n] = (f32x4){0.f, 0.f, 0.f, 0.f};
        cur = nxt; cA = nA; cB = nB; ++ui;
        if constexpr (ALIGN_EPI) { if (wr == 1) PG8_BAR; }
    }
    PG8_WAIT_V(0);
    if constexpr (!ALIGN_EPI) { if (wr == 0) PG8_BAR; }
    PG8_BAR;
    if constexpr (Epi::AFTER_DRAIN) { E.fused(acc, cur, wr, wc, fr, fq, lds, wid, lane); S.done(cur); }
#undef PG8_SA
#undef PG8_SB
#undef PG8_STAGE
#undef PG8_LDA
#undef PG8_LDB
#undef PG8_MMA
#undef PG8_WAIT_V
#undef PG8_WAIT_L
#undef PG8_BAR
#undef PG8_SCHED
}
}


namespace {
constexpr int B_ = 8, S_ = 4096, M_ = B_ * S_, D_ = 1024, DIN = 4288, DFF = 4096;
constexpr int C_QA = 0, C_QB = 512, C_QI = 1024, C_KVB = 1280, C_KA = 2048, C_VA = 2112, C_KI = 2176, C_WI = 2208, C_GB = 2216, C_GATE = 2304;
constexpr int NC = 255;
constexpr float EPS = 1e-6f;
using pg8::PW;
#define GAS __attribute__((address_space(1)))
#define LAS __attribute__((address_space(3)))
typedef unsigned v4u __attribute__((ext_vector_type(4)));
typedef float f32x4 __attribute__((ext_vector_type(4)));

__device__ __forceinline__ int t5_bucket(int n) {
    if (n < 16) return n < 0 ? 0 : n;
    float nf = (float)n;
    int large = 16 + (int)(logf(nf / 16.f) / logf(8.f) * 16.f);
    return large < 31 ? large : 31;
}


__device__ __forceinline__ int win_src_col(int n) {
    if (n < 512) return n;
    if (n < 1024) return 936 + (n - 512);
    if (n < 1280) return 640 + (n - 1024);
    if (n < 2048) return 1448 + (n - 1280);
    if (n < 2112) return 512 + (n - 2048);
    if (n < 2176) return 576 + (n - 2112);
    if (n < 2208) return 896 + (n - 2176);
    if (n < 2216) return 928 + (n - 2208);
    if (n < 2240) return n;
    if (n < 2304) return -1;
    return 2240 + (n - 2304);
}
__device__ __forceinline__ float wave_sum(float v) {
#pragma unroll
    for (int o = 1; o < 64; o <<= 1) v += __shfl_xor(v, o);
    return v;
}
template <bool MAP>
__device__ __forceinline__ void transpose_item(const float* __restrict__ W, int K, int Nsrc, int Ndst, _Float16* __restrict__ WT, const float* __restrict__ gain, float* scr, int item, int lane, int dpitch = 0, int koff = 0) {
    const int nblk = Ndst / 32, kb = item / nblk, nb = item % nblk, k0 = 64 * kb, n0 = 32 * nb;
    const int nd = n0 + (lane & 31); const int ns = MAP ? win_src_col(nd) : nd;
#pragma unroll 8
    for (int i = 0; i < 32; ++i) { const int kk = 2 * i + (lane >> 5); float v = 0.f;
        if (ns >= 0) { v = W[(size_t)(k0 + kk) * Nsrc + ns]; if (gain) v *= gain[k0 + kk]; }
        scr[kk * 33 + (lane & 31)] = v; }
    __builtin_amdgcn_s_waitcnt(0xc07f); asm volatile("" ::: "memory");
    const int c = lane & 7;
#pragma unroll
    for (int j = 0; j < 4; ++j) { const int n = (lane >> 3) + 8 * j; const float* s = scr + (8 * c) * 33 + n;
        v4u o; o.x = pg8::pkh(s[0 * 33], s[1 * 33]); o.y = pg8::pkh(s[2 * 33], s[3 * 33]); o.z = pg8::pkh(s[4 * 33], s[5 * 33]); o.w = pg8::pkh(s[6 * 33], s[7 * 33]);
        *(v4u*)(WT + (size_t)(n0 + n) * (dpitch ? dpitch : K) + koff + k0 + 8 * c) = o; }
    __builtin_amdgcn_s_waitcnt(0xc07f); asm volatile("" ::: "memory");
}
__device__ __forceinline__ void rms_row_to_f16(const float* __restrict__ xrow, _Float16* __restrict__ orow, int lane) {
    const f32x4* xr = (const f32x4*)xrow + lane;
    f32x4 v[4]; float s = 0.f;
#pragma unroll
    for (int j = 0; j < 4; ++j) { v[j] = xr[64 * j]; s += (v[j].x * v[j].x + v[j].y * v[j].y) + (v[j].z * v[j].z + v[j].w * v[j].w); }
    const float rstd = rsqrtf(wave_sum(s) * (1.f / D_) + EPS);
    unsigned long long* o8 = (unsigned long long*)orow + lane;
#pragma unroll
    for (int j = 0; j < 4; ++j) o8[64 * j] = (unsigned long long)pg8::pkh(v[j].x * rstd, v[j].y * rstd) | ((unsigned long long)pg8::pkh(v[j].z * rstd, v[j].w * rstd) << 32);
}

struct Args {
    const float* x; const float* norm_mix; const float* w_in; const float* pe_k; const float* w1_k; const float* w2_k; const float* pe_v; const float* w1_v; const float* w2_v;
    const float* rel_bias; const float* w_ba; const float* w_bb; const float* w_out; const float* norm_mlp; const float* w_mi; const float* w_mo; const float* norm_final;
    float* out; unsigned char* ws;
};
constexpr size_t MiB = 1u << 20;
constexpr size_t WS_ROWSQ = 65536, WS_ROWSQ2 = 196608;
constexpr size_t WS_CTL = 0, WS_WIN = 1 * MiB, WS_WBA = 10 * MiB, WS_WBB = 11 * MiB, WS_WOUT = 12 * MiB, WS_WMI = 14 * MiB, WS_WMO = 22 * MiB, WS_CW = 30 * MiB,
                 WS_KCMP = 32 * MiB, WS_VCMP = 33 * MiB, WS_H = 34 * MiB, WS_PROJ = 98 * MiB, WS_MIX = 370 * MiB, WS_END = 434 * MiB;

__device__ __forceinline__ void prologue_body(const Args& a, unsigned char* lds) {
    const int tid = threadIdx.x, lane = tid & 63, wave = tid >> 6;
    float* scr = (float*)(lds + wave * 8704);
    const int gw = blockIdx.x * 8 + wave, NGW = gridDim.x * 8;
    constexpr int I_IN = (D_ / 64) * (PW / 32), I_BA = (512 / 64) * (D_ / 32), I_OUT = (D_ / 64) * (D_ / 32), I_MI = (D_ / 64) * (DFF / 32), I_MO = (DFF / 64) * (D_ / 32);
    constexpr int I_C1 = (2048 / 64) * (128 / 32), I_C2 = (128 / 64) * (64 / 32);
    constexpr int NITEMS = I_IN + 2 * I_BA + I_OUT + I_MI + I_MO + 2 * I_C1 + 2 * I_C2;
    for (int it = gw; it < NITEMS; it += NGW) {
        int r = it;
        if (r < I_IN) { transpose_item<true>(a.w_in, D_, DIN, PW, (_Float16*)(a.ws + WS_WIN), a.norm_mix, scr, r, lane); continue; } r -= I_IN;
        if (r < I_BA) { transpose_item<false>(a.w_ba, 512, D_, D_, (_Float16*)(a.ws + WS_WBA), nullptr, scr, r, lane, 1024, 0); continue; } r -= I_BA;
        if (r < I_BA) { transpose_item<false>(a.w_bb, 512, D_, D_, (_Float16*)(a.ws + WS_WBA), nullptr, scr, r, lane, 1024, 512); continue; } r -= I_BA;
        if (r < I_OUT) { transpose_item<false>(a.w_out, D_, D_, D_, (_Float16*)(a.ws + WS_WOUT), nullptr, scr, r, lane); continue; } r -= I_OUT;
        if (r < I_MI) { transpose_item<false>(a.w_mi, D_, DFF, DFF, (_Float16*)(a.ws + WS_WMI), a.norm_mlp, scr, r, lane); continue; } r -= I_MI;
        if (r < I_MO) { transpose_item<false>(a.w_mo, DFF, D_, D_, (_Float16*)(a.ws + WS_WMO), nullptr, scr, r, lane); continue; } r -= I_MO;
        if (r < I_C1) { transpose_item<false>(a.w1_k, 2048, 128, 128, (_Float16*)(a.ws + WS_CW), nullptr, scr, r, lane); continue; } r -= I_C1;
        if (r < I_C1) { transpose_item<false>(a.w1_v, 2048, 128, 128, (_Float16*)(a.ws + WS_CW + 512 * 1024), nullptr, scr, r, lane); continue; } r -= I_C1;
        if (r < I_C2) { transpose_item<false>(a.w2_k, 128, 64, 64, (_Float16*)(a.ws + WS_CW + 1024 * 1024), nullptr, scr, r, lane); continue; } r -= I_C2;
        transpose_item<false>(a.w2_v, 128, 64, 64, (_Float16*)(a.ws + WS_CW + 1024 * 1024 + 16384), nullptr, scr, r, lane);
    }
#pragma unroll 4
    for (int m = gw; m < M_; m += NGW) rms_row_to_f16(a.x + (size_t)m * D_, (_Float16*)(a.ws + WS_H) + (size_t)m * D_, lane);
}
struct EpiAccOut {
    static constexpr bool PERM = true, AFTER_DRAIN = false, MID = false;
    _Float16* x2h; const _Float16* xh; float* rowsq;
    __device__ __forceinline__ void operator()(const f32x4 (&acc)[2][2][4][2], const pg8::Unit& u, int wr, int wc, int fr, int fq) const {
        const int row0 = u.pm * 256 + wr * 64 + fr, col0 = u.pn * 256 + wc * 32 + 8 * fq;
#pragma unroll
        for (int ai = 0; ai < 2; ++ai)
#pragma unroll
            for (int m = 0; m < 4; ++m) { const size_t r = (size_t)(row0 + ai * 128 + m * 16); float sq = 0.f;
#pragma unroll
                for (int bj = 0; bj < 2; ++bj) { const size_t o = r * 1024 + col0 + bj * 128;
                    float p[8]; pg8::unpk8(*(const pg8::u32x4*)(xh + o), p);
                    const f32x4 a0 = acc[ai][bj][m][0], a1 = acc[ai][bj][m][1];
                    const float v[8] = {p[0] + a0[0], p[1] + a0[1], p[2] + a0[2], p[3] + a0[3], p[4] + a1[0], p[5] + a1[1], p[6] + a1[2], p[7] + a1[3]};
                    pg8::u32x4 w; w.x = pg8::pkh(v[0], v[1]); w.y = pg8::pkh(v[2], v[3]); w.z = pg8::pkh(v[4], v[5]); w.w = pg8::pkh(v[6], v[7]);
                    *(pg8::u32x4*)(x2h + o) = w;
                    sq += (v[0] * v[0] + v[1] * v[1]) + (v[2] * v[2] + v[3] * v[3]) + (v[4] * v[4] + v[5] * v[5]) + (v[6] * v[6] + v[7] * v[7]); }
                sq += __shfl_xor(sq, 16); sq += __shfl_xor(sq, 32);
                if (fq == 0) atomicAdd(rowsq + r, sq); }
    }
};
__device__ __forceinline__ void final_scale_row(const _Float16* __restrict__ xrow, float* __restrict__ orow, const float* __restrict__ g, float rsq, int lane) {
    const float rstd = rsqrtf(rsq * (1.f / D_) + EPS);
#pragma unroll
    for (int j = 0; j < 2; ++j) {
        float p[8]; pg8::unpk8(*((const pg8::u32x4*)xrow + lane + 64 * j), p);
        const f32x4 g0 = *((const f32x4*)g + 2 * (lane + 64 * j)), g1 = *((const f32x4*)g + 2 * (lane + 64 * j) + 1);
        *((f32x4*)orow + 2 * (lane + 64 * j)) = (f32x4){p[0] * rstd * g0.x, p[1] * rstd * g0.y, p[2] * rstd * g0.z, p[3] * rstd * g0.w};
        *((f32x4*)orow + 2 * (lane + 64 * j) + 1) = (f32x4){p[4] * rstd * g1.x, p[5] * rstd * g1.y, p[6] * rstd * g1.z, p[7] * rstd * g1.w};
    }
}

namespace dsa {
typedef _Float16 f16x8 __attribute__((ext_vector_type(8)));
typedef _Float16 f16x4 __attribute__((ext_vector_type(4)));
typedef short s16x4 __attribute__((ext_vector_type(4)));
typedef float f32x4 __attribute__((ext_vector_type(4)));
typedef unsigned u32x4 __attribute__((ext_vector_type(4)));
typedef unsigned u32x2 __attribute__((ext_vector_type(2)));
constexpr int TQ = 16, NBIN = 2048, CANDCAP = 512, VPITCH = 144;
constexpr int L_HIST = 0, L_SEL = 65536, L_SELD = L_SEL + 8192, L_CTL = L_SELD + 8192, L_BIAS = L_CTL + 512, L_VST = L_BIAS + 4096, L_END = L_VST + 8 * 32 * VPITCH;
static_assert(L_END <= 131072, "dsa LDS");

__device__ __forceinline__ float idx_score(const f32x4 a1, const f32x4 a2, float lin, const float (&wh)[8]) {
    float s = fmaf(wh[0], fabsf(a1.x), lin);
    s = fmaf(wh[1], fabsf(a1.y), s); s = fmaf(wh[2], fabsf(a1.z), s); s = fmaf(wh[3], fabsf(a1.w), s);
    s = fmaf(wh[4], fabsf(a2.x), s); s = fmaf(wh[5], fabsf(a2.y), s); s = fmaf(wh[6], fabsf(a2.z), s); s = fmaf(wh[7], fabsf(a2.w), s);
    return s;
}
__device__ __forceinline__ int score_bin(float sc, float inv) { int b = (int)(fmaf(sc, inv, 1024.f)); b = b < 0 ? 0 : b; return b > NBIN - 1 ? NBIN - 1 : b; }

template <int PASS>
__device__ __forceinline__ void score_pass(LAS unsigned char* lds, const _Float16* __restrict__ proj, int b, int t0, int nkb, int wave, int lane,
                                           const f16x8 (&afr)[4][2], const f16x8 alin, const float (&wq)[4][8], const float (&binv)[4]) {
    LAS unsigned* hist = (LAS unsigned*)(lds + L_HIST);
    LAS unsigned short* sel = (LAS unsigned short*)(lds + L_SEL);
    LAS unsigned short* seld = (LAS unsigned short*)(lds + L_SELD);
    LAS u32x2* cand = (LAS u32x2*)(lds + L_HIST);
    LAS int* ctl = (LAS int*)(lds + L_CTL);
    const int kc = lane >> 4, n16 = lane & 15;
    int bst[4];
#pragma unroll
    for (int grp = 0; grp < 4; ++grp) bst[grp] = (PASS == 2) ? ctl[(4 * grp + kc) * 8 + 2] : 0;
    const f32x4 zero = {0.f, 0.f, 0.f, 0.f};
    const _Float16* kbase = proj + (size_t)(b * S_ + n16) * PW + C_KI + 8 * kc;
    f16x8 bnext = *(const f16x8*)(kbase + (size_t)(16 * (wave < nkb ? wave : 0)) * PW);
    for (int kb = wave; kb < nkb; kb += 8) {
        const f16x8 bfr = bnext;
        { const int kn = kb + 8 < nkb ? kb + 8 : kb; bnext = *(const f16x8*)(kbase + (size_t)(16 * kn) * PW); }
        const int s = 16 * kb + n16;
        const bool lastkb = kb == nkb - 1;
        const f32x4 a3 = __builtin_amdgcn_mfma_f32_16x16x32_f16(alin, bfr, zero, 0, 0, 0);
        const float lin4[4] = {a3.x, a3.y, a3.z, a3.w};
#pragma unroll
        for (int grp = 0; grp < 4; ++grp) {
            const f32x4 a1 = __builtin_amdgcn_mfma_f32_16x16x32_f16(afr[grp][0], bfr, zero, 0, 0, 0);
            const f32x4 a2 = __builtin_amdgcn_mfma_f32_16x16x32_f16(afr[grp][1], bfr, zero, 0, 0, 0);
            const float sc = idx_score(a1, a2, lin4[grp], wq[grp]);
            const int row = 4 * grp + kc, t = t0 + row;
            if (!lastkb || s <= t) {
                const int bin = score_bin(sc, binv[grp]);
                if (PASS == 1) { __hip_atomic_fetch_add(hist + row * 1024 + (bin >> 1), (bin & 1) ? 0x10000u : 1u, __ATOMIC_RELAXED, __HIP_MEMORY_SCOPE_WORKGROUP); }
                else {
                    if (bin > bst[grp]) { const int pos = __hip_atomic_fetch_add(ctl + row * 8 + 0, 1, __ATOMIC_RELAXED, __HIP_MEMORY_SCOPE_WORKGROUP); sel[row * 256 + (pos & 255)] = (unsigned short)s;
                        const int dd = t - s; seld[row * 256 + (pos & 255)] = (unsigned short)((dd > 127 ? 127 : dd) * 32); }
                    else if (bin == bst[grp]) { const int pos = __hip_atomic_fetch_add(ctl + row * 8 + 1, 1, __ATOMIC_RELAXED, __HIP_MEMORY_SCOPE_WORKGROUP);
                        if (pos < CANDCAP) { u32x2 e; e.x = __float_as_uint(sc); e.y = (unsigned)s; cand[row * CANDCAP + pos] = e; } }
                }
            }
        }
    }
}

__device__ __forceinline__ void dsa_tile(LAS unsigned char* lds, const _Float16* __restrict__ proj, _Float16* __restrict__ o_a, int b, int qt) {
    int tid_ = threadIdx.x; asm volatile("" : "+v"(tid_));
    const int tid = tid_, lane = tid & 63, wave = __builtin_amdgcn_readfirstlane(tid >> 6);
    const int kc = lane >> 4, n16 = lane & 15;
    const int t0 = qt * TQ, nkb = qt + 1;
    LAS unsigned* hist = (LAS unsigned*)(lds + L_HIST);
    LAS unsigned short* sel = (LAS unsigned short*)(lds + L_SEL);
    LAS u32x2* cand = (LAS u32x2*)(lds + L_HIST);
    LAS int* ctl = (LAS int*)(lds + L_CTL);
    LAS float* biaslut = (LAS float*)(lds + L_BIAS);
    for (int i = tid; i < (TQ * 1024 + 4096) / 4; i += 512) ((LAS u32x4*)hist)[i] = (u32x4){0u, 0u, 0u, 0u};
    if (tid < TQ * 8) ctl[tid] = 0;
    f16x8 afr[4][2]; f16x8 alin; float wq[4][8]; float binv[4];
    { const int g = n16 >> 2, r = n16 & 3;
      { const int qq = 4 * r + g; const _Float16* qrow = proj + (size_t)(b * S_ + t0 + qq) * PW;
        const f16x8 wg = *(const f16x8*)(qrow + C_WI);
        float lin[8];
#pragma unroll
        for (int e = 0; e < 8; ++e) lin[e] = 0.f;
#pragma unroll
        for (int h = 0; h < 8; ++h) { const f16x8 qh = *(const f16x8*)(qrow + C_QI + h * 32 + 8 * kc); const float wh = (float)wg[h] * (0.5f / 16.f);
#pragma unroll
            for (int e = 0; e < 8; ++e) lin[e] = fmaf(wh, (float)qh[e], lin[e]); }
#pragma unroll
        for (int e = 0; e < 8; ++e) alin[e] = (_Float16)lin[e]; }
#pragma unroll
      for (int grp = 0; grp < 4; ++grp) {
          const _Float16* qrow = proj + (size_t)(b * S_ + t0 + 4 * grp + g) * PW + C_QI;
          afr[grp][0] = *(const f16x8*)(qrow + r * 32 + 8 * kc);
          afr[grp][1] = *(const f16x8*)(qrow + (4 + r) * 32 + 8 * kc);
          const f16x8 wv = *(const f16x8*)(proj + (size_t)(b * S_ + t0 + 4 * grp + kc) * PW + C_WI);
          float ss = 0.f;
#pragma unroll
          for (int h = 0; h < 8; ++h) { const float wfull = (float)wv[h] * (1.f / 16.f); wq[grp][h] = 0.5f * wfull; ss = fmaf(wfull, wfull, ss); }
          binv[grp] = 32.f * rsqrtf(ss + 1e-12f);
      } }
    __syncthreads();
    score_pass<1>(lds, proj, b, t0, nkb, wave, lane, afr, alin, wq, binv);
    __syncthreads();
#pragma unroll 1
    for (int i = 0; i < 2; ++i) {
        const int row = 2 * wave + i, n = t0 + row + 1;
        if (n <= 256) { if (lane == 0) { ctl[row * 8 + 2] = -1; ctl[row * 8 + 3] = 0; } }
        else {
            const LAS u32x4* hp = (const LAS u32x4*)(hist + row * 1024 + 16 * lane);
            unsigned tot = 0;
#pragma unroll
            for (int q4 = 0; q4 < 4; ++q4) { const u32x4 hv = hp[q4];
                tot += (hv.x & 0xffffu) + (hv.x >> 16) + (hv.y & 0xffffu) + (hv.y >> 16) + (hv.z & 0xffffu) + (hv.z >> 16) + (hv.w & 0xffffu) + (hv.w >> 16); }
            unsigned suf = tot;
#pragma unroll
            for (int o = 1; o < 64; o <<= 1) { const unsigned v = __shfl_down(suf, o); if (lane + o < 64) suf += v; }
            const unsigned above_lane = suf - tot;
            const unsigned long long cross = __ballot(above_lane < 256u && suf >= 256u);
            const int lx = __builtin_ctzll(cross);
            const unsigned abovex = __shfl(above_lane, lx);
            const unsigned c2 = lane < 32 ? (unsigned)((const LAS unsigned short*)hist)[row * 2048 + 32 * lx + lane] : 0u;
            unsigned suf2 = c2;
#pragma unroll
            for (int o = 1; o < 32; o <<= 1) { const unsigned v = __shfl_down(suf2, o); if (lane + o < 32) suf2 += v; }
            const unsigned above2 = abovex + suf2 - c2;
            if (lane < 32 && above2 < 256u && above2 + c2 >= 256u) {
                const int bs = 32 * lx + lane; const unsigned cum = above2;
                ctl[row * 8 + 2] = bs; ctl[row * 8 + 3] = 256 - (int)cum;
            }
        }
    }
    __syncthreads();
    score_pass<2>(lds, proj, b, t0, nkb, wave, lane, afr, alin, wq, binv);
    __syncthreads();
#pragma unroll 1
    for (int i = 0; i < 2; ++i) {
        const int row = 2 * wave + i, n = t0 + row + 1;
        const int need = ctl[row * 8 + 3], base = ctl[row * 8 + 0];
        int nc = ctl[row * 8 + 1];
        nc = nc < CANDCAP ? nc : CANDCAP;
        if (lane == 0) { const int nf = base + (need < nc ? need : nc); ctl[row * 8 + 4] = n <= 256 ? n : (nf < 256 ? nf : 256); }
        if (need > 0) {
            for (int c0 = 0; c0 < nc; c0 += 64) {
                const int ci = c0 + lane; const bool act = ci < nc;
                const u32x2 me = cand[row * CANDCAP + (act ? ci : 0)];
                const float msc = __uint_as_float(me.x); int rank = 0;
                for (int j = 0; j < nc; ++j) { const u32x2 ot = cand[row * CANDCAP + j]; const float osc = __uint_as_float(ot.x);
                    rank += (osc > msc || (osc == msc && ot.y < me.y)) ? 1 : 0; }
                if (act && rank < need) { sel[row * 256 + ((base + rank) & 255)] = (unsigned short)me.y; const int dd = t0 + row - (int)me.y; ((LAS unsigned short*)(lds + L_SELD))[row * 256 + ((base + rank) & 255)] = (unsigned short)((dd > 127 ? 127 : dd) * 32); }
            }
        }
    }
    __syncthreads();
    int tq_ = threadIdx.x; asm volatile("" : "+v"(tq_));
    const int lane_a = tq_ & 63;
    LAS unsigned char* vst = lds + L_VST + wave * (32 * VPITCH);
#pragma unroll 1
    for (int i = 0; i < 2; ++i) { const int lane = lane_a, kc = lane >> 4, n16 = lane & 15;
        const int row = 2 * wave + i, t = t0 + row; const int nvalid = ctl[row * 8 + 4];
        const _Float16* qrow = proj + (size_t)(b * S_ + t) * PW + C_QA;
        const int head = n16, hm = head & 7;
        f16x8 qb0, qb1;
        { const f16x8 z = {0, 0, 0, 0, 0, 0, 0, 0}; qb0 = z; qb1 = z;
          if (head < 8) { qb0 = *(const f16x8*)(qrow + head * 64 + 8 * kc); qb1 = *(const f16x8*)(qrow + head * 64 + 32 + 8 * kc); } }
        f32x4 ot[4];
#pragma unroll
        for (int dt = 0; dt < 4; ++dt) ot[dt] = (f32x4){0.f, 0.f, 0.f, 0.f};
        float mrun = -INFINITY, lrun = 0.f;
        const LAS unsigned short* selr = sel + row * 256;
        const LAS unsigned short* seldr = (const LAS unsigned short*)(lds + L_SELD) + row * 256;
        const LAS unsigned char* biasb = lds + L_BIAS + hm * 4;
        const _Float16* pbat = proj + (size_t)(b * S_) * PW;
        LAS unsigned char* kst = lds + L_HIST + wave * (32 * VPITCH);
        u32x4 gk[4], gv[4];
        const char* pbyte = (const char*)pbat;
#define DSA_GATHER(jj) do { _Pragma("unroll") for (int i_ = 0; i_ < 4; ++i_) { const int pos_ = 32 * (jj) + 8 * i_ + (lane >> 3); \
            const unsigned idx_ = pos_ < nvalid ? (unsigned)selr[pos_] : 0u; const char* rp_ = pbyte + (size_t)(idx_ * (unsigned)(PW * 2) + (unsigned)(C_KA * 2 + 16 * (lane & 7))); \
            gk[i_] = *(const u32x4*)rp_; gv[i_] = *(const u32x4*)(rp_ + 128); } } while (0)
        DSA_GATHER(0);
        const int nsteps = (nvalid + 31) >> 5;
#pragma unroll 1
        for (int j = 0; j < nsteps; ++j) {
#pragma unroll
            for (int i_ = 0; i_ < 4; ++i_) { const int ro = (8 * i_ + (lane >> 3)) * VPITCH + 16 * (lane & 7);
                *(LAS u32x4*)(kst + ro) = gk[i_]; *(LAS u32x4*)(vst + ro) = gv[i_]; }
            if (j + 1 < nsteps) DSA_GATHER(j + 1);
            asm volatile("s_waitcnt lgkmcnt(0)" ::: "memory");
            const f16x8 ca0 = *(const LAS f16x8*)(kst + n16 * VPITCH + 16 * kc), ca1 = *(const LAS f16x8*)(kst + n16 * VPITCH + 64 + 16 * kc);
            const f16x8 cb0 = *(const LAS f16x8*)(kst + (16 + n16) * VPITCH + 16 * kc), cb1 = *(const LAS f16x8*)(kst + (16 + n16) * VPITCH + 64 + 16 * kc);
            f32x4 sa = {0.f, 0.f, 0.f, 0.f}, sb = {0.f, 0.f, 0.f, 0.f};
            sa = __builtin_amdgcn_mfma_f32_16x16x32_f16(ca0, qb0, sa, 0, 0, 0); sa = __builtin_amdgcn_mfma_f32_16x16x32_f16(ca1, qb1, sa, 0, 0, 0);
            sb = __builtin_amdgcn_mfma_f32_16x16x32_f16(cb0, qb0, sb, 0, 0, 0); sb = __builtin_amdgcn_mfma_f32_16x16x32_f16(cb1, qb1, sb, 0, 0, 0);
            const int p0 = 32 * j + 4 * kc;
            const u32x2 iwa = *(const LAS u32x2*)(seldr + p0), iwb = *(const LAS u32x2*)(seldr + p0 + 16);
            const unsigned wa0 = iwa.x, wa1 = iwa.y, wb0 = iwb.x, wb1 = iwb.y;
            const unsigned bo[8] = {wa0 & 0xffffu, wa0 >> 16, wa1 & 0xffffu, wa1 >> 16, wb0 & 0xffffu, wb0 >> 16, wb1 & 0xffffu, wb1 >> 16};
            float v[8] = {sa.x, sa.y, sa.z, sa.w, sb.x, sb.y, sb.z, sb.w};
            float tm = -INFINITY;
#pragma unroll
            for (int e = 0; e < 8; ++e) {
                const bool ok = (p0 + (e & 3) + 16 * (e >> 2)) < nvalid;
                const float lg = v[e] * 0.125f + *(const LAS float*)(biasb + bo[e]);
                v[e] = ok ? lg : -INFINITY; tm = fmaxf(tm, v[e]);
            }
            tm = fmaxf(tm, __shfl_xor(tm, 16)); tm = fmaxf(tm, __shfl_xor(tm, 32));
            const float mn = fmaxf(mrun, tm);
            const float alpha = __expf(mrun - mn);
            float ps = 0.f;
#pragma unroll
            for (int e = 0; e < 8; ++e) { v[e] = __expf(v[e] - mn); ps += v[e]; }
            lrun = lrun * alpha + ps; mrun = mn;
#pragma unroll
            for (int dt = 0; dt < 4; ++dt) ot[dt] = ot[dt] * alpha;
            const f16x8 pfr = {(_Float16)v[0], (_Float16)v[1], (_Float16)v[2], (_Float16)v[3], (_Float16)v[4], (_Float16)v[5], (_Float16)v[6], (_Float16)v[7]};
            asm volatile("s_waitcnt lgkmcnt(0)" ::: "memory");
            const int q = n16 >> 2, p = n16 & 3;
#pragma unroll
            for (int dt = 0; dt < 4; ++dt) {
                const s16x4 ta = __builtin_amdgcn_ds_read_tr16_b64_v4i16((LAS s16x4*)(vst + (4 * kc + q) * VPITCH + (16 * dt + 4 * p) * 2));
                const s16x4 tb = __builtin_amdgcn_ds_read_tr16_b64_v4i16((LAS s16x4*)(vst + (16 + 4 * kc + q) * VPITCH + (16 * dt + 4 * p) * 2));
                const f16x4 fa = __builtin_bit_cast(f16x4, ta), fb = __builtin_bit_cast(f16x4, tb);
                const f16x8 vfr = {fa.x, fa.y, fa.z, fa.w, fb.x, fb.y, fb.z, fb.w};
                ot[dt] = __builtin_amdgcn_mfma_f32_16x16x32_f16(vfr, pfr, ot[dt], 0, 0, 0);
            }
            asm volatile("s_waitcnt lgkmcnt(0)" ::: "memory");
        }
#undef DSA_GATHER
        lrun += __shfl_xor(lrun, 16); lrun += __shfl_xor(lrun, 32);
        const float inv = 1.f / fmaxf(lrun, 1e-30f);
        if (head < 8) {
            _Float16* orow = o_a + (size_t)(b * S_ + t) * 1024 + head * 64 + 4 * kc;
#pragma unroll
            for (int dt = 0; dt < 4; ++dt) { u32x2 w; w.x = pg8::pkh(ot[dt].x * inv, ot[dt].y * inv); w.y = pg8::pkh(ot[dt].z * inv, ot[dt].w * inv); *(u32x2*)(orow + 16 * dt) = w; }
        }
    }
    __syncthreads();
}
}


namespace nsa {
typedef _Float16 f16x8 __attribute__((ext_vector_type(8)));
typedef _Float16 f16x4 __attribute__((ext_vector_type(4)));
typedef short s16x4 __attribute__((ext_vector_type(4)));
typedef float f32x4 __attribute__((ext_vector_type(4)));
typedef float f32x16 __attribute__((ext_vector_type(16)));
typedef unsigned u32x4 __attribute__((ext_vector_type(4)));
typedef unsigned u32x2 __attribute__((ext_vector_type(2)));
constexpr int KP = 144, VP = 192;
constexpr int TILE_B = 64 * KP + 64 * VP;
constexpr int L_T0 = 0, L_BIAS = 2 * TILE_B, L_IMPA = L_BIAS + 4096, L_IMPC = L_IMPA + 16384, L_MASK = L_IMPC + 16384, L_END = L_MASK + 512;
static_assert(L_END <= 131072, "nsa LDS");
constexpr float LOG2E = 1.4426950408889634f;
constexpr float SC = 0.125f * LOG2E;

struct Src { const _Float16* k; const _Float16* v; int pitch; };

struct Stage { u32x4 kr, vr; };
__device__ __forceinline__ void stage_load(Stage& st, const Src& s, int row0, int tid, bool need_v) {
    const int r = tid >> 3, c = tid & 7;
    st.kr = *(const u32x4*)(s.k + (size_t)(row0 + r) * s.pitch + 8 * c);
    if (need_v) st.vr = *(const u32x4*)(s.v + (size_t)(row0 + r) * s.pitch + 8 * c);
}
__device__ __forceinline__ void stage_store(const Stage& st, LAS unsigned char* tb, int tid, bool need_v) {
    const int r = tid >> 3, c = tid & 7;
    *(LAS u32x4*)(tb + r * KP + 16 * c) = st.kr;
    if (need_v) *(LAS u32x4*)(tb + 64 * KP + r * VP + 16 * c) = st.vr;
}

struct RowState { float m, l; f32x16 o0, o1; };

__device__ __forceinline__ void qk_half(const LAS unsigned char* kt, const f16x8 (&qf)[4], int rho, int hi, int kh, f32x16& s0) {
#pragma unroll
    for (int i = 0; i < 16; ++i) s0[i] = 0.f;
    const LAS unsigned char* kb = kt + (32 * kh + rho) * KP + 16 * hi;
#pragma unroll
    for (int ks = 0; ks < 4; ++ks) {
        const f16x8 a0 = *(const LAS f16x8*)(kb + 32 * ks);
        s0 = __builtin_amdgcn_mfma_f32_32x32x16_f16(a0, qf[ks], s0, 0, 0, 0);
    }
}
__device__ __forceinline__ void logits(f32x16& s0, const LAS float* lut, int hb, int hi, int dbase, int dstep, int dlim, bool bit) {
#pragma unroll
    for (int rg = 0; rg < 16; ++rg) {
        const int kl = (rg & 3) + 8 * (rg >> 2) + 4 * hi;
        const int d = dbase - dstep * kl;
        int dc = d < 0 ? 0 : d; dc = dc > 127 ? 127 : dc;
        const float bias = lut[dc * 8 + hb];
        const bool ok = bit && d >= 0 && d < dlim;
        s0[rg] = ok ? fmaf(s0[rg], SC, bias) : -INFINITY;
    }
}
__device__ __forceinline__ void pv_half(RowState& rs, const f32x16& s0, const LAS unsigned char* vt, int rho, int hi, int kh) {
    const int l16 = rho & 15, g16 = rho >> 4, q = l16 >> 2, p = l16 & 3;
    const LAS unsigned char* vb = vt + (32 * kh + 4 * hi + q) * VP + (16 * g16 + 4 * p) * 2;
#pragma unroll
    for (int sx = 0; sx < 2; ++sx) {
        f16x8 pfr;
#pragma unroll
        for (int j = 0; j < 8; ++j) pfr[j] = (_Float16)s0[8 * sx + j];
#pragma unroll
        for (int dt = 0; dt < 2; ++dt) {
            const s16x4 ta = __builtin_amdgcn_ds_read_tr16_b64_v4i16((LAS s16x4*)(vb + (16 * sx) * VP + 64 * dt));
            const s16x4 tb = __builtin_amdgcn_ds_read_tr16_b64_v4i16((LAS s16x4*)(vb + (16 * sx + 8) * VP + 64 * dt));
            const f16x4 fa = __builtin_bit_cast(f16x4, ta), fb = __builtin_bit_cast(f16x4, tb);
            const f16x8 vfr = {fa.x, fa.y, fa.z, fa.w, fb.x, fb.y, fb.z, fb.w};
            if (dt == 0) rs.o0 = __builtin_amdgcn_mfma_f32_32x32x16_f16(vfr, pfr, rs.o0, 0, 0, 0);
            else rs.o1 = __builtin_amdgcn_mfma_f32_32x32x16_f16(vfr, pfr, rs.o1, 0, 0, 0);
        }
    }
}
__device__ __forceinline__ void rescale_if_needed(RowState& rs, float tmx) {
    if (__any(tmx > rs.m + 8.f)) {
        const float mn = fmaxf(rs.m, tmx);
        const float mu = (mn == -INFINITY) ? 0.f : mn;
        const float alpha = __builtin_amdgcn_exp2f(rs.m - mu);
        rs.l *= alpha; rs.m = mn;
#pragma unroll
        for (int i = 0; i < 16; ++i) { rs.o0[i] *= alpha; rs.o1[i] *= alpha; }
    }
}
__device__ __forceinline__ void tile_fast(RowState& rs, const LAS unsigned char* kt, const LAS unsigned char* vt, const f16x8 (&qf)[4], float c, int rho, int hi) {
    const LAS unsigned char* kb = kt + rho * KP + 16 * hi;
    f16x8 ka[4], kb2[4];
#pragma unroll
    for (int ks = 0; ks < 4; ++ks) { ka[ks] = *(const LAS f16x8*)(kb + 32 * ks); kb2[ks] = *(const LAS f16x8*)(kb + 32 * KP + 32 * ks); }
    const int l16 = rho & 15, g16 = rho >> 4, q = l16 >> 2, p = l16 & 3;
    const LAS unsigned char* vb = vt + (4 * hi + q) * VP + (16 * g16 + 4 * p) * 2;
    s16x4 va[4][2], vc[4][2];
    __builtin_amdgcn_sched_barrier(0);
    f32x16 s0, s1;
#pragma unroll
    for (int i = 0; i < 16; ++i) { s0[i] = 0.f; s1[i] = 0.f; }
#pragma unroll
    for (int ks = 0; ks < 4; ++ks) {
        s0 = __builtin_amdgcn_mfma_f32_32x32x16_f16(ka[ks], qf[ks], s0, 0, 0, 0);
        s1 = __builtin_amdgcn_mfma_f32_32x32x16_f16(kb2[ks], qf[ks], s1, 0, 0, 0);
    }
    __builtin_amdgcn_sched_barrier(0);
#pragma unroll
    for (int st = 0; st < 4; ++st)
#pragma unroll
        for (int dt = 0; dt < 2; ++dt) {
            va[st][dt] = __builtin_amdgcn_ds_read_tr16_b64_v4i16((LAS s16x4*)(vb + (16 * st) * VP + 64 * dt));
            vc[st][dt] = __builtin_amdgcn_ds_read_tr16_b64_v4i16((LAS s16x4*)(vb + (16 * st + 8) * VP + 64 * dt));
        }
    __builtin_amdgcn_sched_barrier(0);
    float tm = -INFINITY;
#pragma unroll
    for (int i = 0; i < 16; ++i) tm = fmaxf(tm, fmaxf(s0[i], s1[i]));
    { const auto r2 = __builtin_amdgcn_permlane32_swap(__float_as_uint(tm), __float_as_uint(tm), false, false); tm = fmaxf(__uint_as_float(r2[0]), __uint_as_float(r2[1])); }
    rescale_if_needed(rs, fmaf(tm, SC, c));
    const float mu = (rs.m == -INFINITY) ? 0.f : rs.m;
    const float cm = c - mu;
    float ps = 0.f;
#pragma unroll
    for (int i = 0; i < 16; ++i) { s0[i] = __builtin_amdgcn_exp2f(fmaf(s0[i], SC, cm)); s1[i] = __builtin_amdgcn_exp2f(fmaf(s1[i], SC, cm)); ps += s0[i] + s1[i]; }
    rs.l += ps;
#pragma unroll
    for (int st = 0; st < 4; ++st) {
        f16x8 pfr;
#pragma unroll
        for (int j = 0; j < 8; ++j) pfr[j] = (_Float16)((st & 2) ? s1[8 * (st & 1) + j] : s0[8 * (st & 1) + j]);
#pragma unroll
        for (int dt = 0; dt < 2; ++dt) {
            const f16x4 fa = __builtin_bit_cast(f16x4, va[st][dt]), fb = __builtin_bit_cast(f16x4, vc[st][dt]);
            const f16x8 vfr = {fa.x, fa.y, fa.z, fa.w, fb.x, fb.y, fb.z, fb.w};
            if (dt == 0) rs.o0 = __builtin_amdgcn_mfma_f32_32x32x16_f16(vfr, pfr, rs.o0, 0, 0, 0);
            else rs.o1 = __builtin_amdgcn_mfma_f32_32x32x16_f16(vfr, pfr, rs.o1, 0, 0, 0);
        }
    }
}
template <bool IMP>
__device__ __forceinline__ void tile_general(RowState& rs, const LAS unsigned char* kt, const LAS unsigned char* vt, const f16x8 (&qf)[4], const LAS float* lut, int hb, int rho, int hi,
                                             int dbase, int dstep, unsigned dlim, float mc, float invl, LAS float* impA, LAS float* impC, int n, bool wr) {
    const LAS unsigned char* kb = kt + rho * KP + 16 * hi;
    f16x8 ka[4], kb2[4];
#pragma unroll
    for (int ks = 0; ks < 4; ++ks) { ka[ks] = *(const LAS f16x8*)(kb + 32 * ks); kb2[ks] = *(const LAS f16x8*)(kb + 32 * KP + 32 * ks); }
    const int d0 = dbase - dstep * 4 * hi;
    __builtin_amdgcn_sched_barrier(0);
    f32x16 s0, s1;
#pragma unroll
    for (int i = 0; i < 16; ++i) { s0[i] = 0.f; s1[i] = 0.f; }
#pragma unroll
    for (int ks = 0; ks < 4; ++ks) {
        s0 = __builtin_amdgcn_mfma_f32_32x32x16_f16(ka[ks], qf[ks], s0, 0, 0, 0);
        s1 = __builtin_amdgcn_mfma_f32_32x32x16_f16(kb2[ks], qf[ks], s1, 0, 0, 0);
    }
    __builtin_amdgcn_sched_barrier(0);
    float b0[16], b1[16];
#pragma unroll
    for (int rg = 0; rg < 16; ++rg) {
        const int kl = (rg & 3) + 8 * (rg >> 2);
        int da = d0 - dstep * kl, db = d0 - dstep * (kl + 32);
        da = da < 0 ? 0 : da; da = da > 127 ? 127 : da; db = db < 0 ? 0 : db; db = db > 127 ? 127 : db;
        b0[rg] = lut[da * 8 + hb]; b1[rg] = lut[db * 8 + hb];
    }
    float tm = -INFINITY;
#pragma unroll
    for (int rg = 0; rg < 16; ++rg) {
        const int kl = (rg & 3) + 8 * (rg >> 2);
        const unsigned da = (unsigned)(d0 - dstep * kl), db = (unsigned)(d0 - dstep * (kl + 32));
        s0[rg] = da < dlim ? fmaf(s0[rg], SC, b0[rg]) : -INFINITY;
        s1[rg] = db < dlim ? fmaf(s1[rg], SC, b1[rg]) : -INFINITY;
        tm = fmaxf(tm, fmaxf(s0[rg], s1[rg]));
    }
    __builtin_amdgcn_sched_barrier(0);
    const int l16 = rho & 15, g16 = rho >> 4, q = l16 >> 2, p = l16 & 3;
    const LAS unsigned char* vb = vt + (4 * hi + q) * VP + (16 * g16 + 4 * p) * 2;
    s16x4 va[4][2], vc[4][2];
    if (!IMP) {
#pragma unroll
        for (int st = 0; st < 4; ++st)
#pragma unroll
            for (int dt = 0; dt < 2; ++dt) {
                va[st][dt] = __builtin_amdgcn_ds_read_tr16_b64_v4i16((LAS s16x4*)(vb + (16 * st) * VP + 64 * dt));
                vc[st][dt] = __builtin_amdgcn_ds_read_tr16_b64_v4i16((LAS s16x4*)(vb + (16 * st + 8) * VP + 64 * dt));
            }
        __builtin_amdgcn_sched_barrier(0);
    }
    if (!IMP) {
        { const auto r2 = __builtin_amdgcn_permlane32_swap(__float_as_uint(tm), __float_as_uint(tm), false, false); tm = fmaxf(__uint_as_float(r2[0]), __uint_as_float(r2[1])); }
        rescale_if_needed(rs, tm);
        const float mu = (rs.m == -INFINITY) ? 0.f : rs.m;
        float ps = 0.f;
#pragma unroll
        for (int i = 0; i < 16; ++i) { s0[i] = __builtin_amdgcn_exp2f(s0[i] - mu); s1[i] = __builtin_amdgcn_exp2f(s1[i] - mu); ps += s0[i] + s1[i]; }
        rs.l += ps;
#pragma unroll
        for (int st = 0; st < 4; ++st) {
            f16x8 pfr;
#pragma unroll
            for (int j = 0; j < 8; ++j) pfr[j] = (_Float16)((st & 2) ? s1[8 * (st & 1) + j] : s0[8 * (st & 1) + j]);
#pragma unroll
            for (int dt = 0; dt < 2; ++dt) {
                const f16x4 fa = __builtin_bit_cast(f16x4, va[st][dt]), fb = __builtin_bit_cast(f16x4, vc[st][dt]);
                const f16x8 vfr = {fa.x, fa.y, fa.z, fa.w, fb.x, fb.y, fb.z, fb.w};
                if (dt == 0) rs.o0 = __builtin_amdgcn_mfma_f32_32x32x16_f16(vfr, pfr, rs.o0, 0, 0, 0);
                else rs.o1 = __builtin_amdgcn_mfma_f32_32x32x16_f16(vfr, pfr, rs.o1, 0, 0, 0);
            }
        }
    } else {
        const float mu = (mc == -INFINITY) ? 0.f : mc;
#pragma unroll
        for (int kh = 0; kh < 2; ++kh)
#pragma unroll
            for (int ii = 0; ii < 4; ++ii) {
                float pv[4];
#pragma unroll
                for (int e = 0; e < 4; ++e) pv[e] = __builtin_amdgcn_exp2f((kh ? s1[4 * ii + e] : s0[4 * ii + e]) - mu) * invl;
                float a = (pv[0] + pv[1]) + (pv[2] + 0.5f * pv[3]), c = 0.5f * pv[3];
                a += __shfl_xor(a, 1); a += __shfl_xor(a, 2); c += __shfl_xor(c, 1); c += __shfl_xor(c, 2);
                const int nb = 16 * n + 8 * kh + 2 * ii + hi;
                if (wr) { impA[nb] = a; if (nb + 1 < 64) impC[nb + 1] = c; }
            }
    }
}
__device__ __forceinline__ void probs(RowState& rs, f32x16& s0, float sc, float c) {
    float tm = -INFINITY;
#pragma unroll
    for (int i = 0; i < 16; ++i) tm = fmaxf(tm, s0[i]);
    tm = fmaxf(tm, __shfl_xor(tm, 32));
    rescale_if_needed(rs, fmaf(tm, sc, c));
    const float mu = (rs.m == -INFINITY) ? 0.f : rs.m;
    const float cm = c - mu;
    float ps = 0.f;
#pragma unroll
    for (int i = 0; i < 16; ++i) { s0[i] = __builtin_amdgcn_exp2f(fmaf(s0[i], sc, cm)); ps += s0[i]; }
    rs.l += ps;
}
__device__ __forceinline__ void rs_init(RowState& rs) { rs.m = -INFINITY; rs.l = 0.f;
#pragma unroll
    for (int i = 0; i < 16; ++i) { rs.o0[i] = 0.f; rs.o1[i] = 0.f; } }
__device__ __forceinline__ void rs_flush(RowState& rs, float gate, _Float16* orow, bool first) {
    const float lt = rs.l + __shfl_xor(rs.l, 32);
    const float w = gate / fmaxf(lt, 1e-30f);
#pragma unroll
    for (int i = 0; i < 4; ++i) {
        float a[8] = {w * rs.o0[4 * i], w * rs.o0[4 * i + 1], w * rs.o0[4 * i + 2], w * rs.o0[4 * i + 3], w * rs.o1[4 * i], w * rs.o1[4 * i + 1], w * rs.o1[4 * i + 2], w * rs.o1[4 * i + 3]};
        if (!first) { const u32x2 p0 = *(const u32x2*)(orow + 8 * i), p1 = *(const u32x2*)(orow + 32 + 8 * i);
            const unsigned u0 = p0.x, u1 = p0.y, u2 = p1.x, u3 = p1.y; const pg8::f16x2 h0 = __builtin_bit_cast(pg8::f16x2, u0), h1 = __builtin_bit_cast(pg8::f16x2, u1), h2 = __builtin_bit_cast(pg8::f16x2, u2), h3 = __builtin_bit_cast(pg8::f16x2, u3);
            a[0] += (float)h0.x; a[1] += (float)h0.y; a[2] += (float)h1.x; a[3] += (float)h1.y; a[4] += (float)h2.x; a[5] += (float)h2.y; a[6] += (float)h3.x; a[7] += (float)h3.y; }
        u32x2 w0; w0.x = pg8::pkh(a[0], a[1]); w0.y = pg8::pkh(a[2], a[3]); *(u32x2*)(orow + 8 * i) = w0;
        u32x2 w1; w1.x = pg8::pkh(a[4], a[5]); w1.y = pg8::pkh(a[6], a[7]); *(u32x2*)(orow + 32 + 8 * i) = w1;
    }
}

__device__ __forceinline__ void nsa_unit(LAS unsigned char* lds, const _Float16* __restrict__ proj, const _Float16* __restrict__ kcmp, const _Float16* __restrict__ vcmp,
                                         _Float16* __restrict__ o_b, int b, int g, int qb) {
    const int tid = threadIdx.x, lane = tid & 63, wave = __builtin_amdgcn_readfirstlane(tid >> 6);
    const int rho = lane & 31, hi = lane >> 5, ql = rho >> 2, r = rho & 3, hb = g * 4 + r;
    const int t = 64 * qb + 8 * wave + ql;
    const _Float16* prow = proj + (size_t)(b * S_ + t) * PW;
    f16x8 qf[4];
#pragma unroll
    for (int ks = 0; ks < 4; ++ks) qf[ks] = *(const f16x8*)(prow + C_QB + hb * 64 + 16 * ks + 8 * hi);
    for (int i = tid; i < 2048; i += 512) ((LAS u32x4*)(lds + L_IMPA))[i] = (u32x4){0u, 0u, 0u, 0u};
    RowState rs; rs_init(rs);
    const LAS float* lut = (const LAS float*)(lds + L_BIAS);
    const float bias31 = lut[127 * 8 + hb];
    const _Float16* kc = kcmp + (size_t)(b * 2 + g) * 256 * 64;
    const long vcoff = (vcmp + (size_t)(b * 2 + g) * 256 * 64) - kc;
    const _Float16* pb = proj + (size_t)(b * S_) * PW + C_KVB + g * 64;
    const int ncmp = (4 * qb + 3 + 63) / 64;
    const int wlo = qb - 8 > 0 ? qb - 8 : 0;
    const int e0 = ncmp, e1 = 2 * ncmp, e2 = e1 + qb + 1, NT = e2 + (qb - wlo + 1);
    const int sr = tid >> 3, scq = tid & 7;
    float mc = 0.f, invl = 0.f; unsigned mlo = 0u, mhi = 0u;
    Stage stg;
#define NSA_DECODE(i, br, n) do { if ((i) < e0) { br = 0; n = (i); } else if ((i) < e1) { br = 1; n = (i) - e0; } else if ((i) < e2) { br = 2; n = (i) - e1; } else { br = 3; n = wlo + (i) - e2; } } while (0)
#define NSA_LOAD(i) do { int br_, n_; NSA_DECODE(i, br_, n_); const _Float16* kp_ = (br_ < 2) ? kc : (br_ == 2 ? pb + 2 * 128 : pb + 4 * 128); const int pitch_ = (br_ < 2) ? 64 : PW; \
        const long vo_ = (br_ < 2) ? vcoff : 128; const _Float16* rp_ = kp_ + (size_t)(64 * n_ + sr) * pitch_ + 8 * scq; stg.kr = *(const u32x4*)rp_; stg.vr = *(const u32x4*)(rp_ + vo_); } while (0)
#define NSA_STORE(buf) do { LAS unsigned char* tb_ = lds + L_T0 + (buf) * TILE_B; *(LAS u32x4*)(tb_ + sr * KP + 16 * scq) = stg.kr; *(LAS u32x4*)(tb_ + 64 * KP + sr * VP + 16 * scq) = stg.vr; } while (0)
    __syncthreads();
    NSA_LOAD(0); NSA_STORE(0);
    __syncthreads();
#pragma unroll 1
    for (int i = 0; i < NT; ++i) {
        int br, n; NSA_DECODE(i, br, n);
        const LAS unsigned char* tb = lds + L_T0 + (i & 1) * TILE_B;
        const bool more = i + 1 < NT;
        if (more) NSA_LOAD(i + 1);
        bool bit = true; int dbase, dstep = 1, dlim = 1 << 30; bool near = true;
        if (br < 2) { dbase = t - 31 - 1024 * n; dstep = 16; }
        else { dbase = t - 64 * n; near = n >= qb - 2; if (br == 2) bit = (n < 32) ? ((mlo >> n) & 1u) : ((mhi >> (n - 32)) & 1u); else dlim = 512; }
        const bool interior = (br >= 2) && (n <= qb - 3) && !(br == 3 && n == qb - 8);
        const bool skip = (br == 2) && !__any(bit);
        if (!skip) {
            if (interior) tile_fast(rs, tb, tb + 64 * KP, qf, bit ? bias31 : -INFINITY, rho, hi);
            else {
                const unsigned dl = bit ? (unsigned)dlim : 0u;
                int tq = threadIdx.x; asm volatile("" : "+v"(tq));
                LAS float* impA = (LAS float*)(lds + L_IMPA) + ((tq >> 6) * 8 + ((tq & 31) >> 2)) * 64;
                LAS float* impC = (LAS float*)(lds + L_IMPC) + ((tq >> 6) * 8 + ((tq & 31) >> 2)) * 64;
                if (br != 1) tile_general<false>(rs, tb, tb + 64 * KP, qf, lut, hb, rho, hi, dbase, dstep, dl, 0.f, 0.f, impA, impC, n, false);
                else tile_general<true>(rs, tb, tb + 64 * KP, qf, lut, hb, rho, hi, dbase, dstep, dl, mc, invl, impA, impC, n, r == 0);
            }
        }
        if (i + 1 == e0) {
            mc = rs.m; const float lc = rs.l + __shfl_xor(rs.l, 32); invl = 1.f / fmaxf(lc, 1e-30f);
            rs_flush(rs, pg8::sigm((float)prow[C_GB + 0 * 8 + hb]), o_b + (size_t)(b * S_ + t) * 1024 + hb * 64 + 4 * hi, true); rs_init(rs);
        } else if (i + 1 == e1) {
            asm volatile("s_waitcnt lgkmcnt(0)" ::: "memory");
            int tq = threadIdx.x; asm volatile("" : "+v"(tq));
            const int qs = (tq & 63) >> 3, j = tq & 7, wv = tq >> 6;
            LAS float* sA = (LAS float*)(lds + L_IMPA) + (wv * 8 + qs) * 64;
            const LAS float* sC = (const LAS float*)(lds + L_IMPC) + (wv * 8 + qs) * 64;
            float sc[8];
#pragma unroll
            for (int e = 0; e < 8; ++e) { const int nn = 8 * j + e; const bool forced = (nn == 0) || (nn == qb) || (nn == qb - 1);
                sc[e] = (nn <= qb) ? (forced ? 1.0e4f : (sA[nn] + sC[nn])) : -INFINITY; }
            asm volatile("s_waitcnt lgkmcnt(0)" ::: "memory");
#pragma unroll
            for (int e = 0; e < 8; ++e) sA[8 * j + e] = sc[e];
            asm volatile("s_waitcnt lgkmcnt(0)" ::: "memory");
            int rank[8];
#pragma unroll
            for (int e = 0; e < 8; ++e) rank[e] = 0;
            for (int m = 0; m <= qb; ++m) { const float sm = sA[m];
#pragma unroll
                for (int e = 0; e < 8; ++e) rank[e] += (sm > sc[e] || (sm == sc[e] && m < 8 * j + e)) ? 1 : 0; }
            unsigned bits = 0;
#pragma unroll
            for (int e = 0; e < 8; ++e) bits |= ((8 * j + e <= qb) && rank[e] < 16) ? (1u << e) : 0u;
            ((LAS unsigned char*)(lds + L_MASK))[(wv * 8 + qs) * 8 + j] = (unsigned char)bits;
            asm volatile("s_waitcnt lgkmcnt(0)" ::: "memory");
            const u32x2 mk = *(const LAS u32x2*)(lds + L_MASK + (wv * 8 + ((tq & 31) >> 2)) * 8);
            mlo = mk.x; mhi = mk.y;
        } else if (i + 1 == e2) {
            rs_flush(rs, pg8::sigm((float)prow[C_GB + 1 * 8 + hb]), o_b + (size_t)(b * S_ + t) * 1024 + hb * 64 + 4 * hi, false); rs_init(rs);
        } else if (i + 1 == NT) {
            rs_flush(rs, pg8::sigm((float)prow[C_GB + 2 * 8 + hb]), o_b + (size_t)(b * S_ + t) * 1024 + hb * 64 + 4 * hi, false);
        }
        if (more) NSA_STORE((i + 1) & 1);
        __syncthreads();
    }
#undef NSA_DECODE
#undef NSA_LOAD
#undef NSA_STORE
}
}


namespace cmpx {
typedef _Float16 f16x8 __attribute__((ext_vector_type(8)));
typedef float f32x4 __attribute__((ext_vector_type(4)));
typedef unsigned u32x4 __attribute__((ext_vector_type(4)));
constexpr int L_PART = 0, L_HID = 65536, HIDP = 272, L_END = L_HID + 16 * HIDP;
__device__ __forceinline__ void item(LAS unsigned char* lds, const _Float16* __restrict__ proj, const float* __restrict__ pe, const _Float16* __restrict__ w1t, const _Float16* __restrict__ w2t,
                                     _Float16* __restrict__ dst, int b, int g, int kv, int ct) {
    const int tid = threadIdx.x, lane = tid & 63, wave = __builtin_amdgcn_readfirstlane(tid >> 6), kc = lane >> 4, n16 = lane & 15;
    f32x4 acc[8];
#pragma unroll
    for (int nt = 0; nt < 8; ++nt) acc[nt] = (f32x4){0.f, 0.f, 0.f, 0.f};
    const int c = 16 * ct + n16;
#pragma unroll 2
    for (int ks = 0; ks < 8; ++ks) {
        const int k0 = 32 * (8 * wave + ks) + 8 * kc, lt = k0 >> 6, d = k0 & 63;
        int trow = 16 * c + lt; trow = trow > S_ - 1 ? S_ - 1 : trow;
        const f16x8 raw = *(const f16x8*)(proj + (size_t)(b * S_ + trow) * PW + C_KVB + kv * 128 + g * 64 + d);
        const f32x4 p0 = *(const f32x4*)(pe + lt * 64 + d), p1 = *(const f32x4*)(pe + lt * 64 + d + 4);
        f16x8 afr;
        afr[0] = (_Float16)((float)raw[0] + p0.x); afr[1] = (_Float16)((float)raw[1] + p0.y); afr[2] = (_Float16)((float)raw[2] + p0.z); afr[3] = (_Float16)((float)raw[3] + p0.w);
        afr[4] = (_Float16)((float)raw[4] + p1.x); afr[5] = (_Float16)((float)raw[5] + p1.y); afr[6] = (_Float16)((float)raw[6] + p1.z); afr[7] = (_Float16)((float)raw[7] + p1.w);
#pragma unroll
        for (int nt = 0; nt < 8; ++nt) {
            const f16x8 bfr = *(const f16x8*)(w1t + (size_t)(16 * nt + n16) * 2048 + k0);
            acc[nt] = __builtin_amdgcn_mfma_f32_16x16x32_f16(afr, bfr, acc[nt], 0, 0, 0);
        }
    }
    LAS float* part = (LAS float*)(lds + L_PART) + wave * 2048;
#pragma unroll
    for (int nt = 0; nt < 8; ++nt) { part[(4 * kc + 0) * 128 + 16 * nt + n16] = acc[nt].x; part[(4 * kc + 1) * 128 + 16 * nt + n16] = acc[nt].y;
        part[(4 * kc + 2) * 128 + 16 * nt + n16] = acc[nt].z; part[(4 * kc + 3) * 128 + 16 * nt + n16] = acc[nt].w; }
    __syncthreads();
    { const LAS float* pp = (const LAS float*)(lds + L_PART);
#pragma unroll
      for (int e = 0; e < 4; ++e) { const int o = tid + 512 * e; float a = 0.f;
#pragma unroll
          for (int w = 0; w < 8; ++w) a += pp[w * 2048 + o];
          const float z = 0.7978845608028654f * (a + 0.044715f * a * a * a);
          const float th = 1.f - 2.f / (__expf(2.f * z) + 1.f);
          ((LAS _Float16*)(lds + L_HID + (o >> 7) * HIDP))[o & 127] = (_Float16)(0.5f * a * (1.f + th)); } }
    __syncthreads();
    if (wave < 4) {
        f32x4 o = {0.f, 0.f, 0.f, 0.f};
#pragma unroll
        for (int ks = 0; ks < 4; ++ks) {
            const f16x8 afr = *(const LAS f16x8*)(lds + L_HID + n16 * HIDP + (32 * ks + 8 * kc) * 2);
            const f16x8 bfr = *(const f16x8*)(w2t + (size_t)(16 * wave + n16) * 128 + 32 * ks + 8 * kc);
            o = __builtin_amdgcn_mfma_f32_16x16x32_f16(afr, bfr, o, 0, 0, 0);
        }
        const float ov[4] = {o.x, o.y, o.z, o.w};
#pragma unroll
        for (int e = 0; e < 4; ++e) { const int cc = 16 * ct + 4 * kc + e; dst[((size_t)(b * 2 + g) * 256 + cc) * 64 + 16 * wave + n16] = (_Float16)(cc == 255 ? 0.f : ov[e]); }
    }
    __syncthreads();
}
}


#define XB_TMO      128
#define XB_XCNT(j)  (256  + 64 * (j))
#define XB_XSUB(j)  (1280 + 64 * (j))
#define XB_XGEN(j)  (2304 + 64 * (j))
#define XB_TOP      3328
#define XB_TOPGEN   3392
#define XCD_BAR_WORDS 3456
#define XB_SPIN_CAP (1u << 18)
__device__ __forceinline__ unsigned xb_ld(unsigned* p)              { return __hip_atomic_load(p, __ATOMIC_RELAXED, __HIP_MEMORY_SCOPE_AGENT); }
__device__ __forceinline__ unsigned xb_add(unsigned* p, unsigned v) { return __hip_atomic_fetch_add(p, v, __ATOMIC_RELAXED, __HIP_MEMORY_SCOPE_AGENT); }
__device__ __forceinline__ unsigned xb_xcc_id() { return (unsigned)__builtin_amdgcn_s_getreg((3 << 11) | 20) & 0xFu; }
#define XB_SPIN(cond, bar) do { unsigned _sp = 0; while (cond) { __builtin_amdgcn_s_sleep(1); \
    if ((++_sp & 255u) == 0u) { if (xb_ld(&(bar)[XB_TMO])) break; if (_sp > XB_SPIN_CAP) { atomicAdd(&(bar)[XB_TMO], 1u); break; } } } } while (0)
struct XcdBarrier { unsigned* bar; unsigned x; volatile LAS unsigned* st; };
__device__ __forceinline__ XcdBarrier xcd_barrier_post(unsigned* bar, volatile LAS unsigned* st) {
    XcdBarrier b; b.bar = bar; b.x = xb_xcc_id(); b.st = st;
    if (threadIdx.x == 0) (void)xb_add(&bar[XB_XCNT(b.x)], 1u);
    return b;
}
__device__ __forceinline__ void xcd_barrier_complete(unsigned* bar, unsigned x, unsigned& nloc, unsigned& nx) {
    const unsigned G = gridDim.x * gridDim.y * gridDim.z;
    unsigned sum, cnt, mine, sp = 0u;
    for (;;) {
        sum = 0u; cnt = 0u; mine = 0u;
#pragma unroll
        for (unsigned j = 0; j < 16; ++j) { const unsigned c = xb_ld(&bar[XB_XCNT(j)]); sum += c; cnt += (c > 0u) ? 1u : 0u; mine = (j == x) ? c : mine; }
        if (sum == G) break;
        __builtin_amdgcn_s_sleep(1);
        if ((++sp & 255u) == 0u) { if (xb_ld(&bar[XB_TMO])) break; if (sp > XB_SPIN_CAP) { atomicAdd(&bar[XB_TMO], 1u); break; } }
    }
    nloc = mine > 0u ? mine : 1u; nx = cnt > 0u ? cnt : 1u;
}
__device__ __forceinline__ void xcd_barrier(const XcdBarrier& b) {
    asm volatile("s_waitcnt vmcnt(0)" ::: "memory");
    __syncthreads();
    if (threadIdx.x == 0) {
        unsigned* bar = b.bar;
        __builtin_amdgcn_s_waitcnt(0);
        unsigned nloc = b.st[0], nx = b.st[1];
        if (nloc == 0u) { xcd_barrier_complete(bar, b.x, nloc, nx); b.st[0] = nloc; b.st[1] = nx; }
        const unsigned old = xb_add(&bar[XB_XSUB(b.x)], 1u);
        const unsigned gen = old / nloc;
        if (old + 1u == (gen + 1u) * nloc) {
            __builtin_amdgcn_fence(__ATOMIC_RELEASE, "agent");
            asm volatile("s_waitcnt vmcnt(0)" ::: "memory");
            const unsigned og = xb_add(&bar[XB_TOP], 1u);
            const unsigned tg = og / nx;
            if (og + 1u == (tg + 1u) * nx) xb_add(&bar[XB_TOPGEN], 1u);
            else XB_SPIN(xb_ld(&bar[XB_TOPGEN]) == tg, bar);
            __builtin_amdgcn_fence(__ATOMIC_ACQUIRE, "agent");
            xb_add(&bar[XB_XGEN(b.x)], 1u);
            asm volatile("s_waitcnt vmcnt(0)" ::: "memory");
        } else {
            XB_SPIN(xb_ld(&bar[XB_XGEN(b.x)]) == gen, bar);
            __builtin_amdgcn_fence(__ATOMIC_ACQUIRE, "agent");
            asm volatile("s_waitcnt vmcnt(0)" ::: "memory");
        }
    }
    __syncthreads();
}

constexpr int MEGA_LDS = 131072 + 256;

template <class Epi>
__device__ __forceinline__ void gemm_run(LAS unsigned char* lds, const void* A, const void* Bt, const Epi& E, int M, int N, int K) {
    pg8::Gemm g{(const pg8::bf16_t*)A, (const pg8::bf16_t*)Bt, M, N, K};
    pg8::StaticOrder S; S.init(M, N, (int)gridDim.x, (int)blockIdx.x);
    pg8::gemm_phase<Epi, pg8::StaticOrder, true, true>(lds, g, S, E);
}

__global__ void __launch_bounds__(512, 2) mega_fwd(Args a) {
    extern __shared__ __attribute__((aligned(16))) unsigned char lds_raw[];
    LAS unsigned char* lds = (LAS unsigned char*)lds_raw;
    unsigned char* ws = a.ws;
    if (threadIdx.x == 0) *(LAS dsa::u32x4*)(lds + 131072) = (dsa::u32x4){0u, 0u, 0u, 0u};
    __syncthreads();
    XcdBarrier bar = xcd_barrier_post((unsigned*)(ws + WS_CTL), (volatile LAS unsigned*)(lds + 131072));
    const _Float16* proj = (const _Float16*)(ws + WS_PROJ);
    _Float16* o_a = (_Float16*)(ws + WS_H); _Float16* o_b = (_Float16*)(ws + WS_H) + 512;
    _Float16* kcmp = (_Float16*)(ws + WS_KCMP); _Float16* vcmp = (_Float16*)(ws + WS_VCMP);

    prologue_body(a, lds_raw);
    xcd_barrier(bar);
    gemm_run(lds, ws + WS_H, ws + WS_WIN, pg8::EpiProj{(_Float16*)(ws + WS_PROJ)}, M_, PW, D_);
    xcd_barrier(bar);
#pragma unroll 1
    for (int it = blockIdx.x; it < 512; it += gridDim.x) { const int ct = it & 15, kv = (it >> 4) & 1, g = (it >> 5) & 1, b = it >> 6;
        cmpx::item(lds, proj, kv ? a.pe_v : a.pe_k, (const _Float16*)(ws + WS_CW + (kv ? 512 * 1024 : 0)), (const _Float16*)(ws + WS_CW + 1024 * 1024 + (kv ? 16384 : 0)), kv ? vcmp : kcmp, b, g, kv, ct); }
    { LAS float* biaslut = (LAS float*)(lds + dsa::L_BIAS);
      for (int i = threadIdx.x; i < 1024; i += 512) { const int d = i >> 3, h = i & 7; biaslut[i] = a.rel_bias[t5_bucket(d) * 16 + h]; } }
    __syncthreads();
#pragma unroll 1
    for (int v = blockIdx.x >> 3; v < 256; v += (gridDim.x >> 3)) { const int b = blockIdx.x & 7, j = v & 127;
        dsa::dsa_tile(lds, proj, o_a, b, (v < 128) ? 255 - j : j); }
    xcd_barrier(bar);
    { LAS float* lut = (LAS float*)(lds + nsa::L_BIAS);
      for (int i = threadIdx.x; i < 1024; i += 512) { const int d = i >> 3, h = i & 7; lut[i] = a.rel_bias[t5_bucket(d) * 16 + 8 + h] * nsa::LOG2E; } }
    __syncthreads();
#pragma unroll 1
    for (int v = blockIdx.x >> 3; v < 128; v += (gridDim.x >> 3)) { const int bg = 2 * (blockIdx.x & 7) + (v >> 6), j = v & 31;
        nsa::nsa_unit(lds, proj, kcmp, vcmp, o_b, bg >> 1, bg & 1, (v & 32) ? j : 63 - j);
        __syncthreads(); }
    xcd_barrier(bar);
    gemm_run(lds, ws + WS_H, ws + WS_WBA, pg8::EpiMixF{(_Float16*)(ws + WS_MIX), proj}, M_, D_, D_);
    xcd_barrier(bar);
    gemm_run(lds, ws + WS_MIX, ws + WS_WOUT, pg8::EpiResidSq{a.x, a.out, (_Float16*)(ws + WS_H), (float*)(ws + WS_ROWSQ)}, M_, D_, D_);
    xcd_barrier(bar);
    gemm_run(lds, ws + WS_H, ws + WS_WMI, pg8::EpiRelu2N{(_Float16*)(ws + WS_PROJ), (const float*)(ws + WS_ROWSQ)}, M_, DFF, D_);
    xcd_barrier(bar);
    gemm_run(lds, ws + WS_PROJ, ws + WS_WMO, EpiAccOut{(_Float16*)(ws + WS_MIX), (const _Float16*)(ws + WS_H), (float*)(ws + WS_ROWSQ2)}, M_, D_, DFF);
    xcd_barrier(bar);
    { int tx = threadIdx.x; asm volatile("" : "+v"(tx)); const int lane = tx & 63; const float* rq = (const float*)(ws + WS_ROWSQ2);
#pragma unroll 4
      for (int m = blockIdx.x * 8 + (tx >> 6); m < M_; m += gridDim.x * 8) final_scale_row((const _Float16*)(ws + WS_MIX) + (size_t)m * D_, a.out + (size_t)m * D_, a.norm_final, rq[m], lane); }
}
}

extern "C" void kernel_launch(void* const* d_in, const int* in_sizes, int n_in, void* d_out, int out_size, void* d_ws, size_t ws_size, hipStream_t stream) {
    if (ws_size < WS_END) { fprintf(stderr, "ws too small: %zu\n", ws_size); return; }
    static int grid = 0;
    if (!grid) {
        int dev = 0, cus = 0, per_cu = 0;
        (void)hipGetDevice(&dev);
        (void)hipDeviceGetAttribute(&cus, hipDeviceAttributeMultiprocessorCount, dev);
        (void)hipFuncSetAttribute((const void*)mega_fwd, hipFuncAttributeMaxDynamicSharedMemorySize, MEGA_LDS);
        (void)hipOccupancyMaxActiveBlocksPerMultiprocessor(&per_cu, (const void*)mega_fwd, 512, MEGA_LDS);
        (void)hipGetLastError();
        grid = cus;
        if (per_cu < 1) fprintf(stderr, "occupancy query says %d blocks/CU\n", per_cu);
    }
    Args a{};
    a.x = (const float*)d_in[0]; a.norm_mix = (const float*)d_in[1]; a.w_in = (const float*)d_in[2];
    a.pe_k = (const float*)d_in[3]; a.w1_k = (const float*)d_in[4]; a.w2_k = (const float*)d_in[5];
    a.pe_v = (const float*)d_in[6]; a.w1_v = (const float*)d_in[7]; a.w2_v = (const float*)d_in[8];
    a.rel_bias = (const float*)d_in[9]; a.w_ba = (const float*)d_in[10]; a.w_bb = (const float*)d_in[11];
    a.w_out = (const float*)d_in[12]; a.norm_mlp = (const float*)d_in[13]; a.w_mi = (const float*)d_in[14];
    a.w_mo = (const float*)d_in[15]; a.norm_final = (const float*)d_in[16];
    a.out = (float*)d_out; a.ws = (unsigned char*)d_ws;
    (void)hipMemsetAsync(d_ws, 0, 327680, stream);
    hipLaunchKernelGGL(mega_fwd, dim3(grid), dim3(512), MEGA_LDS, stream, a);
}
```

```cpp
#include <hip/hip_runtime.h>
#include <hip/hip_fp16.h>
#include <cstdint>
#include <cstdio>

namespace pg8 {
#define PG8_LAS __attribute__((address_space(3)))
typedef unsigned short bf16_t;
typedef _Float16 bf16x8 __attribute__((ext_vector_type(8)));
typedef float f32x4 __attribute__((ext_vector_type(4)));
typedef unsigned u32x4 __attribute__((ext_vector_type(4)));
constexpr int BM = 256, BK = 64, HALF = 128, HTB = HALF * BK * 2  , STAGE_BYTES = 8 * HTB, NXCD = 8, WGM = 8;

__host__ __device__ __forceinline__ int lds_byte(int r, int c) { const int st = (r >> 4) * 2 + (c >> 5), rr = r & 15, cc = c & 31, ob = rr * 64 + cc * 2; return st * 1024 + (ob ^ (((ob >> 9) & 1) << 5)); }
__host__ __device__ __forceinline__ void stage_rc(int b, int& R, int& C) { const int st = b / 1024, sb = b % 1024, swz = sb ^ (((sb >> 9) & 1) << 5); R = (st >> 1) * 16 + swz / 64; C = (st & 1) * 32 + (swz % 64) / 2; }
__host__ __device__ __forceinline__ int perm32(int rho) { const int n = rho >> 4, i = rho & 15; return 8 * (i >> 2) + 4 * n + (i & 3); }

struct Unit { int pm, pn; };
struct Gemm { const bf16_t* A; const bf16_t* Bt; int M, N, K; };

struct StaticOrder {
    int nM, nN, nwg, G, c;
    __host__ __device__ void init(int M, int N, int G_, int c_) { nM = M / BM; nN = N / BM; nwg = nM * nN; G = G_; c = c_; }
    __host__ __device__ bool next(int i, Unit& u) const {
        const long L = (long)i * G + c; if (L >= nwg) return false;
        int wgid = (int)L; { const int q = nwg / NXCD, r = nwg % NXCD, xcd = wgid % NXCD, off = wgid / NXCD; wgid = (xcd < r ? xcd * (q + 1) : r * (q + 1) + (xcd - r) * q) + off; }
        const int nig = WGM * nN, gid = wgid / nig, fm = gid * WGM, gsz = (nM - fm) < WGM ? (nM - fm) : WGM;
        u.pm = fm + ((wgid % nig) % gsz); u.pn = (wgid % nig) / gsz; return true;
    }
    __device__ __forceinline__ void a_ready(const Unit&) const {}
    __device__ __forceinline__ void done(const Unit&) const {}
};


typedef unsigned u32x2 __attribute__((ext_vector_type(2)));
typedef float f32x2 __attribute__((ext_vector_type(2)));
typedef _Float16 f16x2 __attribute__((ext_vector_type(2)));
constexpr int PW = 4352;
__device__ __forceinline__ unsigned pkh(float a, float b) { f32x2 v = {a, b}; f16x2 h = __builtin_convertvector(v, f16x2); return __builtin_bit_cast(unsigned, h); }
__device__ __forceinline__ float sigm(float v) { return __builtin_amdgcn_rcpf(1.f + __expf(-v)); }
__device__ __forceinline__ float sigm_gate(float v) { return fmaxf(sigm(v), 6.2e-5f); }
__device__ __forceinline__ void unpk8(const u32x4 w, float (&f)[8]) {
#pragma unroll
    for (int i = 0; i < 4; ++i) { const unsigned wi = (i == 0) ? w.x : (i == 1) ? w.y : (i == 2) ? w.z : w.w; const f16x2 h = __builtin_bit_cast(f16x2, wi); f[2 * i] = (float)h.x; f[2 * i + 1] = (float)h.y; } }

struct EpiProj {
    static constexpr bool PERM = true, AFTER_DRAIN = false, MID = false;
    _Float16* O;
    __device__ __forceinline__ void operator()(const f32x4 (&acc)[2][2][4][2], const Unit& u, int wr, int wc, int fr, int fq) const {
        const int row0 = u.pm * BM + wr * 64 + fr, col0 = u.pn * BM + wc * 32 + 8 * fq; const bool sg = u.pn >= 9;
#pragma unroll
        for (int ai = 0; ai < 2; ++ai)
#pragma unroll
            for (int m = 0; m < 4; ++m) { _Float16* rowp = O + (size_t)(row0 + ai * HALF + m * 16) * PW + col0;
#pragma unroll
                for (int bj = 0; bj < 2; ++bj) { f32x4 v0 = acc[ai][bj][m][0], v1 = acc[ai][bj][m][1];
                    if (sg) {
#pragma unroll
                        for (int i = 0; i < 4; ++i) { v0[i] = sigm_gate(v0[i]); v1[i] = sigm_gate(v1[i]); } }
                    u32x4 w; w.x = pkh(v0[0], v0[1]); w.y = pkh(v0[2], v0[3]); w.z = pkh(v1[0], v1[1]); w.w = pkh(v1[2], v1[3]);
                    *(u32x4*)(rowp + bj * HALF) = w; } }
    }
};
struct EpiMixF {
    static constexpr bool PERM = true, AFTER_DRAIN = false, MID = true;
    _Float16* mix; const _Float16* proj;
    __device__ __forceinline__ void mid(f32x4 (&acc)[2][2][4][2], const Unit& u, int wr, int wc, int fr, int fq) const {
        int row0 = u.pm * BM + wr * 64 + fr, col0 = u.pn * BM + wc * 32 + 8 * fq;
        asm volatile("" : "+v"(row0), "+v"(col0));
#pragma unroll
        for (int ai = 0; ai < 2; ++ai)
#pragma unroll
            for (int m = 0; m < 4; ++m) { const _Float16* gr = proj + (size_t)(row0 + ai * HALF + m * 16) * PW + 2304 + col0;
#pragma unroll
                for (int bj = 0; bj < 2; ++bj)
#pragma unroll
                    for (int n = 0; n < 2; ++n) {
                        const u32x2 wa = *(const u32x2*)(gr + bj * HALF + 4 * n), wb = *(const u32x2*)(gr + 1024 + bj * HALF + 4 * n);
                        const unsigned a0 = wa.x, a1 = wa.y, b0 = wb.x, b1 = wb.y;
                        const f16x2 ga0 = __builtin_bit_cast(f16x2, a0), ga1 = __builtin_bit_cast(f16x2, a1), gb0 = __builtin_bit_cast(f16x2, b0), gb1 = __builtin_bit_cast(f16x2, b1);
                        acc[ai][bj][m][n][0] *= (float)ga0.x * __builtin_amdgcn_rcpf((float)gb0.x); acc[ai][bj][m][n][1] *= (float)ga0.y * __builtin_amdgcn_rcpf((float)gb0.y);
                        acc[ai][bj][m][n][2] *= (float)ga1.x * __builtin_amdgcn_rcpf((float)gb1.x); acc[ai][bj][m][n][3] *= (float)ga1.y * __builtin_amdgcn_rcpf((float)gb1.y);
                        __builtin_amdgcn_sched_barrier(0);
                    } }
    }
    __device__ __forceinline__ void operator()(const f32x4 (&acc)[2][2][4][2], const Unit& u, int wr, int wc, int fr, int fq) const {
        const int row0 = u.pm * BM + wr * 64 + fr, col0 = u.pn * BM + wc * 32 + 8 * fq;
#pragma unroll
        for (int ai = 0; ai < 2; ++ai)
#pragma unroll
            for (int m = 0; m < 4; ++m) { const size_t r = (size_t)(row0 + ai * HALF + m * 16);
#pragma unroll
                for (int bj = 0; bj < 2; ++bj) { const int c = col0 + bj * HALF;
                    float gb[8]; unpk8(*(const u32x4*)(proj + r * PW + 3328 + c), gb);
                    const f32x4 v0 = acc[ai][bj][m][0], v1 = acc[ai][bj][m][1];
                    u32x4 w; w.x = pkh(gb[0] * v0[0], gb[1] * v0[1]); w.y = pkh(gb[2] * v0[2], gb[3] * v0[3]); w.z = pkh(gb[4] * v1[0], gb[5] * v1[1]); w.w = pkh(gb[6] * v1[2], gb[7] * v1[3]);
                    *(u32x4*)(mix + r * 1024 + c) = w; } }
    }
};
struct EpiResidSq {
    static constexpr bool PERM = true, AFTER_DRAIN = false, MID = false;
    const float* x; float* out; _Float16* xh; float* rowsq;
    __device__ __forceinline__ void operator()(const f32x4 (&acc)[2][2][4][2], const Unit& u, int wr, int wc, int fr, int fq) const {
        const int row0 = u.pm * BM + wr * 64 + fr, col0 = u.pn * BM + wc * 32 + 8 * fq;
#pragma unroll
        for (int ai = 0; ai < 2; ++ai)
#pragma unroll
            for (int m = 0; m < 4; ++m) { const size_t r = (size_t)(row0 + ai * HALF + m * 16); float sq = 0.f;
#pragma unroll
                for (int bj = 0; bj < 2; ++bj) { const size_t o = r * 1024 + col0 + bj * HALF;
                    const f32x4 a0 = *(const f32x4*)(x + o) + acc[ai][bj][m][0], a1 = *(const f32x4*)(x + o + 4) + acc[ai][bj][m][1];
                    u32x4 w; w.x = pkh(a0[0], a0[1]); w.y = pkh(a0[2], a0[3]); w.z = pkh(a1[0], a1[1]); w.w = pkh(a1[2], a1[3]);
                    *(u32x4*)(xh + o) = w;
                    sq += (a0[0] * a0[0] + a0[1] * a0[1]) + (a0[2] * a0[2] + a0[3] * a0[3]) + (a1[0] * a1[0] + a1[1] * a1[1]) + (a1[2] * a1[2] + a1[3] * a1[3]); }
                sq += __shfl_xor(sq, 16); sq += __shfl_xor(sq, 32);
                if (fq == 0) atomicAdd(rowsq + r, sq); }
    }
};
struct EpiRelu2N {
    static constexpr bool PERM = true, AFTER_DRAIN = false, MID = false;
    _Float16* U; const float* rowsq;
    __device__ __forceinline__ void operator()(const f32x4 (&acc)[2][2][4][2], const Unit& u, int wr, int wc, int fr, int fq) const {
        const int row0 = u.pm * BM + wr * 64 + fr, col0 = u.pn * BM + wc * 32 + 8 * fq;
#pragma unroll
        for (int ai = 0; ai < 2; ++ai)
#pragma unroll
            for (int m = 0; m < 4; ++m) { const int r = row0 + ai * HALF + m * 16; _Float16* rowp = U + (size_t)r * 4096 + col0;
                const float inv = 1.f / (rowsq[r] * (1.f / 1024.f) + 1e-6f);
#pragma unroll
                for (int bj = 0; bj < 2; ++bj) { f32x4 v0 = acc[ai][bj][m][0], v1 = acc[ai][bj][m][1];
#pragma unroll
                    for (int i = 0; i < 4; ++i) { const float a = fmaxf(v0[i], 0.f), b = fmaxf(v1[i], 0.f); v0[i] = a * a * inv; v1[i] = b * b * inv; }
                    u32x4 w; w.x = pkh(v0[0], v0[1]); w.y = pkh(v0[2], v0[3]); w.z = pkh(v1[0], v1[1]); w.w = pkh(v1[2], v1[3]);
                    *(u32x4*)(rowp + bj * HALF) = w; } }
    }
};
template <class Epi, class Sched, bool ALIGN_EPI = false, bool SP2 = false>
__device__ __forceinline__ void gemm_phase(PG8_LAS unsigned char* lds, const Gemm g, const Sched& S, const Epi& E) {
    int tid_ = threadIdx.x; asm volatile("" : "+v"(tid_));
    const int tid = tid_, wid = __builtin_amdgcn_readfirstlane(tid >> 6), lane = tid & 63, wr = wid >> 2, wc = wid & 3, fr = lane & 15, fq = lane >> 4;
    const int K = g.K, nt = K / BK;
    unsigned voffA[2], voffB[2];
#pragma unroll
    for (int i = 0; i < 2; ++i) { int R, C; stage_rc(tid * 16 + i * 8192, R, C); const int Rb = Epi::PERM ? ((R & ~31) + perm32(R & 31)) : R;
        voffA[i] = (unsigned)(R * K + C) * 2u; voffB[i] = (unsigned)(Rb * K + C) * 2u; }
    const size_t kstep = (size_t)(BK * 2);
    const size_t hstep = (size_t)HALF * K * 2;
    const size_t tstep = 2 * hstep;
    const unsigned ldsw = (unsigned)wid * 1024u;
    const int aoff = lds_byte(wr * 64 + fr, fq * 8), boff = lds_byte(wc * 32 + fr, fq * 8);
#define PG8_SA(b, h) (((b) * 2 + (h)) * HTB)
#define PG8_SB(b, h) ((4 + (b) * 2 + (h)) * HTB)
#define PG8_STAGE(bufoff, gbase, voff) do { _Pragma("unroll") for (int _i = 0; _i < 2; ++_i) \
        __builtin_amdgcn_global_load_lds((const unsigned*)((const char*)(gbase) + (voff)[_i]), (PG8_LAS unsigned*)(lds + (bufoff) + ldsw + _i * 8192), 16, 0, 0); } while (0)
#define PG8_LDA(dst, b, h) do { _Pragma("unroll") for (int m = 0; m < 4; ++m) _Pragma("unroll") for (int k = 0; k < 2; ++k) dst[m][k] = *(const PG8_LAS bf16x8*)(lds + PG8_SA(b, h) + aoff + m * 2048 + k * 1024); } while (0)
#define PG8_LDB(dst, b, h) do { _Pragma("unroll") for (int n = 0; n < 2; ++n) _Pragma("unroll") for (int k = 0; k < 2; ++k) dst[n][k] = *(const PG8_LAS bf16x8*)(lds + PG8_SB(b, h) + boff + n * 2048 + k * 1024); } while (0)
#define PG8_MMA(ai, bj, At, Bt) do { __builtin_amdgcn_s_setprio(1); _Pragma("unroll") for (int m = 0; m < 4; ++m) _Pragma("unroll") for (int n = 0; n < 2; ++n) _Pragma("unroll") for (int k = 0; k < 2; ++k) \
        acc[ai][bj][m][n] = __builtin_amdgcn_mfma_f32_16x16x32_f16(Bt[n][k], At[m][k], acc[ai][bj][m][n], 0, 0, 0); __builtin_amdgcn_s_setprio(0); } while (0)
#define PG8_WAIT_V(n) asm volatile("s_waitcnt vmcnt(" #n ")" ::: "memory")
#define PG8_WAIT_L(n) asm volatile("s_waitcnt lgkmcnt(" #n ")" ::: "memory")
#define PG8_BAR __builtin_amdgcn_s_barrier()
#define PG8_SCHED __builtin_amdgcn_sched_barrier(0)
    Unit cur, nxt; int ui = 0;
    if (!S.next(0, cur)) return;
    f32x4 acc[2][2][4][2];
#pragma unroll
    for (int a = 0; a < 2; ++a)
#pragma unroll
        for (int b = 0; b < 2; ++b)
#pragma unroll
            for (int m = 0; m < 4; ++m)
#pragma unroll
                for (int n = 0; n < 2; ++n) acc[a][b][m][n] = (f32x4){0.f, 0.f, 0.f, 0.f};
    bf16x8 At[4][2], B0[2][2], B1[2][2];
    const char* cA = (const char*)g.A + (size_t)cur.pm * tstep; const char* cB = (const char*)g.Bt + (size_t)cur.pn * tstep;
    S.a_ready(cur);
    if constexpr (SP2) {
        PG8_STAGE(PG8_SB(0, 0), cB, voffB); PG8_STAGE(PG8_SB(0, 1), cB + hstep, voffB); PG8_STAGE(PG8_SA(0, 0), cA, voffA); PG8_STAGE(PG8_SA(0, 1), cA + hstep, voffA);
        if (wr == 1) PG8_BAR;
        PG8_WAIT_V(2); PG8_BAR;
        PG8_STAGE(PG8_SB(1, 0), cB + kstep, voffB); PG8_STAGE(PG8_SA(1, 0), cA + kstep, voffA); PG8_STAGE(PG8_SB(1, 1), cB + hstep + kstep, voffB);
        PG8_WAIT_V(6); PG8_BAR;
    } else {
        PG8_STAGE(PG8_SB(0, 0), cB, voffB); PG8_STAGE(PG8_SA(0, 0), cA, voffA); PG8_STAGE(PG8_SB(0, 1), cB + hstep, voffB); PG8_STAGE(PG8_SA(0, 1), cA + hstep, voffA);
        if (wr == 1) PG8_BAR;
        PG8_WAIT_V(4); PG8_BAR;
        PG8_STAGE(PG8_SB(1, 0), cB + kstep, voffB); PG8_STAGE(PG8_SA(1, 0), cA + kstep, voffA); PG8_STAGE(PG8_SB(1, 1), cB + hstep + kstep, voffB);
        PG8_WAIT_V(6); PG8_BAR;
    }
    for (;;) {
        const bool has_next = S.next(ui + 1, nxt);
        const char* nA = has_next ? (const char*)g.A + (size_t)nxt.pm * tstep : cA; const char* nB = has_next ? (const char*)g.Bt + (size_t)nxt.pn * tstep : cB;
        for (int t = 0; t < nt; t += 2) {
            if constexpr (Epi::MID) { if (t == nt / 2) E.mid(acc, cur, wr, wc, fr, fq); }
            const bool last = (t == nt - 2);
            const char* a1 = cA + (size_t)(t + 1) * kstep;
            const char* a2 = last ? nA : cA + (size_t)(t + 2) * kstep; const char* b2 = last ? nB : cB + (size_t)(t + 2) * kstep;
            const char* a3 = a2 + kstep; const char* b3 = b2 + kstep;
            if (last && has_next) S.a_ready(nxt);
            if constexpr (SP2) {
            PG8_LDB(B0, 0, 0); PG8_LDB(B1, 0, 1); PG8_SCHED; PG8_LDA(At, 0, 0); PG8_STAGE(PG8_SA(1, 1), a1 + hstep, voffA);
            PG8_WAIT_V(8); PG8_WAIT_L(0); PG8_BAR; PG8_MMA(0, 0, At, B0); PG8_MMA(0, 1, At, B1); PG8_BAR; PG8_SCHED;
            PG8_LDA(At, 0, 1); PG8_STAGE(PG8_SB(0, 0), b2, voffB); PG8_STAGE(PG8_SB(0, 1), b2 + hstep, voffB); PG8_STAGE(PG8_SA(0, 0), a2, voffA);
            PG8_WAIT_V(8); PG8_WAIT_L(0); PG8_BAR; PG8_MMA(1, 0, At, B0); PG8_MMA(1, 1, At, B1); PG8_BAR; PG8_SCHED;
            PG8_LDB(B0, 1, 0); PG8_LDB(B1, 1, 1); PG8_SCHED; PG8_LDA(At, 1, 0); PG8_STAGE(PG8_SA(0, 1), a2 + hstep, voffA);
            PG8_WAIT_V(8); PG8_WAIT_L(0); PG8_BAR; PG8_MMA(0, 0, At, B0); PG8_MMA(0, 1, At, B1); PG8_BAR; PG8_SCHED;
            PG8_LDA(At, 1, 1); PG8_STAGE(PG8_SB(1, 0), b3, voffB); PG8_STAGE(PG8_SB(1, 1), b3 + hstep, voffB); PG8_STAGE(PG8_SA(1, 0), a3, voffA);
            PG8_WAIT_V(8); PG8_WAIT_L(0); PG8_BAR; PG8_MMA(1, 0, At, B0); PG8_MMA(1, 1, At, B1); PG8_BAR; PG8_SCHED;
            } else {
            PG8_LDB(B0, 0, 0); PG8_SCHED; PG8_LDA(At, 0, 0); PG8_STAGE(PG8_SA(1, 1), a1 + hstep, voffA);
            PG8_WAIT_L(8); PG8_BAR; PG8_WAIT_L(0); PG8_MMA(0, 0, At, B0); PG8_BAR; PG8_SCHED;
            PG8_LDB(B1, 0, 1); PG8_STAGE(PG8_SB(0, 0), b2, voffB);
            PG8_BAR; PG8_WAIT_L(0); PG8_MMA(0, 1, At, B1); PG8_BAR;
            PG8_LDA(At, 0, 1); PG8_STAGE(PG8_SA(0, 0), a2, voffA);
            PG8_BAR; PG8_WAIT_L(0); PG8_MMA(1, 0, At, B0); PG8_BAR; PG8_SCHED;
            PG8_STAGE(PG8_SB(0, 1), b2 + hstep, voffB);
            PG8_WAIT_V(6); PG8_BAR; PG8_MMA(1, 1, At, B1); PG8_BAR;
            PG8_LDB(B0, 1, 0); PG8_SCHED; PG8_LDA(At, 1, 0); PG8_STAGE(PG8_SA(0, 1), a2 + hstep, voffA);
            PG8_WAIT_L(8); PG8_BAR; PG8_WAIT_L(0); PG8_MMA(0, 0, At, B0); PG8_BAR; PG8_SCHED;
            PG8_LDB(B1, 1, 1); PG8_STAGE(PG8_SB(1, 0), b3, voffB);
            PG8_BAR; PG8_WAIT_L(0); PG8_MMA(0, 1, At, B1); PG8_BAR;
            PG8_LDA(At, 1, 1); PG8_STAGE(PG8_SA(1, 0), a3, voffA);
            PG8_BAR; PG8_WAIT_L(0); PG8_MMA(1, 0, At, B0); PG8_BAR; PG8_SCHED;
            PG8_STAGE(PG8_SB(1, 1), b3 + hstep, voffB);
            PG8_WAIT_V(6); PG8_BAR; PG8_MMA(1, 1, At, B1); PG8_BAR;
            }
        }
        if constexpr (ALIGN_EPI) { if (wr == 0) PG8_BAR; }
        if constexpr (!Epi::AFTER_DRAIN) { E(acc, cur, wr, wc, fr, fq); S.done(cur); }
        if (!has_next) break;
#pragma unroll
        for (int a = 0; a < 2; ++a)
#pragma unroll
            for (int b = 0; b < 2; ++b)
#pragma unroll
                for (int m = 0; m < 4; ++m)
#pragma unroll
                    for (int n = 0; n < 2; ++n) acc[a][b][m][n] = (f32x4){0.f, 0.f, 0.f, 0.f};
        cur = nxt; cA = nA; cB = nB; ++ui;
        if constexpr (ALIGN_EPI) { if (wr == 1) PG8_BAR; }
    }
    PG8_WAIT_V(0);
    if constexpr (!ALIGN_EPI) { if (wr == 0) PG8_BAR; }
    PG8_BAR;
    if constexpr (Epi::AFTER_DRAIN) { E.fused(acc, cur, wr, wc, fr, fq, lds, wid, lane); S.done(cur); }
#undef PG8_SA
#undef PG8_SB
#undef PG8_STAGE
#undef PG8_LDA
#undef PG8_LDB
#undef PG8_MMA
#undef PG8_WAIT_V
#undef PG8_WAIT_L
#undef PG8_BAR
#undef PG8_SCHED
}
}


namespace {
constexpr int B_ = 8, S_ = 4096, M_ = B_ * S_, D_ = 1024, DIN = 4288, DFF = 4096;
constexpr int C_QA = 0, C_QB = 512, C_QI = 1024, C_KVB = 1280, C_KA = 2048, C_VA = 2112, C_KI = 2176, C_WI = 2208, C_GB = 2216, C_GATE = 2304;
constexpr int NC = 255;
constexpr float EPS = 1e-6f;
using pg8::PW;
#define GAS __attribute__((address_space(1)))
#define LAS __attribute__((address_space(3)))
typedef unsigned v4u __attribute__((ext_vector_type(4)));
typedef float f32x4 __attribute__((ext_vector_type(4)));

__device__ __forceinline__ int t5_bucket(int n) {
    if (n < 16) return n < 0 ? 0 : n;
    float nf = (float)n;
    int large = 16 + (int)(logf(nf / 16.f) / logf(8.f) * 16.f);
    return large < 31 ? large : 31;
}


__device__ __forceinline__ int win_src_col(int n) {
    if (n < 512) return n;
    if (n < 1024) return 936 + (n - 512);
    if (n < 1280) return 640 + (n - 1024);
    if (n < 2048) return 1448 + (n - 1280);
    if (n < 2112) return 512 + (n - 2048);
    if (n < 2176) return 576 + (n - 2112);
    if (n < 2208) return 896 + (n - 2176);
    if (n < 2216) return 928 + (n - 2208);
    if (n < 2240) return n;
    if (n < 2304) return -1;
    return 2240 + (n - 2304);
}
__device__ __forceinline__ float wave_sum(float v) {
#pragma unroll
    for (int o = 1; o < 64; o <<= 1) v += __shfl_xor(v, o);
    return v;
}
template <bool MAP>
__device__ __forceinline__ void transpose_item(const float* __restrict__ W, int K, int Nsrc, int Ndst, _Float16* __restrict__ WT, const float* __restrict__ gain, float* scr, int item, int lane, int dpitch = 0, int koff = 0) {
    const int nblk = Ndst / 32, kb = item / nblk, nb = item % nblk, k0 = 64 * kb, n0 = 32 * nb;
    const int nd = n0 + (lane & 31); const int ns = MAP ? win_src_col(nd) : nd;
#pragma unroll 8
    for (int i = 0; i < 32; ++i) { const int kk = 2 * i + (lane >> 5); float v = 0.f;
        if (ns >= 0) { v = W[(size_t)(k0 + kk) * Nsrc + ns]; if (gain) v *= gain[k0 + kk]; }
        scr[kk * 33 + (lane & 31)] = v; }
    __builtin_amdgcn_s_waitcnt(0xc07f); asm volatile("" ::: "memory");
    const int c = lane & 7;
#pragma unroll
    for (int j = 0; j < 4; ++j) { const int n = (lane >> 3) + 8 * j; const float* s = scr + (8 * c) * 33 + n;
        v4u o; o.x = pg8::pkh(s[0 * 33], s[1 * 33]); o.y = pg8::pkh(s[2 * 33], s[3 * 33]); o.z = pg8::pkh(s[4 * 33], s[5 * 33]); o.w = pg8::pkh(s[6 * 33], s[7 * 33]);
        *(v4u*)(WT + (size_t)(n0 + n) * (dpitch ? dpitch : K) + koff + k0 + 8 * c) = o; }
    __builtin_amdgcn_s_waitcnt(0xc07f); asm volatile("" ::: "memory");
}
__device__ __forceinline__ void rms_row_to_f16(const float* __restrict__ xrow, _Float16* __restrict__ orow, int lane) {
    const f32x4* xr = (const f32x4*)xrow + lane;
    f32x4 v[4]; float s = 0.f;
#pragma unroll
    for (int j = 0; j < 4; ++j) { v[j] = xr[64 * j]; s += (v[j].x * v[j].x + v[j].y * v[j].y) + (v[j].z * v[j].z + v[j].w * v[j].w); }
    const float rstd = rsqrtf(wave_sum(s) * (1.f / D_) + EPS);
    unsigned long long* o8 = (unsigned long long*)orow + lane;
#pragma unroll
    for (int j = 0; j < 4; ++j) o8[64 * j] = (unsigned long long)pg8::pkh(v[j].x * rstd, v[j].y * rstd) | ((unsigned long long)pg8::pkh(v[j].z * rstd, v[j].w * rstd) << 32);
}

struct Args {
    const float* x; const float* norm_mix; const float* w_in; const float* pe_k; const float* w1_k; const float* w2_k; const float* pe_v; const float* w1_v; const float* w2_v;
    const float* rel_bias; const float* w_ba; const float* w_bb; const float* w_out; const float* norm_mlp; const float* w_mi; const float* w_mo; const float* norm_final;
    float* out; unsigned char* ws;
};
constexpr size_t MiB = 1u << 20;
constexpr size_t WS_PCNT = 32768, WS_XBUF = 524288;
constexpr size_t WS_ROWSQ = 65536, WS_ROWSQ2 = 196608;
constexpr size_t WS_CTL = 0, WS_WIN = 1 * MiB, WS_WBA = 10 * MiB, WS_WBB = 11 * MiB, WS_WOUT = 12 * MiB, WS_WMI = 14 * MiB, WS_WMO = 22 * MiB, WS_CW = 30 * MiB,
                 WS_KCMP = 32 * MiB, WS_VCMP = 33 * MiB, WS_H = 34 * MiB, WS_PROJ = 98 * MiB, WS_MIX = 370 * MiB, WS_END = 434 * MiB;

__device__ __forceinline__ void prologue_body(const Args& a, unsigned char* lds) {
    const int tid = threadIdx.x, lane = tid & 63, wave = tid >> 6;
    float* scr = (float*)(lds + wave * 8704);
    const int gw = blockIdx.x * 8 + wave, NGW = gridDim.x * 8;
    constexpr int I_IN = (D_ / 64) * (PW / 32), I_BA = (512 / 64) * (D_ / 32), I_OUT = (D_ / 64) * (D_ / 32), I_MI = (D_ / 64) * (DFF / 32), I_MO = (DFF / 64) * (D_ / 32);
    constexpr int I_C1 = (2048 / 64) * (128 / 32), I_C2 = (128 / 64) * (64 / 32);
    constexpr int NITEMS = I_IN + 2 * I_BA + I_OUT + I_MI + I_MO + 2 * I_C1 + 2 * I_C2;
    for (int it = gw; it < NITEMS; it += NGW) {
        int r = it;
        if (r < I_IN) { transpose_item<true>(a.w_in, D_, DIN, PW, (_Float16*)(a.ws + WS_WIN), a.norm_mix, scr, r, lane); continue; } r -= I_IN;
        if (r < I_BA) { transpose_item<false>(a.w_ba, 512, D_, D_, (_Float16*)(a.ws + WS_WBA), nullptr, scr, r, lane, 1024, 0); continue; } r -= I_BA;
        if (r < I_BA) { transpose_item<false>(a.w_bb, 512, D_, D_, (_Float16*)(a.ws + WS_WBA), nullptr, scr, r, lane, 1024, 512); continue; } r -= I_BA;
        if (r < I_OUT) { transpose_item<false>(a.w_out, D_, D_, D_, (_Float16*)(a.ws + WS_WOUT), nullptr, scr, r, lane); continue; } r -= I_OUT;
        if (r < I_MI) { transpose_item<false>(a.w_mi, D_, DFF, DFF, (_Float16*)(a.ws + WS_WMI), a.norm_mlp, scr, r, lane); continue; } r -= I_MI;
        if (r < I_MO) { transpose_item<false>(a.w_mo, DFF, D_, D_, (_Float16*)(a.ws + WS_WMO), nullptr, scr, r, lane); continue; } r -= I_MO;
        if (r < I_C1) { transpose_item<false>(a.w1_k, 2048, 128, 128, (_Float16*)(a.ws + WS_CW), nullptr, scr, r, lane); continue; } r -= I_C1;
        if (r < I_C1) { transpose_item<false>(a.w1_v, 2048, 128, 128, (_Float16*)(a.ws + WS_CW + 512 * 1024), nullptr, scr, r, lane); continue; } r -= I_C1;
        if (r < I_C2) { transpose_item<false>(a.w2_k, 128, 64, 64, (_Float16*)(a.ws + WS_CW + 1024 * 1024), nullptr, scr, r, lane); continue; } r -= I_C2;
        transpose_item<false>(a.w2_v, 128, 64, 64, (_Float16*)(a.ws + WS_CW + 1024 * 1024 + 16384), nullptr, scr, r, lane);
    }
#pragma unroll 4
    for (int m = gw; m < M_; m += NGW) rms_row_to_f16(a.x + (size_t)m * D_, (_Float16*)(a.ws + WS_H) + (size_t)m * D_, lane);
}
struct EpiAccOut {
    static constexpr bool PERM = true, AFTER_DRAIN = false, MID = false;
    _Float16* x2h; const _Float16* xh; float* rowsq;
    __device__ __forceinline__ void operator()(const f32x4 (&acc)[2][2][4][2], const pg8::Unit& u, int wr, int wc, int fr, int fq) const {
        const int row0 = u.pm * 256 + wr * 64 + fr, col0 = u.pn * 256 + wc * 32 + 8 * fq;
#pragma unroll
        for (int ai = 0; ai < 2; ++ai)
#pragma unroll
            for (int m = 0; m < 4; ++m) { const size_t r = (size_t)(row0 + ai * 128 + m * 16); float sq = 0.f;
#pragma unroll
                for (int bj = 0; bj < 2; ++bj) { const size_t o = r * 1024 + col0 + bj * 128;
                    float p[8]; pg8::unpk8(*(const pg8::u32x4*)(xh + o), p);
                    const f32x4 a0 = acc[ai][bj][m][0], a1 = acc[ai][bj][m][1];
                    const float v[8] = {p[0] + a0[0], p[1] + a0[1], p[2] + a0[2], p[3] + a0[3], p[4] + a1[0], p[5] + a1[1], p[6] + a1[2], p[7] + a1[3]};
                    pg8::u32x4 w; w.x = pg8::pkh(v[0], v[1]); w.y = pg8::pkh(v[2], v[3]); w.z = pg8::pkh(v[4], v[5]); w.w = pg8::pkh(v[6], v[7]);
                    *(pg8::u32x4*)(x2h + o) = w;
                    sq += (v[0] * v[0] + v[1] * v[1]) + (v[2] * v[2] + v[3] * v[3]) + (v[4] * v[4] + v[5] * v[5]) + (v[6] * v[6] + v[7] * v[7]); }
                sq += __shfl_xor(sq, 16); sq += __shfl_xor(sq, 32);
                if (fq == 0) atomicAdd(rowsq + r, sq); }
    }
};
__device__ __forceinline__ void final_scale_row(const _Float16* __restrict__ xrow, float* __restrict__ orow, const float* __restrict__ g, float rsq, int lane) {
    const float rstd = rsqrtf(rsq * (1.f / D_) + EPS);
#pragma unroll
    for (int j = 0; j < 2; ++j) {
        float p[8]; pg8::unpk8(*((const pg8::u32x4*)xrow + lane + 64 * j), p);
        const f32x4 g0 = *((const f32x4*)g + 2 * (lane + 64 * j)), g1 = *((const f32x4*)g + 2 * (lane + 64 * j) + 1);
        *((f32x4*)orow + 2 * (lane + 64 * j)) = (f32x4){p[0] * rstd * g0.x, p[1] * rstd * g0.y, p[2] * rstd * g0.z, p[3] * rstd * g0.w};
        *((f32x4*)orow + 2 * (lane + 64 * j) + 1) = (f32x4){p[4] * rstd * g1.x, p[5] * rstd * g1.y, p[6] * rstd * g1.z, p[7] * rstd * g1.w};
    }
}

struct SliceOrder {
    pg8::StaticOrder S; int slice;
    __device__ bool next(int i, pg8::Unit& u) const { return i == 0 ? S.next(slice, u) : false; }
    __device__ __forceinline__ void a_ready(const pg8::Unit&) const {}
    __device__ __forceinline__ void done(const pg8::Unit&) const {}
};
struct EpiFinalNorm {
    static constexpr bool PERM = true, AFTER_DRAIN = true, MID = false;
    float* out; const _Float16* xh; const float* g; float* xbuf; unsigned* cnt;
    __device__ __forceinline__ void fused(f32x4 (&acc)[2][2][4][2], const pg8::Unit& u, int wr, int wc, int fr, int fq, PG8_LAS unsigned char* lds, int wid, int lane) const {
        const int rl0 = wr * 64 + fr, col0 = u.pn * 256 + wc * 32 + 8 * fq;
        PG8_LAS float* red = (PG8_LAS float*)lds;
#pragma unroll
        for (int ai = 0; ai < 2; ++ai)
#pragma unroll
            for (int m = 0; m < 4; ++m) { const int rl = rl0 + ai * 128 + m * 16; const size_t r = (size_t)(u.pm * 256 + rl); float sq = 0.f;
#pragma unroll
                for (int bj = 0; bj < 2; ++bj) { float p[8]; pg8::unpk8(*(const pg8::u32x4*)(xh + r * 1024 + col0 + bj * 128), p);
#pragma unroll
                    for (int i = 0; i < 4; ++i) { acc[ai][bj][m][0][i] += p[i]; acc[ai][bj][m][1][i] += p[4 + i];
                        sq = fmaf(acc[ai][bj][m][0][i], acc[ai][bj][m][0][i], sq); sq = fmaf(acc[ai][bj][m][1][i], acc[ai][bj][m][1][i], sq); } }
                sq += __shfl_xor(sq, 16); sq += __shfl_xor(sq, 32);
                if (fq == 0) red[wc * 256 + rl] = sq; }
        __syncthreads();
        const int tid = wid * 64 + lane;
        if (tid < 256) { const float tot = (red[tid] + red[256 + tid]) + (red[512 + tid] + red[768 + tid]);
            __hip_atomic_store(xbuf + ((size_t)u.pm * 4 + u.pn) * 256 + tid, tot, __ATOMIC_RELAXED, __HIP_MEMORY_SCOPE_AGENT); }
        asm volatile("s_waitcnt vmcnt(0)" ::: "memory");
        __syncthreads();
        if (tid == 0) { __hip_atomic_fetch_add(cnt + u.pm, 1u, __ATOMIC_RELAXED, __HIP_MEMORY_SCOPE_AGENT);
            unsigned sp = 0; while (__hip_atomic_load(cnt + u.pm, __ATOMIC_RELAXED, __HIP_MEMORY_SCOPE_AGENT) < 4u && ++sp < (1u << 22)) __builtin_amdgcn_s_sleep(1); }
        __syncthreads();
        if (tid < 256) { float tot = 0.f;
#pragma unroll
            for (int q = 0; q < 4; ++q) tot += __hip_atomic_load(xbuf + ((size_t)u.pm * 4 + q) * 256 + tid, __ATOMIC_RELAXED, __HIP_MEMORY_SCOPE_AGENT);
            red[1024 + tid] = rsqrtf(tot * (1.f / 1024.f) + 1e-6f); }
        __syncthreads();
#pragma unroll
        for (int ai = 0; ai < 2; ++ai)
#pragma unroll
            for (int m = 0; m < 4; ++m) { const int rl = rl0 + ai * 128 + m * 16; const size_t r = (size_t)(u.pm * 256 + rl); const float rstd = red[1024 + rl];
#pragma unroll
                for (int bj = 0; bj < 2; ++bj) { const int c = col0 + bj * 128; const f32x4 g0 = *(const f32x4*)(g + c), g1 = *(const f32x4*)(g + c + 4);
                    *(f32x4*)(out + r * 1024 + c) = acc[ai][bj][m][0] * rstd * g0; *(f32x4*)(out + r * 1024 + c + 4) = acc[ai][bj][m][1] * rstd * g1; } }
        __syncthreads();
    }
};

namespace dsa {
typedef _Float16 f16x8 __attribute__((ext_vector_type(8)));
typedef _Float16 f16x4 __attribute__((ext_vector_type(4)));
typedef short s16x4 __attribute__((ext_vector_type(4)));
typedef float f32x4 __attribute__((ext_vector_type(4)));
typedef unsigned u32x4 __attribute__((ext_vector_type(4)));
typedef unsigned u32x2 __attribute__((ext_vector_type(2)));
constexpr int TQ = 16, NBIN = 2048, CANDCAP = 512, VPITCH = 144;
constexpr int L_HIST = 0, L_SEL = 65536, L_SELD = L_SEL + 8192, L_CTL = L_SELD + 8192, L_BIAS = L_CTL + 512, L_VST = L_BIAS + 4096, L_END = L_VST + 8 * 32 * VPITCH;
static_assert(L_END <= 131072, "dsa LDS");

__device__ __forceinline__ float idx_score(const f32x4 a1, const f32x4 a2, float lin, const float (&wh)[8]) {
    float s = fmaf(wh[0], fabsf(a1.x), lin);
    s = fmaf(wh[1], fabsf(a1.y), s); s = fmaf(wh[2], fabsf(a1.z), s); s = fmaf(wh[3], fabsf(a1.w), s);
    s = fmaf(wh[4], fabsf(a2.x), s); s = fmaf(wh[5], fabsf(a2.y), s); s = fmaf(wh[6], fabsf(a2.z), s); s = fmaf(wh[7], fabsf(a2.w), s);
    return s;
}
__device__ __forceinline__ int score_bin(float sc, float inv) { int b = (int)(fmaf(sc, inv, 1024.f)); b = b < 0 ? 0 : b; return b > NBIN - 1 ? NBIN - 1 : b; }

template <int PASS>
__device__ __forceinline__ void score_pass(LAS unsigned char* lds, const _Float16* __restrict__ proj, int b, int t0, int nkb, int wave, int lane,
                                           const f16x8 (&afr)[4][2], const f16x8 alin, const float (&wq)[4][8], const float (&binv)[4]) {
    LAS unsigned* hist = (LAS unsigned*)(lds + L_HIST);
    LAS unsigned short* sel = (LAS unsigned short*)(lds + L_SEL);
    LAS unsigned short* seld = (LAS unsigned short*)(lds + L_SELD);
    LAS u32x2* cand = (LAS u32x2*)(lds + L_HIST);
    LAS int* ctl = (LAS int*)(lds + L_CTL);
    const int kc = lane >> 4, n16 = lane & 15;
    int bst[4];
#pragma unroll
    for (int grp = 0; grp < 4; ++grp) bst[grp] = (PASS == 2) ? ctl[(4 * grp + kc) * 8 + 2] : 0;
    const f32x4 zero = {0.f, 0.f, 0.f, 0.f};
    const _Float16* kbase = proj + (size_t)(b * S_ + n16) * PW + C_KI + 8 * kc;
    f16x8 bnext = *(const f16x8*)(kbase + (size_t)(16 * (wave < nkb ? wave : 0)) * PW);
    for (int kb = wave; kb < nkb; kb += 8) {
        const f16x8 bfr = bnext;
        { const int kn = kb + 8 < nkb ? kb + 8 : kb; bnext = *(const f16x8*)(kbase + (size_t)(16 * kn) * PW); }
        const int s = 16 * kb + n16;
        const bool lastkb = kb == nkb - 1;
        const f32x4 a3 = __builtin_amdgcn_mfma_f32_16x16x32_f16(alin, bfr, zero, 0, 0, 0);
        const float lin4[4] = {a3.x, a3.y, a3.z, a3.w};
#pragma unroll
        for (int grp = 0; grp < 4; ++grp) {
            const f32x4 a1 = __builtin_amdgcn_mfma_f32_16x16x32_f16(afr[grp][0], bfr, zero, 0, 0, 0);
            const f32x4 a2 = __builtin_amdgcn_mfma_f32_16x16x32_f16(afr[grp][1], bfr, zero, 0, 0, 0);
            const float sc = idx_score(a1, a2, lin4[grp], wq[grp]);
            const int row = 4 * grp + kc, t = t0 + row;
            if (!lastkb || s <= t) {
                const int bin = score_bin(sc, binv[grp]);
                if (PASS == 1) { __hip_atomic_fetch_add(hist + row * 1024 + (bin >> 1), (bin & 1) ? 0x10000u : 1u, __ATOMIC_RELAXED, __HIP_MEMORY_SCOPE_WORKGROUP); }
                else {
                    if (bin > bst[grp]) { const int pos = __hip_atomic_fetch_add(ctl + row * 8 + 0, 1, __ATOMIC_RELAXED, __HIP_MEMORY_SCOPE_WORKGROUP); sel[row * 256 + (pos & 255)] = (unsigned short)s;
                        const int dd = t - s; seld[row * 256 + (pos & 255)] = (unsigned short)((dd > 127 ? 127 : dd) * 32); }
                    else if (bin == bst[grp]) { const int pos = __hip_atomic_fetch_add(ctl + row * 8 + 1, 1, __ATOMIC_RELAXED, __HIP_MEMORY_SCOPE_WORKGROUP);
                        if (pos < CANDCAP) { u32x2 e; e.x = __float_as_uint(sc); e.y = (unsigned)s; cand[row * CANDCAP + pos] = e; } }
                }
            }
        }
    }
}

__device__ __forceinline__ void dsa_tile(LAS unsigned char* lds, const _Float16* __restrict__ proj, _Float16* __restrict__ o_a, int b, int qt) {
    int tid_ = threadIdx.x; asm volatile("" : "+v"(tid_));
    const int tid = tid_, lane = tid & 63, wave = __builtin_amdgcn_readfirstlane(tid >> 6);
    const int kc = lane >> 4, n16 = lane & 15;
    const int t0 = qt * TQ, nkb = qt + 1;
    LAS unsigned* hist = (LAS unsigned*)(lds + L_HIST);
    LAS unsigned short* sel = (LAS unsigned short*)(lds + L_SEL);
    LAS u32x2* cand = (LAS u32x2*)(lds + L_HIST);
    LAS int* ctl = (LAS int*)(lds + L_CTL);
    LAS float* biaslut = (LAS float*)(lds + L_BIAS);
    for (int i = tid; i < (TQ * 1024 + 4096) / 4; i += 512) ((LAS u32x4*)hist)[i] = (u32x4){0u, 0u, 0u, 0u};
    if (tid < TQ * 8) ctl[tid] = 0;
    f16x8 afr[4][2]; f16x8 alin; float wq[4][8]; float binv[4];
    { const int g = n16 >> 2, r = n16 & 3;
      { const int qq = 4 * r + g; const _Float16* qrow = proj + (size_t)(b * S_ + t0 + qq) * PW;
        const f16x8 wg = *(const f16x8*)(qrow + C_WI);
        float lin[8];
#pragma unroll
        for (int e = 0; e < 8; ++e) lin[e] = 0.f;
#pragma unroll
        for (int h = 0; h < 8; ++h) { const f16x8 qh = *(const f16x8*)(qrow + C_QI + h * 32 + 8 * kc); const float wh = (float)wg[h] * (0.5f / 16.f);
#pragma unroll
            for (int e = 0; e < 8; ++e) lin[e] = fmaf(wh, (float)qh[e], lin[e]); }
#pragma unroll
        for (int e = 0; e < 8; ++e) alin[e] = (_Float16)lin[e]; }
#pragma unroll
      for (int grp = 0; grp < 4; ++grp) {
          const _Float16* qrow = proj + (size_t)(b * S_ + t0 + 4 * grp + g) * PW + C_QI;
          afr[grp][0] = *(const f16x8*)(qrow + r * 32 + 8 * kc);
          afr[grp][1] = *(const f16x8*)(qrow + (4 + r) * 32 + 8 * kc);
          const f16x8 wv = *(const f16x8*)(proj + (size_t)(b * S_ + t0 + 4 * grp + kc) * PW + C_WI);
          float ss = 0.f;
#pragma unroll
          for (int h = 0; h < 8; ++h) { const float wfull = (float)wv[h] * (1.f / 16.f); wq[grp][h] = 0.5f * wfull; ss = fmaf(wfull, wfull, ss); }
          binv[grp] = 32.f * rsqrtf(ss + 1e-12f);
      } }
    __syncthreads();
    score_pass<1>(lds, proj, b, t0, nkb, wave, lane, afr, alin, wq, binv);
    __syncthreads();
#pragma unroll 1
    for (int i = 0; i < 2; ++i) {
        const int row = 2 * wave + i, n = t0 + row + 1;
        if (n <= 256) { if (lane == 0) { ctl[row * 8 + 2] = -1; ctl[row * 8 + 3] = 0; } }
        else {
            const LAS u32x4* hp = (const LAS u32x4*)(hist + row * 1024 + 16 * lane);
            unsigned tot = 0;
#pragma unroll
            for (int q4 = 0; q4 < 4; ++q4) { const u32x4 hv = hp[q4];
                tot += (hv.x & 0xffffu) + (hv.x >> 16) + (hv.y & 0xffffu) + (hv.y >> 16) + (hv.z & 0xffffu) + (hv.z >> 16) + (hv.w & 0xffffu) + (hv.w >> 16); }
            unsigned suf = tot;
#pragma unroll
            for (int o = 1; o < 64; o <<= 1) { const unsigned v = __shfl_down(suf, o); if (lane + o < 64) suf += v; }
            const unsigned above_lane = suf - tot;
            const unsigned long long cross = __ballot(above_lane < 256u && suf >= 256u);
            const int lx = __builtin_ctzll(cross);
            const unsigned abovex = __shfl(above_lane, lx);
            const unsigned c2 = lane < 32 ? (unsigned)((const LAS unsigned short*)hist)[row * 2048 + 32 * lx + lane] : 0u;
            unsigned suf2 = c2;
#pragma unroll
            for (int o = 1; o < 32; o <<= 1) { const unsigned v = __shfl_down(suf2, o); if (lane + o < 32) suf2 += v; }
            const unsigned above2 = abovex + suf2 - c2;
            if (lane < 32 && above2 < 256u && above2 + c2 >= 256u) {
                const int bs = 32 * lx + lane; const unsigned cum = above2;
                ctl[row * 8 + 2] = bs; ctl[row * 8 + 3] = 256 - (int)cum;
            }
        }
    }
    __syncthreads();
    score_pass<2>(lds, proj, b, t0, nkb, wave, lane, afr, alin, wq, binv);
    __syncthreads();
#pragma unroll 1
    for (int i = 0; i < 2; ++i) {
        const int row = 2 * wave + i, n = t0 + row + 1;
        const int need = ctl[row * 8 + 3], base = ctl[row * 8 + 0];
        int nc = ctl[row * 8 + 1];
        nc = nc < CANDCAP ? nc : CANDCAP;
        if (lane == 0) { const int nf = base + (need < nc ? need : nc); ctl[row * 8 + 4] = n <= 256 ? n : (nf < 256 ? nf : 256); }
        if (need > 0) {
            for (int c0 = 0; c0 < nc; c0 += 64) {
                const int ci = c0 + lane; const bool act = ci < nc;
                const u32x2 me = cand[row * CANDCAP + (act ? ci : 0)];
                const float msc = __uint_as_float(me.x); int rank = 0;
                for (int j = 0; j < nc; ++j) { const u32x2 ot = cand[row * CANDCAP + j]; const float osc = __uint_as_float(ot.x);
                    rank += (osc > msc || (osc == msc && ot.y < me.y)) ? 1 : 0; }
                if (act && rank < need) { sel[row * 256 + ((base + rank) & 255)] = (unsigned short)me.y; const int dd = t0 + row - (int)me.y; ((LAS unsigned short*)(lds + L_SELD))[row * 256 + ((base + rank) & 255)] = (unsigned short)((dd > 127 ? 127 : dd) * 32); }
            }
        }
    }
    __syncthreads();
    int tq_ = threadIdx.x; asm volatile("" : "+v"(tq_));
    const int lane_a = tq_ & 63;
    LAS unsigned char* vst = lds + L_VST + wave * (32 * VPITCH);
#pragma unroll 1
    for (int i = 0; i < 2; ++i) { const int lane = lane_a, kc = lane >> 4, n16 = lane & 15;
        const int row = 2 * wave + i, t = t0 + row; const int nvalid = ctl[row * 8 + 4];
        const _Float16* qrow = proj + (size_t)(b * S_ + t) * PW + C_QA;
        const int head = n16, hm = head & 7;
        f16x8 qb0, qb1;
        { const f16x8 z = {0, 0, 0, 0, 0, 0, 0, 0}; qb0 = z; qb1 = z;
          if (head < 8) { qb0 = *(const f16x8*)(qrow + head * 64 + 8 * kc); qb1 = *(const f16x8*)(qrow + head * 64 + 32 + 8 * kc); } }
        f32x4 ot[4];
#pragma unroll
        for (int dt = 0; dt < 4; ++dt) ot[dt] = (f32x4){0.f, 0.f, 0.f, 0.f};
        float mrun = -INFINITY, lrun = 0.f;
        const LAS unsigned short* selr = sel + row * 256;
        const LAS unsigned short* seldr = (const LAS unsigned short*)(lds + L_SELD) + row * 256;
        const LAS unsigned char* biasb = lds + L_BIAS + hm * 4;
        const _Float16* pbat = proj + (size_t)(b * S_) * PW;
        LAS unsigned char* kst = lds + L_HIST + wave * (32 * VPITCH);
        u32x4 gk[4], gv[4];
        const char* pbyte = (const char*)pbat;
#define DSA_GATHER(jj) do { _Pragma("unroll") for (int i_ = 0; i_ < 4; ++i_) { const int pos_ = 32 * (jj) + 8 * i_ + (lane >> 3); \
            const unsigned idx_ = pos_ < nvalid ? (unsigned)selr[pos_] : 0u; const char* rp_ = pbyte + (size_t)(idx_ * (unsigned)(PW * 2) + (unsigned)(C_KA * 2 + 16 * (lane & 7))); \
            gk[i_] = *(const u32x4*)rp_; gv[i_] = *(const u32x4*)(rp_ + 128); } } while (0)
        DSA_GATHER(0);
        const int nsteps = (nvalid + 31) >> 5;
#pragma unroll 1
        for (int j = 0; j < nsteps; ++j) {
#pragma unroll
            for (int i_ = 0; i_ < 4; ++i_) { const int ro = (8 * i_ + (lane >> 3)) * VPITCH + 16 * (lane & 7);
                *(LAS u32x4*)(kst + ro) = gk[i_]; *(LAS u32x4*)(vst + ro) = gv[i_]; }
            if (j + 1 < nsteps) DSA_GATHER(j + 1);
            asm volatile("s_waitcnt lgkmcnt(0)" ::: "memory");
            const f16x8 ca0 = *(const LAS f16x8*)(kst + n16 * VPITCH + 16 * kc), ca1 = *(const LAS f16x8*)(kst + n16 * VPITCH + 64 + 16 * kc);
            const f16x8 cb0 = *(const LAS f16x8*)(kst + (16 + n16) * VPITCH + 16 * kc), cb1 = *(const LAS f16x8*)(kst + (16 + n16) * VPITCH + 64 + 16 * kc);
            f32x4 sa = {0.f, 0.f, 0.f, 0.f}, sb = {0.f, 0.f, 0.f, 0.f};
            sa = __builtin_amdgcn_mfma_f32_16x16x32_f16(ca0, qb0, sa, 0, 0, 0); sa = __builtin_amdgcn_mfma_f32_16x16x32_f16(ca1, qb1, sa, 0, 0, 0);
            sb = __builtin_amdgcn_mfma_f32_16x16x32_f16(cb0, qb0, sb, 0, 0, 0); sb = __builtin_amdgcn_mfma_f32_16x16x32_f16(cb1, qb1, sb, 0, 0, 0);
            const int p0 = 32 * j + 4 * kc;
            const u32x2 iwa = *(const LAS u32x2*)(seldr + p0), iwb = *(const LAS u32x2*)(seldr + p0 + 16);
            const unsigned wa0 = iwa.x, wa1 = iwa.y, wb0 = iwb.x, wb1 = iwb.y;
            const unsigned bo[8] = {wa0 & 0xffffu, wa0 >> 16, wa1 & 0xffffu, wa1 >> 16, wb0 & 0xffffu, wb0 >> 16, wb1 & 0xffffu, wb1 >> 16};
            float v[8] = {sa.x, sa.y, sa.z, sa.w, sb.x, sb.y, sb.z, sb.w};
            float tm = -INFINITY;
#pragma unroll
            for (int e = 0; e < 8; ++e) {
                const bool ok = (p0 + (e & 3) + 16 * (e >> 2)) < nvalid;
                const float lg = v[e] * 0.125f + *(const LAS float*)(biasb + bo[e]);
                v[e] = ok ? lg : -INFINITY; tm = fmaxf(tm, v[e]);
            }
            tm = fmaxf(tm, __shfl_xor(tm, 16)); tm = fmaxf(tm, __shfl_xor(tm, 32));
            const float mn = fmaxf(mrun, tm);
            const float alpha = __expf(mrun - mn);
            float ps = 0.f;
#pragma unroll
            for (int e = 0; e < 8; ++e) { v[e] = __expf(v[e] - mn); ps += v[e]; }
            lrun = lrun * alpha + ps; mrun = mn;
#pragma unroll
            for (int dt = 0; dt < 4; ++dt) ot[dt] = ot[dt] * alpha;
            const f16x8 pfr = {(_Float16)v[0], (_Float16)v[1], (_Float16)v[2], (_Float16)v[3], (_Float16)v[4], (_Float16)v[5], (_Float16)v[6], (_Float16)v[7]};
            asm volatile("s_waitcnt lgkmcnt(0)" ::: "memory");
            const int q = n16 >> 2, p = n16 & 3;
#pragma unroll
            for (int dt = 0; dt < 4; ++dt) {
                const s16x4 ta = __builtin_amdgcn_ds_read_tr16_b64_v4i16((LAS s16x4*)(vst + (4 * kc + q) * VPITCH + (16 * dt + 4 * p) * 2));
                const s16x4 tb = __builtin_amdgcn_ds_read_tr16_b64_v4i16((LAS s16x4*)(vst + (16 + 4 * kc + q) * VPITCH + (16 * dt + 4 * p) * 2));
                const f16x4 fa = __builtin_bit_cast(f16x4, ta), fb = __builtin_bit_cast(f16x4, tb);
                const f16x8 vfr = {fa.x, fa.y, fa.z, fa.w, fb.x, fb.y, fb.z, fb.w};
                ot[dt] = __builtin_amdgcn_mfma_f32_16x16x32_f16(vfr, pfr, ot[dt], 0, 0, 0);
            }
            asm volatile("s_waitcnt lgkmcnt(0)" ::: "memory");
        }
#undef DSA_GATHER
        lrun += __shfl_xor(lrun, 16); lrun += __shfl_xor(lrun, 32);
        const float inv = 1.f / fmaxf(lrun, 1e-30f);
        if (head < 8) {
            _Float16* orow = o_a + (size_t)(b * S_ + t) * 1024 + head * 64 + 4 * kc;
#pragma unroll
            for (int dt = 0; dt < 4; ++dt) { u32x2 w; w.x = pg8::pkh(ot[dt].x * inv, ot[dt].y * inv); w.y = pg8::pkh(ot[dt].z * inv, ot[dt].w * inv); *(u32x2*)(orow + 16 * dt) = w; }
        }
    }
    __syncthreads();
}
}


namespace nsa {
typedef _Float16 f16x8 __attribute__((ext_vector_type(8)));
typedef _Float16 f16x4 __attribute__((ext_vector_type(4)));
typedef short s16x4 __attribute__((ext_vector_type(4)));
typedef float f32x4 __attribute__((ext_vector_type(4)));
typedef float f32x16 __attribute__((ext_vector_type(16)));
typedef unsigned u32x4 __attribute__((ext_vector_type(4)));
typedef unsigned u32x2 __attribute__((ext_vector_type(2)));
constexpr int KP = 144, VP = 192;
constexpr int TILE_B = 64 * KP + 64 * VP;
constexpr int L_T0 = 0, L_BIAS = 2 * TILE_B, L_IMPA = L_BIAS + 4096, L_IMPC = L_IMPA + 16384, L_MASK = L_IMPC + 16384, L_END = L_MASK + 512;
static_assert(L_END <= 131072, "nsa LDS");
constexpr float LOG2E = 1.4426950408889634f;
constexpr float SC = 0.125f * LOG2E;

struct Src { const _Float16* k; const _Float16* v; int pitch; };

struct Stage { u32x4 kr, vr; };
__device__ __forceinline__ void stage_load(Stage& st, const Src& s, int row0, int tid, bool need_v) {
    const int r = tid >> 3, c = tid & 7;
    st.kr = *(const u32x4*)(s.k + (size_t)(row0 + r) * s.pitch + 8 * c);
    if (need_v) st.vr = *(const u32x4*)(s.v + (size_t)(row0 + r) * s.pitch + 8 * c);
}
__device__ __forceinline__ void stage_store(const Stage& st, LAS unsigned char* tb, int tid, bool need_v) {
    const int r = tid >> 3, c = tid & 7;
    *(LAS u32x4*)(tb + r * KP + 16 * c) = st.kr;
    if (need_v) *(LAS u32x4*)(tb + 64 * KP + r * VP + 16 * c) = st.vr;
}

struct RowState { float m, l; f32x16 o0, o1; };

__device__ __forceinline__ void qk_half(const LAS unsigned char* kt, const f16x8 (&qf)[4], int rho, int hi, int kh, f32x16& s0) {
#pragma unroll
    for (int i = 0; i < 16; ++i) s0[i] = 0.f;
    const LAS unsigned char* kb = kt + (32 * kh + rho) * KP + 16 * hi;
#pragma unroll
    for (int ks = 0; ks < 4; ++ks) {
        const f16x8 a0 = *(const LAS f16x8*)(kb + 32 * ks);
        s0 = __builtin_amdgcn_mfma_f32_32x32x16_f16(a0, qf[ks], s0, 0, 0, 0);
    }
}
__device__ __forceinline__ void logits(f32x16& s0, const LAS float* lut, int hb, int hi, int dbase, int dstep, int dlim, bool bit) {
#pragma unroll
    for (int rg = 0; rg < 16; ++rg) {
        const int kl = (rg & 3) + 8 * (rg >> 2) + 4 * hi;
        const int d = dbase - dstep * kl;
        int dc = d < 0 ? 0 : d; dc = dc > 127 ? 127 : dc;
        const float bias = lut[dc * 8 + hb];
        const bool ok = bit && d >= 0 && d < dlim;
        s0[rg] = ok ? fmaf(s0[rg], SC, bias) : -INFINITY;
    }
}
__device__ __forceinline__ void pv_half(RowState& rs, const f32x16& s0, const LAS unsigned char* vt, int rho, int hi, int kh) {
    const int l16 = rho & 15, g16 = rho >> 4, q = l16 >> 2, p = l16 & 3;
    const LAS unsigned char* vb = vt + (32 * kh + 4 * hi + q) * VP + (16 * g16 + 4 * p) * 2;
#pragma unroll
    for (int sx = 0; sx < 2; ++sx) {
        f16x8 pfr;
#pragma unroll
        for (int j = 0; j < 8; ++j) pfr[j] = (_Float16)s0[8 * sx + j];
#pragma unroll
        for (int dt = 0; dt < 2; ++dt) {
            const s16x4 ta = __builtin_amdgcn_ds_read_tr16_b64_v4i16((LAS s16x4*)(vb + (16 * sx) * VP + 64 * dt));
            const s16x4 tb = __builtin_amdgcn_ds_read_tr16_b64_v4i16((LAS s16x4*)(vb + (16 * sx + 8) * VP + 64 * dt));
            const f16x4 fa = __builtin_bit_cast(f16x4, ta), fb = __builtin_bit_cast(f16x4, tb);
            const f16x8 vfr = {fa.x, fa.y, fa.z, fa.w, fb.x, fb.y, fb.z, fb.w};
            if (dt == 0) rs.o0 = __builtin_amdgcn_mfma_f32_32x32x16_f16(vfr, pfr, rs.o0, 0, 0, 0);
            else rs.o1 = __builtin_amdgcn_mfma_f32_32x32x16_f16(vfr, pfr, rs.o1, 0, 0, 0);
        }
    }
}
__device__ __forceinline__ void rescale_if_needed(RowState& rs, float tmx) {
    if (__any(tmx > rs.m + 8.f)) {
        const float mn = fmaxf(rs.m, tmx);
        const float mu = (mn == -INFINITY) ? 0.f : mn;
        const float alpha = __builtin_amdgcn_exp2f(rs.m - mu);
        rs.l *= alpha; rs.m = mn;
#pragma unroll
        for (int i = 0; i < 16; ++i) { rs.o0[i] *= alpha; rs.o1[i] *= alpha; }
    }
}
__device__ __forceinline__ void tile_fast(RowState& rs, const LAS unsigned char* kt, const LAS unsigned char* vt, const f16x8 (&qf)[4], float c, int rho, int hi) {
    const LAS unsigned char* kb = kt + rho * KP + 16 * hi;
    f16x8 ka[4], kb2[4];
#pragma unroll
    for (int ks = 0; ks < 4; ++ks) { ka[ks] = *(const LAS f16x8*)(kb + 32 * ks); kb2[ks] = *(const LAS f16x8*)(kb + 32 * KP + 32 * ks); }
    const int l16 = rho & 15, g16 = rho >> 4, q = l16 >> 2, p = l16 & 3;
    const LAS unsigned char* vb = vt + (4 * hi + q) * VP + (16 * g16 + 4 * p) * 2;
    s16x4 va[4][2], vc[4][2];
    __builtin_amdgcn_sched_barrier(0);
    f32x16 s0, s1;
#pragma unroll
    for (int i = 0; i < 16; ++i) { s0[i] = 0.f; s1[i] = 0.f; }
#pragma unroll
    for (int ks = 0; ks < 4; ++ks) {
        s0 = __builtin_amdgcn_mfma_f32_32x32x16_f16(ka[ks], qf[ks], s0, 0, 0, 0);
        s1 = __builtin_amdgcn_mfma_f32_32x32x16_f16(kb2[ks], qf[ks], s1, 0, 0, 0);
    }
    __builtin_amdgcn_sched_barrier(0);
#pragma unroll
    for (int st = 0; st < 4; ++st)
#pragma unroll
        for (int dt = 0; dt < 2; ++dt) {
            va[st][dt] = __builtin_amdgcn_ds_read_tr16_b64_v4i16((LAS s16x4*)(vb + (16 * st) * VP + 64 * dt));
            vc[st][dt] = __builtin_amdgcn_ds_read_tr16_b64_v4i16((LAS s16x4*)(vb + (16 * st + 8) * VP + 64 * dt));
        }
    __builtin_amdgcn_sched_barrier(0);
    float tm = -INFINITY;
#pragma unroll
    for (int i = 0; i < 16; ++i) tm = fmaxf(tm, fmaxf(s0[i], s1[i]));
    { const auto r2 = __builtin_amdgcn_permlane32_swap(__float_as_uint(tm), __float_as_uint(tm), false, false); tm = fmaxf(__uint_as_float(r2[0]), __uint_as_float(r2[1])); }
    rescale_if_needed(rs, fmaf(tm, SC, c));
    const float mu = (rs.m == -INFINITY) ? 0.f : rs.m;
    const float cm = c - mu;
    float ps = 0.f;
#pragma unroll
    for (int i = 0; i < 16; ++i) { s0[i] = __builtin_amdgcn_exp2f(fmaf(s0[i], SC, cm)); s1[i] = __builtin_amdgcn_exp2f(fmaf(s1[i], SC, cm)); ps += s0[i] + s1[i]; }
    rs.l += ps;
#pragma unroll
    for (int st = 0; st < 4; ++st) {
        f16x8 pfr;
#pragma unroll
        for (int j = 0; j < 8; ++j) pfr[j] = (_Float16)((st & 2) ? s1[8 * (st & 1) + j] : s0[8 * (st & 1) + j]);
#pragma unroll
        for (int dt = 0; dt < 2; ++dt) {
            const f16x4 fa = __builtin_bit_cast(f16x4, va[st][dt]), fb = __builtin_bit_cast(f16x4, vc[st][dt]);
            const f16x8 vfr = {fa.x, fa.y, fa.z, fa.w, fb.x, fb.y, fb.z, fb.w};
            if (dt == 0) rs.o0 = __builtin_amdgcn_mfma_f32_32x32x16_f16(vfr, pfr, rs.o0, 0, 0, 0);
            else rs.o1 = __builtin_amdgcn_mfma_f32_32x32x16_f16(vfr, pfr, rs.o1, 0, 0, 0);
        }
    }
}
template <bool IMP>
__device__ __forceinline__ void tile_general(RowState& rs, const LAS unsigned char* kt, const LAS unsigned char* vt, const f16x8 (&qf)[4], const LAS float* lut, int hb, int rho, int hi,
                                             int dbase, int dstep, unsigned dlim, float mc, float invl, LAS float* impA, LAS float* impC, int n, bool wr) {
    const LAS unsigned char* kb = kt + rho * KP + 16 * hi;
    f16x8 ka[4], kb2[4];
#pragma unroll
    for (int ks = 0; ks < 4; ++ks) { ka[ks] = *(const LAS f16x8*)(kb + 32 * ks); kb2[ks] = *(const LAS f16x8*)(kb + 32 * KP + 32 * ks); }
    const int d0 = dbase - dstep * 4 * hi;
    __builtin_amdgcn_sched_barrier(0);
    f32x16 s0, s1;
#pragma unroll
    for (int i = 0; i < 16; ++i) { s0[i] = 0.f; s1[i] = 0.f; }
#pragma unroll
    for (int ks = 0; ks < 4; ++ks) {
        s0 = __builtin_amdgcn_mfma_f32_32x32x16_f16(ka[ks], qf[ks], s0, 0, 0, 0);
        s1 = __builtin_amdgcn_mfma_f32_32x32x16_f16(kb2[ks], qf[ks], s1, 0, 0, 0);
    }
    __builtin_amdgcn_sched_barrier(0);
    float b0[16], b1[16];
#pragma unroll
    for (int rg = 0; rg < 16; ++rg) {
        const int kl = (rg & 3) + 8 * (rg >> 2);
        int da = d0 - dstep * kl, db = d0 - dstep * (kl + 32);
        da = da < 0 ? 0 : da; da = da > 127 ? 127 : da; db = db < 0 ? 0 : db; db = db > 127 ? 127 : db;
        b0[rg] = lut[da * 8 + hb]; b1[rg] = lut[db * 8 + hb];
    }
    float tm = -INFINITY;
#pragma unroll
    for (int rg = 0; rg < 16; ++rg) {
        const int kl = (rg & 3) + 8 * (rg >> 2);
        const unsigned da = (unsigned)(d0 - dstep * kl), db = (unsigned)(d0 - dstep * (kl + 32));
        s0[rg] = da < dlim ? fmaf(s0[rg], SC, b0[rg]) : -INFINITY;
        s1[rg] = db < dlim ? fmaf(s1[rg], SC, b1[rg]) : -INFINITY;
        tm = fmaxf(tm, fmaxf(s0[rg], s1[rg]));
    }
    __builtin_amdgcn_sched_barrier(0);
    const int l16 = rho & 15, g16 = rho >> 4, q = l16 >> 2, p = l16 & 3;
    const LAS unsigned char* vb = vt + (4 * hi + q) * VP + (16 * g16 + 4 * p) * 2;
    s16x4 va[4][2], vc[4][2];
    if (!IMP) {
#pragma unroll
        for (int st = 0; st < 4; ++st)
#pragma unroll
            for (int dt = 0; dt < 2; ++dt) {
                va[st][dt] = __builtin_amdgcn_ds_read_tr16_b64_v4i16((LAS s16x4*)(vb + (16 * st) * VP + 64 * dt));
                vc[st][dt] = __builtin_amdgcn_ds_read_tr16_b64_v4i16((LAS s16x4*)(vb + (16 * st + 8) * VP + 64 * dt));
            }
        __builtin_amdgcn_sched_barrier(0);
    }
    if (!IMP) {
        { const auto r2 = __builtin_amdgcn_permlane32_swap(__float_as_uint(tm), __float_as_uint(tm), false, false); tm = fmaxf(__uint_as_float(r2[0]), __uint_as_float(r2[1])); }
        rescale_if_needed(rs, tm);
        const float mu = (rs.m == -INFINITY) ? 0.f : rs.m;
        float ps = 0.f;
#pragma unroll
        for (int i = 0; i < 16; ++i) { s0[i] = __builtin_amdgcn_exp2f(s0[i] - mu); s1[i] = __builtin_amdgcn_exp2f(s1[i] - mu); ps += s0[i] + s1[i]; }
        rs.l += ps;
#pragma unroll
        for (int st = 0; st < 4; ++st) {
            f16x8 pfr;
#pragma unroll
            for (int j = 0; j < 8; ++j) pfr[j] = (_Float16)((st & 2) ? s1[8 * (st & 1) + j] : s0[8 * (st & 1) + j]);
#pragma unroll
            for (int dt = 0; dt < 2; ++dt) {
                const f16x4 fa = __builtin_bit_cast(f16x4, va[st][dt]), fb = __builtin_bit_cast(f16x4, vc[st][dt]);
                const f16x8 vfr = {fa.x, fa.y, fa.z, fa.w, fb.x, fb.y, fb.z, fb.w};
                if (dt == 0) rs.o0 = __builtin_amdgcn_mfma_f32_32x32x16_f16(vfr, pfr, rs.o0, 0, 0, 0);
                else rs.o1 = __builtin_amdgcn_mfma_f32_32x32x16_f16(vfr, pfr, rs.o1, 0, 0, 0);
            }
        }
    } else {
        const float mu = (mc == -INFINITY) ? 0.f : mc;
#pragma unroll
        for (int kh = 0; kh < 2; ++kh)
#pragma unroll
            for (int ii = 0; ii < 4; ++ii) {
                float pv[4];
#pragma unroll
                for (int e = 0; e < 4; ++e) pv[e] = __builtin_amdgcn_exp2f((kh ? s1[4 * ii + e] : s0[4 * ii + e]) - mu) * invl;
                float a = (pv[0] + pv[1]) + (pv[2] + 0.5f * pv[3]), c = 0.5f * pv[3];
                a += __shfl_xor(a, 1); a += __shfl_xor(a, 2); c += __shfl_xor(c, 1); c += __shfl_xor(c, 2);
                const int nb = 16 * n + 8 * kh + 2 * ii + hi;
                if (wr) { impA[nb] = a; if (nb + 1 < 64) impC[nb + 1] = c; }
            }
    }
}
__device__ __forceinline__ void probs(RowState& rs, f32x16& s0, float sc, float c) {
    float tm = -INFINITY;
#pragma unroll
    for (int i = 0; i < 16; ++i) tm = fmaxf(tm, s0[i]);
    tm = fmaxf(tm, __shfl_xor(tm, 32));
    rescale_if_needed(rs, fmaf(tm, sc, c));
    const float mu = (rs.m == -INFINITY) ? 0.f : rs.m;
    const float cm = c - mu;
    float ps = 0.f;
#pragma unroll
    for (int i = 0; i < 16; ++i) { s0[i] = __builtin_amdgcn_exp2f(fmaf(s0[i], sc, cm)); ps += s0[i]; }
    rs.l += ps;
}
__device__ __forceinline__ void rs_init(RowState& rs) { rs.m = -INFINITY; rs.l = 0.f;
#pragma unroll
    for (int i = 0; i < 16; ++i) { rs.o0[i] = 0.f; rs.o1[i] = 0.f; } }
__device__ __forceinline__ void rs_flush(RowState& rs, float gate, _Float16* orow, bool first) {
    const float lt = rs.l + __shfl_xor(rs.l, 32);
    const float w = gate / fmaxf(lt, 1e-30f);
#pragma unroll
    for (int i = 0; i < 4; ++i) {
        float a[8] = {w * rs.o0[4 * i], w * rs.o0[4 * i + 1], w * rs.o0[4 * i + 2], w * rs.o0[4 * i + 3], w * rs.o1[4 * i], w * rs.o1[4 * i + 1], w * rs.o1[4 * i + 2], w * rs.o1[4 * i + 3]};
        if (!first) { const u32x2 p0 = *(const u32x2*)(orow + 8 * i), p1 = *(const u32x2*)(orow + 32 + 8 * i);
            const unsigned u0 = p0.x, u1 = p0.y, u2 = p1.x, u3 = p1.y; const pg8::f16x2 h0 = __builtin_bit_cast(pg8::f16x2, u0), h1 = __builtin_bit_cast(pg8::f16x2, u1), h2 = __builtin_bit_cast(pg8::f16x2, u2), h3 = __builtin_bit_cast(pg8::f16x2, u3);
            a[0] += (float)h0.x; a[1] += (float)h0.y; a[2] += (float)h1.x; a[3] += (float)h1.y; a[4] += (float)h2.x; a[5] += (float)h2.y; a[6] += (float)h3.x; a[7] += (float)h3.y; }
        u32x2 w0; w0.x = pg8::pkh(a[0], a[1]); w0.y = pg8::pkh(a[2], a[3]); *(u32x2*)(orow + 8 * i) = w0;
        u32x2 w1; w1.x = pg8::pkh(a[4], a[5]); w1.y = pg8::pkh(a[6], a[7]); *(u32x2*)(orow + 32 + 8 * i) = w1;
    }
}

__device__ __forceinline__ void nsa_unit(LAS unsigned char* lds, const _Float16* __restrict__ proj, const _Float16* __restrict__ kcmp, const _Float16* __restrict__ vcmp,
                                         _Float16* __restrict__ o_b, int b, int g, int qb) {
    const int tid = threadIdx.x, lane = tid & 63, wave = __builtin_amdgcn_readfirstlane(tid >> 6);
    const int rho = lane & 31, hi = lane >> 5, ql = rho >> 2, r = rho & 3, hb = g * 4 + r;
    const int t = 64 * qb + 8 * wave + ql;
    const _Float16* prow = proj + (size_t)(b * S_ + t) * PW;
    f16x8 qf[4];
#pragma unroll
    for (int ks = 0; ks < 4; ++ks) qf[ks] = *(const f16x8*)(prow + C_QB + hb * 64 + 16 * ks + 8 * hi);
    for (int i = tid; i < 2048; i += 512) ((LAS u32x4*)(lds + L_IMPA))[i] = (u32x4){0u, 0u, 0u, 0u};
    RowState rs; rs_init(rs);
    const LAS float* lut = (const LAS float*)(lds + L_BIAS);
    const float bias31 = lut[127 * 8 + hb];
    const _Float16* kc = kcmp + (size_t)(b * 2 + g) * 256 * 64;
    const long vcoff = (vcmp + (size_t)(b * 2 + g) * 256 * 64) - kc;
    const _Float16* pb = proj + (size_t)(b * S_) * PW + C_KVB + g * 64;
    const int ncmp = (4 * qb + 3 + 63) / 64;
    const int wlo = qb - 8 > 0 ? qb - 8 : 0;
    const int e0 = ncmp, e1 = 2 * ncmp, e2 = e1 + qb + 1, NT = e2 + (qb - wlo + 1);
    const int sr = tid >> 3, scq = tid & 7;
    float mc = 0.f, invl = 0.f; unsigned mlo = 0u, mhi = 0u;
    Stage stg;
#define NSA_DECODE(i, br, n) do { if ((i) < e0) { br = 0; n = (i); } else if ((i) < e1) { br = 1; n = (i) - e0; } else if ((i) < e2) { br = 2; n = (i) - e1; } else { br = 3; n = wlo + (i) - e2; } } while (0)
#define NSA_LOAD(i) do { int br_, n_; NSA_DECODE(i, br_, n_); const _Float16* kp_ = (br_ < 2) ? kc : (br_ == 2 ? pb + 2 * 128 : pb + 4 * 128); const int pitch_ = (br_ < 2) ? 64 : PW; \
        const long vo_ = (br_ < 2) ? vcoff : 128; const _Float16* rp_ = kp_ + (size_t)(64 * n_ + sr) * pitch_ + 8 * scq; stg.kr = *(const u32x4*)rp_; stg.vr = *(const u32x4*)(rp_ + vo_); } while (0)
#define NSA_STORE(buf) do { LAS unsigned char* tb_ = lds + L_T0 + (buf) * TILE_B; *(LAS u32x4*)(tb_ + sr * KP + 16 * scq) = stg.kr; *(LAS u32x4*)(tb_ + 64 * KP + sr * VP + 16 * scq) = stg.vr; } while (0)
    __syncthreads();
    NSA_LOAD(0); NSA_STORE(0);
    __syncthreads();
#pragma unroll 1
    for (int i = 0; i < NT; ++i) {
        int br, n; NSA_DECODE(i, br, n);
        const LAS unsigned char* tb = lds + L_T0 + (i & 1) * TILE_B;
        const bool more = i + 1 < NT;
        if (more) NSA_LOAD(i + 1);
        bool bit = true; int dbase, dstep = 1, dlim = 1 << 30; bool near = true;
        if (br < 2) { dbase = t - 31 - 1024 * n; dstep = 16; }
        else { dbase = t - 64 * n; near = n >= qb - 2; if (br == 2) bit = (n < 32) ? ((mlo >> n) & 1u) : ((mhi >> (n - 32)) & 1u); else dlim = 512; }
        const bool interior = (br >= 2) && (n <= qb - 3) && !(br == 3 && n == qb - 8);
        const bool skip = (br == 2) && !__any(bit);
        if (!skip) {
            if (interior) tile_fast(rs, tb, tb + 64 * KP, qf, bit ? bias31 : -INFINITY, rho, hi);
            else {
                const unsigned dl = bit ? (unsigned)dlim : 0u;
                int tq = threadIdx.x; asm volatile("" : "+v"(tq));
                LAS float* impA = (LAS float*)(lds + L_IMPA) + ((tq >> 6) * 8 + ((tq & 31) >> 2)) * 64;
                LAS float* impC = (LAS float*)(lds + L_IMPC) + ((tq >> 6) * 8 + ((tq & 31) >> 2)) * 64;
                if (br != 1) tile_general<false>(rs, tb, tb + 64 * KP, qf, lut, hb, rho, hi, dbase, dstep, dl, 0.f, 0.f, impA, impC, n, false);
                else tile_general<true>(rs, tb, tb + 64 * KP, qf, lut, hb, rho, hi, dbase, dstep, dl, mc, invl, impA, impC, n, r == 0);
            }
        }
        if (i + 1 == e0) {
            mc = rs.m; const float lc = rs.l + __shfl_xor(rs.l, 32); invl = 1.f / fmaxf(lc, 1e-30f);
            rs_flush(rs, pg8::sigm((float)prow[C_GB + 0 * 8 + hb]), o_b + (size_t)(b * S_ + t) * 1024 + hb * 64 + 4 * hi, true); rs_init(rs);
        } else if (i + 1 == e1) {
            asm volatile("s_waitcnt lgkmcnt(0)" ::: "memory");
            int tq = threadIdx.x; asm volatile("" : "+v"(tq));
            const int qs = (tq & 63) >> 3, j = tq & 7, wv = tq >> 6;
            LAS float* sA = (LAS float*)(lds + L_IMPA) + (wv * 8 + qs) * 64;
            const LAS float* sC = (const LAS float*)(lds + L_IMPC) + (wv * 8 + qs) * 64;
            float sc[8];
#pragma unroll
            for (int e = 0; e < 8; ++e) { const int nn = 8 * j + e; const bool forced = (nn == 0) || (nn == qb) || (nn == qb - 1);
                sc[e] = (nn <= qb) ? (forced ? 1.0e4f : (sA[nn] + sC[nn])) : -INFINITY; }
            asm volatile("s_waitcnt lgkmcnt(0)" ::: "memory");
#pragma unroll
            for (int e = 0; e < 8; ++e) sA[8 * j + e] = sc[e];
            asm volatile("s_waitcnt lgkmcnt(0)" ::: "memory");
            int rank[8];
#pragma unroll
            for (int e = 0; e < 8; ++e) rank[e] = 0;
            for (int m = 0; m <= qb; ++m) { const float sm = sA[m];
#pragma unroll
                for (int e = 0; e < 8; ++e) rank[e] += (sm > sc[e] || (sm == sc[e] && m < 8 * j + e)) ? 1 : 0; }
            unsigned bits = 0;
#pragma unroll
            for (int e = 0; e < 8; ++e) bits |= ((8 * j + e <= qb) && rank[e] < 16) ? (1u << e) : 0u;
            ((LAS unsigned char*)(lds + L_MASK))[(wv * 8 + qs) * 8 + j] = (unsigned char)bits;
            asm volatile("s_waitcnt lgkmcnt(0)" ::: "memory");
            const u32x2 mk = *(const LAS u32x2*)(lds + L_MASK + (wv * 8 + ((tq & 31) >> 2)) * 8);
            mlo = mk.x; mhi = mk.y;
        } else if (i + 1 == e2) {
            rs_flush(rs, pg8::sigm((float)prow[C_GB + 1 * 8 + hb]), o_b + (size_t)(b * S_ + t) * 1024 + hb * 64 + 4 * hi, false); rs_init(rs);
        } else if (i + 1 == NT) {
            rs_flush(rs, pg8::sigm((float)prow[C_GB + 2 * 8 + hb]), o_b + (size_t)(b * S_ + t) * 1024 + hb * 64 + 4 * hi, false);
        }
        if (more) NSA_STORE((i + 1) & 1);
        __syncthreads();
    }
#undef NSA_DECODE
#undef NSA_LOAD
#undef NSA_STORE
}
}


namespace cmpx {
typedef _Float16 f16x8 __attribute__((ext_vector_type(8)));
typedef float f32x4 __attribute__((ext_vector_type(4)));
typedef unsigned u32x4 __attribute__((ext_vector_type(4)));
constexpr int L_PART = 0, L_HID = 65536, HIDP = 272, L_END = L_HID + 16 * HIDP;
__device__ __forceinline__ void item(LAS unsigned char* lds, const _Float16* __restrict__ proj, const float* __restrict__ pe, const _Float16* __restrict__ w1t, const _Float16* __restrict__ w2t,
                                     _Float16* __restrict__ dst, int b, int g, int kv, int ct) {
    const int tid = threadIdx.x, lane = tid & 63, wave = __builtin_amdgcn_readfirstlane(tid >> 6), kc = lane >> 4, n16 = lane & 15;
    f32x4 acc[8];
#pragma unroll
    for (int nt = 0; nt < 8; ++nt) acc[nt] = (f32x4){0.f, 0.f, 0.f, 0.f};
    const int c = 16 * ct + n16;
#pragma unroll 2
    for (int ks = 0; ks < 8; ++ks) {
        const int k0 = 32 * (8 * wave + ks) + 8 * kc, lt = k0 >> 6, d = k0 & 63;
        int trow = 16 * c + lt; trow = trow > S_ - 1 ? S_ - 1 : trow;
        const f16x8 raw = *(const f16x8*)(proj + (size_t)(b * S_ + trow) * PW + C_KVB + kv * 128 + g * 64 + d);
        const f32x4 p0 = *(const f32x4*)(pe + lt * 64 + d), p1 = *(const f32x4*)(pe + lt * 64 + d + 4);
        f16x8 afr;
        afr[0] = (_Float16)((float)raw[0] + p0.x); afr[1] = (_Float16)((float)raw[1] + p0.y); afr[2] = (_Float16)((float)raw[2] + p0.z); afr[3] = (_Float16)((float)raw[3] + p0.w);
        afr[4] = (_Float16)((float)raw[4] + p1.x); afr[5] = (_Float16)((float)raw[5] + p1.y); afr[6] = (_Float16)((float)raw[6] + p1.z); afr[7] = (_Float16)((float)raw[7] + p1.w);
#pragma unroll
        for (int nt = 0; nt < 8; ++nt) {
            const f16x8 bfr = *(const f16x8*)(w1t + (size_t)(16 * nt + n16) * 2048 + k0);
            acc[nt] = __builtin_amdgcn_mfma_f32_16x16x32_f16(afr, bfr, acc[nt], 0, 0, 0);
        }
    }
    LAS float* part = (LAS float*)(lds + L_PART) + wave * 2048;
#pragma unroll
    for (int nt = 0; nt < 8; ++nt) { part[(4 * kc + 0) * 128 + 16 * nt + n16] = acc[nt].x; part[(4 * kc + 1) * 128 + 16 * nt + n16] = acc[nt].y;
        part[(4 * kc + 2) * 128 + 16 * nt + n16] = acc[nt].z; part[(4 * kc + 3) * 128 + 16 * nt + n16] = acc[nt].w; }
    __syncthreads();
    { const LAS float* pp = (const LAS float*)(lds + L_PART);
#pragma unroll
      for (int e = 0; e < 4; ++e) { const int o = tid + 512 * e; float a = 0.f;
#pragma unroll
          for (int w = 0; w < 8; ++w) a += pp[w * 2048 + o];
          const float z = 0.7978845608028654f * (a + 0.044715f * a * a * a);
          const float th = 1.f - 2.f / (__expf(2.f * z) + 1.f);
          ((LAS _Float16*)(lds + L_HID + (o >> 7) * HIDP))[o & 127] = (_Float16)(0.5f * a * (1.f + th)); } }
    __syncthreads();
    if (wave < 4) {
        f32x4 o = {0.f, 0.f, 0.f, 0.f};
#pragma unroll
        for (int ks = 0; ks < 4; ++ks) {
            const f16x8 afr = *(const LAS f16x8*)(lds + L_HID + n16 * HIDP + (32 * ks + 8 * kc) * 2);
            const f16x8 bfr = *(const f16x8*)(w2t + (size_t)(16 * wave + n16) * 128 + 32 * ks + 8 * kc);
            o = __builtin_amdgcn_mfma_f32_16x16x32_f16(afr, bfr, o, 0, 0, 0);
        }
        const float ov[4] = {o.x, o.y, o.z, o.w};
#pragma unroll
        for (int e = 0; e < 4; ++e) { const int cc = 16 * ct + 4 * kc + e; dst[((size_t)(b * 2 + g) * 256 + cc) * 64 + 16 * wave + n16] = (_Float16)(cc == 255 ? 0.f : ov[e]); }
    }
    __syncthreads();
}
}


#define XB_TMO      128
#define XB_XCNT(j)  (256  + 64 * (j))
#define XB_XSUB(j)  (1280 + 64 * (j))
#define XB_XGEN(j)  (2304 + 64 * (j))
#define XB_TOP      3328
#define XB_TOPGEN   3392
#define XCD_BAR_WORDS 3456
#define XB_SPIN_CAP (1u << 18)
__device__ __forceinline__ unsigned xb_ld(unsigned* p)              { return __hip_atomic_load(p, __ATOMIC_RELAXED, __HIP_MEMORY_SCOPE_AGENT); }
__device__ __forceinline__ unsigned xb_add(unsigned* p, unsigned v) { return __hip_atomic_fetch_add(p, v, __ATOMIC_RELAXED, __HIP_MEMORY_SCOPE_AGENT); }
__device__ __forceinline__ unsigned xb_xcc_id() { return (unsigned)__builtin_amdgcn_s_getreg((3 << 11) | 20) & 0xFu; }
#define XB_SPIN(cond, bar) do { unsigned _sp = 0; while (cond) { __builtin_amdgcn_s_sleep(1); \
    if ((++_sp & 255u) == 0u) { if (xb_ld(&(bar)[XB_TMO])) break; if (_sp > XB_SPIN_CAP) { atomicAdd(&(bar)[XB_TMO], 1u); break; } } } } while (0)
struct XcdBarrier { unsigned* bar; unsigned x; volatile LAS unsigned* st; };
__device__ __forceinline__ XcdBarrier xcd_barrier_post(unsigned* bar, volatile LAS unsigned* st) {
    XcdBarrier b; b.bar = bar; b.x = xb_xcc_id(); b.st = st;
    if (threadIdx.x == 0) (void)xb_add(&bar[XB_XCNT(b.x)], 1u);
    return b;
}
__device__ __forceinline__ void xcd_barrier_complete(unsigned* bar, unsigned x, unsigned& nloc, unsigned& nx) {
    const unsigned G = gridDim.x * gridDim.y * gridDim.z;
    unsigned sum, cnt, mine, sp = 0u;
    for (;;) {
        sum = 0u; cnt = 0u; mine = 0u;
#pragma unroll
        for (unsigned j = 0; j < 16; ++j) { const unsigned c = xb_ld(&bar[XB_XCNT(j)]); sum += c; cnt += (c > 0u) ? 1u : 0u; mine = (j == x) ? c : mine; }
        if (sum == G) break;
        __builtin_amdgcn_s_sleep(1);
        if ((++sp & 255u) == 0u) { if (xb_ld(&bar[XB_TMO])) break; if (sp > XB_SPIN_CAP) { atomicAdd(&bar[XB_TMO], 1u); break; } }
    }
    nloc = mine > 0u ? mine : 1u; nx = cnt > 0u ? cnt : 1u;
}
__device__ __forceinline__ void xcd_barrier(const XcdBarrier& b) {
    asm volatile("s_waitcnt vmcnt(0)" ::: "memory");
    __syncthreads();
    if (threadIdx.x == 0) {
        unsigned* bar = b.bar;
        __builtin_amdgcn_s_waitcnt(0);
        unsigned nloc = b.st[0], nx = b.st[1];
        if (nloc == 0u) { xcd_barrier_complete(bar, b.x, nloc, nx); b.st[0] = nloc; b.st[1] = nx; }
        const unsigned old = xb_add(&bar[XB_XSUB(b.x)], 1u);
        const unsigned gen = old / nloc;
        if (old + 1u == (gen + 1u) * nloc) {
            __builtin_amdgcn_fence(__ATOMIC_RELEASE, "agent");
            asm volatile("s_waitcnt vmcnt(0)" ::: "memory");
            const unsigned og = xb_add(&bar[XB_TOP], 1u);
            const unsigned tg = og / nx;
            if (og + 1u == (tg + 1u) * nx) xb_add(&bar[XB_TOPGEN], 1u);
            else XB_SPIN(xb_ld(&bar[XB_TOPGEN]) == tg, bar);
            __builtin_amdgcn_fence(__ATOMIC_ACQUIRE, "agent");
            xb_add(&bar[XB_XGEN(b.x)], 1u);
            asm volatile("s_waitcnt vmcnt(0)" ::: "memory");
        } else {
            XB_SPIN(xb_ld(&bar[XB_XGEN(b.x)]) == gen, bar);
            __builtin_amdgcn_fence(__ATOMIC_ACQUIRE, "agent");
            asm volatile("s_waitcnt vmcnt(0)" ::: "memory");
        }
    }
    __syncthreads();
}

constexpr int MEGA_LDS = 131072 + 256;

template <class Epi>
__device__ __forceinline__ void gemm_run(LAS unsigned char* lds, const void* A, const void* Bt, const Epi& E, int M, int N, int K) {
    pg8::Gemm g{(const pg8::bf16_t*)A, (const pg8::bf16_t*)Bt, M, N, K};
    pg8::StaticOrder S; S.init(M, N, (int)gridDim.x, (int)blockIdx.x);
    pg8::gemm_phase<Epi, pg8::StaticOrder, true, true>(lds, g, S, E);
}

__global__ void __launch_bounds__(512, 2) mega_fwd(Args a) {
    extern __shared__ __attribute__((aligned(16))) unsigned char lds_raw[];
    LAS unsigned char* lds = (LAS unsigned char*)lds_raw;
    unsigned char* ws = a.ws;
    if (threadIdx.x == 0) *(LAS dsa::u32x4*)(lds + 131072) = (dsa::u32x4){0u, 0u, 0u, 0u};
    __syncthreads();
    XcdBarrier bar = xcd_barrier_post((unsigned*)(ws + WS_CTL), (volatile LAS unsigned*)(lds + 131072));
    const _Float16* proj = (const _Float16*)(ws + WS_PROJ);
    _Float16* o_a = (_Float16*)(ws + WS_H); _Float16* o_b = (_Float16*)(ws + WS_H) + 512;
    _Float16* kcmp = (_Float16*)(ws + WS_KCMP); _Float16* vcmp = (_Float16*)(ws + WS_VCMP);

    prologue_body(a, lds_raw);
    xcd_barrier(bar);
    gemm_run(lds, ws + WS_H, ws + WS_WIN, pg8::EpiProj{(_Float16*)(ws + WS_PROJ)}, M_, PW, D_);
    xcd_barrier(bar);
#pragma unroll 1
    for (int it = blockIdx.x; it < 512; it += gridDim.x) { const int ct = it & 15, kv = (it >> 4) & 1, g = (it >> 5) & 1, b = it >> 6;
        cmpx::item(lds, proj, kv ? a.pe_v : a.pe_k, (const _Float16*)(ws + WS_CW + (kv ? 512 * 1024 : 0)), (const _Float16*)(ws + WS_CW + 1024 * 1024 + (kv ? 16384 : 0)), kv ? vcmp : kcmp, b, g, kv, ct); }
    { LAS float* biaslut = (LAS float*)(lds + dsa::L_BIAS);
      for (int i = threadIdx.x; i < 1024; i += 512) { const int d = i >> 3, h = i & 7; biaslut[i] = a.rel_bias[t5_bucket(d) * 16 + h]; } }
    __syncthreads();
#pragma unroll 1
    for (int v = blockIdx.x >> 3; v < 256; v += (gridDim.x >> 3)) { const int b = blockIdx.x & 7, j = v & 127;
        dsa::dsa_tile(lds, proj, o_a, b, (v < 128) ? 255 - j : j); }
    xcd_barrier(bar);
    { LAS float* lut = (LAS float*)(lds + nsa::L_BIAS);
      for (int i = threadIdx.x; i < 1024; i += 512) { const int d = i >> 3, h = i & 7; lut[i] = a.rel_bias[t5_bucket(d) * 16 + 8 + h] * nsa::LOG2E; } }
    __syncthreads();
#pragma unroll 1
    for (int v = blockIdx.x >> 3; v < 128; v += (gridDim.x >> 3)) { const int bg = 2 * (blockIdx.x & 7) + (v >> 6), j = v & 31;
        nsa::nsa_unit(lds, proj, kcmp, vcmp, o_b, bg >> 1, bg & 1, (v & 32) ? j : 63 - j);
        __syncthreads(); }
    xcd_barrier(bar);
    gemm_run(lds, ws + WS_H, ws + WS_WBA, pg8::EpiMixF{(_Float16*)(ws + WS_MIX), proj}, M_, D_, D_);
    xcd_barrier(bar);
    gemm_run(lds, ws + WS_MIX, ws + WS_WOUT, pg8::EpiResidSq{a.x, a.out, (_Float16*)(ws + WS_H), (float*)(ws + WS_ROWSQ)}, M_, D_, D_);
    xcd_barrier(bar);
    gemm_run(lds, ws + WS_H, ws + WS_WMI, pg8::EpiRelu2N{(_Float16*)(ws + WS_PROJ), (const float*)(ws + WS_ROWSQ)}, M_, DFF, D_);
    xcd_barrier(bar);
#pragma unroll 1
    for (int sl = 0; sl < 2; ++sl) {
        pg8::Gemm g{(const pg8::bf16_t*)(ws + WS_PROJ), (const pg8::bf16_t*)(ws + WS_WMO), M_, D_, DFF};
        SliceOrder SO; SO.S.init(M_, D_, (int)gridDim.x, (int)blockIdx.x); SO.slice = sl;
        pg8::gemm_phase<EpiFinalNorm, SliceOrder, false, true>(lds, g, SO, EpiFinalNorm{a.out, (const _Float16*)(ws + WS_H), a.norm_final, (float*)(ws + WS_XBUF), (unsigned*)(ws + WS_PCNT)});
        __syncthreads();
    }
}
}

extern "C" void kernel_launch(void* const* d_in, const int* in_sizes, int n_in, void* d_out, int out_size, void* d_ws, size_t ws_size, hipStream_t stream) {
    if (ws_size < WS_END) { fprintf(stderr, "ws too small: %zu\n", ws_size); return; }
    static int grid = 0;
    if (!grid) {
        int dev = 0, cus = 0, per_cu = 0;
        (void)hipGetDevice(&dev);
        (void)hipDeviceGetAttribute(&cus, hipDeviceAttributeMultiprocessorCount, dev);
        (void)hipFuncSetAttribute((const void*)mega_fwd, hipFuncAttributeMaxDynamicSharedMemorySize, MEGA_LDS);
        (void)hipOccupancyMaxActiveBlocksPerMultiprocessor(&per_cu, (const void*)mega_fwd, 512, MEGA_LDS);
        (void)hipGetLastError();
        grid = cus;
        if (per_cu < 1) fprintf(stderr, "occupancy query says %d blocks/CU\n", per_cu);
    }
    Args a{};
    a.x = (const float*)d_in[0]; a.norm_mix = (const float*)d_in[1]; a.w_in = (const float*)d_in[2];
    a.pe_k = (const float*)d_in[3]; a.w1_k = (const float*)d_in[4]; a.w2_k = (const float*)d_in[5];
    a.pe_v = (const float*)d_in[6]; a.w1_v = (const float*)d_in[7]; a.w2_v = (const float*)d_in[8];
    a.rel_bias = (const float*)d_in[9]; a.w_ba = (const float*)d_in[10]; a.w_bb = (const float*)d_in[11];
    a.w_out = (const float*)d_in[12]; a.norm_mlp = (const float*)d_in[13]; a.w_mi = (const float*)d_in[14];
    a.w_mo = (const float*)d_in[15]; a.norm_final = (const float*)d_in[16];
    a.out = (float*)d_out; a.ws = (unsigned char*)d_ws;
    (void)hipMemsetAsync(d_ws, 0, 327680, stream);
    hipLaunchKernelGGL(mega_fwd, dim3(grid), dim3(512), MEGA_LDS, stream, a);
}
```

```cpp
#include <hip/hip_runtime.h>
#include <hip/hip_fp16.h>
#include <cstdint>
#include <cstdio>

namespace pg8 {
#define PG8_LAS __attribute__((address_space(3)))
typedef unsigned short bf16_t;
typedef _Float16 bf16x8 __attribute__((ext_vector_type(8)));
typedef float f32x4 __attribute__((ext_vector_type(4)));
typedef unsigned u32x4 __attribute__((ext_vector_type(4)));
constexpr int BM = 256, BK = 64, HALF = 128, HTB = HALF * BK * 2  , STAGE_BYTES = 8 * HTB, NXCD = 8, WGM = 8;

__host__ __device__ __forceinline__ int lds_byte(int r, int c) { const int st = (r >> 4) * 2 + (c >> 5), rr = r & 15, cc = c & 31, ob = rr * 64 + cc * 2; return st * 1024 + (ob ^ (((ob >> 9) & 1) << 5)); }
__host__ __device__ __forceinline__ void stage_rc(int b, int& R, int& C) { const int st = b / 1024, sb = b % 1024, swz = sb ^ (((sb >> 9) & 1) << 5); R = (st >> 1) * 16 + swz / 64; C = (st & 1) * 32 + (swz % 64) / 2; }
__host__ __device__ __forceinline__ int perm32(int rho) { const int n = rho >> 4, i = rho & 15; return 8 * (i >> 2) + 4 * n + (i & 3); }

struct Unit { int pm, pn; };
struct Gemm { const bf16_t* A; const bf16_t* Bt; int M, N, K; };

struct StaticOrder {
    int nM, nN, nwg, G, c;
    __host__ __device__ void init(int M, int N, int G_, int c_) { nM = M / BM; nN = N / BM; nwg = nM * nN; G = G_; c = c_; }
    __host__ __device__ bool next(int i, Unit& u) const {
        const long L = (long)i * G + c; if (L >= nwg) return false;
        int wgid = (int)L; { const int q = nwg / NXCD, r = nwg % NXCD, xcd = wgid % NXCD, off = wgid / NXCD; wgid = (xcd < r ? xcd * (q + 1) : r * (q + 1) + (xcd - r) * q) + off; }
        const int nig = WGM * nN, gid = wgid / nig, fm = gid * WGM, gsz = (nM - fm) < WGM ? (nM - fm) : WGM;
        u.pm = fm + ((wgid % nig) % gsz); u.pn = (wgid % nig) / gsz; return true;
    }
    __device__ __forceinline__ void a_ready(const Unit&) const {}
    __device__ __forceinline__ void done(const Unit&) const {}
};


typedef unsigned u32x2 __attribute__((ext_vector_type(2)));
typedef float f32x2 __attribute__((ext_vector_type(2)));
typedef _Float16 f16x2 __attribute__((ext_vector_type(2)));
constexpr int PW = 4352;
__device__ __forceinline__ unsigned pkh(float a, float b) { f32x2 v = {a, b}; f16x2 h = __builtin_convertvector(v, f16x2); return __builtin_bit_cast(unsigned, h); }
__device__ __forceinline__ float sigm(float v) { return __builtin_amdgcn_rcpf(1.f + __expf(-v)); }
__device__ __forceinline__ float sigm_gate(float v) { return fmaxf(sigm(v), 6.2e-5f); }
__device__ __forceinline__ void unpk8(const u32x4 w, float (&f)[8]) {
#pragma unroll
    for (int i = 0; i < 4; ++i) { const unsigned wi = (i == 0) ? w.x : (i == 1) ? w.y : (i == 2) ? w.z : w.w; const f16x2 h = __builtin_bit_cast(f16x2, wi); f[2 * i] = (float)h.x; f[2 * i + 1] = (float)h.y; } }

struct EpiProj {
    static constexpr bool PERM = true, AFTER_DRAIN = false, MID = false;
    _Float16* O;
    __device__ __forceinline__ void operator()(const f32x4 (&acc)[2][2][4][2], const Unit& u, int wr, int wc, int fr, int fq) const {
        const int row0 = u.pm * BM + wr * 64 + fr, col0 = u.pn * BM + wc * 32 + 8 * fq; const bool sg = u.pn >= 9;
#pragma unroll
        for (int ai = 0; ai < 2; ++ai)
#pragma unroll
            for (int m = 0; m < 4; ++m) { _Float16* rowp = O + (size_t)(row0 + ai * HALF + m * 16) * PW + col0;
#pragma unroll
                for (int bj = 0; bj < 2; ++bj) { f32x4 v0 = acc[ai][bj][m][0], v1 = acc[ai][bj][m][1];
                    if (sg) {
#pragma unroll
                        for (int i = 0; i < 4; ++i) { v0[i] = sigm_gate(v0[i]); v1[i] = sigm_gate(v1[i]); } }
                    u32x4 w; w.x = pkh(v0[0], v0[1]); w.y = pkh(v0[2], v0[3]); w.z = pkh(v1[0], v1[1]); w.w = pkh(v1[2], v1[3]);
                    *(u32x4*)(rowp + bj * HALF) = w; } }
    }
};
struct EpiMixF {
    static constexpr bool PERM = true, AFTER_DRAIN = false, MID = true;
    _Float16* mix; const _Float16* proj;
    __device__ __forceinline__ void mid(f32x4 (&acc)[2][2][4][2], const Unit& u, int wr, int wc, int fr, int fq) const {
        int row0 = u.pm * BM + wr * 64 + fr, col0 = u.pn * BM + wc * 32 + 8 * fq;
        asm volatile("" : "+v"(row0), "+v"(col0));
#pragma unroll
        for (int ai = 0; ai < 2; ++ai)
#pragma unroll
            for (int m = 0; m < 4; ++m) { const _Float16* gr = proj + (size_t)(row0 + ai * HALF + m * 16) * PW + 2304 + col0;
#pragma unroll
                for (int bj = 0; bj < 2; ++bj)
#pragma unroll
                    for (int n = 0; n < 2; ++n) {
                        const u32x2 wa = *(const u32x2*)(gr + bj * HALF + 4 * n), wb = *(const u32x2*)(gr + 1024 + bj * HALF + 4 * n);
                        const unsigned a0 = wa.x, a1 = wa.y, b0 = wb.x, b1 = wb.y;
                        const f16x2 ga0 = __builtin_bit_cast(f16x2, a0), ga1 = __builtin_bit_cast(f16x2, a1), gb0 = __builtin_bit_cast(f16x2, b0), gb1 = __builtin_bit_cast(f16x2, b1);
                        acc[ai][bj][m][n][0] *= (float)ga0.x * __builtin_amdgcn_rcpf((float)gb0.x); acc[ai][bj][m][n][1] *= (float)ga0.y * __builtin_amdgcn_rcpf((float)gb0.y);
                        acc[ai][bj][m][n][2] *= (float)ga1.x * __builtin_amdgcn_rcpf((float)gb1.x); acc[ai][bj][m][n][3] *= (float)ga1.y * __builtin_amdgcn_rcpf((float)gb1.y);
                        __builtin_amdgcn_sched_barrier(0);
                    } }
    }
    __device__ __forceinline__ void operator()(const f32x4 (&acc)[2][2][4][2], const Unit& u, int wr, int wc, int fr, int fq) const {
        const int row0 = u.pm * BM + wr * 64 + fr, col0 = u.pn * BM + wc * 32 + 8 * fq;
#pragma unroll
        for (int ai = 0; ai < 2; ++ai)
#pragma unroll
            for (int m = 0; m < 4; ++m) { const size_t r = (size_t)(row0 + ai * HALF + m * 16);
#pragma unroll
                for (int bj = 0; bj < 2; ++bj) { const int c = col0 + bj * HALF;
                    float gb[8]; unpk8(*(const u32x4*)(proj + r * PW + 3328 + c), gb);
                    const f32x4 v0 = acc[ai][bj][m][0], v1 = acc[ai][bj][m][1];
                    u32x4 w; w.x = pkh(gb[0] * v0[0], gb[1] * v0[1]); w.y = pkh(gb[2] * v0[2], gb[3] * v0[3]); w.z = pkh(gb[4] * v1[0], gb[5] * v1[1]); w.w = pkh(gb[6] * v1[2], gb[7] * v1[3]);
                    *(u32x4*)(mix + r * 1024 + c) = w; } }
    }
};
struct EpiResidSq {
    static constexpr bool PERM = true, AFTER_DRAIN = false, MID = false;
    const float* x; float* out; _Float16* xh; float* rowsq;
    __device__ __forceinline__ void operator()(const f32x4 (&acc)[2][2][4][2], const Unit& u, int wr, int wc, int fr, int fq) const {
        const int row0 = u.pm * BM + wr * 64 + fr, col0 = u.pn * BM + wc * 32 + 8 * fq;
#pragma unroll
        for (int ai = 0; ai < 2; ++ai)
#pragma unroll
            for (int m = 0; m < 4; ++m) { const size_t r = (size_t)(row0 + ai * HALF + m * 16); float sq = 0.f;
#pragma unroll
                for (int bj = 0; bj < 2; ++bj) { const size_t o = r * 1024 + col0 + bj * HALF;
                    const f32x4 a0 = *(const f32x4*)(x + o) + acc[ai][bj][m][0], a1 = *(const f32x4*)(x + o + 4) + acc[ai][bj][m][1];
                    u32x4 w; w.x = pkh(a0[0], a0[1]); w.y = pkh(a0[2], a0[3]); w.z = pkh(a1[0], a1[1]); w.w = pkh(a1[2], a1[3]);
                    *(u32x4*)(xh + o) = w;
                    sq += (a0[0] * a0[0] + a0[1] * a0[1]) + (a0[2] * a0[2] + a0[3] * a0[3]) + (a1[0] * a1[0] + a1[1] * a1[1]) + (a1[2] * a1[2] + a1[3] * a1[3]); }
                sq += __shfl_xor(sq, 16); sq += __shfl_xor(sq, 32);
                if (fq == 0) atomicAdd(rowsq + r, sq); }
    }
};
struct EpiRelu2N {
    static constexpr bool PERM = true, AFTER_DRAIN = false, MID = false;
    _Float16* U; const float* rowsq;
    __device__ __forceinline__ void operator()(const f32x4 (&acc)[2][2][4][2], const Unit& u, int wr, int wc, int fr, int fq) const {
        const int row0 = u.pm * BM + wr * 64 + fr, col0 = u.pn * BM + wc * 32 + 8 * fq;
#pragma unroll
        for (int ai = 0; ai < 2; ++ai)
#pragma unroll
            for (int m = 0; m < 4; ++m) { const int r = row0 + ai * HALF + m * 16; _Float16* rowp = U + (size_t)r * 4096 + col0;
                const float inv = 1.f / (rowsq[r] * (1.f / 1024.f) + 1e-6f);
#pragma unroll
                for (int bj = 0; bj < 2; ++bj) { f32x4 v0 = acc[ai][bj][m][0], v1 = acc[ai][bj][m][1];
#pragma unroll
                    for (int i = 0; i < 4; ++i) { const float a = fmaxf(v0[i], 0.f), b = fmaxf(v1[i], 0.f); v0[i] = a * a * inv; v1[i] = b * b * inv; }
                    u32x4 w; w.x = pkh(v0[0], v0[1]); w.y = pkh(v0[2], v0[3]); w.z = pkh(v1[0], v1[1]); w.w = pkh(v1[2], v1[3]);
                    *(u32x4*)(rowp + bj * HALF) = w; } }
    }
};
template <class Epi, class Sched, bool ALIGN_EPI = false, bool SP2 = false>
__device__ __forceinline__ void gemm_phase(PG8_LAS unsigned char* lds, const Gemm g, const Sched& S, const Epi& E) {
    int tid_ = threadIdx.x; asm volatile("" : "+v"(tid_));
    const int tid = tid_, wid = __builtin_amdgcn_readfirstlane(tid >> 6), lane = tid & 63, wr = wid >> 2, wc = wid & 3, fr = lane & 15, fq = lane >> 4;
    const int K = g.K, nt = K / BK;
    unsigned voffA[2], voffB[2];
#pragma unroll
    for (int i = 0; i < 2; ++i) { int R, C; stage_rc(tid * 16 + i * 8192, R, C); const int Rb = Epi::PERM ? ((R & ~31) + perm32(R & 31)) : R;
        voffA[i] = (unsigned)(R * K + C) * 2u; voffB[i] = (unsigned)(Rb * K + C) * 2u; }
    const size_t kstep = (size_t)(BK * 2);
    const size_t hstep = (size_t)HALF * K * 2;
    const size_t tstep = 2 * hstep;
    const unsigned ldsw = (unsigned)wid * 1024u;
    const int aoff = lds_byte(wr * 64 + fr, fq * 8), boff = lds_byte(wc * 32 + fr, fq * 8);
#define PG8_SA(b, h) (((b) * 2 + (h)) * HTB)
#define PG8_SB(b, h) ((4 + (b) * 2 + (h)) * HTB)
#define PG8_STAGE(bufoff, gbase, voff) do { _Pragma("unroll") for (int _i = 0; _i < 2; ++_i) \
        __builtin_amdgcn_global_load_lds((const unsigned*)((const char*)(gbase) + (voff)[_i]), (PG8_LAS unsigned*)(lds + (bufoff) + ldsw + _i * 8192), 16, 0, 0); } while (0)
#define PG8_LDA(dst, b, h) do { _Pragma("unroll") for (int m = 0; m < 4; ++m) _Pragma("unroll") for (int k = 0; k < 2; ++k) dst[m][k] = *(const PG8_LAS bf16x8*)(lds + PG8_SA(b, h) + aoff + m * 2048 + k * 1024); } while (0)
#define PG8_LDB(dst, b, h) do { _Pragma("unroll") for (int n = 0; n < 2; ++n) _Pragma("unroll") for (int k = 0; k < 2; ++k) dst[n][k] = *(const PG8_LAS bf16x8*)(lds + PG8_SB(b, h) + boff + n * 2048 + k * 1024); } while (0)
#define PG8_MMA(ai, bj, At, Bt) do { __builtin_amdgcn_s_setprio(1); _Pragma("unroll") for (int m = 0; m < 4; ++m) _Pragma("unroll") for (int n = 0; n < 2; ++n) _Pragma("unroll") for (int k = 0; k < 2; ++k) \
        acc[ai][bj][m][n] = __builtin_amdgcn_mfma_f32_16x16x32_f16(Bt[n][k], At[m][k], acc[ai][bj][m][n], 0, 0, 0); __builtin_amdgcn_s_setprio(0); } while (0)
#define PG8_WAIT_V(n) asm volatile("s_waitcnt vmcnt(" #n ")" ::: "memory")
#define PG8_WAIT_L(n) asm volatile("s_waitcnt lgkmcnt(" #n ")" ::: "memory")
#define PG8_BAR __builtin_amdgcn_s_barrier()
#define PG8_SCHED __builtin_amdgcn_sched_barrier(0)
    Unit cur, nxt; int ui = 0;
    if (!S.next(0, cur)) return;
    f32x4 acc[2][2][4][2];
#pragma unroll
    for (int a = 0; a < 2; ++a)
#pragma unroll
        for (int b = 0; b < 2; ++b)
#pragma unroll
            for (int m = 0; m < 4; ++m)
#pragma unroll
                for (int n = 0; n < 2; ++n) acc[a][b][m][n] = (f32x4){0.f, 0.f, 0.f, 0.f};
    bf16x8 At[4][2], B0[2][2], B1[2][2];
    const char* cA = (const char*)g.A + (size_t)cur.pm * tstep; const char* cB = (const char*)g.Bt + (size_t)cur.pn * tstep;
    S.a_ready(cur);
    if constexpr (SP2) {
        PG8_STAGE(PG8_SB(0, 0), cB, voffB); PG8_STAGE(PG8_SB(0, 1), cB + hstep, voffB); PG8_STAGE(PG8_SA(0, 0), cA, voffA); PG8_STAGE(PG8_SA(0, 1), cA + hstep, voffA);
        if (wr == 1) PG8_BAR;
        PG8_WAIT_V(2); PG8_BAR;
        PG8_STAGE(PG8_SB(1, 0), cB + kstep, voffB); PG8_STAGE(PG8_SA(1, 0), cA + kstep, voffA); PG8_STAGE(PG8_SB(1, 1), cB + hstep + kstep, voffB);
        PG8_WAIT_V(6); PG8_BAR;
    } else {
        PG8_STAGE(PG8_SB(0, 0), cB, voffB); PG8_STAGE(PG8_SA(0, 0), cA, voffA); PG8_STAGE(PG8_SB(0, 1), cB + hstep, voffB); PG8_STAGE(PG8_SA(0, 1), cA + hstep, voffA);
        if (wr == 1) PG8_BAR;
        PG8_WAIT_V(4); PG8_BAR;
        PG8_STAGE(PG8_SB(1, 0), cB + kstep, voffB); PG8_STAGE(PG8_SA(1, 0), cA + kstep, voffA); PG8_STAGE(PG8_SB(1, 1), cB + hstep + kstep, voffB);
        PG8_WAIT_V(6); PG8_BAR;
    }
    for (;;) {
        const bool has_next = S.next(ui + 1, nxt);
        const char* nA = has_next ? (const char*)g.A + (size_t)nxt.pm * tstep : cA; const char* nB = has_next ? (const char*)g.Bt + (size_t)nxt.pn * tstep : cB;
        for (int t = 0; t < nt; t += 2) {
            if constexpr (Epi::MID) { if (t == nt / 2) E.mid(acc, cur, wr, wc, fr, fq); }
            const bool last = (t == nt - 2);
            const char* a1 = cA + (size_t)(t + 1) * kstep;
            const char* a2 = last ? nA : cA + (size_t)(t + 2) * kstep; const char* b2 = last ? nB : cB + (size_t)(t + 2) * kstep;
            const char* a3 = a2 + kstep; const char* b3 = b2 + kstep;
            if (last && has_next) S.a_ready(nxt);
            if constexpr (SP2) {
            PG8_LDB(B0, 0, 0); PG8_LDB(B1, 0, 1); PG8_SCHED; PG8_LDA(At, 0, 0); PG8_STAGE(PG8_SA(1, 1), a1 + hstep, voffA);
            PG8_WAIT_V(8); PG8_WAIT_L(0); PG8_BAR; PG8_MMA(0, 0, At, B0); PG8_MMA(0, 1, At, B1); PG8_BAR; PG8_SCHED;
            PG8_LDA(At, 0, 1); PG8_STAGE(PG8_SB(0, 0), b2, voffB); PG8_STAGE(PG8_SB(0, 1), b2 + hstep, voffB); PG8_STAGE(PG8_SA(0, 0), a2, voffA);
            PG8_WAIT_V(8); PG8_WAIT_L(0); PG8_BAR; PG8_MMA(1, 0, At, B0); PG8_MMA(1, 1, At, B1); PG8_BAR; PG8_SCHED;
            PG8_LDB(B0, 1, 0); PG8_LDB(B1, 1, 1); PG8_SCHED; PG8_LDA(At, 1, 0); PG8_STAGE(PG8_SA(0, 1), a2 + hstep, voffA);
            PG8_WAIT_V(8); PG8_WAIT_L(0); PG8_BAR; PG8_MMA(0, 0, At, B0); PG8_MMA(0, 1, At, B1); PG8_BAR; PG8_SCHED;
            PG8_LDA(At, 1, 1); PG8_STAGE(PG8_SB(1, 0), b3, voffB); PG8_STAGE(PG8_SB(1, 1), b3 + hstep, voffB); PG8_STAGE(PG8_SA(1, 0), a3, voffA);
            PG8_WAIT_V(8); PG8_WAIT_L(0); PG8_BAR; PG8_MMA(1, 0, At, B0); PG8_MMA(1, 1, At, B1); PG8_BAR; PG8_SCHED;
            } else {
            PG8_LDB(B0, 0, 0); PG8_SCHED; PG8_LDA(At, 0, 0); PG8_STAGE(PG8_SA(1, 1), a1 + hstep, voffA);
            PG8_WAIT_L(8); PG8_BAR; PG8_WAIT_L(0); PG8_MMA(0, 0, At, B0); PG8_BAR; PG8_SCHED;
            PG8_LDB(B1, 0, 1); PG8_STAGE(PG8_SB(0, 0), b2, voffB);
            PG8_BAR; PG8_WAIT_L(0); PG8_MMA(0, 1, At, B1); PG8_BAR;
            PG8_LDA(At, 0, 1); PG8_STAGE(PG8_SA(0, 0), a2, voffA);
            PG8_BAR; PG8_WAIT_L(0); PG8_MMA(1, 0, At, B0); PG8_BAR; PG8_SCHED;
            PG8_STAGE(PG8_SB(0, 1), b2 + hstep, voffB);
            PG8_WAIT_V(6); PG8_BAR; PG8_MMA(1, 1, At, B1); PG8_BAR;
            PG8_LDB(B0, 1, 0); PG8_SCHED; PG8_LDA(At, 1, 0); PG8_STAGE(PG8_SA(0, 1), a2 + hstep, voffA);
            PG8_WAIT_L(8); PG8_BAR; PG8_WAIT_L(0); PG8_MMA(0, 0, At, B0); PG8_BAR; PG8_SCHED;
            PG8_LDB(B1, 1, 1); PG8_STAGE(PG8_SB(1, 0), b3, voffB);
            PG8_BAR; PG8_WAIT_L(0); PG8_MMA(0, 1, At, B1); PG8_BAR;
            PG8_LDA(At, 1, 1); PG8_STAGE(PG8_SA(1, 0), a3, voffA);
            PG8_BAR; PG8_WAIT_L(0); PG8_MMA(1, 0, At, B0); PG8_BAR; PG8_SCHED;
            PG8_STAGE(PG8_SB(1, 1), b3 + hstep, voffB);
            PG8_WAIT_V(6); PG8_BAR; PG8_MMA(1, 1, At, B1); PG8_BAR;
            }
        }
        if constexpr (ALIGN_EPI) { if (wr == 0) PG8_BAR; }
        if constexpr (!Epi::AFTER_DRAIN) { E(acc, cur, wr, wc, fr, fq); S.done(cur); }
        if (!has_next) break;
#pragma unroll
        for (int a = 0; a < 2; ++a)
#pragma unroll
            for (int b = 0; b < 2; ++b)
#pragma unroll
                for (int m = 0; m < 4; ++m)
#pragma unroll
                    for (int n = 0; n < 2; ++n) acc[a][b][m][n] = (f32x4){0.f, 0.f, 0.f, 0.f};
        cur = nxt; cA = nA; cB = nB; ++ui;
        if constexpr (ALIGN_EPI) { if (wr == 1) PG8_BAR; }
    }
    PG8_WAIT_V(0);
    if constexpr (!ALIGN_EPI) { if (wr == 0) PG8_BAR; }
    PG8_BAR;
    if constexpr (Epi::AFTER_DRAIN) { E.fused(acc, cur, wr, wc, fr, fq, lds, wid, lane); S.done(cur); }
#undef PG8_SA
#undef PG8_SB
#undef PG8_STAGE
#undef PG8_LDA
#undef PG8_LDB
#undef PG8_MMA
#undef PG8_WAIT_V
#undef PG8_WAIT_L
#undef PG8_BAR
#undef PG8_SCHED
}
}


namespace {
constexpr int B_ = 8, S_ = 4096, M_ = B_ * S_, D_ = 1024, DIN = 4288, DFF = 4096;
constexpr int C_QA = 0, C_QB = 512, C_QI = 1024, C_KVB = 1280, C_KA = 2048, C_VA = 2112, C_KI = 2176, C_WI = 2208, C_GB = 2216, C_GATE = 2304;
constexpr int NC = 255;
constexpr float EPS = 1e-6f;
using pg8::PW;
#define GAS __attribute__((address_space(1)))
#define LAS __attribute__((address_space(3)))
typedef unsigned v4u __attribute__((ext_vector_type(4)));
typedef float f32x4 __attribute__((ext_vector_type(4)));

__device__ __forceinline__ int t5_bucket(int n) {
    if (n < 16) return n < 0 ? 0 : n;
    float nf = (float)n;
    int large = 16 + (int)(logf(nf / 16.f) / logf(8.f) * 16.f);
    return large < 31 ? large : 31;
}


__device__ __forceinline__ int win_src_col(int n) {
    if (n < 512) return n;
    if (n < 1024) return 936 + (n - 512);
    if (n < 1280) return 640 + (n - 1024);
    if (n < 2048) return 1448 + (n - 1280);
    if (n < 2112) return 512 + (n - 2048);
    if (n < 2176) return 576 + (n - 2112);
    if (n < 2208) return 896 + (n - 2176);
    if (n < 2216) return 928 + (n - 2208);
    if (n < 2240) return n;
    if (n < 2304) return -1;
    return 2240 + (n - 2304);
}
__device__ __forceinline__ float wave_sum(float v) {
#pragma unroll
    for (int o = 1; o < 64; o <<= 1) v += __shfl_xor(v, o);
    return v;
}
template <bool MAP>
__device__ __forceinline__ void transpose_item(const float* __restrict__ W, int K, int Nsrc, int Ndst, _Float16* __restrict__ WT, const float* __restrict__ gain, float* scr, int item, int lane, int dpitch = 0, int koff = 0) {
    const int nblk = Ndst / 32, kb = item / nblk, nb = item % nblk, k0 = 64 * kb, n0 = 32 * nb;
    const int nd = n0 + (lane & 31); const int ns = MAP ? win_src_col(nd) : nd;
#pragma unroll 8
    for (int i = 0; i < 32; ++i) { const int kk = 2 * i + (lane >> 5); float v = 0.f;
        if (ns >= 0) { v = W[(size_t)(k0 + kk) * Nsrc + ns]; if (gain) v *= gain[k0 + kk]; }
        scr[kk * 33 + (lane & 31)] = v; }
    __builtin_amdgcn_s_waitcnt(0xc07f); asm volatile("" ::: "memory");
    const int c = lane & 7;
#pragma unroll
    for (int j = 0; j < 4; ++j) { const int n = (lane >> 3) + 8 * j; const float* s = scr + (8 * c) * 33 + n;
        v4u o; o.x = pg8::pkh(s[0 * 33], s[1 * 33]); o.y = pg8::pkh(s[2 * 33], s[3 * 33]); o.z = pg8::pkh(s[4 * 33], s[5 * 33]); o.w = pg8::pkh(s[6 * 33], s[7 * 33]);
        *(v4u*)(WT + (size_t)(n0 + n) * (dpitch ? dpitch : K) + koff + k0 + 8 * c) = o; }
    __builtin_amdgcn_s_waitcnt(0xc07f); asm volatile("" ::: "memory");
}
__device__ __forceinline__ void rms_row_to_f16(const float* __restrict__ xrow, _Float16* __restrict__ orow, int lane) {
    const f32x4* xr = (const f32x4*)xrow + lane;
    f32x4 v[4]; float s = 0.f;
#pragma unroll
    for (int j = 0; j < 4; ++j) { v[j] = xr[64 * j]; s += (v[j].x * v[j].x + v[j].y * v[j].y) + (v[j].z * v[j].z + v[j].w * v[j].w); }
    const float rstd = rsqrtf(wave_sum(s) * (1.f / D_) + EPS);
    unsigned long long* o8 = (unsigned long long*)orow + lane;
#pragma unroll
    for (int j = 0; j < 4; ++j) o8[64 * j] = (unsigned long long)pg8::pkh(v[j].x * rstd, v[j].y * rstd) | ((unsigned long long)pg8::pkh(v[j].z * rstd, v[j].w * rstd) << 32);
}

struct Args {
    const float* x; const float* norm_mix; const float* w_in; const float* pe_k; const float* w1_k; const float* w2_k; const float* pe_v; const float* w1_v; const float* w2_v;
    const float* rel_bias; const float* w_ba; const float* w_bb; const float* w_out; const float* norm_mlp; const float* w_mi; const float* w_mo; const float* norm_final;
    float* out; unsigned char* ws;
};
constexpr size_t MiB = 1u << 20;
constexpr size_t WS_PCNT = 32768, WS_XBUF = 524288;
constexpr size_t WS_ROWSQ = 65536, WS_ROWSQ2 = 196608;
constexpr size_t WS_CTL = 0, WS_WIN = 1 * MiB, WS_WBA = 10 * MiB, WS_WBB = 11 * MiB, WS_WOUT = 12 * MiB, WS_WMI = 14 * MiB, WS_WMO = 22 * MiB, WS_CW = 30 * MiB,
                 WS_KCMP = 32 * MiB, WS_VCMP = 33 * MiB, WS_H = 34 * MiB, WS_PROJ = 98 * MiB, WS_MIX = 370 * MiB, WS_END = 434 * MiB;

__device__ __forceinline__ void prologue_body(const Args& a, unsigned char* lds) {
    const int tid = threadIdx.x, lane = tid & 63, wave = tid >> 6;
    float* scr = (float*)(lds + wave * 8704);
    const int gw = blockIdx.x * 8 + wave, NGW = gridDim.x * 8;
    constexpr int I_IN = (D_ / 64) * (PW / 32), I_BA = (512 / 64) * (D_ / 32), I_OUT = (D_ / 64) * (D_ / 32), I_MI = (D_ / 64) * (DFF / 32), I_MO = (DFF / 64) * (D_ / 32);
    constexpr int I_C1 = (2048 / 64) * (128 / 32), I_C2 = (128 / 64) * (64 / 32);
    constexpr int NITEMS = I_IN + 2 * I_BA + I_OUT + I_MI + I_MO + 2 * I_C1 + 2 * I_C2;
    for (int it = gw; it < NITEMS; it += NGW) {
        int r = it;
        if (r < I_IN) { transpose_item<true>(a.w_in, D_, DIN, PW, (_Float16*)(a.ws + WS_WIN), a.norm_mix, scr, r, lane); continue; } r -= I_IN;
        if (r < I_BA) { transpose_item<false>(a.w_ba, 512, D_, D_, (_Float16*)(a.ws + WS_WBA), nullptr, scr, r, lane, 1024, 0); continue; } r -= I_BA;
        if (r < I_BA) { transpose_item<false>(a.w_bb, 512, D_, D_, (_Float16*)(a.ws + WS_WBA), nullptr, scr, r, lane, 1024, 512); continue; } r -= I_BA;
        if (r < I_OUT) { transpose_item<false>(a.w_out, D_, D_, D_, (_Float16*)(a.ws + WS_WOUT), nullptr, scr, r, lane); continue; } r -= I_OUT;
        if (r < I_MI) { transpose_item<false>(a.w_mi, D_, DFF, DFF, (_Float16*)(a.ws + WS_WMI), a.norm_mlp, scr, r, lane); continue; } r -= I_MI;
        if (r < I_MO) { transpose_item<false>(a.w_mo, DFF, D_, D_, (_Float16*)(a.ws + WS_WMO), nullptr, scr, r, lane); continue; } r -= I_MO;
        if (r < I_C1) { transpose_item<false>(a.w1_k, 2048, 128, 128, (_Float16*)(a.ws + WS_CW), nullptr, scr, r, lane); continue; } r -= I_C1;
        if (r < I_C1) { transpose_item<false>(a.w1_v, 2048, 128, 128, (_Float16*)(a.ws + WS_CW + 512 * 1024), nullptr, scr, r, lane); continue; } r -= I_C1;
        if (r < I_C2) { transpose_item<false>(a.w2_k, 128, 64, 64, (_Float16*)(a.ws + WS_CW + 1024 * 1024), nullptr, scr, r, lane); continue; } r -= I_C2;
        transpose_item<false>(a.w2_v, 128, 64, 64, (_Float16*)(a.ws + WS_CW + 1024 * 1024 + 16384), nullptr, scr, r, lane);
    }
#pragma unroll 4
    for (int m = gw; m < M_; m += NGW) rms_row_to_f16(a.x + (size_t)m * D_, (_Float16*)(a.ws + WS_H) + (size_t)m * D_, lane);
}
struct EpiAccOut {
    static constexpr bool PERM = true, AFTER_DRAIN = false, MID = false;
    _Float16* x2h; const _Float16* xh; float* rowsq;
    __device__ __forceinline__ void operator()(const f32x4 (&acc)[2][2][4][2], const pg8::Unit& u, int wr, int wc, int fr, int fq) const {
        const int row0 = u.pm * 256 + wr * 64 + fr, col0 = u.pn * 256 + wc * 32 + 8 * fq;
#pragma unroll
        for (int ai = 0; ai < 2; ++ai)
#pragma unroll
            for (int m = 0; m < 4; ++m) { const size_t r = (size_t)(row0 + ai * 128 + m * 16); float sq = 0.f;
#pragma unroll
                for (int bj = 0; bj < 2; ++bj) { const size_t o = r * 1024 + col0 + bj * 128;
                    float p[8]; pg8::unpk8(*(const pg8::u32x4*)(xh + o), p);
                    const f32x4 a0 = acc[ai][bj][m][0], a1 = acc[ai][bj][m][1];
                    const float v[8] = {p[0] + a0[0], p[1] + a0[1], p[2] + a0[2], p[3] + a0[3], p[4] + a1[0], p[5] + a1[1], p[6] + a1[2], p[7] + a1[3]};
                    pg8::u32x4 w; w.x = pg8::pkh(v[0], v[1]); w.y = pg8::pkh(v[2], v[3]); w.z = pg8::pkh(v[4], v[5]); w.w = pg8::pkh(v[6], v[7]);
                    *(pg8::u32x4*)(x2h + o) = w;
                    sq += (v[0] * v[0] + v[1] * v[1]) + (v[2] * v[2] + v[3] * v[3]) + (v[4] * v[4] + v[5] * v[5]) + (v[6] * v[6] + v[7] * v[7]); }
                sq += __shfl_xor(sq, 16); sq += __shfl_xor(sq, 32);
                if (fq == 0) atomicAdd(rowsq + r, sq); }
    }
};
__device__ __forceinline__ void final_scale_row(const _Float16* __restrict__ xrow, float* __restrict__ orow, const float* __restrict__ g, float rsq, int lane) {
    const float rstd = rsqrtf(rsq * (1.f / D_) + EPS);
#pragma unroll
    for (int j = 0; j < 2; ++j) {
        float p[8]; pg8::unpk8(*((const pg8::u32x4*)xrow + lane + 64 * j), p);
        const f32x4 g0 = *((const f32x4*)g + 2 * (lane + 64 * j)), g1 = *((const f32x4*)g + 2 * (lane + 64 * j) + 1);
        *((f32x4*)orow + 2 * (lane + 64 * j)) = (f32x4){p[0] * rstd * g0.x, p[1] * rstd * g0.y, p[2] * rstd * g0.z, p[3] * rstd * g0.w};
        *((f32x4*)orow + 2 * (lane + 64 * j) + 1) = (f32x4){p[4] * rstd * g1.x, p[5] * rstd * g1.y, p[6] * rstd * g1.z, p[7] * rstd * g1.w};
    }
}

struct SliceOrder {
    pg8::StaticOrder S; int slice;
    __device__ bool next(int i, pg8::Unit& u) const { return i == 0 ? S.next(slice, u) : false; }
    __device__ __forceinline__ void a_ready(const pg8::Unit&) const {}
    __device__ __forceinline__ void done(const pg8::Unit&) const {}
};
struct EpiFinalNorm {
    static constexpr bool PERM = true, AFTER_DRAIN = true, MID = false;
    float* out; const _Float16* xh; const float* g; float* xbuf; unsigned* cnt;
    __device__ __forceinline__ void fused(f32x4 (&acc)[2][2][4][2], const pg8::Unit& u, int wr, int wc, int fr, int fq, PG8_LAS unsigned char* lds, int wid, int lane) const {
        const int rl0 = wr * 64 + fr, col0 = u.pn * 256 + wc * 32 + 8 * fq;
        PG8_LAS float* red = (PG8_LAS float*)lds;
#pragma unroll
        for (int ai = 0; ai < 2; ++ai)
#pragma unroll
            for (int m = 0; m < 4; ++m) { const int rl = rl0 + ai * 128 + m * 16; const size_t r = (size_t)(u.pm * 256 + rl); float sq = 0.f;
#pragma unroll
                for (int bj = 0; bj < 2; ++bj) { float p[8]; pg8::unpk8(*(const pg8::u32x4*)(xh + r * 1024 + col0 + bj * 128), p);
#pragma unroll
                    for (int i = 0; i < 4; ++i) { acc[ai][bj][m][0][i] += p[i]; acc[ai][bj][m][1][i] += p[4 + i];
                        sq = fmaf(acc[ai][bj][m][0][i], acc[ai][bj][m][0][i], sq); sq = fmaf(acc[ai][bj][m][1][i], acc[ai][bj][m][1][i], sq); } }
                sq += __shfl_xor(sq, 16); sq += __shfl_xor(sq, 32);
                if (fq == 0) red[wc * 256 + rl] = sq; }
        __syncthreads();
        const int tid = wid * 64 + lane;
        if (tid < 256) { const float tot = (red[tid] + red[256 + tid]) + (red[512 + tid] + red[768 + tid]);
            __hip_atomic_store(xbuf + ((size_t)u.pm * 4 + u.pn) * 256 + tid, tot, __ATOMIC_RELAXED, __HIP_MEMORY_SCOPE_AGENT); }
        asm volatile("s_waitcnt vmcnt(0)" ::: "memory");
        __syncthreads();
        if (tid == 0) { __hip_atomic_fetch_add(cnt + u.pm, 1u, __ATOMIC_RELAXED, __HIP_MEMORY_SCOPE_AGENT);
            unsigned sp = 0; while (__hip_atomic_load(cnt + u.pm, __ATOMIC_RELAXED, __HIP_MEMORY_SCOPE_AGENT) < 4u && ++sp < (1u << 22)) __builtin_amdgcn_s_sleep(1); }
        __syncthreads();
        if (tid < 256) { float tot = 0.f;
#pragma unroll
            for (int q = 0; q < 4; ++q) tot += __hip_atomic_load(xbuf + ((size_t)u.pm * 4 + q) * 256 + tid, __ATOMIC_RELAXED, __HIP_MEMORY_SCOPE_AGENT);
            red[1024 + tid] = rsqrtf(tot * (1.f / 1024.f) + 1e-6f); }
        __syncthreads();
#pragma unroll
        for (int ai = 0; ai < 2; ++ai)
#pragma unroll
            for (int m = 0; m < 4; ++m) { const int rl = rl0 + ai * 128 + m * 16; const size_t r = (size_t)(u.pm * 256 + rl); const float rstd = red[1024 + rl];
#pragma unroll
                for (int bj = 0; bj < 2; ++bj) { const int c = col0 + bj * 128; const f32x4 g0 = *(const f32x4*)(g + c), g1 = *(const f32x4*)(g + c + 4);
                    *(f32x4*)(out + r * 1024 + c) = acc[ai][bj][m][0] * rstd * g0; *(f32x4*)(out + r * 1024 + c + 4) = acc[ai][bj][m][1] * rstd * g1; } }
        __syncthreads();
    }
};

namespace dsa {
typedef _Float16 f16x8 __attribute__((ext_vector_type(8)));
typedef _Float16 f16x4 __attribute__((ext_vector_type(4)));
typedef short s16x4 __attribute__((ext_vector_type(4)));
typedef float f32x4 __attribute__((ext_vector_type(4)));
typedef unsigned u32x4 __attribute__((ext_vector_type(4)));
typedef unsigned u32x2 __attribute__((ext_vector_type(2)));
constexpr int TQ = 16, NBIN = 2048, CANDCAP = 512, VPITCH = 144;
constexpr int L_HIST = 0, L_SEL = 65536, L_SELD = L_SEL + 8192, L_CTL = L_SELD + 8192, L_BIAS = L_CTL + 512, L_VST = L_BIAS + 4096, L_END = L_VST + 8 * 32 * VPITCH;
static_assert(L_END <= 131072, "dsa LDS");

__device__ __forceinline__ float idx_score(const f32x4 a1, const f32x4 a2, float lin, const float (&wh)[8]) {
    float s = fmaf(wh[0], fabsf(a1.x), lin);
    s = fmaf(wh[1], fabsf(a1.y), s); s = fmaf(wh[2], fabsf(a1.z), s); s = fmaf(wh[3], fabsf(a1.w), s);
    s = fmaf(wh[4], fabsf(a2.x), s); s = fmaf(wh[5], fabsf(a2.y), s); s = fmaf(wh[6], fabsf(a2.z), s); s = fmaf(wh[7], fabsf(a2.w), s);
    return s;
}
__device__ __forceinline__ int score_bin(float sc, float inv) { int b = (int)(fmaf(sc, inv, 1024.f)); b = b < 0 ? 0 : b; return b > NBIN - 1 ? NBIN - 1 : b; }

template <int PASS>
__device__ __forceinline__ void score_pass(LAS unsigned char* lds, const _Float16* __restrict__ proj, int b, int t0, int nkb, int wave, int lane,
                                           const f16x8 (&afr)[4][2], const f16x8 alin, const float (&wq)[4][8], const float (&binv)[4]) {
    LAS unsigned* hist = (LAS unsigned*)(lds + L_HIST);
    LAS unsigned short* sel = (LAS unsigned short*)(lds + L_SEL);
    LAS unsigned short* seld = (LAS unsigned short*)(lds + L_SELD);
    LAS u32x2* cand = (LAS u32x2*)(lds + L_HIST);
    LAS int* ctl = (LAS int*)(lds + L_CTL);
    const int kc = lane >> 4, n16 = lane & 15;
    int bst[4];
#pragma unroll
    for (int grp = 0; grp < 4; ++grp) bst[grp] = (PASS == 2) ? ctl[(4 * grp + kc) * 8 + 2] : 0;
    const f32x4 zero = {0.f, 0.f, 0.f, 0.f};
    const _Float16* kbase = proj + (size_t)(b * S_ + n16) * PW + C_KI + 8 * kc;
    f16x8 bnext = *(const f16x8*)(kbase + (size_t)(16 * (wave < nkb ? wave : 0)) * PW);
    for (int kb = wave; kb < nkb; kb += 8) {
        const f16x8 bfr = bnext;
        { const int kn = kb + 8 < nkb ? kb + 8 : kb; bnext = *(const f16x8*)(kbase + (size_t)(16 * kn) * PW); }
        const int s = 16 * kb + n16;
        const bool lastkb = kb == nkb - 1;
        const f32x4 a3 = __builtin_amdgcn_mfma_f32_16x16x32_f16(alin, bfr, zero, 0, 0, 0);
        const float lin4[4] = {a3.x, a3.y, a3.z, a3.w};
#pragma unroll
        for (int grp = 0; grp < 4; ++grp) {
            const f32x4 a1 = __builtin_amdgcn_mfma_f32_16x16x32_f16(afr[grp][0], bfr, zero, 0, 0, 0);
            const f32x4 a2 = __builtin_amdgcn_mfma_f32_16x16x32_f16(afr[grp][1], bfr, zero, 0, 0, 0);
            const float sc = idx_score(a1, a2, lin4[grp], wq[grp]);
            const int row = 4 * grp + kc, t = t0 + row;
            if (!lastkb || s <= t) {
                const int bin = score_bin(sc, binv[grp]);
                if (PASS == 1) { __hip_atomic_fetch_add(hist + row * 1024 + (bin >> 1), (bin & 1) ? 0x10000u : 1u, __ATOMIC_RELAXED, __HIP_MEMORY_SCOPE_WORKGROUP); }
                else {
                    if (bin > bst[grp]) { const int pos = __hip_atomic_fetch_add(ctl + row * 8 + 0, 1, __ATOMIC_RELAXED, __HIP_MEMORY_SCOPE_WORKGROUP); sel[row * 256 + (pos & 255)] = (unsigned short)s;
                        const int dd = t - s; seld[row * 256 + (pos & 255)] = (unsigned short)((dd > 127 ? 127 : dd) * 32); }
                    else if (bin == bst[grp]) { const int pos = __hip_atomic_fetch_add(ctl + row * 8 + 1, 1, __ATOMIC_RELAXED, __HIP_MEMORY_SCOPE_WORKGROUP);
                        if (pos < CANDCAP) { u32x2 e; e.x = __float_as_uint(sc); e.y = (unsigned)s; cand[row * CANDCAP + pos] = e; } }
                }
            }
        }
    }
}

__device__ __forceinline__ void dsa_tile(LAS unsigned char* lds, const _Float16* __restrict__ proj, _Float16* __restrict__ o_a, int b, int qt) {
    int tid_ = threadIdx.x; asm volatile("" : "+v"(tid_));
    const int tid = tid_, lane = tid & 63, wave = __builtin_amdgcn_readfirstlane(tid >> 6);
    const int kc = lane >> 4, n16 = lane & 15;
    const int t0 = qt * TQ, nkb = qt + 1;
    LAS unsigned* hist = (LAS unsigned*)(lds + L_HIST);
    LAS unsigned short* sel = (LAS unsigned short*)(lds + L_SEL);
    LAS u32x2* cand = (LAS u32x2*)(lds + L_HIST);
    LAS int* ctl = (LAS int*)(lds + L_CTL);
    LAS float* biaslut = (LAS float*)(lds + L_BIAS);
    for (int i = tid; i < (TQ * 1024 + 4096) / 4; i += 512) ((LAS u32x4*)hist)[i] = (u32x4){0u, 0u, 0u, 0u};
    if (tid < TQ * 8) ctl[tid] = 0;
    f16x8 afr[4][2]; f16x8 alin; float wq[4][8]; float binv[4];
    { const int g = n16 >> 2, r = n16 & 3;
      { const int qq = 4 * r + g; const _Float16* qrow = proj + (size_t)(b * S_ + t0 + qq) * PW;
        const f16x8 wg = *(const f16x8*)(qrow + C_WI);
        float lin[8];
#pragma unroll
        for (int e = 0; e < 8; ++e) lin[e] = 0.f;
#pragma unroll
        for (int h = 0; h < 8; ++h) { const f16x8 qh = *(const f16x8*)(qrow + C_QI + h * 32 + 8 * kc); const float wh = (float)wg[h] * (0.5f / 16.f);
#pragma unroll
            for (int e = 0; e < 8; ++e) lin[e] = fmaf(wh, (float)qh[e], lin[e]); }
#pragma unroll
        for (int e = 0; e < 8; ++e) alin[e] = (_Float16)lin[e]; }
#pragma unroll
      for (int grp = 0; grp < 4; ++grp) {
          const _Float16* qrow = proj + (size_t)(b * S_ + t0 + 4 * grp + g) * PW + C_QI;
          afr[grp][0] = *(const f16x8*)(qrow + r * 32 + 8 * kc);
          afr[grp][1] = *(const f16x8*)(qrow + (4 + r) * 32 + 8 * kc);
          const f16x8 wv = *(const f16x8*)(proj + (size_t)(b * S_ + t0 + 4 * grp + kc) * PW + C_WI);
          float ss = 0.f;
#pragma unroll
          for (int h = 0; h < 8; ++h) { const float wfull = (float)wv[h] * (1.f / 16.f); wq[grp][h] = 0.5f * wfull; ss = fmaf(wfull, wfull, ss); }
          binv[grp] = 32.f * rsqrtf(ss + 1e-12f);
      } }
    __syncthreads();
    score_pass<1>(lds, proj, b, t0, nkb, wave, lane, afr, alin, wq, binv);
    __syncthreads();
#pragma unroll 1
    for (int i = 0; i < 2; ++i) {
        const int row = 2 * wave + i, n = t0 + row + 1;
        if (n <= 256) { if (lane == 0) { ctl[row * 8 + 2] = -1; ctl[row * 8 + 3] = 0; } }
        else {
            const LAS u32x4* hp = (const LAS u32x4*)(hist + row * 1024 + 16 * lane);
            unsigned tot = 0;
#pragma unroll
            for (int q4 = 0; q4 < 4; ++q4) { const u32x4 hv = hp[q4];
                tot += (hv.x & 0xffffu) + (hv.x >> 16) + (hv.y & 0xffffu) + (hv.y >> 16) + (hv.z & 0xffffu) + (hv.z >> 16) + (hv.w & 0xffffu) + (hv.w >> 16); }
            unsigned suf = tot;
#pragma unroll
            for (int o = 1; o < 64; o <<= 1) { const unsigned v = __shfl_down(suf, o); if (lane + o < 64) suf += v; }
            const unsigned above_lane = suf - tot;
            const unsigned long long cross = __ballot(above_lane < 256u && suf >= 256u);
            const int lx = __builtin_ctzll(cross);
            const unsigned abovex = __shfl(above_lane, lx);
            const unsigned c2 = lane < 32 ? (unsigned)((const LAS unsigned short*)hist)[row * 2048 + 32 * lx + lane] : 0u;
            unsigned suf2 = c2;
#pragma unroll
            for (int o = 1; o < 32; o <<= 1) { const unsigned v = __shfl_down(suf2, o); if (lane + o < 32) suf2 += v; }
            const unsigned above2 = abovex + suf2 - c2;
            if (lane < 32 && above2 < 256u && above2 + c2 >= 256u) {
                const int bs = 32 * lx + lane; const unsigned cum = above2;
                ctl[row * 8 + 2] = bs; ctl[row * 8 + 3] = 256 - (int)cum;
            }
        }
    }
    __syncthreads();
    score_pass<2>(lds, proj, b, t0, nkb, wave, lane, afr, alin, wq, binv);
    __syncthreads();
#pragma unroll 1
    for (int i = 0; i < 2; ++i) {
        const int row = 2 * wave + i, n = t0 + row + 1;
        const int need = ctl[row * 8 + 3], base = ctl[row * 8 + 0];
        int nc = ctl[row * 8 + 1];
        nc = nc < CANDCAP ? nc : CANDCAP;
        if (lane == 0) { const int nf = base + (need < nc ? need : nc); ctl[row * 8 + 4] = n <= 256 ? n : (nf < 256 ? nf : 256); }
        if (need > 0) {
            for (int c0 = 0; c0 < nc; c0 += 64) {
                const int ci = c0 + lane; const bool act = ci < nc;
                const u32x2 me = cand[row * CANDCAP + (act ? ci : 0)];
                const float msc = __uint_as_float(me.x); int rank = 0;
                for (int j = 0; j < nc; ++j) { const u32x2 ot = cand[row * CANDCAP + j]; const float osc = __uint_as_float(ot.x);
                    rank += (osc > msc || (osc == msc && ot.y < me.y)) ? 1 : 0; }
                if (act && rank < need) { sel[row * 256 + ((base + rank) & 255)] = (unsigned short)me.y; const int dd = t0 + row - (int)me.y; ((LAS unsigned short*)(lds + L_SELD))[row * 256 + ((base + rank) & 255)] = (unsigned short)((dd > 127 ? 127 : dd) * 32); }
            }
        }
    }
    __syncthreads();
    int tq_ = threadIdx.x; asm volatile("" : "+v"(tq_));
    const int lane_a = tq_ & 63;
    LAS unsigned char* vst = lds + L_VST + wave * (32 * VPITCH);
#pragma unroll 1
    for (int i = 0; i < 2; ++i) { const int lane = lane_a, kc = lane >> 4, n16 = lane & 15;
        const int row = 2 * wave + i, t = t0 + row; const int nvalid = ctl[row * 8 + 4];
        const _Float16* qrow = proj + (size_t)(b * S_ + t) * PW + C_QA;
        const int head = n16, hm = head & 7;
        f16x8 qb0, qb1;
        { const f16x8 z = {0, 0, 0, 0, 0, 0, 0, 0}; qb0 = z; qb1 = z;
          if (head < 8) { qb0 = *(const f16x8*)(qrow + head * 64 + 8 * kc); qb1 = *(const f16x8*)(qrow + head * 64 + 32 + 8 * kc); } }
        f32x4 ot[4];
#pragma unroll
        for (int dt = 0; dt < 4; ++dt) ot[dt] = (f32x4){0.f, 0.f, 0.f, 0.f};
        float mrun = -INFINITY, lrun = 0.f;
        const LAS unsigned short* selr = sel + row * 256;
        const LAS unsigned short* seldr = (const LAS unsigned short*)(lds + L_SELD) + row * 256;
        const LAS unsigned char* biasb = lds + L_BIAS + hm * 4;
        const _Float16* pbat = proj + (size_t)(b * S_) * PW;
        LAS unsigned char* kst = lds + L_HIST + wave * (32 * VPITCH);
        u32x4 gk[4], gv[4];
        const char* pbyte = (const char*)pbat;
#define DSA_GATHER(jj) do { _Pragma("unroll") for (int i_ = 0; i_ < 4; ++i_) { const int pos_ = 32 * (jj) + 8 * i_ + (lane >> 3); \
            const unsigned idx_ = pos_ < nvalid ? (unsigned)selr[pos_] : 0u; const char* rp_ = pbyte + (size_t)(idx_ * (unsigned)(PW * 2) + (unsigned)(C_KA * 2 + 16 * (lane & 7))); \
            gk[i_] = *(const u32x4*)rp_; gv[i_] = *(const u32x4*)(rp_ + 128); } } while (0)
        DSA_GATHER(0);
        const int nsteps = (nvalid + 31) >> 5;
#pragma unroll 1
        for (int j = 0; j < nsteps; ++j) {
#pragma unroll
            for (int i_ = 0; i_ < 4; ++i_) { const int ro = (8 * i_ + (lane >> 3)) * VPITCH + 16 * (lane & 7);
                *(LAS u32x4*)(kst + ro) = gk[i_]; *(LAS u32x4*)(vst + ro) = gv[i_]; }
            if (j + 1 < nsteps) DSA_GATHER(j + 1);
            asm volatile("s_waitcnt lgkmcnt(0)" ::: "memory");
            const f16x8 ca0 = *(const LAS f16x8*)(kst + n16 * VPITCH + 16 * kc), ca1 = *(const LAS f16x8*)(kst + n16 * VPITCH + 64 + 16 * kc);
            const f16x8 cb0 = *(const LAS f16x8*)(kst + (16 + n16) * VPITCH + 16 * kc), cb1 = *(const LAS f16x8*)(kst + (16 + n16) * VPITCH + 64 + 16 * kc);
            f32x4 sa = {0.f, 0.f, 0.f, 0.f}, sb = {0.f, 0.f, 0.f, 0.f};
            sa = __builtin_amdgcn_mfma_f32_16x16x32_f16(ca0, qb0, sa, 0, 0, 0); sa = __builtin_amdgcn_mfma_f32_16x16x32_f16(ca1, qb1, sa, 0, 0, 0);
            sb = __builtin_amdgcn_mfma_f32_16x16x32_f16(cb0, qb0, sb, 0, 0, 0); sb = __builtin_amdgcn_mfma_f32_16x16x32_f16(cb1, qb1, sb, 0, 0, 0);
            const int p0 = 32 * j + 4 * kc;
            const u32x2 iwa = *(const LAS u32x2*)(seldr + p0), iwb = *(const LAS u32x2*)(seldr + p0 + 16);
            const unsigned wa0 = iwa.x, wa1 = iwa.y, wb0 = iwb.x, wb1 = iwb.y;
            const unsigned bo[8] = {wa0 & 0xffffu, wa0 >> 16, wa1 & 0xffffu, wa1 >> 16, wb0 & 0xffffu, wb0 >> 16, wb1 & 0xffffu, wb1 >> 16};
            float v[8] = {sa.x, sa.y, sa.z, sa.w, sb.x, sb.y, sb.z, sb.w};
            float tm = -INFINITY;
#pragma unroll
            for (int e = 0; e < 8; ++e) {
                const bool ok = (p0 + (e & 3) + 16 * (e >> 2)) < nvalid;
                const float lg = v[e] * 0.125f + *(const LAS float*)(biasb + bo[e]);
                v[e] = ok ? lg : -INFINITY; tm = fmaxf(tm, v[e]);
            }
            tm = fmaxf(tm, __shfl_xor(tm, 16)); tm = fmaxf(tm, __shfl_xor(tm, 32));
            const float mn = fmaxf(mrun, tm);
            const float alpha = __expf(mrun - mn);
            float ps = 0.f;
#pragma unroll
            for (int e = 0; e < 8; ++e) { v[e] = __expf(v[e] - mn); ps += v[e]; }
            lrun = lrun * alpha + ps; mrun = mn;
#pragma unroll
            for (int dt = 0; dt < 4; ++dt) ot[dt] = ot[dt] * alpha;
            const f16x8 pfr = {(_Float16)v[0], (_Float16)v[1], (_Float16)v[2], (_Float16)v[3], (_Float16)v[4], (_Float16)v[5], (_Float16)v[6], (_Float16)v[7]};
            asm volatile("s_waitcnt lgkmcnt(0)" ::: "memory");
            const int q = n16 >> 2, p = n16 & 3;
#pragma unroll
            for (int dt = 0; dt < 4; ++dt) {
                const s16x4 ta = __builtin_amdgcn_ds_read_tr16_b64_v4i16((LAS s16x4*)(vst + (4 * kc + q) * VPITCH + (16 * dt + 4 * p) * 2));
                const s16x4 tb = __builtin_amdgcn_ds_read_tr16_b64_v4i16((LAS s16x4*)(vst + (16 + 4 * kc + q) * VPITCH + (16 * dt + 4 * p) * 2));
                const f16x4 fa = __builtin_bit_cast(f16x4, ta), fb = __builtin_bit_cast(f16x4, tb);
                const f16x8 vfr = {fa.x, fa.y, fa.z, fa.w, fb.x, fb.y, fb.z, fb.w};
                ot[dt] = __builtin_amdgcn_mfma_f32_16x16x32_f16(vfr, pfr, ot[dt], 0, 0, 0);
            }
            asm volatile("s_waitcnt lgkmcnt(0)" ::: "memory");
        }
#undef DSA_GATHER
        lrun += __shfl_xor(lrun, 16); lrun += __shfl_xor(lrun, 32);
        const float inv = 1.f / fmaxf(lrun, 1e-30f);
        if (head < 8) {
            _Float16* orow = o_a + (size_t)(b * S_ + t) * 1024 + head * 64 + 4 * kc;
#pragma unroll
            for (int dt = 0; dt < 4; ++dt) { u32x2 w; w.x = pg8::pkh(ot[dt].x * inv, ot[dt].y * inv); w.y = pg8::pkh(ot[dt].z * inv, ot[dt].w * inv); *(u32x2*)(orow + 16 * dt) = w; }
        }
    }
    __syncthreads();
}
}


namespace nsa {
typedef _Float16 f16x8 __attribute__((ext_vector_type(8)));
typedef _Float16 f16x4 __attribute__((ext_vector_type(4)));
typedef short s16x4 __attribute__((ext_vector_type(4)));
typedef float f32x4 __attribute__((ext_vector_type(4)));
typedef float f32x16 __attribute__((ext_vector_type(16)));
typedef unsigned u32x4 __attribute__((ext_vector_type(4)));
typedef unsigned u32x2 __attribute__((ext_vector_type(2)));
constexpr int KP = 144, VP = 192;
constexpr int TILE_B = 64 * KP + 64 * VP;
constexpr int L_T0 = 0, L_BIAS = 2 * TILE_B, L_IMPA = L_BIAS + 4096, L_IMPC = L_IMPA + 16384, L_MASK = L_IMPC + 16384, L_END = L_MASK + 512;
static_assert(L_END <= 131072, "nsa LDS");
constexpr float LOG2E = 1.4426950408889634f;
constexpr float SC = 0.125f * LOG2E;

struct Src { const _Float16* k; const _Float16* v; int pitch; };

struct Stage { u32x4 kr, vr; };
__device__ __forceinline__ void stage_load(Stage& st, const Src& s, int row0, int tid, bool need_v) {
    const int r = tid >> 3, c = tid & 7;
    st.kr = *(const u32x4*)(s.k + (size_t)(row0 + r) * s.pitch + 8 * c);
    if (need_v) st.vr = *(const u32x4*)(s.v + (size_t)(row0 + r) * s.pitch + 8 * c);
}
__device__ __forceinline__ void stage_store(const Stage& st, LAS unsigned char* tb, int tid, bool need_v) {
    const int r = tid >> 3, c = tid & 7;
    *(LAS u32x4*)(tb + r * KP + 16 * c) = st.kr;
    if (need_v) *(LAS u32x4*)(tb + 64 * KP + r * VP + 16 * c) = st.vr;
}

struct RowState { float m, l; f32x16 o0, o1; };

__device__ __forceinline__ void qk_half(const LAS unsigned char* kt, const f16x8 (&qf)[4], int rho, int hi, int kh, f32x16& s0) {
#pragma unroll
    for (int i = 0; i < 16; ++i) s0[i] = 0.f;
    const LAS unsigned char* kb = kt + (32 * kh + rho) * KP + 16 * hi;
#pragma unroll
    for (int ks = 0; ks < 4; ++ks) {
        const f16x8 a0 = *(const LAS f16x8*)(kb + 32 * ks);
        s0 = __builtin_amdgcn_mfma_f32_32x32x16_f16(a0, qf[ks], s0, 0, 0, 0);
    }
}
__device__ __forceinline__ void logits(f32x16& s0, const LAS float* lut, int hb, int hi, int dbase, int dstep, int dlim, bool bit) {
#pragma unroll
    for (int rg = 0; rg < 16; ++rg) {
        const int kl = (rg & 3) + 8 * (rg >> 2) + 4 * hi;
        const int d = dbase - dstep * kl;
        int dc = d < 0 ? 0 : d; dc = dc > 127 ? 127 : dc;
        const float bias = lut[dc * 8 + hb];
        const bool ok = bit && d >= 0 && d < dlim;
        s0[rg] = ok ? fmaf(s0[rg], SC, bias) : -INFINITY;
    }
}
__device__ __forceinline__ void pv_half(RowState& rs, const f32x16& s0, const LAS unsigned char* vt, int rho, int hi, int kh) {
    const int l16 = rho & 15, g16 = rho >> 4, q = l16 >> 2, p = l16 & 3;
    const LAS unsigned char* vb = vt + (32 * kh + 4 * hi + q) * VP + (16 * g16 + 4 * p) * 2;
#pragma unroll
    for (int sx = 0; sx < 2; ++sx) {
        f16x8 pfr;
#pragma unroll
        for (int j = 0; j < 8; ++j) pfr[j] = (_Float16)s0[8 * sx + j];
#pragma unroll
        for (int dt = 0; dt < 2; ++dt) {
            const s16x4 ta = __builtin_amdgcn_ds_read_tr16_b64_v4i16((LAS s16x4*)(vb + (16 * sx) * VP + 64 * dt));
            const s16x4 tb = __builtin_amdgcn_ds_read_tr16_b64_v4i16((LAS s16x4*)(vb + (16 * sx + 8) * VP + 64 * dt));
            const f16x4 fa = __builtin_bit_cast(f16x4, ta), fb = __builtin_bit_cast(f16x4, tb);
            const f16x8 vfr = {fa.x, fa.y, fa.z, fa.w, fb.x, fb.y, fb.z, fb.w};
            if (dt == 0) rs.o0 = __builtin_amdgcn_mfma_f32_32x32x16_f16(vfr, pfr, rs.o0, 0, 0, 0);
            else rs.o1 = __builtin_amdgcn_mfma_f32_32x32x16_f16(vfr, pfr, rs.o1, 0, 0, 0);
        }
    }
}
__device__ __forceinline__ void rescale_if_needed(RowState& rs, float tmx) {
    if (__any(tmx > rs.m + 8.f)) {
        const float mn = fmaxf(rs.m, tmx);
        const float mu = (mn == -INFINITY) ? 0.f : mn;
        const float alpha = __builtin_amdgcn_exp2f(rs.m - mu);
        rs.l *= alpha; rs.m = mn;
#pragma unroll
        for (int i = 0; i < 16; ++i) { rs.o0[i] *= alpha; rs.o1[i] *= alpha; }
    }
}
__device__ __forceinline__ void tile_fast(RowState& rs, const LAS unsigned char* kt, const LAS unsigned char* vt, const f16x8 (&qf)[4], float c, int rho, int hi) {
    const LAS unsigned char* kb = kt + rho * KP + 16 * hi;
    f16x8 ka[4], kb2[4];
#pragma unroll
    for (int ks = 0; ks < 4; ++ks) { ka[ks] = *(const LAS f16x8*)(kb + 32 * ks); kb2[ks] = *(const LAS f16x8*)(kb + 32 * KP + 32 * ks); }
    const int l16 = rho & 15, g16 = rho >> 4, q = l16 >> 2, p = l16 & 3;
    const LAS unsigned char* vb = vt + (4 * hi + q) * VP + (16 * g16 + 4 * p) * 2;
    s16x4 va[4][2], vc[4][2];
    __builtin_amdgcn_sched_barrier(0);
    f32x16 s0, s1;
#pragma unroll
    for (int i = 0; i < 16; ++i) { s0[i] = 0.f; s1[i] = 0.f; }
#pragma unroll
    for (int ks = 0; ks < 4; ++ks) {
        s0 = __builtin_amdgcn_mfma_f32_32x32x16_f16(ka[ks], qf[ks], s0, 0, 0, 0);
        s1 = __builtin_amdgcn_mfma_f32_32x32x16_f16(kb2[ks], qf[ks], s1, 0, 0, 0);
    }
    __builtin_amdgcn_sched_barrier(0);
#pragma unroll
    for (int st = 0; st < 4; ++st)
#pragma unroll
        for (int dt = 0; dt < 2; ++dt) {
            va[st][dt] = __builtin_amdgcn_ds_read_tr16_b64_v4i16((LAS s16x4*)(vb + (16 * st) * VP + 64 * dt));
            vc[st][dt] = __builtin_amdgcn_ds_read_tr16_b64_v4i16((LAS s16x4*)(vb + (16 * st + 8) * VP + 64 * dt));
        }
    __builtin_amdgcn_sched_barrier(0);
    float tm = -INFINITY;
#pragma unroll
    for (int i = 0; i < 16; ++i) tm = fmaxf(tm, fmaxf(s0[i], s1[i]));
    { const auto r2 = __builtin_amdgcn_permlane32_swap(__float_as_uint(tm), __float_as_uint(tm), false, false); tm = fmaxf(__uint_as_float(r2[0]), __uint_as_float(r2[1])); }
    rescale_if_needed(rs, fmaf(tm, SC, c));
    const float mu = (rs.m == -INFINITY) ? 0.f : rs.m;
    const float cm = c - mu;
    float ps = 0.f;
#pragma unroll
    for (int i = 0; i < 16; ++i) { s0[i] = __builtin_amdgcn_exp2f(fmaf(s0[i], SC, cm)); s1[i] = __builtin_amdgcn_exp2f(fmaf(s1[i], SC, cm)); ps += s0[i] + s1[i]; }
    rs.l += ps;
#pragma unroll
    for (int st = 0; st < 4; ++st) {
        f16x8 pfr;
#pragma unroll
        for (int j = 0; j < 8; ++j) pfr[j] = (_Float16)((st & 2) ? s1[8 * (st & 1) + j] : s0[8 * (st & 1) + j]);
#pragma unroll
        for (int dt = 0; dt < 2; ++dt) {
            const f16x4 fa = __builtin_bit_cast(f16x4, va[st][dt]), fb = __builtin_bit_cast(f16x4, vc[st][dt]);
            const f16x8 vfr = {fa.x, fa.y, fa.z, fa.w, fb.x, fb.y, fb.z, fb.w};
            if (dt == 0) rs.o0 = __builtin_amdgcn_mfma_f32_32x32x16_f16(vfr, pfr, rs.o0, 0, 0, 0);
            else rs.o1 = __builtin_amdgcn_mfma_f32_32x32x16_f16(vfr, pfr, rs.o1, 0, 0, 0);
        }
    }
}
template <bool IMP>
__device__ __forceinline__ void tile_general(RowState& rs, const LAS unsigned char* kt, const LAS unsigned char* vt, const f16x8 (&qf)[4], const LAS float* lut, int hb, int rho, int hi,
                                             int dbase, int dstep, unsigned dlim, float mc, float invl, LAS float* impA, LAS float* impC, int n, bool wr) {
    const LAS unsigned char* kb = kt + rho * KP + 16 * hi;
    f16x8 ka[4], kb2[4];
#pragma unroll
    for (int ks = 0; ks < 4; ++ks) { ka[ks] = *(const LAS f16x8*)(kb + 32 * ks); kb2[ks] = *(const LAS f16x8*)(kb + 32 * KP + 32 * ks); }
    const int d0 = dbase - dstep * 4 * hi;
    __builtin_amdgcn_sched_barrier(0);
    f32x16 s0, s1;
#pragma unroll
    for (int i = 0; i < 16; ++i) { s0[i] = 0.f; s1[i] = 0.f; }
#pragma unroll
    for (int ks = 0; ks < 4; ++ks) {
        s0 = __builtin_amdgcn_mfma_f32_32x32x16_f16(ka[ks], qf[ks], s0, 0, 0, 0);
        s1 = __builtin_amdgcn_mfma_f32_32x32x16_f16(kb2[ks], qf[ks], s1, 0, 0, 0);
    }
    __builtin_amdgcn_sched_barrier(0);
    float b0[16], b1[16];
#pragma unroll
    for (int rg = 0; rg < 16; ++rg) {
        const int kl = (rg & 3) + 8 * (rg >> 2);
        int da = d0 - dstep * kl, db = d0 - dstep * (kl + 32);
        da = da < 0 ? 0 : da; da = da > 127 ? 127 : da; db = db < 0 ? 0 : db; db = db > 127 ? 127 : db;
        b0[rg] = lut[da * 8 + hb]; b1[rg] = lut[db * 8 + hb];
    }
    float tm = -INFINITY;
#pragma unroll
    for (int rg = 0; rg < 16; ++rg) {
        const int kl = (rg & 3) + 8 * (rg >> 2);
        const unsigned da = (unsigned)(d0 - dstep * kl), db = (unsigned)(d0 - dstep * (kl + 32));
        s0[rg] = da < dlim ? fmaf(s0[rg], SC, b0[rg]) : -INFINITY;
        s1[rg] = db < dlim ? fmaf(s1[rg], SC, b1[rg]) : -INFINITY;
        tm = fmaxf(tm, fmaxf(s0[rg], s1[rg]));
    }
    __builtin_amdgcn_sched_barrier(0);
    const int l16 = rho & 15, g16 = rho >> 4, q = l16 >> 2, p = l16 & 3;
    const LAS unsigned char* vb = vt + (4 * hi + q) * VP + (16 * g16 + 4 * p) * 2;
    s16x4 va[4][2], vc[4][2];
    if (!IMP) {
#pragma unroll
        for (int st = 0; st < 4; ++st)
#pragma unroll
            for (int dt = 0; dt < 2; ++dt) {
                va[st][dt] = __builtin_amdgcn_ds_read_tr16_b64_v4i16((LAS s16x4*)(vb + (16 * st) * VP + 64 * dt));
                vc[st][dt] = __builtin_amdgcn_ds_read_tr16_b64_v4i16((LAS s16x4*)(vb + (16 * st + 8) * VP + 64 * dt));
            }
        __builtin_amdgcn_sched_barrier(0);
    }
    if (!IMP) {
        { const auto r2 = __builtin_amdgcn_permlane32_swap(__float_as_uint(tm), __float_as_uint(tm), false, false); tm = fmaxf(__uint_as_float(r2[0]), __uint_as_float(r2[1])); }
        rescale_if_needed(rs, tm);
        const float mu = (rs.m == -INFINITY) ? 0.f : rs.m;
        float ps = 0.f;
#pragma unroll
        for (int i = 0; i < 16; ++i) { s0[i] = __builtin_amdgcn_exp2f(s0[i] - mu); s1[i] = __builtin_amdgcn_exp2f(s1[i] - mu); ps += s0[i] + s1[i]; }
        rs.l += ps;
#pragma unroll
        for (int st = 0; st < 4; ++st) {
            f16x8 pfr;
#pragma unroll
            for (int j = 0; j < 8; ++j) pfr[j] = (_Float16)((st & 2) ? s1[8 * (st & 1) + j] : s0[8 * (st & 1) + j]);
#pragma unroll
            for (int dt = 0; dt < 2; ++dt) {
                const f16x4 fa = __builtin_bit_cast(f16x4, va[st][dt]), fb = __builtin_bit_cast(f16x4, vc[st][dt]);
                const f16x8 vfr = {fa.x, fa.y, fa.z, fa.w, fb.x, fb.y, fb.z, fb.w};
                if (dt == 0) rs.o0 = __builtin_amdgcn_mfma_f32_32x32x16_f16(vfr, pfr, rs.o0, 0, 0, 0);
                else rs.o1 = __builtin_amdgcn_mfma_f32_32x32x16_f16(vfr, pfr, rs.o1, 0, 0, 0);
            }
        }
    } else {
        const float mu = (mc == -INFINITY) ? 0.f : mc;
#pragma unroll
        for (int kh = 0; kh < 2; ++kh)
#pragma unroll
            for (int ii = 0; ii < 4; ++ii) {
                float pv[4];
#pragma unroll
                for (int e = 0; e < 4; ++e) pv[e] = __builtin_amdgcn_exp2f((kh ? s1[4 * ii + e] : s0[4 * ii + e]) - mu) * invl;
                float a = (pv[0] + pv[1]) + (pv[2] + 0.5f * pv[3]), c = 0.5f * pv[3];
                a += __shfl_xor(a, 1); a += __shfl_xor(a, 2); c += __shfl_xor(c, 1); c += __shfl_xor(c, 2);
                const int nb = 16 * n + 8 * kh + 2 * ii + hi;
                if (wr) { impA[nb] = a; if (nb + 1 < 64) impC[nb + 1] = c; }
            }
    }
}
__device__ __forceinline__ void probs(RowState& rs, f32x16& s0, float sc, float c) {
    float tm = -INFINITY;
#pragma unroll
    for (int i = 0; i < 16; ++i) tm = fmaxf(tm, s0[i]);
    tm = fmaxf(tm, __shfl_xor(tm, 32));
    rescale_if_needed(rs, fmaf(tm, sc, c));
    const float mu = (rs.m == -INFINITY) ? 0.f : rs.m;
    const float cm = c - mu;
    float ps = 0.f;
#pragma unroll
    for (int i = 0; i < 16; ++i) { s0[i] = __builtin_amdgcn_exp2f(fmaf(s0[i], sc, cm)); ps += s0[i]; }
    rs.l += ps;
}
__device__ __forceinline__ void rs_init(RowState& rs) { rs.m = -INFINITY; rs.l = 0.f;
#pragma unroll
    for (int i = 0; i < 16; ++i) { rs.o0[i] = 0.f; rs.o1[i] = 0.f; } }
template <int MODE>
__device__ __forceinline__ void rs_flush(RowState& rs, float gate, LAS unsigned char* accl, _Float16* orow) {
    const float lt = rs.l + __shfl_xor(rs.l, 32);
    const float w = gate / fmaxf(lt, 1e-30f);
#pragma unroll
    for (int i = 0; i < 4; ++i) {
        float a[8] = {w * rs.o0[4 * i], w * rs.o0[4 * i + 1], w * rs.o0[4 * i + 2], w * rs.o0[4 * i + 3], w * rs.o1[4 * i], w * rs.o1[4 * i + 1], w * rs.o1[4 * i + 2], w * rs.o1[4 * i + 3]};
        LAS unsigned char* ap = accl + (i >> 1) * 16384 + (i & 1) * 1024;
        if (MODE != 0) { float p[8]; pg8::unpk8(*(const LAS u32x4*)ap, p);
#pragma unroll
            for (int e = 0; e < 8; ++e) a[e] += p[e]; }
        u32x4 wv; wv.x = pg8::pkh(a[0], a[1]); wv.y = pg8::pkh(a[2], a[3]); wv.z = pg8::pkh(a[4], a[5]); wv.w = pg8::pkh(a[6], a[7]);
        if (MODE != 2) *(LAS u32x4*)ap = wv;
        else { u32x2 w0; w0.x = wv.x; w0.y = wv.y; u32x2 w1; w1.x = wv.z; w1.y = wv.w; *(u32x2*)(orow + 8 * i) = w0; *(u32x2*)(orow + 32 + 8 * i) = w1; }
    }
}

__device__ __forceinline__ void nsa_unit(LAS unsigned char* lds, const _Float16* __restrict__ proj, const _Float16* __restrict__ kcmp, const _Float16* __restrict__ vcmp,
                                         _Float16* __restrict__ o_b, int b, int g, int qb) {
    const int tid = threadIdx.x, lane = tid & 63, wave = __builtin_amdgcn_readfirstlane(tid >> 6);
    const int rho = lane & 31, hi = lane >> 5, ql = rho >> 2, r = rho & 3, hb = g * 4 + r;
    const int t = 64 * qb + 8 * wave + ql;
    const _Float16* prow = proj + (size_t)(b * S_ + t) * PW;
    f16x8 qf[4];
#pragma unroll
    for (int ks = 0; ks < 4; ++ks) qf[ks] = *(const f16x8*)(prow + C_QB + hb * 64 + 16 * ks + 8 * hi);
    for (int i = tid; i < 2048; i += 512) ((LAS u32x4*)(lds + L_IMPA))[i] = (u32x4){0u, 0u, 0u, 0u};
    RowState rs; rs_init(rs);
    const LAS float* lut = (const LAS float*)(lds + L_BIAS);
    const float bias31 = lut[127 * 8 + hb];
    const _Float16* kc = kcmp + (size_t)(b * 2 + g) * 256 * 64;
    const long vcoff = (vcmp + (size_t)(b * 2 + g) * 256 * 64) - kc;
    const _Float16* pb = proj + (size_t)(b * S_) * PW + C_KVB + g * 64;
    const int ncmp = (4 * qb + 3 + 63) / 64;
    const int wlo = qb - 8 > 0 ? qb - 8 : 0;
    const int e0 = ncmp, e1 = 2 * ncmp, e2 = e1 + qb + 1, NT = e2 + (qb - wlo + 1);
    const int sr = tid >> 3, scq = tid & 7;
    float mc = 0.f, invl = 0.f; unsigned mlo = 0u, mhi = 0u;
    Stage stg;
#define NSA_DECODE(i, br, n) do { if ((i) < e0) { br = 0; n = (i); } else if ((i) < e1) { br = 1; n = (i) - e0; } else if ((i) < e2) { br = 2; n = (i) - e1; } else { br = 3; n = wlo + (i) - e2; } } while (0)
#define NSA_LOAD(i) do { int br_, n_; NSA_DECODE(i, br_, n_); const _Float16* kp_ = (br_ < 2) ? kc : (br_ == 2 ? pb + 2 * 128 : pb + 4 * 128); const int pitch_ = (br_ < 2) ? 64 : PW; \
        const long vo_ = (br_ < 2) ? vcoff : 128; const _Float16* rp_ = kp_ + (size_t)(64 * n_ + sr) * pitch_ + 8 * scq; stg.kr = *(const u32x4*)rp_; stg.vr = *(const u32x4*)(rp_ + vo_); } while (0)
#define NSA_STORE(buf) do { LAS unsigned char* tb_ = lds + L_T0 + (buf) * TILE_B; *(LAS u32x4*)(tb_ + sr * KP + 16 * scq) = stg.kr; *(LAS u32x4*)(tb_ + 64 * KP + sr * VP + 16 * scq) = stg.vr; } while (0)
    __syncthreads();
    NSA_LOAD(0); NSA_STORE(0);
    __syncthreads();
#pragma unroll 1
    for (int i = 0; i < NT; ++i) {
        int br, n; NSA_DECODE(i, br, n);
        const LAS unsigned char* tb = lds + L_T0 + (i & 1) * TILE_B;
        const bool more = i + 1 < NT;
        if (more) NSA_LOAD(i + 1);
        bool bit = true; int dbase, dstep = 1, dlim = 1 << 30; bool near = true;
        if (br < 2) { dbase = t - 31 - 1024 * n; dstep = 16; }
        else { dbase = t - 64 * n; near = n >= qb - 2; if (br == 2) bit = (n < 32) ? ((mlo >> n) & 1u) : ((mhi >> (n - 32)) & 1u); else dlim = 512; }
        const bool interior = (br >= 2) && (n <= qb - 3) && !(br == 3 && n == qb - 8);
        const bool skip = (br == 2) && !__any(bit);
        if (!skip) {
            if (interior) tile_fast(rs, tb, tb + 64 * KP, qf, bit ? bias31 : -INFINITY, rho, hi);
            else {
                const unsigned dl = bit ? (unsigned)dlim : 0u;
                int tq = threadIdx.x; asm volatile("" : "+v"(tq));
                LAS float* impA = (LAS float*)(lds + L_IMPA) + ((tq >> 6) * 8 + ((tq & 31) >> 2)) * 64;
                LAS float* impC = (LAS float*)(lds + L_IMPC) + ((tq >> 6) * 8 + ((tq & 31) >> 2)) * 64;
                if (br != 1) tile_general<false>(rs, tb, tb + 64 * KP, qf, lut, hb, rho, hi, dbase, dstep, dl, 0.f, 0.f, impA, impC, n, false);
                else tile_general<true>(rs, tb, tb + 64 * KP, qf, lut, hb, rho, hi, dbase, dstep, dl, mc, invl, impA, impC, n, r == 0);
            }
        }
        if (i + 1 == e0) {
            mc = rs.m; const float lc = rs.l + __shfl_xor(rs.l, 32); invl = 1.f / fmaxf(lc, 1e-30f);
        } else if (i + 1 == e1) {
            asm volatile("s_waitcnt lgkmcnt(0)" ::: "memory");
            int tq = threadIdx.x; asm volatile("" : "+v"(tq));
            const int qs = (tq & 63) >> 3, j = tq & 7, wv = tq >> 6;
            LAS float* sA = (LAS float*)(lds + L_IMPA) + (wv * 8 + qs) * 64;
            const LAS float* sC = (const LAS float*)(lds + L_IMPC) + (wv * 8 + qs) * 64;
            float sc[8];
#pragma unroll
            for (int e = 0; e < 8; ++e) { const int nn = 8 * j + e; const bool forced = (nn == 0) || (nn == qb) || (nn == qb - 1);
                sc[e] = (nn <= qb) ? (forced ? 1.0e4f : (sA[nn] + sC[nn])) : -INFINITY; }
            asm volatile("s_waitcnt lgkmcnt(0)" ::: "memory");
#pragma unroll
            for (int e = 0; e < 8; ++e) sA[8 * j + e] = sc[e];
            asm volatile("s_waitcnt lgkmcnt(0)" ::: "memory");
            int rank[8];
#pragma unroll
            for (int e = 0; e < 8; ++e) rank[e] = 0;
            for (int m = 0; m <= qb; ++m) { const float sm = sA[m];
#pragma unroll
                for (int e = 0; e < 8; ++e) rank[e] += (sm > sc[e] || (sm == sc[e] && m < 8 * j + e)) ? 1 : 0; }
            unsigned bits = 0;
#pragma unroll
            for (int e = 0; e < 8; ++e) bits |= ((8 * j + e <= qb) && rank[e] < 16) ? (1u << e) : 0u;
            ((LAS unsigned char*)(lds + L_MASK))[(wv * 8 + qs) * 8 + j] = (unsigned char)bits;
            asm volatile("s_waitcnt lgkmcnt(0)" ::: "memory");
            const u32x2 mk = *(const LAS u32x2*)(lds + L_MASK + (wv * 8 + ((tq & 31) >> 2)) * 8);
            mlo = mk.x; mhi = mk.y;
            rs_flush<0>(rs, pg8::sigm((float)prow[C_GB + 0 * 8 + hb]), lds + L_IMPA + (tq >> 6) * 2048 + (tq & 63) * 16, nullptr); rs_init(rs);
        } else if (i + 1 == e2) {
            rs_flush<1>(rs, pg8::sigm((float)prow[C_GB + 1 * 8 + hb]), lds + L_IMPA + wave * 2048 + lane * 16, nullptr); rs_init(rs);
        } else if (i + 1 == NT) {
            rs_flush<2>(rs, pg8::sigm((float)prow[C_GB + 2 * 8 + hb]), lds + L_IMPA + wave * 2048 + lane * 16, o_b + (size_t)(b * S_ + t) * 1024 + hb * 64 + 4 * hi);
        }
        if (more) NSA_STORE((i + 1) & 1);
        __syncthreads();
    }
#undef NSA_DECODE
#undef NSA_LOAD
#undef NSA_STORE
}
}


namespace cmpx {
typedef _Float16 f16x8 __attribute__((ext_vector_type(8)));
typedef float f32x4 __attribute__((ext_vector_type(4)));
typedef unsigned u32x4 __attribute__((ext_vector_type(4)));
constexpr int L_PART = 0, L_HID = 65536, HIDP = 272, L_END = L_HID + 16 * HIDP;
__device__ __forceinline__ void item(LAS unsigned char* lds, const _Float16* __restrict__ proj, const float* __restrict__ pe, const _Float16* __restrict__ w1t, const _Float16* __restrict__ w2t,
                                     _Float16* __restrict__ dst, int b, int g, int kv, int ct) {
    const int tid = threadIdx.x, lane = tid & 63, wave = __builtin_amdgcn_readfirstlane(tid >> 6), kc = lane >> 4, n16 = lane & 15;
    f32x4 acc[8];
#pragma unroll
    for (int nt = 0; nt < 8; ++nt) acc[nt] = (f32x4){0.f, 0.f, 0.f, 0.f};
    const int c = 16 * ct + n16;
#pragma unroll 2
    for (int ks = 0; ks < 8; ++ks) {
        const int k0 = 32 * (8 * wave + ks) + 8 * kc, lt = k0 >> 6, d = k0 & 63;
        int trow = 16 * c + lt; trow = trow > S_ - 1 ? S_ - 1 : trow;
        const f16x8 raw = *(const f16x8*)(proj + (size_t)(b * S_ + trow) * PW + C_KVB + kv * 128 + g * 64 + d);
        const f32x4 p0 = *(const f32x4*)(pe + lt * 64 + d), p1 = *(const f32x4*)(pe + lt * 64 + d + 4);
        f16x8 afr;
        afr[0] = (_Float16)((float)raw[0] + p0.x); afr[1] = (_Float16)((float)raw[1] + p0.y); afr[2] = (_Float16)((float)raw[2] + p0.z); afr[3] = (_Float16)((float)raw[3] + p0.w);
        afr[4] = (_Float16)((float)raw[4] + p1.x); afr[5] = (_Float16)((float)raw[5] + p1.y); afr[6] = (_Float16)((float)raw[6] + p1.z); afr[7] = (_Float16)((float)raw[7] + p1.w);
#pragma unroll
        for (int nt = 0; nt < 8; ++nt) {
            const f16x8 bfr = *(const f16x8*)(w1t + (size_t)(16 * nt + n16) * 2048 + k0);
            acc[nt] = __builtin_amdgcn_mfma_f32_16x16x32_f16(afr, bfr, acc[nt], 0, 0, 0);
        }
    }
    LAS float* part = (LAS float*)(lds + L_PART) + wave * 2048;
#pragma unroll
    for (int nt = 0; nt < 8; ++nt) { part[(4 * kc + 0) * 128 + 16 * nt + n16] = acc[nt].x; part[(4 * kc + 1) * 128 + 16 * nt + n16] = acc[nt].y;
        part[(4 * kc + 2) * 128 + 16 * nt + n16] = acc[nt].z; part[(4 * kc + 3) * 128 + 16 * nt + n16] = acc[nt].w; }
    __syncthreads();
    { const LAS float* pp = (const LAS float*)(lds + L_PART);
#pragma unroll
      for (int e = 0; e < 4; ++e) { const int o = tid + 512 * e; float a = 0.f;
#pragma unroll
          for (int w = 0; w < 8; ++w) a += pp[w * 2048 + o];
          const float z = 0.7978845608028654f * (a + 0.044715f * a * a * a);
          const float th = 1.f - 2.f / (__expf(2.f * z) + 1.f);
          ((LAS _Float16*)(lds + L_HID + (o >> 7) * HIDP))[o & 127] = (_Float16)(0.5f * a * (1.f + th)); } }
    __syncthreads();
    if (wave < 4) {
        f32x4 o = {0.f, 0.f, 0.f, 0.f};
#pragma unroll
        for (int ks = 0; ks < 4; ++ks) {
            const f16x8 afr = *(const LAS f16x8*)(lds + L_HID + n16 * HIDP + (32 * ks + 8 * kc) * 2);
            const f16x8 bfr = *(const f16x8*)(w2t + (size_t)(16 * wave + n16) * 128 + 32 * ks + 8 * kc);
            o = __builtin_amdgcn_mfma_f32_16x16x32_f16(afr, bfr, o, 0, 0, 0);
        }
        const float ov[4] = {o.x, o.y, o.z, o.w};
#pragma unroll
        for (int e = 0; e < 4; ++e) { const int cc = 16 * ct + 4 * kc + e; dst[((size_t)(b * 2 + g) * 256 + cc) * 64 + 16 * wave + n16] = (_Float16)(cc == 255 ? 0.f : ov[e]); }
    }
    __syncthreads();
}
}


#define XB_TMO      128
#define XB_XCNT(j)  (256  + 64 * (j))
#define XB_XSUB(j)  (1280 + 64 * (j))
#define XB_XGEN(j)  (2304 + 64 * (j))
#define XB_TOP      3328
#define XB_TOPGEN   3392
#define XCD_BAR_WORDS 3456
#define XB_SPIN_CAP (1u << 18)
__device__ __forceinline__ unsigned xb_ld(unsigned* p)              { return __hip_atomic_load(p, __ATOMIC_RELAXED, __HIP_MEMORY_SCOPE_AGENT); }
__device__ __forceinline__ unsigned xb_add(unsigned* p, unsigned v) { return __hip_atomic_fetch_add(p, v, __ATOMIC_RELAXED, __HIP_MEMORY_SCOPE_AGENT); }
__device__ __forceinline__ unsigned xb_xcc_id() { return (unsigned)__builtin_amdgcn_s_getreg((3 << 11) | 20) & 0xFu; }
#define XB_SPIN(cond, bar) do { unsigned _sp = 0; while (cond) { __builtin_amdgcn_s_sleep(1); \
    if ((++_sp & 255u) == 0u) { if (xb_ld(&(bar)[XB_TMO])) break; if (_sp > XB_SPIN_CAP) { atomicAdd(&(bar)[XB_TMO], 1u); break; } } } } while (0)
struct XcdBarrier { unsigned* bar; unsigned x; volatile LAS unsigned* st; };
__device__ __forceinline__ XcdBarrier xcd_barrier_post(unsigned* bar, volatile LAS unsigned* st) {
    XcdBarrier b; b.bar = bar; b.x = xb_xcc_id(); b.st = st;
    if (threadIdx.x == 0) (void)xb_add(&bar[XB_XCNT(b.x)], 1u);
    return b;
}
__device__ __forceinline__ void xcd_barrier_complete(unsigned* bar, unsigned x, unsigned& nloc, unsigned& nx) {
    const unsigned G = gridDim.x * gridDim.y * gridDim.z;
    unsigned sum, cnt, mine, sp = 0u;
    for (;;) {
        sum = 0u; cnt = 0u; mine = 0u;
#pragma unroll
        for (unsigned j = 0; j < 16; ++j) { const unsigned c = xb_ld(&bar[XB_XCNT(j)]); sum += c; cnt += (c > 0u) ? 1u : 0u; mine = (j == x) ? c : mine; }
        if (sum == G) break;
        __builtin_amdgcn_s_sleep(1);
        if ((++sp & 255u) == 0u) { if (xb_ld(&bar[XB_TMO])) break; if (sp > XB_SPIN_CAP) { atomicAdd(&bar[XB_TMO], 1u); break; } }
    }
    nloc = mine > 0u ? mine : 1u; nx = cnt > 0u ? cnt : 1u;
}
__device__ __forceinline__ void xcd_barrier(const XcdBarrier& b) {
    asm volatile("s_waitcnt vmcnt(0)" ::: "memory");
    __syncthreads();
    if (threadIdx.x == 0) {
        unsigned* bar = b.bar;
        __builtin_amdgcn_s_waitcnt(0);
        unsigned nloc = b.st[0], nx = b.st[1];
        if (nloc == 0u) { xcd_barrier_complete(bar, b.x, nloc, nx); b.st[0] = nloc; b.st[1] = nx; }
        const unsigned old = xb_add(&bar[XB_XSUB(b.x)], 1u);
        const unsigned gen = old / nloc;
        if (old + 1u == (gen + 1u) * nloc) {
            __builtin_amdgcn_fence(__ATOMIC_RELEASE, "agent");
            asm volatile("s_waitcnt vmcnt(0)" ::: "memory");
            const unsigned og = xb_add(&bar[XB_TOP], 1u);
            const unsigned tg = og / nx;
            if (og + 1u == (tg + 1u) * nx) xb_add(&bar[XB_TOPGEN], 1u);
            else XB_SPIN(xb_ld(&bar[XB_TOPGEN]) == tg, bar);
            __builtin_amdgcn_fence(__ATOMIC_ACQUIRE, "agent");
            xb_add(&bar[XB_XGEN(b.x)], 1u);
            asm volatile("s_waitcnt vmcnt(0)" ::: "memory");
        } else {
            XB_SPIN(xb_ld(&bar[XB_XGEN(b.x)]) == gen, bar);
            __builtin_amdgcn_fence(__ATOMIC_ACQUIRE, "agent");
            asm volatile("s_waitcnt vmcnt(0)" ::: "memory");
        }
    }
    __syncthreads();
}

constexpr int MEGA_LDS = 131072 + 256;

template <class Epi>
__device__ __forceinline__ void gemm_run(LAS unsigned char* lds, const void* A, const void* Bt, const Epi& E, int M, int N, int K) {
    pg8::Gemm g{(const pg8::bf16_t*)A, (const pg8::bf16_t*)Bt, M, N, K};
    pg8::StaticOrder S; S.init(M, N, (int)gridDim.x, (int)blockIdx.x);
    pg8::gemm_phase<Epi, pg8::StaticOrder, true, true>(lds, g, S, E);
}

__global__ void __launch_bounds__(512, 2) mega_fwd(Args a) {
    extern __shared__ __attribute__((aligned(16))) unsigned char lds_raw[];
    LAS unsigned char* lds = (LAS unsigned char*)lds_raw;
    unsigned char* ws = a.ws;
    if (threadIdx.x == 0) *(LAS dsa::u32x4*)(lds + 131072) = (dsa::u32x4){0u, 0u, 0u, 0u};
    __syncthreads();
    XcdBarrier bar = xcd_barrier_post((unsigned*)(ws + WS_CTL), (volatile LAS unsigned*)(lds + 131072));
    const _Float16* proj = (const _Float16*)(ws + WS_PROJ);
    _Float16* o_a = (_Float16*)(ws + WS_H); _Float16* o_b = (_Float16*)(ws + WS_H) + 512;
    _Float16* kcmp = (_Float16*)(ws + WS_KCMP); _Float16* vcmp = (_Float16*)(ws + WS_VCMP);

    prologue_body(a, lds_raw);
    xcd_barrier(bar);
    gemm_run(lds, ws + WS_H, ws + WS_WIN, pg8::EpiProj{(_Float16*)(ws + WS_PROJ)}, M_, PW, D_);
    xcd_barrier(bar);
#pragma unroll 1
    for (int it = blockIdx.x; it < 512; it += gridDim.x) { const int ct = it & 15, kv = (it >> 4) & 1, g = (it >> 5) & 1, b = it >> 6;
        cmpx::item(lds, proj, kv ? a.pe_v : a.pe_k, (const _Float16*)(ws + WS_CW + (kv ? 512 * 1024 : 0)), (const _Float16*)(ws + WS_CW + 1024 * 1024 + (kv ? 16384 : 0)), kv ? vcmp : kcmp, b, g, kv, ct); }
    { LAS float* biaslut = (LAS float*)(lds + dsa::L_BIAS);
      for (int i = threadIdx.x; i < 1024; i += 512) { const int d = i >> 3, h = i & 7; biaslut[i] = a.rel_bias[t5_bucket(d) * 16 + h]; } }
    __syncthreads();
#pragma unroll 1
    for (int v = blockIdx.x >> 3; v < 256; v += (gridDim.x >> 3)) { const int b = blockIdx.x & 7, j = v & 127;
        dsa::dsa_tile(lds, proj, o_a, b, (v < 128) ? 255 - j : j); }
    xcd_barrier(bar);
    { LAS float* lut = (LAS float*)(lds + nsa::L_BIAS);
      for (int i = threadIdx.x; i < 1024; i += 512) { const int d = i >> 3, h = i & 7; lut[i] = a.rel_bias[t5_bucket(d) * 16 + 8 + h] * nsa::LOG2E; } }
    __syncthreads();
#pragma unroll 1
    for (int v = blockIdx.x >> 3; v < 128; v += (gridDim.x >> 3)) { const int bg = 2 * (blockIdx.x & 7) + (v >> 6), j = v & 31;
        nsa::nsa_unit(lds, proj, kcmp, vcmp, o_b, bg >> 1, bg & 1, (v & 32) ? j : 63 - j);
        __syncthreads(); }
    xcd_barrier(bar);
    gemm_run(lds, ws + WS_H, ws + WS_WBA, pg8::EpiMixF{(_Float16*)(ws + WS_MIX), proj}, M_, D_, D_);
    xcd_barrier(bar);
    gemm_run(lds, ws + WS_MIX, ws + WS_WOUT, pg8::EpiResidSq{a.x, a.out, (_Float16*)(ws + WS_H), (float*)(ws + WS_ROWSQ)}, M_, D_, D_);
    xcd_barrier(bar);
    gemm_run(lds, ws + WS_H, ws + WS_WMI, pg8::EpiRelu2N{(_Float16*)(ws + WS_PROJ), (const float*)(ws + WS_ROWSQ)}, M_, DFF, D_);
    xcd_barrier(bar);
#pragma unroll 1
    for (int sl = 0; sl < 2; ++sl) {
        pg8::Gemm g{(const pg8::bf16_t*)(ws + WS_PROJ), (const pg8::bf16_t*)(ws + WS_WMO), M_, D_, DFF};
        SliceOrder SO; SO.S.init(M_, D_, (int)gridDim.x, (int)blockIdx.x); SO.slice = sl;
        pg8::gemm_phase<EpiFinalNorm, SliceOrder, false, true>(lds, g, SO, EpiFinalNorm{a.out, (const _Float16*)(ws + WS_H), a.norm_final, (float*)(ws + WS_XBUF), (unsigned*)(ws + WS_PCNT)});
        __syncthreads();
    }
}
}

extern "C" void kernel_launch(void* const* d_in, const int* in_sizes, int n_in, void* d_out, int out_size, void* d_ws, size_t ws_size, hipStream_t stream) {
    if (ws_size < WS_END) { fprintf(stderr, "ws too small: %zu\n", ws_size); return; }
    static int grid = 0;
    if (!grid) {
        int dev = 0, cus = 0, per_cu = 0;
        (void)hipGetDevice(&dev);
        (void)hipDeviceGetAttribute(&cus, hipDeviceAttributeMultiprocessorCount, dev);
        (void)hipFuncSetAttribute((const void*)mega_fwd, hipFuncAttributeMaxDynamicSharedMemorySize, MEGA_LDS);
        (void)hipOccupancyMaxActiveBlocksPerMultiprocessor(&per_cu, (const void*)mega_fwd, 512, MEGA_LDS);
        (void)hipGetLastError();
        grid = cus;
        if (per_cu < 1) fprintf(stderr, "occupancy query says %d blocks/CU\n", per_cu);
    }
    Args a{};
    a.x = (const float*)d_in[0]; a.norm_mix = (const float*)d_in[1]; a.w_in = (const float*)d_in[2];
    a.pe_k = (const float*)d_in[3]; a.w1_k = (const float*)d_in[4]; a.w2_k = (const float*)d_in[5];
    a.pe_v = (const float*)d_in[6]; a.w1_v = (const float*)d_in[7]; a.w2_v = (const float*)d_in[8];
    a.rel_bias = (const float*)d_in[9]; a.w_ba = (const float*)d_in[10]; a.w_bb = (const float*)d_in[11];
    a.w_out = (const float*)d_in[12]; a.norm_mlp = (const float*)d_in[13]; a.w_mi = (const float*)d_in[14];
    a.w_mo = (const float*)d_in[15]; a.norm_final = (const float*)d_in[16];
    a.out = (float*)d_out; a.ws = (unsigned char*)d_ws;
    (void)hipMemsetAsync(d_ws, 0, 327680, stream);
    hipLaunchKernelGGL(mega_fwd, dim3(grid), dim3(512), MEGA_LDS, stream, a);
}
```

```cpp
#include <hip/hip_runtime.h>
#include <hip/hip_fp16.h>
#include <cstdint>
#include <cstdio>

namespace pg8 {
#define PG8_LAS __attribute__((address_space(3)))
typedef unsigned short bf16_t;
typedef _Float16 bf16x8 __attribute__((ext_vector_type(8)));
typedef float f32x4 __attribute__((ext_vector_type(4)));
typedef unsigned u32x4 __attribute__((ext_vector_type(4)));
constexpr int BM = 256, BK = 64, HALF = 128, HTB = HALF * BK * 2  , STAGE_BYTES = 8 * HTB, NXCD = 8, WGM = 8;

__host__ __device__ __forceinline__ int lds_byte(int r, int c) { const int st = (r >> 4) * 2 + (c >> 5), rr = r & 15, cc = c & 31, ob = rr * 64 + cc * 2; return st * 1024 + (ob ^ (((ob >> 9) & 1) << 5)); }
__host__ __device__ __forceinline__ void stage_rc(int b, int& R, int& C) { const int st = b / 1024, sb = b % 1024, swz = sb ^ (((sb >> 9) & 1) << 5); R = (st >> 1) * 16 + swz / 64; C = (st & 1) * 32 + (swz % 64) / 2; }
__host__ __device__ __forceinline__ int perm32(int rho) { const int n = rho >> 4, i = rho & 15; return 8 * (i >> 2) + 4 * n + (i & 3); }

struct Unit { int pm, pn; };
struct Gemm { const bf16_t* A; const bf16_t* Bt; int M, N, K; };

struct StaticOrder {
    int nM, nN, nwg, G, c;
    __host__ __device__ void init(int M, int N, int G_, int c_) { nM = M / BM; nN = N / BM; nwg = nM * nN; G = G_; c = c_; }
    __host__ __device__ bool next(int i, Unit& u) const {
        const long L = (long)i * G + c; if (L >= nwg) return false;
        int wgid = (int)L; { const int q = nwg / NXCD, r = nwg % NXCD, xcd = wgid % NXCD, off = wgid / NXCD; wgid = (xcd < r ? xcd * (q + 1) : r * (q + 1) + (xcd - r) * q) + off; }
        const int nig = WGM * nN, gid = wgid / nig, fm = gid * WGM, gsz = (nM - fm) < WGM ? (nM - fm) : WGM;
        u.pm = fm + ((wgid % nig) % gsz); u.pn = (wgid % nig) / gsz; return true;
    }
    __device__ __forceinline__ void a_ready(const Unit&) const {}
    __device__ __forceinline__ void done(const Unit&) const {}
};


typedef unsigned u32x2 __attribute__((ext_vector_type(2)));
typedef float f32x2 __attribute__((ext_vector_type(2)));
typedef _Float16 f16x2 __attribute__((ext_vector_type(2)));
constexpr int PW = 4352;
__device__ __forceinline__ unsigned pkh(float a, float b) { f32x2 v = {a, b}; f16x2 h = __builtin_convertvector(v, f16x2); return __builtin_bit_cast(unsigned, h); }
__device__ __forceinline__ float sigm(float v) { return __builtin_amdgcn_rcpf(1.f + __expf(-v)); }
__device__ __forceinline__ float sigm_gate(float v) { return fmaxf(sigm(v), 6.2e-5f); }
__device__ __forceinline__ void unpk8(const u32x4 w, float (&f)[8]) {
#pragma unroll
    for (int i = 0; i < 4; ++i) { const unsigned wi = (i == 0) ? w.x : (i == 1) ? w.y : (i == 2) ? w.z : w.w; const f16x2 h = __builtin_bit_cast(f16x2, wi); f[2 * i] = (float)h.x; f[2 * i + 1] = (float)h.y; } }

struct EpiProj {
    static constexpr bool PERM = true, AFTER_DRAIN = false, MID = false;
    _Float16* O;
    __device__ __forceinline__ void operator()(const f32x4 (&acc)[2][2][4][2], const Unit& u, int wr, int wc, int fr, int fq) const {
        const int row0 = u.pm * BM + wr * 64 + fr, col0 = u.pn * BM + wc * 32 + 8 * fq; const bool sg = u.pn >= 9;
#pragma unroll
        for (int ai = 0; ai < 2; ++ai)
#pragma unroll
            for (int m = 0; m < 4; ++m) { _Float16* rowp = O + (size_t)(row0 + ai * HALF + m * 16) * PW + col0;
#pragma unroll
                for (int bj = 0; bj < 2; ++bj) { f32x4 v0 = acc[ai][bj][m][0], v1 = acc[ai][bj][m][1];
                    if (sg) {
#pragma unroll
                        for (int i = 0; i < 4; ++i) { v0[i] = sigm_gate(v0[i]); v1[i] = sigm_gate(v1[i]); } }
                    u32x4 w; w.x = pkh(v0[0], v0[1]); w.y = pkh(v0[2], v0[3]); w.z = pkh(v1[0], v1[1]); w.w = pkh(v1[2], v1[3]);
                    *(u32x4*)(rowp + bj * HALF) = w; } }
    }
};
struct EpiMixF {
    static constexpr bool PERM = true, AFTER_DRAIN = false, MID = true;
    _Float16* mix; const _Float16* proj;
    __device__ __forceinline__ void mid(f32x4 (&acc)[2][2][4][2], const Unit& u, int wr, int wc, int fr, int fq) const {
        int row0 = u.pm * BM + wr * 64 + fr, col0 = u.pn * BM + wc * 32 + 8 * fq;
        asm volatile("" : "+v"(row0), "+v"(col0));
#pragma unroll
        for (int ai = 0; ai < 2; ++ai)
#pragma unroll
            for (int m = 0; m < 4; ++m) { const _Float16* gr = proj + (size_t)(row0 + ai * HALF + m * 16) * PW + 2304 + col0;
#pragma unroll
                for (int bj = 0; bj < 2; ++bj)
#pragma unroll
                    for (int n = 0; n < 2; ++n) {
                        const u32x2 wa = *(const u32x2*)(gr + bj * HALF + 4 * n), wb = *(const u32x2*)(gr + 1024 + bj * HALF + 4 * n);
                        const unsigned a0 = wa.x, a1 = wa.y, b0 = wb.x, b1 = wb.y;
                        const f16x2 ga0 = __builtin_bit_cast(f16x2, a0), ga1 = __builtin_bit_cast(f16x2, a1), gb0 = __builtin_bit_cast(f16x2, b0), gb1 = __builtin_bit_cast(f16x2, b1);
                        acc[ai][bj][m][n][0] *= (float)ga0.x * __builtin_amdgcn_rcpf((float)gb0.x); acc[ai][bj][m][n][1] *= (float)ga0.y * __builtin_amdgcn_rcpf((float)gb0.y);
                        acc[ai][bj][m][n][2] *= (float)ga1.x * __builtin_amdgcn_rcpf((float)gb1.x); acc[ai][bj][m][n][3] *= (float)ga1.y * __builtin_amdgcn_rcpf((float)gb1.y);
                        __builtin_amdgcn_sched_barrier(0);
                    } }
    }
    __device__ __forceinline__ void operator()(const f32x4 (&acc)[2][2][4][2], const Unit& u, int wr, int wc, int fr, int fq) const {
        const int row0 = u.pm * BM + wr * 64 + fr, col0 = u.pn * BM + wc * 32 + 8 * fq;
#pragma unroll
        for (int ai = 0; ai < 2; ++ai)
#pragma unroll
            for (int m = 0; m < 4; ++m) { const size_t r = (size_t)(row0 + ai * HALF + m * 16);
#pragma unroll
                for (int bj = 0; bj < 2; ++bj) { const int c = col0 + bj * HALF;
                    float gb[8]; unpk8(*(const u32x4*)(proj + r * PW + 3328 + c), gb);
                    const f32x4 v0 = acc[ai][bj][m][0], v1 = acc[ai][bj][m][1];
                    u32x4 w; w.x = pkh(gb[0] * v0[0], gb[1] * v0[1]); w.y = pkh(gb[2] * v0[2], gb[3] * v0[3]); w.z = pkh(gb[4] * v1[0], gb[5] * v1[1]); w.w = pkh(gb[6] * v1[2], gb[7] * v1[3]);
                    *(u32x4*)(mix + r * 1024 + c) = w; } }
    }
};
struct EpiResidSq {
    static constexpr bool PERM = true, AFTER_DRAIN = false, MID = false;
    const float* x; float* out; _Float16* xh; float* rowsq;
    __device__ __forceinline__ void operator()(const f32x4 (&acc)[2][2][4][2], const Unit& u, int wr, int wc, int fr, int fq) const {
        const int row0 = u.pm * BM + wr * 64 + fr, col0 = u.pn * BM + wc * 32 + 8 * fq;
#pragma unroll
        for (int ai = 0; ai < 2; ++ai)
#pragma unroll
            for (int m = 0; m < 4; ++m) { const size_t r = (size_t)(row0 + ai * HALF + m * 16); float sq = 0.f;
#pragma unroll
                for (int bj = 0; bj < 2; ++bj) { const size_t o = r * 1024 + col0 + bj * HALF;
                    const f32x4 a0 = *(const f32x4*)(x + o) + acc[ai][bj][m][0], a1 = *(const f32x4*)(x + o + 4) + acc[ai][bj][m][1];
                    u32x4 w; w.x = pkh(a0[0], a0[1]); w.y = pkh(a0[2], a0[3]); w.z = pkh(a1[0], a1[1]); w.w = pkh(a1[2], a1[3]);
                    *(u32x4*)(xh + o) = w;
                    sq += (a0[0] * a0[0] + a0[1] * a0[1]) + (a0[2] * a0[2] + a0[3] * a0[3]) + (a1[0] * a1[0] + a1[1] * a1[1]) + (a1[2] * a1[2] + a1[3] * a1[3]); }
                sq += __shfl_xor(sq, 16); sq += __shfl_xor(sq, 32);
                if (fq == 0) atomicAdd(rowsq + r, sq); }
    }
};
struct EpiRelu2N {
    static constexpr bool PERM = true, AFTER_DRAIN = false, MID = false;
    _Float16* U; const float* rowsq;
    __device__ __forceinline__ void operator()(const f32x4 (&acc)[2][2][4][2], const Unit& u, int wr, int wc, int fr, int fq) const {
        const int row0 = u.pm * BM + wr * 64 + fr, col0 = u.pn * BM + wc * 32 + 8 * fq;
#pragma unroll
        for (int ai = 0; ai < 2; ++ai)
#pragma unroll
            for (int m = 0; m < 4; ++m) { const int r = row0 + ai * HALF + m * 16; _Float16* rowp = U + (size_t)r * 4096 + col0;
                const float inv = 1.f / (rowsq[r] * (1.f / 1024.f) + 1e-6f);
#pragma unroll
                for (int bj = 0; bj < 2; ++bj) { f32x4 v0 = acc[ai][bj][m][0], v1 = acc[ai][bj][m][1];
#pragma unroll
                    for (int i = 0; i < 4; ++i) { const float a = fmaxf(v0[i], 0.f), b = fmaxf(v1[i], 0.f); v0[i] = a * a * inv; v1[i] = b * b * inv; }
                    u32x4 w; w.x = pkh(v0[0], v0[1]); w.y = pkh(v0[2], v0[3]); w.z = pkh(v1[0], v1[1]); w.w = pkh(v1[2], v1[3]);
                    *(u32x4*)(rowp + bj * HALF) = w; } }
    }
};
template <class Epi, class Sched, bool ALIGN_EPI = false, bool SP2 = false>
__device__ __forceinline__ void gemm_phase(PG8_LAS unsigned char* lds, const Gemm g, const Sched& S, const Epi& E) {
    int tid_ = threadIdx.x; asm volatile("" : "+v"(tid_));
    const int tid = tid_, wid = __builtin_amdgcn_readfirstlane(tid >> 6), lane = tid & 63, wr = wid >> 2, wc = wid & 3, fr = lane & 15, fq = lane >> 4;
    const int K = g.K, nt = K / BK;
    unsigned voffA[2], voffB[2];
#pragma unroll
    for (int i = 0; i < 2; ++i) { int R, C; stage_rc(tid * 16 + i * 8192, R, C); const int Rb = Epi::PERM ? ((R & ~31) + perm32(R & 31)) : R;
        voffA[i] = (unsigned)(R * K + C) * 2u; voffB[i] = (unsigned)(Rb * K + C) * 2u; }
    const size_t kstep = (size_t)(BK * 2);
    const size_t hstep = (size_t)HALF * K * 2;
    const size_t tstep = 2 * hstep;
    const unsigned ldsw = (unsigned)wid * 1024u;
    const int aoff = lds_byte(wr * 64 + fr, fq * 8), boff = lds_byte(wc * 32 + fr, fq * 8);
#define PG8_SA(b, h) (((b) * 2 + (h)) * HTB)
#define PG8_SB(b, h) ((4 + (b) * 2 + (h)) * HTB)
#define PG8_STAGE(bufoff, gbase, voff) do { _Pragma("unroll") for (int _i = 0; _i < 2; ++_i) \
        __builtin_amdgcn_global_load_lds((const unsigned*)((const char*)(gbase) + (voff)[_i]), (PG8_LAS unsigned*)(lds + (bufoff) + ldsw + _i * 8192), 16, 0, 0); } while (0)
#define PG8_LDA(dst, b, h) do { _Pragma("unroll") for (int m = 0; m < 4; ++m) _Pragma("unroll") for (int k = 0; k < 2; ++k) dst[m][k] = *(const PG8_LAS bf16x8*)(lds + PG8_SA(b, h) + aoff + m * 2048 + k * 1024); } while (0)
#define PG8_LDB(dst, b, h) do { _Pragma("unroll") for (int n = 0; n < 2; ++n) _Pragma("unroll") for (int k = 0; k < 2; ++k) dst[n][k] = *(const PG8_LAS bf16x8*)(lds + PG8_SB(b, h) + boff + n * 2048 + k * 1024); } while (0)
#define PG8_MMA(ai, bj, At, Bt) do { __builtin_amdgcn_s_setprio(1); _Pragma("unroll") for (int m = 0; m < 4; ++m) _Pragma("unroll") for (int n = 0; n < 2; ++n) _Pragma("unroll") for (int k = 0; k < 2; ++k) \
        acc[ai][bj][m][n] = __builtin_amdgcn_mfma_f32_16x16x32_f16(Bt[n][k], At[m][k], acc[ai][bj][m][n], 0, 0, 0); __builtin_amdgcn_s_setprio(0); } while (0)
#define PG8_WAIT_V(n) asm volatile("s_waitcnt vmcnt(" #n ")" ::: "memory")
#define PG8_WAIT_L(n) asm volatile("s_waitcnt lgkmcnt(" #n ")" ::: "memory")
#define PG8_BAR __builtin_amdgcn_s_barrier()
#define PG8_SCHED __builtin_amdgcn_sched_barrier(0)
    Unit cur, nxt; int ui = 0;
    if (!S.next(0, cur)) return;
    f32x4 acc[2][2][4][2];
#pragma unroll
    for (int a = 0; a < 2; ++a)
#pragma unroll
        for (int b = 0; b < 2; ++b)
#pragma unroll
            for (int m = 0; m < 4; ++m)
#pragma unroll
                for (int n = 0; n < 2; ++n) acc[a][b][m][n] = (f32x4){0.f, 0.f, 0.f, 0.f};
    bf16x8 At[4][2], B0[2][2], B1[2][2];
    const char* cA = (const char*)g.A + (size_t)cur.pm * tstep; const char* cB = (const char*)g.Bt + (size_t)cur.pn * tstep;
    S.a_ready(cur);
    if constexpr (SP2) {
        PG8_STAGE(PG8_SB(0, 0), cB, voffB); PG8_STAGE(PG8_SB(0, 1), cB + hstep, voffB); PG8_STAGE(PG8_SA(0, 0), cA, voffA); PG8_STAGE(PG8_SA(0, 1), cA + hstep, voffA);
        if (wr == 1) PG8_BAR;
        PG8_WAIT_V(2); PG8_BAR;
        PG8_STAGE(PG8_SB(1, 0), cB + kstep, voffB); PG8_STAGE(PG8_SA(1, 0), cA + kstep, voffA); PG8_STAGE(PG8_SB(1, 1), cB + hstep + kstep, voffB);
        PG8_WAIT_V(6); PG8_BAR;
    } else {
        PG8_STAGE(PG8_SB(0, 0), cB, voffB); PG8_STAGE(PG8_SA(0, 0), cA, voffA); PG8_STAGE(PG8_SB(0, 1), cB + hstep, voffB); PG8_STAGE(PG8_SA(0, 1), cA + hstep, voffA);
        if (wr == 1) PG8_BAR;
        PG8_WAIT_V(4); PG8_BAR;
        PG8_STAGE(PG8_SB(1, 0), cB + kstep, voffB); PG8_STAGE(PG8_SA(1, 0), cA + kstep, voffA); PG8_STAGE(PG8_SB(1, 1), cB + hstep + kstep, voffB);
        PG8_WAIT_V(6); PG8_BAR;
    }
    for (;;) {
        const bool has_next = S.next(ui + 1, nxt);
        const char* nA = has_next ? (const char*)g.A + (size_t)nxt.pm * tstep : cA; const char* nB = has_next ? (const char*)g.Bt + (size_t)nxt.pn * tstep : cB;
        for (int t = 0; t < nt; t += 2) {
            if constexpr (Epi::MID) { if (t == nt / 2) E.mid(acc, cur, wr, wc, fr, fq); }
            const bool last = (t == nt - 2);
            const char* a1 = cA + (size_t)(t + 1) * kstep;
            const char* a2 = last ? nA : cA + (size_t)(t + 2) * kstep; const char* b2 = last ? nB : cB + (size_t)(t + 2) * kstep;
            const char* a3 = a2 + kstep; const char* b3 = b2 + kstep;
            if (last && has_next) S.a_ready(nxt);
            if constexpr (SP2) {
            PG8_LDB(B0, 0, 0); PG8_LDB(B1, 0, 1); PG8_SCHED; PG8_LDA(At, 0, 0); PG8_STAGE(PG8_SA(1, 1), a1 + hstep, voffA);
            PG8_WAIT_V(8); PG8_WAIT_L(0); PG8_BAR; PG8_MMA(0, 0, At, B0); PG8_MMA(0, 1, At, B1); PG8_BAR; PG8_SCHED;
            PG8_LDA(At, 0, 1); PG8_STAGE(PG8_SB(0, 0), b2, voffB); PG8_STAGE(PG8_SB(0, 1), b2 + hstep, voffB); PG8_STAGE(PG8_SA(0, 0), a2, voffA);
            PG8_WAIT_V(8); PG8_WAIT_L(0); PG8_BAR; PG8_MMA(1, 0, At, B0); PG8_MMA(1, 1, At, B1); PG8_BAR; PG8_SCHED;
            PG8_LDB(B0, 1, 0); PG8_LDB(B1, 1, 1); PG8_SCHED; PG8_LDA(At, 1, 0); PG8_STAGE(PG8_SA(0, 1), a2 + hstep, voffA);
            PG8_WAIT_V(8); PG8_WAIT_L(0); PG8_BAR; PG8_MMA(0, 0, At, B0); PG8_MMA(0, 1, At, B1); PG8_BAR; PG8_SCHED;
            PG8_LDA(At, 1, 1); PG8_STAGE(PG8_SB(1, 0), b3, voffB); PG8_STAGE(PG8_SB(1, 1), b3 + hstep, voffB); PG8_STAGE(PG8_SA(1, 0), a3, voffA);
            PG8_WAIT_V(8); PG8_WAIT_L(0); PG8_BAR; PG8_MMA(1, 0, At, B0); PG8_MMA(1, 1, At, B1); PG8_BAR; PG8_SCHED;
            } else {
            PG8_LDB(B0, 0, 0); PG8_SCHED; PG8_LDA(At, 0, 0); PG8_STAGE(PG8_SA(1, 1), a1 + hstep, voffA);
            PG8_WAIT_L(8); PG8_BAR; PG8_WAIT_L(0); PG8_MMA(0, 0, At, B0); PG8_BAR; PG8_SCHED;
            PG8_LDB(B1, 0, 1); PG8_STAGE(PG8_SB(0, 0), b2, voffB);
            PG8_BAR; PG8_WAIT_L(0); PG8_MMA(0, 1, At, B1); PG8_BAR;
            PG8_LDA(At, 0, 1); PG8_STAGE(PG8_SA(0, 0), a2, voffA);
            PG8_BAR; PG8_WAIT_L(0); PG8_MMA(1, 0, At, B0); PG8_BAR; PG8_SCHED;
            PG8_STAGE(PG8_SB(0, 1), b2 + hstep, voffB);
            PG8_WAIT_V(6); PG8_BAR; PG8_MMA(1, 1, At, B1); PG8_BAR;
            PG8_LDB(B0, 1, 0); PG8_SCHED; PG8_LDA(At, 1, 0); PG8_STAGE(PG8_SA(0, 1), a2 + hstep, voffA);
            PG8_WAIT_L(8); PG8_BAR; PG8_WAIT_L(0); PG8_MMA(0, 0, At, B0); PG8_BAR; PG8_SCHED;
            PG8_LDB(B1, 1, 1); PG8_STAGE(PG8_SB(1, 0), b3, voffB);
            PG8_BAR; PG8_WAIT_L(0); PG8_MMA(0, 1, At, B1); PG8_BAR;
            PG8_LDA(At, 1, 1); PG8_STAGE(PG8_SA(1, 0), a3, voffA);
            PG8_BAR; PG8_WAIT_L(0); PG8_MMA(1, 0, At, B0); PG8_BAR; PG8_SCHED;
            PG8_STAGE(PG8_SB(1, 1), b3 + hstep, voffB);
            PG8_WAIT_V(6); PG8_BAR; PG8_MMA(1, 1, At, B1); PG8_BAR;
            }
        }
        if constexpr (ALIGN_EPI) { if (wr == 0) PG8_BAR; }
        if constexpr (!Epi::AFTER_DRAIN) { E(acc, cur, wr, wc, fr, fq); S.done(cur); }
        if (!has_next) break;
#pragma unroll
        for (int a = 0; a < 2; ++a)
#pragma unroll
            for (int b = 0; b < 2; ++b)
#pragma unroll
                for (int m = 0; m < 4; ++m)
#pragma unroll
                    for (int n = 0; n < 2; ++n) acc[a][b][m][n] = (f32x4){0.f, 0.f, 0.f, 0.f};
        cur = nxt; cA = nA; cB = nB; ++ui;
        if constexpr (ALIGN_EPI) { if (wr == 1) PG8_BAR; }
    }
    PG8_WAIT_V(0);
    if constexpr (!ALIGN_EPI) { if (wr == 0) PG8_BAR; }
    PG8_BAR;
    if constexpr (Epi::AFTER_DRAIN) { E.fused(acc, cur, wr, wc, fr, fq, lds, wid, lane); S.done(cur); }
#undef PG8_SA
#undef PG8_SB
#undef PG8_STAGE
#undef PG8_LDA
#undef PG8_LDB
#undef PG8_MMA
#undef PG8_WAIT_V
#undef PG8_WAIT_L
#undef PG8_BAR
#undef PG8_SCHED
}
}


namespace {
constexpr int B_ = 8, S_ = 4096, M_ = B_ * S_, D_ = 1024, DIN = 4288, DFF = 4096;
constexpr int C_QA = 0, C_QB = 512, C_QI = 1024, C_KVB = 1280, C_KA = 2048, C_VA = 2112, C_KI = 2176, C_WI = 2208, C_GB = 2216, C_GATE = 2304;
constexpr int NC = 255;
constexpr float EPS = 1e-6f;
using pg8::PW;
#define GAS __attribute__((address_space(1)))
#define LAS __attribute__((address_space(3)))
typedef unsigned v4u __attribute__((ext_vector_type(4)));
typedef float f32x4 __attribute__((ext_vector_type(4)));

__device__ __forceinline__ int t5_bucket(int n) {
    if (n < 16) return n < 0 ? 0 : n;
    float nf = (float)n;
    int large = 16 + (int)(logf(nf / 16.f) / logf(8.f) * 16.f);
    return large < 31 ? large : 31;
}


__device__ __forceinline__ int win_src_col(int n) {
    if (n < 512) return n;
    if (n < 1024) return 936 + (n - 512);
    if (n < 1280) return 640 + (n - 1024);
    if (n < 2048) return 1448 + (n - 1280);
    if (n < 2112) return 512 + (n - 2048);
    if (n < 2176) return 576 + (n - 2112);
    if (n < 2208) return 896 + (n - 2176);
    if (n < 2216) return 928 + (n - 2208);
    if (n < 2240) return n;
    if (n < 2304) return -1;
    return 2240 + (n - 2304);
}
__device__ __forceinline__ float wave_sum(float v) {
#pragma unroll
    for (int o = 1; o < 64; o <<= 1) v += __shfl_xor(v, o);
    return v;
}
template <bool MAP>
__device__ __forceinline__ void transpose_item(const float* __restrict__ W, int K, int Nsrc, int Ndst, _Float16* __restrict__ WT, const float* __restrict__ gain, float* scr, int item, int lane, int dpitch = 0, int koff = 0) {
    const int nblk = Ndst / 32, kb = item / nblk, nb = item % nblk, k0 = 64 * kb, n0 = 32 * nb;
    const int nd = n0 + (lane & 31); const int ns = MAP ? win_src_col(nd) : nd;
#pragma unroll 8
    for (int i = 0; i < 32; ++i) { const int kk = 2 * i + (lane >> 5); float v = 0.f;
        if (ns >= 0) { v = W[(size_t)(k0 + kk) * Nsrc + ns]; if (gain) v *= gain[k0 + kk]; }
        scr[kk * 33 + (lane & 31)] = v; }
    __builtin_amdgcn_s_waitcnt(0xc07f); asm volatile("" ::: "memory");
    const int c = lane & 7;
#pragma unroll
    for (int j = 0; j < 4; ++j) { const int n = (lane >> 3) + 8 * j; const float* s = scr + (8 * c) * 33 + n;
        v4u o; o.x = pg8::pkh(s[0 * 33], s[1 * 33]); o.y = pg8::pkh(s[2 * 33], s[3 * 33]); o.z = pg8::pkh(s[4 * 33], s[5 * 33]); o.w = pg8::pkh(s[6 * 33], s[7 * 33]);
        *(v4u*)(WT + (size_t)(n0 + n) * (dpitch ? dpitch : K) + koff + k0 + 8 * c) = o; }
    __builtin_amdgcn_s_waitcnt(0xc07f); asm volatile("" ::: "memory");
}
__device__ __forceinline__ void rms_row_to_f16(const float* __restrict__ xrow, _Float16* __restrict__ orow, int lane) {
    const f32x4* xr = (const f32x4*)xrow + lane;
    f32x4 v[4]; float s = 0.f;
#pragma unroll
    for (int j = 0; j < 4; ++j) { v[j] = xr[64 * j]; s += (v[j].x * v[j].x + v[j].y * v[j].y) + (v[j].z * v[j].z + v[j].w * v[j].w); }
    const float rstd = rsqrtf(wave_sum(s) * (1.f / D_) + EPS);
    unsigned long long* o8 = (unsigned long long*)orow + lane;
#pragma unroll
    for (int j = 0; j < 4; ++j) o8[64 * j] = (unsigned long long)pg8::pkh(v[j].x * rstd, v[j].y * rstd) | ((unsigned long long)pg8::pkh(v[j].z * rstd, v[j].w * rstd) << 32);
}

struct Args {
    const float* x; const float* norm_mix; const float* w_in; const float* pe_k; const float* w1_k; const float* w2_k; const float* pe_v; const float* w1_v; const float* w2_v;
    const float* rel_bias; const float* w_ba; const float* w_bb; const float* w_out; const float* norm_mlp; const float* w_mi; const float* w_mo; const float* norm_final;
    float* out; unsigned char* ws;
};
constexpr size_t MiB = 1u << 20;
constexpr size_t WS_PCNT = 32768, WS_XBUF = 524288;
constexpr size_t WS_ROWSQ = 65536, WS_ROWSQ2 = 196608;
constexpr size_t WS_CTL = 0, WS_WIN = 1 * MiB, WS_WBA = 10 * MiB, WS_WBB = 11 * MiB, WS_WOUT = 12 * MiB, WS_WMI = 14 * MiB, WS_WMO = 22 * MiB, WS_CW = 30 * MiB,
                 WS_KCMP = 32 * MiB, WS_VCMP = 33 * MiB, WS_H = 34 * MiB, WS_PROJ = 98 * MiB, WS_MIX = 370 * MiB, WS_END = 434 * MiB;

__device__ __forceinline__ void prologue_body(const Args& a, unsigned char* lds) {
    const int tid = threadIdx.x, lane = tid & 63, wave = tid >> 6;
    float* scr = (float*)(lds + wave * 8704);
    const int gw = blockIdx.x * 8 + wave, NGW = gridDim.x * 8;
    constexpr int I_IN = (D_ / 64) * (PW / 32), I_BA = (512 / 64) * (D_ / 32), I_OUT = (D_ / 64) * (D_ / 32), I_MI = (D_ / 64) * (DFF / 32), I_MO = (DFF / 64) * (D_ / 32);
    constexpr int I_C1 = (2048 / 64) * (128 / 32), I_C2 = (128 / 64) * (64 / 32);
    constexpr int NITEMS = I_IN + 2 * I_BA + I_OUT + I_MI + I_MO + 2 * I_C1 + 2 * I_C2;
    for (int it = gw; it < NITEMS; it += NGW) {
        int r = it;
        if (r < I_IN) { transpose_item<true>(a.w_in, D_, DIN, PW, (_Float16*)(a.ws + WS_WIN), a.norm_mix, scr, r, lane); continue; } r -= I_IN;
        if (r < I_BA) { transpose_item<false>(a.w_ba, 512, D_, D_, (_Float16*)(a.ws + WS_WBA), nullptr, scr, r, lane, 1024, 0); continue; } r -= I_BA;
        if (r < I_BA) { transpose_item<false>(a.w_bb, 512, D_, D_, (_Float16*)(a.ws + WS_WBA), nullptr, scr, r, lane, 1024, 512); continue; } r -= I_BA;
        if (r < I_OUT) { transpose_item<false>(a.w_out, D_, D_, D_, (_Float16*)(a.ws + WS_WOUT), nullptr, scr, r, lane); continue; } r -= I_OUT;
        if (r < I_MI) { transpose_item<false>(a.w_mi, D_, DFF, DFF, (_Float16*)(a.ws + WS_WMI), a.norm_mlp, scr, r, lane); continue; } r -= I_MI;
        if (r < I_MO) { transpose_item<false>(a.w_mo, DFF, D_, D_, (_Float16*)(a.ws + WS_WMO), nullptr, scr, r, lane); continue; } r -= I_MO;
        if (r < I_C1) { transpose_item<false>(a.w1_k, 2048, 128, 128, (_Float16*)(a.ws + WS_CW), nullptr, scr, r, lane); continue; } r -= I_C1;
        if (r < I_C1) { transpose_item<false>(a.w1_v, 2048, 128, 128, (_Float16*)(a.ws + WS_CW + 512 * 1024), nullptr, scr, r, lane); continue; } r -= I_C1;
        if (r < I_C2) { transpose_item<false>(a.w2_k, 128, 64, 64, (_Float16*)(a.ws + WS_CW + 1024 * 1024), nullptr, scr, r, lane); continue; } r -= I_C2;
        transpose_item<false>(a.w2_v, 128, 64, 64, (_Float16*)(a.ws + WS_CW + 1024 * 1024 + 16384), nullptr, scr, r, lane);
    }
#pragma unroll 4
    for (int m = gw; m < M_; m += NGW) rms_row_to_f16(a.x + (size_t)m * D_, (_Float16*)(a.ws + WS_H) + (size_t)m * D_, lane);
}
struct EpiAccOut {
    static constexpr bool PERM = true, AFTER_DRAIN = false, MID = false;
    _Float16* x2h; const _Float16* xh; float* rowsq;
    __device__ __forceinline__ void operator()(const f32x4 (&acc)[2][2][4][2], const pg8::Unit& u, int wr, int wc, int fr, int fq) const {
        const int row0 = u.pm * 256 + wr * 64 + fr, col0 = u.pn * 256 + wc * 32 + 8 * fq;
#pragma unroll
        for (int ai = 0; ai < 2; ++ai)
#pragma unroll
            for (int m = 0; m < 4; ++m) { const size_t r = (size_t)(row0 + ai * 128 + m * 16); float sq = 0.f;
#pragma unroll
                for (int bj = 0; bj < 2; ++bj) { const size_t o = r * 1024 + col0 + bj * 128;
                    float p[8]; pg8::unpk8(*(const pg8::u32x4*)(xh + o), p);
                    const f32x4 a0 = acc[ai][bj][m][0], a1 = acc[ai][bj][m][1];
                    const float v[8] = {p[0] + a0[0], p[1] + a0[1], p[2] + a0[2], p[3] + a0[3], p[4] + a1[0], p[5] + a1[1], p[6] + a1[2], p[7] + a1[3]};
                    pg8::u32x4 w; w.x = pg8::pkh(v[0], v[1]); w.y = pg8::pkh(v[2], v[3]); w.z = pg8::pkh(v[4], v[5]); w.w = pg8::pkh(v[6], v[7]);
                    *(pg8::u32x4*)(x2h + o) = w;
                    sq += (v[0] * v[0] + v[1] * v[1]) + (v[2] * v[2] + v[3] * v[3]) + (v[4] * v[4] + v[5] * v[5]) + (v[6] * v[6] + v[7] * v[7]); }
                sq += __shfl_xor(sq, 16); sq += __shfl_xor(sq, 32);
                if (fq == 0) atomicAdd(rowsq + r, sq); }
    }
};
__device__ __forceinline__ void final_scale_row(const _Float16* __restrict__ xrow, float* __restrict__ orow, const float* __restrict__ g, float rsq, int lane) {
    const float rstd = rsqrtf(rsq * (1.f / D_) + EPS);
#pragma unroll
    for (int j = 0; j < 2; ++j) {
        float p[8]; pg8::unpk8(*((const pg8::u32x4*)xrow + lane + 64 * j), p);
        const f32x4 g0 = *((const f32x4*)g + 2 * (lane + 64 * j)), g1 = *((const f32x4*)g + 2 * (lane + 64 * j) + 1);
        *((f32x4*)orow + 2 * (lane + 64 * j)) = (f32x4){p[0] * rstd * g0.x, p[1] * rstd * g0.y, p[2] * rstd * g0.z, p[3] * rstd * g0.w};
        *((f32x4*)orow + 2 * (lane + 64 * j) + 1) = (f32x4){p[4] * rstd * g1.x, p[5] * rstd * g1.y, p[6] * rstd * g1.z, p[7] * rstd * g1.w};
    }
}

struct SliceOrder {
    pg8::StaticOrder S; int slice;
    __device__ bool next(int i, pg8::Unit& u) const { return i == 0 ? S.next(slice, u) : false; }
    __device__ __forceinline__ void a_ready(const pg8::Unit&) const {}
    __device__ __forceinline__ void done(const pg8::Unit&) const {}
};
struct EpiFinalNorm {
    static constexpr bool PERM = true, AFTER_DRAIN = true, MID = false;
    float* out; const _Float16* xh; const float* g; float* xbuf; unsigned* cnt;
    __device__ __forceinline__ void fused(f32x4 (&acc)[2][2][4][2], const pg8::Unit& u, int wr, int wc, int fr, int fq, PG8_LAS unsigned char* lds, int wid, int lane) const {
        const int rl0 = wr * 64 + fr, col0 = u.pn * 256 + wc * 32 + 8 * fq;
        PG8_LAS float* red = (PG8_LAS float*)lds;
#pragma unroll
        for (int ai = 0; ai < 2; ++ai)
#pragma unroll
            for (int m = 0; m < 4; ++m) { const int rl = rl0 + ai * 128 + m * 16; const size_t r = (size_t)(u.pm * 256 + rl); float sq = 0.f;
#pragma unroll
                for (int bj = 0; bj < 2; ++bj) { float p[8]; pg8::unpk8(*(const pg8::u32x4*)(xh + r * 1024 + col0 + bj * 128), p);
#pragma unroll
                    for (int i = 0; i < 4; ++i) { acc[ai][bj][m][0][i] += p[i]; acc[ai][bj][m][1][i] += p[4 + i];
                        sq = fmaf(acc[ai][bj][m][0][i], acc[ai][bj][m][0][i], sq); sq = fmaf(acc[ai][bj][m][1][i], acc[ai][bj][m][1][i], sq); } }
                sq += __shfl_xor(sq, 16); sq += __shfl_xor(sq, 32);
                if (fq == 0) red[wc * 256 + rl] = sq; }
        __syncthreads();
        const int tid = wid * 64 + lane;
        if (tid < 256) { const float tot = (red[tid] + red[256 + tid]) + (red[512 + tid] + red[768 + tid]);
            __hip_atomic_store(xbuf + ((size_t)u.pm * 4 + u.pn) * 256 + tid, tot, __ATOMIC_RELAXED, __HIP_MEMORY_SCOPE_AGENT); }
        asm volatile("s_waitcnt vmcnt(0)" ::: "memory");
        __syncthreads();
        if (tid == 0) { __hip_atomic_fetch_add(cnt + u.pm, 1u, __ATOMIC_RELAXED, __HIP_MEMORY_SCOPE_AGENT);
            unsigned sp = 0; while (__hip_atomic_load(cnt + u.pm, __ATOMIC_RELAXED, __HIP_MEMORY_SCOPE_AGENT) < 4u && ++sp < (1u << 22)) __builtin_amdgcn_s_sleep(1); }
        __syncthreads();
        if (tid < 256) { float tot = 0.f;
#pragma unroll
            for (int q = 0; q < 4; ++q) tot += __hip_atomic_load(xbuf + ((size_t)u.pm * 4 + q) * 256 + tid, __ATOMIC_RELAXED, __HIP_MEMORY_SCOPE_AGENT);
            red[1024 + tid] = rsqrtf(tot * (1.f / 1024.f) + 1e-6f); }
        __syncthreads();
#pragma unroll
        for (int ai = 0; ai < 2; ++ai)
#pragma unroll
            for (int m = 0; m < 4; ++m) { const int rl = rl0 + ai * 128 + m * 16; const size_t r = (size_t)(u.pm * 256 + rl); const float rstd = red[1024 + rl];
#pragma unroll
                for (int bj = 0; bj < 2; ++bj) { const int c = col0 + bj * 128; const f32x4 g0 = *(const f32x4*)(g + c), g1 = *(const f32x4*)(g + c + 4);
                    *(f32x4*)(out + r * 1024 + c) = acc[ai][bj][m][0] * rstd * g0; *(f32x4*)(out + r * 1024 + c + 4) = acc[ai][bj][m][1] * rstd * g1; } }
        __syncthreads();
    }
};

namespace dsa {
typedef _Float16 f16x8 __attribute__((ext_vector_type(8)));
typedef _Float16 f16x4 __attribute__((ext_vector_type(4)));
typedef short s16x4 __attribute__((ext_vector_type(4)));
typedef float f32x4 __attribute__((ext_vector_type(4)));
typedef unsigned u32x4 __attribute__((ext_vector_type(4)));
typedef unsigned u32x2 __attribute__((ext_vector_type(2)));
constexpr int TQ = 16, NBIN = 2048, CANDCAP = 512, VPITCH = 144;
constexpr int L_HIST = 0, L_SEL = 65536, L_SELD = L_SEL + 8192, L_CTL = L_SELD + 8192, L_BIAS = L_CTL + 512, L_VST = L_BIAS + 4096, L_END = L_VST + 8 * 32 * VPITCH;
static_assert(L_END <= 131072, "dsa LDS");

__device__ __forceinline__ float idx_score(const f32x4 a1, const f32x4 a2, float lin, const float (&wh)[8]) {
    float s = fmaf(wh[0], fabsf(a1.x), lin);
    s = fmaf(wh[1], fabsf(a1.y), s); s = fmaf(wh[2], fabsf(a1.z), s); s = fmaf(wh[3], fabsf(a1.w), s);
    s = fmaf(wh[4], fabsf(a2.x), s); s = fmaf(wh[5], fabsf(a2.y), s); s = fmaf(wh[6], fabsf(a2.z), s); s = fmaf(wh[7], fabsf(a2.w), s);
    return s;
}
__device__ __forceinline__ int score_bin(float sc, float inv) { int b = (int)(fmaf(sc, inv, 1024.f)); b = b < 0 ? 0 : b; return b > NBIN - 1 ? NBIN - 1 : b; }

template <int PASS>
__device__ __forceinline__ void score_pass(LAS unsigned char* lds, const _Float16* __restrict__ proj, int b, int t0, int nkb, int wave, int lane,
                                           const f16x8 (&afr)[4][2], const f16x8 alin, const float (&wq)[4][8], const float (&binv)[4]) {
    LAS unsigned* hist = (LAS unsigned*)(lds + L_HIST);
    LAS unsigned short* sel = (LAS unsigned short*)(lds + L_SEL);
    LAS unsigned short* seld = (LAS unsigned short*)(lds + L_SELD);
    LAS u32x2* cand = (LAS u32x2*)(lds + L_HIST);
    LAS int* ctl = (LAS int*)(lds + L_CTL);
    const int kc = lane >> 4, n16 = lane & 15;
    int bst[4];
#pragma unroll
    for (int grp = 0; grp < 4; ++grp) bst[grp] = (PASS == 2) ? ctl[(4 * grp + kc) * 8 + 2] : 0;
    const f32x4 zero = {0.f, 0.f, 0.f, 0.f};
    const _Float16* kbase = proj + (size_t)(b * S_ + n16) * PW + C_KI + 8 * kc;
    f16x8 bnext = *(const f16x8*)(kbase + (size_t)(16 * (wave < nkb ? wave : 0)) * PW);
    for (int kb = wave; kb < nkb; kb += 8) {
        const f16x8 bfr = bnext;
        { const int kn = kb + 8 < nkb ? kb + 8 : kb; bnext = *(const f16x8*)(kbase + (size_t)(16 * kn) * PW); }
        const int s = 16 * kb + n16;
        const bool lastkb = kb == nkb - 1;
        const f32x4 a3 = __builtin_amdgcn_mfma_f32_16x16x32_f16(alin, bfr, zero, 0, 0, 0);
        const float lin4[4] = {a3.x, a3.y, a3.z, a3.w};
#pragma unroll
        for (int grp = 0; grp < 4; ++grp) {
            const f32x4 a1 = __builtin_amdgcn_mfma_f32_16x16x32_f16(afr[grp][0], bfr, zero, 0, 0, 0);
            const f32x4 a2 = __builtin_amdgcn_mfma_f32_16x16x32_f16(afr[grp][1], bfr, zero, 0, 0, 0);
            const float sc = idx_score(a1, a2, lin4[grp], wq[grp]);
            const int row = 4 * grp + kc, t = t0 + row;
            if (!lastkb || s <= t) {
                const int bin = score_bin(sc, binv[grp]);
                if (PASS == 1) { __hip_atomic_fetch_add(hist + row * 1024 + (bin >> 1), (bin & 1) ? 0x10000u : 1u, __ATOMIC_RELAXED, __HIP_MEMORY_SCOPE_WORKGROUP); }
                else {
                    if (bin > bst[grp]) { const int pos = __hip_atomic_fetch_add(ctl + row * 8 + 0, 1, __ATOMIC_RELAXED, __HIP_MEMORY_SCOPE_WORKGROUP); sel[row * 256 + (pos & 255)] = (unsigned short)s;
                        const int dd = t - s; seld[row * 256 + (pos & 255)] = (unsigned short)((dd > 127 ? 127 : dd) * 32); }
                    else if (bin == bst[grp]) { const int pos = __hip_atomic_fetch_add(ctl + row * 8 + 1, 1, __ATOMIC_RELAXED, __HIP_MEMORY_SCOPE_WORKGROUP);
                        if (pos < CANDCAP) { u32x2 e; e.x = __float_as_uint(sc); e.y = (unsigned)s; cand[row * CANDCAP + pos] = e; } }
                }
            }
        }
    }
}

__device__ __forceinline__ void dsa_tile(LAS unsigned char* lds, const _Float16* __restrict__ proj, _Float16* __restrict__ o_a, int b, int qt) {
    int tid_ = threadIdx.x; asm volatile("" : "+v"(tid_));
    const int tid = tid_, lane = tid & 63, wave = __builtin_amdgcn_readfirstlane(tid >> 6);
    const int kc = lane >> 4, n16 = lane & 15;
    const int t0 = qt * TQ, nkb = qt + 1;
    LAS unsigned* hist = (LAS unsigned*)(lds + L_HIST);
    LAS unsigned short* sel = (LAS unsigned short*)(lds + L_SEL);
    LAS u32x2* cand = (LAS u32x2*)(lds + L_HIST);
    LAS int* ctl = (LAS int*)(lds + L_CTL);
    LAS float* biaslut = (LAS float*)(lds + L_BIAS);
    for (int i = tid; i < (TQ * 1024 + 4096) / 4; i += 512) ((LAS u32x4*)hist)[i] = (u32x4){0u, 0u, 0u, 0u};
    if (tid < TQ * 8) ctl[tid] = 0;
    f16x8 afr[4][2]; f16x8 alin; float wq[4][8]; float binv[4];
    { const int g = n16 >> 2, r = n16 & 3;
      { const int qq = 4 * r + g; const _Float16* qrow = proj + (size_t)(b * S_ + t0 + qq) * PW;
        const f16x8 wg = *(const f16x8*)(qrow + C_WI);
        float lin[8];
#pragma unroll
        for (int e = 0; e < 8; ++e) lin[e] = 0.f;
#pragma unroll
        for (int h = 0; h < 8; ++h) { const f16x8 qh = *(const f16x8*)(qrow + C_QI + h * 32 + 8 * kc); const float wh = (float)wg[h] * (0.5f / 16.f);
#pragma unroll
            for (int e = 0; e < 8; ++e) lin[e] = fmaf(wh, (float)qh[e], lin[e]); }
#pragma unroll
        for (int e = 0; e < 8; ++e) alin[e] = (_Float16)lin[e]; }
#pragma unroll
      for (int grp = 0; grp < 4; ++grp) {
          const _Float16* qrow = proj + (size_t)(b * S_ + t0 + 4 * grp + g) * PW + C_QI;
          afr[grp][0] = *(const f16x8*)(qrow + r * 32 + 8 * kc);
          afr[grp][1] = *(const f16x8*)(qrow + (4 + r) * 32 + 8 * kc);
          const f16x8 wv = *(const f16x8*)(proj + (size_t)(b * S_ + t0 + 4 * grp + kc) * PW + C_WI);
          float ss = 0.f;
#pragma unroll
          for (int h = 0; h < 8; ++h) { const float wfull = (float)wv[h] * (1.f / 16.f); wq[grp][h] = 0.5f * wfull; ss = fmaf(wfull, wfull, ss); }
          binv[grp] = 32.f * rsqrtf(ss + 1e-12f);
      } }
    __syncthreads();
    score_pass<1>(lds, proj, b, t0, nkb, wave, lane, afr, alin, wq, binv);
    __syncthreads();
#pragma unroll 1
    for (int i = 0; i < 2; ++i) {
        const int row = 2 * wave + i, n = t0 + row + 1;
        if (n <= 256) { if (lane == 0) { ctl[row * 8 + 2] = -1; ctl[row * 8 + 3] = 0; } }
        else {
            const LAS u32x4* hp = (const LAS u32x4*)(hist + row * 1024 + 16 * lane);
            unsigned tot = 0;
#pragma unroll
            for (int q4 = 0; q4 < 4; ++q4) { const u32x4 hv = hp[q4];
                tot += (hv.x & 0xffffu) + (hv.x >> 16) + (hv.y & 0xffffu) + (hv.y >> 16) + (hv.z & 0xffffu) + (hv.z >> 16) + (hv.w & 0xffffu) + (hv.w >> 16); }
            unsigned suf = tot;
#pragma unroll
            for (int o = 1; o < 64; o <<= 1) { const unsigned v = __shfl_down(suf, o); if (lane + o < 64) suf += v; }
            const unsigned above_lane = suf - tot;
            const unsigned long long cross = __ballot(above_lane < 256u && suf >= 256u);
            const int lx = __builtin_ctzll(cross);
            const unsigned abovex = __shfl(above_lane, lx);
            const unsigned c2 = lane < 32 ? (unsigned)((const LAS unsigned short*)hist)[row * 2048 + 32 * lx + lane] : 0u;
            unsigned suf2 = c2;
#pragma unroll
            for (int o = 1; o < 32; o <<= 1) { const unsigned v = __shfl_down(suf2, o); if (lane + o < 32) suf2 += v; }
            const unsigned above2 = abovex + suf2 - c2;
            if (lane < 32 && above2 < 256u && above2 + c2 >= 256u) {
                const int bs = 32 * lx + lane; const unsigned cum = above2;
                ctl[row * 8 + 2] = bs; ctl[row * 8 + 3] = 256 - (int)cum;
            }
        }
    }
    __syncthreads();
    score_pass<2>(lds, proj, b, t0, nkb, wave, lane, afr, alin, wq, binv);
    __syncthreads();
#pragma unroll 1
    for (int i = 0; i < 2; ++i) {
        const int row = 2 * wave + i, n = t0 + row + 1;
        const int need = ctl[row * 8 + 3], base = ctl[row * 8 + 0];
        int nc = ctl[row * 8 + 1];
        nc = nc < CANDCAP ? nc : CANDCAP;
        if (lane == 0) { const int nf = base + (need < nc ? need : nc); ctl[row * 8 + 4] = n <= 256 ? n : (nf < 256 ? nf : 256); }
        if (need > 0) {
            for (int c0 = 0; c0 < nc; c0 += 64) {
                const int ci = c0 + lane; const bool act = ci < nc;
                const u32x2 me = cand[row * CANDCAP + (act ? ci : 0)];
                const float msc = __uint_as_float(me.x); int rank = 0;
                for (int j = 0; j < nc; ++j) { const u32x2 ot = cand[row * CANDCAP + j]; const float osc = __uint_as_float(ot.x);
                    rank += (osc > msc || (osc == msc && ot.y < me.y)) ? 1 : 0; }
                if (act && rank < need) { sel[row * 256 + ((base + rank) & 255)] = (unsigned short)me.y; const int dd = t0 + row - (int)me.y; ((LAS unsigned short*)(lds + L_SELD))[row * 256 + ((base + rank) & 255)] = (unsigned short)((dd > 127 ? 127 : dd) * 32); }
            }
        }
    }
    __syncthreads();
    int tq_ = threadIdx.x; asm volatile("" : "+v"(tq_));
    const int lane_a = tq_ & 63;
    LAS unsigned char* vst = lds + L_VST + wave * (32 * VPITCH);
#pragma unroll 1
    for (int i = 0; i < 2; ++i) { const int lane = lane_a, kc = lane >> 4, n16 = lane & 15;
        const int row = 2 * wave + i, t = t0 + row; const int nvalid = ctl[row * 8 + 4];
        const _Float16* qrow = proj + (size_t)(b * S_ + t) * PW + C_QA;
        const int head = n16, hm = head & 7;
        f16x8 qb0, qb1;
        { const f16x8 z = {0, 0, 0, 0, 0, 0, 0, 0}; qb0 = z; qb1 = z;
          if (head < 8) { qb0 = *(const f16x8*)(qrow + head * 64 + 8 * kc); qb1 = *(const f16x8*)(qrow + head * 64 + 32 + 8 * kc); } }
        f32x4 ot[4];
#pragma unroll
        for (int dt = 0; dt < 4; ++dt) ot[dt] = (f32x4){0.f, 0.f, 0.f, 0.f};
        float mrun = -INFINITY, lrun = 0.f;
        const LAS unsigned short* selr = sel + row * 256;
        const LAS unsigned short* seldr = (const LAS unsigned short*)(lds + L_SELD) + row * 256;
        const LAS unsigned char* biasb = lds + L_BIAS + hm * 4;
        const _Float16* pbat = proj + (size_t)(b * S_) * PW;
        LAS unsigned char* kst = lds + L_HIST + wave * (32 * VPITCH);
        u32x4 gk[4], gv[4];
        const char* pbyte = (const char*)pbat;
#define DSA_GATHER(jj) do { _Pragma("unroll") for (int i_ = 0; i_ < 4; ++i_) { const int pos_ = 32 * (jj) + 8 * i_ + (lane >> 3); \
            const unsigned idx_ = pos_ < nvalid ? (unsigned)selr[pos_] : 0u; const char* rp_ = pbyte + (size_t)(idx_ * (unsigned)(PW * 2) + (unsigned)(C_KA * 2 + 16 * (lane & 7))); \
            gk[i_] = *(const u32x4*)rp_; gv[i_] = *(const u32x4*)(rp_ + 128); } } while (0)
        DSA_GATHER(0);
        const int nsteps = (nvalid + 31) >> 5;
#pragma unroll 1
        for (int j = 0; j < nsteps; ++j) {
#pragma unroll
            for (int i_ = 0; i_ < 4; ++i_) { const int ro = (8 * i_ + (lane >> 3)) * VPITCH + 16 * (lane & 7);
                *(LAS u32x4*)(kst + ro) = gk[i_]; *(LAS u32x4*)(vst + ro) = gv[i_]; }
            if (j + 1 < nsteps) DSA_GATHER(j + 1);
            asm volatile("s_waitcnt lgkmcnt(0)" ::: "memory");
            const f16x8 ca0 = *(const LAS f16x8*)(kst + n16 * VPITCH + 16 * kc), ca1 = *(const LAS f16x8*)(kst + n16 * VPITCH + 64 + 16 * kc);
            const f16x8 cb0 = *(const LAS f16x8*)(kst + (16 + n16) * VPITCH + 16 * kc), cb1 = *(const LAS f16x8*)(kst + (16 + n16) * VPITCH + 64 + 16 * kc);
            f32x4 sa = {0.f, 0.f, 0.f, 0.f}, sb = {0.f, 0.f, 0.f, 0.f};
            sa = __builtin_amdgcn_mfma_f32_16x16x32_f16(ca0, qb0, sa, 0, 0, 0); sa = __builtin_amdgcn_mfma_f32_16x16x32_f16(ca1, qb1, sa, 0, 0, 0);
            sb = __builtin_amdgcn_mfma_f32_16x16x32_f16(cb0, qb0, sb, 0, 0, 0); sb = __builtin_amdgcn_mfma_f32_16x16x32_f16(cb1, qb1, sb, 0, 0, 0);
            const int p0 = 32 * j + 4 * kc;
            const u32x2 iwa = *(const LAS u32x2*)(seldr + p0), iwb = *(const LAS u32x2*)(seldr + p0 + 16);
            const unsigned wa0 = iwa.x, wa1 = iwa.y, wb0 = iwb.x, wb1 = iwb.y;
            const unsigned bo[8] = {wa0 & 0xffffu, wa0 >> 16, wa1 & 0xffffu, wa1 >> 16, wb0 & 0xffffu, wb0 >> 16, wb1 & 0xffffu, wb1 >> 16};
            float v[8] = {sa.x, sa.y, sa.z, sa.w, sb.x, sb.y, sb.z, sb.w};
            float tm = -INFINITY;
#pragma unroll
            for (int e = 0; e < 8; ++e) {
                const bool ok = (p0 + (e & 3) + 16 * (e >> 2)) < nvalid;
                const float lg = v[e] * 0.125f + *(const LAS float*)(biasb + bo[e]);
                v[e] = ok ? lg : -INFINITY; tm = fmaxf(tm, v[e]);
            }
            tm = fmaxf(tm, __shfl_xor(tm, 16)); tm = fmaxf(tm, __shfl_xor(tm, 32));
            const float mn = fmaxf(mrun, tm);
            const float alpha = __expf(mrun - mn);
            float ps = 0.f;
#pragma unroll
            for (int e = 0; e < 8; ++e) { v[e] = __expf(v[e] - mn); ps += v[e]; }
            lrun = lrun * alpha + ps; mrun = mn;
#pragma unroll
            for (int dt = 0; dt < 4; ++dt) ot[dt] = ot[dt] * alpha;
            const f16x8 pfr = {(_Float16)v[0], (_Float16)v[1], (_Float16)v[2], (_Float16)v[3], (_Float16)v[4], (_Float16)v[5], (_Float16)v[6], (_Float16)v[7]};
            asm volatile("s_waitcnt lgkmcnt(0)" ::: "memory");
            const int q = n16 >> 2, p = n16 & 3;
#pragma unroll
            for (int dt = 0; dt < 4; ++dt) {
                const s16x4 ta = __builtin_amdgcn_ds_read_tr16_b64_v4i16((LAS s16x4*)(vst + (4 * kc + q) * VPITCH + (16 * dt + 4 * p) * 2));
                const s16x4 tb = __builtin_amdgcn_ds_read_tr16_b64_v4i16((LAS s16x4*)(vst + (16 + 4 * kc + q) * VPITCH + (16 * dt + 4 * p) * 2));
                const f16x4 fa = __builtin_bit_cast(f16x4, ta), fb = __builtin_bit_cast(f16x4, tb);
                const f16x8 vfr = {fa.x, fa.y, fa.z, fa.w, fb.x, fb.y, fb.z, fb.w};
                ot[dt] = __builtin_amdgcn_mfma_f32_16x16x32_f16(vfr, pfr, ot[dt], 0, 0, 0);
            }
            asm volatile("s_waitcnt lgkmcnt(0)" ::: "memory");
        }
#undef DSA_GATHER
        lrun += __shfl_xor(lrun, 16); lrun += __shfl_xor(lrun, 32);
        const float inv = 1.f / fmaxf(lrun, 1e-30f);
        if (head < 8) {
            _Float16* orow = o_a + (size_t)(b * S_ + t) * 1024 + head * 64 + 4 * kc;
#pragma unroll
            for (int dt = 0; dt < 4; ++dt) { u32x2 w; w.x = pg8::pkh(ot[dt].x * inv, ot[dt].y * inv); w.y = pg8::pkh(ot[dt].z * inv, ot[dt].w * inv); *(u32x2*)(orow + 16 * dt) = w; }
        }
    }
    __syncthreads();
}
}


namespace nsa {
typedef _Float16 f16x8 __attribute__((ext_vector_type(8)));
typedef _Float16 f16x4 __attribute__((ext_vector_type(4)));
typedef short s16x4 __attribute__((ext_vector_type(4)));
typedef float f32x4 __attribute__((ext_vector_type(4)));
typedef float f32x16 __attribute__((ext_vector_type(16)));
typedef unsigned u32x4 __attribute__((ext_vector_type(4)));
typedef unsigned u32x2 __attribute__((ext_vector_type(2)));
constexpr int KP = 144, VP = 192;
constexpr int TILE_B = 64 * KP + 64 * VP;
constexpr int L_T0 = 0, L_BIAS = 2 * TILE_B, L_IMPA = L_BIAS + 4096, L_IMPC = L_IMPA + 16384, L_MASK = L_IMPC + 16384, L_END = L_MASK + 512;
static_assert(L_END <= 131072, "nsa LDS");
constexpr float LOG2E = 1.4426950408889634f;
constexpr float SC = 0.125f * LOG2E;
__device__ __forceinline__ float max3f(float a, float b, float c) { float r; asm("v_max3_f32 %0, %1, %2, %3" : "=v"(r) : "v"(a), "v"(b), "v"(c)); return r; }

struct Src { const _Float16* k; const _Float16* v; int pitch; };

struct Stage { u32x4 kr, vr; };
__device__ __forceinline__ void stage_load(Stage& st, const Src& s, int row0, int tid, bool need_v) {
    const int r = tid >> 3, c = tid & 7;
    st.kr = *(const u32x4*)(s.k + (size_t)(row0 + r) * s.pitch + 8 * c);
    if (need_v) st.vr = *(const u32x4*)(s.v + (size_t)(row0 + r) * s.pitch + 8 * c);
}
__device__ __forceinline__ void stage_store(const Stage& st, LAS unsigned char* tb, int tid, bool need_v) {
    const int r = tid >> 3, c = tid & 7;
    *(LAS u32x4*)(tb + r * KP + 16 * c) = st.kr;
    if (need_v) *(LAS u32x4*)(tb + 64 * KP + r * VP + 16 * c) = st.vr;
}

struct RowState { float m, l; f32x16 o0, o1; };

__device__ __forceinline__ void qk_half(const LAS unsigned char* kt, const f16x8 (&qf)[4], int rho, int hi, int kh, f32x16& s0) {
#pragma unroll
    for (int i = 0; i < 16; ++i) s0[i] = 0.f;
    const LAS unsigned char* kb = kt + (32 * kh + rho) * KP + 16 * hi;
#pragma unroll
    for (int ks = 0; ks < 4; ++ks) {
        const f16x8 a0 = *(const LAS f16x8*)(kb + 32 * ks);
        s0 = __builtin_amdgcn_mfma_f32_32x32x16_f16(a0, qf[ks], s0, 0, 0, 0);
    }
}
__device__ __forceinline__ void logits(f32x16& s0, const LAS float* lut, int hb, int hi, int dbase, int dstep, int dlim, bool bit) {
#pragma unroll
    for (int rg = 0; rg < 16; ++rg) {
        const int kl = (rg & 3) + 8 * (rg >> 2) + 4 * hi;
        const int d = dbase - dstep * kl;
        int dc = d < 0 ? 0 : d; dc = dc > 127 ? 127 : dc;
        const float bias = lut[dc * 8 + hb];
        const bool ok = bit && d >= 0 && d < dlim;
        s0[rg] = ok ? fmaf(s0[rg], SC, bias) : -INFINITY;
    }
}
__device__ __forceinline__ void pv_half(RowState& rs, const f32x16& s0, const LAS unsigned char* vt, int rho, int hi, int kh) {
    const int l16 = rho & 15, g16 = rho >> 4, q = l16 >> 2, p = l16 & 3;
    const LAS unsigned char* vb = vt + (32 * kh + 4 * hi + q) * VP + (16 * g16 + 4 * p) * 2;
#pragma unroll
    for (int sx = 0; sx < 2; ++sx) {
        f16x8 pfr;
#pragma unroll
        for (int j = 0; j < 8; ++j) pfr[j] = (_Float16)s0[8 * sx + j];
#pragma unroll
        for (int dt = 0; dt < 2; ++dt) {
            const s16x4 ta = __builtin_amdgcn_ds_read_tr16_b64_v4i16((LAS s16x4*)(vb + (16 * sx) * VP + 64 * dt));
            const s16x4 tb = __builtin_amdgcn_ds_read_tr16_b64_v4i16((LAS s16x4*)(vb + (16 * sx + 8) * VP + 64 * dt));
            const f16x4 fa = __builtin_bit_cast(f16x4, ta), fb = __builtin_bit_cast(f16x4, tb);
            const f16x8 vfr = {fa.x, fa.y, fa.z, fa.w, fb.x, fb.y, fb.z, fb.w};
            if (dt == 0) rs.o0 = __builtin_amdgcn_mfma_f32_32x32x16_f16(vfr, pfr, rs.o0, 0, 0, 0);
            else rs.o1 = __builtin_amdgcn_mfma_f32_32x32x16_f16(vfr, pfr, rs.o1, 0, 0, 0);
        }
    }
}
__device__ __forceinline__ void rescale_if_needed(RowState& rs, float tmx) {
    if (__any(tmx > rs.m + 8.f)) {
        const float mn = fmaxf(rs.m, tmx);
        const float mu = (mn == -INFINITY) ? 0.f : mn;
        const float alpha = __builtin_amdgcn_exp2f(rs.m - mu);
        rs.l *= alpha; rs.m = mn;
#pragma unroll
        for (int i = 0; i < 16; ++i) { rs.o0[i] *= alpha; rs.o1[i] *= alpha; }
    }
}
__device__ __forceinline__ void tile_fast(RowState& rs, const LAS unsigned char* kt, const LAS unsigned char* vt, const f16x8 (&qf)[4], float c, int rho, int hi) {
    const LAS unsigned char* kb = kt + rho * KP + 16 * hi;
    f16x8 ka[4], kb2[4];
#pragma unroll
    for (int ks = 0; ks < 4; ++ks) { ka[ks] = *(const LAS f16x8*)(kb + 32 * ks); kb2[ks] = *(const LAS f16x8*)(kb + 32 * KP + 32 * ks); }
    const int l16 = rho & 15, g16 = rho >> 4, q = l16 >> 2, p = l16 & 3;
    const LAS unsigned char* vb = vt + (4 * hi + q) * VP + (16 * g16 + 4 * p) * 2;
    s16x4 va[4][2], vc[4][2];
    __builtin_amdgcn_sched_barrier(0);
    f32x16 s0, s1;
#pragma unroll
    for (int i = 0; i < 16; ++i) { s0[i] = 0.f; s1[i] = 0.f; }
#pragma unroll
    for (int ks = 0; ks < 4; ++ks) {
        s0 = __builtin_amdgcn_mfma_f32_32x32x16_f16(ka[ks], qf[ks], s0, 0, 0, 0);
        s1 = __builtin_amdgcn_mfma_f32_32x32x16_f16(kb2[ks], qf[ks], s1, 0, 0, 0);
    }
    __builtin_amdgcn_sched_barrier(0);
#pragma unroll
    for (int st = 0; st < 4; ++st)
#pragma unroll
        for (int dt = 0; dt < 2; ++dt) {
            va[st][dt] = __builtin_amdgcn_ds_read_tr16_b64_v4i16((LAS s16x4*)(vb + (16 * st) * VP + 64 * dt));
            vc[st][dt] = __builtin_amdgcn_ds_read_tr16_b64_v4i16((LAS s16x4*)(vb + (16 * st + 8) * VP + 64 * dt));
        }
    __builtin_amdgcn_sched_barrier(0);
    float tm = max3f(s0[0], s1[0], -INFINITY);
#pragma unroll
    for (int i = 1; i < 16; ++i) tm = max3f(tm, s0[i], s1[i]);
    { const auto r2 = __builtin_amdgcn_permlane32_swap(__float_as_uint(tm), __float_as_uint(tm), false, false); tm = fmaxf(__uint_as_float(r2[0]), __uint_as_float(r2[1])); }
    rescale_if_needed(rs, fmaf(tm, SC, c));
    const float mu = (rs.m == -INFINITY) ? 0.f : rs.m;
    const float cm = c - mu;
    float ps = 0.f;
#pragma unroll
    for (int i = 0; i < 16; ++i) { s0[i] = __builtin_amdgcn_exp2f(fmaf(s0[i], SC, cm)); s1[i] = __builtin_amdgcn_exp2f(fmaf(s1[i], SC, cm)); ps += s0[i] + s1[i]; }
    rs.l += ps;
#pragma unroll
    for (int st = 0; st < 4; ++st) {
        f16x8 pfr;
#pragma unroll
        for (int j = 0; j < 8; ++j) pfr[j] = (_Float16)((st & 2) ? s1[8 * (st & 1) + j] : s0[8 * (st & 1) + j]);
#pragma unroll
        for (int dt = 0; dt < 2; ++dt) {
            const f16x4 fa = __builtin_bit_cast(f16x4, va[st][dt]), fb = __builtin_bit_cast(f16x4, vc[st][dt]);
            const f16x8 vfr = {fa.x, fa.y, fa.z, fa.w, fb.x, fb.y, fb.z, fb.w};
            if (dt == 0) rs.o0 = __builtin_amdgcn_mfma_f32_32x32x16_f16(vfr, pfr, rs.o0, 0, 0, 0);
            else rs.o1 = __builtin_amdgcn_mfma_f32_32x32x16_f16(vfr, pfr, rs.o1, 0, 0, 0);
        }
    }
}
template <bool IMP>
__device__ __forceinline__ void tile_general(RowState& rs, const LAS unsigned char* kt, const LAS unsigned char* vt, const f16x8 (&qf)[4], const LAS float* lut, int hb, int rho, int hi,
                                             int dbase, int dstep, unsigned dlim, float mc, float invl, LAS float* impA, LAS float* impC, int n, bool wr) {
    const LAS unsigned char* kb = kt + rho * KP + 16 * hi;
    f16x8 ka[4], kb2[4];
#pragma unroll
    for (int ks = 0; ks < 4; ++ks) { ka[ks] = *(const LAS f16x8*)(kb + 32 * ks); kb2[ks] = *(const LAS f16x8*)(kb + 32 * KP + 32 * ks); }
    const int d0 = dbase - dstep * 4 * hi;
    __builtin_amdgcn_sched_barrier(0);
    f32x16 s0, s1;
#pragma unroll
    for (int i = 0; i < 16; ++i) { s0[i] = 0.f; s1[i] = 0.f; }
#pragma unroll
    for (int ks = 0; ks < 4; ++ks) {
        s0 = __builtin_amdgcn_mfma_f32_32x32x16_f16(ka[ks], qf[ks], s0, 0, 0, 0);
        s1 = __builtin_amdgcn_mfma_f32_32x32x16_f16(kb2[ks], qf[ks], s1, 0, 0, 0);
    }
    __builtin_amdgcn_sched_barrier(0);
    float b0[16], b1[16];
#pragma unroll
    for (int rg = 0; rg < 16; ++rg) {
        const int kl = (rg & 3) + 8 * (rg >> 2);
        int da = d0 - dstep * kl, db = d0 - dstep * (kl + 32);
        da = da < 0 ? 0 : da; da = da > 127 ? 127 : da; db = db < 0 ? 0 : db; db = db > 127 ? 127 : db;
        b0[rg] = lut[da * 8 + hb]; b1[rg] = lut[db * 8 + hb];
    }
    float tm = -INFINITY;
#pragma unroll
    for (int rg = 0; rg < 16; ++rg) {
        const int kl = (rg & 3) + 8 * (rg >> 2);
        const unsigned da = (unsigned)(d0 - dstep * kl), db = (unsigned)(d0 - dstep * (kl + 32));
        s0[rg] = da < dlim ? fmaf(s0[rg], SC, b0[rg]) : -INFINITY;
        s1[rg] = db < dlim ? fmaf(s1[rg], SC, b1[rg]) : -INFINITY;
        tm = max3f(tm, s0[rg], s1[rg]);
    }
    __builtin_amdgcn_sched_barrier(0);
    const int l16 = rho & 15, g16 = rho >> 4, q = l16 >> 2, p = l16 & 3;
    const LAS unsigned char* vb = vt + (4 * hi + q) * VP + (16 * g16 + 4 * p) * 2;
    s16x4 va[4][2], vc[4][2];
    if (!IMP) {
#pragma unroll
        for (int st = 0; st < 4; ++st)
#pragma unroll
            for (int dt = 0; dt < 2; ++dt) {
                va[st][dt] = __builtin_amdgcn_ds_read_tr16_b64_v4i16((LAS s16x4*)(vb + (16 * st) * VP + 64 * dt));
                vc[st][dt] = __builtin_amdgcn_ds_read_tr16_b64_v4i16((LAS s16x4*)(vb + (16 * st + 8) * VP + 64 * dt));
            }
        __builtin_amdgcn_sched_barrier(0);
    }
    if (!IMP) {
        { const auto r2 = __builtin_amdgcn_permlane32_swap(__float_as_uint(tm), __float_as_uint(tm), false, false); tm = fmaxf(__uint_as_float(r2[0]), __uint_as_float(r2[1])); }
        rescale_if_needed(rs, tm);
        const float mu = (rs.m == -INFINITY) ? 0.f : rs.m;
        float ps = 0.f;
#pragma unroll
        for (int i = 0; i < 16; ++i) { s0[i] = __builtin_amdgcn_exp2f(s0[i] - mu); s1[i] = __builtin_amdgcn_exp2f(s1[i] - mu); ps += s0[i] + s1[i]; }
        rs.l += ps;
#pragma unroll
        for (int st = 0; st < 4; ++st) {
            f16x8 pfr;
#pragma unroll
            for (int j = 0; j < 8; ++j) pfr[j] = (_Float16)((st & 2) ? s1[8 * (st & 1) + j] : s0[8 * (st & 1) + j]);
#pragma unroll
            for (int dt = 0; dt < 2; ++dt) {
                const f16x4 fa = __builtin_bit_cast(f16x4, va[st][dt]), fb = __builtin_bit_cast(f16x4, vc[st][dt]);
                const f16x8 vfr = {fa.x, fa.y, fa.z, fa.w, fb.x, fb.y, fb.z, fb.w};
                if (dt == 0) rs.o0 = __builtin_amdgcn_mfma_f32_32x32x16_f16(vfr, pfr, rs.o0, 0, 0, 0);
                else rs.o1 = __builtin_amdgcn_mfma_f32_32x32x16_f16(vfr, pfr, rs.o1, 0, 0, 0);
            }
        }
    } else {
        const float mu = (mc == -INFINITY) ? 0.f : mc;
#pragma unroll
        for (int kh = 0; kh < 2; ++kh)
#pragma unroll
            for (int ii = 0; ii < 4; ++ii) {
                float pv[4];
#pragma unroll
                for (int e = 0; e < 4; ++e) pv[e] = __builtin_amdgcn_exp2f((kh ? s1[4 * ii + e] : s0[4 * ii + e]) - mu) * invl;
                float a = (pv[0] + pv[1]) + (pv[2] + 0.5f * pv[3]), c = 0.5f * pv[3];
                a += __shfl_xor(a, 1); a += __shfl_xor(a, 2); c += __shfl_xor(c, 1); c += __shfl_xor(c, 2);
                const int nb = 16 * n + 8 * kh + 2 * ii + hi;
                if (wr) { impA[nb] = a; if (nb + 1 < 64) impC[nb + 1] = c; }
            }
    }
}
__device__ __forceinline__ void probs(RowState& rs, f32x16& s0, float sc, float c) {
    float tm = -INFINITY;
#pragma unroll
    for (int i = 0; i < 16; ++i) tm = fmaxf(tm, s0[i]);
    tm = fmaxf(tm, __shfl_xor(tm, 32));
    rescale_if_needed(rs, fmaf(tm, sc, c));
    const float mu = (rs.m == -INFINITY) ? 0.f : rs.m;
    const float cm = c - mu;
    float ps = 0.f;
#pragma unroll
    for (int i = 0; i < 16; ++i) { s0[i] = __builtin_amdgcn_exp2f(fmaf(s0[i], sc, cm)); ps += s0[i]; }
    rs.l += ps;
}
__device__ __forceinline__ void rs_init(RowState& rs) { rs.m = -INFINITY; rs.l = 0.f;
#pragma unroll
    for (int i = 0; i < 16; ++i) { rs.o0[i] = 0.f; rs.o1[i] = 0.f; } }
template <int MODE>
__device__ __forceinline__ void rs_flush(RowState& rs, float gate, LAS unsigned char* accl, _Float16* orow) {
    const float lt = rs.l + __shfl_xor(rs.l, 32);
    const float w = gate / fmaxf(lt, 1e-30f);
#pragma unroll
    for (int i = 0; i < 4; ++i) {
        float a[8] = {w * rs.o0[4 * i], w * rs.o0[4 * i + 1], w * rs.o0[4 * i + 2], w * rs.o0[4 * i + 3], w * rs.o1[4 * i], w * rs.o1[4 * i + 1], w * rs.o1[4 * i + 2], w * rs.o1[4 * i + 3]};
        LAS unsigned char* ap = accl + (i >> 1) * 16384 + (i & 1) * 1024;
        if (MODE != 0) { float p[8]; pg8::unpk8(*(const LAS u32x4*)ap, p);
#pragma unroll
            for (int e = 0; e < 8; ++e) a[e] += p[e]; }
        u32x4 wv; wv.x = pg8::pkh(a[0], a[1]); wv.y = pg8::pkh(a[2], a[3]); wv.z = pg8::pkh(a[4], a[5]); wv.w = pg8::pkh(a[6], a[7]);
        if (MODE != 2) *(LAS u32x4*)ap = wv;
        else { u32x2 w0; w0.x = wv.x; w0.y = wv.y; u32x2 w1; w1.x = wv.z; w1.y = wv.w; *(u32x2*)(orow + 8 * i) = w0; *(u32x2*)(orow + 32 + 8 * i) = w1; }
    }
}

__device__ __forceinline__ void nsa_unit(LAS unsigned char* lds, const _Float16* __restrict__ proj, const _Float16* __restrict__ kcmp, const _Float16* __restrict__ vcmp,
                                         _Float16* __restrict__ o_b, int b, int g, int qb) {
    const int tid = threadIdx.x, lane = tid & 63, wave = __builtin_amdgcn_readfirstlane(tid >> 6);
    const int rho = lane & 31, hi = lane >> 5, ql = rho >> 2, r = rho & 3, hb = g * 4 + r;
    const int t = 64 * qb + 8 * wave + ql;
    const _Float16* prow = proj + (size_t)(b * S_ + t) * PW;
    f16x8 qf[4];
#pragma unroll
    for (int ks = 0; ks < 4; ++ks) qf[ks] = *(const f16x8*)(prow + C_QB + hb * 64 + 16 * ks + 8 * hi);
    for (int i = tid; i < 2048; i += 512) ((LAS u32x4*)(lds + L_IMPA))[i] = (u32x4){0u, 0u, 0u, 0u};
    RowState rs; rs_init(rs);
    const LAS float* lut = (const LAS float*)(lds + L_BIAS);
    const float bias31 = lut[127 * 8 + hb];
    const _Float16* kc = kcmp + (size_t)(b * 2 + g) * 256 * 64;
    const long vcoff = (vcmp + (size_t)(b * 2 + g) * 256 * 64) - kc;
    const _Float16* pb = proj + (size_t)(b * S_) * PW + C_KVB + g * 64;
    const int ncmp = (4 * qb + 3 + 63) / 64;
    const int wlo = qb - 8 > 0 ? qb - 8 : 0;
    const int e0 = ncmp, e1 = 2 * ncmp, e2 = e1 + qb + 1, NT = e2 + (qb - wlo + 1);
    const int sr = tid >> 3, scq = tid & 7;
    float mc = 0.f, invl = 0.f; unsigned mlo = 0u, mhi = 0u;
    Stage stg;
#define NSA_DECODE(i, br, n) do { if ((i) < e0) { br = 0; n = (i); } else if ((i) < e1) { br = 1; n = (i) - e0; } else if ((i) < e2) { br = 2; n = (i) - e1; } else { br = 3; n = wlo + (i) - e2; } } while (0)
#define NSA_LOAD(i) do { int br_, n_; NSA_DECODE(i, br_, n_); const _Float16* kp_ = (br_ < 2) ? kc : (br_ == 2 ? pb + 2 * 128 : pb + 4 * 128); const int pitch_ = (br_ < 2) ? 64 : PW; \
        const long vo_ = (br_ < 2) ? vcoff : 128; const _Float16* rp_ = kp_ + (size_t)(64 * n_ + sr) * pitch_ + 8 * scq; stg.kr = *(const u32x4*)rp_; stg.vr = *(const u32x4*)(rp_ + vo_); } while (0)
#define NSA_STORE(buf) do { LAS unsigned char* tb_ = lds + L_T0 + (buf) * TILE_B; *(LAS u32x4*)(tb_ + sr * KP + 16 * scq) = stg.kr; *(LAS u32x4*)(tb_ + 64 * KP + sr * VP + 16 * scq) = stg.vr; } while (0)
    __syncthreads();
    NSA_LOAD(0); NSA_STORE(0);
    __syncthreads();
#pragma unroll 1
    for (int i = 0; i < NT; ++i) {
        int br, n; NSA_DECODE(i, br, n);
        const LAS unsigned char* tb = lds + L_T0 + (i & 1) * TILE_B;
        const bool more = i + 1 < NT;
        if (more) NSA_LOAD(i + 1);
        bool bit = true; int dbase, dstep = 1, dlim = 1 << 30; bool near = true;
        if (br < 2) { dbase = t - 31 - 1024 * n; dstep = 16; }
        else { dbase = t - 64 * n; near = n >= qb - 2; if (br == 2) bit = (n < 32) ? ((mlo >> n) & 1u) : ((mhi >> (n - 32)) & 1u); else dlim = 512; }
        const bool interior = (br >= 2) && (n <= qb - 3) && !(br == 3 && n == qb - 8);
        const bool skip = (br == 2) && !__any(bit);
        if (!skip) {
            if (interior) tile_fast(rs, tb, tb + 64 * KP, qf, bit ? bias31 : -INFINITY, rho, hi);
            else {
                const unsigned dl = bit ? (unsigned)dlim : 0u;
                int tq = threadIdx.x; asm volatile("" : "+v"(tq));
                LAS float* impA = (LAS float*)(lds + L_IMPA) + ((tq >> 6) * 8 + ((tq & 31) >> 2)) * 64;
                LAS float* impC = (LAS float*)(lds + L_IMPC) + ((tq >> 6) * 8 + ((tq & 31) >> 2)) * 64;
                if (br != 1) tile_general<false>(rs, tb, tb + 64 * KP, qf, lut, hb, rho, hi, dbase, dstep, dl, 0.f, 0.f, impA, impC, n, false);
                else tile_general<true>(rs, tb, tb + 64 * KP, qf, lut, hb, rho, hi, dbase, dstep, dl, mc, invl, impA, impC, n, r == 0);
            }
        }
        if (i + 1 == e0) {
            mc = rs.m; const float lc = rs.l + __shfl_xor(rs.l, 32); invl = 1.f / fmaxf(lc, 1e-30f);
        } else if (i + 1 == e1) {
            asm volatile("s_waitcnt lgkmcnt(0)" ::: "memory");
            int tq = threadIdx.x; asm volatile("" : "+v"(tq));
            const int qs = (tq & 63) >> 3, j = tq & 7, wv = tq >> 6;
            LAS float* sA = (LAS float*)(lds + L_IMPA) + (wv * 8 + qs) * 64;
            const LAS float* sC = (const LAS float*)(lds + L_IMPC) + (wv * 8 + qs) * 64;
            float sc[8];
#pragma unroll
            for (int e = 0; e < 8; ++e) { const int nn = 8 * j + e; const bool forced = (nn == 0) || (nn == qb) || (nn == qb - 1);
                sc[e] = (nn <= qb) ? (forced ? 1.0e4f : (sA[nn] + sC[nn])) : -INFINITY; }
            asm volatile("s_waitcnt lgkmcnt(0)" ::: "memory");
#pragma unroll
            for (int e = 0; e < 8; ++e) sA[8 * j + e] = sc[e];
            asm volatile("s_waitcnt lgkmcnt(0)" ::: "memory");
            int rank[8];
#pragma unroll
            for (int e = 0; e < 8; ++e) rank[e] = 0;
            for (int m = 0; m <= qb; ++m) { const float sm = sA[m];
#pragma unroll
                for (int e = 0; e < 8; ++e) rank[e] += (sm > sc[e] || (sm == sc[e] && m < 8 * j + e)) ? 1 : 0; }
            unsigned bits = 0;
#pragma unroll
            for (int e = 0; e < 8; ++e) bits |= ((8 * j + e <= qb) && rank[e] < 16) ? (1u << e) : 0u;
            ((LAS unsigned char*)(lds + L_MASK))[(wv * 8 + qs) * 8 + j] = (unsigned char)bits;
            asm volatile("s_waitcnt lgkmcnt(0)" ::: "memory");
            const u32x2 mk = *(const LAS u32x2*)(lds + L_MASK + (wv * 8 + ((tq & 31) >> 2)) * 8);
            mlo = mk.x; mhi = mk.y;
            rs_flush<0>(rs, pg8::sigm((float)prow[C_GB + 0 * 8 + hb]), lds + L_IMPA + (tq >> 6) * 2048 + (tq & 63) * 16, nullptr); rs_init(rs);
        } else if (i + 1 == e2) {
            rs_flush<1>(rs, pg8::sigm((float)prow[C_GB + 1 * 8 + hb]), lds + L_IMPA + wave * 2048 + lane * 16, nullptr); rs_init(rs);
        } else if (i + 1 == NT) {
            rs_flush<2>(rs, pg8::sigm((float)prow[C_GB + 2 * 8 + hb]), lds + L_IMPA + wave * 2048 + lane * 16, o_b + (size_t)(b * S_ + t) * 1024 + hb * 64 + 4 * hi);
        }
        if (more) NSA_STORE((i + 1) & 1);
        __syncthreads();
    }
#undef NSA_DECODE
#undef NSA_LOAD
#undef NSA_STORE
}
}


namespace cmpx {
typedef _Float16 f16x8 __attribute__((ext_vector_type(8)));
typedef float f32x4 __attribute__((ext_vector_type(4)));
typedef unsigned u32x4 __attribute__((ext_vector_type(4)));
constexpr int L_PART = 0, L_HID = 65536, HIDP = 272, L_END = L_HID + 16 * HIDP;
__device__ __forceinline__ void item(LAS unsigned char* lds, const _Float16* __restrict__ proj, const float* __restrict__ pe, const _Float16* __restrict__ w1t, const _Float16* __restrict__ w2t,
                                     _Float16* __restrict__ dst, int b, int g, int kv, int ct) {
    const int tid = threadIdx.x, lane = tid & 63, wave = __builtin_amdgcn_readfirstlane(tid >> 6), kc = lane >> 4, n16 = lane & 15;
    f32x4 acc[8];
#pragma unroll
    for (int nt = 0; nt < 8; ++nt) acc[nt] = (f32x4){0.f, 0.f, 0.f, 0.f};
    const int c = 16 * ct + n16;
#pragma unroll 2
    for (int ks = 0; ks < 8; ++ks) {
        const int k0 = 32 * (8 * wave + ks) + 8 * kc, lt = k0 >> 6, d = k0 & 63;
        int trow = 16 * c + lt; trow = trow > S_ - 1 ? S_ - 1 : trow;
        const f16x8 raw = *(const f16x8*)(proj + (size_t)(b * S_ + trow) * PW + C_KVB + kv * 128 + g * 64 + d);
        const f32x4 p0 = *(const f32x4*)(pe + lt * 64 + d), p1 = *(const f32x4*)(pe + lt * 64 + d + 4);
        f16x8 afr;
        afr[0] = (_Float16)((float)raw[0] + p0.x); afr[1] = (_Float16)((float)raw[1] + p0.y); afr[2] = (_Float16)((float)raw[2] + p0.z); afr[3] = (_Float16)((float)raw[3] + p0.w);
        afr[4] = (_Float16)((float)raw[4] + p1.x); afr[5] = (_Float16)((float)raw[5] + p1.y); afr[6] = (_Float16)((float)raw[6] + p1.z); afr[7] = (_Float16)((float)raw[7] + p1.w);
#pragma unroll
        for (int nt = 0; nt < 8; ++nt) {
            const f16x8 bfr = *(const f16x8*)(w1t + (size_t)(16 * nt + n16) * 2048 + k0);
            acc[nt] = __builtin_amdgcn_mfma_f32_16x16x32_f16(afr, bfr, acc[nt], 0, 0, 0);
        }
    }
    LAS float* part = (LAS float*)(lds + L_PART) + wave * 2048;
#pragma unroll
    for (int nt = 0; nt < 8; ++nt) { part[(4 * kc + 0) * 128 + 16 * nt + n16] = acc[nt].x; part[(4 * kc + 1) * 128 + 16 * nt + n16] = acc[nt].y;
        part[(4 * kc + 2) * 128 + 16 * nt + n16] = acc[nt].z; part[(4 * kc + 3) * 128 + 16 * nt + n16] = acc[nt].w; }
    __syncthreads();
    { const LAS float* pp = (const LAS float*)(lds + L_PART);
#pragma unroll
      for (int e = 0; e < 4; ++e) { const int o = tid + 512 * e; float a = 0.f;
#pragma unroll
          for (int w = 0; w < 8; ++w) a += pp[w * 2048 + o];
          const float z = 0.7978845608028654f * (a + 0.044715f * a * a * a);
          const float th = 1.f - 2.f / (__expf(2.f * z) + 1.f);
          ((LAS _Float16*)(lds + L_HID + (o >> 7) * HIDP))[o & 127] = (_Float16)(0.5f * a * (1.f + th)); } }
    __syncthreads();
    if (wave < 4) {
        f32x4 o = {0.f, 0.f, 0.f, 0.f};
#pragma unroll
        for (int ks = 0; ks < 4; ++ks) {
            const f16x8 afr = *(const LAS f16x8*)(lds + L_HID + n16 * HIDP + (32 * ks + 8 * kc) * 2);
            const f16x8 bfr = *(const f16x8*)(w2t + (size_t)(16 * wave + n16) * 128 + 32 * ks + 8 * kc);
            o = __builtin_amdgcn_mfma_f32_16x16x32_f16(afr, bfr, o, 0, 0, 0);
        }
        const float ov[4] = {o.x, o.y, o.z, o.w};
#pragma unroll
        for (int e = 0; e < 4; ++e) { const int cc = 16 * ct + 4 * kc + e; dst[((size_t)(b * 2 + g) * 256 + cc) * 64 + 16 * wave + n16] = (_Float16)(cc == 255 ? 0.f : ov[e]); }
    }
    __syncthreads();
}
}


#define XB_TMO      128
#define XB_XCNT(j)  (256  + 64 * (j))
#define XB_XSUB(j)  (1280 + 64 * (j))
#define XB_XGEN(j)  (2304 + 64 * (j))
#define XB_TOP      3328
#define XB_TOPGEN   3392
#define XCD_BAR_WORDS 3456
#define XB_SPIN_CAP (1u << 18)
__device__ __forceinline__ unsigned xb_ld(unsigned* p)              { return __hip_atomic_load(p, __ATOMIC_RELAXED, __HIP_MEMORY_SCOPE_AGENT); }
__device__ __forceinline__ unsigned xb_add(unsigned* p, unsigned v) { return __hip_atomic_fetch_add(p, v, __ATOMIC_RELAXED, __HIP_MEMORY_SCOPE_AGENT); }
__device__ __forceinline__ unsigned xb_xcc_id() { return (unsigned)__builtin_amdgcn_s_getreg((3 << 11) | 20) & 0xFu; }
#define XB_SPIN(cond, bar) do { unsigned _sp = 0; while (cond) { __builtin_amdgcn_s_sleep(1); \
    if ((++_sp & 255u) == 0u) { if (xb_ld(&(bar)[XB_TMO])) break; if (_sp > XB_SPIN_CAP) { atomicAdd(&(bar)[XB_TMO], 1u); break; } } } } while (0)
struct XcdBarrier { unsigned* bar; unsigned x; volatile LAS unsigned* st; };
__device__ __forceinline__ XcdBarrier xcd_barrier_post(unsigned* bar, volatile LAS unsigned* st) {
    XcdBarrier b; b.bar = bar; b.x = xb_xcc_id(); b.st = st;
    if (threadIdx.x == 0) (void)xb_add(&bar[XB_XCNT(b.x)], 1u);
    return b;
}
__device__ __forceinline__ void xcd_barrier_complete(unsigned* bar, unsigned x, unsigned& nloc, unsigned& nx) {
    const unsigned G = gridDim.x * gridDim.y * gridDim.z;
    unsigned sum, cnt, mine, sp = 0u;
    for (;;) {
        sum = 0u; cnt = 0u; mine = 0u;
#pragma unroll
        for (unsigned j = 0; j < 16; ++j) { const unsigned c = xb_ld(&bar[XB_XCNT(j)]); sum += c; cnt += (c > 0u) ? 1u : 0u; mine = (j == x) ? c : mine; }
        if (sum == G) break;
        __builtin_amdgcn_s_sleep(1);
        if ((++sp & 255u) == 0u) { if (xb_ld(&bar[XB_TMO])) break; if (sp > XB_SPIN_CAP) { atomicAdd(&bar[XB_TMO], 1u); break; } }
    }
    nloc = mine > 0u ? mine : 1u; nx = cnt > 0u ? cnt : 1u;
}
__device__ __forceinline__ void xcd_barrier(const XcdBarrier& b) {
    asm volatile("s_waitcnt vmcnt(0)" ::: "memory");
    __syncthreads();
    if (threadIdx.x == 0) {
        unsigned* bar = b.bar;
        __builtin_amdgcn_s_waitcnt(0);
        unsigned nloc = b.st[0], nx = b.st[1];
        if (nloc == 0u) { xcd_barrier_complete(bar, b.x, nloc, nx); b.st[0] = nloc; b.st[1] = nx; }
        const unsigned old = xb_add(&bar[XB_XSUB(b.x)], 1u);
        const unsigned gen = old / nloc;
        if (old + 1u == (gen + 1u) * nloc) {
            __builtin_amdgcn_fence(__ATOMIC_RELEASE, "agent");
            asm volatile("s_waitcnt vmcnt(0)" ::: "memory");
            const unsigned og = xb_add(&bar[XB_TOP], 1u);
            const unsigned tg = og / nx;
            if (og + 1u == (tg + 1u) * nx) xb_add(&bar[XB_TOPGEN], 1u);
            else XB_SPIN(xb_ld(&bar[XB_TOPGEN]) == tg, bar);
            __builtin_amdgcn_fence(__ATOMIC_ACQUIRE, "agent");
            xb_add(&bar[XB_XGEN(b.x)], 1u);
            asm volatile("s_waitcnt vmcnt(0)" ::: "memory");
        } else {
            XB_SPIN(xb_ld(&bar[XB_XGEN(b.x)]) == gen, bar);
            __builtin_amdgcn_fence(__ATOMIC_ACQUIRE, "agent");
            asm volatile("s_waitcnt vmcnt(0)" ::: "memory");
        }
    }
    __syncthreads();
}

constexpr int MEGA_LDS = 131072 + 256;

template <class Epi>
__device__ __forceinline__ void gemm_run(LAS unsigned char* lds, const void* A, const void* Bt, const Epi& E, int M, int N, int K) {
    pg8::Gemm g{(const pg8::bf16_t*)A, (const pg8::bf16_t*)Bt, M, N, K};
    pg8::StaticOrder S; S.init(M, N, (int)gridDim.x, (int)blockIdx.x);
    pg8::gemm_phase<Epi, pg8::StaticOrder, true, true>(lds, g, S, E);
}

__global__ void __launch_bounds__(512, 2) mega_fwd(Args a) {
    extern __shared__ __attribute__((aligned(16))) unsigned char lds_raw[];
    LAS unsigned char* lds = (LAS unsigned char*)lds_raw;
    unsigned char* ws = a.ws;
    if (threadIdx.x == 0) *(LAS dsa::u32x4*)(lds + 131072) = (dsa::u32x4){0u, 0u, 0u, 0u};
    __syncthreads();
    XcdBarrier bar = xcd_barrier_post((unsigned*)(ws + WS_CTL), (volatile LAS unsigned*)(lds + 131072));
    const _Float16* proj = (const _Float16*)(ws + WS_PROJ);
    _Float16* o_a = (_Float16*)(ws + WS_H); _Float16* o_b = (_Float16*)(ws + WS_H) + 512;
    _Float16* kcmp = (_Float16*)(ws + WS_KCMP); _Float16* vcmp = (_Float16*)(ws + WS_VCMP);

    prologue_body(a, lds_raw);
    xcd_barrier(bar);
    gemm_run(lds, ws + WS_H, ws + WS_WIN, pg8::EpiProj{(_Float16*)(ws + WS_PROJ)}, M_, PW, D_);
    xcd_barrier(bar);
#pragma unroll 1
    for (int it = blockIdx.x; it < 512; it += gridDim.x) { const int ct = it & 15, kv = (it >> 4) & 1, g = (it >> 5) & 1, b = it >> 6;
        cmpx::item(lds, proj, kv ? a.pe_v : a.pe_k, (const _Float16*)(ws + WS_CW + (kv ? 512 * 1024 : 0)), (const _Float16*)(ws + WS_CW + 1024 * 1024 + (kv ? 16384 : 0)), kv ? vcmp : kcmp, b, g, kv, ct); }
    { LAS float* biaslut = (LAS float*)(lds + dsa::L_BIAS);
      for (int i = threadIdx.x; i < 1024; i += 512) { const int d = i >> 3, h = i & 7; biaslut[i] = a.rel_bias[t5_bucket(d) * 16 + h]; } }
    __syncthreads();
#pragma unroll 1
    for (int v = blockIdx.x >> 3; v < 256; v += (gridDim.x >> 3)) { const int b = blockIdx.x & 7, j = v & 127;
        dsa::dsa_tile(lds, proj, o_a, b, (v < 128) ? 255 - j : j); }
    xcd_barrier(bar);
    { LAS float* lut = (LAS float*)(lds + nsa::L_BIAS);
      for (int i = threadIdx.x; i < 1024; i += 512) { const int d = i >> 3, h = i & 7; lut[i] = a.rel_bias[t5_bucket(d) * 16 + 8 + h] * nsa::LOG2E; } }
    __syncthreads();
#pragma unroll 1
    for (int v = blockIdx.x >> 3; v < 128; v += (gridDim.x >> 3)) { const int bg = 2 * (blockIdx.x & 7) + (v >> 6), j = v & 31;
        nsa::nsa_unit(lds, proj, kcmp, vcmp, o_b, bg >> 1, bg & 1, (v & 32) ? j : 63 - j);
        __syncthreads(); }
    xcd_barrier(bar);
    gemm_run(lds, ws + WS_H, ws + WS_WBA, pg8::EpiMixF{(_Float16*)(ws + WS_MIX), proj}, M_, D_, D_);
    xcd_barrier(bar);
    gemm_run(lds, ws + WS_MIX, ws + WS_WOUT, pg8::EpiResidSq{a.x, a.out, (_Float16*)(ws + WS_H), (float*)(ws + WS_ROWSQ)}, M_, D_, D_);
    xcd_barrier(bar);
    gemm_run(lds, ws + WS_H, ws + WS_WMI, pg8::EpiRelu2N{(_Float16*)(ws + WS_PROJ), (const float*)(ws + WS_ROWSQ)}, M_, DFF, D_);
    xcd_barrier(bar);
#pragma unroll 1
    for (int sl = 0; sl < 2; ++sl) {
        pg8::Gemm g{(const pg8::bf16_t*)(ws + WS_PROJ), (const pg8::bf16_t*)(ws + WS_WMO), M_, D_, DFF};
        SliceOrder SO; SO.S.init(M_, D_, (int)gridDim.x, (int)blockIdx.x); SO.slice = sl;
        pg8::gemm_phase<EpiFinalNorm, SliceOrder, false, true>(lds, g, SO, EpiFinalNorm{a.out, (const _Float16*)(ws + WS_H), a.norm_final, (float*)(ws + WS_XBUF), (unsigned*)(ws + WS_PCNT)});
        __syncthreads();
    }
}
}

extern "C" void kernel_launch(void* const* d_in, const int* in_sizes, int n_in, void* d_out, int out_size, void* d_ws, size_t ws_size, hipStream_t stream) {
    if (ws_size < WS_END) { fprintf(stderr, "ws too small: %zu\n", ws_size); return; }
    static int grid = 0;
    if (!grid) {
        int dev = 0, cus = 0, per_cu = 0;
        (void)hipGetDevice(&dev);
        (void)hipDeviceGetAttribute(&cus, hipDeviceAttributeMultiprocessorCount, dev);
        (void)hipFuncSetAttribute((const void*)mega_fwd, hipFuncAttributeMaxDynamicSharedMemorySize, MEGA_LDS);
        (void)hipOccupancyMaxActiveBlocksPerMultiprocessor(&per_cu, (const void*)mega_fwd, 512, MEGA_LDS);
        (void)hipGetLastError();
        grid = cus;
        if (per_cu < 1) fprintf(stderr, "occupancy query says %d blocks/CU\n", per_cu);
    }
    Args a{};
    a.x = (const float*)d_in[0]; a.norm_mix = (const float*)d_in[1]; a.w_in = (const float*)d_in[2];
    a.pe_k = (const float*)d_in[3]; a.w1_k = (const float*)d_in[4]; a.w2_k = (const float*)d_in[5];
    a.pe_v = (const float*)d_in[6]; a.w1_v = (const float*)d_in[7]; a.w2_v = (const float*)d_in[8];
    a.rel_bias = (const float*)d_in[9]; a.w_ba = (const float*)d_in[10]; a.w_bb = (const float*)d_in[11];
    a.w_out = (const float*)d_in[12]; a.norm_mlp = (const float*)d_in[13]; a.w_mi = (const float*)d_in[14];
    a.w_mo = (const float*)d_in[15]; a.norm_final = (const float*)d_in[16];
    a.out = (float*)d_out; a.ws = (unsigned char*)d_ws;
    (void)hipMemsetAsync(d_ws, 0, 327680, stream);
    hipLaunchKernelGGL(mega_fwd, dim3(grid), dim3(512), MEGA_LDS, stream, a);
}
```

```cpp
#include <hip/hip_runtime.h>
#include <hip/hip_fp16.h>
#include <cstdint>
#include <cstdio>

namespace pg8 {
#define PG8_LAS __attribute__((address_space(3)))
typedef unsigned short bf16_t;
typedef _Float16 bf16x8 __attribute__((ext_vector_type(8)));
typedef float f32x4 __attribute__((ext_vector_type(4)));
typedef unsigned u32x4 __attribute__((ext_vector_type(4)));
constexpr int BM = 256, BK = 64, HALF = 128, HTB = HALF * BK * 2  , STAGE_BYTES = 8 * HTB, NXCD = 8, WGM = 8;

__host__ __device__ __forceinline__ int lds_byte(int r, int c) { const int st = (r >> 4) * 2 + (c >> 5), rr = r & 15, cc = c & 31, ob = rr * 64 + cc * 2; return st * 1024 + (ob ^ (((ob >> 9) & 1) << 5)); }
__host__ __device__ __forceinline__ void stage_rc(int b, int& R, int& C) { const int st = b / 1024, sb = b % 1024, swz = sb ^ (((sb >> 9) & 1) << 5); R = (st >> 1) * 16 + swz / 64; C = (st & 1) * 32 + (swz % 64) / 2; }
__host__ __device__ __forceinline__ int perm32(int rho) { const int n = rho >> 4, i = rho & 15; return 8 * (i >> 2) + 4 * n + (i & 3); }

struct Unit { int pm, pn; };
struct Gemm { const bf16_t* A; const bf16_t* Bt; int M, N, K; };

struct StaticOrder {
    int nM, nN, nwg, G, c;
    __host__ __device__ void init(int M, int N, int G_, int c_) { nM = M / BM; nN = N / BM; nwg = nM * nN; G = G_; c = c_; }
    __host__ __device__ bool next(int i, Unit& u) const {
        const long L = (long)i * G + c; if (L >= nwg) return false;
        int wgid = (int)L; { const int q = nwg / NXCD, r = nwg % NXCD, xcd = wgid % NXCD, off = wgid / NXCD; wgid = (xcd < r ? xcd * (q + 1) : r * (q + 1) + (xcd - r) * q) + off; }
        const int nig = WGM * nN, gid = wgid / nig, fm = gid * WGM, gsz = (nM - fm) < WGM ? (nM - fm) : WGM;
        u.pm = fm + ((wgid % nig) % gsz); u.pn = (wgid % nig) / gsz; return true;
    }
    __device__ __forceinline__ void a_ready(const Unit&) const {}
    __device__ __forceinline__ void done(const Unit&) const {}
};


typedef unsigned u32x2 __attribute__((ext_vector_type(2)));
typedef float f32x2 __attribute__((ext_vector_type(2)));
typedef _Float16 f16x2 __attribute__((ext_vector_type(2)));
constexpr int PW = 4352;
__device__ __forceinline__ unsigned pkh(float a, float b) { f32x2 v = {a, b}; f16x2 h = __builtin_convertvector(v, f16x2); return __builtin_bit_cast(unsigned, h); }
__device__ __forceinline__ float sigm(float v) { return __builtin_amdgcn_rcpf(1.f + __expf(-v)); }
__device__ __forceinline__ float sigm_gate(float v) { return fmaxf(sigm(v), 6.2e-5f); }
__device__ __forceinline__ void unpk8(const u32x4 w, float (&f)[8]) {
#pragma unroll
    for (int i = 0; i < 4; ++i) { const unsigned wi = (i == 0) ? w.x : (i == 1) ? w.y : (i == 2) ? w.z : w.w; const f16x2 h = __builtin_bit_cast(f16x2, wi); f[2 * i] = (float)h.x; f[2 * i + 1] = (float)h.y; } }

struct EpiProj {
    static constexpr bool PERM = true, AFTER_DRAIN = false, MID = false;
    _Float16* O;
    __device__ __forceinline__ void operator()(const f32x4 (&acc)[2][2][4][2], const Unit& u, int wr, int wc, int fr, int fq) const {
        const int row0 = u.pm * BM + wr * 64 + fr, col0 = u.pn * BM + wc * 32 + 8 * fq; const bool sg = u.pn >= 9;
#pragma unroll
        for (int ai = 0; ai < 2; ++ai)
#pragma unroll
            for (int m = 0; m < 4; ++m) { _Float16* rowp = O + (size_t)(row0 + ai * HALF + m * 16) * PW + col0;
#pragma unroll
                for (int bj = 0; bj < 2; ++bj) { f32x4 v0 = acc[ai][bj][m][0], v1 = acc[ai][bj][m][1];
                    if (sg) {
#pragma unroll
                        for (int i = 0; i < 4; ++i) { v0[i] = sigm_gate(v0[i]); v1[i] = sigm_gate(v1[i]); } }
                    u32x4 w; w.x = pkh(v0[0], v0[1]); w.y = pkh(v0[2], v0[3]); w.z = pkh(v1[0], v1[1]); w.w = pkh(v1[2], v1[3]);
                    *(u32x4*)(rowp + bj * HALF) = w; } }
    }
};
struct EpiMixF {
    static constexpr bool PERM = true, AFTER_DRAIN = false, MID = true;
    _Float16* mix; const _Float16* proj;
    __device__ __forceinline__ void mid(f32x4 (&acc)[2][2][4][2], const Unit& u, int wr, int wc, int fr, int fq) const {
        int row0 = u.pm * BM + wr * 64 + fr, col0 = u.pn * BM + wc * 32 + 8 * fq;
        asm volatile("" : "+v"(row0), "+v"(col0));
#pragma unroll
        for (int ai = 0; ai < 2; ++ai)
#pragma unroll
            for (int m2 = 0; m2 < 2; ++m2) {
                u32x4 wa[2][2], wb[2][2];
#pragma unroll
                for (int q = 0; q < 2; ++q) { const _Float16* gr = proj + (size_t)(row0 + ai * HALF + (2 * m2 + q) * 16) * PW + 2304 + col0;
                    wa[q][0] = *(const u32x4*)(gr); wb[q][0] = *(const u32x4*)(gr + 1024); wa[q][1] = *(const u32x4*)(gr + HALF); wb[q][1] = *(const u32x4*)(gr + 1024 + HALF); }
#pragma unroll
                for (int q = 0; q < 2; ++q)
#pragma unroll
                    for (int bj = 0; bj < 2; ++bj) { float ga[8], gb[8]; unpk8(wa[q][bj], ga); unpk8(wb[q][bj], gb); const int m = 2 * m2 + q;
#pragma unroll
                        for (int i = 0; i < 4; ++i) { acc[ai][bj][m][0][i] *= ga[i] * __builtin_amdgcn_rcpf(gb[i]); acc[ai][bj][m][1][i] *= ga[4 + i] * __builtin_amdgcn_rcpf(gb[4 + i]); } }
                __builtin_amdgcn_sched_barrier(0);
            }
    }
    __device__ __forceinline__ void operator()(const f32x4 (&acc)[2][2][4][2], const Unit& u, int wr, int wc, int fr, int fq) const {
        const int row0 = u.pm * BM + wr * 64 + fr, col0 = u.pn * BM + wc * 32 + 8 * fq;
#pragma unroll
        for (int ai = 0; ai < 2; ++ai)
#pragma unroll
            for (int m = 0; m < 4; ++m) { const size_t r = (size_t)(row0 + ai * HALF + m * 16);
#pragma unroll
                for (int bj = 0; bj < 2; ++bj) { const int c = col0 + bj * HALF;
                    float gb[8]; unpk8(*(const u32x4*)(proj + r * PW + 3328 + c), gb);
                    const f32x4 v0 = acc[ai][bj][m][0], v1 = acc[ai][bj][m][1];
                    u32x4 w; w.x = pkh(gb[0] * v0[0], gb[1] * v0[1]); w.y = pkh(gb[2] * v0[2], gb[3] * v0[3]); w.z = pkh(gb[4] * v1[0], gb[5] * v1[1]); w.w = pkh(gb[6] * v1[2], gb[7] * v1[3]);
                    *(u32x4*)(mix + r * 1024 + c) = w; } }
    }
};
struct EpiResidSq {
    static constexpr bool PERM = true, AFTER_DRAIN = false, MID = false;
    const float* x; float* out; _Float16* xh; float* rowsq;
    __device__ __forceinline__ void operator()(const f32x4 (&acc)[2][2][4][2], const Unit& u, int wr, int wc, int fr, int fq) const {
        const int row0 = u.pm * BM + wr * 64 + fr, col0 = u.pn * BM + wc * 32 + 8 * fq;
#pragma unroll
        for (int ai = 0; ai < 2; ++ai)
#pragma unroll
            for (int m = 0; m < 4; ++m) { const size_t r = (size_t)(row0 + ai * HALF + m * 16); float sq = 0.f;
#pragma unroll
                for (int bj = 0; bj < 2; ++bj) { const size_t o = r * 1024 + col0 + bj * HALF;
                    const f32x4 a0 = *(const f32x4*)(x + o) + acc[ai][bj][m][0], a1 = *(const f32x4*)(x + o + 4) + acc[ai][bj][m][1];
                    u32x4 w; w.x = pkh(a0[0], a0[1]); w.y = pkh(a0[2], a0[3]); w.z = pkh(a1[0], a1[1]); w.w = pkh(a1[2], a1[3]);
                    *(u32x4*)(xh + o) = w;
                    sq += (a0[0] * a0[0] + a0[1] * a0[1]) + (a0[2] * a0[2] + a0[3] * a0[3]) + (a1[0] * a1[0] + a1[1] * a1[1]) + (a1[2] * a1[2] + a1[3] * a1[3]); }
                sq += __shfl_xor(sq, 16); sq += __shfl_xor(sq, 32);
                if (fq == 0) atomicAdd(rowsq + r, sq); }
    }
};
struct EpiRelu2N {
    static constexpr bool PERM = true, AFTER_DRAIN = false, MID = false;
    _Float16* U; const float* rowsq;
    __device__ __forceinline__ void operator()(const f32x4 (&acc)[2][2][4][2], const Unit& u, int wr, int wc, int fr, int fq) const {
        const int row0 = u.pm * BM + wr * 64 + fr, col0 = u.pn * BM + wc * 32 + 8 * fq;
#pragma unroll
        for (int ai = 0; ai < 2; ++ai)
#pragma unroll
            for (int m = 0; m < 4; ++m) { const int r = row0 + ai * HALF + m * 16; _Float16* rowp = U + (size_t)r * 4096 + col0;
                const float inv = 1.f / (rowsq[r] * (1.f / 1024.f) + 1e-6f);
#pragma unroll
                for (int bj = 0; bj < 2; ++bj) { f32x4 v0 = acc[ai][bj][m][0], v1 = acc[ai][bj][m][1];
#pragma unroll
                    for (int i = 0; i < 4; ++i) { const float a = fmaxf(v0[i], 0.f), b = fmaxf(v1[i], 0.f); v0[i] = a * a * inv; v1[i] = b * b * inv; }
                    u32x4 w; w.x = pkh(v0[0], v0[1]); w.y = pkh(v0[2], v0[3]); w.z = pkh(v1[0], v1[1]); w.w = pkh(v1[2], v1[3]);
                    *(u32x4*)(rowp + bj * HALF) = w; } }
    }
};
template <class Epi, class Sched, bool ALIGN_EPI = false, bool SP2 = false>
__device__ __forceinline__ void gemm_phase(PG8_LAS unsigned char* lds, const Gemm g, const Sched& S, const Epi& E) {
    int tid_ = threadIdx.x; asm volatile("" : "+v"(tid_));
    const int tid = tid_, wid = __builtin_amdgcn_readfirstlane(tid >> 6), lane = tid & 63, wr = wid >> 2, wc = wid & 3, fr = lane & 15, fq = lane >> 4;
    const int K = g.K, nt = K / BK;
    unsigned voffA[2], voffB[2];
#pragma unroll
    for (int i = 0; i < 2; ++i) { int R, C; stage_rc(tid * 16 + i * 8192, R, C); const int Rb = Epi::PERM ? ((R & ~31) + perm32(R & 31)) : R;
        voffA[i] = (unsigned)(R * K + C) * 2u; voffB[i] = (unsigned)(Rb * K + C) * 2u; }
    const size_t kstep = (size_t)(BK * 2);
    const size_t hstep = (size_t)HALF * K * 2;
    const size_t tstep = 2 * hstep;
    const unsigned ldsw = (unsigned)wid * 1024u;
    const int aoff = lds_byte(wr * 64 + fr, fq * 8), boff = lds_byte(wc * 32 + fr, fq * 8);
#define PG8_SA(b, h) (((b) * 2 + (h)) * HTB)
#define PG8_SB(b, h) ((4 + (b) * 2 + (h)) * HTB)
#define PG8_STAGE(bufoff, gbase, voff) do { _Pragma("unroll") for (int _i = 0; _i < 2; ++_i) \
        __builtin_amdgcn_global_load_lds((const unsigned*)((const char*)(gbase) + (voff)[_i]), (PG8_LAS unsigned*)(lds + (bufoff) + ldsw + _i * 8192), 16, 0, 0); } while (0)
#define PG8_LDA(dst, b, h) do { _Pragma("unroll") for (int m = 0; m < 4; ++m) _Pragma("unroll") for (int k = 0; k < 2; ++k) dst[m][k] = *(const PG8_LAS bf16x8*)(lds + PG8_SA(b, h) + aoff + m * 2048 + k * 1024); } while (0)
#define PG8_LDB(dst, b, h) do { _Pragma("unroll") for (int n = 0; n < 2; ++n) _Pragma("unroll") for (int k = 0; k < 2; ++k) dst[n][k] = *(const PG8_LAS bf16x8*)(lds + PG8_SB(b, h) + boff + n * 2048 + k * 1024); } while (0)
#define PG8_MMA(ai, bj, At, Bt) do { __builtin_amdgcn_s_setprio(1); _Pragma("unroll") for (int m = 0; m < 4; ++m) _Pragma("unroll") for (int n = 0; n < 2; ++n) _Pragma("unroll") for (int k = 0; k < 2; ++k) \
        acc[ai][bj][m][n] = __builtin_amdgcn_mfma_f32_16x16x32_f16(Bt[n][k], At[m][k], acc[ai][bj][m][n], 0, 0, 0); __builtin_amdgcn_s_setprio(0); } while (0)
#define PG8_WAIT_V(n) asm volatile("s_waitcnt vmcnt(" #n ")" ::: "memory")
#define PG8_WAIT_L(n) asm volatile("s_waitcnt lgkmcnt(" #n ")" ::: "memory")
#define PG8_BAR __builtin_amdgcn_s_barrier()
#define PG8_SCHED __builtin_amdgcn_sched_barrier(0)
    Unit cur, nxt; int ui = 0;
    if (!S.next(0, cur)) return;
    f32x4 acc[2][2][4][2];
#pragma unroll
    for (int a = 0; a < 2; ++a)
#pragma unroll
        for (int b = 0; b < 2; ++b)
#pragma unroll
            for (int m = 0; m < 4; ++m)
#pragma unroll
                for (int n = 0; n < 2; ++n) acc[a][b][m][n] = (f32x4){0.f, 0.f, 0.f, 0.f};
    bf16x8 At[4][2], B0[2][2], B1[2][2];
    const char* cA = (const char*)g.A + (size_t)cur.pm * tstep; const char* cB = (const char*)g.Bt + (size_t)cur.pn * tstep;
    S.a_ready(cur);
    if constexpr (SP2) {
        PG8_STAGE(PG8_SB(0, 0), cB, voffB); PG8_STAGE(PG8_SB(0, 1), cB + hstep, voffB); PG8_STAGE(PG8_SA(0, 0), cA, voffA); PG8_STAGE(PG8_SA(0, 1), cA + hstep, voffA);
        if (wr == 1) PG8_BAR;
        PG8_WAIT_V(2); PG8_BAR;
        PG8_STAGE(PG8_SB(1, 0), cB + kstep, voffB); PG8_STAGE(PG8_SA(1, 0), cA + kstep, voffA); PG8_STAGE(PG8_SB(1, 1), cB + hstep + kstep, voffB);
        PG8_WAIT_V(6); PG8_BAR;
    } else {
        PG8_STAGE(PG8_SB(0, 0), cB, voffB); PG8_STAGE(PG8_SA(0, 0), cA, voffA); PG8_STAGE(PG8_SB(0, 1), cB + hstep, voffB); PG8_STAGE(PG8_SA(0, 1), cA + hstep, voffA);
        if (wr == 1) PG8_BAR;
        PG8_WAIT_V(4); PG8_BAR;
        PG8_STAGE(PG8_SB(1, 0), cB + kstep, voffB); PG8_STAGE(PG8_SA(1, 0), cA + kstep, voffA); PG8_STAGE(PG8_SB(1, 1), cB + hstep + kstep, voffB);
        PG8_WAIT_V(6); PG8_BAR;
    }
    for (;;) {
        const bool has_next = S.next(ui + 1, nxt);
        const char* nA = has_next ? (const char*)g.A + (size_t)nxt.pm * tstep : cA; const char* nB = has_next ? (const char*)g.Bt + (size_t)nxt.pn * tstep : cB;
        for (int t = 0; t < nt; t += 2) {
            if constexpr (Epi::MID) { if (t == nt / 2) E.mid(acc, cur, wr, wc, fr, fq); }
            const bool last = (t == nt - 2);
            const char* a1 = cA + (size_t)(t + 1) * kstep;
            const char* a2 = last ? nA : cA + (size_t)(t + 2) * kstep; const char* b2 = last ? nB : cB + (size_t)(t + 2) * kstep;
            const char* a3 = a2 + kstep; const char* b3 = b2 + kstep;
            if (last && has_next) S.a_ready(nxt);
            if constexpr (SP2) {
            PG8_LDB(B0, 0, 0); PG8_LDB(B1, 0, 1); PG8_SCHED; PG8_LDA(At, 0, 0); PG8_STAGE(PG8_SA(1, 1), a1 + hstep, voffA);
            PG8_WAIT_V(8); PG8_WAIT_L(0); PG8_BAR; PG8_MMA(0, 0, At, B0); PG8_MMA(0, 1, At, B1); PG8_BAR; PG8_SCHED;
            PG8_LDA(At, 0, 1); PG8_STAGE(PG8_SB(0, 0), b2, voffB); PG8_STAGE(PG8_SB(0, 1), b2 + hstep, voffB); PG8_STAGE(PG8_SA(0, 0), a2, voffA);
            PG8_WAIT_V(8); PG8_WAIT_L(0); PG8_BAR; PG8_MMA(1, 0, At, B0); PG8_MMA(1, 1, At, B1); PG8_BAR; PG8_SCHED;
            PG8_LDB(B0, 1, 0); PG8_LDB(B1, 1, 1); PG8_SCHED; PG8_LDA(At, 1, 0); PG8_STAGE(PG8_SA(0, 1), a2 + hstep, voffA);
            PG8_WAIT_V(8); PG8_WAIT_L(0); PG8_BAR; PG8_MMA(0, 0, At, B0); PG8_MMA(0, 1, At, B1); PG8_BAR; PG8_SCHED;
            PG8_LDA(At, 1, 1); PG8_STAGE(PG8_SB(1, 0), b3, voffB); PG8_STAGE(PG8_SB(1, 1), b3 + hstep, voffB); PG8_STAGE(PG8_SA(1, 0), a3, voffA);
            PG8_WAIT_V(8); PG8_WAIT_L(0); PG8_BAR; PG8_MMA(1, 0, At, B0); PG8_MMA(1, 1, At, B1); PG8_BAR; PG8_SCHED;
            } else {
            PG8_LDB(B0, 0, 0); PG8_SCHED; PG8_LDA(At, 0, 0); PG8_STAGE(PG8_SA(1, 1), a1 + hstep, voffA);
            PG8_WAIT_L(8); PG8_BAR; PG8_WAIT_L(0); PG8_MMA(0, 0, At, B0); PG8_BAR; PG8_SCHED;
            PG8_LDB(B1, 0, 1); PG8_STAGE(PG8_SB(0, 0), b2, voffB);
            PG8_BAR; PG8_WAIT_L(0); PG8_MMA(0, 1, At, B1); PG8_BAR;
            PG8_LDA(At, 0, 1); PG8_STAGE(PG8_SA(0, 0), a2, voffA);
            PG8_BAR; PG8_WAIT_L(0); PG8_MMA(1, 0, At, B0); PG8_BAR; PG8_SCHED;
            PG8_STAGE(PG8_SB(0, 1), b2 + hstep, voffB);
            PG8_WAIT_V(6); PG8_BAR; PG8_MMA(1, 1, At, B1); PG8_BAR;
            PG8_LDB(B0, 1, 0); PG8_SCHED; PG8_LDA(At, 1, 0); PG8_STAGE(PG8_SA(0, 1), a2 + hstep, voffA);
            PG8_WAIT_L(8); PG8_BAR; PG8_WAIT_L(0); PG8_MMA(0, 0, At, B0); PG8_BAR; PG8_SCHED;
            PG8_LDB(B1, 1, 1); PG8_STAGE(PG8_SB(1, 0), b3, voffB);
            PG8_BAR; PG8_WAIT_L(0); PG8_MMA(0, 1, At, B1); PG8_BAR;
            PG8_LDA(At, 1, 1); PG8_STAGE(PG8_SA(1, 0), a3, voffA);
            PG8_BAR; PG8_WAIT_L(0); PG8_MMA(1, 0, At, B0); PG8_BAR; PG8_SCHED;
            PG8_STAGE(PG8_SB(1, 1), b3 + hstep, voffB);
            PG8_WAIT_V(6); PG8_BAR; PG8_MMA(1, 1, At, B1); PG8_BAR;
            }
        }
        if constexpr (ALIGN_EPI) { if (wr == 0) PG8_BAR; }
        if constexpr (!Epi::AFTER_DRAIN) { E(acc, cur, wr, wc, fr, fq); S.done(cur); }
        if (!has_next) break;
#pragma unroll
        for (int a = 0; a < 2; ++a)
#pragma unroll
            for (int b = 0; b < 2; ++b)
#pragma unroll
                for (int m = 0; m < 4; ++m)
#pragma unroll
                    for (int n = 0; n < 2; ++n) acc[a][b][m][n] = (f32x4){0.f, 0.f, 0.f, 0.f};
        cur = nxt; cA = nA; cB = nB; ++ui;
        if constexpr (ALIGN_EPI) { if (wr == 1) PG8_BAR; }
    }
    PG8_WAIT_V(0);
    if constexpr (!ALIGN_EPI) { if (wr == 0) PG8_BAR; }
    PG8_BAR;
    if constexpr (Epi::AFTER_DRAIN) { E.fused(acc, cur, wr, wc, fr, fq, lds, wid, lane); S.done(cur); }
#undef PG8_SA
#undef PG8_SB
#undef PG8_STAGE
#undef PG8_LDA
#undef PG8_LDB
#undef PG8_MMA
#undef PG8_WAIT_V
#undef PG8_WAIT_L
#undef PG8_BAR
#undef PG8_SCHED
}
}


namespace {
constexpr int B_ = 8, S_ = 4096, M_ = B_ * S_, D_ = 1024, DIN = 4288, DFF = 4096;
constexpr int C_QA = 0, C_QB = 512, C_QI = 1024, C_KVB = 1280, C_KA = 2048, C_VA = 2112, C_KI = 2176, C_WI = 2208, C_GB = 2216, C_GATE = 2304;
constexpr int NC = 255;
constexpr float EPS = 1e-6f;
using pg8::PW;
#define GAS __attribute__((address_space(1)))
#define LAS __attribute__((address_space(3)))
typedef unsigned v4u __attribute__((ext_vector_type(4)));
typedef float f32x4 __attribute__((ext_vector_type(4)));

__device__ __forceinline__ int t5_bucket(int n) {
    if (n < 16) return n < 0 ? 0 : n;
    float nf = (float)n;
    int large = 16 + (int)(logf(nf / 16.f) / logf(8.f) * 16.f);
    return large < 31 ? large : 31;
}


__device__ __forceinline__ int win_src_col(int n) {
    if (n < 512) return n;
    if (n < 1024) return 936 + (n - 512);
    if (n < 1280) return 640 + (n - 1024);
    if (n < 2048) return 1448 + (n - 1280);
    if (n < 2112) return 512 + (n - 2048);
    if (n < 2176) return 576 + (n - 2112);
    if (n < 2208) return 896 + (n - 2176);
    if (n < 2216) return 928 + (n - 2208);
    if (n < 2240) return n;
    if (n < 2304) return -1;
    return 2240 + (n - 2304);
}
__device__ __forceinline__ float wave_sum(float v) {
#pragma unroll
    for (int o = 1; o < 64; o <<= 1) v += __shfl_xor(v, o);
    return v;
}
template <bool MAP>
__device__ __forceinline__ void transpose_item(const float* __restrict__ W, int K, int Nsrc, int Ndst, _Float16* __restrict__ WT, const float* __restrict__ gain, float* scr, int item, int lane, int dpitch = 0, int koff = 0) {
    const int nblk = Ndst / 32, kb = item / nblk, nb = item % nblk, k0 = 64 * kb, n0 = 32 * nb;
    const int c4 = lane & 7, nd = n0 + 4 * c4; const int ns = MAP ? win_src_col(nd) : nd;
#pragma unroll
    for (int i = 0; i < 8; ++i) { const int kk = 8 * i + (lane >> 3); f32x4 v = {0.f, 0.f, 0.f, 0.f};
        if (ns >= 0) { v = *(const f32x4*)(W + (size_t)(k0 + kk) * Nsrc + ns); if (gain) v = v * gain[k0 + kk]; }
        float* sp = scr + kk * 33 + 4 * c4; sp[0] = v.x; sp[1] = v.y; sp[2] = v.z; sp[3] = v.w; }
    __builtin_amdgcn_s_waitcnt(0xc07f); asm volatile("" ::: "memory");
    const int c = lane & 7;
#pragma unroll
    for (int j = 0; j < 4; ++j) { const int n = (lane >> 3) + 8 * j; const float* s = scr + (8 * c) * 33 + n;
        v4u o; o.x = pg8::pkh(s[0 * 33], s[1 * 33]); o.y = pg8::pkh(s[2 * 33], s[3 * 33]); o.z = pg8::pkh(s[4 * 33], s[5 * 33]); o.w = pg8::pkh(s[6 * 33], s[7 * 33]);
        *(v4u*)(WT + (size_t)(n0 + n) * (dpitch ? dpitch : K) + koff + k0 + 8 * c) = o; }
    __builtin_amdgcn_s_waitcnt(0xc07f); asm volatile("" ::: "memory");
}
__device__ __forceinline__ void rms_row_to_f16(const float* __restrict__ xrow, _Float16* __restrict__ orow, int lane) {
    const f32x4* xr = (const f32x4*)xrow + lane;
    f32x4 v[4]; float s = 0.f;
#pragma unroll
    for (int j = 0; j < 4; ++j) { v[j] = xr[64 * j]; s += (v[j].x * v[j].x + v[j].y * v[j].y) + (v[j].z * v[j].z + v[j].w * v[j].w); }
    const float rstd = rsqrtf(wave_sum(s) * (1.f / D_) + EPS);
    unsigned long long* o8 = (unsigned long long*)orow + lane;
#pragma unroll
    for (int j = 0; j < 4; ++j) o8[64 * j] = (unsigned long long)pg8::pkh(v[j].x * rstd, v[j].y * rstd) | ((unsigned long long)pg8::pkh(v[j].z * rstd, v[j].w * rstd) << 32);
}

struct Args {
    const float* x; const float* norm_mix; const float* w_in; const float* pe_k; const float* w1_k; const float* w2_k; const float* pe_v; const float* w1_v; const float* w2_v;
    const float* rel_bias; const float* w_ba; const float* w_bb; const float* w_out; const float* norm_mlp; const float* w_mi; const float* w_mo; const float* norm_final;
    float* out; unsigned char* ws;
};
constexpr size_t MiB = 1u << 20;
constexpr size_t WS_PCNT = 32768, WS_XBUF = 524288;
constexpr size_t WS_ROWSQ = 65536, WS_ROWSQ2 = 196608;
constexpr size_t WS_CTL = 0, WS_WIN = 1 * MiB, WS_WBA = 10 * MiB, WS_WBB = 11 * MiB, WS_WOUT = 12 * MiB, WS_WMI = 14 * MiB, WS_WMO = 22 * MiB, WS_CW = 30 * MiB,
                 WS_KCMP = 32 * MiB, WS_VCMP = 33 * MiB, WS_H = 34 * MiB, WS_PROJ = 98 * MiB, WS_MIX = 370 * MiB, WS_END = 434 * MiB;

__device__ __forceinline__ void prologue_body(const Args& a, unsigned char* lds) {
    const int tid = threadIdx.x, lane = tid & 63, wave = tid >> 6;
    float* scr = (float*)(lds + wave * 8704);
    const int gw = blockIdx.x * 8 + wave, NGW = gridDim.x * 8;
    constexpr int I_IN = (D_ / 64) * (PW / 32), I_BA = (512 / 64) * (D_ / 32), I_OUT = (D_ / 64) * (D_ / 32), I_MI = (D_ / 64) * (DFF / 32), I_MO = (DFF / 64) * (D_ / 32);
    constexpr int I_C1 = (2048 / 64) * (128 / 32), I_C2 = (128 / 64) * (64 / 32);
    constexpr int NITEMS = I_IN + 2 * I_BA + I_OUT + I_MI + I_MO + 2 * I_C1 + 2 * I_C2;
    for (int it = gw; it < NITEMS; it += NGW) {
        int r = it;
        if (r < I_IN) { transpose_item<true>(a.w_in, D_, DIN, PW, (_Float16*)(a.ws + WS_WIN), a.norm_mix, scr, r, lane); continue; } r -= I_IN;
        if (r < I_BA) { transpose_item<false>(a.w_ba, 512, D_, D_, (_Float16*)(a.ws + WS_WBA), nullptr, scr, r, lane, 1024, 0); continue; } r -= I_BA;
        if (r < I_BA) { transpose_item<false>(a.w_bb, 512, D_, D_, (_Float16*)(a.ws + WS_WBA), nullptr, scr, r, lane, 1024, 512); continue; } r -= I_BA;
        if (r < I_OUT) { transpose_item<false>(a.w_out, D_, D_, D_, (_Float16*)(a.ws + WS_WOUT), nullptr, scr, r, lane); continue; } r -= I_OUT;
        if (r < I_MI) { transpose_item<false>(a.w_mi, D_, DFF, DFF, (_Float16*)(a.ws + WS_WMI), a.norm_mlp, scr, r, lane); continue; } r -= I_MI;
        if (r < I_MO) { transpose_item<false>(a.w_mo, DFF, D_, D_, (_Float16*)(a.ws + WS_WMO), nullptr, scr, r, lane); continue; } r -= I_MO;
        if (r < I_C1) { transpose_item<false>(a.w1_k, 2048, 128, 128, (_Float16*)(a.ws + WS_CW), nullptr, scr, r, lane); continue; } r -= I_C1;
        if (r < I_C1) { transpose_item<false>(a.w1_v, 2048, 128, 128, (_Float16*)(a.ws + WS_CW + 512 * 1024), nullptr, scr, r, lane); continue; } r -= I_C1;
        if (r < I_C2) { transpose_item<false>(a.w2_k, 128, 64, 64, (_Float16*)(a.ws + WS_CW + 1024 * 1024), nullptr, scr, r, lane); continue; } r -= I_C2;
        transpose_item<false>(a.w2_v, 128, 64, 64, (_Float16*)(a.ws + WS_CW + 1024 * 1024 + 16384), nullptr, scr, r, lane);
    }
#pragma unroll 4
    for (int m = gw; m < M_; m += NGW) rms_row_to_f16(a.x + (size_t)m * D_, (_Float16*)(a.ws + WS_H) + (size_t)m * D_, lane);
}
struct EpiAccOut {
    static constexpr bool PERM = true, AFTER_DRAIN = false, MID = false;
    _Float16* x2h; const _Float16* xh; float* rowsq;
    __device__ __forceinline__ void operator()(const f32x4 (&acc)[2][2][4][2], const pg8::Unit& u, int wr, int wc, int fr, int fq) const {
        const int row0 = u.pm * 256 + wr * 64 + fr, col0 = u.pn * 256 + wc * 32 + 8 * fq;
#pragma unroll
        for (int ai = 0; ai < 2; ++ai)
#pragma unroll
            for (int m = 0; m < 4; ++m) { const size_t r = (size_t)(row0 + ai * 128 + m * 16); float sq = 0.f;
#pragma unroll
                for (int bj = 0; bj < 2; ++bj) { const size_t o = r * 1024 + col0 + bj * 128;
                    float p[8]; pg8::unpk8(*(const pg8::u32x4*)(xh + o), p);
                    const f32x4 a0 = acc[ai][bj][m][0], a1 = acc[ai][bj][m][1];
                    const float v[8] = {p[0] + a0[0], p[1] + a0[1], p[2] + a0[2], p[3] + a0[3], p[4] + a1[0], p[5] + a1[1], p[6] + a1[2], p[7] + a1[3]};
                    pg8::u32x4 w; w.x = pg8::pkh(v[0], v[1]); w.y = pg8::pkh(v[2], v[3]); w.z = pg8::pkh(v[4], v[5]); w.w = pg8::pkh(v[6], v[7]);
                    *(pg8::u32x4*)(x2h + o) = w;
                    sq += (v[0] * v[0] + v[1] * v[1]) + (v[2] * v[2] + v[3] * v[3]) + (v[4] * v[4] + v[5] * v[5]) + (v[6] * v[6] + v[7] * v[7]); }
                sq += __shfl_xor(sq, 16); sq += __shfl_xor(sq, 32);
                if (fq == 0) atomicAdd(rowsq + r, sq); }
    }
};
__device__ __forceinline__ void final_scale_row(const _Float16* __restrict__ xrow, float* __restrict__ orow, const float* __restrict__ g, float rsq, int lane) {
    const float rstd = rsqrtf(rsq * (1.f / D_) + EPS);
#pragma unroll
    for (int j = 0; j < 2; ++j) {
        float p[8]; pg8::unpk8(*((const pg8::u32x4*)xrow + lane + 64 * j), p);
        const f32x4 g0 = *((const f32x4*)g + 2 * (lane + 64 * j)), g1 = *((const f32x4*)g + 2 * (lane + 64 * j) + 1);
        *((f32x4*)orow + 2 * (lane + 64 * j)) = (f32x4){p[0] * rstd * g0.x, p[1] * rstd * g0.y, p[2] * rstd * g0.z, p[3] * rstd * g0.w};
        *((f32x4*)orow + 2 * (lane + 64 * j) + 1) = (f32x4){p[4] * rstd * g1.x, p[5] * rstd * g1.y, p[6] * rstd * g1.z, p[7] * rstd * g1.w};
    }
}

struct SliceOrder {
    pg8::StaticOrder S; int slice;
    __device__ bool next(int i, pg8::Unit& u) const { return i == 0 ? S.next(slice, u) : false; }
    __device__ __forceinline__ void a_ready(const pg8::Unit&) const {}
    __device__ __forceinline__ void done(const pg8::Unit&) const {}
};
struct EpiFinalNorm {
    static constexpr bool PERM = true, AFTER_DRAIN = true, MID = false;
    float* out; const _Float16* xh; const float* g; float* xbuf; unsigned* cnt;
    __device__ __forceinline__ void fused(f32x4 (&acc)[2][2][4][2], const pg8::Unit& u, int wr, int wc, int fr, int fq, PG8_LAS unsigned char* lds, int wid, int lane) const {
        const int rl0 = wr * 64 + fr, col0 = u.pn * 256 + wc * 32 + 8 * fq;
        PG8_LAS float* red = (PG8_LAS float*)lds;
#pragma unroll
        for (int ai = 0; ai < 2; ++ai)
#pragma unroll
            for (int m = 0; m < 4; ++m) { const int rl = rl0 + ai * 128 + m * 16; const size_t r = (size_t)(u.pm * 256 + rl); float sq = 0.f;
#pragma unroll
                for (int bj = 0; bj < 2; ++bj) { float p[8]; pg8::unpk8(*(const pg8::u32x4*)(xh + r * 1024 + col0 + bj * 128), p);
#pragma unroll
                    for (int i = 0; i < 4; ++i) { acc[ai][bj][m][0][i] += p[i]; acc[ai][bj][m][1][i] += p[4 + i];
                        sq = fmaf(acc[ai][bj][m][0][i], acc[ai][bj][m][0][i], sq); sq = fmaf(acc[ai][bj][m][1][i], acc[ai][bj][m][1][i], sq); } }
                sq += __shfl_xor(sq, 16); sq += __shfl_xor(sq, 32);
                if (fq == 0) red[wc * 256 + rl] = sq; }
        __syncthreads();
        const int tid = wid * 64 + lane;
        if (tid < 256) { const float tot = (red[tid] + red[256 + tid]) + (red[512 + tid] + red[768 + tid]);
            __hip_atomic_store(xbuf + ((size_t)u.pm * 4 + u.pn) * 256 + tid, tot, __ATOMIC_RELAXED, __HIP_MEMORY_SCOPE_AGENT); }
        asm volatile("s_waitcnt vmcnt(0)" ::: "memory");
        __syncthreads();
        if (tid == 0) { __hip_atomic_fetch_add(cnt + u.pm, 1u, __ATOMIC_RELAXED, __HIP_MEMORY_SCOPE_AGENT);
            unsigned sp = 0; while (__hip_atomic_load(cnt + u.pm, __ATOMIC_RELAXED, __HIP_MEMORY_SCOPE_AGENT) < 4u && ++sp < (1u << 22)) __builtin_amdgcn_s_sleep(1); }
        __syncthreads();
        if (tid < 256) { float tot = 0.f;
#pragma unroll
            for (int q = 0; q < 4; ++q) tot += __hip_atomic_load(xbuf + ((size_t)u.pm * 4 + q) * 256 + tid, __ATOMIC_RELAXED, __HIP_MEMORY_SCOPE_AGENT);
            red[1024 + tid] = rsqrtf(tot * (1.f / 1024.f) + 1e-6f); }
        __syncthreads();
#pragma unroll
        for (int ai = 0; ai < 2; ++ai)
#pragma unroll
            for (int m = 0; m < 4; ++m) { const int rl = rl0 + ai * 128 + m * 16; const size_t r = (size_t)(u.pm * 256 + rl); const float rstd = red[1024 + rl];
#pragma unroll
                for (int bj = 0; bj < 2; ++bj) { const int c = col0 + bj * 128; const f32x4 g0 = *(const f32x4*)(g + c), g1 = *(const f32x4*)(g + c + 4);
                    *(f32x4*)(out + r * 1024 + c) = acc[ai][bj][m][0] * rstd * g0; *(f32x4*)(out + r * 1024 + c + 4) = acc[ai][bj][m][1] * rstd * g1; } }
        __syncthreads();
    }
};

namespace dsa {
typedef _Float16 f16x8 __attribute__((ext_vector_type(8)));
typedef _Float16 f16x4 __attribute__((ext_vector_type(4)));
typedef short s16x4 __attribute__((ext_vector_type(4)));
typedef float f32x4 __attribute__((ext_vector_type(4)));
typedef unsigned u32x4 __attribute__((ext_vector_type(4)));
typedef unsigned u32x2 __attribute__((ext_vector_type(2)));
constexpr int TQ = 16, NBIN = 2048, CANDCAP = 512, VPITCH = 144;
constexpr int L_HIST = 0, L_SEL = 65536, L_SELD = L_SEL + 8192, L_CTL = L_SELD + 8192, L_BIAS = L_CTL + 512, L_VST = L_BIAS + 4096, L_END = L_VST + 8 * 32 * VPITCH;
static_assert(L_END <= 131072, "dsa LDS");

__device__ __forceinline__ float idx_score(const f32x4 a1, const f32x4 a2, float lin, const float (&wh)[8]) {
    float s = fmaf(wh[0], fabsf(a1.x), lin);
    s = fmaf(wh[1], fabsf(a1.y), s); s = fmaf(wh[2], fabsf(a1.z), s); s = fmaf(wh[3], fabsf(a1.w), s);
    s = fmaf(wh[4], fabsf(a2.x), s); s = fmaf(wh[5], fabsf(a2.y), s); s = fmaf(wh[6], fabsf(a2.z), s); s = fmaf(wh[7], fabsf(a2.w), s);
    return s;
}
__device__ __forceinline__ int score_bin(float sc, float inv) { int b = (int)(fmaf(sc, inv, 1024.f)); b = b < 0 ? 0 : b; return b > NBIN - 1 ? NBIN - 1 : b; }

template <int PASS>
__device__ __forceinline__ void score_pass(LAS unsigned char* lds, const _Float16* __restrict__ proj, int b, int t0, int nkb, int wave, int lane,
                                           const f16x8 (&afr)[4][2], const f16x8 alin, const float (&wq)[4][8], const float (&binv)[4]) {
    LAS unsigned* hist = (LAS unsigned*)(lds + L_HIST);
    LAS unsigned short* sel = (LAS unsigned short*)(lds + L_SEL);
    LAS unsigned short* seld = (LAS unsigned short*)(lds + L_SELD);
    LAS u32x2* cand = (LAS u32x2*)(lds + L_HIST);
    LAS int* ctl = (LAS int*)(lds + L_CTL);
    const int kc = lane >> 4, n16 = lane & 15;
    int bst[4];
#pragma unroll
    for (int grp = 0; grp < 4; ++grp) bst[grp] = (PASS == 2) ? ctl[(4 * grp + kc) * 8 + 2] : 0;
    const f32x4 zero = {0.f, 0.f, 0.f, 0.f};
    const _Float16* kbase = proj + (size_t)(b * S_ + n16) * PW + C_KI + 8 * kc;
    f16x8 bnext = *(const f16x8*)(kbase + (size_t)(16 * (wave < nkb ? wave : 0)) * PW);
    for (int kb = wave; kb < nkb; kb += 8) {
        const f16x8 bfr = bnext;
        { const int kn = kb + 8 < nkb ? kb + 8 : kb; bnext = *(const f16x8*)(kbase + (size_t)(16 * kn) * PW); }
        const int s = 16 * kb + n16;
        const bool lastkb = kb == nkb - 1;
        const f32x4 a3 = __builtin_amdgcn_mfma_f32_16x16x32_f16(alin, bfr, zero, 0, 0, 0);
        const float lin4[4] = {a3.x, a3.y, a3.z, a3.w};
#pragma unroll
        for (int grp = 0; grp < 4; ++grp) {
            const f32x4 a1 = __builtin_amdgcn_mfma_f32_16x16x32_f16(afr[grp][0], bfr, zero, 0, 0, 0);
            const f32x4 a2 = __builtin_amdgcn_mfma_f32_16x16x32_f16(afr[grp][1], bfr, zero, 0, 0, 0);
            const float sc = idx_score(a1, a2, lin4[grp], wq[grp]);
            const int row = 4 * grp + kc, t = t0 + row;
            if (!lastkb || s <= t) {
                const int bin = score_bin(sc, binv[grp]);
                if (PASS == 1) { __hip_atomic_fetch_add(hist + row * 1024 + (bin >> 1), (bin & 1) ? 0x10000u : 1u, __ATOMIC_RELAXED, __HIP_MEMORY_SCOPE_WORKGROUP); }
                else {
                    if (bin > bst[grp]) { const int pos = __hip_atomic_fetch_add(ctl + row * 8 + 0, 1, __ATOMIC_RELAXED, __HIP_MEMORY_SCOPE_WORKGROUP); sel[row * 256 + (pos & 255)] = (unsigned short)s;
                        const int dd = t - s; seld[row * 256 + (pos & 255)] = (unsigned short)((dd > 127 ? 127 : dd) * 32); }
                    else if (bin == bst[grp]) { const int pos = __hip_atomic_fetch_add(ctl + row * 8 + 1, 1, __ATOMIC_RELAXED, __HIP_MEMORY_SCOPE_WORKGROUP);
                        if (pos < CANDCAP) { u32x2 e; e.x = __float_as_uint(sc); e.y = (unsigned)s; cand[row * CANDCAP + pos] = e; } }
                }
            }
        }
    }
}

__device__ __forceinline__ void dsa_tile(LAS unsigned char* lds, const _Float16* __restrict__ proj, _Float16* __restrict__ o_a, int b, int qt) {
    int tid_ = threadIdx.x; asm volatile("" : "+v"(tid_));
    const int tid = tid_, lane = tid & 63, wave = __builtin_amdgcn_readfirstlane(tid >> 6);
    const int kc = lane >> 4, n16 = lane & 15;
    const int t0 = qt * TQ, nkb = qt + 1;
    LAS unsigned* hist = (LAS unsigned*)(lds + L_HIST);
    LAS unsigned short* sel = (LAS unsigned short*)(lds + L_SEL);
    LAS u32x2* cand = (LAS u32x2*)(lds + L_HIST);
    LAS int* ctl = (LAS int*)(lds + L_CTL);
    LAS float* biaslut = (LAS float*)(lds + L_BIAS);
    for (int i = tid; i < (TQ * 1024 + 4096) / 4; i += 512) ((LAS u32x4*)hist)[i] = (u32x4){0u, 0u, 0u, 0u};
    if (tid < TQ * 8) ctl[tid] = 0;
    f16x8 afr[4][2]; f16x8 alin; float wq[4][8]; float binv[4];
    { const int g = n16 >> 2, r = n16 & 3;
      { const int qq = 4 * r + g; const _Float16* qrow = proj + (size_t)(b * S_ + t0 + qq) * PW;
        const f16x8 wg = *(const f16x8*)(qrow + C_WI);
        float lin[8];
#pragma unroll
        for (int e = 0; e < 8; ++e) lin[e] = 0.f;
#pragma unroll
        for (int h = 0; h < 8; ++h) { const f16x8 qh = *(const f16x8*)(qrow + C_QI + h * 32 + 8 * kc); const float wh = (float)wg[h] * (0.5f / 16.f);
#pragma unroll
            for (int e = 0; e < 8; ++e) lin[e] = fmaf(wh, (float)qh[e], lin[e]); }
#pragma unroll
        for (int e = 0; e < 8; ++e) alin[e] = (_Float16)lin[e]; }
#pragma unroll
      for (int grp = 0; grp < 4; ++grp) {
          const _Float16* qrow = proj + (size_t)(b * S_ + t0 + 4 * grp + g) * PW + C_QI;
          afr[grp][0] = *(const f16x8*)(qrow + r * 32 + 8 * kc);
          afr[grp][1] = *(const f16x8*)(qrow + (4 + r) * 32 + 8 * kc);
          const f16x8 wv = *(const f16x8*)(proj + (size_t)(b * S_ + t0 + 4 * grp + kc) * PW + C_WI);
          float ss = 0.f;
#pragma unroll
          for (int h = 0; h < 8; ++h) { const float wfull = (float)wv[h] * (1.f / 16.f); wq[grp][h] = 0.5f * wfull; ss = fmaf(wfull, wfull, ss); }
          binv[grp] = 32.f * rsqrtf(ss + 1e-12f);
      } }
    __syncthreads();
    score_pass<1>(lds, proj, b, t0, nkb, wave, lane, afr, alin, wq, binv);
    __syncthreads();
#pragma unroll 1
    for (int i = 0; i < 2; ++i) {
        const int row = 2 * wave + i, n = t0 + row + 1;
        if (n <= 256) { if (lane == 0) { ctl[row * 8 + 2] = -1; ctl[row * 8 + 3] = 0; } }
        else {
            const LAS u32x4* hp = (const LAS u32x4*)(hist + row * 1024 + 16 * lane);
            unsigned tot = 0;
#pragma unroll
            for (int q4 = 0; q4 < 4; ++q4) { const u32x4 hv = hp[q4];
                tot += (hv.x & 0xffffu) + (hv.x >> 16) + (hv.y & 0xffffu) + (hv.y >> 16) + (hv.z & 0xffffu) + (hv.z >> 16) + (hv.w & 0xffffu) + (hv.w >> 16); }
            unsigned suf = tot;
#pragma unroll
            for (int o = 1; o < 64; o <<= 1) { const unsigned v = __shfl_down(suf, o); if (lane + o < 64) suf += v; }
            const unsigned above_lane = suf - tot;
            const unsigned long long cross = __ballot(above_lane < 256u && suf >= 256u);
            const int lx = __builtin_ctzll(cross);
            const unsigned abovex = __shfl(above_lane, lx);
            const unsigned c2 = lane < 32 ? (unsigned)((const LAS unsigned short*)hist)[row * 2048 + 32 * lx + lane] : 0u;
            unsigned suf2 = c2;
#pragma unroll
            for (int o = 1; o < 32; o <<= 1) { const unsigned v = __shfl_down(suf2, o); if (lane + o < 32) suf2 += v; }
            const unsigned above2 = abovex + suf2 - c2;
            if (lane < 32 && above2 < 256u && above2 + c2 >= 256u) {
                const int bs = 32 * lx + lane; const unsigned cum = above2;
                ctl[row * 8 + 2] = bs; ctl[row * 8 + 3] = 256 - (int)cum;
            }
        }
    }
    __syncthreads();
    score_pass<2>(lds, proj, b, t0, nkb, wave, lane, afr, alin, wq, binv);
    __syncthreads();
#pragma unroll 1
    for (int i = 0; i < 2; ++i) {
        const int row = 2 * wave + i, n = t0 + row + 1;
        const int need = ctl[row * 8 + 3], base = ctl[row * 8 + 0];
        int nc = ctl[row * 8 + 1];
        nc = nc < CANDCAP ? nc : CANDCAP;
        if (lane == 0) { const int nf = base + (need < nc ? need : nc); ctl[row * 8 + 4] = n <= 256 ? n : (nf < 256 ? nf : 256); }
        if (need > 0) {
            for (int c0 = 0; c0 < nc; c0 += 64) {
                const int ci = c0 + lane; const bool act = ci < nc;
                const u32x2 me = cand[row * CANDCAP + (act ? ci : 0)];
                const float msc = __uint_as_float(me.x); int rank = 0;
                for (int j = 0; j < nc; ++j) { const u32x2 ot = cand[row * CANDCAP + j]; const float osc = __uint_as_float(ot.x);
                    rank += (osc > msc || (osc == msc && ot.y < me.y)) ? 1 : 0; }
                if (act && rank < need) { sel[row * 256 + ((base + rank) & 255)] = (unsigned short)me.y; const int dd = t0 + row - (int)me.y; ((LAS unsigned short*)(lds + L_SELD))[row * 256 + ((base + rank) & 255)] = (unsigned short)((dd > 127 ? 127 : dd) * 32); }
            }
        }
    }
    __syncthreads();
    int tq_ = threadIdx.x; asm volatile("" : "+v"(tq_));
    const int lane_a = tq_ & 63;
    LAS unsigned char* vst = lds + L_VST + wave * (32 * VPITCH);
#pragma unroll 1
    for (int i = 0; i < 2; ++i) { const int lane = lane_a, kc = lane >> 4, n16 = lane & 15;
        const int row = 2 * wave + i, t = t0 + row; const int nvalid = ctl[row * 8 + 4];
        const _Float16* qrow = proj + (size_t)(b * S_ + t) * PW + C_QA;
        const int head = n16, hm = head & 7;
        f16x8 qb0, qb1;
        { const f16x8 z = {0, 0, 0, 0, 0, 0, 0, 0}; qb0 = z; qb1 = z;
          if (head < 8) { qb0 = *(const f16x8*)(qrow + head * 64 + 8 * kc); qb1 = *(const f16x8*)(qrow + head * 64 + 32 + 8 * kc); } }
        f32x4 ot[4];
#pragma unroll
        for (int dt = 0; dt < 4; ++dt) ot[dt] = (f32x4){0.f, 0.f, 0.f, 0.f};
        float mrun = -INFINITY, lrun = 0.f;
        const LAS unsigned short* selr = sel + row * 256;
        const LAS unsigned short* seldr = (const LAS unsigned short*)(lds + L_SELD) + row * 256;
        const LAS unsigned char* biasb = lds + L_BIAS + hm * 4;
        const _Float16* pbat = proj + (size_t)(b * S_) * PW;
        LAS unsigned char* kst = lds + L_HIST + wave * (32 * VPITCH);
        u32x4 gk[4], gv[4];
        const char* pbyte = (const char*)pbat;
#define DSA_GATHER(jj) do { _Pragma("unroll") for (int i_ = 0; i_ < 4; ++i_) { const int pos_ = 32 * (jj) + 8 * i_ + (lane >> 3); \
            const unsigned idx_ = pos_ < nvalid ? (unsigned)selr[pos_] : 0u; const char* rp_ = pbyte + (size_t)(idx_ * (unsigned)(PW * 2) + (unsigned)(C_KA * 2 + 16 * (lane & 7))); \
            gk[i_] = *(const u32x4*)rp_; gv[i_] = *(const u32x4*)(rp_ + 128); } } while (0)
        DSA_GATHER(0);
        const int nsteps = (nvalid + 31) >> 5;
#pragma unroll 1
        for (int j = 0; j < nsteps; ++j) {
#pragma unroll
            for (int i_ = 0; i_ < 4; ++i_) { const int ro = (8 * i_ + (lane >> 3)) * VPITCH + 16 * (lane & 7);
                *(LAS u32x4*)(kst + ro) = gk[i_]; *(LAS u32x4*)(vst + ro) = gv[i_]; }
            if (j + 1 < nsteps) DSA_GATHER(j + 1);
            asm volatile("s_waitcnt lgkmcnt(0)" ::: "memory");
            const f16x8 ca0 = *(const LAS f16x8*)(kst + n16 * VPITCH + 16 * kc), ca1 = *(const LAS f16x8*)(kst + n16 * VPITCH + 64 + 16 * kc);
            const f16x8 cb0 = *(const LAS f16x8*)(kst + (16 + n16) * VPITCH + 16 * kc), cb1 = *(const LAS f16x8*)(kst + (16 + n16) * VPITCH + 64 + 16 * kc);
            f32x4 sa = {0.f, 0.f, 0.f, 0.f}, sb = {0.f, 0.f, 0.f, 0.f};
            sa = __builtin_amdgcn_mfma_f32_16x16x32_f16(ca0, qb0, sa, 0, 0, 0); sa = __builtin_amdgcn_mfma_f32_16x16x32_f16(ca1, qb1, sa, 0, 0, 0);
            sb = __builtin_amdgcn_mfma_f32_16x16x32_f16(cb0, qb0, sb, 0, 0, 0); sb = __builtin_amdgcn_mfma_f32_16x16x32_f16(cb1, qb1, sb, 0, 0, 0);
            const int p0 = 32 * j + 4 * kc;
            const u32x2 iwa = *(const LAS u32x2*)(seldr + p0), iwb = *(const LAS u32x2*)(seldr + p0 + 16);
            const unsigned wa0 = iwa.x, wa1 = iwa.y, wb0 = iwb.x, wb1 = iwb.y;
            const unsigned bo[8] = {wa0 & 0xffffu, wa0 >> 16, wa1 & 0xffffu, wa1 >> 16, wb0 & 0xffffu, wb0 >> 16, wb1 & 0xffffu, wb1 >> 16};
            float v[8] = {sa.x, sa.y, sa.z, sa.w, sb.x, sb.y, sb.z, sb.w};
            float tm = -INFINITY;
#pragma unroll
            for (int e = 0; e < 8; ++e) {
                const bool ok = (p0 + (e & 3) + 16 * (e >> 2)) < nvalid;
                const float lg = v[e] * 0.125f + *(const LAS float*)(biasb + bo[e]);
                v[e] = ok ? lg : -INFINITY; tm = fmaxf(tm, v[e]);
            }
            tm = fmaxf(tm, __shfl_xor(tm, 16)); tm = fmaxf(tm, __shfl_xor(tm, 32));
            const float mn = fmaxf(mrun, tm);
            const float alpha = __expf(mrun - mn);
            float ps = 0.f;
#pragma unroll
            for (int e = 0; e < 8; ++e) { v[e] = __expf(v[e] - mn); ps += v[e]; }
            lrun = lrun * alpha + ps; mrun = mn;
#pragma unroll
            for (int dt = 0; dt < 4; ++dt) ot[dt] = ot[dt] * alpha;
            const f16x8 pfr = {(_Float16)v[0], (_Float16)v[1], (_Float16)v[2], (_Float16)v[3], (_Float16)v[4], (_Float16)v[5], (_Float16)v[6], (_Float16)v[7]};
            asm volatile("s_waitcnt lgkmcnt(0)" ::: "memory");
            const int q = n16 >> 2, p = n16 & 3;
#pragma unroll
            for (int dt = 0; dt < 4; ++dt) {
                const s16x4 ta = __builtin_amdgcn_ds_read_tr16_b64_v4i16((LAS s16x4*)(vst + (4 * kc + q) * VPITCH + (16 * dt + 4 * p) * 2));
                const s16x4 tb = __builtin_amdgcn_ds_read_tr16_b64_v4i16((LAS s16x4*)(vst + (16 + 4 * kc + q) * VPITCH + (16 * dt + 4 * p) * 2));
                const f16x4 fa = __builtin_bit_cast(f16x4, ta), fb = __builtin_bit_cast(f16x4, tb);
                const f16x8 vfr = {fa.x, fa.y, fa.z, fa.w, fb.x, fb.y, fb.z, fb.w};
                ot[dt] = __builtin_amdgcn_mfma_f32_16x16x32_f16(vfr, pfr, ot[dt], 0, 0, 0);
            }
            asm volatile("s_waitcnt lgkmcnt(0)" ::: "memory");
        }
#undef DSA_GATHER
        lrun += __shfl_xor(lrun, 16); lrun += __shfl_xor(lrun, 32);
        const float inv = 1.f / fmaxf(lrun, 1e-30f);
        if (head < 8) {
            _Float16* orow = o_a + (size_t)(b * S_ + t) * 1024 + head * 64 + 4 * kc;
#pragma unroll
            for (int dt = 0; dt < 4; ++dt) { u32x2 w; w.x = pg8::pkh(ot[dt].x * inv, ot[dt].y * inv); w.y = pg8::pkh(ot[dt].z * inv, ot[dt].w * inv); *(u32x2*)(orow + 16 * dt) = w; }
        }
    }
    __syncthreads();
}
}


namespace nsa {
typedef _Float16 f16x8 __attribute__((ext_vector_type(8)));
typedef _Float16 f16x4 __attribute__((ext_vector_type(4)));
typedef short s16x4 __attribute__((ext_vector_type(4)));
typedef float f32x4 __attribute__((ext_vector_type(4)));
typedef float f32x16 __attribute__((ext_vector_type(16)));
typedef unsigned u32x4 __attribute__((ext_vector_type(4)));
typedef unsigned u32x2 __attribute__((ext_vector_type(2)));
constexpr int KP = 144, VP = 192;
constexpr int TILE_B = 64 * KP + 64 * VP;
constexpr int L_T0 = 0, L_BIAS = 2 * TILE_B, L_IMPA = L_BIAS + 4096, L_IMPC = L_IMPA + 16384, L_MASK = L_IMPC + 16384, L_END = L_MASK + 512;
static_assert(L_END <= 131072, "nsa LDS");
constexpr float LOG2E = 1.4426950408889634f;
constexpr float SC = 0.125f * LOG2E;
__device__ __forceinline__ float max3f(float a, float b, float c) { float r; asm("v_max3_f32 %0, %1, %2, %3" : "=v"(r) : "v"(a), "v"(b), "v"(c)); return r; }

struct Src { const _Float16* k; const _Float16* v; int pitch; };

struct Stage { u32x4 kr, vr; };
__device__ __forceinline__ void stage_load(Stage& st, const Src& s, int row0, int tid, bool need_v) {
    const int r = tid >> 3, c = tid & 7;
    st.kr = *(const u32x4*)(s.k + (size_t)(row0 + r) * s.pitch + 8 * c);
    if (need_v) st.vr = *(const u32x4*)(s.v + (size_t)(row0 + r) * s.pitch + 8 * c);
}
__device__ __forceinline__ void stage_store(const Stage& st, LAS unsigned char* tb, int tid, bool need_v) {
    const int r = tid >> 3, c = tid & 7;
    *(LAS u32x4*)(tb + r * KP + 16 * c) = st.kr;
    if (need_v) *(LAS u32x4*)(tb + 64 * KP + r * VP + 16 * c) = st.vr;
}

struct RowState { float m, l; f32x16 o0, o1; };

__device__ __forceinline__ void qk_half(const LAS unsigned char* kt, const f16x8 (&qf)[4], int rho, int hi, int kh, f32x16& s0) {
#pragma unroll
    for (int i = 0; i < 16; ++i) s0[i] = 0.f;
    const LAS unsigned char* kb = kt + (32 * kh + rho) * KP + 16 * hi;
#pragma unroll
    for (int ks = 0; ks < 4; ++ks) {
        const f16x8 a0 = *(const LAS f16x8*)(kb + 32 * ks);
        s0 = __builtin_amdgcn_mfma_f32_32x32x16_f16(a0, qf[ks], s0, 0, 0, 0);
    }
}
__device__ __forceinline__ void logits(f32x16& s0, const LAS float* lut, int hb, int hi, int dbase, int dstep, int dlim, bool bit) {
#pragma unroll
    for (int rg = 0; rg < 16; ++rg) {
        const int kl = (rg & 3) + 8 * (rg >> 2) + 4 * hi;
        const int d = dbase - dstep * kl;
        int dc = d < 0 ? 0 : d; dc = dc > 127 ? 127 : dc;
        const float bias = lut[dc * 8 + hb];
        const bool ok = bit && d >= 0 && d < dlim;
        s0[rg] = ok ? fmaf(s0[rg], SC, bias) : -INFINITY;
    }
}
__device__ __forceinline__ void pv_half(RowState& rs, const f32x16& s0, const LAS unsigned char* vt, int rho, int hi, int kh) {
    const int l16 = rho & 15, g16 = rho >> 4, q = l16 >> 2, p = l16 & 3;
    const LAS unsigned char* vb = vt + (32 * kh + 4 * hi + q) * VP + (16 * g16 + 4 * p) * 2;
#pragma unroll
    for (int sx = 0; sx < 2; ++sx) {
        f16x8 pfr;
#pragma unroll
        for (int j = 0; j < 8; ++j) pfr[j] = (_Float16)s0[8 * sx + j];
#pragma unroll
        for (int dt = 0; dt < 2; ++dt) {
            const s16x4 ta = __builtin_amdgcn_ds_read_tr16_b64_v4i16((LAS s16x4*)(vb + (16 * sx) * VP + 64 * dt));
            const s16x4 tb = __builtin_amdgcn_ds_read_tr16_b64_v4i16((LAS s16x4*)(vb + (16 * sx + 8) * VP + 64 * dt));
            const f16x4 fa = __builtin_bit_cast(f16x4, ta), fb = __builtin_bit_cast(f16x4, tb);
            const f16x8 vfr = {fa.x, fa.y, fa.z, fa.w, fb.x, fb.y, fb.z, fb.w};
            if (dt == 0) rs.o0 = __builtin_amdgcn_mfma_f32_32x32x16_f16(vfr, pfr, rs.o0, 0, 0, 0);
            else rs.o1 = __builtin_amdgcn_mfma_f32_32x32x16_f16(vfr, pfr, rs.o1, 0, 0, 0);
        }
    }
}
__device__ __forceinline__ void rescale_if_needed(RowState& rs, float tmx) {
    if (__any(tmx > rs.m + 8.f)) {
        const float mn = fmaxf(rs.m, tmx);
        const float mu = (mn == -INFINITY) ? 0.f : mn;
        const float alpha = __builtin_amdgcn_exp2f(rs.m - mu);
        rs.l *= alpha; rs.m = mn;
#pragma unroll
        for (int i = 0; i < 16; ++i) { rs.o0[i] *= alpha; rs.o1[i] *= alpha; }
    }
}
__device__ __forceinline__ void tile_fast(RowState& rs, const LAS unsigned char* kt, const LAS unsigned char* vt, const f16x8 (&qf)[4], float c, int rho, int hi) {
    const LAS unsigned char* kb = kt + rho * KP + 16 * hi;
    f16x8 ka[4], kb2[4];
#pragma unroll
    for (int ks = 0; ks < 4; ++ks) { ka[ks] = *(const LAS f16x8*)(kb + 32 * ks); kb2[ks] = *(const LAS f16x8*)(kb + 32 * KP + 32 * ks); }
    const int l16 = rho & 15, g16 = rho >> 4, q = l16 >> 2, p = l16 & 3;
    const LAS unsigned char* vb = vt + (4 * hi + q) * VP + (16 * g16 + 4 * p) * 2;
    s16x4 va[4][2], vc[4][2];
    __builtin_amdgcn_sched_barrier(0);
    f32x16 s0, s1;
#pragma unroll
    for (int i = 0; i < 16; ++i) { s0[i] = 0.f; s1[i] = 0.f; }
#pragma unroll
    for (int ks = 0; ks < 4; ++ks) {
        s0 = __builtin_amdgcn_mfma_f32_32x32x16_f16(ka[ks], qf[ks], s0, 0, 0, 0);
        s1 = __builtin_amdgcn_mfma_f32_32x32x16_f16(kb2[ks], qf[ks], s1, 0, 0, 0);
    }
    __builtin_amdgcn_sched_barrier(0);
#pragma unroll
    for (int st = 0; st < 4; ++st)
#pragma unroll
        for (int dt = 0; dt < 2; ++dt) {
            va[st][dt] = __builtin_amdgcn_ds_read_tr16_b64_v4i16((LAS s16x4*)(vb + (16 * st) * VP + 64 * dt));
            vc[st][dt] = __builtin_amdgcn_ds_read_tr16_b64_v4i16((LAS s16x4*)(vb + (16 * st + 8) * VP + 64 * dt));
        }
    __builtin_amdgcn_sched_barrier(0);
    float tm = max3f(s0[0], s1[0], -INFINITY);
#pragma unroll
    for (int i = 1; i < 16; ++i) tm = max3f(tm, s0[i], s1[i]);
    { const auto r2 = __builtin_amdgcn_permlane32_swap(__float_as_uint(tm), __float_as_uint(tm), false, false); tm = fmaxf(__uint_as_float(r2[0]), __uint_as_float(r2[1])); }
    rescale_if_needed(rs, fmaf(tm, SC, c));
    const float mu = (rs.m == -INFINITY) ? 0.f : rs.m;
    const float cm = c - mu;
    float ps = 0.f;
#pragma unroll
    for (int i = 0; i < 16; ++i) { s0[i] = __builtin_amdgcn_exp2f(fmaf(s0[i], SC, cm)); s1[i] = __builtin_amdgcn_exp2f(fmaf(s1[i], SC, cm)); ps += s0[i] + s1[i]; }
    rs.l += ps;
#pragma unroll
    for (int st = 0; st < 4; ++st) {
        f16x8 pfr;
#pragma unroll
        for (int j = 0; j < 8; ++j) pfr[j] = (_Float16)((st & 2) ? s1[8 * (st & 1) + j] : s0[8 * (st & 1) + j]);
#pragma unroll
        for (int dt = 0; dt < 2; ++dt) {
            const f16x4 fa = __builtin_bit_cast(f16x4, va[st][dt]), fb = __builtin_bit_cast(f16x4, vc[st][dt]);
            const f16x8 vfr = {fa.x, fa.y, fa.z, fa.w, fb.x, fb.y, fb.z, fb.w};
            if (dt == 0) rs.o0 = __builtin_amdgcn_mfma_f32_32x32x16_f16(vfr, pfr, rs.o0, 0, 0, 0);
            else rs.o1 = __builtin_amdgcn_mfma_f32_32x32x16_f16(vfr, pfr, rs.o1, 0, 0, 0);
        }
    }
}
template <bool IMP>
__device__ __forceinline__ void tile_general(RowState& rs, const LAS unsigned char* kt, const LAS unsigned char* vt, const f16x8 (&qf)[4], const LAS float* lut, int hb, int rho, int hi,
                                             int dbase, int dstep, unsigned dlim, float mc, float invl, LAS float* impA, LAS float* impC, int n, bool wr) {
    const LAS unsigned char* kb = kt + rho * KP + 16 * hi;
    f16x8 ka[4], kb2[4];
#pragma unroll
    for (int ks = 0; ks < 4; ++ks) { ka[ks] = *(const LAS f16x8*)(kb + 32 * ks); kb2[ks] = *(const LAS f16x8*)(kb + 32 * KP + 32 * ks); }
    const int d0 = dbase - dstep * 4 * hi;
    __builtin_amdgcn_sched_barrier(0);
    f32x16 s0, s1;
#pragma unroll
    for (int i = 0; i < 16; ++i) { s0[i] = 0.f; s1[i] = 0.f; }
#pragma unroll
    for (int ks = 0; ks < 4; ++ks) {
        s0 = __builtin_amdgcn_mfma_f32_32x32x16_f16(ka[ks], qf[ks], s0, 0, 0, 0);
        s1 = __builtin_amdgcn_mfma_f32_32x32x16_f16(kb2[ks], qf[ks], s1, 0, 0, 0);
    }
    __builtin_amdgcn_sched_barrier(0);
    float b0[16], b1[16];
#pragma unroll
    for (int rg = 0; rg < 16; ++rg) {
        const int kl = (rg & 3) + 8 * (rg >> 2);
        int da = d0 - dstep * kl, db = d0 - dstep * (kl + 32);
        da = da < 0 ? 0 : da; da = da > 127 ? 127 : da; db = db < 0 ? 0 : db; db = db > 127 ? 127 : db;
        b0[rg] = lut[da * 8 + hb]; b1[rg] = lut[db * 8 + hb];
    }
    float tm = -INFINITY;
#pragma unroll
    for (int rg = 0; rg < 16; ++rg) {
        const int kl = (rg & 3) + 8 * (rg >> 2);
        const unsigned da = (unsigned)(d0 - dstep * kl), db = (unsigned)(d0 - dstep * (kl + 32));
        s0[rg] = da < dlim ? fmaf(s0[rg], SC, b0[rg]) : -INFINITY;
        s1[rg] = db < dlim ? fmaf(s1[rg], SC, b1[rg]) : -INFINITY;
        tm = max3f(tm, s0[rg], s1[rg]);
    }
    __builtin_amdgcn_sched_barrier(0);
    const int l16 = rho & 15, g16 = rho >> 4, q = l16 >> 2, p = l16 & 3;
    const LAS unsigned char* vb = vt + (4 * hi + q) * VP + (16 * g16 + 4 * p) * 2;
    s16x4 va[4][2], vc[4][2];
    if (!IMP) {
#pragma unroll
        for (int st = 0; st < 4; ++st)
#pragma unroll
            for (int dt = 0; dt < 2; ++dt) {
                va[st][dt] = __builtin_amdgcn_ds_read_tr16_b64_v4i16((LAS s16x4*)(vb + (16 * st) * VP + 64 * dt));
                vc[st][dt] = __builtin_amdgcn_ds_read_tr16_b64_v4i16((LAS s16x4*)(vb + (16 * st + 8) * VP + 64 * dt));
            }
        __builtin_amdgcn_sched_barrier(0);
    }
    if (!IMP) {
        { const auto r2 = __builtin_amdgcn_permlane32_swap(__float_as_uint(tm), __float_as_uint(tm), false, false); tm = fmaxf(__uint_as_float(r2[0]), __uint_as_float(r2[1])); }
        rescale_if_needed(rs, tm);
        const float mu = (rs.m == -INFINITY) ? 0.f : rs.m;
        float ps = 0.f;
#pragma unroll
        for (int i = 0; i < 16; ++i) { s0[i] = __builtin_amdgcn_exp2f(s0[i] - mu); s1[i] = __builtin_amdgcn_exp2f(s1[i] - mu); ps += s0[i] + s1[i]; }
        rs.l += ps;
#pragma unroll
        for (int st = 0; st < 4; ++st) {
            f16x8 pfr;
#pragma unroll
            for (int j = 0; j < 8; ++j) pfr[j] = (_Float16)((st & 2) ? s1[8 * (st & 1) + j] : s0[8 * (st & 1) + j]);
#pragma unroll
            for (int dt = 0; dt < 2; ++dt) {
                const f16x4 fa = __builtin_bit_cast(f16x4, va[st][dt]), fb = __builtin_bit_cast(f16x4, vc[st][dt]);
                const f16x8 vfr = {fa.x, fa.y, fa.z, fa.w, fb.x, fb.y, fb.z, fb.w};
                if (dt == 0) rs.o0 = __builtin_amdgcn_mfma_f32_32x32x16_f16(vfr, pfr, rs.o0, 0, 0, 0);
                else rs.o1 = __builtin_amdgcn_mfma_f32_32x32x16_f16(vfr, pfr, rs.o1, 0, 0, 0);
            }
        }
    } else {
        const float mu = (mc == -INFINITY) ? 0.f : mc;
#pragma unroll
        for (int kh = 0; kh < 2; ++kh)
#pragma unroll
            for (int ii = 0; ii < 4; ++ii) {
                float pv[4];
#pragma unroll
                for (int e = 0; e < 4; ++e) pv[e] = __builtin_amdgcn_exp2f((kh ? s1[4 * ii + e] : s0[4 * ii + e]) - mu) * invl;
                float a = (pv[0] + pv[1]) + (pv[2] + 0.5f * pv[3]), c = 0.5f * pv[3];
                a += __shfl_xor(a, 1); a += __shfl_xor(a, 2); c += __shfl_xor(c, 1); c += __shfl_xor(c, 2);
                const int nb = 16 * n + 8 * kh + 2 * ii + hi;
                if (wr) { impA[nb] = a; if (nb + 1 < 64) impC[nb + 1] = c; }
            }
    }
}
__device__ __forceinline__ void probs(RowState& rs, f32x16& s0, float sc, float c) {
    float tm = -INFINITY;
#pragma unroll
    for (int i = 0; i < 16; ++i) tm = fmaxf(tm, s0[i]);
    tm = fmaxf(tm, __shfl_xor(tm, 32));
    rescale_if_needed(rs, fmaf(tm, sc, c));
    const float mu = (rs.m == -INFINITY) ? 0.f : rs.m;
    const float cm = c - mu;
    float ps = 0.f;
#pragma unroll
    for (int i = 0; i < 16; ++i) { s0[i] = __builtin_amdgcn_exp2f(fmaf(s0[i], sc, cm)); ps += s0[i]; }
    rs.l += ps;
}
__device__ __forceinline__ void rs_init(RowState& rs) { rs.m = -INFINITY; rs.l = 0.f;
#pragma unroll
    for (int i = 0; i < 16; ++i) { rs.o0[i] = 0.f; rs.o1[i] = 0.f; } }
template <int MODE>
__device__ __forceinline__ void rs_flush(RowState& rs, float gate, LAS unsigned char* accl, _Float16* orow) {
    const float lt = rs.l + __shfl_xor(rs.l, 32);
    const float w = gate / fmaxf(lt, 1e-30f);
#pragma unroll
    for (int i = 0; i < 4; ++i) {
        float a[8] = {w * rs.o0[4 * i], w * rs.o0[4 * i + 1], w * rs.o0[4 * i + 2], w * rs.o0[4 * i + 3], w * rs.o1[4 * i], w * rs.o1[4 * i + 1], w * rs.o1[4 * i + 2], w * rs.o1[4 * i + 3]};
        LAS unsigned char* ap = accl + (i >> 1) * 16384 + (i & 1) * 1024;
        if (MODE != 0) { float p[8]; pg8::unpk8(*(const LAS u32x4*)ap, p);
#pragma unroll
            for (int e = 0; e < 8; ++e) a[e] += p[e]; }
        u32x4 wv; wv.x = pg8::pkh(a[0], a[1]); wv.y = pg8::pkh(a[2], a[3]); wv.z = pg8::pkh(a[4], a[5]); wv.w = pg8::pkh(a[6], a[7]);
        if (MODE != 2) *(LAS u32x4*)ap = wv;
        else { u32x2 w0; w0.x = wv.x; w0.y = wv.y; u32x2 w1; w1.x = wv.z; w1.y = wv.w; *(u32x2*)(orow + 8 * i) = w0; *(u32x2*)(orow + 32 + 8 * i) = w1; }
    }
}

__device__ __forceinline__ void nsa_unit(LAS unsigned char* lds, const _Float16* __restrict__ proj, const _Float16* __restrict__ kcmp, const _Float16* __restrict__ vcmp,
                                         _Float16* __restrict__ o_b, int b, int g, int qb) {
    const int tid = threadIdx.x, lane = tid & 63, wave = __builtin_amdgcn_readfirstlane(tid >> 6);
    const int rho = lane & 31, hi = lane >> 5, ql = rho >> 2, r = rho & 3, hb = g * 4 + r;
    const int t = 64 * qb + 8 * wave + ql;
    const _Float16* prow = proj + (size_t)(b * S_ + t) * PW;
    f16x8 qf[4];
#pragma unroll
    for (int ks = 0; ks < 4; ++ks) qf[ks] = *(const f16x8*)(prow + C_QB + hb * 64 + 16 * ks + 8 * hi);
    for (int i = tid; i < 2048; i += 512) ((LAS u32x4*)(lds + L_IMPA))[i] = (u32x4){0u, 0u, 0u, 0u};
    RowState rs; rs_init(rs);
    const LAS float* lut = (const LAS float*)(lds + L_BIAS);
    const float bias31 = lut[127 * 8 + hb];
    const _Float16* kc = kcmp + (size_t)(b * 2 + g) * 256 * 64;
    const long vcoff = (vcmp + (size_t)(b * 2 + g) * 256 * 64) - kc;
    const _Float16* pb = proj + (size_t)(b * S_) * PW + C_KVB + g * 64;
    const int ncmp = (4 * qb + 3 + 63) / 64;
    const int wlo = qb - 8 > 0 ? qb - 8 : 0;
    const int e0 = ncmp, e1 = 2 * ncmp, e2 = e1 + qb + 1, NT = e2 + (qb - wlo + 1);
    const int sr = tid >> 3, scq = tid & 7;
    float mc = 0.f, invl = 0.f; unsigned mlo = 0u, mhi = 0u;
    Stage stg;
#define NSA_DECODE(i, br, n) do { if ((i) < e0) { br = 0; n = (i); } else if ((i) < e1) { br = 1; n = (i) - e0; } else if ((i) < e2) { br = 2; n = (i) - e1; } else { br = 3; n = wlo + (i) - e2; } } while (0)
#define NSA_LOAD(i) do { int br_, n_; NSA_DECODE(i, br_, n_); const _Float16* kp_ = (br_ < 2) ? kc : (br_ == 2 ? pb + 2 * 128 : pb + 4 * 128); const int pitch_ = (br_ < 2) ? 64 : PW; \
        const long vo_ = (br_ < 2) ? vcoff : 128; const _Float16* rp_ = kp_ + (size_t)(64 * n_ + sr) * pitch_ + 8 * scq; stg.kr = *(const u32x4*)rp_; stg.vr = *(const u32x4*)(rp_ + vo_); } while (0)
#define NSA_STORE(buf) do { LAS unsigned char* tb_ = lds + L_T0 + (buf) * TILE_B; *(LAS u32x4*)(tb_ + sr * KP + 16 * scq) = stg.kr; *(LAS u32x4*)(tb_ + 64 * KP + sr * VP + 16 * scq) = stg.vr; } while (0)
    __syncthreads();
    NSA_LOAD(0); NSA_STORE(0);
    __syncthreads();
#pragma unroll 1
    for (int i = 0; i < NT; ++i) {
        int br, n; NSA_DECODE(i, br, n);
        const LAS unsigned char* tb = lds + L_T0 + (i & 1) * TILE_B;
        const bool more = i + 1 < NT;
        if (more) NSA_LOAD(i + 1);
        bool bit = true; int dbase, dstep = 1, dlim = 1 << 30; bool near = true;
        if (br < 2) { dbase = t - 31 - 1024 * n; dstep = 16; }
        else { dbase = t - 64 * n; near = n >= qb - 2; if (br == 2) bit = (n < 32) ? ((mlo >> n) & 1u) : ((mhi >> (n - 32)) & 1u); else dlim = 512; }
        const bool interior = (br >= 2) && (n <= qb - 3) && !(br == 3 && n == qb - 8);
        const bool skip = (br == 2) && !__any(bit);
        if (!skip) {
            if (interior) tile_fast(rs, tb, tb + 64 * KP, qf, bit ? bias31 : -INFINITY, rho, hi);
            else {
                const unsigned dl = bit ? (unsigned)dlim : 0u;
                int tq = threadIdx.x; asm volatile("" : "+v"(tq));
                LAS float* impA = (LAS float*)(lds + L_IMPA) + ((tq >> 6) * 8 + ((tq & 31) >> 2)) * 64;
                LAS float* impC = (LAS float*)(lds + L_IMPC) + ((tq >> 6) * 8 + ((tq & 31) >> 2)) * 64;
                if (br != 1) tile_general<false>(rs, tb, tb + 64 * KP, qf, lut, hb, rho, hi, dbase, dstep, dl, 0.f, 0.f, impA, impC, n, false);
                else tile_general<true>(rs, tb, tb + 64 * KP, qf, lut, hb, rho, hi, dbase, dstep, dl, mc, invl, impA, impC, n, r == 0);
            }
        }
        if (i + 1 == e0) {
            mc = rs.m; const float lc = rs.l + __shfl_xor(rs.l, 32); invl = 1.f / fmaxf(lc, 1e-30f);
        } else if (i + 1 == e1) {
            asm volatile("s_waitcnt lgkmcnt(0)" ::: "memory");
            int tq = threadIdx.x; asm volatile("" : "+v"(tq));
            const int qs = (tq & 63) >> 3, j = tq & 7, wv = tq >> 6;
            LAS float* sA = (LAS float*)(lds + L_IMPA) + (wv * 8 + qs) * 64;
            const LAS float* sC = (const LAS float*)(lds + L_IMPC) + (wv * 8 + qs) * 64;
            float sc[8];
#pragma unroll
            for (int e = 0; e < 8; ++e) { const int nn = 8 * j + e; const bool forced = (nn == 0) || (nn == qb) || (nn == qb - 1);
                sc[e] = (nn <= qb) ? (forced ? 1.0e4f : (sA[nn] + sC[nn])) : -INFINITY; }
            asm volatile("s_waitcnt lgkmcnt(0)" ::: "memory");
#pragma unroll
            for (int e = 0; e < 8; ++e) sA[8 * j + e] = sc[e];
            asm volatile("s_waitcnt lgkmcnt(0)" ::: "memory");
            int rank[8];
#pragma unroll
            for (int e = 0; e < 8; ++e) rank[e] = 0;
            for (int m = 0; m <= qb; ++m) { const float sm = sA[m];
#pragma unroll
                for (int e = 0; e < 8; ++e) rank[e] += (sm > sc[e] || (sm == sc[e] && m < 8 * j + e)) ? 1 : 0; }
            unsigned bits = 0;
#pragma unroll
            for (int e = 0; e < 8; ++e) bits |= ((8 * j + e <= qb) && rank[e] < 16) ? (1u << e) : 0u;
            ((LAS unsigned char*)(lds + L_MASK))[(wv * 8 + qs) * 8 + j] = (unsigned char)bits;
            asm volatile("s_waitcnt lgkmcnt(0)" ::: "memory");
            const u32x2 mk = *(const LAS u32x2*)(lds + L_MASK + (wv * 8 + ((tq & 31) >> 2)) * 8);
            mlo = mk.x; mhi = mk.y;
            rs_flush<0>(rs, pg8::sigm((float)prow[C_GB + 0 * 8 + hb]), lds + L_IMPA + (tq >> 6) * 2048 + (tq & 63) * 16, nullptr); rs_init(rs);
        } else if (i + 1 == e2) {
            rs_flush<1>(rs, pg8::sigm((float)prow[C_GB + 1 * 8 + hb]), lds + L_IMPA + wave * 2048 + lane * 16, nullptr); rs_init(rs);
        } else if (i + 1 == NT) {
            rs_flush<2>(rs, pg8::sigm((float)prow[C_GB + 2 * 8 + hb]), lds + L_IMPA + wave * 2048 + lane * 16, o_b + (size_t)(b * S_ + t) * 1024 + hb * 64 + 4 * hi);
        }
        if (more) NSA_STORE((i + 1) & 1);
        __syncthreads();
    }
#undef NSA_DECODE
#undef NSA_LOAD
#undef NSA_STORE
}
}


namespace cmpx {
typedef _Float16 f16x8 __attribute__((ext_vector_type(8)));
typedef float f32x4 __attribute__((ext_vector_type(4)));
typedef unsigned u32x4 __attribute__((ext_vector_type(4)));
constexpr int L_PART = 0, L_HID = 65536, HIDP = 272, L_END = L_HID + 16 * HIDP;
__device__ __forceinline__ void item(LAS unsigned char* lds, const _Float16* __restrict__ proj, const float* __restrict__ pe, const _Float16* __restrict__ w1t, const _Float16* __restrict__ w2t,
                                     _Float16* __restrict__ dst, int b, int g, int kv, int ct) {
    const int tid = threadIdx.x, lane = tid & 63, wave = __builtin_amdgcn_readfirstlane(tid >> 6), kc = lane >> 4, n16 = lane & 15;
    f32x4 acc[8];
#pragma unroll
    for (int nt = 0; nt < 8; ++nt) acc[nt] = (f32x4){0.f, 0.f, 0.f, 0.f};
    const int c = 16 * ct + n16;
#pragma unroll 2
    for (int ks = 0; ks < 8; ++ks) {
        const int k0 = 32 * (8 * wave + ks) + 8 * kc, lt = k0 >> 6, d = k0 & 63;
        int trow = 16 * c + lt; trow = trow > S_ - 1 ? S_ - 1 : trow;
        const f16x8 raw = *(const f16x8*)(proj + (size_t)(b * S_ + trow) * PW + C_KVB + kv * 128 + g * 64 + d);
        const f32x4 p0 = *(const f32x4*)(pe + lt * 64 + d), p1 = *(const f32x4*)(pe + lt * 64 + d + 4);
        f16x8 afr;
        afr[0] = (_Float16)((float)raw[0] + p0.x); afr[1] = (_Float16)((float)raw[1] + p0.y); afr[2] = (_Float16)((float)raw[2] + p0.z); afr[3] = (_Float16)((float)raw[3] + p0.w);
        afr[4] = (_Float16)((float)raw[4] + p1.x); afr[5] = (_Float16)((float)raw[5] + p1.y); afr[6] = (_Float16)((float)raw[6] + p1.z); afr[7] = (_Float16)((float)raw[7] + p1.w);
#pragma unroll
        for (int nt = 0; nt < 8; ++nt) {
            const f16x8 bfr = *(const f16x8*)(w1t + (size_t)(16 * nt + n16) * 2048 + k0);
            acc[nt] = __builtin_amdgcn_mfma_f32_16x16x32_f16(afr, bfr, acc[nt], 0, 0, 0);
        }
    }
    LAS float* part = (LAS float*)(lds + L_PART) + wave * 2048;
#pragma unroll
    for (int nt = 0; nt < 8; ++nt) { part[(4 * kc + 0) * 128 + 16 * nt + n16] = acc[nt].x; part[(4 * kc + 1) * 128 + 16 * nt + n16] = acc[nt].y;
        part[(4 * kc + 2) * 128 + 16 * nt + n16] = acc[nt].z; part[(4 * kc + 3) * 128 + 16 * nt + n16] = acc[nt].w; }
    __syncthreads();
    { const LAS float* pp = (const LAS float*)(lds + L_PART);
#pragma unroll
      for (int e = 0; e < 4; ++e) { const int o = tid + 512 * e; float a = 0.f;
#pragma unroll
          for (int w = 0; w < 8; ++w) a += pp[w * 2048 + o];
          const float z = 0.7978845608028654f * (a + 0.044715f * a * a * a);
          const float th = 1.f - 2.f / (__expf(2.f * z) + 1.f);
          ((LAS _Float16*)(lds + L_HID + (o >> 7) * HIDP))[o & 127] = (_Float16)(0.5f * a * (1.f + th)); } }
    __syncthreads();
    if (wave < 4) {
        f32x4 o = {0.f, 0.f, 0.f, 0.f};
#pragma unroll
        for (int ks = 0; ks < 4; ++ks) {
            const f16x8 afr = *(const LAS f16x8*)(lds + L_HID + n16 * HIDP + (32 * ks + 8 * kc) * 2);
            const f16x8 bfr = *(const f16x8*)(w2t + (size_t)(16 * wave + n16) * 128 + 32 * ks + 8 * kc);
            o = __builtin_amdgcn_mfma_f32_16x16x32_f16(afr, bfr, o, 0, 0, 0);
        }
        const float ov[4] = {o.x, o.y, o.z, o.w};
#pragma unroll
        for (int e = 0; e < 4; ++e) { const int cc = 16 * ct + 4 * kc + e; dst[((size_t)(b * 2 + g) * 256 + cc) * 64 + 16 * wave + n16] = (_Float16)(cc == 255 ? 0.f : ov[e]); }
    }
    __syncthreads();
}
}


#define XB_TMO      128
#define XB_XCNT(j)  (256  + 64 * (j))
#define XB_XSUB(j)  (1280 + 64 * (j))
#define XB_XGEN(j)  (2304 + 64 * (j))
#define XB_TOP      3328
#define XB_TOPGEN   3392
#define XCD_BAR_WORDS 3456
#define XB_SPIN_CAP (1u << 18)
__device__ __forceinline__ unsigned xb_ld(unsigned* p)              { return __hip_atomic_load(p, __ATOMIC_RELAXED, __HIP_MEMORY_SCOPE_AGENT); }
__device__ __forceinline__ unsigned xb_add(unsigned* p, unsigned v) { return __hip_atomic_fetch_add(p, v, __ATOMIC_RELAXED, __HIP_MEMORY_SCOPE_AGENT); }
__device__ __forceinline__ unsigned xb_xcc_id() { return (unsigned)__builtin_amdgcn_s_getreg((3 << 11) | 20) & 0xFu; }
#define XB_SPIN(cond, bar) do { unsigned _sp = 0; while (cond) { __builtin_amdgcn_s_sleep(1); \
    if ((++_sp & 255u) == 0u) { if (xb_ld(&(bar)[XB_TMO])) break; if (_sp > XB_SPIN_CAP) { atomicAdd(&(bar)[XB_TMO], 1u); break; } } } } while (0)
struct XcdBarrier { unsigned* bar; unsigned x; volatile LAS unsigned* st; };
__device__ __forceinline__ XcdBarrier xcd_barrier_post(unsigned* bar, volatile LAS unsigned* st) {
    XcdBarrier b; b.bar = bar; b.x = xb_xcc_id(); b.st = st;
    if (threadIdx.x == 0) (void)xb_add(&bar[XB_XCNT(b.x)], 1u);
    return b;
}
__device__ __forceinline__ void xcd_barrier_complete(unsigned* bar, unsigned x, unsigned& nloc, unsigned& nx) {
    const unsigned G = gridDim.x * gridDim.y * gridDim.z;
    unsigned sum, cnt, mine, sp = 0u;
    for (;;) {
        sum = 0u; cnt = 0u; mine = 0u;
#pragma unroll
        for (unsigned j = 0; j < 16; ++j) { const unsigned c = xb_ld(&bar[XB_XCNT(j)]); sum += c; cnt += (c > 0u) ? 1u : 0u; mine = (j == x) ? c : mine; }
        if (sum == G) break;
        __builtin_amdgcn_s_sleep(1);
        if ((++sp & 255u) == 0u) { if (xb_ld(&bar[XB_TMO])) break; if (sp > XB_SPIN_CAP) { atomicAdd(&bar[XB_TMO], 1u); break; } }
    }
    nloc = mine > 0u ? mine : 1u; nx = cnt > 0u ? cnt : 1u;
}
__device__ __forceinline__ void xcd_barrier(const XcdBarrier& b) {
    asm volatile("s_waitcnt vmcnt(0)" ::: "memory");
    __syncthreads();
    if (threadIdx.x == 0) {
        unsigned* bar = b.bar;
        __builtin_amdgcn_s_waitcnt(0);
        unsigned nloc = b.st[0], nx = b.st[1];
        if (nloc == 0u) { xcd_barrier_complete(bar, b.x, nloc, nx); b.st[0] = nloc; b.st[1] = nx; }
        const unsigned old = xb_add(&bar[XB_XSUB(b.x)], 1u);
        const unsigned gen = old / nloc;
        if (old + 1u == (gen + 1u) * nloc) {
            __builtin_amdgcn_fence(__ATOMIC_RELEASE, "agent");
            asm volatile("s_waitcnt vmcnt(0)" ::: "memory");
            const unsigned og = xb_add(&bar[XB_TOP], 1u);
            const unsigned tg = og / nx;
            if (og + 1u == (tg + 1u) * nx) xb_add(&bar[XB_TOPGEN], 1u);
            else XB_SPIN(xb_ld(&bar[XB_TOPGEN]) == tg, bar);
            __builtin_amdgcn_fence(__ATOMIC_ACQUIRE, "agent");
            xb_add(&bar[XB_XGEN(b.x)], 1u);
            asm volatile("s_waitcnt vmcnt(0)" ::: "memory");
        } else {
            XB_SPIN(xb_ld(&bar[XB_XGEN(b.x)]) == gen, bar);
            __builtin_amdgcn_fence(__ATOMIC_ACQUIRE, "agent");
            asm volatile("s_waitcnt vmcnt(0)" ::: "memory");
        }
    }
    __syncthreads();
}

constexpr int MEGA_LDS = 131072 + 256;

template <class Epi>
__device__ __forceinline__ void gemm_run(LAS unsigned char* lds, const void* A, const void* Bt, const Epi& E, int M, int N, int K) {
    pg8::Gemm g{(const pg8::bf16_t*)A, (const pg8::bf16_t*)Bt, M, N, K};
    pg8::StaticOrder S; S.init(M, N, (int)gridDim.x, (int)blockIdx.x);
    pg8::gemm_phase<Epi, pg8::StaticOrder, true, true>(lds, g, S, E);
}

__global__ void __launch_bounds__(512, 2) mega_fwd(Args a) {
    extern __shared__ __attribute__((aligned(16))) unsigned char lds_raw[];
    LAS unsigned char* lds = (LAS unsigned char*)lds_raw;
    unsigned char* ws = a.ws;
    if (threadIdx.x == 0) *(LAS dsa::u32x4*)(lds + 131072) = (dsa::u32x4){0u, 0u, 0u, 0u};
    __syncthreads();
    XcdBarrier bar = xcd_barrier_post((unsigned*)(ws + WS_CTL), (volatile LAS unsigned*)(lds + 131072));
    const _Float16* proj = (const _Float16*)(ws + WS_PROJ);
    _Float16* o_a = (_Float16*)(ws + WS_H); _Float16* o_b = (_Float16*)(ws + WS_H) + 512;
    _Float16* kcmp = (_Float16*)(ws + WS_KCMP); _Float16* vcmp = (_Float16*)(ws + WS_VCMP);

    prologue_body(a, lds_raw);
    xcd_barrier(bar);
    gemm_run(lds, ws + WS_H, ws + WS_WIN, pg8::EpiProj{(_Float16*)(ws + WS_PROJ)}, M_, PW, D_);
    xcd_barrier(bar);
#pragma unroll 1
    for (int it = blockIdx.x; it < 512; it += gridDim.x) { const int ct = it & 15, kv = (it >> 4) & 1, g = (it >> 5) & 1, b = it >> 6;
        cmpx::item(lds, proj, kv ? a.pe_v : a.pe_k, (const _Float16*)(ws + WS_CW + (kv ? 512 * 1024 : 0)), (const _Float16*)(ws + WS_CW + 1024 * 1024 + (kv ? 16384 : 0)), kv ? vcmp : kcmp, b, g, kv, ct); }
    { LAS float* biaslut = (LAS float*)(lds + dsa::L_BIAS);
      for (int i = threadIdx.x; i < 1024; i += 512) { const int d = i >> 3, h = i & 7; biaslut[i] = a.rel_bias[t5_bucket(d) * 16 + h]; } }
    __syncthreads();
#pragma unroll 1
    for (int v = blockIdx.x >> 3; v < 256; v += (gridDim.x >> 3)) { const int b = blockIdx.x & 7, j = v & 127;
        dsa::dsa_tile(lds, proj, o_a, b, (v < 128) ? 255 - j : j); }
    xcd_barrier(bar);
    { LAS float* lut = (LAS float*)(lds + nsa::L_BIAS);
      for (int i = threadIdx.x; i < 1024; i += 512) { const int d = i >> 3, h = i & 7; lut[i] = a.rel_bias[t5_bucket(d) * 16 + 8 + h] * nsa::LOG2E; } }
    __syncthreads();
#pragma unroll 1
    for (int v = blockIdx.x >> 3; v < 128; v += (gridDim.x >> 3)) { const int bg = 2 * (blockIdx.x & 7) + (v >> 6), j = v & 31;
        nsa::nsa_unit(lds, proj, kcmp, vcmp, o_b, bg >> 1, bg & 1, (v & 32) ? j : 63 - j);
        __syncthreads(); }
    xcd_barrier(bar);
    gemm_run(lds, ws + WS_H, ws + WS_WBA, pg8::EpiMixF{(_Float16*)(ws + WS_MIX), proj}, M_, D_, D_);
    xcd_barrier(bar);
    gemm_run(lds, ws + WS_MIX, ws + WS_WOUT, pg8::EpiResidSq{a.x, a.out, (_Float16*)(ws + WS_H), (float*)(ws + WS_ROWSQ)}, M_, D_, D_);
    xcd_barrier(bar);
    gemm_run(lds, ws + WS_H, ws + WS_WMI, pg8::EpiRelu2N{(_Float16*)(ws + WS_PROJ), (const float*)(ws + WS_ROWSQ)}, M_, DFF, D_);
    xcd_barrier(bar);
#pragma unroll 1
    for (int sl = 0; sl < 2; ++sl) {
        pg8::Gemm g{(const pg8::bf16_t*)(ws + WS_PROJ), (const pg8::bf16_t*)(ws + WS_WMO), M_, D_, DFF};
        SliceOrder SO; SO.S.init(M_, D_, (int)gridDim.x, (int)blockIdx.x); SO.slice = sl;
        pg8::gemm_phase<EpiFinalNorm, SliceOrder, false, true>(lds, g, SO, EpiFinalNorm{a.out, (const _Float16*)(ws + WS_H), a.norm_final, (float*)(ws + WS_XBUF), (unsigned*)(ws + WS_PCNT)});
        __syncthreads();
    }
}
}

extern "C" void kernel_launch(void* const* d_in, const int* in_sizes, int n_in, void* d_out, int out_size, void* d_ws, size_t ws_size, hipStream_t stream) {
    if (ws_size < WS_END) { fprintf(stderr, "ws too small: %zu\n", ws_size); return; }
    static int grid = 0;
    if (!grid) {
        int dev = 0, cus = 0, per_cu = 0;
        (void)hipGetDevice(&dev);
        (void)hipDeviceGetAttribute(&cus, hipDeviceAttributeMultiprocessorCount, dev);
        (void)hipFuncSetAttribute((const void*)mega_fwd, hipFuncAttributeMaxDynamicSharedMemorySize, MEGA_LDS);
        (void)hipOccupancyMaxActiveBlocksPerMultiprocessor(&per_cu, (const void*)mega_fwd, 512, MEGA_LDS);
        (void)hipGetLastError();
        grid = cus;
        if (per_cu < 1) fprintf(stderr, "occupancy query says %d blocks/CU\n", per_cu);
    }
    Args a{};
    a.x = (const float*)d_in[0]; a.norm_mix = (const float*)d_in[1]; a.w_in = (const float*)d_in[2];
    a.pe_k = (const float*)d_in[3]; a.w1_k = (const float*)d_in[4]; a.w2_k = (const float*)d_in[5];
    a.pe_v = (const float*)d_in[6]; a.w1_v = (const float*)d_in[7]; a.w2_v = (const float*)d_in[8];
    a.rel_bias = (const float*)d_in[9]; a.w_ba = (const float*)d_in[10]; a.w_bb = (const float*)d_in[11];
    a.w_out = (const float*)d_in[12]; a.norm_mlp = (const float*)d_in[13]; a.w_mi = (const float*)d_in[14];
    a.w_mo = (const float*)d_in[15]; a.norm_final = (const float*)d_in[16];
    a.out = (float*)d_out; a.ws = (unsigned char*)d_ws;
    (void)hipMemsetAsync(d_ws, 0, 327680, stream);
    hipLaunchKernelGGL(mega_fwd, dim3(grid), dim3(512), MEGA_LDS, stream, a);
}
```

```cpp
#include <hip/hip_runtime.h>
#include <hip/hip_fp16.h>
#include <cstdint>
#include <cstdio>

namespace pg8 {
#define PG8_LAS __attribute__((address_space(3)))
typedef unsigned short bf16_t;
typedef _Float16 bf16x8 __attribute__((ext_vector_type(8)));
typedef float f32x4 __attribute__((ext_vector_type(4)));
typedef unsigned u32x4 __attribute__((ext_vector_type(4)));
constexpr int BM = 256, BK = 64, HALF = 128, HTB = HALF * BK * 2  , STAGE_BYTES = 8 * HTB, NXCD = 8, WGM = 8;

__host__ __device__ __forceinline__ int lds_byte(int r, int c) { const int st = (r >> 4) * 2 + (c >> 5), rr = r & 15, cc = c & 31, ob = rr * 64 + cc * 2; return st * 1024 + (ob ^ (((ob >> 9) & 1) << 5)); }
__host__ __device__ __forceinline__ void stage_rc(int b, int& R, int& C) { const int st = b / 1024, sb = b % 1024, swz = sb ^ (((sb >> 9) & 1) << 5); R = (st >> 1) * 16 + swz / 64; C = (st & 1) * 32 + (swz % 64) / 2; }
__host__ __device__ __forceinline__ int perm32(int rho) { const int n = rho >> 4, i = rho & 15; return 8 * (i >> 2) + 4 * n + (i & 3); }

struct Unit { int pm, pn; };
struct Gemm { const bf16_t* A; const bf16_t* Bt; int M, N, K; };

struct StaticOrder {
    int nM, nN, nwg, G, c;
    __host__ __device__ void init(int M, int N, int G_, int c_) { nM = M / BM; nN = N / BM; nwg = nM * nN; G = G_; c = c_; }
    __host__ __device__ bool next(int i, Unit& u) const {
        const long L = (long)i * G + c; if (L >= nwg) return false;
        int wgid = (int)L; { const int q = nwg / NXCD, r = nwg % NXCD, xcd = wgid % NXCD, off = wgid / NXCD; wgid = (xcd < r ? xcd * (q + 1) : r * (q + 1) + (xcd - r) * q) + off; }
        const int nig = WGM * nN, gid = wgid / nig, fm = gid * WGM, gsz = (nM - fm) < WGM ? (nM - fm) : WGM;
        u.pm = fm + ((wgid % nig) % gsz); u.pn = (wgid % nig) / gsz; return true;
    }
    __device__ __forceinline__ void a_ready(const Unit&) const {}
    __device__ __forceinline__ void done(const Unit&) const {}
};


typedef unsigned u32x2 __attribute__((ext_vector_type(2)));
typedef float f32x2 __attribute__((ext_vector_type(2)));
typedef _Float16 f16x2 __attribute__((ext_vector_type(2)));
constexpr int PW = 4352;
__device__ __forceinline__ unsigned pkh(float a, float b) { f32x2 v = {a, b}; f16x2 h = __builtin_convertvector(v, f16x2); return __builtin_bit_cast(unsigned, h); }
__device__ __forceinline__ float sigm(float v) { return __builtin_amdgcn_rcpf(1.f + __expf(-v)); }
__device__ __forceinline__ float sigm_gate(float v) { return fmaxf(sigm(v), 6.2e-5f); }
__device__ __forceinline__ void unpk8(const u32x4 w, float (&f)[8]) {
#pragma unroll
    for (int i = 0; i < 4; ++i) { const unsigned wi = (i == 0) ? w.x : (i == 1) ? w.y : (i == 2) ? w.z : w.w; const f16x2 h = __builtin_bit_cast(f16x2, wi); f[2 * i] = (float)h.x; f[2 * i + 1] = (float)h.y; } }

struct EpiProj {
    static constexpr bool PERM = true, AFTER_DRAIN = false, MID = false;
    _Float16* O;
    __device__ __forceinline__ void operator()(const f32x4 (&acc)[2][2][4][2], const Unit& u, int wr, int wc, int fr, int fq) const {
        const int row0 = u.pm * BM + wr * 64 + fr, col0 = u.pn * BM + wc * 32 + 8 * fq; const bool sg = u.pn >= 9;
#pragma unroll
        for (int ai = 0; ai < 2; ++ai)
#pragma unroll
            for (int m = 0; m < 4; ++m) { _Float16* rowp = O + (size_t)(row0 + ai * HALF + m * 16) * PW + col0;
#pragma unroll
                for (int bj = 0; bj < 2; ++bj) { f32x4 v0 = acc[ai][bj][m][0], v1 = acc[ai][bj][m][1];
                    if (sg) {
#pragma unroll
                        for (int i = 0; i < 4; ++i) { v0[i] = sigm_gate(v0[i]); v1[i] = sigm_gate(v1[i]); } }
                    u32x4 w; w.x = pkh(v0[0], v0[1]); w.y = pkh(v0[2], v0[3]); w.z = pkh(v1[0], v1[1]); w.w = pkh(v1[2], v1[3]);
                    *(u32x4*)(rowp + bj * HALF) = w; } }
    }
};
struct EpiMixF {
    static constexpr bool PERM = true, AFTER_DRAIN = false, MID = true;
    _Float16* mix; const _Float16* proj;
    __device__ __forceinline__ void mid(f32x4 (&acc)[2][2][4][2], const Unit& u, int wr, int wc, int fr, int fq) const {
        int row0 = u.pm * BM + wr * 64 + fr, col0 = u.pn * BM + wc * 32 + 8 * fq;
        asm volatile("" : "+v"(row0), "+v"(col0));
#pragma unroll
        for (int ai = 0; ai < 2; ++ai)
#pragma unroll
            for (int m2 = 0; m2 < 2; ++m2) {
                u32x4 wa[2][2], wb[2][2];
#pragma unroll
                for (int q = 0; q < 2; ++q) { const _Float16* gr = proj + (size_t)(row0 + ai * HALF + (2 * m2 + q) * 16) * PW + 2304 + col0;
                    wa[q][0] = *(const u32x4*)(gr); wb[q][0] = *(const u32x4*)(gr + 1024); wa[q][1] = *(const u32x4*)(gr + HALF); wb[q][1] = *(const u32x4*)(gr + 1024 + HALF); }
#pragma unroll
                for (int q = 0; q < 2; ++q)
#pragma unroll
                    for (int bj = 0; bj < 2; ++bj) { float ga[8], gb[8]; unpk8(wa[q][bj], ga); unpk8(wb[q][bj], gb); const int m = 2 * m2 + q;
#pragma unroll
                        for (int i = 0; i < 4; ++i) { acc[ai][bj][m][0][i] *= ga[i] * __builtin_amdgcn_rcpf(gb[i]); acc[ai][bj][m][1][i] *= ga[4 + i] * __builtin_amdgcn_rcpf(gb[4 + i]); } }
                __builtin_amdgcn_sched_barrier(0);
            }
    }
    __device__ __forceinline__ void operator()(const f32x4 (&acc)[2][2][4][2], const Unit& u, int wr, int wc, int fr, int fq) const {
        const int row0 = u.pm * BM + wr * 64 + fr, col0 = u.pn * BM + wc * 32 + 8 * fq;
#pragma unroll
        for (int ai = 0; ai < 2; ++ai) {
            u32x4 gw[4][2];
#pragma unroll
            for (int m = 0; m < 4; ++m)
#pragma unroll
                for (int bj = 0; bj < 2; ++bj) gw[m][bj] = *(const u32x4*)(proj + (size_t)(row0 + ai * HALF + m * 16) * PW + 3328 + col0 + bj * HALF);
#pragma unroll
            for (int m = 0; m < 4; ++m) { const size_t r = (size_t)(row0 + ai * HALF + m * 16);
#pragma unroll
                for (int bj = 0; bj < 2; ++bj) { const int c = col0 + bj * HALF;
                    float gb[8]; unpk8(gw[m][bj], gb);
                    const f32x4 v0 = acc[ai][bj][m][0], v1 = acc[ai][bj][m][1];
                    u32x4 w; w.x = pkh(gb[0] * v0[0], gb[1] * v0[1]); w.y = pkh(gb[2] * v0[2], gb[3] * v0[3]); w.z = pkh(gb[4] * v1[0], gb[5] * v1[1]); w.w = pkh(gb[6] * v1[2], gb[7] * v1[3]);
                    *(u32x4*)(mix + r * 1024 + c) = w; } }
        }
    }
};
struct EpiResidSq {
    static constexpr bool PERM = true, AFTER_DRAIN = false, MID = false;
    const float* x; float* out; _Float16* xh; float* rowsq;
    __device__ __forceinline__ void operator()(const f32x4 (&acc)[2][2][4][2], const Unit& u, int wr, int wc, int fr, int fq) const {
        const int row0 = u.pm * BM + wr * 64 + fr, col0 = u.pn * BM + wc * 32 + 8 * fq;
#pragma unroll
        for (int ai = 0; ai < 2; ++ai)
#pragma unroll
            for (int mh = 0; mh < 2; ++mh) {
                f32x4 xv[2][2][2];
#pragma unroll
                for (int q = 0; q < 2; ++q)
#pragma unroll
                    for (int bj = 0; bj < 2; ++bj) { const size_t o = (size_t)(row0 + ai * HALF + (2 * mh + q) * 16) * 1024 + col0 + bj * HALF;
                        xv[q][bj][0] = *(const f32x4*)(x + o); xv[q][bj][1] = *(const f32x4*)(x + o + 4); }
#pragma unroll
                for (int q = 0; q < 2; ++q) { const int m = 2 * mh + q; const size_t r = (size_t)(row0 + ai * HALF + m * 16); float sq = 0.f;
#pragma unroll
                    for (int bj = 0; bj < 2; ++bj) { const size_t o = r * 1024 + col0 + bj * HALF;
                        const f32x4 a0 = xv[q][bj][0] + acc[ai][bj][m][0], a1 = xv[q][bj][1] + acc[ai][bj][m][1];
                        u32x4 w; w.x = pkh(a0[0], a0[1]); w.y = pkh(a0[2], a0[3]); w.z = pkh(a1[0], a1[1]); w.w = pkh(a1[2], a1[3]);
                        *(u32x4*)(xh + o) = w;
                        sq += (a0[0] * a0[0] + a0[1] * a0[1]) + (a0[2] * a0[2] + a0[3] * a0[3]) + (a1[0] * a1[0] + a1[1] * a1[1]) + (a1[2] * a1[2] + a1[3] * a1[3]); }
                    sq += __shfl_xor(sq, 16); sq += __shfl_xor(sq, 32);
                    if (fq == 0) atomicAdd(rowsq + r, sq); }
            }
    }
};
struct EpiRelu2N {
    static constexpr bool PERM = true, AFTER_DRAIN = false, MID = false;
    _Float16* U; const float* rowsq;
    __device__ __forceinline__ void operator()(const f32x4 (&acc)[2][2][4][2], const Unit& u, int wr, int wc, int fr, int fq) const {
        const int row0 = u.pm * BM + wr * 64 + fr, col0 = u.pn * BM + wc * 32 + 8 * fq;
        float rq[2][4];
#pragma unroll
        for (int ai = 0; ai < 2; ++ai)
#pragma unroll
            for (int m = 0; m < 4; ++m) rq[ai][m] = rowsq[row0 + ai * HALF + m * 16];
#pragma unroll
        for (int ai = 0; ai < 2; ++ai)
#pragma unroll
            for (int m = 0; m < 4; ++m) { const int r = row0 + ai * HALF + m * 16; _Float16* rowp = U + (size_t)r * 4096 + col0;
                const float inv = 1.f / (rq[ai][m] * (1.f / 1024.f) + 1e-6f);
#pragma unroll
                for (int bj = 0; bj < 2; ++bj) { f32x4 v0 = acc[ai][bj][m][0], v1 = acc[ai][bj][m][1];
#pragma unroll
                    for (int i = 0; i < 4; ++i) { const float a = fmaxf(v0[i], 0.f), b = fmaxf(v1[i], 0.f); v0[i] = a * a * inv; v1[i] = b * b * inv; }
                    u32x4 w; w.x = pkh(v0[0], v0[1]); w.y = pkh(v0[2], v0[3]); w.z = pkh(v1[0], v1[1]); w.w = pkh(v1[2], v1[3]);
                    *(u32x4*)(rowp + bj * HALF) = w; } }
    }
};
template <class Epi, class Sched, bool ALIGN_EPI = false, bool SP2 = false>
__device__ __forceinline__ void gemm_phase(PG8_LAS unsigned char* lds, const Gemm g, const Sched& S, const Epi& E) {
    int tid_ = threadIdx.x; asm volatile("" : "+v"(tid_));
    const int tid = tid_, wid = __builtin_amdgcn_readfirstlane(tid >> 6), lane = tid & 63, wr = wid >> 2, wc = wid & 3, fr = lane & 15, fq = lane >> 4;
    const int K = g.K, nt = K / BK;
    unsigned voffA[2], voffB[2];
#pragma unroll
    for (int i = 0; i < 2; ++i) { int R, C; stage_rc(tid * 16 + i * 8192, R, C); const int Rb = Epi::PERM ? ((R & ~31) + perm32(R & 31)) : R;
        voffA[i] = (unsigned)(R * K + C) * 2u; voffB[i] = (unsigned)(Rb * K + C) * 2u; }
    const size_t kstep = (size_t)(BK * 2);
    const size_t hstep = (size_t)HALF * K * 2;
    const size_t tstep = 2 * hstep;
    const unsigned ldsw = (unsigned)wid * 1024u;
    const int aoff = lds_byte(wr * 64 + fr, fq * 8), boff = lds_byte(wc * 32 + fr, fq * 8);
#define PG8_SA(b, h) (((b) * 2 + (h)) * HTB)
#define PG8_SB(b, h) ((4 + (b) * 2 + (h)) * HTB)
#define PG8_STAGE(bufoff, gbase, voff) do { _Pragma("unroll") for (int _i = 0; _i < 2; ++_i) \
        __builtin_amdgcn_global_load_lds((const unsigned*)((const char*)(gbase) + (voff)[_i]), (PG8_LAS unsigned*)(lds + (bufoff) + ldsw + _i * 8192), 16, 0, 0); } while (0)
#define PG8_LDA(dst, b, h) do { _Pragma("unroll") for (int m = 0; m < 4; ++m) _Pragma("unroll") for (int k = 0; k < 2; ++k) dst[m][k] = *(const PG8_LAS bf16x8*)(lds + PG8_SA(b, h) + aoff + m * 2048 + k * 1024); } while (0)
#define PG8_LDB(dst, b, h) do { _Pragma("unroll") for (int n = 0; n < 2; ++n) _Pragma("unroll") for (int k = 0; k < 2; ++k) dst[n][k] = *(const PG8_LAS bf16x8*)(lds + PG8_SB(b, h) + boff + n * 2048 + k * 1024); } while (0)
#define PG8_MMA(ai, bj, At, Bt) do { __builtin_amdgcn_s_setprio(1); _Pragma("unroll") for (int m = 0; m < 4; ++m) _Pragma("unroll") for (int n = 0; n < 2; ++n) _Pragma("unroll") for (int k = 0; k < 2; ++k) \
        acc[ai][bj][m][n] = __builtin_amdgcn_mfma_f32_16x16x32_f16(Bt[n][k], At[m][k], acc[ai][bj][m][n], 0, 0, 0); __builtin_amdgcn_s_setprio(0); } while (0)
#define PG8_WAIT_V(n) asm volatile("s_waitcnt vmcnt(" #n ")" ::: "memory")
#define PG8_WAIT_L(n) asm volatile("s_waitcnt lgkmcnt(" #n ")" ::: "memory")
#define PG8_BAR __builtin_amdgcn_s_barrier()
#define PG8_SCHED __builtin_amdgcn_sched_barrier(0)
    Unit cur, nxt; int ui = 0;
    if (!S.next(0, cur)) return;
    f32x4 acc[2][2][4][2];
#pragma unroll
    for (int a = 0; a < 2; ++a)
#pragma unroll
        for (int b = 0; b < 2; ++b)
#pragma unroll
            for (int m = 0; m < 4; ++m)
#pragma unroll
                for (int n = 0; n < 2; ++n) acc[a][b][m][n] = (f32x4){0.f, 0.f, 0.f, 0.f};
    bf16x8 At[4][2], B0[2][2], B1[2][2];
    const char* cA = (const char*)g.A + (size_t)cur.pm * tstep; const char* cB = (const char*)g.Bt + (size_t)cur.pn * tstep;
    S.a_ready(cur);
    if constexpr (SP2) {
        PG8_STAGE(PG8_SB(0, 0), cB, voffB); PG8_STAGE(PG8_SB(0, 1), cB + hstep, voffB); PG8_STAGE(PG8_SA(0, 0), cA, voffA); PG8_STAGE(PG8_SA(0, 1), cA + hstep, voffA);
        if (wr == 1) PG8_BAR;
        PG8_WAIT_V(2); PG8_BAR;
        PG8_STAGE(PG8_SB(1, 0), cB + kstep, voffB); PG8_STAGE(PG8_SA(1, 0), cA + kstep, voffA); PG8_STAGE(PG8_SB(1, 1), cB + hstep + kstep, voffB);
        PG8_WAIT_V(6); PG8_BAR;
    } else {
        PG8_STAGE(PG8_SB(0, 0), cB, voffB); PG8_STAGE(PG8_SA(0, 0), cA, voffA); PG8_STAGE(PG8_SB(0, 1), cB + hstep, voffB); PG8_STAGE(PG8_SA(0, 1), cA + hstep, voffA);
        if (wr == 1) PG8_BAR;
        PG8_WAIT_V(4); PG8_BAR;
        PG8_STAGE(PG8_SB(1, 0), cB + kstep, voffB); PG8_STAGE(PG8_SA(1, 0), cA + kstep, voffA); PG8_STAGE(PG8_SB(1, 1), cB + hstep + kstep, voffB);
        PG8_WAIT_V(6); PG8_BAR;
    }
    for (;;) {
        const bool has_next = S.next(ui + 1, nxt);
        const char* nA = has_next ? (const char*)g.A + (size_t)nxt.pm * tstep : cA; const char* nB = has_next ? (const char*)g.Bt + (size_t)nxt.pn * tstep : cB;
        for (int t = 0; t < nt; t += 2) {
            if constexpr (Epi::MID) { if (t == nt / 2) E.mid(acc, cur, wr, wc, fr, fq); }
            const bool last = (t == nt - 2);
            const char* a1 = cA + (size_t)(t + 1) * kstep;
            const char* a2 = last ? nA : cA + (size_t)(t + 2) * kstep; const char* b2 = last ? nB : cB + (size_t)(t + 2) * kstep;
            const char* a3 = a2 + kstep; const char* b3 = b2 + kstep;
            if (last && has_next) S.a_ready(nxt);
            if constexpr (SP2) {
            PG8_LDB(B0, 0, 0); PG8_LDB(B1, 0, 1); PG8_SCHED; PG8_LDA(At, 0, 0); PG8_STAGE(PG8_SA(1, 1), a1 + hstep, voffA);
            PG8_WAIT_V(8); PG8_WAIT_L(0); PG8_BAR; PG8_MMA(0, 0, At, B0); PG8_MMA(0, 1, At, B1); PG8_BAR; PG8_SCHED;
            PG8_LDA(At, 0, 1); PG8_STAGE(PG8_SB(0, 0), b2, voffB); PG8_STAGE(PG8_SB(0, 1), b2 + hstep, voffB); PG8_STAGE(PG8_SA(0, 0), a2, voffA);
            PG8_WAIT_V(8); PG8_WAIT_L(0); PG8_BAR; PG8_MMA(1, 0, At, B0); PG8_MMA(1, 1, At, B1); PG8_BAR; PG8_SCHED;
            PG8_LDB(B0, 1, 0); PG8_LDB(B1, 1, 1); PG8_SCHED; PG8_LDA(At, 1, 0); PG8_STAGE(PG8_SA(0, 1), a2 + hstep, voffA);
            PG8_WAIT_V(8); PG8_WAIT_L(0); PG8_BAR; PG8_MMA(0, 0, At, B0); PG8_MMA(0, 1, At, B1); PG8_BAR; PG8_SCHED;
            PG8_LDA(At, 1, 1); PG8_STAGE(PG8_SB(1, 0), b3, voffB); PG8_STAGE(PG8_SB(1, 1), b3 + hstep, voffB); PG8_STAGE(PG8_SA(1, 0), a3, voffA);
            PG8_WAIT_V(8); PG8_WAIT_L(0); PG8_BAR; PG8_MMA(1, 0, At, B0); PG8_MMA(1, 1, At, B1); PG8_BAR; PG8_SCHED;
            } else {
            PG8_LDB(B0, 0, 0); PG8_SCHED; PG8_LDA(At, 0, 0); PG8_STAGE(PG8_SA(1, 1), a1 + hstep, voffA);
            PG8_WAIT_L(8); PG8_BAR; PG8_WAIT_L(0); PG8_MMA(0, 0, At, B0); PG8_BAR; PG8_SCHED;
            PG8_LDB(B1, 0, 1); PG8_STAGE(PG8_SB(0, 0), b2, voffB);
            PG8_BAR; PG8_WAIT_L(0); PG8_MMA(0, 1, At, B1); PG8_BAR;
            PG8_LDA(At, 0, 1); PG8_STAGE(PG8_SA(0, 0), a2, voffA);
            PG8_BAR; PG8_WAIT_L(0); PG8_MMA(1, 0, At, B0); PG8_BAR; PG8_SCHED;
            PG8_STAGE(PG8_SB(0, 1), b2 + hstep, voffB);
            PG8_WAIT_V(6); PG8_BAR; PG8_MMA(1, 1, At, B1); PG8_BAR;
            PG8_LDB(B0, 1, 0); PG8_SCHED; PG8_LDA(At, 1, 0); PG8_STAGE(PG8_SA(0, 1), a2 + hstep, voffA);
            PG8_WAIT_L(8); PG8_BAR; PG8_WAIT_L(0); PG8_MMA(0, 0, At, B0); PG8_BAR; PG8_SCHED;
            PG8_LDB(B1, 1, 1); PG8_STAGE(PG8_SB(1, 0), b3, voffB);
            PG8_BAR; PG8_WAIT_L(0); PG8_MMA(0, 1, At, B1); PG8_BAR;
            PG8_LDA(At, 1, 1); PG8_STAGE(PG8_SA(1, 0), a3, voffA);
            PG8_BAR; PG8_WAIT_L(0); PG8_MMA(1, 0, At, B0); PG8_BAR; PG8_SCHED;
            PG8_STAGE(PG8_SB(1, 1), b3 + hstep, voffB);
            PG8_WAIT_V(6); PG8_BAR; PG8_MMA(1, 1, At, B1); PG8_BAR;
            }
        }
        if constexpr (ALIGN_EPI) { if (wr == 0) PG8_BAR; }
        if constexpr (!Epi::AFTER_DRAIN) { E(acc, cur, wr, wc, fr, fq); S.done(cur); }
        if (!has_next) break;
#pragma unroll
        for (int a = 0; a < 2; ++a)
#pragma unroll
            for (int b = 0; b < 2; ++b)
#pragma unroll
                for (int m = 0; m < 4; ++m)
#pragma unroll
                    for (int n = 0; n < 2; ++n) acc[a][b][m][n] = (f32x4){0.f, 0.f, 0.f, 0.f};
        cur = nxt; cA = nA; cB = nB; ++ui;
        if constexpr (ALIGN_EPI) { if (wr == 1) PG8_BAR; }
    }
    PG8_WAIT_V(0);
    if constexpr (!ALIGN_EPI) { if (wr == 0) PG8_BAR; }
    PG8_BAR;
    if constexpr (Epi::AFTER_DRAIN) { E.fused(acc, cur, wr, wc, fr, fq, lds, wid, lane); S.done(cur); }
#undef PG8_SA
#undef PG8_SB
#undef PG8_STAGE
#undef PG8_LDA
#undef PG8_LDB
#undef PG8_MMA
#undef PG8_WAIT_V
#undef PG8_WAIT_L
#undef PG8_BAR
#undef PG8_SCHED
}
}


namespace {
constexpr int B_ = 8, S_ = 4096, M_ = B_ * S_, D_ = 1024, DIN = 4288, DFF = 4096;
constexpr int C_QA = 0, C_QB = 512, C_QI = 1024, C_KVB = 1280, C_KA = 2048, C_VA = 2112, C_KI = 2176, C_WI = 2208, C_GB = 2216, C_GATE = 2304;
constexpr int NC = 255;
constexpr float EPS = 1e-6f;
using pg8::PW;
#define GAS __attribute__((address_space(1)))
#define LAS __attribute__((address_space(3)))
typedef unsigned v4u __attribute__((ext_vector_type(4)));
typedef float f32x4 __attribute__((ext_vector_type(4)));

__device__ __forceinline__ int t5_bucket(int n) {
    if (n < 16) return n < 0 ? 0 : n;
    float nf = (float)n;
    int large = 16 + (int)(logf(nf / 16.f) / logf(8.f) * 16.f);
    return large < 31 ? large : 31;
}


__device__ __forceinline__ int win_src_col(int n) {
    if (n < 512) return n;
    if (n < 1024) return 936 + (n - 512);
    if (n < 1280) return 640 + (n - 1024);
    if (n < 2048) return 1448 + (n - 1280);
    if (n < 2112) return 512 + (n - 2048);
    if (n < 2176) return 576 + (n - 2112);
    if (n < 2208) return 896 + (n - 2176);
    if (n < 2216) return 928 + (n - 2208);
    if (n < 2240) return n;
    if (n < 2304) return -1;
    return 2240 + (n - 2304);
}
__device__ __forceinline__ float wave_sum(float v) {
#pragma unroll
    for (int o = 1; o < 64; o <<= 1) v += __shfl_xor(v, o);
    return v;
}
template <bool MAP>
__device__ __forceinline__ void transpose_item(const float* __restrict__ W, int K, int Nsrc, int Ndst, _Float16* __restrict__ WT, const float* __restrict__ gain, float* scr, int item, int lane, int dpitch = 0, int koff = 0) {
    const int nblk = Ndst / 32, kb = item / nblk, nb = item % nblk, k0 = 64 * kb, n0 = 32 * nb;
    const int c4 = lane & 7, nd = n0 + 4 * c4; const int ns = MAP ? win_src_col(nd) : nd;
#pragma unroll
    for (int i = 0; i < 8; ++i) { const int kk = 8 * i + (lane >> 3); f32x4 v = {0.f, 0.f, 0.f, 0.f};
        if (ns >= 0) { v = *(const f32x4*)(W + (size_t)(k0 + kk) * Nsrc + ns); if (gain) v = v * gain[k0 + kk]; }
        float* sp = scr + kk * 33 + 4 * c4; sp[0] = v.x; sp[1] = v.y; sp[2] = v.z; sp[3] = v.w; }
    __builtin_amdgcn_s_waitcnt(0xc07f); asm volatile("" ::: "memory");
    const int c = lane & 7;
#pragma unroll
    for (int j = 0; j < 4; ++j) { const int n = (lane >> 3) + 8 * j; const float* s = scr + (8 * c) * 33 + n;
        v4u o; o.x = pg8::pkh(s[0 * 33], s[1 * 33]); o.y = pg8::pkh(s[2 * 33], s[3 * 33]); o.z = pg8::pkh(s[4 * 33], s[5 * 33]); o.w = pg8::pkh(s[6 * 33], s[7 * 33]);
        *(v4u*)(WT + (size_t)(n0 + n) * (dpitch ? dpitch : K) + koff + k0 + 8 * c) = o; }
    __builtin_amdgcn_s_waitcnt(0xc07f); asm volatile("" ::: "memory");
}
__device__ __forceinline__ void rms_row_to_f16(const float* __restrict__ xrow, _Float16* __restrict__ orow, int lane) {
    const f32x4* xr = (const f32x4*)xrow + lane;
    f32x4 v[4]; float s = 0.f;
#pragma unroll
    for (int j = 0; j < 4; ++j) { v[j] = xr[64 * j]; s += (v[j].x * v[j].x + v[j].y * v[j].y) + (v[j].z * v[j].z + v[j].w * v[j].w); }
    const float rstd = rsqrtf(wave_sum(s) * (1.f / D_) + EPS);
    unsigned long long* o8 = (unsigned long long*)orow + lane;
#pragma unroll
    for (int j = 0; j < 4; ++j) o8[64 * j] = (unsigned long long)pg8::pkh(v[j].x * rstd, v[j].y * rstd) | ((unsigned long long)pg8::pkh(v[j].z * rstd, v[j].w * rstd) << 32);
}

struct Args {
    const float* x; const float* norm_mix; const float* w_in; const float* pe_k; const float* w1_k; const float* w2_k; const float* pe_v; const float* w1_v; const float* w2_v;
    const float* rel_bias; const float* w_ba; const float* w_bb; const float* w_out; const float* norm_mlp; const float* w_mi; const float* w_mo; const float* norm_final;
    float* out; unsigned char* ws;
};
constexpr size_t MiB = 1u << 20;
constexpr size_t WS_PCNT = 32768, WS_XBUF = 524288;
constexpr size_t WS_ROWSQ = 65536, WS_ROWSQ2 = 196608;
constexpr size_t WS_CTL = 0, WS_WIN = 1 * MiB, WS_WBA = 10 * MiB, WS_WBB = 11 * MiB, WS_WOUT = 12 * MiB, WS_WMI = 14 * MiB, WS_WMO = 22 * MiB, WS_CW = 30 * MiB,
                 WS_KCMP = 32 * MiB, WS_VCMP = 33 * MiB, WS_H = 34 * MiB, WS_PROJ = 98 * MiB, WS_MIX = 370 * MiB, WS_END = 434 * MiB;

__device__ __forceinline__ void prologue_body(const Args& a, unsigned char* lds) {
    const int tid = threadIdx.x, lane = tid & 63, wave = tid >> 6;
    float* scr = (float*)(lds + wave * 8704);
    const int gw = blockIdx.x * 8 + wave, NGW = gridDim.x * 8;
    constexpr int I_IN = (D_ / 64) * (PW / 32), I_BA = (512 / 64) * (D_ / 32), I_OUT = (D_ / 64) * (D_ / 32), I_MI = (D_ / 64) * (DFF / 32), I_MO = (DFF / 64) * (D_ / 32);
    constexpr int I_C1 = (2048 / 64) * (128 / 32), I_C2 = (128 / 64) * (64 / 32);
    constexpr int NITEMS = I_IN + 2 * I_BA + I_OUT + I_MI + I_MO + 2 * I_C1 + 2 * I_C2;
    for (int it = gw; it < NITEMS; it += NGW) {
        int r = it;
        if (r < I_IN) { transpose_item<true>(a.w_in, D_, DIN, PW, (_Float16*)(a.ws + WS_WIN), a.norm_mix, scr, r, lane); continue; } r -= I_IN;
        if (r < I_BA) { transpose_item<false>(a.w_ba, 512, D_, D_, (_Float16*)(a.ws + WS_WBA), nullptr, scr, r, lane, 1024, 0); continue; } r -= I_BA;
        if (r < I_BA) { transpose_item<false>(a.w_bb, 512, D_, D_, (_Float16*)(a.ws + WS_WBA), nullptr, scr, r, lane, 1024, 512); continue; } r -= I_BA;
        if (r < I_OUT) { transpose_item<false>(a.w_out, D_, D_, D_, (_Float16*)(a.ws + WS_WOUT), nullptr, scr, r, lane); continue; } r -= I_OUT;
        if (r < I_MI) { transpose_item<false>(a.w_mi, D_, DFF, DFF, (_Float16*)(a.ws + WS_WMI), a.norm_mlp, scr, r, lane); continue; } r -= I_MI;
        if (r < I_MO) { transpose_item<false>(a.w_mo, DFF, D_, D_, (_Float16*)(a.ws + WS_WMO), nullptr, scr, r, lane); continue; } r -= I_MO;
        if (r < I_C1) { transpose_item<false>(a.w1_k, 2048, 128, 128, (_Float16*)(a.ws + WS_CW), nullptr, scr, r, lane); continue; } r -= I_C1;
        if (r < I_C1) { transpose_item<false>(a.w1_v, 2048, 128, 128, (_Float16*)(a.ws + WS_CW + 512 * 1024), nullptr, scr, r, lane); continue; } r -= I_C1;
        if (r < I_C2) { transpose_item<false>(a.w2_k, 128, 64, 64, (_Float16*)(a.ws + WS_CW + 1024 * 1024), nullptr, scr, r, lane); continue; } r -= I_C2;
        transpose_item<false>(a.w2_v, 128, 64, 64, (_Float16*)(a.ws + WS_CW + 1024 * 1024 + 16384), nullptr, scr, r, lane);
    }
#pragma unroll 4
    for (int m = gw; m < M_; m += NGW) rms_row_to_f16(a.x + (size_t)m * D_, (_Float16*)(a.ws + WS_H) + (size_t)m * D_, lane);
}
struct EpiAccOut {
    static constexpr bool PERM = true, AFTER_DRAIN = false, MID = false;
    _Float16* x2h; const _Float16* xh; float* rowsq;
    __device__ __forceinline__ void operator()(const f32x4 (&acc)[2][2][4][2], const pg8::Unit& u, int wr, int wc, int fr, int fq) const {
        const int row0 = u.pm * 256 + wr * 64 + fr, col0 = u.pn * 256 + wc * 32 + 8 * fq;
#pragma unroll
        for (int ai = 0; ai < 2; ++ai)
#pragma unroll
            for (int m = 0; m < 4; ++m) { const size_t r = (size_t)(row0 + ai * 128 + m * 16); float sq = 0.f;
#pragma unroll
                for (int bj = 0; bj < 2; ++bj) { const size_t o = r * 1024 + col0 + bj * 128;
                    float p[8]; pg8::unpk8(*(const pg8::u32x4*)(xh + o), p);
                    const f32x4 a0 = acc[ai][bj][m][0], a1 = acc[ai][bj][m][1];
                    const float v[8] = {p[0] + a0[0], p[1] + a0[1], p[2] + a0[2], p[3] + a0[3], p[4] + a1[0], p[5] + a1[1], p[6] + a1[2], p[7] + a1[3]};
                    pg8::u32x4 w; w.x = pg8::pkh(v[0], v[1]); w.y = pg8::pkh(v[2], v[3]); w.z = pg8::pkh(v[4], v[5]); w.w = pg8::pkh(v[6], v[7]);
                    *(pg8::u32x4*)(x2h + o) = w;
                    sq += (v[0] * v[0] + v[1] * v[1]) + (v[2] * v[2] + v[3] * v[3]) + (v[4] * v[4] + v[5] * v[5]) + (v[6] * v[6] + v[7] * v[7]); }
                sq += __shfl_xor(sq, 16); sq += __shfl_xor(sq, 32);
                if (fq == 0) atomicAdd(rowsq + r, sq); }
    }
};
__device__ __forceinline__ void final_scale_row(const _Float16* __restrict__ xrow, float* __restrict__ orow, const float* __restrict__ g, float rsq, int lane) {
    const float rstd = rsqrtf(rsq * (1.f / D_) + EPS);
#pragma unroll
    for (int j = 0; j < 2; ++j) {
        float p[8]; pg8::unpk8(*((const pg8::u32x4*)xrow + lane + 64 * j), p);
        const f32x4 g0 = *((const f32x4*)g + 2 * (lane + 64 * j)), g1 = *((const f32x4*)g + 2 * (lane + 64 * j) + 1);
        *((f32x4*)orow + 2 * (lane + 64 * j)) = (f32x4){p[0] * rstd * g0.x, p[1] * rstd * g0.y, p[2] * rstd * g0.z, p[3] * rstd * g0.w};
        *((f32x4*)orow + 2 * (lane + 64 * j) + 1) = (f32x4){p[4] * rstd * g1.x, p[5] * rstd * g1.y, p[6] * rstd * g1.z, p[7] * rstd * g1.w};
    }
}

struct SliceOrder {
    pg8::StaticOrder S; int slice;
    __device__ bool next(int i, pg8::Unit& u) const { return i == 0 ? S.next(slice, u) : false; }
    __device__ __forceinline__ void a_ready(const pg8::Unit&) const {}
    __device__ __forceinline__ void done(const pg8::Unit&) const {}
};
struct EpiFinalNorm {
    static constexpr bool PERM = true, AFTER_DRAIN = true, MID = false;
    float* out; const _Float16* xh; const float* g; float* xbuf; unsigned* cnt;
    __device__ __forceinline__ void fused(f32x4 (&acc)[2][2][4][2], const pg8::Unit& u, int wr, int wc, int fr, int fq, PG8_LAS unsigned char* lds, int wid, int lane) const {
        const int rl0 = wr * 64 + fr, col0 = u.pn * 256 + wc * 32 + 8 * fq;
        PG8_LAS float* red = (PG8_LAS float*)lds;
#pragma unroll
        for (int ai = 0; ai < 2; ++ai) {
            pg8::u32x4 xw[4][2];
#pragma unroll
            for (int m = 0; m < 4; ++m)
#pragma unroll
                for (int bj = 0; bj < 2; ++bj) xw[m][bj] = *(const pg8::u32x4*)(xh + (size_t)(u.pm * 256 + rl0 + ai * 128 + m * 16) * 1024 + col0 + bj * 128);
#pragma unroll
            for (int m = 0; m < 4; ++m) { const int rl = rl0 + ai * 128 + m * 16; float sq = 0.f;
#pragma unroll
                for (int bj = 0; bj < 2; ++bj) { float p[8]; pg8::unpk8(xw[m][bj], p);
#pragma unroll
                    for (int i = 0; i < 4; ++i) { acc[ai][bj][m][0][i] += p[i]; acc[ai][bj][m][1][i] += p[4 + i];
                        sq = fmaf(acc[ai][bj][m][0][i], acc[ai][bj][m][0][i], sq); sq = fmaf(acc[ai][bj][m][1][i], acc[ai][bj][m][1][i], sq); } }
                sq += __shfl_xor(sq, 16); sq += __shfl_xor(sq, 32);
                if (fq == 0) red[wc * 256 + rl] = sq; }
        }
        __syncthreads();
        const int tid = wid * 64 + lane;
        if (tid < 256) { const float tot = (red[tid] + red[256 + tid]) + (red[512 + tid] + red[768 + tid]);
            __hip_atomic_store(xbuf + ((size_t)u.pm * 4 + u.pn) * 256 + tid, tot, __ATOMIC_RELAXED, __HIP_MEMORY_SCOPE_AGENT); }
        asm volatile("s_waitcnt vmcnt(0)" ::: "memory");
        __syncthreads();
        if (tid == 0) { __hip_atomic_fetch_add(cnt + u.pm, 1u, __ATOMIC_RELAXED, __HIP_MEMORY_SCOPE_AGENT);
            unsigned sp = 0; while (__hip_atomic_load(cnt + u.pm, __ATOMIC_RELAXED, __HIP_MEMORY_SCOPE_AGENT) < 4u && ++sp < (1u << 22)) __builtin_amdgcn_s_sleep(1); }
        __syncthreads();
        if (tid < 256) { float tot = 0.f;
#pragma unroll
            for (int q = 0; q < 4; ++q) tot += __hip_atomic_load(xbuf + ((size_t)u.pm * 4 + q) * 256 + tid, __ATOMIC_RELAXED, __HIP_MEMORY_SCOPE_AGENT);
            red[1024 + tid] = rsqrtf(tot * (1.f / 1024.f) + 1e-6f); }
        __syncthreads();
#pragma unroll
        for (int ai = 0; ai < 2; ++ai)
#pragma unroll
            for (int m = 0; m < 4; ++m) { const int rl = rl0 + ai * 128 + m * 16; const size_t r = (size_t)(u.pm * 256 + rl); const float rstd = red[1024 + rl];
#pragma unroll
                for (int bj = 0; bj < 2; ++bj) { const int c = col0 + bj * 128; const f32x4 g0 = *(const f32x4*)(g + c), g1 = *(const f32x4*)(g + c + 4);
                    *(f32x4*)(out + r * 1024 + c) = acc[ai][bj][m][0] * rstd * g0; *(f32x4*)(out + r * 1024 + c + 4) = acc[ai][bj][m][1] * rstd * g1; } }
        __syncthreads();
    }
};

namespace dsa {
typedef _Float16 f16x8 __attribute__((ext_vector_type(8)));
typedef _Float16 f16x4 __attribute__((ext_vector_type(4)));
typedef short s16x4 __attribute__((ext_vector_type(4)));
typedef float f32x4 __attribute__((ext_vector_type(4)));
typedef unsigned u32x4 __attribute__((ext_vector_type(4)));
typedef unsigned u32x2 __attribute__((ext_vector_type(2)));
constexpr int TQ = 16, NBIN = 2048, CANDCAP = 512, VPITCH = 144;
constexpr int L_HIST = 0, L_SEL = 65536, L_SELD = L_SEL + 8192, L_CTL = L_SELD + 8192, L_BIAS = L_CTL + 512, L_VST = L_BIAS + 4096, L_END = L_VST + 8 * 32 * VPITCH;
static_assert(L_END <= 131072, "dsa LDS");

__device__ __forceinline__ float idx_score(const f32x4 a1, const f32x4 a2, float lin, const float (&wh)[8]) {
    float s = fmaf(wh[0], fabsf(a1.x), lin);
    s = fmaf(wh[1], fabsf(a1.y), s); s = fmaf(wh[2], fabsf(a1.z), s); s = fmaf(wh[3], fabsf(a1.w), s);
    s = fmaf(wh[4], fabsf(a2.x), s); s = fmaf(wh[5], fabsf(a2.y), s); s = fmaf(wh[6], fabsf(a2.z), s); s = fmaf(wh[7], fabsf(a2.w), s);
    return s;
}
__device__ __forceinline__ int score_bin(float sc, float inv) { int b = (int)(fmaf(sc, inv, 1024.f)); b = b < 0 ? 0 : b; return b > NBIN - 1 ? NBIN - 1 : b; }

template <int PASS>
__device__ __forceinline__ void score_pass(LAS unsigned char* lds, const _Float16* __restrict__ proj, int b, int t0, int nkb, int wave, int lane,
                                           const f16x8 (&afr)[4][2], const f16x8 alin, const float (&wq)[4][8], const float (&binv)[4]) {
    LAS unsigned* hist = (LAS unsigned*)(lds + L_HIST);
    LAS unsigned short* sel = (LAS unsigned short*)(lds + L_SEL);
    LAS unsigned short* seld = (LAS unsigned short*)(lds + L_SELD);
    LAS u32x2* cand = (LAS u32x2*)(lds + L_HIST);
    LAS int* ctl = (LAS int*)(lds + L_CTL);
    const int kc = lane >> 4, n16 = lane & 15;
    int bst[4];
#pragma unroll
    for (int grp = 0; grp < 4; ++grp) bst[grp] = (PASS == 2) ? ctl[(4 * grp + kc) * 8 + 2] : 0;
    const f32x4 zero = {0.f, 0.f, 0.f, 0.f};
    const _Float16* kbase = proj + (size_t)(b * S_ + n16) * PW + C_KI + 8 * kc;
    f16x8 bnext = *(const f16x8*)(kbase + (size_t)(16 * (wave < nkb ? wave : 0)) * PW);
    for (int kb = wave; kb < nkb; kb += 8) {
        const f16x8 bfr = bnext;
        { const int kn = kb + 8 < nkb ? kb + 8 : kb; bnext = *(const f16x8*)(kbase + (size_t)(16 * kn) * PW); }
        const int s = 16 * kb + n16;
        const bool lastkb = kb == nkb - 1;
        const f32x4 a3 = __builtin_amdgcn_mfma_f32_16x16x32_f16(alin, bfr, zero, 0, 0, 0);
        const float lin4[4] = {a3.x, a3.y, a3.z, a3.w};
#pragma unroll
        for (int grp = 0; grp < 4; ++grp) {
            const f32x4 a1 = __builtin_amdgcn_mfma_f32_16x16x32_f16(afr[grp][0], bfr, zero, 0, 0, 0);
            const f32x4 a2 = __builtin_amdgcn_mfma_f32_16x16x32_f16(afr[grp][1], bfr, zero, 0, 0, 0);
            const float sc = idx_score(a1, a2, lin4[grp], wq[grp]);
            const int row = 4 * grp + kc, t = t0 + row;
            if (!lastkb || s <= t) {
                const int bin = score_bin(sc, binv[grp]);
                if (PASS == 1) { __hip_atomic_fetch_add(hist + row * 1024 + (bin >> 1), (bin & 1) ? 0x10000u : 1u, __ATOMIC_RELAXED, __HIP_MEMORY_SCOPE_WORKGROUP); }
                else {
                    if (bin > bst[grp]) { const int pos = __hip_atomic_fetch_add(ctl + row * 8 + 0, 1, __ATOMIC_RELAXED, __HIP_MEMORY_SCOPE_WORKGROUP); sel[row * 256 + (pos & 255)] = (unsigned short)s;
                        const int dd = t - s; seld[row * 256 + (pos & 255)] = (unsigned short)((dd > 127 ? 127 : dd) * 32); }
                    else if (bin == bst[grp]) { const int pos = __hip_atomic_fetch_add(ctl + row * 8 + 1, 1, __ATOMIC_RELAXED, __HIP_MEMORY_SCOPE_WORKGROUP);
                        if (pos < CANDCAP) { u32x2 e; e.x = __float_as_uint(sc); e.y = (unsigned)s; cand[row * CANDCAP + pos] = e; } }
                }
            }
        }
    }
}

__device__ __forceinline__ void dsa_tile(LAS unsigned char* lds, const _Float16* __restrict__ proj, _Float16* __restrict__ o_a, int b, int qt) {
    int tid_ = threadIdx.x; asm volatile("" : "+v"(tid_));
    const int tid = tid_, lane = tid & 63, wave = __builtin_amdgcn_readfirstlane(tid >> 6);
    const int kc = lane >> 4, n16 = lane & 15;
    const int t0 = qt * TQ, nkb = qt + 1;
    LAS unsigned* hist = (LAS unsigned*)(lds + L_HIST);
    LAS unsigned short* sel = (LAS unsigned short*)(lds + L_SEL);
    LAS u32x2* cand = (LAS u32x2*)(lds + L_HIST);
    LAS int* ctl = (LAS int*)(lds + L_CTL);
    LAS float* biaslut = (LAS float*)(lds + L_BIAS);
    for (int i = tid; i < (TQ * 1024 + 4096) / 4; i += 512) ((LAS u32x4*)hist)[i] = (u32x4){0u, 0u, 0u, 0u};
    if (tid < TQ * 8) ctl[tid] = 0;
    f16x8 afr[4][2]; f16x8 alin; float wq[4][8]; float binv[4];
    { const int g = n16 >> 2, r = n16 & 3;
      { const int qq = 4 * r + g; const _Float16* qrow = proj + (size_t)(b * S_ + t0 + qq) * PW;
        const f16x8 wg = *(const f16x8*)(qrow + C_WI);
        float lin[8];
#pragma unroll
        for (int e = 0; e < 8; ++e) lin[e] = 0.f;
#pragma unroll
        for (int h = 0; h < 8; ++h) { const f16x8 qh = *(const f16x8*)(qrow + C_QI + h * 32 + 8 * kc); const float wh = (float)wg[h] * (0.5f / 16.f);
#pragma unroll
            for (int e = 0; e < 8; ++e) lin[e] = fmaf(wh, (float)qh[e], lin[e]); }
#pragma unroll
        for (int e = 0; e < 8; ++e) alin[e] = (_Float16)lin[e]; }
#pragma unroll
      for (int grp = 0; grp < 4; ++grp) {
          const _Float16* qrow = proj + (size_t)(b * S_ + t0 + 4 * grp + g) * PW + C_QI;
          afr[grp][0] = *(const f16x8*)(qrow + r * 32 + 8 * kc);
          afr[grp][1] = *(const f16x8*)(qrow + (4 + r) * 32 + 8 * kc);
          const f16x8 wv = *(const f16x8*)(proj + (size_t)(b * S_ + t0 + 4 * grp + kc) * PW + C_WI);
          float ss = 0.f;
#pragma unroll
          for (int h = 0; h < 8; ++h) { const float wfull = (float)wv[h] * (1.f / 16.f); wq[grp][h] = 0.5f * wfull; ss = fmaf(wfull, wfull, ss); }
          binv[grp] = 32.f * rsqrtf(ss + 1e-12f);
      } }
    __syncthreads();
    score_pass<1>(lds, proj, b, t0, nkb, wave, lane, afr, alin, wq, binv);
    __syncthreads();
#pragma unroll 1
    for (int i = 0; i < 2; ++i) {
        const int row = 2 * wave + i, n = t0 + row + 1;
        if (n <= 256) { if (lane == 0) { ctl[row * 8 + 2] = -1; ctl[row * 8 + 3] = 0; } }
        else {
            const LAS u32x4* hp = (const LAS u32x4*)(hist + row * 1024 + 16 * lane);
            unsigned tot = 0;
#pragma unroll
            for (int q4 = 0; q4 < 4; ++q4) { const u32x4 hv = hp[q4];
                tot += (hv.x & 0xffffu) + (hv.x >> 16) + (hv.y & 0xffffu) + (hv.y >> 16) + (hv.z & 0xffffu) + (hv.z >> 16) + (hv.w & 0xffffu) + (hv.w >> 16); }
            unsigned suf = tot;
#pragma unroll
            for (int o = 1; o < 64; o <<= 1) { const unsigned v = __shfl_down(suf, o); if (lane + o < 64) suf += v; }
            const unsigned above_lane = suf - tot;
            const unsigned long long cross = __ballot(above_lane < 256u && suf >= 256u);
            const int lx = __builtin_ctzll(cross);
            const unsigned abovex = __shfl(above_lane, lx);
            const unsigned c2 = lane < 32 ? (unsigned)((const LAS unsigned short*)hist)[row * 2048 + 32 * lx + lane] : 0u;
            unsigned suf2 = c2;
#pragma unroll
            for (int o = 1; o < 32; o <<= 1) { const unsigned v = __shfl_down(suf2, o); if (lane + o < 32) suf2 += v; }
            const unsigned above2 = abovex + suf2 - c2;
            if (lane < 32 && above2 < 256u && above2 + c2 >= 256u) {
                const int bs = 32 * lx + lane; const unsigned cum = above2;
                ctl[row * 8 + 2] = bs; ctl[row * 8 + 3] = 256 - (int)cum;
            }
        }
    }
    __syncthreads();
    score_pass<2>(lds, proj, b, t0, nkb, wave, lane, afr, alin, wq, binv);
    __syncthreads();
#pragma unroll 1
    for (int i = 0; i < 2; ++i) {
        const int row = 2 * wave + i, n = t0 + row + 1;
        const int need = ctl[row * 8 + 3], base = ctl[row * 8 + 0];
        int nc = ctl[row * 8 + 1];
        nc = nc < CANDCAP ? nc : CANDCAP;
        if (lane == 0) { const int nf = base + (need < nc ? need : nc); ctl[row * 8 + 4] = n <= 256 ? n : (nf < 256 ? nf : 256); }
        if (need > 0) {
            for (int c0 = 0; c0 < nc; c0 += 64) {
                const int ci = c0 + lane; const bool act = ci < nc;
                const u32x2 me = cand[row * CANDCAP + (act ? ci : 0)];
                const float msc = __uint_as_float(me.x); int rank = 0;
                for (int j = 0; j < nc; ++j) { const u32x2 ot = cand[row * CANDCAP + j]; const float osc = __uint_as_float(ot.x);
                    rank += (osc > msc || (osc == msc && ot.y < me.y)) ? 1 : 0; }
                if (act && rank < need) { sel[row * 256 + ((base + rank) & 255)] = (unsigned short)me.y; const int dd = t0 + row - (int)me.y; ((LAS unsigned short*)(lds + L_SELD))[row * 256 + ((base + rank) & 255)] = (unsigned short)((dd > 127 ? 127 : dd) * 32); }
            }
        }
    }
    __syncthreads();
    int tq_ = threadIdx.x; asm volatile("" : "+v"(tq_));
    const int lane_a = tq_ & 63;
    LAS unsigned char* vst = lds + L_VST + wave * (32 * VPITCH);
#pragma unroll 1
    for (int i = 0; i < 2; ++i) { const int lane = lane_a, kc = lane >> 4, n16 = lane & 15;
        const int row = 2 * wave + i, t = t0 + row; const int nvalid = ctl[row * 8 + 4];
        const _Float16* qrow = proj + (size_t)(b * S_ + t) * PW + C_QA;
        const int head = n16, hm = head & 7;
        f16x8 qb0, qb1;
        { const f16x8 z = {0, 0, 0, 0, 0, 0, 0, 0}; qb0 = z; qb1 = z;
          if (head < 8) { qb0 = *(const f16x8*)(qrow + head * 64 + 8 * kc); qb1 = *(const f16x8*)(qrow + head * 64 + 32 + 8 * kc); } }
        f32x4 ot[4];
#pragma unroll
        for (int dt = 0; dt < 4; ++dt) ot[dt] = (f32x4){0.f, 0.f, 0.f, 0.f};
        float mrun = -INFINITY, lrun = 0.f;
        const LAS unsigned short* selr = sel + row * 256;
        const LAS unsigned short* seldr = (const LAS unsigned short*)(lds + L_SELD) + row * 256;
        const LAS unsigned char* biasb = lds + L_BIAS + hm * 4;
        const _Float16* pbat = proj + (size_t)(b * S_) * PW;
        LAS unsigned char* kst = lds + L_HIST + wave * (32 * VPITCH);
        u32x4 gk[4], gv[4];
        const char* pbyte = (const char*)pbat;
#define DSA_GATHER(jj) do { _Pragma("unroll") for (int i_ = 0; i_ < 4; ++i_) { const int pos_ = 32 * (jj) + 8 * i_ + (lane >> 3); \
            const unsigned idx_ = pos_ < nvalid ? (unsigned)selr[pos_] : 0u; const char* rp_ = pbyte + (size_t)(idx_ * (unsigned)(PW * 2) + (unsigned)(C_KA * 2 + 16 * (lane & 7))); \
            gk[i_] = *(const u32x4*)rp_; gv[i_] = *(const u32x4*)(rp_ + 128); } } while (0)
        DSA_GATHER(0);
        const int nsteps = (nvalid + 31) >> 5;
#pragma unroll 1
        for (int j = 0; j < nsteps; ++j) {
#pragma unroll
            for (int i_ = 0; i_ < 4; ++i_) { const int ro = (8 * i_ + (lane >> 3)) * VPITCH + 16 * (lane & 7);
                *(LAS u32x4*)(kst + ro) = gk[i_]; *(LAS u32x4*)(vst + ro) = gv[i_]; }
            if (j + 1 < nsteps) DSA_GATHER(j + 1);
            asm volatile("s_waitcnt lgkmcnt(0)" ::: "memory");
            const f16x8 ca0 = *(const LAS f16x8*)(kst + n16 * VPITCH + 16 * kc), ca1 = *(const LAS f16x8*)(kst + n16 * VPITCH + 64 + 16 * kc);
            const f16x8 cb0 = *(const LAS f16x8*)(kst + (16 + n16) * VPITCH + 16 * kc), cb1 = *(const LAS f16x8*)(kst + (16 + n16) * VPITCH + 64 + 16 * kc);
            f32x4 sa = {0.f, 0.f, 0.f, 0.f}, sb = {0.f, 0.f, 0.f, 0.f};
            sa = __builtin_amdgcn_mfma_f32_16x16x32_f16(ca0, qb0, sa, 0, 0, 0); sa = __builtin_amdgcn_mfma_f32_16x16x32_f16(ca1, qb1, sa, 0, 0, 0);
            sb = __builtin_amdgcn_mfma_f32_16x16x32_f16(cb0, qb0, sb, 0, 0, 0); sb = __builtin_amdgcn_mfma_f32_16x16x32_f16(cb1, qb1, sb, 0, 0, 0);
            const int p0 = 32 * j + 4 * kc;
            const u32x2 iwa = *(const LAS u32x2*)(seldr + p0), iwb = *(const LAS u32x2*)(seldr + p0 + 16);
            const unsigned wa0 = iwa.x, wa1 = iwa.y, wb0 = iwb.x, wb1 = iwb.y;
            const unsigned bo[8] = {wa0 & 0xffffu, wa0 >> 16, wa1 & 0xffffu, wa1 >> 16, wb0 & 0xffffu, wb0 >> 16, wb1 & 0xffffu, wb1 >> 16};
            float v[8] = {sa.x, sa.y, sa.z, sa.w, sb.x, sb.y, sb.z, sb.w};
            float tm = -INFINITY;
#pragma unroll
            for (int e = 0; e < 8; ++e) {
                const bool ok = (p0 + (e & 3) + 16 * (e >> 2)) < nvalid;
                const float lg = v[e] * 0.125f + *(const LAS float*)(biasb + bo[e]);
                v[e] = ok ? lg : -INFINITY; tm = fmaxf(tm, v[e]);
            }
            tm = fmaxf(tm, __shfl_xor(tm, 16)); tm = fmaxf(tm, __shfl_xor(tm, 32));
            const float mn = fmaxf(mrun, tm);
            const float alpha = __expf(mrun - mn);
            float ps = 0.f;
#pragma unroll
            for (int e = 0; e < 8; ++e) { v[e] = __expf(v[e] - mn); ps += v[e]; }
            lrun = lrun * alpha + ps; mrun = mn;
#pragma unroll
            for (int dt = 0; dt < 4; ++dt) ot[dt] = ot[dt] * alpha;
            const f16x8 pfr = {(_Float16)v[0], (_Float16)v[1], (_Float16)v[2], (_Float16)v[3], (_Float16)v[4], (_Float16)v[5], (_Float16)v[6], (_Float16)v[7]};
            asm volatile("s_waitcnt lgkmcnt(0)" ::: "memory");
            const int q = n16 >> 2, p = n16 & 3;
#pragma unroll
            for (int dt = 0; dt < 4; ++dt) {
                const s16x4 ta = __builtin_amdgcn_ds_read_tr16_b64_v4i16((LAS s16x4*)(vst + (4 * kc + q) * VPITCH + (16 * dt + 4 * p) * 2));
                const s16x4 tb = __builtin_amdgcn_ds_read_tr16_b64_v4i16((LAS s16x4*)(vst + (16 + 4 * kc + q) * VPITCH + (16 * dt + 4 * p) * 2));
                const f16x4 fa = __builtin_bit_cast(f16x4, ta), fb = __builtin_bit_cast(f16x4, tb);
                const f16x8 vfr = {fa.x, fa.y, fa.z, fa.w, fb.x, fb.y, fb.z, fb.w};
                ot[dt] = __builtin_amdgcn_mfma_f32_16x16x32_f16(vfr, pfr, ot[dt], 0, 0, 0);
            }
            asm volatile("s_waitcnt lgkmcnt(0)" ::: "memory");
        }
#undef DSA_GATHER
        lrun += __shfl_xor(lrun, 16); lrun += __shfl_xor(lrun, 32);
        const float inv = 1.f / fmaxf(lrun, 1e-30f);
        if (head < 8) {
            _Float16* orow = o_a + (size_t)(b * S_ + t) * 1024 + head * 64 + 4 * kc;
#pragma unroll
            for (int dt = 0; dt < 4; ++dt) { u32x2 w; w.x = pg8::pkh(ot[dt].x * inv, ot[dt].y * inv); w.y = pg8::pkh(ot[dt].z * inv, ot[dt].w * inv); *(u32x2*)(orow + 16 * dt) = w; }
        }
    }
    __syncthreads();
}
}


namespace nsa {
typedef _Float16 f16x8 __attribute__((ext_vector_type(8)));
typedef _Float16 f16x4 __attribute__((ext_vector_type(4)));
typedef short s16x4 __attribute__((ext_vector_type(4)));
typedef float f32x4 __attribute__((ext_vector_type(4)));
typedef float f32x16 __attribute__((ext_vector_type(16)));
typedef unsigned u32x4 __attribute__((ext_vector_type(4)));
typedef unsigned u32x2 __attribute__((ext_vector_type(2)));
constexpr int KP = 144, VP = 192;
constexpr int TILE_B = 64 * KP + 64 * VP;
constexpr int L_T0 = 0, L_BIAS = 2 * TILE_B, L_IMPA = L_BIAS + 4096, L_IMPC = L_IMPA + 16384, L_MASK = L_IMPC + 16384, L_END = L_MASK + 512;
static_assert(L_END <= 131072, "nsa LDS");
constexpr float LOG2E = 1.4426950408889634f;
constexpr float SC = 0.125f * LOG2E;
__device__ __forceinline__ float max3f(float a, float b, float c) { float r; asm("v_max3_f32 %0, %1, %2, %3" : "=v"(r) : "v"(a), "v"(b), "v"(c)); return r; }

struct Src { const _Float16* k; const _Float16* v; int pitch; };

struct Stage { u32x4 kr, vr; };
__device__ __forceinline__ void stage_load(Stage& st, const Src& s, int row0, int tid, bool need_v) {
    const int r = tid >> 3, c = tid & 7;
    st.kr = *(const u32x4*)(s.k + (size_t)(row0 + r) * s.pitch + 8 * c);
    if (need_v) st.vr = *(const u32x4*)(s.v + (size_t)(row0 + r) * s.pitch + 8 * c);
}
__device__ __forceinline__ void stage_store(const Stage& st, LAS unsigned char* tb, int tid, bool need_v) {
    const int r = tid >> 3, c = tid & 7;
    *(LAS u32x4*)(tb + r * KP + 16 * c) = st.kr;
    if (need_v) *(LAS u32x4*)(tb + 64 * KP + r * VP + 16 * c) = st.vr;
}

struct RowState { float m, l; f32x16 o0, o1; };

__device__ __forceinline__ void qk_half(const LAS unsigned char* kt, const f16x8 (&qf)[4], int rho, int hi, int kh, f32x16& s0) {
#pragma unroll
    for (int i = 0; i < 16; ++i) s0[i] = 0.f;
    const LAS unsigned char* kb = kt + (32 * kh + rho) * KP + 16 * hi;
#pragma unroll
    for (int ks = 0; ks < 4; ++ks) {
        const f16x8 a0 = *(const LAS f16x8*)(kb + 32 * ks);
        s0 = __builtin_amdgcn_mfma_f32_32x32x16_f16(a0, qf[ks], s0, 0, 0, 0);
    }
}
__device__ __forceinline__ void logits(f32x16& s0, const LAS float* lut, int hb, int hi, int dbase, int dstep, int dlim, bool bit) {
#pragma unroll
    for (int rg = 0; rg < 16; ++rg) {
        const int kl = (rg & 3) + 8 * (rg >> 2) + 4 * hi;
        const int d = dbase - dstep * kl;
        int dc = d < 0 ? 0 : d; dc = dc > 127 ? 127 : dc;
        const float bias = lut[dc * 8 + hb];
        const bool ok = bit && d >= 0 && d < dlim;
        s0[rg] = ok ? fmaf(s0[rg], SC, bias) : -INFINITY;
    }
}
__device__ __forceinline__ void pv_half(RowState& rs, const f32x16& s0, const LAS unsigned char* vt, int rho, int hi, int kh) {
    const int l16 = rho & 15, g16 = rho >> 4, q = l16 >> 2, p = l16 & 3;
    const LAS unsigned char* vb = vt + (32 * kh + 4 * hi + q) * VP + (16 * g16 + 4 * p) * 2;
#pragma unroll
    for (int sx = 0; sx < 2; ++sx) {
        f16x8 pfr;
#pragma unroll
        for (int j = 0; j < 8; ++j) pfr[j] = (_Float16)s0[8 * sx + j];
#pragma unroll
        for (int dt = 0; dt < 2; ++dt) {
            const s16x4 ta = __builtin_amdgcn_ds_read_tr16_b64_v4i16((LAS s16x4*)(vb + (16 * sx) * VP + 64 * dt));
            const s16x4 tb = __builtin_amdgcn_ds_read_tr16_b64_v4i16((LAS s16x4*)(vb + (16 * sx + 8) * VP + 64 * dt));
            const f16x4 fa = __builtin_bit_cast(f16x4, ta), fb = __builtin_bit_cast(f16x4, tb);
            const f16x8 vfr = {fa.x, fa.y, fa.z, fa.w, fb.x, fb.y, fb.z, fb.w};
            if (dt == 0) rs.o0 = __builtin_amdgcn_mfma_f32_32x32x16_f16(vfr, pfr, rs.o0, 0, 0, 0);
            else rs.o1 = __builtin_amdgcn_mfma_f32_32x32x16_f16(vfr, pfr, rs.o1, 0, 0, 0);
        }
    }
}
__device__ __forceinline__ void rescale_if_needed(RowState& rs, float tmx) {
    if (__any(tmx > rs.m + 8.f)) {
        const float mn = fmaxf(rs.m, tmx);
        const float mu = (mn == -INFINITY) ? 0.f : mn;
        const float alpha = __builtin_amdgcn_exp2f(rs.m - mu);
        rs.l *= alpha; rs.m = mn;
#pragma unroll
        for (int i = 0; i < 16; ++i) { rs.o0[i] *= alpha; rs.o1[i] *= alpha; }
    }
}
__device__ __forceinline__ void tile_fast(RowState& rs, const LAS unsigned char* kt, const LAS unsigned char* vt, const f16x8 (&qf)[4], float c, int rho, int hi) {
    const LAS unsigned char* kb = kt + rho * KP + 16 * hi;
    f16x8 ka[4], kb2[4];
#pragma unroll
    for (int ks = 0; ks < 4; ++ks) { ka[ks] = *(const LAS f16x8*)(kb + 32 * ks); kb2[ks] = *(const LAS f16x8*)(kb + 32 * KP + 32 * ks); }
    const int l16 = rho & 15, g16 = rho >> 4, q = l16 >> 2, p = l16 & 3;
    const LAS unsigned char* vb = vt + (4 * hi + q) * VP + (16 * g16 + 4 * p) * 2;
    s16x4 va[4][2], vc[4][2];
    __builtin_amdgcn_sched_barrier(0);
    f32x16 s0, s1;
#pragma unroll
    for (int i = 0; i < 16; ++i) { s0[i] = 0.f; s1[i] = 0.f; }
#pragma unroll
    for (int ks = 0; ks < 4; ++ks) {
        s0 = __builtin_amdgcn_mfma_f32_32x32x16_f16(ka[ks], qf[ks], s0, 0, 0, 0);
        s1 = __builtin_amdgcn_mfma_f32_32x32x16_f16(kb2[ks], qf[ks], s1, 0, 0, 0);
    }
    __builtin_amdgcn_sched_barrier(0);
#pragma unroll
    for (int st = 0; st < 4; ++st)
#pragma unroll
        for (int dt = 0; dt < 2; ++dt) {
            va[st][dt] = __builtin_amdgcn_ds_read_tr16_b64_v4i16((LAS s16x4*)(vb + (16 * st) * VP + 64 * dt));
            vc[st][dt] = __builtin_amdgcn_ds_read_tr16_b64_v4i16((LAS s16x4*)(vb + (16 * st + 8) * VP + 64 * dt));
        }
    __builtin_amdgcn_sched_barrier(0);
    float tm = max3f(s0[0], s1[0], -INFINITY);
#pragma unroll
    for (int i = 1; i < 16; ++i) tm = max3f(tm, s0[i], s1[i]);
    { const auto r2 = __builtin_amdgcn_permlane32_swap(__float_as_uint(tm), __float_as_uint(tm), false, false); tm = fmaxf(__uint_as_float(r2[0]), __uint_as_float(r2[1])); }
    rescale_if_needed(rs, fmaf(tm, SC, c));
    const float mu = (rs.m == -INFINITY) ? 0.f : rs.m;
    const float cm = c - mu;
    float ps = 0.f;
#pragma unroll
    for (int i = 0; i < 16; ++i) { s0[i] = __builtin_amdgcn_exp2f(fmaf(s0[i], SC, cm)); s1[i] = __builtin_amdgcn_exp2f(fmaf(s1[i], SC, cm)); ps += s0[i] + s1[i]; }
    rs.l += ps;
#pragma unroll
    for (int st = 0; st < 4; ++st) {
        f16x8 pfr;
#pragma unroll
        for (int j = 0; j < 8; ++j) pfr[j] = (_Float16)((st & 2) ? s1[8 * (st & 1) + j] : s0[8 * (st & 1) + j]);
#pragma unroll
        for (int dt = 0; dt < 2; ++dt) {
            const f16x4 fa = __builtin_bit_cast(f16x4, va[st][dt]), fb = __builtin_bit_cast(f16x4, vc[st][dt]);
            const f16x8 vfr = {fa.x, fa.y, fa.z, fa.w, fb.x, fb.y, fb.z, fb.w};
            if (dt == 0) rs.o0 = __builtin_amdgcn_mfma_f32_32x32x16_f16(vfr, pfr, rs.o0, 0, 0, 0);
            else rs.o1 = __builtin_amdgcn_mfma_f32_32x32x16_f16(vfr, pfr, rs.o1, 0, 0, 0);
        }
    }
}
template <bool IMP>
__device__ __forceinline__ void tile_general(RowState& rs, const LAS unsigned char* kt, const LAS unsigned char* vt, const f16x8 (&qf)[4], const LAS float* lut, int hb, int rho, int hi,
                                             int dbase, int dstep, unsigned dlim, float mc, float invl, LAS float* impA, LAS float* impC, int n, bool wr) {
    const LAS unsigned char* kb = kt + rho * KP + 16 * hi;
    f16x8 ka[4], kb2[4];
#pragma unroll
    for (int ks = 0; ks < 4; ++ks) { ka[ks] = *(const LAS f16x8*)(kb + 32 * ks); kb2[ks] = *(const LAS f16x8*)(kb + 32 * KP + 32 * ks); }
    const int d0 = dbase - dstep * 4 * hi;
    __builtin_amdgcn_sched_barrier(0);
    f32x16 s0, s1;
#pragma unroll
    for (int i = 0; i < 16; ++i) { s0[i] = 0.f; s1[i] = 0.f; }
#pragma unroll
    for (int ks = 0; ks < 4; ++ks) {
        s0 = __builtin_amdgcn_mfma_f32_32x32x16_f16(ka[ks], qf[ks], s0, 0, 0, 0);
        s1 = __builtin_amdgcn_mfma_f32_32x32x16_f16(kb2[ks], qf[ks], s1, 0, 0, 0);
    }
    __builtin_amdgcn_sched_barrier(0);
    float b0[16], b1[16];
#pragma unroll
    for (int rg = 0; rg < 16; ++rg) {
        const int kl = (rg & 3) + 8 * (rg >> 2);
        int da = d0 - dstep * kl, db = d0 - dstep * (kl + 32);
        da = da < 0 ? 0 : da; da = da > 127 ? 127 : da; db = db < 0 ? 0 : db; db = db > 127 ? 127 : db;
        b0[rg] = lut[da * 8 + hb]; b1[rg] = lut[db * 8 + hb];
    }
    float tm = -INFINITY;
#pragma unroll
    for (int rg = 0; rg < 16; ++rg) {
        const int kl = (rg & 3) + 8 * (rg >> 2);
        const unsigned da = (unsigned)(d0 - dstep * kl), db = (unsigned)(d0 - dstep * (kl + 32));
        s0[rg] = da < dlim ? fmaf(s0[rg], SC, b0[rg]) : -INFINITY;
        s1[rg] = db < dlim ? fmaf(s1[rg], SC, b1[rg]) : -INFINITY;
        tm = max3f(tm, s0[rg], s1[rg]);
    }
    __builtin_amdgcn_sched_barrier(0);
    const int l16 = rho & 15, g16 = rho >> 4, q = l16 >> 2, p = l16 & 3;
    const LAS unsigned char* vb = vt + (4 * hi + q) * VP + (16 * g16 + 4 * p) * 2;
    s16x4 va[4][2], vc[4][2];
    if (!IMP) {
#pragma unroll
        for (int st = 0; st < 4; ++st)
#pragma unroll
            for (int dt = 0; dt < 2; ++dt) {
                va[st][dt] = __builtin_amdgcn_ds_read_tr16_b64_v4i16((LAS s16x4*)(vb + (16 * st) * VP + 64 * dt));
                vc[st][dt] = __builtin_amdgcn_ds_read_tr16_b64_v4i16((LAS s16x4*)(vb + (16 * st + 8) * VP + 64 * dt));
            }
        __builtin_amdgcn_sched_barrier(0);
    }
    if (!IMP) {
        { const auto r2 = __builtin_amdgcn_permlane32_swap(__float_as_uint(tm), __float_as_uint(tm), false, false); tm = fmaxf(__uint_as_float(r2[0]), __uint_as_float(r2[1])); }
        rescale_if_needed(rs, tm);
        const float mu = (rs.m == -INFINITY) ? 0.f : rs.m;
        float ps = 0.f;
#pragma unroll
        for (int i = 0; i < 16; ++i) { s0[i] = __builtin_amdgcn_exp2f(s0[i] - mu); s1[i] = __builtin_amdgcn_exp2f(s1[i] - mu); ps += s0[i] + s1[i]; }
        rs.l += ps;
#pragma unroll
        for (int st = 0; st < 4; ++st) {
            f16x8 pfr;
#pragma unroll
            for (int j = 0; j < 8; ++j) pfr[j] = (_Float16)((st & 2) ? s1[8 * (st & 1) + j] : s0[8 * (st & 1) + j]);
#pragma unroll
            for (int dt = 0; dt < 2; ++dt) {
                const f16x4 fa = __builtin_bit_cast(f16x4, va[st][dt]), fb = __builtin_bit_cast(f16x4, vc[st][dt]);
                const f16x8 vfr = {fa.x, fa.y, fa.z, fa.w, fb.x, fb.y, fb.z, fb.w};
                if (dt == 0) rs.o0 = __builtin_amdgcn_mfma_f32_32x32x16_f16(vfr, pfr, rs.o0, 0, 0, 0);
                else rs.o1 = __builtin_amdgcn_mfma_f32_32x32x16_f16(vfr, pfr, rs.o1, 0, 0, 0);
            }
        }
    } else {
        const float mu = (mc == -INFINITY) ? 0.f : mc;
#pragma unroll
        for (int kh = 0; kh < 2; ++kh)
#pragma unroll
            for (int ii = 0; ii < 4; ++ii) {
                float pv[4];
#pragma unroll
                for (int e = 0; e < 4; ++e) pv[e] = __builtin_amdgcn_exp2f((kh ? s1[4 * ii + e] : s0[4 * ii + e]) - mu) * invl;
                float a = (pv[0] + pv[1]) + (pv[2] + 0.5f * pv[3]), c = 0.5f * pv[3];
                a += __shfl_xor(a, 1); a += __shfl_xor(a, 2); c += __shfl_xor(c, 1); c += __shfl_xor(c, 2);
                const int nb = 16 * n + 8 * kh + 2 * ii + hi;
                if (wr) { impA[nb] = a; if (nb + 1 < 64) impC[nb + 1] = c; }
            }
    }
}
__device__ __forceinline__ void probs(RowState& rs, f32x16& s0, float sc, float c) {
    float tm = -INFINITY;
#pragma unroll
    for (int i = 0; i < 16; ++i) tm = fmaxf(tm, s0[i]);
    tm = fmaxf(tm, __shfl_xor(tm, 32));
    rescale_if_needed(rs, fmaf(tm, sc, c));
    const float mu = (rs.m == -INFINITY) ? 0.f : rs.m;
    const float cm = c - mu;
    float ps = 0.f;
#pragma unroll
    for (int i = 0; i < 16; ++i) { s0[i] = __builtin_amdgcn_exp2f(fmaf(s0[i], sc, cm)); ps += s0[i]; }
    rs.l += ps;
}
__device__ __forceinline__ void rs_init(RowState& rs) { rs.m = -INFINITY; rs.l = 0.f;
#pragma unroll
    for (int i = 0; i < 16; ++i) { rs.o0[i] = 0.f; rs.o1[i] = 0.f; } }
template <int MODE>
__device__ __forceinline__ void rs_flush(RowState& rs, float gate, LAS unsigned char* accl, _Float16* orow) {
    const float lt = rs.l + __shfl_xor(rs.l, 32);
    const float w = gate / fmaxf(lt, 1e-30f);
#pragma unroll
    for (int i = 0; i < 4; ++i) {
        float a[8] = {w * rs.o0[4 * i], w * rs.o0[4 * i + 1], w * rs.o0[4 * i + 2], w * rs.o0[4 * i + 3], w * rs.o1[4 * i], w * rs.o1[4 * i + 1], w * rs.o1[4 * i + 2], w * rs.o1[4 * i + 3]};
        LAS unsigned char* ap = accl + (i >> 1) * 16384 + (i & 1) * 1024;
        if (MODE != 0) { float p[8]; pg8::unpk8(*(const LAS u32x4*)ap, p);
#pragma unroll
            for (int e = 0; e < 8; ++e) a[e] += p[e]; }
        u32x4 wv; wv.x = pg8::pkh(a[0], a[1]); wv.y = pg8::pkh(a[2], a[3]); wv.z = pg8::pkh(a[4], a[5]); wv.w = pg8::pkh(a[6], a[7]);
        if (MODE != 2) *(LAS u32x4*)ap = wv;
        else { u32x2 w0; w0.x = wv.x; w0.y = wv.y; u32x2 w1; w1.x = wv.z; w1.y = wv.w; *(u32x2*)(orow + 8 * i) = w0; *(u32x2*)(orow + 32 + 8 * i) = w1; }
    }
}

__device__ __forceinline__ void nsa_unit(LAS unsigned char* lds, const _Float16* __restrict__ proj, const _Float16* __restrict__ kcmp, const _Float16* __restrict__ vcmp,
                                         _Float16* __restrict__ o_b, int b, int g, int qb) {
    const int tid = threadIdx.x, lane = tid & 63, wave = __builtin_amdgcn_readfirstlane(tid >> 6);
    const int rho = lane & 31, hi = lane >> 5, ql = rho >> 2, r = rho & 3, hb = g * 4 + r;
    const int t = 64 * qb + 8 * wave + ql;
    const _Float16* prow = proj + (size_t)(b * S_ + t) * PW;
    f16x8 qf[4];
#pragma unroll
    for (int ks = 0; ks < 4; ++ks) qf[ks] = *(const f16x8*)(prow + C_QB + hb * 64 + 16 * ks + 8 * hi);
    for (int i = tid; i < 2048; i += 512) ((LAS u32x4*)(lds + L_IMPA))[i] = (u32x4){0u, 0u, 0u, 0u};
    RowState rs; rs_init(rs);
    const LAS float* lut = (const LAS float*)(lds + L_BIAS);
    const float bias31 = lut[127 * 8 + hb];
    const _Float16* kc = kcmp + (size_t)(b * 2 + g) * 256 * 64;
    const long vcoff = (vcmp + (size_t)(b * 2 + g) * 256 * 64) - kc;
    const _Float16* pb = proj + (size_t)(b * S_) * PW + C_KVB + g * 64;
    const int ncmp = (4 * qb + 3 + 63) / 64;
    const int wlo = qb - 8 > 0 ? qb - 8 : 0;
    const int e0 = ncmp, e1 = 2 * ncmp, e2 = e1 + qb + 1, NT = e2 + (qb - wlo + 1);
    const int sr = tid >> 3, scq = tid & 7;
    float mc = 0.f, invl = 0.f; unsigned mlo = 0u, mhi = 0u;
    Stage stg;
#define NSA_DECODE(i, br, n) do { if ((i) < e0) { br = 0; n = (i); } else if ((i) < e1) { br = 1; n = (i) - e0; } else if ((i) < e2) { br = 2; n = (i) - e1; } else { br = 3; n = wlo + (i) - e2; } } while (0)
#define NSA_LOAD(i) do { int br_, n_; NSA_DECODE(i, br_, n_); const _Float16* kp_ = (br_ < 2) ? kc : (br_ == 2 ? pb + 2 * 128 : pb + 4 * 128); const int pitch_ = (br_ < 2) ? 64 : PW; \
        const long vo_ = (br_ < 2) ? vcoff : 128; const _Float16* rp_ = kp_ + (size_t)(64 * n_ + sr) * pitch_ + 8 * scq; stg.kr = *(const u32x4*)rp_; stg.vr = *(const u32x4*)(rp_ + vo_); } while (0)
#define NSA_STORE(buf) do { LAS unsigned char* tb_ = lds + L_T0 + (buf) * TILE_B; *(LAS u32x4*)(tb_ + sr * KP + 16 * scq) = stg.kr; *(LAS u32x4*)(tb_ + 64 * KP + sr * VP + 16 * scq) = stg.vr; } while (0)
    __syncthreads();
    NSA_LOAD(0); NSA_STORE(0);
    __syncthreads();
#pragma unroll 1
    for (int i = 0; i < NT; ++i) {
        int br, n; NSA_DECODE(i, br, n);
        const LAS unsigned char* tb = lds + L_T0 + (i & 1) * TILE_B;
        const bool more = i + 1 < NT;
        if (more) NSA_LOAD(i + 1);
        bool bit = true; int dbase, dstep = 1, dlim = 1 << 30; bool near = true;
        if (br < 2) { dbase = t - 31 - 1024 * n; dstep = 16; }
        else { dbase = t - 64 * n; near = n >= qb - 2; if (br == 2) bit = (n < 32) ? ((mlo >> n) & 1u) : ((mhi >> (n - 32)) & 1u); else dlim = 512; }
        const bool interior = (br >= 2) && (n <= qb - 3) && !(br == 3 && n == qb - 8);
        const bool skip = (br == 2) && !__any(bit);
        if (!skip) {
            if (interior) tile_fast(rs, tb, tb + 64 * KP, qf, bit ? bias31 : -INFINITY, rho, hi);
            else {
                const unsigned dl = bit ? (unsigned)dlim : 0u;
                int tq = threadIdx.x; asm volatile("" : "+v"(tq));
                LAS float* impA = (LAS float*)(lds + L_IMPA) + ((tq >> 6) * 8 + ((tq & 31) >> 2)) * 64;
                LAS float* impC = (LAS float*)(lds + L_IMPC) + ((tq >> 6) * 8 + ((tq & 31) >> 2)) * 64;
                if (br != 1) tile_general<false>(rs, tb, tb + 64 * KP, qf, lut, hb, rho, hi, dbase, dstep, dl, 0.f, 0.f, impA, impC, n, false);
                else tile_general<true>(rs, tb, tb + 64 * KP, qf, lut, hb, rho, hi, dbase, dstep, dl, mc, invl, impA, impC, n, r == 0);
            }
        }
        if (i + 1 == e0) {
            mc = rs.m; const float lc = rs.l + __shfl_xor(rs.l, 32); invl = 1.f / fmaxf(lc, 1e-30f);
        } else if (i + 1 == e1) {
            asm volatile("s_waitcnt lgkmcnt(0)" ::: "memory");
            int tq = threadIdx.x; asm volatile("" : "+v"(tq));
            const int qs = (tq & 63) >> 3, j = tq & 7, wv = tq >> 6;
            LAS float* sA = (LAS float*)(lds + L_IMPA) + (wv * 8 + qs) * 64;
            const LAS float* sC = (const LAS float*)(lds + L_IMPC) + (wv * 8 + qs) * 64;
            float sc[8];
#pragma unroll
            for (int e = 0; e < 8; ++e) { const int nn = 8 * j + e; const bool forced = (nn == 0) || (nn == qb) || (nn == qb - 1);
                sc[e] = (nn <= qb) ? (forced ? 1.0e4f : (sA[nn] + sC[nn])) : -INFINITY; }
            asm volatile("s_waitcnt lgkmcnt(0)" ::: "memory");
#pragma unroll
            for (int e = 0; e < 8; ++e) sA[8 * j + e] = sc[e];
            asm volatile("s_waitcnt lgkmcnt(0)" ::: "memory");
            int rank[8];
#pragma unroll
            for (int e = 0; e < 8; ++e) rank[e] = 0;
            for (int m = 0; m <= qb; ++m) { const float sm = sA[m];
#pragma unroll
                for (int e = 0; e < 8; ++e) rank[e] += (sm > sc[e] || (sm == sc[e] && m < 8 * j + e)) ? 1 : 0; }
            unsigned bits = 0;
#pragma unroll
            for (int e = 0; e < 8; ++e) bits |= ((8 * j + e <= qb) && rank[e] < 16) ? (1u << e) : 0u;
            ((LAS unsigned char*)(lds + L_MASK))[(wv * 8 + qs) * 8 + j] = (unsigned char)bits;
            asm volatile("s_waitcnt lgkmcnt(0)" ::: "memory");
            const u32x2 mk = *(const LAS u32x2*)(lds + L_MASK + (wv * 8 + ((tq & 31) >> 2)) * 8);
            mlo = mk.x; mhi = mk.y;
            rs_flush<0>(rs, pg8::sigm((float)prow[C_GB + 0 * 8 + hb]), lds + L_IMPA + (tq >> 6) * 2048 + (tq & 63) * 16, nullptr); rs_init(rs);
        } else if (i + 1 == e2) {
            rs_flush<1>(rs, pg8::sigm((float)prow[C_GB + 1 * 8 + hb]), lds + L_IMPA + wave * 2048 + lane * 16, nullptr); rs_init(rs);
        } else if (i + 1 == NT) {
            rs_flush<2>(rs, pg8::sigm((float)prow[C_GB + 2 * 8 + hb]), lds + L_IMPA + wave * 2048 + lane * 16, o_b + (size_t)(b * S_ + t) * 1024 + hb * 64 + 4 * hi);
        }
        if (more) NSA_STORE((i + 1) & 1);
        __syncthreads();
    }
#undef NSA_DECODE
#undef NSA_LOAD
#undef NSA_STORE
}
}


namespace cmpx {
typedef _Float16 f16x8 __attribute__((ext_vector_type(8)));
typedef float f32x4 __attribute__((ext_vector_type(4)));
typedef unsigned u32x4 __attribute__((ext_vector_type(4)));
constexpr int L_PART = 0, L_HID = 65536, HIDP = 272, L_END = L_HID + 16 * HIDP;
__device__ __forceinline__ void item(LAS unsigned char* lds, const _Float16* __restrict__ proj, const float* __restrict__ pe, const _Float16* __restrict__ w1t, const _Float16* __restrict__ w2t,
                                     _Float16* __restrict__ dst, int b, int g, int kv, int ct) {
    const int tid = threadIdx.x, lane = tid & 63, wave = __builtin_amdgcn_readfirstlane(tid >> 6), kc = lane >> 4, n16 = lane & 15;
    f32x4 acc[8];
#pragma unroll
    for (int nt = 0; nt < 8; ++nt) acc[nt] = (f32x4){0.f, 0.f, 0.f, 0.f};
    const int c = 16 * ct + n16;
#pragma unroll 2
    for (int ks = 0; ks < 8; ++ks) {
        const int k0 = 32 * (8 * wave + ks) + 8 * kc, lt = k0 >> 6, d = k0 & 63;
        int trow = 16 * c + lt; trow = trow > S_ - 1 ? S_ - 1 : trow;
        const f16x8 raw = *(const f16x8*)(proj + (size_t)(b * S_ + trow) * PW + C_KVB + kv * 128 + g * 64 + d);
        const f32x4 p0 = *(const f32x4*)(pe + lt * 64 + d), p1 = *(const f32x4*)(pe + lt * 64 + d + 4);
        f16x8 afr;
        afr[0] = (_Float16)((float)raw[0] + p0.x); afr[1] = (_Float16)((float)raw[1] + p0.y); afr[2] = (_Float16)((float)raw[2] + p0.z); afr[3] = (_Float16)((float)raw[3] + p0.w);
        afr[4] = (_Float16)((float)raw[4] + p1.x); afr[5] = (_Float16)((float)raw[5] + p1.y); afr[6] = (_Float16)((float)raw[6] + p1.z); afr[7] = (_Float16)((float)raw[7] + p1.w);
#pragma unroll
        for (int nt = 0; nt < 8; ++nt) {
            const f16x8 bfr = *(const f16x8*)(w1t + (size_t)(16 * nt + n16) * 2048 + k0);
            acc[nt] = __builtin_amdgcn_mfma_f32_16x16x32_f16(afr, bfr, acc[nt], 0, 0, 0);
        }
    }
    LAS float* part = (LAS float*)(lds + L_PART) + wave * 2048;
#pragma unroll
    for (int nt = 0; nt < 8; ++nt) { part[(4 * kc + 0) * 128 + 16 * nt + n16] = acc[nt].x; part[(4 * kc + 1) * 128 + 16 * nt + n16] = acc[nt].y;
        part[(4 * kc + 2) * 128 + 16 * nt + n16] = acc[nt].z; part[(4 * kc + 3) * 128 + 16 * nt + n16] = acc[nt].w; }
    __syncthreads();
    { const LAS float* pp = (const LAS float*)(lds + L_PART);
#pragma unroll
      for (int e = 0; e < 4; ++e) { const int o = tid + 512 * e; float a = 0.f;
#pragma unroll
          for (int w = 0; w < 8; ++w) a += pp[w * 2048 + o];
          const float z = 0.7978845608028654f * (a + 0.044715f * a * a * a);
          const float th = 1.f - 2.f / (__expf(2.f * z) + 1.f);
          ((LAS _Float16*)(lds + L_HID + (o >> 7) * HIDP))[o & 127] = (_Float16)(0.5f * a * (1.f + th)); } }
    __syncthreads();
    if (wave < 4) {
        f32x4 o = {0.f, 0.f, 0.f, 0.f};
#pragma unroll
        for (int ks = 0; ks < 4; ++ks) {
            const f16x8 afr = *(const LAS f16x8*)(lds + L_HID + n16 * HIDP + (32 * ks + 8 * kc) * 2);
            const f16x8 bfr = *(const f16x8*)(w2t + (size_t)(16 * wave + n16) * 128 + 32 * ks + 8 * kc);
            o = __builtin_amdgcn_mfma_f32_16x16x32_f16(afr, bfr, o, 0, 0, 0);
        }
        const float ov[4] = {o.x, o.y, o.z, o.w};
#pragma unroll
        for (int e = 0; e < 4; ++e) { const int cc = 16 * ct + 4 * kc + e; dst[((size_t)(b * 2 + g) * 256 + cc) * 64 + 16 * wave + n16] = (_Float16)(cc == 255 ? 0.f : ov[e]); }
    }
    __syncthreads();
}
}


#define XB_TMO      128
#define XB_XCNT(j)  (256  + 64 * (j))
#define XB_XSUB(j)  (1280 + 64 * (j))
#define XB_XGEN(j)  (2304 + 64 * (j))
#define XB_TOP      3328
#define XB_TOPGEN   3392
#define XCD_BAR_WORDS 3456
#define XB_SPIN_CAP (1u << 18)
__device__ __forceinline__ unsigned xb_ld(unsigned* p)              { return __hip_atomic_load(p, __ATOMIC_RELAXED, __HIP_MEMORY_SCOPE_AGENT); }
__device__ __forceinline__ unsigned xb_add(unsigned* p, unsigned v) { return __hip_atomic_fetch_add(p, v, __ATOMIC_RELAXED, __HIP_MEMORY_SCOPE_AGENT); }
__device__ __forceinline__ unsigned xb_xcc_id() { return (unsigned)__builtin_amdgcn_s_getreg((3 << 11) | 20) & 0xFu; }
#define XB_SPIN(cond, bar) do { unsigned _sp = 0; while (cond) { __builtin_amdgcn_s_sleep(1); \
    if ((++_sp & 255u) == 0u) { if (xb_ld(&(bar)[XB_TMO])) break; if (_sp > XB_SPIN_CAP) { atomicAdd(&(bar)[XB_TMO], 1u); break; } } } } while (0)
struct XcdBarrier { unsigned* bar; unsigned x; volatile LAS unsigned* st; };
__device__ __forceinline__ XcdBarrier xcd_barrier_post(unsigned* bar, volatile LAS unsigned* st) {
    XcdBarrier b; b.bar = bar; b.x = xb_xcc_id(); b.st = st;
    if (threadIdx.x == 0) (void)xb_add(&bar[XB_XCNT(b.x)], 1u);
    return b;
}
__device__ __forceinline__ void xcd_barrier_complete(unsigned* bar, unsigned x, unsigned& nloc, unsigned& nx) {
    const unsigned G = gridDim.x * gridDim.y * gridDim.z;
    unsigned sum, cnt, mine, sp = 0u;
    for (;;) {
        sum = 0u; cnt = 0u; mine = 0u;
#pragma unroll
        for (unsigned j = 0; j < 16; ++j) { const unsigned c = xb_ld(&bar[XB_XCNT(j)]); sum += c; cnt += (c > 0u) ? 1u : 0u; mine = (j == x) ? c : mine; }
        if (sum == G) break;
        __builtin_amdgcn_s_sleep(1);
        if ((++sp & 255u) == 0u) { if (xb_ld(&bar[XB_TMO])) break; if (sp > XB_SPIN_CAP) { atomicAdd(&bar[XB_TMO], 1u); break; } }
    }
    nloc = mine > 0u ? mine : 1u; nx = cnt > 0u ? cnt : 1u;
}
__device__ __forceinline__ void xcd_barrier(const XcdBarrier& b) {
    asm volatile("s_waitcnt vmcnt(0)" ::: "memory");
    __syncthreads();
    if (threadIdx.x == 0) {
        unsigned* bar = b.bar;
        __builtin_amdgcn_s_waitcnt(0);
        unsigned nloc = b.st[0], nx = b.st[1];
        if (nloc == 0u) { xcd_barrier_complete(bar, b.x, nloc, nx); b.st[0] = nloc; b.st[1] = nx; }
        const unsigned old = xb_add(&bar[XB_XSUB(b.x)], 1u);
        const unsigned gen = old / nloc;
        if (old + 1u == (gen + 1u) * nloc) {
            __builtin_amdgcn_fence(__ATOMIC_RELEASE, "agent");
            asm volatile("s_waitcnt vmcnt(0)" ::: "memory");
            const unsigned og = xb_add(&bar[XB_TOP], 1u);
            const unsigned tg = og / nx;
            if (og + 1u == (tg + 1u) * nx) xb_add(&bar[XB_TOPGEN], 1u);
            else XB_SPIN(xb_ld(&bar[XB_TOPGEN]) == tg, bar);
            __builtin_amdgcn_fence(__ATOMIC_ACQUIRE, "agent");
            xb_add(&bar[XB_XGEN(b.x)], 1u);
            asm volatile("s_waitcnt vmcnt(0)" ::: "memory");
        } else {
            XB_SPIN(xb_ld(&bar[XB_XGEN(b.x)]) == gen, bar);
            __builtin_amdgcn_fence(__ATOMIC_ACQUIRE, "agent");
            asm volatile("s_waitcnt vmcnt(0)" ::: "memory");
        }
    }
    __syncthreads();
}

constexpr int MEGA_LDS = 131072 + 256;

template <class Epi>
__device__ __forceinline__ void gemm_run(LAS unsigned char* lds, const void* A, const void* Bt, const Epi& E, int M, int N, int K) {
    pg8::Gemm g{(const pg8::bf16_t*)A, (const pg8::bf16_t*)Bt, M, N, K};
    pg8::StaticOrder S; S.init(M, N, (int)gridDim.x, (int)blockIdx.x);
    pg8::gemm_phase<Epi, pg8::StaticOrder, true, true>(lds, g, S, E);
}

__global__ void __launch_bounds__(512, 2) mega_fwd(Args a) {
    extern __shared__ __attribute__((aligned(16))) unsigned char lds_raw[];
    LAS unsigned char* lds = (LAS unsigned char*)lds_raw;
    unsigned char* ws = a.ws;
    if (threadIdx.x == 0) *(LAS dsa::u32x4*)(lds + 131072) = (dsa::u32x4){0u, 0u, 0u, 0u};
    __syncthreads();
    XcdBarrier bar = xcd_barrier_post((unsigned*)(ws + WS_CTL), (volatile LAS unsigned*)(lds + 131072));
    const _Float16* proj = (const _Float16*)(ws + WS_PROJ);
    _Float16* o_a = (_Float16*)(ws + WS_H); _Float16* o_b = (_Float16*)(ws + WS_H) + 512;
    _Float16* kcmp = (_Float16*)(ws + WS_KCMP); _Float16* vcmp = (_Float16*)(ws + WS_VCMP);

    prologue_body(a, lds_raw);
    xcd_barrier(bar);
    gemm_run(lds, ws + WS_H, ws + WS_WIN, pg8::EpiProj{(_Float16*)(ws + WS_PROJ)}, M_, PW, D_);
    xcd_barrier(bar);
#pragma unroll 1
    for (int it = blockIdx.x; it < 512; it += gridDim.x) { const int ct = it & 15, kv = (it >> 4) & 1, g = (it >> 5) & 1, b = it >> 6;
        cmpx::item(lds, proj, kv ? a.pe_v : a.pe_k, (const _Float16*)(ws + WS_CW + (kv ? 512 * 1024 : 0)), (const _Float16*)(ws + WS_CW + 1024 * 1024 + (kv ? 16384 : 0)), kv ? vcmp : kcmp, b, g, kv, ct); }
    { LAS float* biaslut = (LAS float*)(lds + dsa::L_BIAS);
      for (int i = threadIdx.x; i < 1024; i += 512) { const int d = i >> 3, h = i & 7; biaslut[i] = a.rel_bias[t5_bucket(d) * 16 + h]; } }
    __syncthreads();
#pragma unroll 1
    for (int v = blockIdx.x >> 3; v < 256; v += (gridDim.x >> 3)) { const int b = blockIdx.x & 7, j = v & 127;
        dsa::dsa_tile(lds, proj, o_a, b, (v < 128) ? 255 - j : j); }
    xcd_barrier(bar);
    { LAS float* lut = (LAS float*)(lds + nsa::L_BIAS);
      for (int i = threadIdx.x; i < 1024; i += 512) { const int d = i >> 3, h = i & 7; lut[i] = a.rel_bias[t5_bucket(d) * 16 + 8 + h] * nsa::LOG2E; } }
    __syncthreads();
#pragma unroll 1
    for (int v = blockIdx.x >> 3; v < 128; v += (gridDim.x >> 3)) { const int bg = 2 * (blockIdx.x & 7) + (v >> 6), j = v & 31;
        nsa::nsa_unit(lds, proj, kcmp, vcmp, o_b, bg >> 1, bg & 1, (v & 32) ? j : 63 - j);
        __syncthreads(); }
    xcd_barrier(bar);
    gemm_run(lds, ws + WS_H, ws + WS_WBA, pg8::EpiMixF{(_Float16*)(ws + WS_MIX), proj}, M_, D_, D_);
    xcd_barrier(bar);
    gemm_run(lds, ws + WS_MIX, ws + WS_WOUT, pg8::EpiResidSq{a.x, a.out, (_Float16*)(ws + WS_H), (float*)(ws + WS_ROWSQ)}, M_, D_, D_);
    xcd_barrier(bar);
    gemm_run(lds, ws + WS_H, ws + WS_WMI, pg8::EpiRelu2N{(_Float16*)(ws + WS_PROJ), (const float*)(ws + WS_ROWSQ)}, M_, DFF, D_);
    xcd_barrier(bar);
#pragma unroll 1
    for (int sl = 0; sl < 2; ++sl) {
        pg8::Gemm g{(const pg8::bf16_t*)(ws + WS_PROJ), (const pg8::bf16_t*)(ws + WS_WMO), M_, D_, DFF};
        SliceOrder SO; SO.S.init(M_, D_, (int)gridDim.x, (int)blockIdx.x); SO.slice = sl;
        pg8::gemm_phase<EpiFinalNorm, SliceOrder, false, true>(lds, g, SO, EpiFinalNorm{a.out, (const _Float16*)(ws + WS_H), a.norm_final, (float*)(ws + WS_XBUF), (unsigned*)(ws + WS_PCNT)});
        __syncthreads();
    }
}
}

extern "C" void kernel_launch(void* const* d_in, const int* in_sizes, int n_in, void* d_out, int out_size, void* d_ws, size_t ws_size, hipStream_t stream) {
    if (ws_size < WS_END) { fprintf(stderr, "ws too small: %zu\n", ws_size); return; }
    static int grid = 0;
    if (!grid) {
        int dev = 0, cus = 0, per_cu = 0;
        (void)hipGetDevice(&dev);
        (void)hipDeviceGetAttribute(&cus, hipDeviceAttributeMultiprocessorCount, dev);
        (void)hipFuncSetAttribute((const void*)mega_fwd, hipFuncAttributeMaxDynamicSharedMemorySize, MEGA_LDS);
        (void)hipOccupancyMaxActiveBlocksPerMultiprocessor(&per_cu, (const void*)mega_fwd, 512, MEGA_LDS);
        (void)hipGetLastError();
        grid = cus;
        if (per_cu < 1) fprintf(stderr, "occupancy query says %d blocks/CU\n", per_cu);
        if (cus != 256) { fprintf(stderr, "kernel_launch: built for a 256-CU device (the last GEMM's row-panel exchange needs exactly 256 workgroups); found %d CUs, nothing launched\n", cus); grid = -1; }
    }
    if (grid < 0) return;
    Args a{};
    a.x = (const float*)d_in[0]; a.norm_mix = (const float*)d_in[1]; a.w_in = (const float*)d_in[2];
    a.pe_k = (const float*)d_in[3]; a.w1_k = (const float*)d_in[4]; a.w2_k = (const float*)d_in[5];
    a.pe_v = (const float*)d_in[6]; a.w1_v = (const float*)d_in[7]; a.w2_v = (const float*)d_in[8];
    a.rel_bias = (const float*)d_in[9]; a.w_ba = (const float*)d_in[10]; a.w_bb = (const float*)d_in[11];
    a.w_out = (const float*)d_in[12]; a.norm_mlp = (const float*)d_in[13]; a.w_mi = (const float*)d_in[14];
    a.w_mo = (const float*)d_in[15]; a.norm_final = (const float*)d_in[16];
    a.out = (float*)d_out; a.ws = (unsigned char*)d_ws;
    (void)hipMemsetAsync(d_ws, 0, 327680, stream);
    hipLaunchKernelGGL(mega_fwd, dim3(grid), dim3(512), MEGA_LDS, stream, a);
}
```

```cpp
#include <hip/hip_runtime.h>
#include <hip/hip_fp16.h>
#include <cstdint>
#include <cstdio>

namespace pg8 {
#define PG8_LAS __attribute__((address_space(3)))
typedef unsigned short bf16_t;
typedef _Float16 bf16x8 __attribute__((ext_vector_type(8)));
typedef float f32x4 __attribute__((ext_vector_type(4)));
typedef unsigned u32x4 __attribute__((ext_vector_type(4)));
constexpr int BM = 256, BK = 64, HALF = 128, HTB = HALF * BK * 2  , STAGE_BYTES = 8 * HTB, NXCD = 8, WGM = 8;

__host__ __device__ __forceinline__ int lds_byte(int r, int c) { const int st = (r >> 4) * 2 + (c >> 5), rr = r & 15, cc = c & 31, ob = rr * 64 + cc * 2; return st * 1024 + (ob ^ (((ob >> 9) & 1) << 5)); }
__host__ __device__ __forceinline__ void stage_rc(int b, int& R, int& C) { const int st = b / 1024, sb = b % 1024, swz = sb ^ (((sb >> 9) & 1) << 5); R = (st >> 1) * 16 + swz / 64; C = (st & 1) * 32 + (swz % 64) / 2; }
__host__ __device__ __forceinline__ int perm32(int rho) { const int n = rho >> 4, i = rho & 15; return 8 * (i >> 2) + 4 * n + (i & 3); }

struct Unit { int pm, pn; };
struct Gemm { const bf16_t* A; const bf16_t* Bt; int M, N, K; };

struct StaticOrder {
    int nM, nN, nwg, G, c;
    __host__ __device__ void init(int M, int N, int G_, int c_) { nM = M / BM; nN = N / BM; nwg = nM * nN; G = G_; c = c_; }
    __host__ __device__ bool next(int i, Unit& u) const {
        const long L = (long)i * G + c; if (L >= nwg) return false;
        int wgid = (int)L; { const int q = nwg / NXCD, r = nwg % NXCD, xcd = wgid % NXCD, off = wgid / NXCD; wgid = (xcd < r ? xcd * (q + 1) : r * (q + 1) + (xcd - r) * q) + off; }
        const int nig = WGM * nN, gid = wgid / nig, fm = gid * WGM, gsz = (nM - fm) < WGM ? (nM - fm) : WGM;
        u.pm = fm + ((wgid % nig) % gsz); u.pn = (wgid % nig) / gsz; return true;
    }
    __device__ __forceinline__ void a_ready(const Unit&) const {}
    __device__ __forceinline__ void done(const Unit&) const {}
};


typedef unsigned u32x2 __attribute__((ext_vector_type(2)));
typedef float f32x2 __attribute__((ext_vector_type(2)));
typedef _Float16 f16x2 __attribute__((ext_vector_type(2)));
constexpr int PW = 4352;
__device__ __forceinline__ unsigned pkh(float a, float b) { f32x2 v = {a, b}; f16x2 h = __builtin_convertvector(v, f16x2); return __builtin_bit_cast(unsigned, h); }
__device__ __forceinline__ float sigm(float v) { return __builtin_amdgcn_rcpf(1.f + __expf(-v)); }
__device__ __forceinline__ float sigm_gate(float v) { return fmaxf(sigm(v), 6.2e-5f); }
__device__ __forceinline__ void unpk8(const u32x4 w, float (&f)[8]) {
#pragma unroll
    for (int i = 0; i < 4; ++i) { const unsigned wi = (i == 0) ? w.x : (i == 1) ? w.y : (i == 2) ? w.z : w.w; const f16x2 h = __builtin_bit_cast(f16x2, wi); f[2 * i] = (float)h.x; f[2 * i + 1] = (float)h.y; } }

struct EpiProj {
    static constexpr bool PERM = true, AFTER_DRAIN = false, MID = false;
    _Float16* O;
    __device__ __forceinline__ void operator()(const f32x4 (&acc)[2][2][4][2], const Unit& u, int wr, int wc, int fr, int fq) const {
        const int row0 = u.pm * BM + wr * 64 + fr, col0 = u.pn * BM + wc * 32 + 8 * fq; const bool sg = u.pn >= 9;
#pragma unroll
        for (int ai = 0; ai < 2; ++ai)
#pragma unroll
            for (int m = 0; m < 4; ++m) { _Float16* rowp = O + (size_t)(row0 + ai * HALF + m * 16) * PW + col0;
#pragma unroll
                for (int bj = 0; bj < 2; ++bj) { f32x4 v0 = acc[ai][bj][m][0], v1 = acc[ai][bj][m][1];
                    if (sg) {
#pragma unroll
                        for (int i = 0; i < 4; ++i) { v0[i] = sigm_gate(v0[i]); v1[i] = sigm_gate(v1[i]); } }
                    u32x4 w; w.x = pkh(v0[0], v0[1]); w.y = pkh(v0[2], v0[3]); w.z = pkh(v1[0], v1[1]); w.w = pkh(v1[2], v1[3]);
                    *(u32x4*)(rowp + bj * HALF) = w; } }
    }
};
struct EpiMixF {
    static constexpr bool PERM = true, AFTER_DRAIN = false, MID = true;
    _Float16* mix; const _Float16* proj;
    __device__ __forceinline__ void mid(f32x4 (&acc)[2][2][4][2], const Unit& u, int wr, int wc, int fr, int fq) const {
        int row0 = u.pm * BM + wr * 64 + fr, col0 = u.pn * BM + wc * 32 + 8 * fq;
        asm volatile("" : "+v"(row0), "+v"(col0));
#pragma unroll
        for (int ai = 0; ai < 2; ++ai)
#pragma unroll
            for (int m2 = 0; m2 < 2; ++m2) {
                u32x4 wa[2][2], wb[2][2];
#pragma unroll
                for (int q = 0; q < 2; ++q) { const _Float16* gr = proj + (size_t)(row0 + ai * HALF + (2 * m2 + q) * 16) * PW + 2304 + col0;
                    wa[q][0] = *(const u32x4*)(gr); wb[q][0] = *(const u32x4*)(gr + 1024); wa[q][1] = *(const u32x4*)(gr + HALF); wb[q][1] = *(const u32x4*)(gr + 1024 + HALF); }
#pragma unroll
                for (int q = 0; q < 2; ++q)
#pragma unroll
                    for (int bj = 0; bj < 2; ++bj) { float ga[8], gb[8]; unpk8(wa[q][bj], ga); unpk8(wb[q][bj], gb); const int m = 2 * m2 + q;
#pragma unroll
                        for (int i = 0; i < 4; ++i) { acc[ai][bj][m][0][i] *= ga[i] * __builtin_amdgcn_rcpf(gb[i]); acc[ai][bj][m][1][i] *= ga[4 + i] * __builtin_amdgcn_rcpf(gb[4 + i]); } }
                __builtin_amdgcn_sched_barrier(0);
            }
    }
    __device__ __forceinline__ void operator()(const f32x4 (&acc)[2][2][4][2], const Unit& u, int wr, int wc, int fr, int fq) const {
        const int row0 = u.pm * BM + wr * 64 + fr, col0 = u.pn * BM + wc * 32 + 8 * fq;
#pragma unroll
        for (int ai = 0; ai < 2; ++ai) {
            u32x4 gw[4][2];
#pragma unroll
            for (int m = 0; m < 4; ++m)
#pragma unroll
                for (int bj = 0; bj < 2; ++bj) gw[m][bj] = *(const u32x4*)(proj + (size_t)(row0 + ai * HALF + m * 16) * PW + 3328 + col0 + bj * HALF);
#pragma unroll
            for (int m = 0; m < 4; ++m) { const size_t r = (size_t)(row0 + ai * HALF + m * 16);
#pragma unroll
                for (int bj = 0; bj < 2; ++bj) { const int c = col0 + bj * HALF;
                    float gb[8]; unpk8(gw[m][bj], gb);
                    const f32x4 v0 = acc[ai][bj][m][0], v1 = acc[ai][bj][m][1];
                    u32x4 w; w.x = pkh(gb[0] * v0[0], gb[1] * v0[1]); w.y = pkh(gb[2] * v0[2], gb[3] * v0[3]); w.z = pkh(gb[4] * v1[0], gb[5] * v1[1]); w.w = pkh(gb[6] * v1[2], gb[7] * v1[3]);
                    *(u32x4*)(mix + r * 1024 + c) = w; } }
        }
    }
};
struct EpiResidSq {
    static constexpr bool PERM = true, AFTER_DRAIN = false, MID = false;
    const float* x; float* out; _Float16* xh; float* rowsq;
    __device__ __forceinline__ void operator()(const f32x4 (&acc)[2][2][4][2], const Unit& u, int wr, int wc, int fr, int fq) const {
        const int row0 = u.pm * BM + wr * 64 + fr, col0 = u.pn * BM + wc * 32 + 8 * fq;
#pragma unroll
        for (int ai = 0; ai < 2; ++ai)
#pragma unroll
            for (int mh = 0; mh < 2; ++mh) {
                f32x4 xv[2][2][2];
#pragma unroll
                for (int q = 0; q < 2; ++q)
#pragma unroll
                    for (int bj = 0; bj < 2; ++bj) { const size_t o = (size_t)(row0 + ai * HALF + (2 * mh + q) * 16) * 1024 + col0 + bj * HALF;
                        xv[q][bj][0] = *(const f32x4*)(x + o); xv[q][bj][1] = *(const f32x4*)(x + o + 4); }
#pragma unroll
                for (int q = 0; q < 2; ++q) { const int m = 2 * mh + q; const size_t r = (size_t)(row0 + ai * HALF + m * 16); float sq = 0.f;
#pragma unroll
                    for (int bj = 0; bj < 2; ++bj) { const size_t o = r * 1024 + col0 + bj * HALF;
                        const f32x4 a0 = xv[q][bj][0] + acc[ai][bj][m][0], a1 = xv[q][bj][1] + acc[ai][bj][m][1];
                        u32x4 w; w.x = pkh(a0[0], a0[1]); w.y = pkh(a0[2], a0[3]); w.z = pkh(a1[0], a1[1]); w.w = pkh(a1[2], a1[3]);
                        *(u32x4*)(xh + o) = w;
                        sq += (a0[0] * a0[0] + a0[1] * a0[1]) + (a0[2] * a0[2] + a0[3] * a0[3]) + (a1[0] * a1[0] + a1[1] * a1[1]) + (a1[2] * a1[2] + a1[3] * a1[3]); }
                    sq += __shfl_xor(sq, 16); sq += __shfl_xor(sq, 32);
                    if (fq == 0) atomicAdd(rowsq + r, sq); }
            }
    }
};
struct EpiRelu2N {
    static constexpr bool PERM = true, AFTER_DRAIN = false, MID = false;
    _Float16* U; const float* rowsq;
    __device__ __forceinline__ void operator()(const f32x4 (&acc)[2][2][4][2], const Unit& u, int wr, int wc, int fr, int fq) const {
        const int row0 = u.pm * BM + wr * 64 + fr, col0 = u.pn * BM + wc * 32 + 8 * fq;
        float rq[2][4];
#pragma unroll
        for (int ai = 0; ai < 2; ++ai)
#pragma unroll
            for (int m = 0; m < 4; ++m) rq[ai][m] = rowsq[row0 + ai * HALF + m * 16];
#pragma unroll
        for (int ai = 0; ai < 2; ++ai)
#pragma unroll
            for (int m = 0; m < 4; ++m) { const int r = row0 + ai * HALF + m * 16; _Float16* rowp = U + (size_t)r * 4096 + col0;
                const float inv = 1.f / (rq[ai][m] * (1.f / 1024.f) + 1e-6f);
#pragma unroll
                for (int bj = 0; bj < 2; ++bj) { f32x4 v0 = acc[ai][bj][m][0], v1 = acc[ai][bj][m][1];
#pragma unroll
                    for (int i = 0; i < 4; ++i) { const float a = fmaxf(v0[i], 0.f), b = fmaxf(v1[i], 0.f); v0[i] = a * a * inv; v1[i] = b * b * inv; }
                    u32x4 w; w.x = pkh(v0[0], v0[1]); w.y = pkh(v0[2], v0[3]); w.z = pkh(v1[0], v1[1]); w.w = pkh(v1[2], v1[3]);
                    *(u32x4*)(rowp + bj * HALF) = w; } }
    }
};
template <class Epi, class Sched, bool ALIGN_EPI = false, bool SP2 = false>
__device__ __forceinline__ void gemm_phase(PG8_LAS unsigned char* lds, const Gemm g, const Sched& S, const Epi& E) {
    int tid_ = threadIdx.x; asm volatile("" : "+v"(tid_));
    const int tid = tid_, wid = __builtin_amdgcn_readfirstlane(tid >> 6), lane = tid & 63, wr = wid >> 2, wc = wid & 3, fr = lane & 15, fq = lane >> 4;
    const int K = g.K, nt = K / BK;
    unsigned voffA[2], voffB[2];
#pragma unroll
    for (int i = 0; i < 2; ++i) { int R, C; stage_rc(tid * 16 + i * 8192, R, C); const int Rb = Epi::PERM ? ((R & ~31) + perm32(R & 31)) : R;
        voffA[i] = (unsigned)(R * K + C) * 2u; voffB[i] = (unsigned)(Rb * K + C) * 2u; }
    const size_t kstep = (size_t)(BK * 2);
    const size_t hstep = (size_t)HALF * K * 2;
    const size_t tstep = 2 * hstep;
    const unsigned ldsw = (unsigned)wid * 1024u;
    const int aoff = lds_byte(wr * 64 + fr, fq * 8), boff = lds_byte(wc * 32 + fr, fq * 8);
#define PG8_SA(b, h) (((b) * 2 + (h)) * HTB)
#define PG8_SB(b, h) ((4 + (b) * 2 + (h)) * HTB)
#define PG8_STAGE(bufoff, gbase, voff) do { _Pragma("unroll") for (int _i = 0; _i < 2; ++_i) \
        __builtin_amdgcn_global_load_lds((const unsigned*)((const char*)(gbase) + (voff)[_i]), (PG8_LAS unsigned*)(lds + (bufoff) + ldsw + _i * 8192), 16, 0, 0); } while (0)
#define PG8_LDA(dst, b, h) do { _Pragma("unroll") for (int m = 0; m < 4; ++m) _Pragma("unroll") for (int k = 0; k < 2; ++k) dst[m][k] = *(const PG8_LAS bf16x8*)(lds + PG8_SA(b, h) + aoff + m * 2048 + k * 1024); } while (0)
#define PG8_LDB(dst, b, h) do { _Pragma("unroll") for (int n = 0; n < 2; ++n) _Pragma("unroll") for (int k = 0; k < 2; ++k) dst[n][k] = *(const PG8_LAS bf16x8*)(lds + PG8_SB(b, h) + boff + n * 2048 + k * 1024); } while (0)
#define PG8_MMA(ai, bj, At, Bt) do { __builtin_amdgcn_s_setprio(1); _Pragma("unroll") for (int m = 0; m < 4; ++m) _Pragma("unroll") for (int n = 0; n < 2; ++n) _Pragma("unroll") for (int k = 0; k < 2; ++k) \
        acc[ai][bj][m][n] = __builtin_amdgcn_mfma_f32_16x16x32_f16(Bt[n][k], At[m][k], acc[ai][bj][m][n], 0, 0, 0); __builtin_amdgcn_s_setprio(0); } while (0)
#define PG8_WAIT_V(n) asm volatile("s_waitcnt vmcnt(" #n ")" ::: "memory")
#define PG8_WAIT_L(n) asm volatile("s_waitcnt lgkmcnt(" #n ")" ::: "memory")
#define PG8_BAR __builtin_amdgcn_s_barrier()
#define PG8_SCHED __builtin_amdgcn_sched_barrier(0)
    Unit cur, nxt; int ui = 0;
    if (!S.next(0, cur)) return;
    f32x4 acc[2][2][4][2];
#pragma unroll
    for (int a = 0; a < 2; ++a)
#pragma unroll
        for (int b = 0; b < 2; ++b)
#pragma unroll
            for (int m = 0; m < 4; ++m)
#pragma unroll
                for (int n = 0; n < 2; ++n) acc[a][b][m][n] = (f32x4){0.f, 0.f, 0.f, 0.f};
    bf16x8 At[4][2], B0[2][2], B1[2][2];
    const char* cA = (const char*)g.A + (size_t)cur.pm * tstep; const char* cB = (const char*)g.Bt + (size_t)cur.pn * tstep;
    S.a_ready(cur);
    if constexpr (SP2) {
        PG8_STAGE(PG8_SB(0, 0), cB, voffB); PG8_STAGE(PG8_SB(0, 1), cB + hstep, voffB); PG8_STAGE(PG8_SA(0, 0), cA, voffA); PG8_STAGE(PG8_SA(0, 1), cA + hstep, voffA);
        if (wr == 1) PG8_BAR;
        PG8_WAIT_V(2); PG8_BAR;
        PG8_STAGE(PG8_SB(1, 0), cB + kstep, voffB); PG8_STAGE(PG8_SA(1, 0), cA + kstep, voffA); PG8_STAGE(PG8_SB(1, 1), cB + hstep + kstep, voffB);
        PG8_WAIT_V(6); PG8_BAR;
    } else {
        PG8_STAGE(PG8_SB(0, 0), cB, voffB); PG8_STAGE(PG8_SA(0, 0), cA, voffA); PG8_STAGE(PG8_SB(0, 1), cB + hstep, voffB); PG8_STAGE(PG8_SA(0, 1), cA + hstep, voffA);
        if (wr == 1) PG8_BAR;
        PG8_WAIT_V(4); PG8_BAR;
        PG8_STAGE(PG8_SB(1, 0), cB + kstep, voffB); PG8_STAGE(PG8_SA(1, 0), cA + kstep, voffA); PG8_STAGE(PG8_SB(1, 1), cB + hstep + kstep, voffB);
        PG8_WAIT_V(6); PG8_BAR;
    }
    for (;;) {
        const bool has_next = S.next(ui + 1, nxt);
        const char* nA = has_next ? (const char*)g.A + (size_t)nxt.pm * tstep : cA; const char* nB = has_next ? (const char*)g.Bt + (size_t)nxt.pn * tstep : cB;
        for (int t = 0; t < nt; t += 2) {
            if constexpr (Epi::MID) { if (t == nt / 2) E.mid(acc, cur, wr, wc, fr, fq); }
            const bool last = (t == nt - 2);
            const char* a1 = cA + (size_t)(t + 1) * kstep;
            const char* a2 = last ? nA : cA + (size_t)(t + 2) * kstep; const char* b2 = last ? nB : cB + (size_t)(t + 2) * kstep;
            const char* a3 = a2 + kstep; const char* b3 = b2 + kstep;
            if (last && has_next) S.a_ready(nxt);
            if constexpr (SP2) {
            PG8_LDB(B0, 0, 0); PG8_LDB(B1, 0, 1); PG8_SCHED; PG8_LDA(At, 0, 0); PG8_STAGE(PG8_SA(1, 1), a1 + hstep, voffA);
            PG8_WAIT_V(8); PG8_WAIT_L(0); PG8_BAR; PG8_MMA(0, 0, At, B0); PG8_MMA(0, 1, At, B1); PG8_BAR; PG8_SCHED;
            PG8_LDA(At, 0, 1); PG8_STAGE(PG8_SB(0, 0), b2, voffB); PG8_STAGE(PG8_SB(0, 1), b2 + hstep, voffB); PG8_STAGE(PG8_SA(0, 0), a2, voffA);
            PG8_WAIT_V(8); PG8_WAIT_L(0); PG8_BAR; PG8_MMA(1, 0, At, B0); PG8_MMA(1, 1, At, B1); PG8_BAR; PG8_SCHED;
            PG8_LDB(B0, 1, 0); PG8_LDB(B1, 1, 1); PG8_SCHED; PG8_LDA(At, 1, 0); PG8_STAGE(PG8_SA(0, 1), a2 + hstep, voffA);
            PG8_WAIT_V(8); PG8_WAIT_L(0); PG8_BAR; PG8_MMA(0, 0, At, B0); PG8_MMA(0, 1, At, B1); PG8_BAR; PG8_SCHED;
            PG8_LDA(At, 1, 1); PG8_STAGE(PG8_SB(1, 0), b3, voffB); PG8_STAGE(PG8_SB(1, 1), b3 + hstep, voffB); PG8_STAGE(PG8_SA(1, 0), a3, voffA);
            PG8_WAIT_V(8); PG8_WAIT_L(0); PG8_BAR; PG8_MMA(1, 0, At, B0); PG8_MMA(1, 1, At, B1); PG8_BAR; PG8_SCHED;
            } else {
            PG8_LDB(B0, 0, 0); PG8_SCHED; PG8_LDA(At, 0, 0); PG8_STAGE(PG8_SA(1, 1), a1 + hstep, voffA);
            PG8_WAIT_L(8); PG8_BAR; PG8_WAIT_L(0); PG8_MMA(0, 0, At, B0); PG8_BAR; PG8_SCHED;
            PG8_LDB(B1, 0, 1); PG8_STAGE(PG8_SB(0, 0), b2, voffB);
            PG8_BAR; PG8_WAIT_L(0); PG8_MMA(0, 1, At, B1); PG8_BAR;
            PG8_LDA(At, 0, 1); PG8_STAGE(PG8_SA(0, 0), a2, voffA);
            PG8_BAR; PG8_WAIT_L(0); PG8_MMA(1, 0, At, B0); PG8_BAR; PG8_SCHED;
            PG8_STAGE(PG8_SB(0, 1), b2 + hstep, voffB);
            PG8_WAIT_V(6); PG8_BAR; PG8_MMA(1, 1, At, B1); PG8_BAR;
            PG8_LDB(B0, 1, 0); PG8_SCHED; PG8_LDA(At, 1, 0); PG8_STAGE(PG8_SA(0, 1), a2 + hstep, voffA);
            PG8_WAIT_L(8); PG8_BAR; PG8_WAIT_L(0); PG8_MMA(0, 0, At, B0); PG8_BAR; PG8_SCHED;
            PG8_LDB(B1, 1, 1); PG8_STAGE(PG8_SB(1, 0), b3, voffB);
            PG8_BAR; PG8_WAIT_L(0); PG8_MMA(0, 1, At, B1); PG8_BAR;
            PG8_LDA(At, 1, 1); PG8_STAGE(PG8_SA(1, 0), a3, voffA);
            PG8_BAR; PG8_WAIT_L(0); PG8_MMA(1, 0, At, B0); PG8_BAR; PG8_SCHED;
            PG8_STAGE(PG8_SB(1, 1), b3 + hstep, voffB);
            PG8_WAIT_V(6); PG8_BAR; PG8_MMA(1, 1, At, B1); PG8_BAR;
            }
        }
        if constexpr (ALIGN_EPI) { if (wr == 0) PG8_BAR; }
        if constexpr (!Epi::AFTER_DRAIN) { E(acc, cur, wr, wc, fr, fq); S.done(cur); }
        if (!has_next) break;
#pragma unroll
        for (int a = 0; a < 2; ++a)
#pragma unroll
            for (int b = 0; b < 2; ++b)
#pragma unroll
                for (int m = 0; m < 4; ++m)
#pragma unroll
                    for (int n = 0; n < 2; ++n) acc[a][b][m][n] = (f32x4){0.f, 0.f, 0.f, 0.f};
        cur = nxt; cA = nA; cB = nB; ++ui;
        if constexpr (ALIGN_EPI) { if (wr == 1) PG8_BAR; }
    }
    PG8_WAIT_V(0);
    if constexpr (!ALIGN_EPI) { if (wr == 0) PG8_BAR; }
    PG8_BAR;
    if constexpr (Epi::AFTER_DRAIN) { E.fused(acc, cur, wr, wc, fr, fq, lds, wid, lane); S.done(cur); }
#undef PG8_SA
#undef PG8_SB
#undef PG8_STAGE
#undef PG8_LDA
#undef PG8_LDB
#undef PG8_MMA
#undef PG8_WAIT_V
#undef PG8_WAIT_L
#undef PG8_BAR
#undef PG8_SCHED
}
}


namespace {
constexpr int B_ = 8, S_ = 4096, M_ = B_ * S_, D_ = 1024, DIN = 4288, DFF = 4096;
constexpr int C_QA = 0, C_QB = 512, C_QI = 1024, C_KVB = 1280, C_KA = 2048, C_VA = 2112, C_KI = 2176, C_WI = 2208, C_GB = 2216, C_GATE = 2304;
constexpr int NC = 255;
constexpr float EPS = 1e-6f;
using pg8::PW;
#define GAS __attribute__((address_space(1)))
#define LAS __attribute__((address_space(3)))
typedef unsigned v4u __attribute__((ext_vector_type(4)));
typedef float f32x4 __attribute__((ext_vector_type(4)));

__device__ __forceinline__ int t5_bucket(int n) {
    if (n < 16) return n < 0 ? 0 : n;
    float nf = (float)n;
    int large = 16 + (int)(logf(nf / 16.f) / logf(8.f) * 16.f);
    return large < 31 ? large : 31;
}


__device__ __forceinline__ int win_src_col(int n) {
    if (n < 512) return n;
    if (n < 1024) return 936 + (n - 512);
    if (n < 1280) return 640 + (n - 1024);
    if (n < 2048) return 1448 + (n - 1280);
    if (n < 2112) return 512 + (n - 2048);
    if (n < 2176) return 576 + (n - 2112);
    if (n < 2208) return 896 + (n - 2176);
    if (n < 2216) return 928 + (n - 2208);
    if (n < 2240) return n;
    if (n < 2304) return -1;
    return 2240 + (n - 2304);
}
__device__ __forceinline__ float wave_sum(float v) {
#pragma unroll
    for (int o = 1; o < 64; o <<= 1) v += __shfl_xor(v, o);
    return v;
}
template <bool MAP>
__device__ __forceinline__ void transpose_item(const float* __restrict__ W, int K, int Nsrc, int Ndst, _Float16* __restrict__ WT, const float* __restrict__ gain, float* scr, int item, int lane, int dpitch = 0, int koff = 0) {
    const int nblk = Ndst / 32, kb = item / nblk, nb = item % nblk, k0 = 64 * kb, n0 = 32 * nb;
    const int c4 = lane & 7, nd = n0 + 4 * c4; const int ns = MAP ? win_src_col(nd) : nd;
#pragma unroll
    for (int i = 0; i < 8; ++i) { const int kk = 8 * i + (lane >> 3); f32x4 v = {0.f, 0.f, 0.f, 0.f};
        if (ns >= 0) { v = *(const f32x4*)(W + (size_t)(k0 + kk) * Nsrc + ns); if (gain) v = v * gain[k0 + kk]; }
        float* sp = scr + kk * 33 + 4 * c4; sp[0] = v.x; sp[1] = v.y; sp[2] = v.z; sp[3] = v.w; }
    __builtin_amdgcn_s_waitcnt(0xc07f); asm volatile("" ::: "memory");
    const int c = lane & 7;
#pragma unroll
    for (int j = 0; j < 4; ++j) { const int n = (lane >> 3) + 8 * j; const float* s = scr + (8 * c) * 33 + n;
        v4u o; o.x = pg8::pkh(s[0 * 33], s[1 * 33]); o.y = pg8::pkh(s[2 * 33], s[3 * 33]); o.z = pg8::pkh(s[4 * 33], s[5 * 33]); o.w = pg8::pkh(s[6 * 33], s[7 * 33]);
        *(v4u*)(WT + (size_t)(n0 + n) * (dpitch ? dpitch : K) + koff + k0 + 8 * c) = o; }
    __builtin_amdgcn_s_waitcnt(0xc07f); asm volatile("" ::: "memory");
}
__device__ __forceinline__ void rms_row_to_f16(const float* __restrict__ xrow, _Float16* __restrict__ orow, int lane) {
    const f32x4* xr = (const f32x4*)xrow + lane;
    f32x4 v[4]; float s = 0.f;
#pragma unroll
    for (int j = 0; j < 4; ++j) { v[j] = xr[64 * j]; s += (v[j].x * v[j].x + v[j].y * v[j].y) + (v[j].z * v[j].z + v[j].w * v[j].w); }
    const float rstd = rsqrtf(wave_sum(s) * (1.f / D_) + EPS);
    unsigned long long* o8 = (unsigned long long*)orow + lane;
#pragma unroll
    for (int j = 0; j < 4; ++j) o8[64 * j] = (unsigned long long)pg8::pkh(v[j].x * rstd, v[j].y * rstd) | ((unsigned long long)pg8::pkh(v[j].z * rstd, v[j].w * rstd) << 32);
}

struct Args {
    const float* x; const float* norm_mix; const float* w_in; const float* pe_k; const float* w1_k; const float* w2_k; const float* pe_v; const float* w1_v; const float* w2_v;
    const float* rel_bias; const float* w_ba; const float* w_bb; const float* w_out; const float* norm_mlp; const float* w_mi; const float* w_mo; const float* norm_final;
    float* out; unsigned char* ws;
};
constexpr size_t MiB = 1u << 20;
constexpr size_t WS_PCNT = 32768, WS_XBUF = 524288;
constexpr size_t WS_ROWSQ = 65536, WS_ROWSQ2 = 196608;
constexpr size_t WS_CTL = 0, WS_WIN = 1 * MiB, WS_WBA = 10 * MiB, WS_WBB = 11 * MiB, WS_WOUT = 12 * MiB, WS_WMI = 14 * MiB, WS_WMO = 22 * MiB, WS_CW = 30 * MiB,
                 WS_KCMP = 32 * MiB, WS_VCMP = 33 * MiB, WS_H = 34 * MiB, WS_PROJ = 98 * MiB, WS_MIX = 370 * MiB, WS_END = 434 * MiB;

__device__ __forceinline__ void prologue_body(const Args& a, unsigned char* lds) {
    const int tid = threadIdx.x, lane = tid & 63, wave = tid >> 6;
    float* scr = (float*)(lds + wave * 8704);
    const int gw = blockIdx.x * 8 + wave, NGW = gridDim.x * 8;
    constexpr int I_IN = (D_ / 64) * (PW / 32), I_BA = (512 / 64) * (D_ / 32), I_OUT = (D_ / 64) * (D_ / 32), I_MI = (D_ / 64) * (DFF / 32), I_MO = (DFF / 64) * (D_ / 32);
    constexpr int I_C1 = (2048 / 64) * (128 / 32), I_C2 = (128 / 64) * (64 / 32);
    constexpr int NITEMS = I_IN + 2 * I_BA + I_OUT + I_MI + I_MO + 2 * I_C1 + 2 * I_C2;
    for (int it = gw; it < NITEMS; it += NGW) {
        int r = it;
        if (r < I_IN) { transpose_item<true>(a.w_in, D_, DIN, PW, (_Float16*)(a.ws + WS_WIN), a.norm_mix, scr, r, lane); continue; } r -= I_IN;
        if (r < I_BA) { transpose_item<false>(a.w_ba, 512, D_, D_, (_Float16*)(a.ws + WS_WBA), nullptr, scr, r, lane, 1024, 0); continue; } r -= I_BA;
        if (r < I_BA) { transpose_item<false>(a.w_bb, 512, D_, D_, (_Float16*)(a.ws + WS_WBA), nullptr, scr, r, lane, 1024, 512); continue; } r -= I_BA;
        if (r < I_OUT) { transpose_item<false>(a.w_out, D_, D_, D_, (_Float16*)(a.ws + WS_WOUT), nullptr, scr, r, lane); continue; } r -= I_OUT;
        if (r < I_MI) { transpose_item<false>(a.w_mi, D_, DFF, DFF, (_Float16*)(a.ws + WS_WMI), a.norm_mlp, scr, r, lane); continue; } r -= I_MI;
        if (r < I_MO) { transpose_item<false>(a.w_mo, DFF, D_, D_, (_Float16*)(a.ws + WS_WMO), nullptr, scr, r, lane); continue; } r -= I_MO;
        if (r < I_C1) { transpose_item<false>(a.w1_k, 2048, 128, 128, (_Float16*)(a.ws + WS_CW), nullptr, scr, r, lane); continue; } r -= I_C1;
        if (r < I_C1) { transpose_item<false>(a.w1_v, 2048, 128, 128, (_Float16*)(a.ws + WS_CW + 512 * 1024), nullptr, scr, r, lane); continue; } r -= I_C1;
        if (r < I_C2) { transpose_item<false>(a.w2_k, 128, 64, 64, (_Float16*)(a.ws + WS_CW + 1024 * 1024), nullptr, scr, r, lane); continue; } r -= I_C2;
        transpose_item<false>(a.w2_v, 128, 64, 64, (_Float16*)(a.ws + WS_CW + 1024 * 1024 + 16384), nullptr, scr, r, lane);
    }
#pragma unroll 4
    for (int m = gw; m < M_; m += NGW) rms_row_to_f16(a.x + (size_t)m * D_, (_Float16*)(a.ws + WS_H) + (size_t)m * D_, lane);
}
struct EpiAccOut {
    static constexpr bool PERM = true, AFTER_DRAIN = false, MID = false;
    _Float16* x2h; const _Float16* xh; float* rowsq;
    __device__ __forceinline__ void operator()(const f32x4 (&acc)[2][2][4][2], const pg8::Unit& u, int wr, int wc, int fr, int fq) const {
        const int row0 = u.pm * 256 + wr * 64 + fr, col0 = u.pn * 256 + wc * 32 + 8 * fq;
#pragma unroll
        for (int ai = 0; ai < 2; ++ai)
#pragma unroll
            for (int m = 0; m < 4; ++m) { const size_t r = (size_t)(row0 + ai * 128 + m * 16); float sq = 0.f;
#pragma unroll
                for (int bj = 0; bj < 2; ++bj) { const size_t o = r * 1024 + col0 + bj * 128;
                    float p[8]; pg8::unpk8(*(const pg8::u32x4*)(xh + o), p);
                    const f32x4 a0 = acc[ai][bj][m][0], a1 = acc[ai][bj][m][1];
                    const float v[8] = {p[0] + a0[0], p[1] + a0[1], p[2] + a0[2], p[3] + a0[3], p[4] + a1[0], p[5] + a1[1], p[6] + a1[2], p[7] + a1[3]};
                    pg8::u32x4 w; w.x = pg8::pkh(v[0], v[1]); w.y = pg8::pkh(v[2], v[3]); w.z = pg8::pkh(v[4], v[5]); w.w = pg8::pkh(v[6], v[7]);
                    *(pg8::u32x4*)(x2h + o) = w;
                    sq += (v[0] * v[0] + v[1] * v[1]) + (v[2] * v[2] + v[3] * v[3]) + (v[4] * v[4] + v[5] * v[5]) + (v[6] * v[6] + v[7] * v[7]); }
                sq += __shfl_xor(sq, 16); sq += __shfl_xor(sq, 32);
                if (fq == 0) atomicAdd(rowsq + r, sq); }
    }
};
__device__ __forceinline__ void final_scale_row(const _Float16* __restrict__ xrow, float* __restrict__ orow, const float* __restrict__ g, float rsq, int lane) {
    const float rstd = rsqrtf(rsq * (1.f / D_) + EPS);
#pragma unroll
    for (int j = 0; j < 2; ++j) {
        float p[8]; pg8::unpk8(*((const pg8::u32x4*)xrow + lane + 64 * j), p);
        const f32x4 g0 = *((const f32x4*)g + 2 * (lane + 64 * j)), g1 = *((const f32x4*)g + 2 * (lane + 64 * j) + 1);
        *((f32x4*)orow + 2 * (lane + 64 * j)) = (f32x4){p[0] * rstd * g0.x, p[1] * rstd * g0.y, p[2] * rstd * g0.z, p[3] * rstd * g0.w};
        *((f32x4*)orow + 2 * (lane + 64 * j) + 1) = (f32x4){p[4] * rstd * g1.x, p[5] * rstd * g1.y, p[6] * rstd * g1.z, p[7] * rstd * g1.w};
    }
}

struct SliceOrder {
    pg8::StaticOrder S; int slice;
    __device__ bool next(int i, pg8::Unit& u) const { return i == 0 ? S.next(slice, u) : false; }
    __device__ __forceinline__ void a_ready(const pg8::Unit&) const {}
    __device__ __forceinline__ void done(const pg8::Unit&) const {}
};
struct EpiFinalNorm {
    static constexpr bool PERM = true, AFTER_DRAIN = true, MID = false;
    float* out; const _Float16* xh; const float* g; float* xbuf; unsigned* cnt;
    __device__ __forceinline__ void fused(f32x4 (&acc)[2][2][4][2], const pg8::Unit& u, int wr, int wc, int fr, int fq, PG8_LAS unsigned char* lds, int wid, int lane) const {
        const int rl0 = wr * 64 + fr, col0 = u.pn * 256 + wc * 32 + 8 * fq;
        PG8_LAS float* red = (PG8_LAS float*)lds;
#pragma unroll
        for (int ai = 0; ai < 2; ++ai) {
            pg8::u32x4 xw[4][2];
#pragma unroll
            for (int m = 0; m < 4; ++m)
#pragma unroll
                for (int bj = 0; bj < 2; ++bj) xw[m][bj] = *(const pg8::u32x4*)(xh + (size_t)(u.pm * 256 + rl0 + ai * 128 + m * 16) * 1024 + col0 + bj * 128);
#pragma unroll
            for (int m = 0; m < 4; ++m) { const int rl = rl0 + ai * 128 + m * 16; float sq = 0.f;
#pragma unroll
                for (int bj = 0; bj < 2; ++bj) { float p[8]; pg8::unpk8(xw[m][bj], p);
#pragma unroll
                    for (int i = 0; i < 4; ++i) { acc[ai][bj][m][0][i] += p[i]; acc[ai][bj][m][1][i] += p[4 + i];
                        sq = fmaf(acc[ai][bj][m][0][i], acc[ai][bj][m][0][i], sq); sq = fmaf(acc[ai][bj][m][1][i], acc[ai][bj][m][1][i], sq); } }
                sq += __shfl_xor(sq, 16); sq += __shfl_xor(sq, 32);
                if (fq == 0) red[wc * 256 + rl] = sq; }
        }
        __syncthreads();
        const int tid = wid * 64 + lane;
        if (tid < 256) { const float tot = (red[tid] + red[256 + tid]) + (red[512 + tid] + red[768 + tid]);
            __hip_atomic_store(xbuf + ((size_t)u.pm * 4 + u.pn) * 256 + tid, tot, __ATOMIC_RELAXED, __HIP_MEMORY_SCOPE_AGENT); }
        asm volatile("s_waitcnt vmcnt(0)" ::: "memory");
        __syncthreads();
        if (tid == 0) { __hip_atomic_fetch_add(cnt + u.pm, 1u, __ATOMIC_RELAXED, __HIP_MEMORY_SCOPE_AGENT);
            unsigned sp = 0; while (__hip_atomic_load(cnt + u.pm, __ATOMIC_RELAXED, __HIP_MEMORY_SCOPE_AGENT) < 4u && ++sp < (1u << 22)) __builtin_amdgcn_s_sleep(1); }
        __syncthreads();
        if (tid < 256) { float tot = 0.f;
#pragma unroll
            for (int q = 0; q < 4; ++q) tot += __hip_atomic_load(xbuf + ((size_t)u.pm * 4 + q) * 256 + tid, __ATOMIC_RELAXED, __HIP_MEMORY_SCOPE_AGENT);
            red[1024 + tid] = rsqrtf(tot * (1.f / 1024.f) + 1e-6f); }
        __syncthreads();
#pragma unroll
        for (int ai = 0; ai < 2; ++ai)
#pragma unroll
            for (int m = 0; m < 4; ++m) { const int rl = rl0 + ai * 128 + m * 16; const size_t r = (size_t)(u.pm * 256 + rl); const float rstd = red[1024 + rl];
#pragma unroll
                for (int bj = 0; bj < 2; ++bj) { const int c = col0 + bj * 128; const f32x4 g0 = *(const f32x4*)(g + c), g1 = *(const f32x4*)(g + c + 4);
                    *(f32x4*)(out + r * 1024 + c) = acc[ai][bj][m][0] * rstd * g0; *(f32x4*)(out + r * 1024 + c + 4) = acc[ai][bj][m][1] * rstd * g1; } }
        __syncthreads();
    }
};

namespace dsa {
typedef _Float16 f16x8 __attribute__((ext_vector_type(8)));
typedef _Float16 f16x4 __attribute__((ext_vector_type(4)));
typedef short s16x4 __attribute__((ext_vector_type(4)));
typedef float f32x4 __attribute__((ext_vector_type(4)));
typedef unsigned u32x4 __attribute__((ext_vector_type(4)));
typedef unsigned u32x2 __attribute__((ext_vector_type(2)));
constexpr int TQ = 16, NBIN = 2048, CANDCAP = 512, VPITCH = 144;
constexpr int L_HIST = 0, L_SEL = 65536, L_SELD = L_SEL + 8192, L_CTL = L_SELD + 8192, L_BIAS = L_CTL + 512, L_VST = L_BIAS + 4096, L_END = L_VST + 8 * 32 * VPITCH;
static_assert(L_END <= 131072, "dsa LDS");

__device__ __forceinline__ float idx_score(const f32x4 a1, const f32x4 a2, float lin, const float (&wh)[8]) {
    float s = fmaf(wh[0], fabsf(a1.x), lin);
    s = fmaf(wh[1], fabsf(a1.y), s); s = fmaf(wh[2], fabsf(a1.z), s); s = fmaf(wh[3], fabsf(a1.w), s);
    s = fmaf(wh[4], fabsf(a2.x), s); s = fmaf(wh[5], fabsf(a2.y), s); s = fmaf(wh[6], fabsf(a2.z), s); s = fmaf(wh[7], fabsf(a2.w), s);
    return s;
}
__device__ __forceinline__ int score_bin(float sc, float inv) { int b = (int)(fmaf(sc, inv, 1024.f)); b = b < 0 ? 0 : b; return b > NBIN - 1 ? NBIN - 1 : b; }

template <int PASS>
__device__ __forceinline__ void score_pass(LAS unsigned char* lds, const _Float16* __restrict__ proj, int b, int t0, int nkb, int wave, int lane,
                                           const f16x8 (&afr)[4][2], const f16x8 alin, const float (&wq)[4][8], const float (&binv)[4]) {
    LAS unsigned* hist = (LAS unsigned*)(lds + L_HIST);
    LAS unsigned short* sel = (LAS unsigned short*)(lds + L_SEL);
    LAS unsigned short* seld = (LAS unsigned short*)(lds + L_SELD);
    LAS u32x2* cand = (LAS u32x2*)(lds + L_HIST);
    LAS int* ctl = (LAS int*)(lds + L_CTL);
    const int kc = lane >> 4, n16 = lane & 15;
    int bst[4];
#pragma unroll
    for (int grp = 0; grp < 4; ++grp) bst[grp] = (PASS == 2) ? ctl[(4 * grp + kc) * 8 + 2] : 0;
    const f32x4 zero = {0.f, 0.f, 0.f, 0.f};
    const _Float16* kbase = proj + (size_t)(b * S_ + n16) * PW + C_KI + 8 * kc;
    f16x8 bnext = *(const f16x8*)(kbase + (size_t)(16 * (wave < nkb ? wave : 0)) * PW);
    for (int kb = wave; kb < nkb; kb += 8) {
        const f16x8 bfr = bnext;
        { const int kn = kb + 8 < nkb ? kb + 8 : kb; bnext = *(const f16x8*)(kbase + (size_t)(16 * kn) * PW); }
        const int s = 16 * kb + n16;
        const bool lastkb = kb == nkb - 1;
        const f32x4 a3 = __builtin_amdgcn_mfma_f32_16x16x32_f16(alin, bfr, zero, 0, 0, 0);
        const float lin4[4] = {a3.x, a3.y, a3.z, a3.w};
#pragma unroll
        for (int grp = 0; grp < 4; ++grp) {
            const f32x4 a1 = __builtin_amdgcn_mfma_f32_16x16x32_f16(afr[grp][0], bfr, zero, 0, 0, 0);
            const f32x4 a2 = __builtin_amdgcn_mfma_f32_16x16x32_f16(afr[grp][1], bfr, zero, 0, 0, 0);
            const float sc = idx_score(a1, a2, lin4[grp], wq[grp]);
            const int row = 4 * grp + kc, t = t0 + row;
            if (!lastkb || s <= t) {
                const int bin = score_bin(sc, binv[grp]);
                if (PASS == 1) { __hip_atomic_fetch_add(hist + row * 1024 + (bin >> 1), (bin & 1) ? 0x10000u : 1u, __ATOMIC_RELAXED, __HIP_MEMORY_SCOPE_WORKGROUP); }
                else {
                    if (bin > bst[grp]) { const int pos = __hip_atomic_fetch_add(ctl + row * 8 + 0, 1, __ATOMIC_RELAXED, __HIP_MEMORY_SCOPE_WORKGROUP); sel[row * 256 + (pos & 255)] = (unsigned short)s;
                        const int dd = t - s; seld[row * 256 + (pos & 255)] = (unsigned short)((dd > 127 ? 127 : dd) * 32); }
                    else if (bin == bst[grp]) { const int pos = __hip_atomic_fetch_add(ctl + row * 8 + 1, 1, __ATOMIC_RELAXED, __HIP_MEMORY_SCOPE_WORKGROUP);
                        if (pos < CANDCAP) { u32x2 e; e.x = __float_as_uint(sc); e.y = (unsigned)s; cand[row * CANDCAP + pos] = e; } }
                }
            }
        }
    }
}

__device__ __forceinline__ void dsa_tile(LAS unsigned char* lds, const _Float16* __restrict__ proj, _Float16* __restrict__ o_a, int b, int qt) {
    int tid_ = threadIdx.x; asm volatile("" : "+v"(tid_));
    const int tid = tid_, lane = tid & 63, wave = __builtin_amdgcn_readfirstlane(tid >> 6);
    const int kc = lane >> 4, n16 = lane & 15;
    const int t0 = qt * TQ, nkb = qt + 1;
    LAS unsigned* hist = (LAS unsigned*)(lds + L_HIST);
    LAS unsigned short* sel = (LAS unsigned short*)(lds + L_SEL);
    LAS u32x2* cand = (LAS u32x2*)(lds + L_HIST);
    LAS int* ctl = (LAS int*)(lds + L_CTL);
    LAS float* biaslut = (LAS float*)(lds + L_BIAS);
    for (int i = tid; i < (TQ * 1024 + 4096) / 4; i += 512) ((LAS u32x4*)hist)[i] = (u32x4){0u, 0u, 0u, 0u};
    if (tid < TQ * 8) ctl[tid] = 0;
    f16x8 afr[4][2]; f16x8 alin; float wq[4][8]; float binv[4];
    { const int g = n16 >> 2, r = n16 & 3;
      { const int qq = 4 * r + g; const _Float16* qrow = proj + (size_t)(b * S_ + t0 + qq) * PW;
        const f16x8 wg = *(const f16x8*)(qrow + C_WI);
        float lin[8];
#pragma unroll
        for (int e = 0; e < 8; ++e) lin[e] = 0.f;
#pragma unroll
        for (int h = 0; h < 8; ++h) { const f16x8 qh = *(const f16x8*)(qrow + C_QI + h * 32 + 8 * kc); const float wh = (float)wg[h] * (0.5f / 16.f);
#pragma unroll
            for (int e = 0; e < 8; ++e) lin[e] = fmaf(wh, (float)qh[e], lin[e]); }
#pragma unroll
        for (int e = 0; e < 8; ++e) alin[e] = (_Float16)lin[e]; }
#pragma unroll
      for (int grp = 0; grp < 4; ++grp) {
          const _Float16* qrow = proj + (size_t)(b * S_ + t0 + 4 * grp + g) * PW + C_QI;
          afr[grp][0] = *(const f16x8*)(qrow + r * 32 + 8 * kc);
          afr[grp][1] = *(const f16x8*)(qrow + (4 + r) * 32 + 8 * kc);
          const f16x8 wv = *(const f16x8*)(proj + (size_t)(b * S_ + t0 + 4 * grp + kc) * PW + C_WI);
          float ss = 0.f;
#pragma unroll
          for (int h = 0; h < 8; ++h) { const float wfull = (float)wv[h] * (1.f / 16.f); wq[grp][h] = 0.5f * wfull; ss = fmaf(wfull, wfull, ss); }
          binv[grp] = 32.f * rsqrtf(ss + 1e-12f);
      } }
    __syncthreads();
    score_pass<1>(lds, proj, b, t0, nkb, wave, lane, afr, alin, wq, binv);
    __syncthreads();
#pragma unroll 1
    for (int i = 0; i < 2; ++i) {
        const int row = 2 * wave + i, n = t0 + row + 1;
        if (n <= 256) { if (lane == 0) { ctl[row * 8 + 2] = -1; ctl[row * 8 + 3] = 0; } }
        else {
            const LAS u32x4* hp = (const LAS u32x4*)(hist + row * 1024 + 16 * lane);
            unsigned tot = 0;
#pragma unroll
            for (int q4 = 0; q4 < 4; ++q4) { const u32x4 hv = hp[q4];
                tot += (hv.x & 0xffffu) + (hv.x >> 16) + (hv.y & 0xffffu) + (hv.y >> 16) + (hv.z & 0xffffu) + (hv.z >> 16) + (hv.w & 0xffffu) + (hv.w >> 16); }
            unsigned suf = tot;
#pragma unroll
            for (int o = 1; o < 64; o <<= 1) { const unsigned v = __shfl_down(suf, o); if (lane + o < 64) suf += v; }
            const unsigned above_lane = suf - tot;
            const unsigned long long cross = __ballot(above_lane < 256u && suf >= 256u);
            const int lx = __builtin_ctzll(cross);
            const unsigned abovex = __shfl(above_lane, lx);
            const unsigned c2 = lane < 32 ? (unsigned)((const LAS unsigned short*)hist)[row * 2048 + 32 * lx + lane] : 0u;
            unsigned suf2 = c2;
#pragma unroll
            for (int o = 1; o < 32; o <<= 1) { const unsigned v = __shfl_down(suf2, o); if (lane + o < 32) suf2 += v; }
            const unsigned above2 = abovex + suf2 - c2;
            if (lane < 32 && above2 < 256u && above2 + c2 >= 256u) {
                const int bs = 32 * lx + lane; const unsigned cum = above2;
                ctl[row * 8 + 2] = bs; ctl[row * 8 + 3] = 256 - (int)cum;
            }
        }
    }
    __syncthreads();
    score_pass<2>(lds, proj, b, t0, nkb, wave, lane, afr, alin, wq, binv);
    __syncthreads();
#pragma unroll 1
    for (int i = 0; i < 2; ++i) {
        const int row = 2 * wave + i, n = t0 + row + 1;
        const int need = ctl[row * 8 + 3], base = ctl[row * 8 + 0];
        int nc = ctl[row * 8 + 1];
        nc = nc < CANDCAP ? nc : CANDCAP;
        if (lane == 0) { const int nf = base + (need < nc ? need : nc); ctl[row * 8 + 4] = n <= 256 ? n : (nf < 256 ? nf : 256); }
        if (need > 0) {
            for (int c0 = 0; c0 < nc; c0 += 64) {
                const int ci = c0 + lane; const bool act = ci < nc;
                const u32x2 me = cand[row * CANDCAP + (act ? ci : 0)];
                const float msc = __uint_as_float(me.x); int rank = 0;
                for (int j = 0; j < nc; ++j) { const u32x2 ot = cand[row * CANDCAP + j]; const float osc = __uint_as_float(ot.x);
                    rank += (osc > msc || (osc == msc && ot.y < me.y)) ? 1 : 0; }
                if (act && rank < need) { sel[row * 256 + ((base + rank) & 255)] = (unsigned short)me.y; const int dd = t0 + row - (int)me.y; ((LAS unsigned short*)(lds + L_SELD))[row * 256 + ((base + rank) & 255)] = (unsigned short)((dd > 127 ? 127 : dd) * 32); }
            }
        }
    }
    __syncthreads();
    int tq_ = threadIdx.x; asm volatile("" : "+v"(tq_));
    const int lane_a = tq_ & 63;
    LAS unsigned char* vst = lds + L_VST + wave * (32 * VPITCH);
#pragma unroll 1
    for (int i = 0; i < 2; ++i) { const int lane = lane_a, kc = lane >> 4, n16 = lane & 15;
        const int row = 2 * wave + i, t = t0 + row; const int nvalid = ctl[row * 8 + 4];
        const _Float16* qrow = proj + (size_t)(b * S_ + t) * PW + C_QA;
        const int head = n16, hm = head & 7;
        f16x8 qb0, qb1;
        { const f16x8 z = {0, 0, 0, 0, 0, 0, 0, 0}; qb0 = z; qb1 = z;
          if (head < 8) { qb0 = *(const f16x8*)(qrow + head * 64 + 8 * kc); qb1 = *(const f16x8*)(qrow + head * 64 + 32 + 8 * kc); } }
        f32x4 ot[4];
#pragma unroll
        for (int dt = 0; dt < 4; ++dt) ot[dt] = (f32x4){0.f, 0.f, 0.f, 0.f};
        float mrun = -INFINITY, lrun = 0.f;
        const LAS unsigned short* selr = sel + row * 256;
        const LAS unsigned short* seldr = (const LAS unsigned short*)(lds + L_SELD) + row * 256;
        const LAS unsigned char* biasb = lds + L_BIAS + hm * 4;
        const _Float16* pbat = proj + (size_t)(b * S_) * PW;
        LAS unsigned char* kst = lds + L_HIST + wave * (32 * VPITCH);
        u32x4 gk[4], gv[4];
        const char* pbyte = (const char*)pbat;
#define DSA_GATHER(jj) do { _Pragma("unroll") for (int i_ = 0; i_ < 4; ++i_) { const int pos_ = 32 * (jj) + 8 * i_ + (lane >> 3); \
            const unsigned idx_ = pos_ < nvalid ? (unsigned)selr[pos_] : 0u; const char* rp_ = pbyte + (size_t)(idx_ * (unsigned)(PW * 2) + (unsigned)(C_KA * 2 + 16 * (lane & 7))); \
            gk[i_] = *(const u32x4*)rp_; gv[i_] = *(const u32x4*)(rp_ + 128); } } while (0)
        DSA_GATHER(0);
        const int nsteps = (nvalid + 31) >> 5;
#pragma unroll 1
        for (int j = 0; j < nsteps; ++j) {
#pragma unroll
            for (int i_ = 0; i_ < 4; ++i_) { const int ro = (8 * i_ + (lane >> 3)) * VPITCH + 16 * (lane & 7);
                *(LAS u32x4*)(kst + ro) = gk[i_]; *(LAS u32x4*)(vst + ro) = gv[i_]; }
            if (j + 1 < nsteps) DSA_GATHER(j + 1);
            asm volatile("s_waitcnt lgkmcnt(0)" ::: "memory");
            const f16x8 ca0 = *(const LAS f16x8*)(kst + n16 * VPITCH + 16 * kc), ca1 = *(const LAS f16x8*)(kst + n16 * VPITCH + 64 + 16 * kc);
            const f16x8 cb0 = *(const LAS f16x8*)(kst + (16 + n16) * VPITCH + 16 * kc), cb1 = *(const LAS f16x8*)(kst + (16 + n16) * VPITCH + 64 + 16 * kc);
            f32x4 sa = {0.f, 0.f, 0.f, 0.f}, sb = {0.f, 0.f, 0.f, 0.f};
            sa = __builtin_amdgcn_mfma_f32_16x16x32_f16(ca0, qb0, sa, 0, 0, 0); sa = __builtin_amdgcn_mfma_f32_16x16x32_f16(ca1, qb1, sa, 0, 0, 0);
            sb = __builtin_amdgcn_mfma_f32_16x16x32_f16(cb0, qb0, sb, 0, 0, 0); sb = __builtin_amdgcn_mfma_f32_16x16x32_f16(cb1, qb1, sb, 0, 0, 0);
            const int p0 = 32 * j + 4 * kc;
            const u32x2 iwa = *(const LAS u32x2*)(seldr + p0), iwb = *(const LAS u32x2*)(seldr + p0 + 16);
            const unsigned wa0 = iwa.x, wa1 = iwa.y, wb0 = iwb.x, wb1 = iwb.y;
            const unsigned bo[8] = {wa0 & 0xffffu, wa0 >> 16, wa1 & 0xffffu, wa1 >> 16, wb0 & 0xffffu, wb0 >> 16, wb1 & 0xffffu, wb1 >> 16};
            float v[8] = {sa.x, sa.y, sa.z, sa.w, sb.x, sb.y, sb.z, sb.w};
            float tm = -INFINITY;
            if (nvalid == 256) {
#pragma unroll
                for (int e = 0; e < 8; ++e) { v[e] = fmaf(v[e], 0.125f, *(const LAS float*)(biasb + bo[e])); tm = fmaxf(tm, v[e]); }
            } else {
#pragma unroll
                for (int e = 0; e < 8; ++e) {
                    const bool ok = (p0 + (e & 3) + 16 * (e >> 2)) < nvalid;
                    const float lg = v[e] * 0.125f + *(const LAS float*)(biasb + bo[e]);
                    v[e] = ok ? lg : -INFINITY; tm = fmaxf(tm, v[e]);
                }
            }
            tm = fmaxf(tm, __shfl_xor(tm, 16)); tm = fmaxf(tm, __shfl_xor(tm, 32));
            const float mn = fmaxf(mrun, tm);
            const float alpha = __expf(mrun - mn);
            float ps = 0.f;
#pragma unroll
            for (int e = 0; e < 8; ++e) { v[e] = __expf(v[e] - mn); ps += v[e]; }
            lrun = lrun * alpha + ps; mrun = mn;
#pragma unroll
            for (int dt = 0; dt < 4; ++dt) ot[dt] = ot[dt] * alpha;
            const f16x8 pfr = {(_Float16)v[0], (_Float16)v[1], (_Float16)v[2], (_Float16)v[3], (_Float16)v[4], (_Float16)v[5], (_Float16)v[6], (_Float16)v[7]};
            asm volatile("s_waitcnt lgkmcnt(0)" ::: "memory");
            const int q = n16 >> 2, p = n16 & 3;
#pragma unroll
            for (int dt = 0; dt < 4; ++dt) {
                const s16x4 ta = __builtin_amdgcn_ds_read_tr16_b64_v4i16((LAS s16x4*)(vst + (4 * kc + q) * VPITCH + (16 * dt + 4 * p) * 2));
                const s16x4 tb = __builtin_amdgcn_ds_read_tr16_b64_v4i16((LAS s16x4*)(vst + (16 + 4 * kc + q) * VPITCH + (16 * dt + 4 * p) * 2));
                const f16x4 fa = __builtin_bit_cast(f16x4, ta), fb = __builtin_bit_cast(f16x4, tb);
                const f16x8 vfr = {fa.x, fa.y, fa.z, fa.w, fb.x, fb.y, fb.z, fb.w};
                ot[dt] = __builtin_amdgcn_mfma_f32_16x16x32_f16(vfr, pfr, ot[dt], 0, 0, 0);
            }
            asm volatile("s_waitcnt lgkmcnt(0)" ::: "memory");
        }
#undef DSA_GATHER
        lrun += __shfl_xor(lrun, 16); lrun += __shfl_xor(lrun, 32);
        const float inv = 1.f / fmaxf(lrun, 1e-30f);
        if (head < 8) {
            _Float16* orow = o_a + (size_t)(b * S_ + t) * 1024 + head * 64 + 4 * kc;
#pragma unroll
            for (int dt = 0; dt < 4; ++dt) { u32x2 w; w.x = pg8::pkh(ot[dt].x * inv, ot[dt].y * inv); w.y = pg8::pkh(ot[dt].z * inv, ot[dt].w * inv); *(u32x2*)(orow + 16 * dt) = w; }
        }
    }
    __syncthreads();
}
}


namespace nsa {
typedef _Float16 f16x8 __attribute__((ext_vector_type(8)));
typedef _Float16 f16x4 __attribute__((ext_vector_type(4)));
typedef short s16x4 __attribute__((ext_vector_type(4)));
typedef float f32x4 __attribute__((ext_vector_type(4)));
typedef float f32x16 __attribute__((ext_vector_type(16)));
typedef unsigned u32x4 __attribute__((ext_vector_type(4)));
typedef unsigned u32x2 __attribute__((ext_vector_type(2)));
constexpr int KP = 144, VP = 192;
constexpr int TILE_B = 64 * KP + 64 * VP;
constexpr int L_T0 = 0, L_BIAS = 2 * TILE_B, L_IMPA = L_BIAS + 4096, L_IMPC = L_IMPA + 16384, L_MASK = L_IMPC + 16384, L_END = L_MASK + 512;
static_assert(L_END <= 131072, "nsa LDS");
constexpr float LOG2E = 1.4426950408889634f;
constexpr float SC = 0.125f * LOG2E;
__device__ __forceinline__ float max3f(float a, float b, float c) { float r; asm("v_max3_f32 %0, %1, %2, %3" : "=v"(r) : "v"(a), "v"(b), "v"(c)); return r; }

struct Src { const _Float16* k; const _Float16* v; int pitch; };

struct Stage { u32x4 kr, vr; };
__device__ __forceinline__ void stage_load(Stage& st, const Src& s, int row0, int tid, bool need_v) {
    const int r = tid >> 3, c = tid & 7;
    st.kr = *(const u32x4*)(s.k + (size_t)(row0 + r) * s.pitch + 8 * c);
    if (need_v) st.vr = *(const u32x4*)(s.v + (size_t)(row0 + r) * s.pitch + 8 * c);
}
__device__ __forceinline__ void stage_store(const Stage& st, LAS unsigned char* tb, int tid, bool need_v) {
    const int r = tid >> 3, c = tid & 7;
    *(LAS u32x4*)(tb + r * KP + 16 * c) = st.kr;
    if (need_v) *(LAS u32x4*)(tb + 64 * KP + r * VP + 16 * c) = st.vr;
}

struct RowState { float m, l; f32x16 o0, o1; };

__device__ __forceinline__ void qk_half(const LAS unsigned char* kt, const f16x8 (&qf)[4], int rho, int hi, int kh, f32x16& s0) {
#pragma unroll
    for (int i = 0; i < 16; ++i) s0[i] = 0.f;
    const LAS unsigned char* kb = kt + (32 * kh + rho) * KP + 16 * hi;
#pragma unroll
    for (int ks = 0; ks < 4; ++ks) {
        const f16x8 a0 = *(const LAS f16x8*)(kb + 32 * ks);
        s0 = __builtin_amdgcn_mfma_f32_32x32x16_f16(a0, qf[ks], s0, 0, 0, 0);
    }
}
__device__ __forceinline__ void logits(f32x16& s0, const LAS float* lut, int hb, int hi, int dbase, int dstep, int dlim, bool bit) {
#pragma unroll
    for (int rg = 0; rg < 16; ++rg) {
        const int kl = (rg & 3) + 8 * (rg >> 2) + 4 * hi;
        const int d = dbase - dstep * kl;
        int dc = d < 0 ? 0 : d; dc = dc > 127 ? 127 : dc;
        const float bias = lut[dc * 8 + hb];
        const bool ok = bit && d >= 0 && d < dlim;
        s0[rg] = ok ? fmaf(s0[rg], SC, bias) : -INFINITY;
    }
}
__device__ __forceinline__ void pv_half(RowState& rs, const f32x16& s0, const LAS unsigned char* vt, int rho, int hi, int kh) {
    const int l16 = rho & 15, g16 = rho >> 4, q = l16 >> 2, p = l16 & 3;
    const LAS unsigned char* vb = vt + (32 * kh + 4 * hi + q) * VP + (16 * g16 + 4 * p) * 2;
#pragma unroll
    for (int sx = 0; sx < 2; ++sx) {
        f16x8 pfr;
#pragma unroll
        for (int j = 0; j < 8; ++j) pfr[j] = (_Float16)s0[8 * sx + j];
#pragma unroll
        for (int dt = 0; dt < 2; ++dt) {
            const s16x4 ta = __builtin_amdgcn_ds_read_tr16_b64_v4i16((LAS s16x4*)(vb + (16 * sx) * VP + 64 * dt));
            const s16x4 tb = __builtin_amdgcn_ds_read_tr16_b64_v4i16((LAS s16x4*)(vb + (16 * sx + 8) * VP + 64 * dt));
            const f16x4 fa = __builtin_bit_cast(f16x4, ta), fb = __builtin_bit_cast(f16x4, tb);
            const f16x8 vfr = {fa.x, fa.y, fa.z, fa.w, fb.x, fb.y, fb.z, fb.w};
            if (dt == 0) rs.o0 = __builtin_amdgcn_mfma_f32_32x32x16_f16(vfr, pfr, rs.o0, 0, 0, 0);
            else rs.o1 = __builtin_amdgcn_mfma_f32_32x32x16_f16(vfr, pfr, rs.o1, 0, 0, 0);
        }
    }
}
__device__ __forceinline__ void rescale_if_needed(RowState& rs, float tmx) {
    if (__any(tmx > rs.m + 8.f)) {
        const float mn = fmaxf(rs.m, tmx);
        const float mu = (mn == -INFINITY) ? 0.f : mn;
        const float alpha = __builtin_amdgcn_exp2f(rs.m - mu);
        rs.l *= alpha; rs.m = mn;
#pragma unroll
        for (int i = 0; i < 16; ++i) { rs.o0[i] *= alpha; rs.o1[i] *= alpha; }
    }
}
__device__ __forceinline__ void tile_fast(RowState& rs, const LAS unsigned char* kt, const LAS unsigned char* vt, const f16x8 (&qf)[4], float c, int rho, int hi) {
    const LAS unsigned char* kb = kt + rho * KP + 16 * hi;
    f16x8 ka[4], kb2[4];
#pragma unroll
    for (int ks = 0; ks < 4; ++ks) { ka[ks] = *(const LAS f16x8*)(kb + 32 * ks); kb2[ks] = *(const LAS f16x8*)(kb + 32 * KP + 32 * ks); }
    const int l16 = rho & 15, g16 = rho >> 4, q = l16 >> 2, p = l16 & 3;
    const LAS unsigned char* vb = vt + (4 * hi + q) * VP + (16 * g16 + 4 * p) * 2;
    s16x4 va[4][2], vc[4][2];
    __builtin_amdgcn_sched_barrier(0);
    f32x16 s0, s1;
#pragma unroll
    for (int i = 0; i < 16; ++i) { s0[i] = 0.f; s1[i] = 0.f; }
#pragma unroll
    for (int ks = 0; ks < 4; ++ks) {
        s0 = __builtin_amdgcn_mfma_f32_32x32x16_f16(ka[ks], qf[ks], s0, 0, 0, 0);
        s1 = __builtin_amdgcn_mfma_f32_32x32x16_f16(kb2[ks], qf[ks], s1, 0, 0, 0);
    }
    __builtin_amdgcn_sched_barrier(0);
#pragma unroll
    for (int st = 0; st < 4; ++st)
#pragma unroll
        for (int dt = 0; dt < 2; ++dt) {
            va[st][dt] = __builtin_amdgcn_ds_read_tr16_b64_v4i16((LAS s16x4*)(vb + (16 * st) * VP + 64 * dt));
            vc[st][dt] = __builtin_amdgcn_ds_read_tr16_b64_v4i16((LAS s16x4*)(vb + (16 * st + 8) * VP + 64 * dt));
        }
    __builtin_amdgcn_sched_barrier(0);
    float tm = max3f(s0[0], s1[0], -INFINITY);
#pragma unroll
    for (int i = 1; i < 16; ++i) tm = max3f(tm, s0[i], s1[i]);
    { const auto r2 = __builtin_amdgcn_permlane32_swap(__float_as_uint(tm), __float_as_uint(tm), false, false); tm = fmaxf(__uint_as_float(r2[0]), __uint_as_float(r2[1])); }
    rescale_if_needed(rs, fmaf(tm, SC, c));
    const float mu = (rs.m == -INFINITY) ? 0.f : rs.m;
    const float cm = c - mu;
    float ps = 0.f;
#pragma unroll
    for (int i = 0; i < 16; ++i) { s0[i] = __builtin_amdgcn_exp2f(fmaf(s0[i], SC, cm)); s1[i] = __builtin_amdgcn_exp2f(fmaf(s1[i], SC, cm)); ps += s0[i] + s1[i]; }
    rs.l += ps;
#pragma unroll
    for (int st = 0; st < 4; ++st) {
        f16x8 pfr;
#pragma unroll
        for (int j = 0; j < 8; ++j) pfr[j] = (_Float16)((st & 2) ? s1[8 * (st & 1) + j] : s0[8 * (st & 1) + j]);
#pragma unroll
        for (int dt = 0; dt < 2; ++dt) {
            const f16x4 fa = __builtin_bit_cast(f16x4, va[st][dt]), fb = __builtin_bit_cast(f16x4, vc[st][dt]);
            const f16x8 vfr = {fa.x, fa.y, fa.z, fa.w, fb.x, fb.y, fb.z, fb.w};
            if (dt == 0) rs.o0 = __builtin_amdgcn_mfma_f32_32x32x16_f16(vfr, pfr, rs.o0, 0, 0, 0);
            else rs.o1 = __builtin_amdgcn_mfma_f32_32x32x16_f16(vfr, pfr, rs.o1, 0, 0, 0);
        }
    }
}
template <bool IMP>
__device__ __forceinline__ void tile_general(RowState& rs, const LAS unsigned char* kt, const LAS unsigned char* vt, const f16x8 (&qf)[4], const LAS float* lut, int hb, int rho, int hi,
                                             int dbase, int dstep, unsigned dlim, float mc, float invl, LAS float* impA, LAS float* impC, int n, bool wr) {
    const LAS unsigned char* kb = kt + rho * KP + 16 * hi;
    f16x8 ka[4], kb2[4];
#pragma unroll
    for (int ks = 0; ks < 4; ++ks) { ka[ks] = *(const LAS f16x8*)(kb + 32 * ks); kb2[ks] = *(const LAS f16x8*)(kb + 32 * KP + 32 * ks); }
    const int d0 = dbase - dstep * 4 * hi;
    __builtin_amdgcn_sched_barrier(0);
    f32x16 s0, s1;
#pragma unroll
    for (int i = 0; i < 16; ++i) { s0[i] = 0.f; s1[i] = 0.f; }
#pragma unroll
    for (int ks = 0; ks < 4; ++ks) {
        s0 = __builtin_amdgcn_mfma_f32_32x32x16_f16(ka[ks], qf[ks], s0, 0, 0, 0);
        s1 = __builtin_amdgcn_mfma_f32_32x32x16_f16(kb2[ks], qf[ks], s1, 0, 0, 0);
    }
    __builtin_amdgcn_sched_barrier(0);
    float b0[16], b1[16];
#pragma unroll
    for (int rg = 0; rg < 16; ++rg) {
        const int kl = (rg & 3) + 8 * (rg >> 2);
        int da = d0 - dstep * kl, db = d0 - dstep * (kl + 32);
        da = da < 0 ? 0 : da; da = da > 127 ? 127 : da; db = db < 0 ? 0 : db; db = db > 127 ? 127 : db;
        b0[rg] = lut[da * 8 + hb]; b1[rg] = lut[db * 8 + hb];
    }
    float tm = -INFINITY;
#pragma unroll
    for (int rg = 0; rg < 16; ++rg) {
        const int kl = (rg & 3) + 8 * (rg >> 2);
        const unsigned da = (unsigned)(d0 - dstep * kl), db = (unsigned)(d0 - dstep * (kl + 32));
        s0[rg] = da < dlim ? fmaf(s0[rg], SC, b0[rg]) : -INFINITY;
        s1[rg] = db < dlim ? fmaf(s1[rg], SC, b1[rg]) : -INFINITY;
        tm = max3f(tm, s0[rg], s1[rg]);
    }
    __builtin_amdgcn_sched_barrier(0);
    const int l16 = rho & 15, g16 = rho >> 4, q = l16 >> 2, p = l16 & 3;
    const LAS unsigned char* vb = vt + (4 * hi + q) * VP + (16 * g16 + 4 * p) * 2;
    s16x4 va[4][2], vc[4][2];
    if (!IMP) {
#pragma unroll
        for (int st = 0; st < 4; ++st)
#pragma unroll
            for (int dt = 0; dt < 2; ++dt) {
                va[st][dt] = __builtin_amdgcn_ds_read_tr16_b64_v4i16((LAS s16x4*)(vb + (16 * st) * VP + 64 * dt));
                vc[st][dt] = __builtin_amdgcn_ds_read_tr16_b64_v4i16((LAS s16x4*)(vb + (16 * st + 8) * VP + 64 * dt));
            }
        __builtin_amdgcn_sched_barrier(0);
    }
    if (!IMP) {
        { const auto r2 = __builtin_amdgcn_permlane32_swap(__float_as_uint(tm), __float_as_uint(tm), false, false); tm = fmaxf(__uint_as_float(r2[0]), __uint_as_float(r2[1])); }
        rescale_if_needed(rs, tm);
        const float mu = (rs.m == -INFINITY) ? 0.f : rs.m;
        float ps = 0.f;
#pragma unroll
        for (int i = 0; i < 16; ++i) { s0[i] = __builtin_amdgcn_exp2f(s0[i] - mu); s1[i] = __builtin_amdgcn_exp2f(s1[i] - mu); ps += s0[i] + s1[i]; }
        rs.l += ps;
#pragma unroll
        for (int st = 0; st < 4; ++st) {
            f16x8 pfr;
#pragma unroll
            for (int j = 0; j < 8; ++j) pfr[j] = (_Float16)((st & 2) ? s1[8 * (st & 1) + j] : s0[8 * (st & 1) + j]);
#pragma unroll
            for (int dt = 0; dt < 2; ++dt) {
                const f16x4 fa = __builtin_bit_cast(f16x4, va[st][dt]), fb = __builtin_bit_cast(f16x4, vc[st][dt]);
                const f16x8 vfr = {fa.x, fa.y, fa.z, fa.w, fb.x, fb.y, fb.z, fb.w};
                if (dt == 0) rs.o0 = __builtin_amdgcn_mfma_f32_32x32x16_f16(vfr, pfr, rs.o0, 0, 0, 0);
                else rs.o1 = __builtin_amdgcn_mfma_f32_32x32x16_f16(vfr, pfr, rs.o1, 0, 0, 0);
            }
        }
    } else {
        const float mu = (mc == -INFINITY) ? 0.f : mc;
#pragma unroll
        for (int kh = 0; kh < 2; ++kh)
#pragma unroll
            for (int ii = 0; ii < 4; ++ii) {
                float pv[4];
#pragma unroll
                for (int e = 0; e < 4; ++e) pv[e] = __builtin_amdgcn_exp2f((kh ? s1[4 * ii + e] : s0[4 * ii + e]) - mu) * invl;
                float a = (pv[0] + pv[1]) + (pv[2] + 0.5f * pv[3]), c = 0.5f * pv[3];
                a += __shfl_xor(a, 1); a += __shfl_xor(a, 2); c += __shfl_xor(c, 1); c += __shfl_xor(c, 2);
                const int nb = 16 * n + 8 * kh + 2 * ii + hi;
                if (wr) { impA[nb] = a; if (nb + 1 < 64) impC[nb + 1] = c; }
            }
    }
}
__device__ __forceinline__ void probs(RowState& rs, f32x16& s0, float sc, float c) {
    float tm = -INFINITY;
#pragma unroll
    for (int i = 0; i < 16; ++i) tm = fmaxf(tm, s0[i]);
    tm = fmaxf(tm, __shfl_xor(tm, 32));
    rescale_if_needed(rs, fmaf(tm, sc, c));
    const float mu = (rs.m == -INFINITY) ? 0.f : rs.m;
    const float cm = c - mu;
    float ps = 0.f;
#pragma unroll
    for (int i = 0; i < 16; ++i) { s0[i] = __builtin_amdgcn_exp2f(fmaf(s0[i], sc, cm)); ps += s0[i]; }
    rs.l += ps;
}
__device__ __forceinline__ void rs_init(RowState& rs) { rs.m = -INFINITY; rs.l = 0.f;
#pragma unroll
    for (int i = 0; i < 16; ++i) { rs.o0[i] = 0.f; rs.o1[i] = 0.f; } }
template <int MODE>
__device__ __forceinline__ void rs_flush(RowState& rs, float gate, LAS unsigned char* accl, _Float16* orow) {
    const float lt = rs.l + __shfl_xor(rs.l, 32);
    const float w = gate / fmaxf(lt, 1e-30f);
#pragma unroll
    for (int i = 0; i < 4; ++i) {
        float a[8] = {w * rs.o0[4 * i], w * rs.o0[4 * i + 1], w * rs.o0[4 * i + 2], w * rs.o0[4 * i + 3], w * rs.o1[4 * i], w * rs.o1[4 * i + 1], w * rs.o1[4 * i + 2], w * rs.o1[4 * i + 3]};
        LAS unsigned char* ap = accl + (i >> 1) * 16384 + (i & 1) * 1024;
        if (MODE != 0) { float p[8]; pg8::unpk8(*(const LAS u32x4*)ap, p);
#pragma unroll
            for (int e = 0; e < 8; ++e) a[e] += p[e]; }
        u32x4 wv; wv.x = pg8::pkh(a[0], a[1]); wv.y = pg8::pkh(a[2], a[3]); wv.z = pg8::pkh(a[4], a[5]); wv.w = pg8::pkh(a[6], a[7]);
        if (MODE != 2) *(LAS u32x4*)ap = wv;
        else { u32x2 w0; w0.x = wv.x; w0.y = wv.y; u32x2 w1; w1.x = wv.z; w1.y = wv.w; *(u32x2*)(orow + 8 * i) = w0; *(u32x2*)(orow + 32 + 8 * i) = w1; }
    }
}

__device__ __forceinline__ void nsa_unit(LAS unsigned char* lds, const _Float16* __restrict__ proj, const _Float16* __restrict__ kcmp, const _Float16* __restrict__ vcmp,
                                         _Float16* __restrict__ o_b, int b, int g, int qb) {
    const int tid = threadIdx.x, lane = tid & 63, wave = __builtin_amdgcn_readfirstlane(tid >> 6);
    const int rho = lane & 31, hi = lane >> 5, ql = rho >> 2, r = rho & 3, hb = g * 4 + r;
    const int t = 64 * qb + 8 * wave + ql;
    const _Float16* prow = proj + (size_t)(b * S_ + t) * PW;
    f16x8 qf[4];
#pragma unroll
    for (int ks = 0; ks < 4; ++ks) qf[ks] = *(const f16x8*)(prow + C_QB + hb * 64 + 16 * ks + 8 * hi);
    for (int i = tid; i < 2048; i += 512) ((LAS u32x4*)(lds + L_IMPA))[i] = (u32x4){0u, 0u, 0u, 0u};
    RowState rs; rs_init(rs);
    const LAS float* lut = (const LAS float*)(lds + L_BIAS);
    const float bias31 = lut[127 * 8 + hb];
    const _Float16* kc = kcmp + (size_t)(b * 2 + g) * 256 * 64;
    const long vcoff = (vcmp + (size_t)(b * 2 + g) * 256 * 64) - kc;
    const _Float16* pb = proj + (size_t)(b * S_) * PW + C_KVB + g * 64;
    const int ncmp = (4 * qb + 3 + 63) / 64;
    const int wlo = qb - 8 > 0 ? qb - 8 : 0;
    const int e0 = ncmp, e1 = 2 * ncmp, e2 = e1 + qb + 1, NT = e2 + (qb - wlo + 1);
    const int sr = tid >> 3, scq = tid & 7;
    float mc = 0.f, invl = 0.f; unsigned mlo = 0u, mhi = 0u;
    Stage stg;
#define NSA_DECODE(i, br, n) do { if ((i) < e0) { br = 0; n = (i); } else if ((i) < e1) { br = 1; n = (i) - e0; } else if ((i) < e2) { br = 2; n = (i) - e1; } else { br = 3; n = wlo + (i) - e2; } } while (0)
#define NSA_LOAD(i) do { int br_, n_; NSA_DECODE(i, br_, n_); const _Float16* kp_ = (br_ < 2) ? kc : (br_ == 2 ? pb + 2 * 128 : pb + 4 * 128); const int pitch_ = (br_ < 2) ? 64 : PW; \
        const long vo_ = (br_ < 2) ? vcoff : 128; const _Float16* rp_ = kp_ + (size_t)(64 * n_ + sr) * pitch_ + 8 * scq; stg.kr = *(const u32x4*)rp_; stg.vr = *(const u32x4*)(rp_ + vo_); } while (0)
#define NSA_STORE(buf) do { LAS unsigned char* tb_ = lds + L_T0 + (buf) * TILE_B; *(LAS u32x4*)(tb_ + sr * KP + 16 * scq) = stg.kr; *(LAS u32x4*)(tb_ + 64 * KP + sr * VP + 16 * scq) = stg.vr; } while (0)
    __syncthreads();
    NSA_LOAD(0); NSA_STORE(0);
    __syncthreads();
#pragma unroll 1
    for (int i = 0; i < NT; ++i) {
        int br, n; NSA_DECODE(i, br, n);
        const LAS unsigned char* tb = lds + L_T0 + (i & 1) * TILE_B;
        const bool more = i + 1 < NT;
        if (more) NSA_LOAD(i + 1);
        bool bit = true; int dbase, dstep = 1, dlim = 1 << 30; bool near = true;
        if (br < 2) { dbase = t - 31 - 1024 * n; dstep = 16; }
        else { dbase = t - 64 * n; near = n >= qb - 2; if (br == 2) bit = (n < 32) ? ((mlo >> n) & 1u) : ((mhi >> (n - 32)) & 1u); else dlim = 512; }
        const bool interior = (br >= 2) && (n <= qb - 3) && !(br == 3 && n == qb - 8);
        const bool skip = (br == 2) && !__any(bit);
        if (!skip) {
            if (interior) tile_fast(rs, tb, tb + 64 * KP, qf, bit ? bias31 : -INFINITY, rho, hi);
            else {
                const unsigned dl = bit ? (unsigned)dlim : 0u;
                int tq = threadIdx.x; asm volatile("" : "+v"(tq));
                LAS float* impA = (LAS float*)(lds + L_IMPA) + ((tq >> 6) * 8 + ((tq & 31) >> 2)) * 64;
                LAS float* impC = (LAS float*)(lds + L_IMPC) + ((tq >> 6) * 8 + ((tq & 31) >> 2)) * 64;
                if (br != 1) tile_general<false>(rs, tb, tb + 64 * KP, qf, lut, hb, rho, hi, dbase, dstep, dl, 0.f, 0.f, impA, impC, n, false);
                else tile_general<true>(rs, tb, tb + 64 * KP, qf, lut, hb, rho, hi, dbase, dstep, dl, mc, invl, impA, impC, n, r == 0);
            }
        }
        if (i + 1 == e0) {
            mc = rs.m; const float lc = rs.l + __shfl_xor(rs.l, 32); invl = 1.f / fmaxf(lc, 1e-30f);
        } else if (i + 1 == e1) {
            asm volatile("s_waitcnt lgkmcnt(0)" ::: "memory");
            int tq = threadIdx.x; asm volatile("" : "+v"(tq));
            const int qs = (tq & 63) >> 3, j = tq & 7, wv = tq >> 6;
            LAS float* sA = (LAS float*)(lds + L_IMPA) + (wv * 8 + qs) * 64;
            const LAS float* sC = (const LAS float*)(lds + L_IMPC) + (wv * 8 + qs) * 64;
            float sc[8];
#pragma unroll
            for (int e = 0; e < 8; ++e) { const int nn = 8 * j + e; const bool forced = (nn == 0) || (nn == qb) || (nn == qb - 1);
                sc[e] = (nn <= qb) ? (forced ? 1.0e4f : (sA[nn] + sC[nn])) : -INFINITY; }
            asm volatile("s_waitcnt lgkmcnt(0)" ::: "memory");
#pragma unroll
            for (int e = 0; e < 8; ++e) sA[8 * j + e] = sc[e];
            asm volatile("s_waitcnt lgkmcnt(0)" ::: "memory");
            int rank[8];
#pragma unroll
            for (int e = 0; e < 8; ++e) rank[e] = 0;
            for (int m = 0; m <= qb; ++m) { const float sm = sA[m];
#pragma unroll
                for (int e = 0; e < 8; ++e) rank[e] += (sm > sc[e] || (sm == sc[e] && m < 8 * j + e)) ? 1 : 0; }
            unsigned bits = 0;
#pragma unroll
            for (int e = 0; e < 8; ++e) bits |= ((8 * j + e <= qb) && rank[e] < 16) ? (1u << e) : 0u;
            ((LAS unsigned char*)(lds + L_MASK))[(wv * 8 + qs) * 8 + j] = (unsigned char)bits;
            asm volatile("s_waitcnt lgkmcnt(0)" ::: "memory");
            const u32x2 mk = *(const LAS u32x2*)(lds + L_MASK + (wv * 8 + ((tq & 31) >> 2)) * 8);
            mlo = mk.x; mhi = mk.y;
            rs_flush<0>(rs, pg8::sigm((float)prow[C_GB + 0 * 8 + hb]), lds + L_IMPA + (tq >> 6) * 2048 + (tq & 63) * 16, nullptr); rs_init(rs);
        } else if (i + 1 == e2) {
            rs_flush<1>(rs, pg8::sigm((float)prow[C_GB + 1 * 8 + hb]), lds + L_IMPA + wave * 2048 + lane * 16, nullptr); rs_init(rs);
        } else if (i + 1 == NT) {
            rs_flush<2>(rs, pg8::sigm((float)prow[C_GB + 2 * 8 + hb]), lds + L_IMPA + wave * 2048 + lane * 16, o_b + (size_t)(b * S_ + t) * 1024 + hb * 64 + 4 * hi);
        }
        if (more) NSA_STORE((i + 1) & 1);
        __syncthreads();
    }
#undef NSA_DECODE
#undef NSA_LOAD
#undef NSA_STORE
}
}


namespace cmpx {
typedef _Float16 f16x8 __attribute__((ext_vector_type(8)));
typedef float f32x4 __attribute__((ext_vector_type(4)));
typedef unsigned u32x4 __attribute__((ext_vector_type(4)));
constexpr int L_PART = 0, L_HID = 65536, HIDP = 272, L_END = L_HID + 16 * HIDP;
__device__ __forceinline__ void item(LAS unsigned char* lds, const _Float16* __restrict__ proj, const float* __restrict__ pe, const _Float16* __restrict__ w1t, const _Float16* __restrict__ w2t,
                                     _Float16* __restrict__ dst, int b, int g, int kv, int ct) {
    const int tid = threadIdx.x, lane = tid & 63, wave = __builtin_amdgcn_readfirstlane(tid >> 6), kc = lane >> 4, n16 = lane & 15;
    f32x4 acc[8];
#pragma unroll
    for (int nt = 0; nt < 8; ++nt) acc[nt] = (f32x4){0.f, 0.f, 0.f, 0.f};
    const int c = 16 * ct + n16;
#pragma unroll 2
    for (int ks = 0; ks < 8; ++ks) {
        const int k0 = 32 * (8 * wave + ks) + 8 * kc, lt = k0 >> 6, d = k0 & 63;
        int trow = 16 * c + lt; trow = trow > S_ - 1 ? S_ - 1 : trow;
        const f16x8 raw = *(const f16x8*)(proj + (size_t)(b * S_ + trow) * PW + C_KVB + kv * 128 + g * 64 + d);
        const f32x4 p0 = *(const f32x4*)(pe + lt * 64 + d), p1 = *(const f32x4*)(pe + lt * 64 + d + 4);
        f16x8 afr;
        afr[0] = (_Float16)((float)raw[0] + p0.x); afr[1] = (_Float16)((float)raw[1] + p0.y); afr[2] = (_Float16)((float)raw[2] + p0.z); afr[3] = (_Float16)((float)raw[3] + p0.w);
        afr[4] = (_Float16)((float)raw[4] + p1.x); afr[5] = (_Float16)((float)raw[5] + p1.y); afr[6] = (_Float16)((float)raw[6] + p1.z); afr[7] = (_Float16)((float)raw[7] + p1.w);
#pragma unroll
        for (int nt = 0; nt < 8; ++nt) {
            const f16x8 bfr = *(const f16x8*)(w1t + (size_t)(16 * nt + n16) * 2048 + k0);
            acc[nt] = __builtin_amdgcn_mfma_f32_16x16x32_f16(afr, bfr, acc[nt], 0, 0, 0);
        }
    }
    LAS float* part = (LAS float*)(lds + L_PART) + wave * 2048;
#pragma unroll
    for (int nt = 0; nt < 8; ++nt) { part[(4 * kc + 0) * 128 + 16 * nt + n16] = acc[nt].x; part[(4 * kc + 1) * 128 + 16 * nt + n16] = acc[nt].y;
        part[(4 * kc + 2) * 128 + 16 * nt + n16] = acc[nt].z; part[(4 * kc + 3) * 128 + 16 * nt + n16] = acc[nt].w; }
    __syncthreads();
    { const LAS float* pp = (const LAS float*)(lds + L_PART);
#pragma unroll
      for (int e = 0; e < 4; ++e) { const int o = tid + 512 * e; float a = 0.f;
#pragma unroll
          for (int w = 0; w < 8; ++w) a += pp[w * 2048 + o];
          const float z = 0.7978845608028654f * (a + 0.044715f * a * a * a);
          const float th = 1.f - 2.f / (__expf(2.f * z) + 1.f);
          ((LAS _Float16*)(lds + L_HID + (o >> 7) * HIDP))[o & 127] = (_Float16)(0.5f * a * (1.f + th)); } }
    __syncthreads();
    if (wave < 4) {
        f32x4 o = {0.f, 0.f, 0.f, 0.f};
#pragma unroll
        for (int ks = 0; ks < 4; ++ks) {
            const f16x8 afr = *(const LAS f16x8*)(lds + L_HID + n16 * HIDP + (32 * ks + 8 * kc) * 2);
            const f16x8 bfr = *(const f16x8*)(w2t + (size_t)(16 * wave + n16) * 128 + 32 * ks + 8 * kc);
            o = __builtin_amdgcn_mfma_f32_16x16x32_f16(afr, bfr, o, 0, 0, 0);
        }
        const float ov[4] = {o.x, o.y, o.z, o.w};
#pragma unroll
        for (int e = 0; e < 4; ++e) { const int cc = 16 * ct + 4 * kc + e; dst[((size_t)(b * 2 + g) * 256 + cc) * 64 + 16 * wave + n16] = (_Float16)(cc == 255 ? 0.f : ov[e]); }
    }
    __syncthreads();
}
}


#define XB_TMO      128
#define XB_XCNT(j)  (256  + 64 * (j))
#define XB_XSUB(j)  (1280 + 64 * (j))
#define XB_XGEN(j)  (2304 + 64 * (j))
#define XB_TOP      3328
#define XB_TOPGEN   3392
#define XCD_BAR_WORDS 3456
#define XB_SPIN_CAP (1u << 18)
__device__ __forceinline__ unsigned xb_ld(unsigned* p)              { return __hip_atomic_load(p, __ATOMIC_RELAXED, __HIP_MEMORY_SCOPE_AGENT); }
__device__ __forceinline__ unsigned xb_add(unsigned* p, unsigned v) { return __hip_atomic_fetch_add(p, v, __ATOMIC_RELAXED, __HIP_MEMORY_SCOPE_AGENT); }
__device__ __forceinline__ unsigned xb_xcc_id() { return (unsigned)__builtin_amdgcn_s_getreg((3 << 11) | 20) & 0xFu; }
#define XB_SPIN(cond, bar) do { unsigned _sp = 0; while (cond) { __builtin_amdgcn_s_sleep(1); \
    if ((++_sp & 255u) == 0u) { if (xb_ld(&(bar)[XB_TMO])) break; if (_sp > XB_SPIN_CAP) { atomicAdd(&(bar)[XB_TMO], 1u); break; } } } } while (0)
struct XcdBarrier { unsigned* bar; unsigned x; volatile LAS unsigned* st; };
__device__ __forceinline__ XcdBarrier xcd_barrier_post(unsigned* bar, volatile LAS unsigned* st) {
    XcdBarrier b; b.bar = bar; b.x = xb_xcc_id(); b.st = st;
    if (threadIdx.x == 0) (void)xb_add(&bar[XB_XCNT(b.x)], 1u);
    return b;
}
__device__ __forceinline__ void xcd_barrier_complete(unsigned* bar, unsigned x, unsigned& nloc, unsigned& nx) {
    const unsigned G = gridDim.x * gridDim.y * gridDim.z;
    unsigned sum, cnt, mine, sp = 0u;
    for (;;) {
        sum = 0u; cnt = 0u; mine = 0u;
#pragma unroll
        for (unsigned j = 0; j < 16; ++j) { const unsigned c = xb_ld(&bar[XB_XCNT(j)]); sum += c; cnt += (c > 0u) ? 1u : 0u; mine = (j == x) ? c : mine; }
        if (sum == G) break;
        __builtin_amdgcn_s_sleep(1);
        if ((++sp & 255u) == 0u) { if (xb_ld(&bar[XB_TMO])) break; if (sp > XB_SPIN_CAP) { atomicAdd(&bar[XB_TMO], 1u); break; } }
    }
    nloc = mine > 0u ? mine : 1u; nx = cnt > 0u ? cnt : 1u;
}
__device__ __forceinline__ void xcd_barrier(const XcdBarrier& b) {
    asm volatile("s_waitcnt vmcnt(0)" ::: "memory");
    __syncthreads();
    if (threadIdx.x == 0) {
        unsigned* bar = b.bar;
        __builtin_amdgcn_s_waitcnt(0);
        unsigned nloc = b.st[0], nx = b.st[1];
        if (nloc == 0u) { xcd_barrier_complete(bar, b.x, nloc, nx); b.st[0] = nloc; b.st[1] = nx; }
        const unsigned old = xb_add(&bar[XB_XSUB(b.x)], 1u);
        const unsigned gen = old / nloc;
        if (old + 1u == (gen + 1u) * nloc) {
            __builtin_amdgcn_fence(__ATOMIC_RELEASE, "agent");
            asm volatile("s_waitcnt vmcnt(0)" ::: "memory");
            const unsigned og = xb_add(&bar[XB_TOP], 1u);
            const unsigned tg = og / nx;
            if (og + 1u == (tg + 1u) * nx) xb_add(&bar[XB_TOPGEN], 1u);
            else XB_SPIN(xb_ld(&bar[XB_TOPGEN]) == tg, bar);
            __builtin_amdgcn_fence(__ATOMIC_ACQUIRE, "agent");
            xb_add(&bar[XB_XGEN(b.x)], 1u);
            asm volatile("s_waitcnt vmcnt(0)" ::: "memory");
        } else {
            XB_SPIN(xb_ld(&bar[XB_XGEN(b.x)]) == gen, bar);
            __builtin_amdgcn_fence(__ATOMIC_ACQUIRE, "agent");
            asm volatile("s_waitcnt vmcnt(0)" ::: "memory");
        }
    }
    __syncthreads();
}

constexpr int MEGA_LDS = 131072 + 256;

template <class Epi>
__device__ __forceinline__ void gemm_run(LAS unsigned char* lds, const void* A, const void* Bt, const Epi& E, int M, int N, int K) {
    pg8::Gemm g{(const pg8::bf16_t*)A, (const pg8::bf16_t*)Bt, M, N, K};
    pg8::StaticOrder S; S.init(M, N, (int)gridDim.x, (int)blockIdx.x);
    pg8::gemm_phase<Epi, pg8::StaticOrder, true, true>(lds, g, S, E);
}

__global__ void __launch_bounds__(512, 2) mega_fwd(Args a) {
    extern __shared__ __attribute__((aligned(16))) unsigned char lds_raw[];
    LAS unsigned char* lds = (LAS unsigned char*)lds_raw;
    unsigned char* ws = a.ws;
    if (threadIdx.x == 0) *(LAS dsa::u32x4*)(lds + 131072) = (dsa::u32x4){0u, 0u, 0u, 0u};
    __syncthreads();
    XcdBarrier bar = xcd_barrier_post((unsigned*)(ws + WS_CTL), (volatile LAS unsigned*)(lds + 131072));
    const _Float16* proj = (const _Float16*)(ws + WS_PROJ);
    _Float16* o_a = (_Float16*)(ws + WS_H); _Float16* o_b = (_Float16*)(ws + WS_H) + 512;
    _Float16* kcmp = (_Float16*)(ws + WS_KCMP); _Float16* vcmp = (_Float16*)(ws + WS_VCMP);

    prologue_body(a, lds_raw);
    xcd_barrier(bar);
    gemm_run(lds, ws + WS_H, ws + WS_WIN, pg8::EpiProj{(_Float16*)(ws + WS_PROJ)}, M_, PW, D_);
    xcd_barrier(bar);
#pragma unroll 1
    for (int it = blockIdx.x; it < 512; it += gridDim.x) { const int ct = it & 15, kv = (it >> 4) & 1, g = (it >> 5) & 1, b = it >> 6;
        cmpx::item(lds, proj, kv ? a.pe_v : a.pe_k, (const _Float16*)(ws + WS_CW + (kv ? 512 * 1024 : 0)), (const _Float16*)(ws + WS_CW + 1024 * 1024 + (kv ? 16384 : 0)), kv ? vcmp : kcmp, b, g, kv, ct); }
    { LAS float* biaslut = (LAS float*)(lds + dsa::L_BIAS);
      for (int i = threadIdx.x; i < 1024; i += 512) { const int d = i >> 3, h = i & 7; biaslut[i] = a.rel_bias[t5_bucket(d) * 16 + h]; } }
    __syncthreads();
#pragma unroll 1
    for (int v = blockIdx.x >> 3; v < 256; v += (gridDim.x >> 3)) { const int b = blockIdx.x & 7, j = v & 127;
        dsa::dsa_tile(lds, proj, o_a, b, (v < 128) ? 255 - j : j); }
    xcd_barrier(bar);
    { LAS float* lut = (LAS float*)(lds + nsa::L_BIAS);
      for (int i = threadIdx.x; i < 1024; i += 512) { const int d = i >> 3, h = i & 7; lut[i] = a.rel_bias[t5_bucket(d) * 16 + 8 + h] * nsa::LOG2E; } }
    __syncthreads();
#pragma unroll 1
    for (int v = blockIdx.x >> 3; v < 128; v += (gridDim.x >> 3)) { const int bg = 2 * (blockIdx.x & 7) + (v >> 6), j = v & 31;
        nsa::nsa_unit(lds, proj, kcmp, vcmp, o_b, bg >> 1, bg & 1, (v & 32) ? j : 63 - j);
        __syncthreads(); }
    xcd_barrier(bar);
    gemm_run(lds, ws + WS_H, ws + WS_WBA, pg8::EpiMixF{(_Float16*)(ws + WS_MIX), proj}, M_, D_, D_);
    xcd_barrier(bar);
    gemm_run(lds, ws + WS_MIX, ws + WS_WOUT, pg8::EpiResidSq{a.x, a.out, (_Float16*)(ws + WS_H), (float*)(ws + WS_ROWSQ)}, M_, D_, D_);
    xcd_barrier(bar);
    gemm_run(lds, ws + WS_H, ws + WS_WMI, pg8::EpiRelu2N{(_Float16*)(ws + WS_PROJ), (const float*)(ws + WS_ROWSQ)}, M_, DFF, D_);
    xcd_barrier(bar);
#pragma unroll 1
    for (int sl = 0; sl < 2; ++sl) {
        pg8::Gemm g{(const pg8::bf16_t*)(ws + WS_PROJ), (const pg8::bf16_t*)(ws + WS_WMO), M_, D_, DFF};
        SliceOrder SO; SO.S.init(M_, D_, (int)gridDim.x, (int)blockIdx.x); SO.slice = sl;
        pg8::gemm_phase<EpiFinalNorm, SliceOrder, false, true>(lds, g, SO, EpiFinalNorm{a.out, (const _Float16*)(ws + WS_H), a.norm_final, (float*)(ws + WS_XBUF), (unsigned*)(ws + WS_PCNT)});
        __syncthreads();
    }
}
}

extern "C" void kernel_launch(void* const* d_in, const int* in_sizes, int n_in, void* d_out, int out_size, void* d_ws, size_t ws_size, hipStream_t stream) {
    if (ws_size < WS_END) { fprintf(stderr, "ws too small: %zu\n", ws_size); return; }
    static int grid = 0;
    if (!grid) {
        int dev = 0, cus = 0, per_cu = 0;
        (void)hipGetDevice(&dev);
        (void)hipDeviceGetAttribute(&cus, hipDeviceAttributeMultiprocessorCount, dev);
        (void)hipFuncSetAttribute((const void*)mega_fwd, hipFuncAttributeMaxDynamicSharedMemorySize, MEGA_LDS);
        (void)hipOccupancyMaxActiveBlocksPerMultiprocessor(&per_cu, (const void*)mega_fwd, 512, MEGA_LDS);
        (void)hipGetLastError();
        grid = cus;
        if (per_cu < 1) fprintf(stderr, "occupancy query says %d blocks/CU\n", per_cu);
        if (cus != 256) { fprintf(stderr, "kernel_launch: built for a 256-CU device (the last GEMM's row-panel exchange needs exactly 256 workgroups); found %d CUs, nothing launched\n", cus); grid = -1; }
    }
    if (grid < 0) return;
    Args a{};
    a.x = (const float*)d_in[0]; a.norm_mix = (const float*)d_in[1]; a.w_in = (const float*)d_in[2];
    a.pe_k = (const float*)d_in[3]; a.w1_k = (const float*)d_in[4]; a.w2_k = (const float*)d_in[5];
    a.pe_v = (const float*)d_in[6]; a.w1_v = (const float*)d_in[7]; a.w2_v = (const float*)d_in[8];
    a.rel_bias = (const float*)d_in[9]; a.w_ba = (const float*)d_in[10]; a.w_bb = (const float*)d_in[11];
    a.w_out = (const float*)d_in[12]; a.norm_mlp = (const float*)d_in[13]; a.w_mi = (const float*)d_in[14];
    a.w_mo = (const float*)d_in[15]; a.norm_final = (const float*)d_in[16];
    a.out = (float*)d_out; a.ws = (unsigned char*)d_ws;
    (void)hipMemsetAsync(d_ws, 0, 327680, stream);
    hipLaunchKernelGGL(mega_fwd, dim3(grid), dim3(512), MEGA_LDS, stream, a);
}
```

```cpp
#include <hip/hip_runtime.h>
#include <hip/hip_fp16.h>
#include <cstdint>
#include <cstdio>

__device__ __forceinline__ float xchg_xor1(float v) { return __int_as_float(__builtin_amdgcn_mov_dpp(__float_as_int(v), 0xB1, 0xf, 0xf, true)); }
__device__ __forceinline__ float xchg_xor2(float v) { return __int_as_float(__builtin_amdgcn_mov_dpp(__float_as_int(v), 0x4E, 0xf, 0xf, true)); }
__device__ __forceinline__ float max_xor16(float v) { const auto r = __builtin_amdgcn_permlane16_swap(__float_as_uint(v), __float_as_uint(v), false, false); return fmaxf(__uint_as_float(r[0]), __uint_as_float(r[1])); }
__device__ __forceinline__ float sum_xor16(float v) { const auto r = __builtin_amdgcn_permlane16_swap(__float_as_uint(v), __float_as_uint(v), false, false); return __uint_as_float(r[0]) + __uint_as_float(r[1]); }
__device__ __forceinline__ float sum_xor32(float v) { const auto r = __builtin_amdgcn_permlane32_swap(__float_as_uint(v), __float_as_uint(v), false, false); return __uint_as_float(r[0]) + __uint_as_float(r[1]); }
__device__ __forceinline__ float max_xor32(float v) { const auto r = __builtin_amdgcn_permlane32_swap(__float_as_uint(v), __float_as_uint(v), false, false); return fmaxf(__uint_as_float(r[0]), __uint_as_float(r[1])); }
namespace pg8 {
#define PG8_LAS __attribute__((address_space(3)))
typedef unsigned short bf16_t;
typedef _Float16 bf16x8 __attribute__((ext_vector_type(8)));
typedef float f32x4 __attribute__((ext_vector_type(4)));
typedef unsigned u32x4 __attribute__((ext_vector_type(4)));
constexpr int BM = 256, BK = 64, HALF = 128, HTB = HALF * BK * 2  , STAGE_BYTES = 8 * HTB, NXCD = 8, WGM = 8;

__host__ __device__ __forceinline__ int lds_byte(int r, int c) { const int st = (r >> 4) * 2 + (c >> 5), rr = r & 15, cc = c & 31, ob = rr * 64 + cc * 2; return st * 1024 + (ob ^ (((ob >> 9) & 1) << 5)); }
__host__ __device__ __forceinline__ void stage_rc(int b, int& R, int& C) { const int st = b / 1024, sb = b % 1024, swz = sb ^ (((sb >> 9) & 1) << 5); R = (st >> 1) * 16 + swz / 64; C = (st & 1) * 32 + (swz % 64) / 2; }
__host__ __device__ __forceinline__ int perm32(int rho) { const int n = rho >> 4, i = rho & 15; return 8 * (i >> 2) + 4 * n + (i & 3); }

struct Unit { int pm, pn; };
struct Gemm { const bf16_t* A; const bf16_t* Bt; int M, N, K; };

struct StaticOrder {
    int nM, nN, nwg, G, c;
    __host__ __device__ void init(int M, int N, int G_, int c_) { nM = M / BM; nN = N / BM; nwg = nM * nN; G = G_; c = c_; }
    __host__ __device__ bool next(int i, Unit& u) const {
        const long L = (long)i * G + c; if (L >= nwg) return false;
        int wgid = (int)L; { const int q = nwg / NXCD, r = nwg % NXCD, xcd = wgid % NXCD, off = wgid / NXCD; wgid = (xcd < r ? xcd * (q + 1) : r * (q + 1) + (xcd - r) * q) + off; }
        const int nig = WGM * nN, gid = wgid / nig, fm = gid * WGM, gsz = (nM - fm) < WGM ? (nM - fm) : WGM;
        u.pm = fm + ((wgid % nig) % gsz); u.pn = (wgid % nig) / gsz; return true;
    }
    __device__ __forceinline__ void a_ready(const Unit&) const {}
    __device__ __forceinline__ void done(const Unit&) const {}
};


typedef unsigned u32x2 __attribute__((ext_vector_type(2)));
typedef float f32x2 __attribute__((ext_vector_type(2)));
typedef _Float16 f16x2 __attribute__((ext_vector_type(2)));
constexpr int PW = 4352;
__device__ __forceinline__ unsigned pkh(float a, float b) { f32x2 v = {a, b}; f16x2 h = __builtin_convertvector(v, f16x2); return __builtin_bit_cast(unsigned, h); }
__device__ __forceinline__ float sigm(float v) { return __builtin_amdgcn_rcpf(1.f + __expf(-v)); }
__device__ __forceinline__ float sigm_gate(float v) { return fmaxf(sigm(v), 6.2e-5f); }
__device__ __forceinline__ void unpk8(const u32x4 w, float (&f)[8]) {
#pragma unroll
    for (int i = 0; i < 4; ++i) { const unsigned wi = (i == 0) ? w.x : (i == 1) ? w.y : (i == 2) ? w.z : w.w; const f16x2 h = __builtin_bit_cast(f16x2, wi); f[2 * i] = (float)h.x; f[2 * i + 1] = (float)h.y; } }

struct EpiProj {
    static constexpr bool PERM = true, AFTER_DRAIN = false, MID = false, PRE = false;
    _Float16* O; _Float16* KI;
    __device__ __forceinline__ void operator()(const f32x4 (&acc)[2][2][4][2], const Unit& u, int wr, int wc, int fr, int fq) const {
        const int row0 = u.pm * BM + wr * 64 + fr, col0 = u.pn * BM + wc * 32 + 8 * fq; const bool sg = u.pn >= 9;
        const bool ki = (u.pn == 8) && (wc == 0);
#pragma unroll
        for (int ai = 0; ai < 2; ++ai)
#pragma unroll
            for (int m = 0; m < 4; ++m) { _Float16* rowp = O + (size_t)(row0 + ai * HALF + m * 16) * PW + col0;
#pragma unroll
                for (int bj = 0; bj < 2; ++bj) { f32x4 v0 = acc[ai][bj][m][0], v1 = acc[ai][bj][m][1];
                    if (sg) {
                        const f32x4 b0 = acc[ai][1][m][0], b1 = acc[ai][1][m][1];
#pragma unroll
                        for (int i = 0; i < 4; ++i) { const float g0 = sigm_gate(b0[i]), g1 = sigm_gate(b1[i]);
                            v0[i] = bj ? g0 : sigm(v0[i]) * __builtin_amdgcn_rcpf(g0); v1[i] = bj ? g1 : sigm(v1[i]) * __builtin_amdgcn_rcpf(g1); } }
                    u32x4 w; w.x = pkh(v0[0], v0[1]); w.y = pkh(v0[2], v0[3]); w.z = pkh(v1[0], v1[1]); w.w = pkh(v1[2], v1[3]);
                    *(u32x4*)(rowp + bj * HALF) = w;
                    if (bj == 1 && ki) *(u32x4*)(KI + (size_t)(row0 + ai * HALF + m * 16) * 32 + 8 * fq) = w; } }
    }
};
struct EpiMixF {
    static constexpr bool PERM = true, AFTER_DRAIN = false, MID = true, PRE = false;
    _Float16* mix; const _Float16* proj;
    __device__ __forceinline__ void mid(f32x4 (&acc)[2][2][4][2], const Unit& u, int wr, int wc, int fr, int fq) const {
        int row0 = u.pm * BM + wr * 64 + fr, col0 = wc * 32 + 8 * fq;
        asm volatile("" : "+v"(row0), "+v"(col0));
#pragma unroll
        for (int ai = 0; ai < 2; ++ai) {
            u32x4 wr4[4][2];
#pragma unroll
            for (int m = 0; m < 4; ++m)
#pragma unroll
                for (int bj = 0; bj < 2; ++bj) wr4[m][bj] = *(const u32x4*)(proj + (size_t)(row0 + ai * HALF + m * 16) * PW + 2304 + 256 * (2 * u.pn + bj) + col0);
#pragma unroll
            for (int m = 0; m < 4; ++m)
#pragma unroll
                for (int bj = 0; bj < 2; ++bj) { float rr[8]; unpk8(wr4[m][bj], rr);
#pragma unroll
                    for (int i = 0; i < 4; ++i) { acc[ai][bj][m][0][i] *= rr[i]; acc[ai][bj][m][1][i] *= rr[4 + i]; } }
            __builtin_amdgcn_sched_barrier(0);
        }
    }
    __device__ __forceinline__ void operator()(const f32x4 (&acc)[2][2][4][2], const Unit& u, int wr, int wc, int fr, int fq) const {
        const int row0 = u.pm * BM + wr * 64 + fr, col0 = u.pn * BM + wc * 32 + 8 * fq;
#pragma unroll
        for (int ai = 0; ai < 2; ++ai) {
            u32x4 gw[4][2];
#pragma unroll
            for (int m = 0; m < 4; ++m)
#pragma unroll
                for (int bj = 0; bj < 2; ++bj) gw[m][bj] = *(const u32x4*)(proj + (size_t)(row0 + ai * HALF + m * 16) * PW + 2304 + 256 * (2 * u.pn + bj) + 128 + (wc * 32 + 8 * fq));
#pragma unroll
            for (int m = 0; m < 4; ++m) { const size_t r = (size_t)(row0 + ai * HALF + m * 16);
#pragma unroll
                for (int bj = 0; bj < 2; ++bj) { const int c = col0 + bj * HALF;
                    float gb[8]; unpk8(gw[m][bj], gb);
                    const f32x4 v0 = acc[ai][bj][m][0], v1 = acc[ai][bj][m][1];
                    u32x4 w; w.x = pkh(gb[0] * v0[0], gb[1] * v0[1]); w.y = pkh(gb[2] * v0[2], gb[3] * v0[3]); w.z = pkh(gb[4] * v1[0], gb[5] * v1[1]); w.w = pkh(gb[6] * v1[2], gb[7] * v1[3]);
                    *(u32x4*)(mix + r * 1024 + c) = w; } }
        }
    }
};
struct EpiResidSq {
    static constexpr bool PERM = true, AFTER_DRAIN = false, MID = false, PRE = true;
    const float* rinv; _Float16* xh; float* rowsq;
    __device__ __forceinline__ void pre(float (&rp)[8], const Unit& u, int wr, int wc, int fr, int fq) const {
        const int row0 = u.pm * BM + wr * 64 + fr;
#pragma unroll
        for (int ai = 0; ai < 2; ++ai)
#pragma unroll
            for (int m = 0; m < 4; ++m) rp[ai * 4 + m] = rinv[row0 + ai * HALF + m * 16];
    }
    __device__ __forceinline__ void operator()(const f32x4 (&acc)[2][2][4][2], const Unit& u, int wr, int wc, int fr, int fq, const float (&rp)[8]) const {
        const int row0 = u.pm * BM + wr * 64 + fr, col0 = u.pn * BM + wc * 32 + 8 * fq;
#pragma unroll
        for (int ai = 0; ai < 2; ++ai) {
            u32x4 hv[4][2];
#pragma unroll
            for (int m = 0; m < 4; ++m)
#pragma unroll
                for (int bj = 0; bj < 2; ++bj) hv[m][bj] = *(const u32x4*)(xh + (size_t)(row0 + ai * HALF + m * 16) * 1024 + col0 + bj * HALF);
#pragma unroll
            for (int m = 0; m < 4; ++m) { const size_t r = (size_t)(row0 + ai * HALF + m * 16); const float ri = rp[ai * 4 + m]; float sq = 0.f;
#pragma unroll
                for (int bj = 0; bj < 2; ++bj) { const size_t o = r * 1024 + col0 + bj * HALF;
                    float hx[8]; unpk8(hv[m][bj], hx);
                    f32x4 a0 = acc[ai][bj][m][0], a1 = acc[ai][bj][m][1];
#pragma unroll
                    for (int i = 0; i < 4; ++i) { a0[i] = fmaf(hx[i], ri, a0[i]); a1[i] = fmaf(hx[4 + i], ri, a1[i]); }
                    u32x4 w; w.x = pkh(a0[0], a0[1]); w.y = pkh(a0[2], a0[3]); w.z = pkh(a1[0], a1[1]); w.w = pkh(a1[2], a1[3]);
                    *(u32x4*)(xh + o) = w;
                    sq += (a0[0] * a0[0] + a0[1] * a0[1]) + (a0[2] * a0[2] + a0[3] * a0[3]) + (a1[0] * a1[0] + a1[1] * a1[1]) + (a1[2] * a1[2] + a1[3] * a1[3]); }
                sq = sum_xor16(sq); sq = sum_xor32(sq);
                if (fq == 0) atomicAdd(rowsq + r, sq); }
        }
    }
};
struct EpiRelu2N {
    static constexpr bool PERM = true, AFTER_DRAIN = false, MID = false, PRE = true;
    _Float16* U; const float* rowsq;
    __device__ __forceinline__ void pre(float (&rqp)[8], const Unit& u, int wr, int wc, int fr, int fq) const {
        const int row0 = u.pm * BM + wr * 64 + fr;
#pragma unroll
        for (int ai = 0; ai < 2; ++ai)
#pragma unroll
            for (int m = 0; m < 4; ++m) rqp[ai * 4 + m] = rowsq[row0 + ai * HALF + m * 16];
    }
    __device__ __forceinline__ void operator()(const f32x4 (&acc)[2][2][4][2], const Unit& u, int wr, int wc, int fr, int fq, const float (&rqp)[8]) const {
        const int row0 = u.pm * BM + wr * 64 + fr, col0 = u.pn * BM + wc * 32 + 8 * fq;
        float rq[2][4];
#pragma unroll
        for (int ai = 0; ai < 2; ++ai)
#pragma unroll
            for (int m = 0; m < 4; ++m) rq[ai][m] = rqp[ai * 4 + m];
#pragma unroll
        for (int ai = 0; ai < 2; ++ai)
#pragma unroll
            for (int m = 0; m < 4; ++m) { const int r = row0 + ai * HALF + m * 16; _Float16* rowp = U + (size_t)r * 4096 + col0;
                const float inv = 1.f / (rq[ai][m] * (1.f / 1024.f) + 1e-6f);
#pragma unroll
                for (int bj = 0; bj < 2; ++bj) { f32x4 v0 = acc[ai][bj][m][0], v1 = acc[ai][bj][m][1];
#pragma unroll
                    for (int i = 0; i < 4; ++i) { const float a = fmaxf(v0[i], 0.f), b = fmaxf(v1[i], 0.f); v0[i] = a * a * inv; v1[i] = b * b * inv; }
                    u32x4 w; w.x = pkh(v0[0], v0[1]); w.y = pkh(v0[2], v0[3]); w.z = pkh(v1[0], v1[1]); w.w = pkh(v1[2], v1[3]);
                    *(u32x4*)(rowp + bj * HALF) = w; } }
    }
};
template <class Epi, class Sched, bool ALIGN_EPI = false, bool SP2 = false>
__device__ __forceinline__ void gemm_phase(PG8_LAS unsigned char* lds, const Gemm g, const Sched& S, const Epi& E) {
    int tid_ = threadIdx.x; asm volatile("" : "+v"(tid_));
    const int tid = tid_, wid = __builtin_amdgcn_readfirstlane(tid >> 6), lane = tid & 63, wr = wid >> 2, wc = wid & 3, fr = lane & 15, fq = lane >> 4;
    const int K = g.K, nt = K / BK;
    unsigned voffA[2], voffB[2];
#pragma unroll
    for (int i = 0; i < 2; ++i) { int R, C; stage_rc(tid * 16 + i * 8192, R, C); const int Rb = Epi::PERM ? ((R & ~31) + perm32(R & 31)) : R;
        voffA[i] = (unsigned)(R * K + C) * 2u; voffB[i] = (unsigned)(Rb * K + C) * 2u; }
    const size_t kstep = (size_t)(BK * 2);
    const size_t hstep = (size_t)HALF * K * 2;
    const size_t tstep = 2 * hstep;
    const unsigned ldsw = (unsigned)wid * 1024u;
    const int aoff = lds_byte(wr * 64 + fr, fq * 8), boff = lds_byte(wc * 32 + fr, fq * 8);
#define PG8_SA(b, h) (((b) * 2 + (h)) * HTB)
#define PG8_SB(b, h) ((4 + (b) * 2 + (h)) * HTB)
#define PG8_STAGE(bufoff, gbase, voff) do { _Pragma("unroll") for (int _i = 0; _i < 2; ++_i) \
        __builtin_amdgcn_global_load_lds((const unsigned*)((const char*)(gbase) + (voff)[_i]), (PG8_LAS unsigned*)(lds + (bufoff) + ldsw + _i * 8192), 16, 0, 0); } while (0)
#define PG8_LDA(dst, b, h) do { _Pragma("unroll") for (int m = 0; m < 4; ++m) _Pragma("unroll") for (int k = 0; k < 2; ++k) dst[m][k] = *(const PG8_LAS bf16x8*)(lds + PG8_SA(b, h) + aoff + m * 2048 + k * 1024); } while (0)
#define PG8_LDB(dst, b, h) do { _Pragma("unroll") for (int n = 0; n < 2; ++n) _Pragma("unroll") for (int k = 0; k < 2; ++k) dst[n][k] = *(const PG8_LAS bf16x8*)(lds + PG8_SB(b, h) + boff + n * 2048 + k * 1024); } while (0)
#define PG8_MMA(ai, bj, At, Bt) do { __builtin_amdgcn_s_setprio(1); _Pragma("unroll") for (int m = 0; m < 4; ++m) _Pragma("unroll") for (int n = 0; n < 2; ++n) _Pragma("unroll") for (int k = 0; k < 2; ++k) \
        acc[ai][bj][m][n] = __builtin_amdgcn_mfma_f32_16x16x32_f16(Bt[n][k], At[m][k], acc[ai][bj][m][n], 0, 0, 0); __builtin_amdgcn_s_setprio(0); } while (0)
#define PG8_WAIT_V(n) asm volatile("s_waitcnt vmcnt(" #n ")" ::: "memory")
#define PG8_WAIT_L(n) asm volatile("s_waitcnt lgkmcnt(" #n ")" ::: "memory")
#define PG8_BAR __builtin_amdgcn_s_barrier()
#define PG8_SCHED __builtin_amdgcn_sched_barrier(0)
    Unit cur, nxt; int ui = 0;
    if (!S.next(0, cur)) return;
    float epre[8];
    if constexpr (Epi::PRE) E.pre(epre, cur, wr, wc, fr, fq);
    f32x4 acc[2][2][4][2];
#pragma unroll
    for (int a = 0; a < 2; ++a)
#pragma unroll
        for (int b = 0; b < 2; ++b)
#pragma unroll
            for (int m = 0; m < 4; ++m)
#pragma unroll
                for (int n = 0; n < 2; ++n) acc[a][b][m][n] = (f32x4){0.f, 0.f, 0.f, 0.f};
    bf16x8 At[4][2], B0[2][2], B1[2][2];
    const char* cA = (const char*)g.A + (size_t)cur.pm * tstep; const char* cB = (const char*)g.Bt + (size_t)cur.pn * tstep;
    S.a_ready(cur);
    if constexpr (SP2) {
        PG8_STAGE(PG8_SB(0, 0), cB, voffB); PG8_STAGE(PG8_SB(0, 1), cB + hstep, voffB); PG8_STAGE(PG8_SA(0, 0), cA, voffA); PG8_STAGE(PG8_SA(0, 1), cA + hstep, voffA);
        if (wr == 1) PG8_BAR;
        PG8_WAIT_V(2); PG8_BAR;
        PG8_STAGE(PG8_SB(1, 0), cB + kstep, voffB); PG8_STAGE(PG8_SA(1, 0), cA + kstep, voffA); PG8_STAGE(PG8_SB(1, 1), cB + hstep + kstep, voffB);
        PG8_WAIT_V(6); PG8_BAR;
    } else {
        PG8_STAGE(PG8_SB(0, 0), cB, voffB); PG8_STAGE(PG8_SA(0, 0), cA, voffA); PG8_STAGE(PG8_SB(0, 1), cB + hstep, voffB); PG8_STAGE(PG8_SA(0, 1), cA + hstep, voffA);
        if (wr == 1) PG8_BAR;
        PG8_WAIT_V(4); PG8_BAR;
        PG8_STAGE(PG8_SB(1, 0), cB + kstep, voffB); PG8_STAGE(PG8_SA(1, 0), cA + kstep, voffA); PG8_STAGE(PG8_SB(1, 1), cB + hstep + kstep, voffB);
        PG8_WAIT_V(6); PG8_BAR;
    }
    for (;;) {
        const bool has_next = S.next(ui + 1, nxt);
        const char* nA = has_next ? (const char*)g.A + (size_t)nxt.pm * tstep : cA; const char* nB = has_next ? (const char*)g.Bt + (size_t)nxt.pn * tstep : cB;
        for (int t = 0; t < nt; t += 2) {
            if constexpr (Epi::MID) { if (t == nt / 2) E.mid(acc, cur, wr, wc, fr, fq); }
            const bool last = (t == nt - 2);
            const char* a1 = cA + (size_t)(t + 1) * kstep;
            const char* a2 = last ? nA : cA + (size_t)(t + 2) * kstep; const char* b2 = last ? nB : cB + (size_t)(t + 2) * kstep;
            const char* a3 = a2 + kstep; const char* b3 = b2 + kstep;
            if (last && has_next) S.a_ready(nxt);
            if constexpr (SP2) {
            PG8_LDB(B0, 0, 0); PG8_LDB(B1, 0, 1); PG8_SCHED; PG8_LDA(At, 0, 0); PG8_STAGE(PG8_SA(1, 1), a1 + hstep, voffA);
            PG8_WAIT_V(8); PG8_WAIT_L(0); PG8_BAR; PG8_MMA(0, 0, At, B0); PG8_MMA(0, 1, At, B1); PG8_BAR; PG8_SCHED;
            PG8_LDA(At, 0, 1); PG8_STAGE(PG8_SB(0, 0), b2, voffB); PG8_STAGE(PG8_SB(0, 1), b2 + hstep, voffB); PG8_STAGE(PG8_SA(0, 0), a2, voffA);
            PG8_WAIT_V(8); PG8_WAIT_L(0); PG8_BAR; PG8_MMA(1, 0, At, B0); PG8_MMA(1, 1, At, B1); PG8_BAR; PG8_SCHED;
            PG8_LDB(B0, 1, 0); PG8_LDB(B1, 1, 1); PG8_SCHED; PG8_LDA(At, 1, 0); PG8_STAGE(PG8_SA(0, 1), a2 + hstep, voffA);
            PG8_WAIT_V(8); PG8_WAIT_L(0); PG8_BAR; PG8_MMA(0, 0, At, B0); PG8_MMA(0, 1, At, B1); PG8_BAR; PG8_SCHED;
            PG8_LDA(At, 1, 1); PG8_STAGE(PG8_SB(1, 0), b3, voffB); PG8_STAGE(PG8_SB(1, 1), b3 + hstep, voffB); PG8_STAGE(PG8_SA(1, 0), a3, voffA);
            PG8_WAIT_V(8); PG8_WAIT_L(0); PG8_BAR; PG8_MMA(1, 0, At, B0); PG8_MMA(1, 1, At, B1); PG8_BAR; PG8_SCHED;
            } else {
            PG8_LDB(B0, 0, 0); PG8_SCHED; PG8_LDA(At, 0, 0); PG8_STAGE(PG8_SA(1, 1), a1 + hstep, voffA);
            PG8_WAIT_L(8); PG8_BAR; PG8_WAIT_L(0); PG8_MMA(0, 0, At, B0); PG8_BAR; PG8_SCHED;
            PG8_LDB(B1, 0, 1); PG8_STAGE(PG8_SB(0, 0), b2, voffB);
            PG8_BAR; PG8_WAIT_L(0); PG8_MMA(0, 1, At, B1); PG8_BAR;
            PG8_LDA(At, 0, 1); PG8_STAGE(PG8_SA(0, 0), a2, voffA);
            PG8_BAR; PG8_WAIT_L(0); PG8_MMA(1, 0, At, B0); PG8_BAR; PG8_SCHED;
            PG8_STAGE(PG8_SB(0, 1), b2 + hstep, voffB);
            PG8_WAIT_V(6); PG8_BAR; PG8_MMA(1, 1, At, B1); PG8_BAR;
            PG8_LDB(B0, 1, 0); PG8_SCHED; PG8_LDA(At, 1, 0); PG8_STAGE(PG8_SA(0, 1), a2 + hstep, voffA);
            PG8_WAIT_L(8); PG8_BAR; PG8_WAIT_L(0); PG8_MMA(0, 0, At, B0); PG8_BAR; PG8_SCHED;
            PG8_LDB(B1, 1, 1); PG8_STAGE(PG8_SB(1, 0), b3, voffB);
            PG8_BAR; PG8_WAIT_L(0); PG8_MMA(0, 1, At, B1); PG8_BAR;
            PG8_LDA(At, 1, 1); PG8_STAGE(PG8_SA(1, 0), a3, voffA);
            PG8_BAR; PG8_WAIT_L(0); PG8_MMA(1, 0, At, B0); PG8_BAR; PG8_SCHED;
            PG8_STAGE(PG8_SB(1, 1), b3 + hstep, voffB);
            PG8_WAIT_V(6); PG8_BAR; PG8_MMA(1, 1, At, B1); PG8_BAR;
            }
        }
        if constexpr (ALIGN_EPI) { if (wr == 0) PG8_BAR; }
        if constexpr (!Epi::AFTER_DRAIN) { if constexpr (Epi::PRE) E(acc, cur, wr, wc, fr, fq, epre); else E(acc, cur, wr, wc, fr, fq); S.done(cur); }
        if (!has_next) break;
#pragma unroll
        for (int a = 0; a < 2; ++a)
#pragma unroll
            for (int b = 0; b < 2; ++b)
#pragma unroll
                for (int m = 0; m < 4; ++m)
#pragma unroll
                    for (int n = 0; n < 2; ++n) acc[a][b][m][n] = (f32x4){0.f, 0.f, 0.f, 0.f};
        cur = nxt; cA = nA; cB = nB; ++ui;
        if constexpr (Epi::PRE) E.pre(epre, cur, wr, wc, fr, fq);
        if constexpr (ALIGN_EPI) { if (wr == 1) PG8_BAR; }
    }
    PG8_WAIT_V(0);
    if constexpr (!ALIGN_EPI) { if (wr == 0) PG8_BAR; }
    PG8_BAR;
    if constexpr (Epi::AFTER_DRAIN) { E.fused(acc, cur, wr, wc, fr, fq, lds, wid, lane); S.done(cur); }
#undef PG8_SA
#undef PG8_SB
#undef PG8_STAGE
#undef PG8_LDA
#undef PG8_LDB
#undef PG8_MMA
#undef PG8_WAIT_V
#undef PG8_WAIT_L
#undef PG8_BAR
#undef PG8_SCHED
}
}


namespace {
constexpr int B_ = 8, S_ = 4096, M_ = B_ * S_, D_ = 1024, DIN = 4288, DFF = 4096;
constexpr int C_QA = 0, C_QB = 512, C_QI = 1024, C_KVB = 1280, C_KA = 2048, C_VA = 2112, C_KI = 2176, C_WI = 2208, C_GB = 2216, C_GATE = 2304;
constexpr int NC = 255;
constexpr float EPS = 1e-6f;
using pg8::PW;
#define GAS __attribute__((address_space(1)))
#define LAS __attribute__((address_space(3)))
typedef unsigned v4u __attribute__((ext_vector_type(4)));
typedef float f32x4 __attribute__((ext_vector_type(4)));

__device__ __forceinline__ int t5_bucket(int n) {
    if (n < 16) return n < 0 ? 0 : n;
    float nf = (float)n;
    int large = 16 + (int)(logf(nf / 16.f) / logf(8.f) * 16.f);
    return large < 31 ? large : 31;
}


__device__ __forceinline__ int win_src_col(int n) {
    if (n < 512) return n;
    if (n < 1024) return 936 + (n - 512);
    if (n < 1280) return 640 + (n - 1024);
    if (n < 2048) return 1448 + (n - 1280);
    if (n < 2112) return 512 + (n - 2048);
    if (n < 2176) return 576 + (n - 2112);
    if (n < 2208) return 896 + (n - 2176);
    if (n < 2216) return 928 + (n - 2208);
    if (n < 2240) return n;
    if (n < 2304) return -1;
    { const int q = n - 2304, j = q >> 8, w = q & 255;
      return (w < 128) ? 2240 + 128 * j + w : 3264 + 128 * j + (w - 128); }
}
__device__ __forceinline__ float wave_sum(float v) {
    v += xchg_xor1(v); v += xchg_xor2(v);
    v += __int_as_float(__builtin_amdgcn_mov_dpp(__float_as_int(v), 0x124, 0xf, 0xf, true));
    v += __int_as_float(__builtin_amdgcn_mov_dpp(__float_as_int(v), 0x128, 0xf, 0xf, true));
    v = sum_xor16(v); v = sum_xor32(v);
    return v;
}
template <bool MAP>
__device__ __forceinline__ void transpose_item(const float* __restrict__ W, int K, int Nsrc, int Ndst, _Float16* __restrict__ WT, const float* __restrict__ gain, float* scr, int item, int lane, int dpitch = 0, int koff = 0) {
    const int nblk = Ndst / 32, kb = item / nblk, nb = item % nblk, k0 = 64 * kb, n0 = 32 * nb;
    const int c4 = lane & 7, nd = n0 + 4 * c4; const int ns = MAP ? win_src_col(nd) : nd;
#pragma unroll
    for (int i = 0; i < 8; ++i) { const int kk = 8 * i + (lane >> 3); f32x4 v = {0.f, 0.f, 0.f, 0.f};
        if (ns >= 0) { v = *(const f32x4*)(W + (size_t)(k0 + kk) * Nsrc + ns); if (gain) v = v * gain[k0 + kk]; }
        float* sp = scr + kk * 33 + 4 * c4; sp[0] = v.x; sp[1] = v.y; sp[2] = v.z; sp[3] = v.w; }
    __builtin_amdgcn_s_waitcnt(0xc07f); asm volatile("" ::: "memory");
    const int c = lane & 7;
#pragma unroll
    for (int j = 0; j < 4; ++j) { const int n = (lane >> 3) + 8 * j; const float* s = scr + (8 * c) * 33 + n;
        v4u o; o.x = pg8::pkh(s[0 * 33], s[1 * 33]); o.y = pg8::pkh(s[2 * 33], s[3 * 33]); o.z = pg8::pkh(s[4 * 33], s[5 * 33]); o.w = pg8::pkh(s[6 * 33], s[7 * 33]);
        *(v4u*)(WT + (size_t)(n0 + n) * (dpitch ? dpitch : K) + koff + k0 + 8 * c) = o; }
    __builtin_amdgcn_s_waitcnt(0xc07f); asm volatile("" ::: "memory");
}
__device__ __forceinline__ void rms_row_to_f16(const float* __restrict__ xrow, _Float16* __restrict__ orow, float* __restrict__ rinv, int lane) {
    const f32x4* xr = (const f32x4*)xrow + lane;
    f32x4 v[4]; float s = 0.f;
#pragma unroll
    for (int j = 0; j < 4; ++j) { v[j] = xr[64 * j]; s += (v[j].x * v[j].x + v[j].y * v[j].y) + (v[j].z * v[j].z + v[j].w * v[j].w); }
    const float ms = wave_sum(s) * (1.f / D_) + EPS; const float rstd = rsqrtf(ms);
    if (lane == 0) *rinv = ms * rstd;
    unsigned long long* o8 = (unsigned long long*)orow + lane;
#pragma unroll
    for (int j = 0; j < 4; ++j) o8[64 * j] = (unsigned long long)pg8::pkh(v[j].x * rstd, v[j].y * rstd) | ((unsigned long long)pg8::pkh(v[j].z * rstd, v[j].w * rstd) << 32);
}

struct Args {
    const float* x; const float* norm_mix; const float* w_in; const float* pe_k; const float* w1_k; const float* w2_k; const float* pe_v; const float* w1_v; const float* w2_v;
    const float* rel_bias; const float* w_ba; const float* w_bb; const float* w_out; const float* norm_mlp; const float* w_mi; const float* w_mo; const float* norm_final;
    float* out; unsigned char* ws;
};
constexpr size_t MiB = 1u << 20;
constexpr size_t WS_PCNT = 32768, WS_XBUF = 524288;
constexpr size_t WS_ROWSQ = 65536, WS_ROWSQ2 = 196608;
constexpr size_t WS_CTL = 0, WS_WIN = 1 * MiB, WS_WBA = 10 * MiB, WS_WBB = 11 * MiB, WS_WOUT = 12 * MiB, WS_WMI = 14 * MiB, WS_WMO = 22 * MiB, WS_CW = 30 * MiB,
                 WS_KCMP = 32 * MiB, WS_VCMP = 33 * MiB, WS_H = 34 * MiB, WS_PROJ = 98 * MiB, WS_MIX = 370 * MiB, WS_KIC = 434 * MiB, WS_OAB = 436 * MiB, WS_RINV = 500 * MiB, WS_END = 501 * MiB;

__device__ __forceinline__ void prologue_body(const Args& a, unsigned char* lds) {
    const int tid = threadIdx.x, lane = tid & 63, wave = tid >> 6;
    float* scr = (float*)(lds + wave * 8704);
    const int gw = blockIdx.x * 8 + wave, NGW = gridDim.x * 8;
    constexpr int I_IN = (D_ / 64) * (PW / 32);
    for (int it = gw; it < I_IN; it += NGW) transpose_item<true>(a.w_in, D_, DIN, PW, (_Float16*)(a.ws + WS_WIN), a.norm_mix, scr, it, lane);
#pragma unroll 4
    for (int m = gw; m < M_; m += NGW) rms_row_to_f16(a.x + (size_t)m * D_, (_Float16*)(a.ws + WS_H) + (size_t)m * D_, (float*)(a.ws + WS_RINV) + m, lane);
}
__device__ __forceinline__ void late_weights_body(const Args& a, unsigned char* lds) {
    const int tid = threadIdx.x, lane = tid & 63, wave = tid >> 6;
    float* scr = (float*)(lds + wave * 8704);
    const int gw = ((int)blockIdx.x - 128) * 8 + wave, NGW = 128 * 8;
    constexpr int I_BA = (512 / 64) * (D_ / 32), I_OUT = (D_ / 64) * (D_ / 32), I_MI = (D_ / 64) * (DFF / 32), I_MO = (DFF / 64) * (D_ / 32);
    constexpr int I_C1 = (2048 / 64) * (128 / 32), I_C2 = (128 / 64) * (64 / 32);
    constexpr int NITEMS = 2 * I_C1 + 2 * I_C2 + 2 * I_BA + I_OUT + I_MI + I_MO;
    for (int it = gw; it < NITEMS; it += NGW) {
        int r = it;
        if (r < I_C1) { transpose_item<false>(a.w1_k, 2048, 128, 128, (_Float16*)(a.ws + WS_CW), nullptr, scr, r, lane); continue; } r -= I_C1;
        if (r < I_C1) { transpose_item<false>(a.w1_v, 2048, 128, 128, (_Float16*)(a.ws + WS_CW + 512 * 1024), nullptr, scr, r, lane); continue; } r -= I_C1;
        if (r < I_C2) { transpose_item<false>(a.w2_k, 128, 64, 64, (_Float16*)(a.ws + WS_CW + 1024 * 1024), nullptr, scr, r, lane); continue; } r -= I_C2;
        if (r < I_C2) { transpose_item<false>(a.w2_v, 128, 64, 64, (_Float16*)(a.ws + WS_CW + 1024 * 1024 + 16384), nullptr, scr, r, lane); continue; } r -= I_C2;
        if (r < I_BA) { transpose_item<false>(a.w_ba, 512, D_, D_, (_Float16*)(a.ws + WS_WBA), nullptr, scr, r, lane, 1024, 0); continue; } r -= I_BA;
        if (r < I_BA) { transpose_item<false>(a.w_bb, 512, D_, D_, (_Float16*)(a.ws + WS_WBA), nullptr, scr, r, lane, 1024, 512); continue; } r -= I_BA;
        if (r < I_OUT) { transpose_item<false>(a.w_out, D_, D_, D_, (_Float16*)(a.ws + WS_WOUT), nullptr, scr, r, lane); continue; } r -= I_OUT;
        if (r < I_MI) { transpose_item<false>(a.w_mi, D_, DFF, DFF, (_Float16*)(a.ws + WS_WMI), a.norm_mlp, scr, r, lane); continue; } r -= I_MI;
        transpose_item<false>(a.w_mo, DFF, D_, D_, (_Float16*)(a.ws + WS_WMO), nullptr, scr, r, lane);
    }
}
struct EpiAccOut {
    static constexpr bool PERM = true, AFTER_DRAIN = false, MID = false, PRE = false;
    _Float16* x2h; const _Float16* xh; float* rowsq;
    __device__ __forceinline__ void operator()(const f32x4 (&acc)[2][2][4][2], const pg8::Unit& u, int wr, int wc, int fr, int fq) const {
        const int row0 = u.pm * 256 + wr * 64 + fr, col0 = u.pn * 256 + wc * 32 + 8 * fq;
#pragma unroll
        for (int ai = 0; ai < 2; ++ai)
#pragma unroll
            for (int m = 0; m < 4; ++m) { const size_t r = (size_t)(row0 + ai * 128 + m * 16); float sq = 0.f;
#pragma unroll
                for (int bj = 0; bj < 2; ++bj) { const size_t o = r * 1024 + col0 + bj * 128;
                    float p[8]; pg8::unpk8(*(const pg8::u32x4*)(xh + o), p);
                    const f32x4 a0 = acc[ai][bj][m][0], a1 = acc[ai][bj][m][1];
                    const float v[8] = {p[0] + a0[0], p[1] + a0[1], p[2] + a0[2], p[3] + a0[3], p[4] + a1[0], p[5] + a1[1], p[6] + a1[2], p[7] + a1[3]};
                    pg8::u32x4 w; w.x = pg8::pkh(v[0], v[1]); w.y = pg8::pkh(v[2], v[3]); w.z = pg8::pkh(v[4], v[5]); w.w = pg8::pkh(v[6], v[7]);
                    *(pg8::u32x4*)(x2h + o) = w;
                    sq += (v[0] * v[0] + v[1] * v[1]) + (v[2] * v[2] + v[3] * v[3]) + (v[4] * v[4] + v[5] * v[5]) + (v[6] * v[6] + v[7] * v[7]); }
                sq = sum_xor16(sq); sq = sum_xor32(sq);
                if (fq == 0) atomicAdd(rowsq + r, sq); }
    }
};
__device__ __forceinline__ void final_scale_row(const _Float16* __restrict__ xrow, float* __restrict__ orow, const float* __restrict__ g, float rsq, int lane) {
    const float rstd = rsqrtf(rsq * (1.f / D_) + EPS);
#pragma unroll
    for (int j = 0; j < 2; ++j) {
        float p[8]; pg8::unpk8(*((const pg8::u32x4*)xrow + lane + 64 * j), p);
        const f32x4 g0 = *((const f32x4*)g + 2 * (lane + 64 * j)), g1 = *((const f32x4*)g + 2 * (lane + 64 * j) + 1);
        *((f32x4*)orow + 2 * (lane + 64 * j)) = (f32x4){p[0] * rstd * g0.x, p[1] * rstd * g0.y, p[2] * rstd * g0.z, p[3] * rstd * g0.w};
        *((f32x4*)orow + 2 * (lane + 64 * j) + 1) = (f32x4){p[4] * rstd * g1.x, p[5] * rstd * g1.y, p[6] * rstd * g1.z, p[7] * rstd * g1.w};
    }
}

struct SliceOrder {
    pg8::StaticOrder S; int slice;
    __device__ bool next(int i, pg8::Unit& u) const { return i == 0 ? S.next(slice, u) : false; }
    __device__ __forceinline__ void a_ready(const pg8::Unit&) const {}
    __device__ __forceinline__ void done(const pg8::Unit&) const {}
};
struct EpiFinalNorm {
    static constexpr bool PERM = true, AFTER_DRAIN = true, MID = false, PRE = false;
    float* out; const _Float16* xh; const float* g; float* xbuf; unsigned* cnt;
    __device__ __forceinline__ void fused(f32x4 (&acc)[2][2][4][2], const pg8::Unit& u, int wr, int wc, int fr, int fq, PG8_LAS unsigned char* lds, int wid, int lane) const {
        const int rl0 = wr * 64 + fr, col0 = u.pn * 256 + wc * 32 + 8 * fq;
        PG8_LAS float* red = (PG8_LAS float*)lds;
#pragma unroll
        for (int ai = 0; ai < 2; ++ai) {
            pg8::u32x4 xw[4][2];
#pragma unroll
            for (int m = 0; m < 4; ++m)
#pragma unroll
                for (int bj = 0; bj < 2; ++bj) xw[m][bj] = *(const pg8::u32x4*)(xh + (size_t)(u.pm * 256 + rl0 + ai * 128 + m * 16) * 1024 + col0 + bj * 128);
#pragma unroll
            for (int m = 0; m < 4; ++m) { const int rl = rl0 + ai * 128 + m * 16; float sq = 0.f;
#pragma unroll
                for (int bj = 0; bj < 2; ++bj) { float p[8]; pg8::unpk8(xw[m][bj], p);
#pragma unroll
                    for (int i = 0; i < 4; ++i) { acc[ai][bj][m][0][i] += p[i]; acc[ai][bj][m][1][i] += p[4 + i];
                        sq = fmaf(acc[ai][bj][m][0][i], acc[ai][bj][m][0][i], sq); sq = fmaf(acc[ai][bj][m][1][i], acc[ai][bj][m][1][i], sq); } }
                sq = sum_xor16(sq); sq = sum_xor32(sq);
                if (fq == 0) red[wc * 256 + rl] = sq; }
        }
        __syncthreads();
        const int tid = wid * 64 + lane;
        if (tid < 256) { const float tot = (red[tid] + red[256 + tid]) + (red[512 + tid] + red[768 + tid]);
            __hip_atomic_store(xbuf + ((size_t)u.pm * 4 + u.pn) * 256 + tid, tot, __ATOMIC_RELAXED, __HIP_MEMORY_SCOPE_AGENT); }
        asm volatile("s_waitcnt vmcnt(0)" ::: "memory");
        __syncthreads();
        if (tid == 0) { __hip_atomic_fetch_add(cnt + u.pm, 1u, __ATOMIC_RELAXED, __HIP_MEMORY_SCOPE_AGENT);
            unsigned sp = 0; while (__hip_atomic_load(cnt + u.pm, __ATOMIC_RELAXED, __HIP_MEMORY_SCOPE_AGENT) < 4u && ++sp < (1u << 22)) __builtin_amdgcn_s_sleep(1); }
        __syncthreads();
        if (tid < 256) { float tot = 0.f;
#pragma unroll
            for (int q = 0; q < 4; ++q) tot += __hip_atomic_load(xbuf + ((size_t)u.pm * 4 + q) * 256 + tid, __ATOMIC_RELAXED, __HIP_MEMORY_SCOPE_AGENT);
            red[1024 + tid] = rsqrtf(tot * (1.f / 1024.f) + 1e-6f); }
        __syncthreads();
#pragma unroll
        for (int ai = 0; ai < 2; ++ai)
#pragma unroll
            for (int m = 0; m < 4; ++m) { const int rl = rl0 + ai * 128 + m * 16; const size_t r = (size_t)(u.pm * 256 + rl); const float rstd = red[1024 + rl];
#pragma unroll
                for (int bj = 0; bj < 2; ++bj) { const int c = col0 + bj * 128; const f32x4 g0 = *(const f32x4*)(g + c), g1 = *(const f32x4*)(g + c + 4);
                    *(f32x4*)(out + r * 1024 + c) = acc[ai][bj][m][0] * rstd * g0; *(f32x4*)(out + r * 1024 + c + 4) = acc[ai][bj][m][1] * rstd * g1; } }
        __syncthreads();
    }
};

namespace dsa {
typedef _Float16 f16x8 __attribute__((ext_vector_type(8)));
typedef _Float16 f16x4 __attribute__((ext_vector_type(4)));
typedef short s16x4 __attribute__((ext_vector_type(4)));
typedef float f32x4 __attribute__((ext_vector_type(4)));
typedef unsigned u32x4 __attribute__((ext_vector_type(4)));
typedef unsigned u32x2 __attribute__((ext_vector_type(2)));
constexpr int TQ = 16, NBIN = 2048, CANDCAP = 512, VPITCH = 144;
constexpr int L_HIST = 0, L_SEL = 65536, L_SELD = L_SEL + 8192, L_CTL = L_SELD + 8192, L_BIAS = L_CTL + 512, L_VST = L_BIAS + 4096, L_END = L_VST + 8 * 32 * VPITCH;
static_assert(L_END <= 131072, "dsa LDS");

template <bool FIRST>
__device__ __forceinline__ f16x8 relu_pack(const f32x4 lo, const f32x4 hi) {
    unsigned o0, o1, o2, o3;
    const float l0 = lo.x, l1 = lo.y, l2 = lo.z, l3 = lo.w, h0 = hi.x, h1 = hi.y, h2 = hi.z, h3 = hi.w;
    if (FIRST)
        asm volatile("s_nop 7\n\tv_cvt_pk_f16_f32 %0, %4, %5 clamp\n\tv_cvt_pk_f16_f32 %1, %6, %7 clamp\n\tv_cvt_pk_f16_f32 %2, %8, %9 clamp\n\tv_cvt_pk_f16_f32 %3, %10, %11 clamp"
                     : "=&v"(o0), "=&v"(o1), "=&v"(o2), "=&v"(o3) : "v"(l0), "v"(l1), "v"(l2), "v"(l3), "v"(h0), "v"(h1), "v"(h2), "v"(h3));
    else
        asm volatile("v_cvt_pk_f16_f32 %0, %4, %5 clamp\n\tv_cvt_pk_f16_f32 %1, %6, %7 clamp\n\tv_cvt_pk_f16_f32 %2, %8, %9 clamp\n\tv_cvt_pk_f16_f32 %3, %10, %11 clamp\n\ts_nop 1"
                     : "=&v"(o0), "=&v"(o1), "=&v"(o2), "=&v"(o3) : "v"(l0), "v"(l1), "v"(l2), "v"(l3), "v"(h0), "v"(h1), "v"(h2), "v"(h3));
    const u32x4 w = {o0, o1, o2, o3};
    return __builtin_bit_cast(f16x8, w);
}
__device__ __forceinline__ int score_bin(float sc) { int b = (int)sc; b = b < 0 ? 0 : b; return b > NBIN - 1 ? NBIN - 1 : b; }

template <int PASS, bool MASKED>
__device__ __forceinline__ void score_block(LAS unsigned char* lds, const f16x8 bfr, int s, int t0, int kc, const f16x8 (&afr)[4][2], const f16x8 (&wfr)[4], const int (&bst)[4]) {
    LAS unsigned* hist = (LAS unsigned*)(lds + L_HIST);
    LAS unsigned short* sel = (LAS unsigned short*)(lds + L_SEL);
    LAS unsigned short* seld = (LAS unsigned short*)(lds + L_SELD);
    LAS u32x2* cand = (LAS u32x2*)(lds + L_HIST);
    LAS int* ctl = (LAS int*)(lds + L_CTL);
    const f32x4 zero = {0.f, 0.f, 0.f, 0.f};
    const f32x4 off = {1024.f, 1024.f, 1024.f, 1024.f};
    f32x4 a1[4], a2[4];
#pragma unroll
    for (int grp = 0; grp < 4; ++grp) {
        a1[grp] = __builtin_amdgcn_mfma_f32_16x16x32_f16(afr[grp][0], bfr, zero, 0, 0, 0);
        a2[grp] = __builtin_amdgcn_mfma_f32_16x16x32_f16(afr[grp][1], bfr, zero, 0, 0, 0);
    }
    __builtin_amdgcn_sched_barrier(0);
    f16x8 rp[4];
    rp[0] = relu_pack<true>(a1[0], a2[0]); rp[1] = relu_pack<false>(a1[1], a2[1]); rp[2] = relu_pack<false>(a1[2], a2[2]); rp[3] = relu_pack<false>(a1[3], a2[3]);
    __builtin_amdgcn_sched_barrier(0);
    float sc[4];
    { const f32x4 c0 = __builtin_amdgcn_mfma_f32_16x16x32_f16(wfr[0], rp[0], off, 0, 0, 0); const f32x4 c1 = __builtin_amdgcn_mfma_f32_16x16x32_f16(wfr[1], rp[1], off, 0, 0, 0);
      const f32x4 c2 = __builtin_amdgcn_mfma_f32_16x16x32_f16(wfr[2], rp[2], off, 0, 0, 0); const f32x4 c3 = __builtin_amdgcn_mfma_f32_16x16x32_f16(wfr[3], rp[3], off, 0, 0, 0);
      sc[0] = c0.x; sc[1] = c1.y; sc[2] = c2.z; sc[3] = c3.w; }
    int bin[4]; bool ok[4];
#pragma unroll
    for (int grp = 0; grp < 4; ++grp) { bin[grp] = score_bin(sc[grp]); ok[grp] = MASKED ? (s <= t0 + 4 * grp + kc) : true; }
    if (PASS == 1) {
#pragma unroll
        for (int grp = 0; grp < 4; ++grp) { const int row = 4 * grp + kc;
            if (ok[grp]) __hip_atomic_fetch_add(hist + row * 1024 + (bin[grp] >> 1), (bin[grp] & 1) ? 0x10000u : 1u, __ATOMIC_RELAXED, __HIP_MEMORY_SCOPE_WORKGROUP); }
    } else {
        bool sg[4], cg[4]; int pos[4];
#pragma unroll
        for (int grp = 0; grp < 4; ++grp) { sg[grp] = ok[grp] && bin[grp] > bst[grp]; cg[grp] = ok[grp] && bin[grp] == bst[grp]; pos[grp] = 0; }
#pragma unroll
        for (int grp = 0; grp < 4; ++grp) { const int row = 4 * grp + kc;
            if (sg[grp]) pos[grp] = __hip_atomic_fetch_add(ctl + row * 8 + 0, 1, __ATOMIC_RELAXED, __HIP_MEMORY_SCOPE_WORKGROUP); }
#pragma unroll
        for (int grp = 0; grp < 4; ++grp) { const int row = 4 * grp + kc;
            if (sg[grp]) { sel[row * 256 + (pos[grp] & 255)] = (unsigned short)s; const int dd = t0 + row - s; seld[row * 256 + (pos[grp] & 255)] = (unsigned short)((dd > 127 ? 127 : dd) * 32); } }
        if (__any((cg[0] || cg[1]) || (cg[2] || cg[3]))) {
#pragma unroll
            for (int grp = 0; grp < 4; ++grp) { const int row = 4 * grp + kc;
                if (cg[grp]) { const int p = __hip_atomic_fetch_add(ctl + row * 8 + 1, 1, __ATOMIC_RELAXED, __HIP_MEMORY_SCOPE_WORKGROUP);
                    if (p < CANDCAP) { u32x2 e; e.x = __float_as_uint(sc[grp]); e.y = (unsigned)s; cand[row * CANDCAP + p] = e; } } }
        }
    }
}
template <int PASS>
__device__ __forceinline__ void score_pass(LAS unsigned char* lds, const _Float16* __restrict__ proj, int b, int t0, int nkb, int wave, int lane,
                                           const f16x8 (&afr)[4][2], const f16x8 (&wfr)[4]) {
    LAS int* ctl = (LAS int*)(lds + L_CTL);
    const int kc = lane >> 4, n16 = lane & 15;
    int bst[4];
#pragma unroll
    for (int grp = 0; grp < 4; ++grp) bst[grp] = (PASS == 2) ? ctl[(4 * grp + kc) * 8 + 2] : 0;
    const _Float16* kbase = (const _Float16*)((const char*)proj + ((long)WS_KIC - (long)WS_PROJ)) + (size_t)(b * S_ + n16) * 32 + 8 * kc;
    const int klast = nkb - 1;
#define DSA_KLOAD(kk) (*(const f16x8*)(kbase + (size_t)(16 * ((kk) < klast ? (kk) : klast)) * 32))
#define DSA_KSTEP(reg, kk) do { f16x8 bfr_ = reg * (_Float16)0.0625f; asm volatile("" : "+v"(bfr_)); reg = DSA_KLOAD((kk) + 32); if ((kk) < nkb) { const int s_ = 16 * (kk) + n16; \
        if ((kk) != klast) score_block<PASS, false>(lds, bfr_, s_, t0, kc, afr, wfr, bst); else score_block<PASS, true>(lds, bfr_, s_, t0, kc, afr, wfr, bst); } } while (0)
    f16x8 kb0 = DSA_KLOAD(wave); __builtin_amdgcn_sched_barrier(0);
    f16x8 kb1 = DSA_KLOAD(wave + 8); __builtin_amdgcn_sched_barrier(0);
    f16x8 kb2 = DSA_KLOAD(wave + 16); __builtin_amdgcn_sched_barrier(0);
    f16x8 kb3 = DSA_KLOAD(wave + 24); __builtin_amdgcn_sched_barrier(0);
#pragma unroll 1
    for (int kb = wave; kb < nkb; kb += 32) {
        DSA_KSTEP(kb0, kb); DSA_KSTEP(kb1, kb + 8); DSA_KSTEP(kb2, kb + 16); DSA_KSTEP(kb3, kb + 24);
    }
#undef DSA_KSTEP
#undef DSA_KLOAD
}

__device__ __forceinline__ unsigned wave_prefix_incl(unsigned x) {
    int v = (int)x;
    v += __builtin_amdgcn_update_dpp(0, v, 0x111, 0xf, 0xf, true);
    v += __builtin_amdgcn_update_dpp(0, v, 0x112, 0xf, 0xf, true);
    v += __builtin_amdgcn_update_dpp(0, v, 0x114, 0xf, 0xf, true);
    v += __builtin_amdgcn_update_dpp(0, v, 0x118, 0xf, 0xf, true);
    v += __builtin_amdgcn_update_dpp(0, v, 0x142, 0xa, 0xf, false);
    v += __builtin_amdgcn_update_dpp(0, v, 0x143, 0xc, 0xf, false);
    return (unsigned)v;
}
__device__ __forceinline__ unsigned wave_suffix_incl(unsigned x) {
    const unsigned p = wave_prefix_incl(x);
    const unsigned tot = (unsigned)__builtin_amdgcn_readlane((int)p, 63);
    return tot - p + x;
}

__device__ __forceinline__ void dsa_tile(LAS unsigned char* lds, const _Float16* __restrict__ proj, _Float16* __restrict__ o_a, int b, int qt) {
    int tid_ = threadIdx.x; asm volatile("" : "+v"(tid_));
    const int tid = tid_, lane = tid & 63, wave = __builtin_amdgcn_readfirstlane(tid >> 6);
    const int kc = lane >> 4, n16 = lane & 15;
    const int t0 = qt * TQ, nkb = qt + 1;
    LAS unsigned* hist = (LAS unsigned*)(lds + L_HIST);
    LAS unsigned short* sel = (LAS unsigned short*)(lds + L_SEL);
    LAS u32x2* cand = (LAS u32x2*)(lds + L_HIST);
    LAS int* ctl = (LAS int*)(lds + L_CTL);
    LAS float* biaslut = (LAS float*)(lds + L_BIAS);
    for (int i = tid; i < (TQ * 1024 + 4096) / 4; i += 512) ((LAS u32x4*)hist)[i] = (u32x4){0u, 0u, 0u, 0u};
    if (tid < TQ * 8) ctl[tid] = 0;
    f16x8 afr[4][2]; f16x8 wfr[4];
    { const int g = n16 >> 2, r = n16 & 3;
      const _Float16 qs = (_Float16)0.0625f;
#pragma unroll
      for (int grp = 0; grp < 4; ++grp) {
          const _Float16* qrow = proj + (size_t)(b * S_ + t0 + 4 * grp + g) * PW + C_QI;
          afr[grp][0] = *(const f16x8*)(qrow + r * 32 + 8 * kc) * qs;
          afr[grp][1] = *(const f16x8*)(qrow + (4 + r) * 32 + 8 * kc) * qs;
      }
      const f16x8 wv = *(const f16x8*)(proj + (size_t)(b * S_ + t0 + 4 * r + kc) * PW + C_WI);
      float wf[8]; float ss = 0.f;
#pragma unroll
      for (int h = 0; h < 8; ++h) { wf[h] = (float)wv[h] * (1.f / 16.f); ss = fmaf(wf[h], wf[h], ss); }
      const float sc2 = 32.f * 256.f * rsqrtf(ss + 1e-12f);
      f16x8 wrow;
#pragma unroll
      for (int h = 0; h < 8; ++h) wrow[h] = (g == kc) ? (_Float16)(wf[h] * sc2) : (_Float16)0.f;
      const f16x8 z8 = {0, 0, 0, 0, 0, 0, 0, 0};
#pragma unroll
      for (int grp = 0; grp < 4; ++grp) wfr[grp] = (r == grp) ? wrow : z8;
    }
    __syncthreads();
    score_pass<1>(lds, proj, b, t0, nkb, wave, lane, afr, wfr);
    __syncthreads();
#pragma unroll 1
    for (int i = 0; i < 2; ++i) {
        const int row = 2 * wave + i, n = t0 + row + 1;
        if (n <= 256) { if (lane == 0) { ctl[row * 8 + 2] = -1; ctl[row * 8 + 3] = 0; } }
        else {
            const LAS u32x4* hp = (const LAS u32x4*)(hist + row * 1024 + 16 * lane);
            unsigned tot = 0;
#pragma unroll
            for (int q4 = 0; q4 < 4; ++q4) { const u32x4 hv = hp[q4];
                tot += (hv.x & 0xffffu) + (hv.x >> 16) + (hv.y & 0xffffu) + (hv.y >> 16) + (hv.z & 0xffffu) + (hv.z >> 16) + (hv.w & 0xffffu) + (hv.w >> 16); }
            const unsigned suf = wave_suffix_incl(tot);
            const unsigned above_lane = suf - tot;
            const unsigned long long cross = __ballot(above_lane < 256u && suf >= 256u);
            const int lx = __builtin_ctzll(cross);
            const unsigned abovex = (unsigned)__builtin_amdgcn_readlane((int)above_lane, lx);
            const unsigned c2 = lane < 32 ? (unsigned)((const LAS unsigned short*)hist)[row * 2048 + 32 * lx + lane] : 0u;
            const unsigned suf2 = wave_suffix_incl(c2);
            const unsigned above2 = abovex + suf2 - c2;
            if (lane < 32 && above2 < 256u && above2 + c2 >= 256u) {
                const int bs = 32 * lx + lane; const unsigned cum = above2;
                ctl[row * 8 + 2] = bs; ctl[row * 8 + 3] = 256 - (int)cum;
            }
        }
    }
    __syncthreads();
    score_pass<2>(lds, proj, b, t0, nkb, wave, lane, afr, wfr);
    __syncthreads();
#pragma unroll 1
    for (int i = 0; i < 2; ++i) {
        const int row = 2 * wave + i, n = t0 + row + 1;
        const int need = ctl[row * 8 + 3], base = ctl[row * 8 + 0];
        int nc = ctl[row * 8 + 1];
        nc = nc < CANDCAP ? nc : CANDCAP;
        if (lane == 0) { const int nf = base + (need < nc ? need : nc); ctl[row * 8 + 4] = n <= 256 ? n : (nf < 256 ? nf : 256); }
        if (need > 0) {
            for (int c0 = 0; c0 < nc; c0 += 64) {
                const int ci = c0 + lane; const bool act = ci < nc;
                const u32x2 me = cand[row * CANDCAP + (act ? ci : 0)];
                const float msc = __uint_as_float(me.x); int rank = 0;
                for (int j = 0; j < nc; ++j) { const u32x2 ot = cand[row * CANDCAP + j]; const float osc = __uint_as_float(ot.x);
                    rank += (osc > msc || (osc == msc && ot.y < me.y)) ? 1 : 0; }
                if (act && rank < need) { sel[row * 256 + ((base + rank) & 255)] = (unsigned short)me.y; const int dd = t0 + row - (int)me.y; ((LAS unsigned short*)(lds + L_SELD))[row * 256 + ((base + rank) & 255)] = (unsigned short)((dd > 127 ? 127 : dd) * 32); }
            }
        }
    }
    __syncthreads();
    int tq_ = threadIdx.x; asm volatile("" : "+v"(tq_));
    const int lane_a = tq_ & 63;
    LAS unsigned char* vst = lds + L_VST + wave * (32 * VPITCH);
#pragma unroll 1
    for (int i = 0; i < 2; ++i) { const int lane = lane_a, kc = lane >> 4, n16 = lane & 15;
        const int row = 2 * wave + i, t = t0 + row; const int nvalid = ctl[row * 8 + 4];
        const _Float16* qrow = proj + (size_t)(b * S_ + t) * PW + C_QA;
        const int head = n16, hm = head & 7;
        f16x8 qb0, qb1;
        { const f16x8 z = {0, 0, 0, 0, 0, 0, 0, 0}; qb0 = z; qb1 = z;
          if (head < 8) { qb0 = *(const f16x8*)(qrow + head * 64 + 8 * kc); qb1 = *(const f16x8*)(qrow + head * 64 + 32 + 8 * kc); } }
        f32x4 ot[4];
#pragma unroll
        for (int dt = 0; dt < 4; ++dt) ot[dt] = (f32x4){0.f, 0.f, 0.f, 0.f};
        float mrun = -INFINITY, lrun = 0.f;
        const LAS unsigned short* selr = sel + row * 256;
        const LAS unsigned short* seldr = (const LAS unsigned short*)(lds + L_SELD) + row * 256;
        const LAS unsigned char* biasb = lds + L_BIAS + hm * 4;
        const _Float16* pbat = proj + (size_t)(b * S_) * PW;
        LAS unsigned char* kst = lds + L_HIST + wave * (32 * VPITCH);
        u32x4 gk[4], gv[4];
        const char* pbyte = (const char*)pbat;
#define DSA_GATHER(jj) do { unsigned ix_[4]; _Pragma("unroll") for (int i_ = 0; i_ < 4; ++i_) ix_[i_] = (unsigned)selr[32 * (jj) + 8 * i_ + (lane >> 3)]; \
        _Pragma("unroll") for (int i_ = 0; i_ < 4; ++i_) { const int pos_ = 32 * (jj) + 8 * i_ + (lane >> 3); \
            const unsigned idx_ = pos_ < nvalid ? ix_[i_] : 0u; const char* rp_ = pbyte + (size_t)(idx_ * (unsigned)(PW * 2) + (unsigned)(C_KA * 2 + 16 * (lane & 7))); \
            gk[i_] = *(const u32x4*)rp_; gv[i_] = *(const u32x4*)(rp_ + 128); } } while (0)
        DSA_GATHER(0);
        const int nsteps = (nvalid + 31) >> 5;
#pragma unroll 1
        for (int j = 0; j < nsteps; ++j) {
#pragma unroll
            for (int i_ = 0; i_ < 4; ++i_) { const int ro = (8 * i_ + (lane >> 3)) * VPITCH + 16 * (lane & 7);
                *(LAS u32x4*)(kst + ro) = gk[i_]; *(LAS u32x4*)(vst + ro) = gv[i_]; }
            if (j + 1 < nsteps) DSA_GATHER(j + 1);
            asm volatile("s_waitcnt lgkmcnt(0)" ::: "memory");
            const f16x8 ca0 = *(const LAS f16x8*)(kst + n16 * VPITCH + 16 * kc), ca1 = *(const LAS f16x8*)(kst + n16 * VPITCH + 64 + 16 * kc);
            const f16x8 cb0 = *(const LAS f16x8*)(kst + (16 + n16) * VPITCH + 16 * kc), cb1 = *(const LAS f16x8*)(kst + (16 + n16) * VPITCH + 64 + 16 * kc);
            f32x4 sa = {0.f, 0.f, 0.f, 0.f}, sb = {0.f, 0.f, 0.f, 0.f};
            sa = __builtin_amdgcn_mfma_f32_16x16x32_f16(ca0, qb0, sa, 0, 0, 0); sa = __builtin_amdgcn_mfma_f32_16x16x32_f16(ca1, qb1, sa, 0, 0, 0);
            sb = __builtin_amdgcn_mfma_f32_16x16x32_f16(cb0, qb0, sb, 0, 0, 0); sb = __builtin_amdgcn_mfma_f32_16x16x32_f16(cb1, qb1, sb, 0, 0, 0);
            const int p0 = 32 * j + 4 * kc;
            const u32x2 iwa = *(const LAS u32x2*)(seldr + p0), iwb = *(const LAS u32x2*)(seldr + p0 + 16);
            const unsigned wa0 = iwa.x, wa1 = iwa.y, wb0 = iwb.x, wb1 = iwb.y;
            const unsigned bo[8] = {wa0 & 0xffffu, wa0 >> 16, wa1 & 0xffffu, wa1 >> 16, wb0 & 0xffffu, wb0 >> 16, wb1 & 0xffffu, wb1 >> 16};
            float v[8] = {sa.x, sa.y, sa.z, sa.w, sb.x, sb.y, sb.z, sb.w};
            float tm = -INFINITY;
            if (nvalid == 256) {
#pragma unroll
                for (int e = 0; e < 8; ++e) { v[e] = fmaf(v[e], 0.125f, *(const LAS float*)(biasb + bo[e])); tm = fmaxf(tm, v[e]); }
            } else {
#pragma unroll
                for (int e = 0; e < 8; ++e) {
                    const bool ok = (p0 + (e & 3) + 16 * (e >> 2)) < nvalid;
                    const float lg = v[e] * 0.125f + *(const LAS float*)(biasb + bo[e]);
                    v[e] = ok ? lg : -INFINITY; tm = fmaxf(tm, v[e]);
                }
            }
            tm = max_xor16(tm); tm = max_xor32(tm);
            const float mn = fmaxf(mrun, tm);
            const float alpha = __expf(mrun - mn);
            float ps = 0.f;
#pragma unroll
            for (int e = 0; e < 8; ++e) { v[e] = __expf(v[e] - mn); ps += v[e]; }
            lrun = lrun * alpha + ps; mrun = mn;
#pragma unroll
            for (int dt = 0; dt < 4; ++dt) ot[dt] = ot[dt] * alpha;
            const f16x8 pfr = {(_Float16)v[0], (_Float16)v[1], (_Float16)v[2], (_Float16)v[3], (_Float16)v[4], (_Float16)v[5], (_Float16)v[6], (_Float16)v[7]};
            asm volatile("s_waitcnt lgkmcnt(0)" ::: "memory");
            const int q = n16 >> 2, p = n16 & 3;
#pragma unroll
            for (int dt = 0; dt < 4; ++dt) {
                const s16x4 ta = __builtin_amdgcn_ds_read_tr16_b64_v4i16((LAS s16x4*)(vst + (4 * kc + q) * VPITCH + (16 * dt + 4 * p) * 2));
                const s16x4 tb = __builtin_amdgcn_ds_read_tr16_b64_v4i16((LAS s16x4*)(vst + (16 + 4 * kc + q) * VPITCH + (16 * dt + 4 * p) * 2));
                const f16x4 fa = __builtin_bit_cast(f16x4, ta), fb = __builtin_bit_cast(f16x4, tb);
                const f16x8 vfr = {fa.x, fa.y, fa.z, fa.w, fb.x, fb.y, fb.z, fb.w};
                ot[dt] = __builtin_amdgcn_mfma_f32_16x16x32_f16(vfr, pfr, ot[dt], 0, 0, 0);
            }
            asm volatile("s_waitcnt lgkmcnt(0)" ::: "memory");
        }
#undef DSA_GATHER
        lrun = sum_xor16(lrun); lrun = sum_xor32(lrun);
        const float inv = 1.f / fmaxf(lrun, 1e-30f);
        if (head < 8) {
            _Float16* orow = o_a + (size_t)(b * S_ + t) * 1024 + head * 64 + 4 * kc;
#pragma unroll
            for (int dt = 0; dt < 4; ++dt) { u32x2 w; w.x = pg8::pkh(ot[dt].x * inv, ot[dt].y * inv); w.y = pg8::pkh(ot[dt].z * inv, ot[dt].w * inv); *(u32x2*)(orow + 16 * dt) = w; }
        }
    }
    __syncthreads();
}
}


namespace nsa {
typedef _Float16 f16x8 __attribute__((ext_vector_type(8)));
typedef _Float16 f16x4 __attribute__((ext_vector_type(4)));
typedef short s16x4 __attribute__((ext_vector_type(4)));
typedef float f32x4 __attribute__((ext_vector_type(4)));
typedef float f32x16 __attribute__((ext_vector_type(16)));
typedef unsigned u32x4 __attribute__((ext_vector_type(4)));
typedef unsigned u32x2 __attribute__((ext_vector_type(2)));
constexpr int KP = 144, VP = 192;
constexpr int TILE_B = 64 * KP + 64 * VP;
constexpr int L_T0 = 0, L_BIAS = 2 * TILE_B, L_IMPA = L_BIAS + 4096, L_IMPC = L_IMPA + 16384, L_MASK = L_IMPC + 16384, L_END = L_MASK + 512;
static_assert(L_END <= 131072, "nsa LDS");
constexpr float LOG2E = 1.4426950408889634f;
constexpr float SC = 0.125f * LOG2E;
__device__ __forceinline__ float max3f(float a, float b, float c) { float r; asm("v_max3_f32 %0, %1, %2, %3" : "=v"(r) : "v"(a), "v"(b), "v"(c)); return r; }

struct Src { const _Float16* k; const _Float16* v; int pitch; };

struct Stage { u32x4 kr, vr; };
__device__ __forceinline__ void stage_load(Stage& st, const Src& s, int row0, int tid, bool need_v) {
    const int r = tid >> 3, c = tid & 7;
    st.kr = *(const u32x4*)(s.k + (size_t)(row0 + r) * s.pitch + 8 * c);
    if (need_v) st.vr = *(const u32x4*)(s.v + (size_t)(row0 + r) * s.pitch + 8 * c);
}
__device__ __forceinline__ void stage_store(const Stage& st, LAS unsigned char* tb, int tid, bool need_v) {
    const int r = tid >> 3, c = tid & 7;
    *(LAS u32x4*)(tb + r * KP + 16 * c) = st.kr;
    if (need_v) *(LAS u32x4*)(tb + 64 * KP + r * VP + 16 * c) = st.vr;
}

struct RowState { float m; f32x4 lacc; f32x16 o0, o1; };
__device__ __forceinline__ float row_sum(const RowState& rs, int rho) {
    const float a = __shfl(rs.lacc[0], rho & 15), b = __shfl(rs.lacc[1], rho & 15);
    return (rho & 16) ? b : a;
}
__device__ __forceinline__ f16x8 ones_frag() {
    int l = threadIdx.x; asm volatile("" : "+v"(l));
    const int m = l & 15, c = (l >> 4) & 3;
    const _Float16 v = (m < 2 && (c & 1) == m) ? (_Float16)1.f : (_Float16)0.f;
    const f16x8 r = {v, v, v, v, v, v, v, v};
    return r;
}

__device__ __forceinline__ void qk_half(const LAS unsigned char* kt, const f16x8 (&qf)[4], int rho, int hi, int kh, f32x16& s0) {
#pragma unroll
    for (int i = 0; i < 16; ++i) s0[i] = 0.f;
    const LAS unsigned char* kb = kt + (32 * kh + rho) * KP + 16 * hi;
#pragma unroll
    for (int ks = 0; ks < 4; ++ks) {
        const f16x8 a0 = *(const LAS f16x8*)(kb + 32 * ks);
        s0 = __builtin_amdgcn_mfma_f32_32x32x16_f16(a0, qf[ks], s0, 0, 0, 0);
    }
}
__device__ __forceinline__ void logits(f32x16& s0, const LAS float* lut, int hb, int hi, int dbase, int dstep, int dlim, bool bit) {
#pragma unroll
    for (int rg = 0; rg < 16; ++rg) {
        const int kl = (rg & 3) + 8 * (rg >> 2) + 4 * hi;
        const int d = dbase - dstep * kl;
        int dc = d < 0 ? 0 : d; dc = dc > 127 ? 127 : dc;
        const float bias = lut[dc * 8 + hb];
        const bool ok = bit && d >= 0 && d < dlim;
        s0[rg] = ok ? fmaf(s0[rg], SC, bias) : -INFINITY;
    }
}
__device__ __forceinline__ void pv_half(RowState& rs, const f32x16& s0, const LAS unsigned char* vt, int rho, int hi, int kh) {
    const int l16 = rho & 15, g16 = rho >> 4, q = l16 >> 2, p = l16 & 3;
    const LAS unsigned char* vb = vt + (32 * kh + 4 * hi + q) * VP + (16 * g16 + 4 * p) * 2;
#pragma unroll
    for (int sx = 0; sx < 2; ++sx) {
        f16x8 pfr;
#pragma unroll
        for (int j = 0; j < 8; ++j) pfr[j] = (_Float16)s0[8 * sx + j];
#pragma unroll
        for (int dt = 0; dt < 2; ++dt) {
            const s16x4 ta = __builtin_amdgcn_ds_read_tr16_b64_v4i16((LAS s16x4*)(vb + (16 * sx) * VP + 64 * dt));
            const s16x4 tb = __builtin_amdgcn_ds_read_tr16_b64_v4i16((LAS s16x4*)(vb + (16 * sx + 8) * VP + 64 * dt));
            const f16x4 fa = __builtin_bit_cast(f16x4, ta), fb = __builtin_bit_cast(f16x4, tb);
            const f16x8 vfr = {fa.x, fa.y, fa.z, fa.w, fb.x, fb.y, fb.z, fb.w};
            if (dt == 0) rs.o0 = __builtin_amdgcn_mfma_f32_32x32x16_f16(vfr, pfr, rs.o0, 0, 0, 0);
            else rs.o1 = __builtin_amdgcn_mfma_f32_32x32x16_f16(vfr, pfr, rs.o1, 0, 0, 0);
        }
    }
}
__device__ __forceinline__ void rescale_if_needed(RowState& rs, float tmx) {
    if (__any(tmx > rs.m + 8.f)) {
        const float mn = fmaxf(rs.m, tmx);
        const float mu = (mn == -INFINITY) ? 0.f : mn;
        const float alpha = __builtin_amdgcn_exp2f(rs.m - mu);
        { int l_ = threadIdx.x; asm volatile("" : "+v"(l_)); const float a16 = __shfl(alpha, (l_ & 15) + 16); rs.lacc[0] *= alpha; rs.lacc[1] *= a16; } rs.m = mn;
#pragma unroll
        for (int i = 0; i < 16; ++i) { rs.o0[i] *= alpha; rs.o1[i] *= alpha; }
    }
}
__device__ __forceinline__ void tile_fast(RowState& rs, const LAS unsigned char* kt, const LAS unsigned char* vt, const f16x8 (&qf)[4], float c, int rho, int hi) {
    const LAS unsigned char* kb = kt + rho * KP + 16 * hi;
    f16x8 ka[4], kb2[4];
#pragma unroll
    for (int ks = 0; ks < 4; ++ks) { ka[ks] = *(const LAS f16x8*)(kb + 32 * ks); kb2[ks] = *(const LAS f16x8*)(kb + 32 * KP + 32 * ks); }
    const int l16 = rho & 15, g16 = rho >> 4, q = l16 >> 2, p = l16 & 3;
    const LAS unsigned char* vb = vt + (4 * hi + q) * VP + (16 * g16 + 4 * p) * 2;
    s16x4 va[4][2], vc[4][2];
    __builtin_amdgcn_sched_barrier(0);
    f32x16 s0, s1;
#pragma unroll
    for (int i = 0; i < 16; ++i) { s0[i] = 0.f; s1[i] = 0.f; }
#pragma unroll
    for (int ks = 0; ks < 4; ++ks) {
        s0 = __builtin_amdgcn_mfma_f32_32x32x16_f16(ka[ks], qf[ks], s0, 0, 0, 0);
        s1 = __builtin_amdgcn_mfma_f32_32x32x16_f16(kb2[ks], qf[ks], s1, 0, 0, 0);
    }
    __builtin_amdgcn_sched_barrier(0);
#pragma unroll
    for (int st = 0; st < 4; ++st)
#pragma unroll
        for (int dt = 0; dt < 2; ++dt) {
            va[st][dt] = __builtin_amdgcn_ds_read_tr16_b64_v4i16((LAS s16x4*)(vb + (16 * st) * VP + 64 * dt));
            vc[st][dt] = __builtin_amdgcn_ds_read_tr16_b64_v4i16((LAS s16x4*)(vb + (16 * st + 8) * VP + 64 * dt));
        }
    __builtin_amdgcn_sched_barrier(0);
    float tm = max3f(s0[0], s1[0], -INFINITY);
#pragma unroll
    for (int i = 1; i < 16; ++i) tm = max3f(tm, s0[i], s1[i]);
    { const auto r2 = __builtin_amdgcn_permlane32_swap(__float_as_uint(tm), __float_as_uint(tm), false, false); tm = fmaxf(__uint_as_float(r2[0]), __uint_as_float(r2[1])); }
    rescale_if_needed(rs, fmaf(tm, SC, c));
    const float mu = (rs.m == -INFINITY) ? 0.f : rs.m;
    const float cm = c - mu;
#pragma unroll
    for (int i = 0; i < 16; ++i) { s0[i] = __builtin_amdgcn_exp2f(fmaf(s0[i], SC, cm)); s1[i] = __builtin_amdgcn_exp2f(fmaf(s1[i], SC, cm)); }
    const f16x8 onesf = ones_frag();
#pragma unroll
    for (int st = 0; st < 4; ++st) {
        f16x8 pfr;
#pragma unroll
        for (int j = 0; j < 8; ++j) pfr[j] = (_Float16)((st & 2) ? s1[8 * (st & 1) + j] : s0[8 * (st & 1) + j]);
        rs.lacc = __builtin_amdgcn_mfma_f32_16x16x32_f16(onesf, pfr, rs.lacc, 0, 0, 0);
#pragma unroll
        for (int dt = 0; dt < 2; ++dt) {
            const f16x4 fa = __builtin_bit_cast(f16x4, va[st][dt]), fb = __builtin_bit_cast(f16x4, vc[st][dt]);
            const f16x8 vfr = {fa.x, fa.y, fa.z, fa.w, fb.x, fb.y, fb.z, fb.w};
            if (dt == 0) rs.o0 = __builtin_amdgcn_mfma_f32_32x32x16_f16(vfr, pfr, rs.o0, 0, 0, 0);
            else rs.o1 = __builtin_amdgcn_mfma_f32_32x32x16_f16(vfr, pfr, rs.o1, 0, 0, 0);
        }
    }
}
template <bool IMP>
__device__ __forceinline__ void tile_general(RowState& rs, const LAS unsigned char* kt, const LAS unsigned char* vt, const f16x8 (&qf)[4], const LAS float* lut, int hb, int rho, int hi,
                                             int dbase, int dstep, unsigned dlim, float mc, float invl, LAS float* impA, LAS float* impC, int n, bool wr) {
    const LAS unsigned char* kb = kt + rho * KP + 16 * hi;
    f16x8 ka[4], kb2[4];
#pragma unroll
    for (int ks = 0; ks < 4; ++ks) { ka[ks] = *(const LAS f16x8*)(kb + 32 * ks); kb2[ks] = *(const LAS f16x8*)(kb + 32 * KP + 32 * ks); }
    const int d0 = dbase - dstep * 4 * hi;
    __builtin_amdgcn_sched_barrier(0);
    f32x16 s0, s1;
#pragma unroll
    for (int i = 0; i < 16; ++i) { s0[i] = 0.f; s1[i] = 0.f; }
#pragma unroll
    for (int ks = 0; ks < 4; ++ks) {
        s0 = __builtin_amdgcn_mfma_f32_32x32x16_f16(ka[ks], qf[ks], s0, 0, 0, 0);
        s1 = __builtin_amdgcn_mfma_f32_32x32x16_f16(kb2[ks], qf[ks], s1, 0, 0, 0);
    }
    __builtin_amdgcn_sched_barrier(0);
    float b0[16], b1[16];
#pragma unroll
    for (int rg = 0; rg < 16; ++rg) {
        const int kl = (rg & 3) + 8 * (rg >> 2);
        int da = d0 - dstep * kl, db = d0 - dstep * (kl + 32);
        da = da < 0 ? 0 : da; da = da > 127 ? 127 : da; db = db < 0 ? 0 : db; db = db > 127 ? 127 : db;
        b0[rg] = lut[da * 8 + hb]; b1[rg] = lut[db * 8 + hb];
    }
    float tm = -INFINITY;
#pragma unroll
    for (int rg = 0; rg < 16; ++rg) {
        const int kl = (rg & 3) + 8 * (rg >> 2);
        const unsigned da = (unsigned)(d0 - dstep * kl), db = (unsigned)(d0 - dstep * (kl + 32));
        s0[rg] = da < dlim ? fmaf(s0[rg], SC, b0[rg]) : -INFINITY;
        s1[rg] = db < dlim ? fmaf(s1[rg], SC, b1[rg]) : -INFINITY;
        tm = max3f(tm, s0[rg], s1[rg]);
    }
    __builtin_amdgcn_sched_barrier(0);
    const int l16 = rho & 15, g16 = rho >> 4, q = l16 >> 2, p = l16 & 3;
    const LAS unsigned char* vb = vt + (4 * hi + q) * VP + (16 * g16 + 4 * p) * 2;
    s16x4 va[4][2], vc[4][2];
    if (!IMP) {
#pragma unroll
        for (int st = 0; st < 4; ++st)
#pragma unroll
            for (int dt = 0; dt < 2; ++dt) {
                va[st][dt] = __builtin_amdgcn_ds_read_tr16_b64_v4i16((LAS s16x4*)(vb + (16 * st) * VP + 64 * dt));
                vc[st][dt] = __builtin_amdgcn_ds_read_tr16_b64_v4i16((LAS s16x4*)(vb + (16 * st + 8) * VP + 64 * dt));
            }
        __builtin_amdgcn_sched_barrier(0);
    }
    if (!IMP) {
        { const auto r2 = __builtin_amdgcn_permlane32_swap(__float_as_uint(tm), __float_as_uint(tm), false, false); tm = fmaxf(__uint_as_float(r2[0]), __uint_as_float(r2[1])); }
        rescale_if_needed(rs, tm);
        const float mu = (rs.m == -INFINITY) ? 0.f : rs.m;
#pragma unroll
        for (int i = 0; i < 16; ++i) { s0[i] = __builtin_amdgcn_exp2f(s0[i] - mu); s1[i] = __builtin_amdgcn_exp2f(s1[i] - mu); }
        const f16x8 onesf = ones_frag();
#pragma unroll
        for (int st = 0; st < 4; ++st) {
            f16x8 pfr;
#pragma unroll
            for (int j = 0; j < 8; ++j) pfr[j] = (_Float16)((st & 2) ? s1[8 * (st & 1) + j] : s0[8 * (st & 1) + j]);
            rs.lacc = __builtin_amdgcn_mfma_f32_16x16x32_f16(onesf, pfr, rs.lacc, 0, 0, 0);
#pragma unroll
            for (int dt = 0; dt < 2; ++dt) {
                const f16x4 fa = __builtin_bit_cast(f16x4, va[st][dt]), fb = __builtin_bit_cast(f16x4, vc[st][dt]);
                const f16x8 vfr = {fa.x, fa.y, fa.z, fa.w, fb.x, fb.y, fb.z, fb.w};
                if (dt == 0) rs.o0 = __builtin_amdgcn_mfma_f32_32x32x16_f16(vfr, pfr, rs.o0, 0, 0, 0);
                else rs.o1 = __builtin_amdgcn_mfma_f32_32x32x16_f16(vfr, pfr, rs.o1, 0, 0, 0);
            }
        }
    } else {
        const float mu = (mc == -INFINITY) ? 0.f : mc;
#pragma unroll
        for (int kh = 0; kh < 2; ++kh)
#pragma unroll
            for (int ii = 0; ii < 4; ++ii) {
                float pv[4];
#pragma unroll
                for (int e = 0; e < 4; ++e) pv[e] = __builtin_amdgcn_exp2f((kh ? s1[4 * ii + e] : s0[4 * ii + e]) - mu) * invl;
                float a = (pv[0] + pv[1]) + (pv[2] + 0.5f * pv[3]), c = 0.5f * pv[3];
                a += xchg_xor1(a); a += xchg_xor2(a); c += xchg_xor1(c); c += xchg_xor2(c);
                const int nb = 16 * n + 8 * kh + 2 * ii + hi;
                if (wr) { impA[nb] = a; if (nb + 1 < 64) impC[nb + 1] = c; }
            }
    }
}
__device__ __forceinline__ void probs(RowState& rs, f32x16& s0, float sc, float c) {
    float tm = -INFINITY;
#pragma unroll
    for (int i = 0; i < 16; ++i) tm = fmaxf(tm, s0[i]);
    tm = fmaxf(tm, __shfl_xor(tm, 32));
    rescale_if_needed(rs, fmaf(tm, sc, c));
    const float mu = (rs.m == -INFINITY) ? 0.f : rs.m;
    const float cm = c - mu;
    float ps = 0.f;
#pragma unroll
    for (int i = 0; i < 16; ++i) { s0[i] = __builtin_amdgcn_exp2f(fmaf(s0[i], sc, cm)); ps += s0[i]; }
    rs.lacc[0] += ps;
}
__device__ __forceinline__ void rs_init(RowState& rs) { rs.m = -INFINITY; rs.lacc = (f32x4){0.f, 0.f, 0.f, 0.f};
#pragma unroll
    for (int i = 0; i < 16; ++i) { rs.o0[i] = 0.f; rs.o1[i] = 0.f; } }
template <int MODE>
__device__ __forceinline__ void rs_flush(RowState& rs, float gate, LAS unsigned char* accl, _Float16* orow) {
    int lf_ = threadIdx.x; asm volatile("" : "+v"(lf_));
    const float lt = row_sum(rs, lf_ & 31);
    const float w = gate / fmaxf(lt, 1e-30f);
#pragma unroll
    for (int i = 0; i < 4; ++i) {
        float a[8] = {w * rs.o0[4 * i], w * rs.o0[4 * i + 1], w * rs.o0[4 * i + 2], w * rs.o0[4 * i + 3], w * rs.o1[4 * i], w * rs.o1[4 * i + 1], w * rs.o1[4 * i + 2], w * rs.o1[4 * i + 3]};
        LAS unsigned char* ap = accl + (i >> 1) * 16384 + (i & 1) * 1024;
        if (MODE != 0) { float p[8]; pg8::unpk8(*(const LAS u32x4*)ap, p);
#pragma unroll
            for (int e = 0; e < 8; ++e) a[e] += p[e]; }
        u32x4 wv; wv.x = pg8::pkh(a[0], a[1]); wv.y = pg8::pkh(a[2], a[3]); wv.z = pg8::pkh(a[4], a[5]); wv.w = pg8::pkh(a[6], a[7]);
        if (MODE != 2) *(LAS u32x4*)ap = wv;
        else { u32x2 w0; w0.x = wv.x; w0.y = wv.y; u32x2 w1; w1.x = wv.z; w1.y = wv.w; *(u32x2*)(orow + 8 * i) = w0; *(u32x2*)(orow + 32 + 8 * i) = w1; }
    }
}

__device__ __forceinline__ void nsa_unit(LAS unsigned char* lds, const _Float16* __restrict__ proj, const _Float16* __restrict__ kcmp, const _Float16* __restrict__ vcmp,
                                         _Float16* __restrict__ o_b, int b, int g, int qb) {
    const int tid = threadIdx.x, lane = tid & 63, wave = __builtin_amdgcn_readfirstlane(tid >> 6);
    const int rho = lane & 31, hi = lane >> 5, ql = rho >> 2, r = rho & 3, hb = g * 4 + r;
    const int t = 64 * qb + 8 * wave + ql;
    const _Float16* prow = proj + (size_t)(b * S_ + t) * PW;
    f16x8 qf[4];
#pragma unroll
    for (int ks = 0; ks < 4; ++ks) qf[ks] = *(const f16x8*)(prow + C_QB + hb * 64 + 16 * ks + 8 * hi);
    for (int i = tid; i < 2048; i += 512) ((LAS u32x4*)(lds + L_IMPA))[i] = (u32x4){0u, 0u, 0u, 0u};
    RowState rs; rs_init(rs);
    const LAS float* lut = (const LAS float*)(lds + L_BIAS);
    const float bias31 = lut[127 * 8 + hb];
    const _Float16* kc = kcmp + (size_t)(b * 2 + g) * 256 * 64;
    const long vcoff = (vcmp + (size_t)(b * 2 + g) * 256 * 64) - kc;
    const _Float16* pb = proj + (size_t)(b * S_) * PW + C_KVB + g * 64;
    const int ncmp = (4 * qb + 3 + 63) / 64;
    const int wlo = qb - 8 > 0 ? qb - 8 : 0;
    const int e0 = ncmp, e1 = 2 * ncmp, e2 = e1 + qb + 1, NT = e2 + (qb - wlo + 1);
    const int sgrp = wave >> 2, tl = tid & 255, sr = tl >> 2, sq = tl & 3;
    float mc = 0.f, invl = 0.f; unsigned mlo = 0u, mhi = 0u;
    u32x4 sk0 = {0u, 0u, 0u, 0u}, sk1 = sk0, sv0 = sk0, sv1 = sk0;
#define NSA_DECODE(i, br, n) do { if ((i) < e0) { br = 0; n = (i); } else if ((i) < e1) { br = 1; n = (i) - e0; } else if ((i) < e2) { br = 2; n = (i) - e1; } else { br = 3; n = wlo + (i) - e2; } } while (0)
#define NSA_LOAD(i) do { int br_, n_; NSA_DECODE(i, br_, n_); const _Float16* kp_ = (br_ < 2) ? kc : (br_ == 2 ? pb + 2 * 128 : pb + 4 * 128); const int pitch_ = (br_ < 2) ? 64 : PW; \
        const long vo_ = (br_ < 2) ? vcoff : 128; const _Float16* rp_ = kp_ + (size_t)(64 * n_ + sr) * pitch_ + 16 * sq; \
        sk0 = *(const u32x4*)rp_; sk1 = *(const u32x4*)(rp_ + 8); sv0 = *(const u32x4*)(rp_ + vo_); sv1 = *(const u32x4*)(rp_ + vo_ + 8); } while (0)
#define NSA_STORE(buf) do { LAS unsigned char* tb_ = lds + L_T0 + (buf) * TILE_B; *(LAS u32x4*)(tb_ + sr * KP + 32 * sq) = sk0; *(LAS u32x4*)(tb_ + sr * KP + 32 * sq + 16) = sk1; \
        *(LAS u32x4*)(tb_ + 64 * KP + sr * VP + 32 * sq) = sv0; *(LAS u32x4*)(tb_ + 64 * KP + sr * VP + 32 * sq + 16) = sv1; } while (0)
    __syncthreads();
    asm volatile("" :: "v"(qf[0]), "v"(qf[1]), "v"(qf[2]), "v"(qf[3]), "v"(bias31));
    if (sgrp == 0) { NSA_LOAD(0); NSA_STORE(0); if (NT > 2) NSA_LOAD(2); } else if (NT > 1) NSA_LOAD(1);
    __syncthreads();
#pragma unroll 1
    for (int i = 0; i < NT; ++i) {
        int br, n; NSA_DECODE(i, br, n);
        const LAS unsigned char* tb = lds + L_T0 + (i & 1) * TILE_B;
        const bool more = i + 1 < NT;
        bool bit = true; int dbase, dstep = 1, dlim = 1 << 30; bool near = true;
        if (br < 2) { dbase = t - 31 - 1024 * n; dstep = 16; }
        else { dbase = t - 64 * n; near = n >= qb - 2; if (br == 2) bit = (n < 32) ? ((mlo >> n) & 1u) : ((mhi >> (n - 32)) & 1u); else dlim = 512; }
        const bool interior = (br >= 2) && (n <= qb - 3) && !(br == 3 && n == qb - 8);
        const bool skip = (br == 2) && !__any(bit);
        if (!skip) {
            if (interior) tile_fast(rs, tb, tb + 64 * KP, qf, bit ? bias31 : -INFINITY, rho, hi);
            else {
                const unsigned dl = bit ? (unsigned)dlim : 0u;
                int tq = threadIdx.x; asm volatile("" : "+v"(tq));
                LAS float* impA = (LAS float*)(lds + L_IMPA) + ((tq >> 6) * 8 + ((tq & 31) >> 2)) * 64;
                LAS float* impC = (LAS float*)(lds + L_IMPC) + ((tq >> 6) * 8 + ((tq & 31) >> 2)) * 64;
                if (br != 1) tile_general<false>(rs, tb, tb + 64 * KP, qf, lut, hb, rho, hi, dbase, dstep, dl, 0.f, 0.f, impA, impC, n, false);
                else tile_general<true>(rs, tb, tb + 64 * KP, qf, lut, hb, rho, hi, dbase, dstep, dl, mc, invl, impA, impC, n, r == 0);
            }
        }
        if (i + 1 == e0) {
            mc = rs.m; const float lc = row_sum(rs, rho); invl = 1.f / fmaxf(lc, 1e-30f);
        } else if (i + 1 == e1) {
            asm volatile("s_waitcnt lgkmcnt(0)" ::: "memory");
            int tq = threadIdx.x; asm volatile("" : "+v"(tq));
            const int qs = (tq & 63) >> 3, j = tq & 7, wv = tq >> 6;
            LAS float* sA = (LAS float*)(lds + L_IMPA) + (wv * 8 + qs) * 64;
            const LAS float* sC = (const LAS float*)(lds + L_IMPC) + (wv * 8 + qs) * 64;
            float sc[8];
#pragma unroll
            for (int e = 0; e < 8; ++e) { const int nn = 8 * j + e; const bool forced = (nn == 0) || (nn == qb) || (nn == qb - 1);
                sc[e] = (nn <= qb) ? (forced ? 1.0e4f : (sA[nn] + sC[nn])) : -INFINITY; }
            asm volatile("s_waitcnt lgkmcnt(0)" ::: "memory");
#pragma unroll
            for (int e = 0; e < 8; ++e) sA[8 * j + e] = sc[e];
            asm volatile("s_waitcnt lgkmcnt(0)" ::: "memory");
            int rank[8]; unsigned long long ke[8];
#pragma unroll
            for (int e = 0; e < 8; ++e) { rank[e] = 0; ke[e] = ((unsigned long long)__float_as_uint(sc[e]) << 32) | (unsigned)(63 - (8 * j + e)); }
#pragma unroll 1
            for (int m = 0; m <= qb; m += 4) { const f32x4 sv = *(const LAS f32x4*)(sA + m);
                const float sv4[4] = {sv.x, sv.y, sv.z, sv.w};
#pragma unroll
                for (int u = 0; u < 4; ++u) { const int mm = m + u;
                    const unsigned long long km = (mm <= qb) ? (((unsigned long long)__float_as_uint(sv4[u]) << 32) | (unsigned)(63 - mm)) : 0ull;
#pragma unroll
                    for (int e = 0; e < 8; ++e) rank[e] += (km > ke[e]) ? 1 : 0; } }
            unsigned bits = 0;
#pragma unroll
            for (int e = 0; e < 8; ++e) bits |= ((8 * j + e <= qb) && rank[e] < 16) ? (1u << e) : 0u;
            ((LAS unsigned char*)(lds + L_MASK))[(wv * 8 + qs) * 8 + j] = (unsigned char)bits;
            asm volatile("s_waitcnt lgkmcnt(0)" ::: "memory");
            const u32x2 mk = *(const LAS u32x2*)(lds + L_MASK + (wv * 8 + ((tq & 31) >> 2)) * 8);
            mlo = mk.x; mhi = mk.y;
            rs_flush<0>(rs, pg8::sigm((float)prow[C_GB + 0 * 8 + hb]), lds + L_IMPA + (tq >> 6) * 2048 + (tq & 63) * 16, nullptr); rs_init(rs);
        } else if (i + 1 == e2) {
            rs_flush<1>(rs, pg8::sigm((float)prow[C_GB + 1 * 8 + hb]), lds + L_IMPA + wave * 2048 + lane * 16, nullptr); rs_init(rs);
        } else if (i + 1 == NT) {
            rs_flush<2>(rs, pg8::sigm((float)prow[C_GB + 2 * 8 + hb]), lds + L_IMPA + wave * 2048 + lane * 16, o_b + (size_t)(b * S_ + t) * 1024 + hb * 64 + 4 * hi);
        }
        if (sgrp == ((i + 1) & 1)) {
            if (more) NSA_STORE((i + 1) & 1);
            if (i + 3 < NT) NSA_LOAD(i + 3);
        }
        asm volatile("s_waitcnt lgkmcnt(0)" ::: "memory");
        __builtin_amdgcn_s_barrier();
    }
#undef NSA_DECODE
#undef NSA_LOAD
#undef NSA_STORE
}
}


namespace cmpx {
typedef _Float16 f16x8 __attribute__((ext_vector_type(8)));
typedef float f32x4 __attribute__((ext_vector_type(4)));
typedef unsigned u32x4 __attribute__((ext_vector_type(4)));
constexpr int L_PART = 0, L_HID = 65536, HIDP = 272, L_END = L_HID + 16 * HIDP;
__device__ __forceinline__ void item(LAS unsigned char* lds, const _Float16* __restrict__ proj, const float* __restrict__ pe, const _Float16* __restrict__ w1t, const _Float16* __restrict__ w2t,
                                     _Float16* __restrict__ dst, int b, int g, int kv, int ct) {
    const int tid = threadIdx.x, lane = tid & 63, wave = __builtin_amdgcn_readfirstlane(tid >> 6), kc = lane >> 4, n16 = lane & 15;
    f32x4 acc[8];
#pragma unroll
    for (int nt = 0; nt < 8; ++nt) acc[nt] = (f32x4){0.f, 0.f, 0.f, 0.f};
    const int c = 16 * ct + n16;
#pragma unroll 2
    for (int ks = 0; ks < 8; ++ks) {
        const int k0 = 32 * (8 * wave + ks) + 8 * kc, lt = k0 >> 6, d = k0 & 63;
        int trow = 16 * c + lt; trow = trow > S_ - 1 ? S_ - 1 : trow;
        const f16x8 raw = *(const f16x8*)(proj + (size_t)(b * S_ + trow) * PW + C_KVB + kv * 128 + g * 64 + d);
        const f32x4 p0 = *(const f32x4*)(pe + lt * 64 + d), p1 = *(const f32x4*)(pe + lt * 64 + d + 4);
        f16x8 afr;
        afr[0] = (_Float16)((float)raw[0] + p0.x); afr[1] = (_Float16)((float)raw[1] + p0.y); afr[2] = (_Float16)((float)raw[2] + p0.z); afr[3] = (_Float16)((float)raw[3] + p0.w);
        afr[4] = (_Float16)((float)raw[4] + p1.x); afr[5] = (_Float16)((float)raw[5] + p1.y); afr[6] = (_Float16)((float)raw[6] + p1.z); afr[7] = (_Float16)((float)raw[7] + p1.w);
#pragma unroll
        for (int nt = 0; nt < 8; ++nt) {
            const f16x8 bfr = *(const f16x8*)(w1t + (size_t)(16 * nt + n16) * 2048 + k0);
            acc[nt] = __builtin_amdgcn_mfma_f32_16x16x32_f16(afr, bfr, acc[nt], 0, 0, 0);
        }
    }
    LAS float* part = (LAS float*)(lds + L_PART) + wave * 2048;
#pragma unroll
    for (int nt = 0; nt < 8; ++nt) { part[(4 * kc + 0) * 128 + 16 * nt + n16] = acc[nt].x; part[(4 * kc + 1) * 128 + 16 * nt + n16] = acc[nt].y;
        part[(4 * kc + 2) * 128 + 16 * nt + n16] = acc[nt].z; part[(4 * kc + 3) * 128 + 16 * nt + n16] = acc[nt].w; }
    __syncthreads();
    { const LAS float* pp = (const LAS float*)(lds + L_PART);
#pragma unroll
      for (int e = 0; e < 4; ++e) { const int o = tid + 512 * e; float a = 0.f;
#pragma unroll
          for (int w = 0; w < 8; ++w) a += pp[w * 2048 + o];
          const float z = 0.7978845608028654f * (a + 0.044715f * a * a * a);
          const float th = 1.f - 2.f / (__expf(2.f * z) + 1.f);
          ((LAS _Float16*)(lds + L_HID + (o >> 7) * HIDP))[o & 127] = (_Float16)(0.5f * a * (1.f + th)); } }
    __syncthreads();
    if (wave < 4) {
        f32x4 o = {0.f, 0.f, 0.f, 0.f};
#pragma unroll
        for (int ks = 0; ks < 4; ++ks) {
            const f16x8 afr = *(const LAS f16x8*)(lds + L_HID + n16 * HIDP + (32 * ks + 8 * kc) * 2);
            const f16x8 bfr = *(const f16x8*)(w2t + (size_t)(16 * wave + n16) * 128 + 32 * ks + 8 * kc);
            o = __builtin_amdgcn_mfma_f32_16x16x32_f16(afr, bfr, o, 0, 0, 0);
        }
        const float ov[4] = {o.x, o.y, o.z, o.w};
#pragma unroll
        for (int e = 0; e < 4; ++e) { const int cc = 16 * ct + 4 * kc + e; dst[((size_t)(b * 2 + g) * 256 + cc) * 64 + 16 * wave + n16] = (_Float16)(cc == 255 ? 0.f : ov[e]); }
    }
    __syncthreads();
}
}


#define XB_TMO      128
#define XB_XCNT(j)  (256  + 64 * (j))
#define XB_XSUB(j)  (1280 + 64 * (j))
#define XB_XGEN(j)  (2304 + 64 * (j))
#define XB_TOP      3328
#define XB_TOPGEN   3392
#define XCD_BAR_WORDS 3456
#define XB_SPIN_CAP (1u << 18)
__device__ __forceinline__ unsigned xb_ld(unsigned* p)              { return __hip_atomic_load(p, __ATOMIC_RELAXED, __HIP_MEMORY_SCOPE_AGENT); }
__device__ __forceinline__ unsigned xb_add(unsigned* p, unsigned v) { return __hip_atomic_fetch_add(p, v, __ATOMIC_RELAXED, __HIP_MEMORY_SCOPE_AGENT); }
__device__ __forceinline__ unsigned xb_xcc_id() { return (unsigned)__builtin_amdgcn_s_getreg((3 << 11) | 20) & 0xFu; }
#define XB_SPIN(cond, bar) do { unsigned _sp = 0; while (cond) { __builtin_amdgcn_s_sleep(1); \
    if ((++_sp & 255u) == 0u) { if (xb_ld(&(bar)[XB_TMO])) break; if (_sp > XB_SPIN_CAP) { atomicAdd(&(bar)[XB_TMO], 1u); break; } } } } while (0)
struct XcdBarrier { unsigned* bar; unsigned x; volatile LAS unsigned* st; };
__device__ __forceinline__ XcdBarrier xcd_barrier_post(unsigned* bar, volatile LAS unsigned* st) {
    XcdBarrier b; b.bar = bar; b.x = xb_xcc_id(); b.st = st;
    if (threadIdx.x == 0) (void)xb_add(&bar[XB_XCNT(b.x)], 1u);
    return b;
}
__device__ __forceinline__ void xcd_barrier_complete(unsigned* bar, unsigned x, unsigned& nloc, unsigned& nx) {
    const unsigned G = gridDim.x * gridDim.y * gridDim.z;
    unsigned sum, cnt, mine, sp = 0u;
    for (;;) {
        sum = 0u; cnt = 0u; mine = 0u;
#pragma unroll
        for (unsigned j = 0; j < 16; ++j) { const unsigned c = xb_ld(&bar[XB_XCNT(j)]); sum += c; cnt += (c > 0u) ? 1u : 0u; mine = (j == x) ? c : mine; }
        if (sum == G) break;
        __builtin_amdgcn_s_sleep(1);
        if ((++sp & 255u) == 0u) { if (xb_ld(&bar[XB_TMO])) break; if (sp > XB_SPIN_CAP) { atomicAdd(&bar[XB_TMO], 1u); break; } }
    }
    nloc = mine > 0u ? mine : 1u; nx = cnt > 0u ? cnt : 1u;
}
__device__ __forceinline__ void xcd_barrier(const XcdBarrier& b) {
    asm volatile("s_waitcnt vmcnt(0)" ::: "memory");
    __syncthreads();
    if (threadIdx.x == 0) {
        unsigned* bar = b.bar;
        __builtin_amdgcn_s_waitcnt(0);
        unsigned nloc = b.st[0], nx = b.st[1];
        if (nloc == 0u) { xcd_barrier_complete(bar, b.x, nloc, nx); b.st[0] = nloc; b.st[1] = nx; }
        const unsigned old = xb_add(&bar[XB_XSUB(b.x)], 1u);
        const unsigned gen = old / nloc;
        if (old + 1u == (gen + 1u) * nloc) {
            __builtin_amdgcn_fence(__ATOMIC_RELEASE, "agent");
            asm volatile("s_waitcnt vmcnt(0)" ::: "memory");
            const unsigned og = xb_add(&bar[XB_TOP], 1u);
            const unsigned tg = og / nx;
            if (og + 1u == (tg + 1u) * nx) xb_add(&bar[XB_TOPGEN], 1u);
            else XB_SPIN(xb_ld(&bar[XB_TOPGEN]) == tg, bar);
            __builtin_amdgcn_fence(__ATOMIC_ACQUIRE, "agent");
            xb_add(&bar[XB_XGEN(b.x)], 1u);
            asm volatile("s_waitcnt vmcnt(0)" ::: "memory");
        } else {
            XB_SPIN(xb_ld(&bar[XB_XGEN(b.x)]) == gen, bar);
            __builtin_amdgcn_fence(__ATOMIC_ACQUIRE, "agent");
            asm volatile("s_waitcnt vmcnt(0)" ::: "memory");
        }
    }
    __syncthreads();
}

constexpr int MEGA_LDS = 131072 + 256;

template <class Epi>
__device__ __forceinline__ void gemm_run(LAS unsigned char* lds, const void* A, const void* Bt, const Epi& E, int M, int N, int K) {
    pg8::Gemm g{(const pg8::bf16_t*)A, (const pg8::bf16_t*)Bt, M, N, K};
    pg8::StaticOrder S; S.init(M, N, (int)gridDim.x, (int)blockIdx.x);
    pg8::gemm_phase<Epi, pg8::StaticOrder, true, true>(lds, g, S, E);
}

__global__ void __launch_bounds__(512, 2) mega_fwd(Args a) {
    extern __shared__ __attribute__((aligned(16))) unsigned char lds_raw[];
    LAS unsigned char* lds = (LAS unsigned char*)lds_raw;
    unsigned char* ws = a.ws;
    if (threadIdx.x == 0) *(LAS dsa::u32x4*)(lds + 131072) = (dsa::u32x4){0u, 0u, 0u, 0u};
    __syncthreads();
    XcdBarrier bar = xcd_barrier_post((unsigned*)(ws + WS_CTL), (volatile LAS unsigned*)(lds + 131072));
    const _Float16* proj = (const _Float16*)(ws + WS_PROJ);
    _Float16* o_a = (_Float16*)(ws + WS_OAB); _Float16* o_b = (_Float16*)(ws + WS_OAB) + 512;
    _Float16* kcmp = (_Float16*)(ws + WS_KCMP); _Float16* vcmp = (_Float16*)(ws + WS_VCMP);

    prologue_body(a, lds_raw);
    xcd_barrier(bar);
    gemm_run(lds, ws + WS_H, ws + WS_WIN, pg8::EpiProj{(_Float16*)(ws + WS_PROJ), (_Float16*)(ws + WS_KIC)}, M_, PW, D_);
    if (blockIdx.x >= 128) late_weights_body(a, lds_raw);
    xcd_barrier(bar);
#pragma unroll 1
    for (int it = blockIdx.x; it < 512; it += gridDim.x) { const int ct = it & 15, kv = (it >> 4) & 1, g = (it >> 5) & 1, b = it >> 6;
        cmpx::item(lds, proj, kv ? a.pe_v : a.pe_k, (const _Float16*)(ws + WS_CW + (kv ? 512 * 1024 : 0)), (const _Float16*)(ws + WS_CW + 1024 * 1024 + (kv ? 16384 : 0)), kv ? vcmp : kcmp, b, g, kv, ct); }
    { LAS float* biaslut = (LAS float*)(lds + dsa::L_BIAS);
      for (int i = threadIdx.x; i < 1024; i += 512) { const int d = i >> 3, h = i & 7; biaslut[i] = a.rel_bias[t5_bucket(d) * 16 + h]; } }
    __syncthreads();
#pragma unroll 1
    for (int v = blockIdx.x >> 3; v < 256; v += (gridDim.x >> 3)) { const int b = blockIdx.x & 7, j = v & 127;
        dsa::dsa_tile(lds, proj, o_a, b, (v < 128) ? 255 - j : j); }
    xcd_barrier(bar);
    { LAS float* lut = (LAS float*)(lds + nsa::L_BIAS);
      for (int i = threadIdx.x; i < 1024; i += 512) { const int d = i >> 3, h = i & 7; lut[i] = a.rel_bias[t5_bucket(d) * 16 + 8 + h] * nsa::LOG2E; } }
    __syncthreads();
#pragma unroll 1
    for (int v = blockIdx.x >> 3; v < 128; v += (gridDim.x >> 3)) { const int bg = 2 * (blockIdx.x & 7) + (v >> 6), j = v & 31;
        nsa::nsa_unit(lds, proj, kcmp, vcmp, o_b, bg >> 1, bg & 1, (v & 32) ? j : 63 - j);
        __syncthreads(); }
    xcd_barrier(bar);
    gemm_run(lds, ws + WS_OAB, ws + WS_WBA, pg8::EpiMixF{(_Float16*)(ws + WS_MIX), proj}, M_, D_, D_);
    xcd_barrier(bar);
    gemm_run(lds, ws + WS_MIX, ws + WS_WOUT, pg8::EpiResidSq{(const float*)(ws + WS_RINV), (_Float16*)(ws + WS_H), (float*)(ws + WS_ROWSQ)}, M_, D_, D_);
    xcd_barrier(bar);
    gemm_run(lds, ws + WS_H, ws + WS_WMI, pg8::EpiRelu2N{(_Float16*)(ws + WS_PROJ), (const float*)(ws + WS_ROWSQ)}, M_, DFF, D_);
    xcd_barrier(bar);
#pragma unroll 1
    for (int sl = 0; sl < 2; ++sl) {
        pg8::Gemm g{(const pg8::bf16_t*)(ws + WS_PROJ), (const pg8::bf16_t*)(ws + WS_WMO), M_, D_, DFF};
        SliceOrder SO; SO.S.init(M_, D_, (int)gridDim.x, (int)blockIdx.x); SO.slice = sl;
        pg8::gemm_phase<EpiFinalNorm, SliceOrder, false, true>(lds, g, SO, EpiFinalNorm{a.out, (const _Float16*)(ws + WS_H), a.norm_final, (float*)(ws + WS_XBUF), (unsigned*)(ws + WS_PCNT)});
        __syncthreads();
    }
}
}

extern "C" void kernel_launch(void* const* d_in, const int* in_sizes, int n_in, void* d_out, int out_size, void* d_ws, size_t ws_size, hipStream_t stream) {
    if (ws_size < WS_END) { fprintf(stderr, "ws too small: %zu\n", ws_size); return; }
    static int grid = 0;
    if (!grid) {
        int dev = 0, cus = 0, per_cu = 0;
        (void)hipGetDevice(&dev);
        (void)hipDeviceGetAttribute(&cus, hipDeviceAttributeMultiprocessorCount, dev);
        (void)hipFuncSetAttribute((const void*)mega_fwd, hipFuncAttributeMaxDynamicSharedMemorySize, MEGA_LDS);
        (void)hipOccupancyMaxActiveBlocksPerMultiprocessor(&per_cu, (const void*)mega_fwd, 512, MEGA_LDS);
        (void)hipGetLastError();
        grid = cus;
        if (per_cu < 1) fprintf(stderr, "occupancy query says %d blocks/CU\n", per_cu);
        if (cus != 256) { fprintf(stderr, "kernel_launch: built for a 256-CU device (the last GEMM's row-panel exchange needs exactly 256 workgroups); found %d CUs, nothing launched\n", cus); grid = -1; }
    }
    if (grid < 0) return;
    Args a{};
    a.x = (const float*)d_in[0]; a.norm_mix = (const float*)d_in[1]; a.w_in = (const float*)d_in[2];
    a.pe_k = (const float*)d_in[3]; a.w1_k = (const float*)d_in[4]; a.w2_k = (const float*)d_in[5];
    a.pe_v = (const float*)d_in[6]; a.w1_v = (const float*)d_in[7]; a.w2_v = (const float*)d_in[8];
    a.rel_bias = (const float*)d_in[9]; a.w_ba = (const float*)d_in[10]; a.w_bb = (const float*)d_in[11];
    a.w_out = (const float*)d_in[12]; a.norm_mlp = (const float*)d_in[13]; a.w_mi = (const float*)d_in[14];
    a.w_mo = (const float*)d_in[15]; a.norm_final = (const float*)d_in[16];
    a.out = (float*)d_out; a.ws = (unsigned char*)d_ws;
    (void)hipMemsetAsync(d_ws, 0, 327680, stream);
    hipLaunchKernelGGL(mega_fwd, dim3(grid), dim3(512), MEGA_LDS, stream, a);
}
```

```cpp
#include <hip/hip_runtime.h>
#include <hip/hip_fp16.h>
#include <cstdint>
#include <cstdio>

__device__ __forceinline__ float xchg_xor1(float v) { return __int_as_float(__builtin_amdgcn_mov_dpp(__float_as_int(v), 0xB1, 0xf, 0xf, true)); }
__device__ __forceinline__ float xchg_xor2(float v) { return __int_as_float(__builtin_amdgcn_mov_dpp(__float_as_int(v), 0x4E, 0xf, 0xf, true)); }
__device__ __forceinline__ float max_xor16(float v) { const auto r = __builtin_amdgcn_permlane16_swap(__float_as_uint(v), __float_as_uint(v), false, false); return fmaxf(__uint_as_float(r[0]), __uint_as_float(r[1])); }
__device__ __forceinline__ float sum_xor16(float v) { const auto r = __builtin_amdgcn_permlane16_swap(__float_as_uint(v), __float_as_uint(v), false, false); return __uint_as_float(r[0]) + __uint_as_float(r[1]); }
__device__ __forceinline__ float sum_xor32(float v) { const auto r = __builtin_amdgcn_permlane32_swap(__float_as_uint(v), __float_as_uint(v), false, false); return __uint_as_float(r[0]) + __uint_as_float(r[1]); }
__device__ __forceinline__ float max_xor32(float v) { const auto r = __builtin_amdgcn_permlane32_swap(__float_as_uint(v), __float_as_uint(v), false, false); return fmaxf(__uint_as_float(r[0]), __uint_as_float(r[1])); }
namespace pg8 {
#define PG8_LAS __attribute__((address_space(3)))
typedef unsigned short bf16_t;
typedef _Float16 bf16x8 __attribute__((ext_vector_type(8)));
typedef float f32x4 __attribute__((ext_vector_type(4)));
typedef unsigned u32x4 __attribute__((ext_vector_type(4)));
constexpr int BM = 256, BK = 64, HALF = 128, HTB = HALF * BK * 2  , STAGE_BYTES = 8 * HTB, NXCD = 8, WGM = 8;

__host__ __device__ __forceinline__ int lds_byte(int r, int c) { const int st = (r >> 4) * 2 + (c >> 5), rr = r & 15, cc = c & 31, ob = rr * 64 + cc * 2; return st * 1024 + (ob ^ (((ob >> 9) & 1) << 5)); }
__host__ __device__ __forceinline__ void stage_rc(int b, int& R, int& C) { const int st = b / 1024, sb = b % 1024, swz = sb ^ (((sb >> 9) & 1) << 5); R = (st >> 1) * 16 + swz / 64; C = (st & 1) * 32 + (swz % 64) / 2; }
__host__ __device__ __forceinline__ int perm32(int rho) { const int n = rho >> 4, i = rho & 15; return 8 * (i >> 2) + 4 * n + (i & 3); }

struct Unit { int pm, pn; };
struct Gemm { const bf16_t* A; const bf16_t* Bt; int M, N, K; };

struct StaticOrder {
    int nM, nN, nwg, G, c;
    __host__ __device__ void init(int M, int N, int G_, int c_) { nM = M / BM; nN = N / BM; nwg = nM * nN; G = G_; c = c_; }
    __host__ __device__ bool next(int i, Unit& u) const {
        const long L = (long)i * G + c; if (L >= nwg) return false;
        int wgid = (int)L; { const int q = nwg / NXCD, r = nwg % NXCD, xcd = wgid % NXCD, off = wgid / NXCD; wgid = (xcd < r ? xcd * (q + 1) : r * (q + 1) + (xcd - r) * q) + off; }
        const int nig = WGM * nN, gid = wgid / nig, fm = gid * WGM, gsz = (nM - fm) < WGM ? (nM - fm) : WGM;
        u.pm = fm + ((wgid % nig) % gsz); u.pn = (wgid % nig) / gsz; return true;
    }
    __device__ __forceinline__ void a_ready(const Unit&) const {}
    __device__ __forceinline__ void done(const Unit&) const {}
};


typedef unsigned u32x2 __attribute__((ext_vector_type(2)));
typedef float f32x2 __attribute__((ext_vector_type(2)));
typedef _Float16 f16x2 __attribute__((ext_vector_type(2)));
constexpr int PW = 4352;
__device__ __forceinline__ unsigned pkh(float a, float b) { f32x2 v = {a, b}; f16x2 h = __builtin_convertvector(v, f16x2); return __builtin_bit_cast(unsigned, h); }
__device__ __forceinline__ float sigm(float v) { return __builtin_amdgcn_rcpf(1.f + __expf(-v)); }
__device__ __forceinline__ float sigm_gate(float v) { return fmaxf(sigm(v), 6.2e-5f); }
__device__ __forceinline__ void unpk8(const u32x4 w, float (&f)[8]) {
#pragma unroll
    for (int i = 0; i < 4; ++i) { const unsigned wi = (i == 0) ? w.x : (i == 1) ? w.y : (i == 2) ? w.z : w.w; const f16x2 h = __builtin_bit_cast(f16x2, wi); f[2 * i] = (float)h.x; f[2 * i + 1] = (float)h.y; } }

struct EpiProj {
    static constexpr bool PERM = true, AFTER_DRAIN = false, MID = false, PRE = false;
    _Float16* O; _Float16* KI;
    __device__ __forceinline__ void operator()(const f32x4 (&acc)[2][2][4][2], const Unit& u, int wr, int wc, int fr, int fq) const {
        const int row0 = u.pm * BM + wr * 64 + fr, col0 = u.pn * BM + wc * 32 + 8 * fq; const bool sg = u.pn >= 9;
        const bool ki = (u.pn == 8) && (wc == 0);
#pragma unroll
        for (int ai = 0; ai < 2; ++ai)
#pragma unroll
            for (int m = 0; m < 4; ++m) { _Float16* rowp = O + (size_t)(row0 + ai * HALF + m * 16) * PW + col0;
#pragma unroll
                for (int bj = 0; bj < 2; ++bj) { f32x4 v0 = acc[ai][bj][m][0], v1 = acc[ai][bj][m][1];
                    if (sg) {
                        const f32x4 b0 = acc[ai][1][m][0], b1 = acc[ai][1][m][1];
#pragma unroll
                        for (int i = 0; i < 4; ++i) { const float g0 = sigm_gate(b0[i]), g1 = sigm_gate(b1[i]);
                            v0[i] = bj ? g0 : sigm(v0[i]) * __builtin_amdgcn_rcpf(g0); v1[i] = bj ? g1 : sigm(v1[i]) * __builtin_amdgcn_rcpf(g1); } }
                    u32x4 w; w.x = pkh(v0[0], v0[1]); w.y = pkh(v0[2], v0[3]); w.z = pkh(v1[0], v1[1]); w.w = pkh(v1[2], v1[3]);
                    *(u32x4*)(rowp + bj * HALF) = w;
                    if (bj == 1 && ki) *(u32x4*)(KI + (size_t)(row0 + ai * HALF + m * 16) * 32 + 8 * fq) = w; } }
    }
};
struct EpiMixF {
    static constexpr bool PERM = true, AFTER_DRAIN = false, MID = true, PRE = false;
    _Float16* mix; const _Float16* proj;
    __device__ __forceinline__ void mid(f32x4 (&acc)[2][2][4][2], const Unit& u, int wr, int wc, int fr, int fq) const {
        int row0 = u.pm * BM + wr * 64 + fr, col0 = wc * 32 + 8 * fq;
        asm volatile("" : "+v"(row0), "+v"(col0));
#pragma unroll
        for (int ai = 0; ai < 2; ++ai) {
            u32x4 wr4[4][2];
#pragma unroll
            for (int m = 0; m < 4; ++m)
#pragma unroll
                for (int bj = 0; bj < 2; ++bj) wr4[m][bj] = *(const u32x4*)(proj + (size_t)(row0 + ai * HALF + m * 16) * PW + 2304 + 256 * (2 * u.pn + bj) + col0);
#pragma unroll
            for (int m = 0; m < 4; ++m)
#pragma unroll
                for (int bj = 0; bj < 2; ++bj) { float rr[8]; unpk8(wr4[m][bj], rr);
#pragma unroll
                    for (int i = 0; i < 4; ++i) { acc[ai][bj][m][0][i] *= rr[i]; acc[ai][bj][m][1][i] *= rr[4 + i]; } }
            __builtin_amdgcn_sched_barrier(0);
        }
    }
    __device__ __forceinline__ void operator()(const f32x4 (&acc)[2][2][4][2], const Unit& u, int wr, int wc, int fr, int fq) const {
        const int row0 = u.pm * BM + wr * 64 + fr, col0 = u.pn * BM + wc * 32 + 8 * fq;
#pragma unroll
        for (int ai = 0; ai < 2; ++ai) {
            u32x4 gw[4][2];
#pragma unroll
            for (int m = 0; m < 4; ++m)
#pragma unroll
                for (int bj = 0; bj < 2; ++bj) gw[m][bj] = *(const u32x4*)(proj + (size_t)(row0 + ai * HALF + m * 16) * PW + 2304 + 256 * (2 * u.pn + bj) + 128 + (wc * 32 + 8 * fq));
#pragma unroll
            for (int m = 0; m < 4; ++m) { const size_t r = (size_t)(row0 + ai * HALF + m * 16);
#pragma unroll
                for (int bj = 0; bj < 2; ++bj) { const int c = col0 + bj * HALF;
                    float gb[8]; unpk8(gw[m][bj], gb);
                    const f32x4 v0 = acc[ai][bj][m][0], v1 = acc[ai][bj][m][1];
                    u32x4 w; w.x = pkh(gb[0] * v0[0], gb[1] * v0[1]); w.y = pkh(gb[2] * v0[2], gb[3] * v0[3]); w.z = pkh(gb[4] * v1[0], gb[5] * v1[1]); w.w = pkh(gb[6] * v1[2], gb[7] * v1[3]);
                    *(u32x4*)(mix + r * 1024 + c) = w; } }
        }
    }
};
struct EpiResidSq {
    static constexpr bool PERM = true, AFTER_DRAIN = false, MID = false, PRE = true;
    const float* rinv; _Float16* xh; float* rowsq;
    __device__ __forceinline__ void pre(float (&rp)[8], const Unit& u, int wr, int wc, int fr, int fq) const {
        const int row0 = u.pm * BM + wr * 64 + fr;
#pragma unroll
        for (int ai = 0; ai < 2; ++ai)
#pragma unroll
            for (int m = 0; m < 4; ++m) rp[ai * 4 + m] = rinv[row0 + ai * HALF + m * 16];
    }
    __device__ __forceinline__ void operator()(const f32x4 (&acc)[2][2][4][2], const Unit& u, int wr, int wc, int fr, int fq, const float (&rp)[8]) const {
        const int row0 = u.pm * BM + wr * 64 + fr, col0 = u.pn * BM + wc * 32 + 8 * fq;
#pragma unroll
        for (int ai = 0; ai < 2; ++ai) {
            u32x4 hv[4][2];
#pragma unroll
            for (int m = 0; m < 4; ++m)
#pragma unroll
                for (int bj = 0; bj < 2; ++bj) hv[m][bj] = *(const u32x4*)(xh + (size_t)(row0 + ai * HALF + m * 16) * 1024 + col0 + bj * HALF);
#pragma unroll
            for (int m = 0; m < 4; ++m) { const size_t r = (size_t)(row0 + ai * HALF + m * 16); const float ri = rp[ai * 4 + m]; float sq = 0.f;
#pragma unroll
                for (int bj = 0; bj < 2; ++bj) { const size_t o = r * 1024 + col0 + bj * HALF;
                    float hx[8]; unpk8(hv[m][bj], hx);
                    f32x4 a0 = acc[ai][bj][m][0], a1 = acc[ai][bj][m][1];
#pragma unroll
                    for (int i = 0; i < 4; ++i) { a0[i] = fmaf(hx[i], ri, a0[i]); a1[i] = fmaf(hx[4 + i], ri, a1[i]); }
                    u32x4 w; w.x = pkh(a0[0], a0[1]); w.y = pkh(a0[2], a0[3]); w.z = pkh(a1[0], a1[1]); w.w = pkh(a1[2], a1[3]);
                    *(u32x4*)(xh + o) = w;
                    sq += (a0[0] * a0[0] + a0[1] * a0[1]) + (a0[2] * a0[2] + a0[3] * a0[3]) + (a1[0] * a1[0] + a1[1] * a1[1]) + (a1[2] * a1[2] + a1[3] * a1[3]); }
                sq = sum_xor16(sq); sq = sum_xor32(sq);
                if (fq == 0) atomicAdd(rowsq + r, sq); }
        }
    }
};
struct EpiRelu2N {
    static constexpr bool PERM = true, AFTER_DRAIN = false, MID = false, PRE = true;
    _Float16* U; const float* rowsq;
    __device__ __forceinline__ void pre(float (&rqp)[8], const Unit& u, int wr, int wc, int fr, int fq) const {
        const int row0 = u.pm * BM + wr * 64 + fr;
#pragma unroll
        for (int ai = 0; ai < 2; ++ai)
#pragma unroll
            for (int m = 0; m < 4; ++m) rqp[ai * 4 + m] = rowsq[row0 + ai * HALF + m * 16];
    }
    __device__ __forceinline__ void operator()(const f32x4 (&acc)[2][2][4][2], const Unit& u, int wr, int wc, int fr, int fq, const float (&rqp)[8]) const {
        const int row0 = u.pm * BM + wr * 64 + fr, col0 = u.pn * BM + wc * 32 + 8 * fq;
        float rq[2][4];
#pragma unroll
        for (int ai = 0; ai < 2; ++ai)
#pragma unroll
            for (int m = 0; m < 4; ++m) rq[ai][m] = rqp[ai * 4 + m];
#pragma unroll
        for (int ai = 0; ai < 2; ++ai)
#pragma unroll
            for (int m = 0; m < 4; ++m) { const int r = row0 + ai * HALF + m * 16; _Float16* rowp = U + (size_t)r * 4096 + col0;
                const float inv = 1.f / (rq[ai][m] * (1.f / 1024.f) + 1e-6f);
#pragma unroll
                for (int bj = 0; bj < 2; ++bj) { f32x4 v0 = acc[ai][bj][m][0], v1 = acc[ai][bj][m][1];
#pragma unroll
                    for (int i = 0; i < 4; ++i) { const float a = fmaxf(v0[i], 0.f), b = fmaxf(v1[i], 0.f); v0[i] = a * a * inv; v1[i] = b * b * inv; }
                    u32x4 w; w.x = pkh(v0[0], v0[1]); w.y = pkh(v0[2], v0[3]); w.z = pkh(v1[0], v1[1]); w.w = pkh(v1[2], v1[3]);
                    *(u32x4*)(rowp + bj * HALF) = w; } }
    }
};
template <class Epi, class Sched, bool ALIGN_EPI = false, bool SP2 = false>
__device__ __forceinline__ void gemm_phase(PG8_LAS unsigned char* lds, const Gemm g, const Sched& S, const Epi& E) {
    int tid_ = threadIdx.x; asm volatile("" : "+v"(tid_));
    const int tid = tid_, wid = __builtin_amdgcn_readfirstlane(tid >> 6), lane = tid & 63, wr = wid >> 2, wc = wid & 3, fr = lane & 15, fq = lane >> 4;
    const int K = g.K, nt = K / BK;
    unsigned voffA[2], voffB[2];
#pragma unroll
    for (int i = 0; i < 2; ++i) { int R, C; stage_rc(tid * 16 + i * 8192, R, C); const int Rb = Epi::PERM ? ((R & ~31) + perm32(R & 31)) : R;
        voffA[i] = (unsigned)(R * K + C) * 2u; voffB[i] = (unsigned)(Rb * K + C) * 2u; }
    const size_t kstep = (size_t)(BK * 2);
    const size_t hstep = (size_t)HALF * K * 2;
    const size_t tstep = 2 * hstep;
    const unsigned ldsw = (unsigned)wid * 1024u;
    const int aoff = lds_byte(wr * 64 + fr, fq * 8), boff = lds_byte(wc * 32 + fr, fq * 8);
#define PG8_SA(b, h) (((b) * 2 + (h)) * HTB)
#define PG8_SB(b, h) ((4 + (b) * 2 + (h)) * HTB)
#define PG8_STAGE(bufoff, gbase, voff) do { _Pragma("unroll") for (int _i = 0; _i < 2; ++_i) \
        __builtin_amdgcn_global_load_lds((const unsigned*)((const char*)(gbase) + (voff)[_i]), (PG8_LAS unsigned*)(lds + (bufoff) + ldsw + _i * 8192), 16, 0, 0); } while (0)
#define PG8_LDA(dst, b, h) do { _Pragma("unroll") for (int m = 0; m < 4; ++m) _Pragma("unroll") for (int k = 0; k < 2; ++k) dst[m][k] = *(const PG8_LAS bf16x8*)(lds + PG8_SA(b, h) + aoff + m * 2048 + k * 1024); } while (0)
#define PG8_LDB(dst, b, h) do { _Pragma("unroll") for (int n = 0; n < 2; ++n) _Pragma("unroll") for (int k = 0; k < 2; ++k) dst[n][k] = *(const PG8_LAS bf16x8*)(lds + PG8_SB(b, h) + boff + n * 2048 + k * 1024); } while (0)
#define PG8_MMA(ai, bj, At, Bt) do { __builtin_amdgcn_s_setprio(1); _Pragma("unroll") for (int m = 0; m < 4; ++m) _Pragma("unroll") for (int n = 0; n < 2; ++n) _Pragma("unroll") for (int k = 0; k < 2; ++k) \
        acc[ai][bj][m][n] = __builtin_amdgcn_mfma_f32_16x16x32_f16(Bt[n][k], At[m][k], acc[ai][bj][m][n], 0, 0, 0); __builtin_amdgcn_s_setprio(0); } while (0)
#define PG8_WAIT_V(n) asm volatile("s_waitcnt vmcnt(" #n ")" ::: "memory")
#define PG8_WAIT_L(n) asm volatile("s_waitcnt lgkmcnt(" #n ")" ::: "memory")
#define PG8_BAR __builtin_amdgcn_s_barrier()
#define PG8_SCHED __builtin_amdgcn_sched_barrier(0)
    Unit cur, nxt; int ui = 0;
    if (!S.next(0, cur)) return;
    float epre[8];
    if constexpr (Epi::PRE) E.pre(epre, cur, wr, wc, fr, fq);
    f32x4 acc[2][2][4][2];
#pragma unroll
    for (int a = 0; a < 2; ++a)
#pragma unroll
        for (int b = 0; b < 2; ++b)
#pragma unroll
            for (int m = 0; m < 4; ++m)
#pragma unroll
                for (int n = 0; n < 2; ++n) acc[a][b][m][n] = (f32x4){0.f, 0.f, 0.f, 0.f};
    bf16x8 At[4][2], B0[2][2], B1[2][2];
    const char* cA = (const char*)g.A + (size_t)cur.pm * tstep; const char* cB = (const char*)g.Bt + (size_t)cur.pn * tstep;
    S.a_ready(cur);
    if constexpr (SP2) {
        PG8_STAGE(PG8_SB(0, 0), cB, voffB); PG8_STAGE(PG8_SB(0, 1), cB + hstep, voffB); PG8_STAGE(PG8_SA(0, 0), cA, voffA); PG8_STAGE(PG8_SA(0, 1), cA + hstep, voffA);
        if (wr == 1) PG8_BAR;
        PG8_WAIT_V(2); PG8_BAR;
        PG8_STAGE(PG8_SB(1, 0), cB + kstep, voffB); PG8_STAGE(PG8_SA(1, 0), cA + kstep, voffA); PG8_STAGE(PG8_SB(1, 1), cB + hstep + kstep, voffB);
        PG8_WAIT_V(6); PG8_BAR;
    } else {
        PG8_STAGE(PG8_SB(0, 0), cB, voffB); PG8_STAGE(PG8_SA(0, 0), cA, voffA); PG8_STAGE(PG8_SB(0, 1), cB + hstep, voffB); PG8_STAGE(PG8_SA(0, 1), cA + hstep, voffA);
        if (wr == 1) PG8_BAR;
        PG8_WAIT_V(4); PG8_BAR;
        PG8_STAGE(PG8_SB(1, 0), cB + kstep, voffB); PG8_STAGE(PG8_SA(1, 0), cA + kstep, voffA); PG8_STAGE(PG8_SB(1, 1), cB + hstep + kstep, voffB);
        PG8_WAIT_V(6); PG8_BAR;
    }
    for (;;) {
        const bool has_next = S.next(ui + 1, nxt);
        const char* nA = has_next ? (const char*)g.A + (size_t)nxt.pm * tstep : cA; const char* nB = has_next ? (const char*)g.Bt + (size_t)nxt.pn * tstep : cB;
        for (int t = 0; t < nt; t += 2) {
            if constexpr (Epi::MID) { if (t == nt / 2) E.mid(acc, cur, wr, wc, fr, fq); }
            const bool last = (t == nt - 2);
            const char* a1 = cA + (size_t)(t + 1) * kstep;
            const char* a2 = last ? nA : cA + (size_t)(t + 2) * kstep; const char* b2 = last ? nB : cB + (size_t)(t + 2) * kstep;
            const char* a3 = a2 + kstep; const char* b3 = b2 + kstep;
            if (last && has_next) S.a_ready(nxt);
            if constexpr (SP2) {
            PG8_LDB(B0, 0, 0); PG8_LDB(B1, 0, 1); PG8_SCHED; PG8_LDA(At, 0, 0); PG8_STAGE(PG8_SA(1, 1), a1 + hstep, voffA);
            PG8_WAIT_V(8); PG8_WAIT_L(0); PG8_BAR; PG8_MMA(0, 0, At, B0); PG8_MMA(0, 1, At, B1); PG8_BAR; PG8_SCHED;
            PG8_LDA(At, 0, 1); PG8_STAGE(PG8_SB(0, 0), b2, voffB); PG8_STAGE(PG8_SB(0, 1), b2 + hstep, voffB); PG8_STAGE(PG8_SA(0, 0), a2, voffA);
            PG8_WAIT_V(8); PG8_WAIT_L(0); PG8_BAR; PG8_MMA(1, 0, At, B0); PG8_MMA(1, 1, At, B1); PG8_BAR; PG8_SCHED;
            PG8_LDB(B0, 1, 0); PG8_LDB(B1, 1, 1); PG8_SCHED; PG8_LDA(At, 1, 0); PG8_STAGE(PG8_SA(0, 1), a2 + hstep, voffA);
            PG8_WAIT_V(8); PG8_WAIT_L(0); PG8_BAR; PG8_MMA(0, 0, At, B0); PG8_MMA(0, 1, At, B1); PG8_BAR; PG8_SCHED;
            PG8_LDA(At, 1, 1); PG8_STAGE(PG8_SB(1, 0), b3, voffB); PG8_STAGE(PG8_SB(1, 1), b3 + hstep, voffB); PG8_STAGE(PG8_SA(1, 0), a3, voffA);
            PG8_WAIT_V(8); PG8_WAIT_L(0); PG8_BAR; PG8_MMA(1, 0, At, B0); PG8_MMA(1, 1, At, B1); PG8_BAR; PG8_SCHED;
            } else {
            PG8_LDB(B0, 0, 0); PG8_SCHED; PG8_LDA(At, 0, 0); PG8_STAGE(PG8_SA(1, 1), a1 + hstep, voffA);
            PG8_WAIT_L(8); PG8_BAR; PG8_WAIT_L(0); PG8_MMA(0, 0, At, B0); PG8_BAR; PG8_SCHED;
            PG8_LDB(B1, 0, 1); PG8_STAGE(PG8_SB(0, 0), b2, voffB);
            PG8_BAR; PG8_WAIT_L(0); PG8_MMA(0, 1, At, B1); PG8_BAR;
            PG8_LDA(At, 0, 1); PG8_STAGE(PG8_SA(0, 0), a2, voffA);
            PG8_BAR; PG8_WAIT_L(0); PG8_MMA(1, 0, At, B0); PG8_BAR; PG8_SCHED;
            PG8_STAGE(PG8_SB(0, 1), b2 + hstep, voffB);
            PG8_WAIT_V(6); PG8_BAR; PG8_MMA(1, 1, At, B1); PG8_BAR;
            PG8_LDB(B0, 1, 0); PG8_SCHED; PG8_LDA(At, 1, 0); PG8_STAGE(PG8_SA(0, 1), a2 + hstep, voffA);
            PG8_WAIT_L(8); PG8_BAR; PG8_WAIT_L(0); PG8_MMA(0, 0, At, B0); PG8_BAR; PG8_SCHED;
            PG8_LDB(B1, 1, 1); PG8_STAGE(PG8_SB(1, 0), b3, voffB);
            PG8_BAR; PG8_WAIT_L(0); PG8_MMA(0, 1, At, B1); PG8_BAR;
            PG8_LDA(At, 1, 1); PG8_STAGE(PG8_SA(1, 0), a3, voffA);
            PG8_BAR; PG8_WAIT_L(0); PG8_MMA(1, 0, At, B0); PG8_BAR; PG8_SCHED;
            PG8_STAGE(PG8_SB(1, 1), b3 + hstep, voffB);
            PG8_WAIT_V(6); PG8_BAR; PG8_MMA(1, 1, At, B1); PG8_BAR;
            }
        }
        if constexpr (ALIGN_EPI) { if (wr == 0) PG8_BAR; }
        if constexpr (!Epi::AFTER_DRAIN) { if constexpr (Epi::PRE) E(acc, cur, wr, wc, fr, fq, epre); else E(acc, cur, wr, wc, fr, fq); S.done(cur); }
        if (!has_next) break;
#pragma unroll
        for (int a = 0; a < 2; ++a)
#pragma unroll
            for (int b = 0; b < 2; ++b)
#pragma unroll
                for (int m = 0; m < 4; ++m)
#pragma unroll
                    for (int n = 0; n < 2; ++n) acc[a][b][m][n] = (f32x4){0.f, 0.f, 0.f, 0.f};
        cur = nxt; cA = nA; cB = nB; ++ui;
        if constexpr (Epi::PRE) E.pre(epre, cur, wr, wc, fr, fq);
        if constexpr (ALIGN_EPI) { if (wr == 1) PG8_BAR; }
    }
    PG8_WAIT_V(0);
    if constexpr (!ALIGN_EPI) { if (wr == 0) PG8_BAR; }
    PG8_BAR;
    if constexpr (Epi::AFTER_DRAIN) { E.fused(acc, cur, wr, wc, fr, fq, lds, wid, lane); S.done(cur); }
#undef PG8_SA
#undef PG8_SB
#undef PG8_STAGE
#undef PG8_LDA
#undef PG8_LDB
#undef PG8_MMA
#undef PG8_WAIT_V
#undef PG8_WAIT_L
#undef PG8_BAR
#undef PG8_SCHED
}
}


namespace {
constexpr int B_ = 8, S_ = 4096, M_ = B_ * S_, D_ = 1024, DIN = 4288, DFF = 4096;
constexpr int C_QA = 0, C_QB = 512, C_QI = 1024, C_KVB = 1280, C_KA = 2048, C_VA = 2112, C_KI = 2176, C_WI = 2208, C_GB = 2216, C_GATE = 2304;
constexpr int NC = 255;
constexpr float EPS = 1e-6f;
using pg8::PW;
#define GAS __attribute__((address_space(1)))
#define LAS __attribute__((address_space(3)))
typedef unsigned v4u __attribute__((ext_vector_type(4)));
typedef float f32x4 __attribute__((ext_vector_type(4)));

__device__ __forceinline__ int t5_bucket(int n) {
    if (n < 16) return n < 0 ? 0 : n;
    float nf = (float)n;
    int large = 16 + (int)(logf(nf / 16.f) / logf(8.f) * 16.f);
    return large < 31 ? large : 31;
}


__device__ __forceinline__ int win_src_col(int n) {
    if (n < 512) return n;
    if (n < 1024) return 936 + (n - 512);
    if (n < 1280) return 640 + (n - 1024);
    if (n < 2048) return 1448 + (n - 1280);
    if (n < 2112) return 512 + (n - 2048);
    if (n < 2176) return 576 + (n - 2112);
    if (n < 2208) return 896 + (n - 2176);
    if (n < 2216) return 928 + (n - 2208);
    if (n < 2240) return n;
    if (n < 2304) return -1;
    { const int q = n - 2304, j = q >> 8, w = q & 255;
      return (w < 128) ? 2240 + 128 * j + w : 3264 + 128 * j + (w - 128); }
}
__device__ __forceinline__ float wave_sum(float v) {
    v += xchg_xor1(v); v += xchg_xor2(v);
    v += __int_as_float(__builtin_amdgcn_mov_dpp(__float_as_int(v), 0x124, 0xf, 0xf, true));
    v += __int_as_float(__builtin_amdgcn_mov_dpp(__float_as_int(v), 0x128, 0xf, 0xf, true));
    v = sum_xor16(v); v = sum_xor32(v);
    return v;
}
template <bool MAP>
__device__ __forceinline__ void transpose_item(const float* __restrict__ W, int K, int Nsrc, int Ndst, _Float16* __restrict__ WT, const float* __restrict__ gain, float* scr, int item, int lane, int dpitch = 0, int koff = 0) {
    const int nblk = Ndst / 32, kb = item / nblk, nb = item % nblk, k0 = 64 * kb, n0 = 32 * nb;
    const int c4 = lane & 7, nd = n0 + 4 * c4; const int ns = MAP ? win_src_col(nd) : nd;
#pragma unroll
    for (int i = 0; i < 8; ++i) { const int kk = 8 * i + (lane >> 3); f32x4 v = {0.f, 0.f, 0.f, 0.f};
        if (ns >= 0) { v = *(const f32x4*)(W + (size_t)(k0 + kk) * Nsrc + ns); if (gain) v = v * gain[k0 + kk]; }
        float* sp = scr + kk * 33 + 4 * c4; sp[0] = v.x; sp[1] = v.y; sp[2] = v.z; sp[3] = v.w; }
    __builtin_amdgcn_s_waitcnt(0xc07f); asm volatile("" ::: "memory");
    const int c = lane & 7;
#pragma unroll
    for (int j = 0; j < 4; ++j) { const int n = (lane >> 3) + 8 * j; const float* s = scr + (8 * c) * 33 + n;
        v4u o; o.x = pg8::pkh(s[0 * 33], s[1 * 33]); o.y = pg8::pkh(s[2 * 33], s[3 * 33]); o.z = pg8::pkh(s[4 * 33], s[5 * 33]); o.w = pg8::pkh(s[6 * 33], s[7 * 33]);
        *(v4u*)(WT + (size_t)(n0 + n) * (dpitch ? dpitch : K) + koff + k0 + 8 * c) = o; }
    __builtin_amdgcn_s_waitcnt(0xc07f); asm volatile("" ::: "memory");
}
__device__ __forceinline__ void rms_row_to_f16(const float* __restrict__ xrow, _Float16* __restrict__ orow, float* __restrict__ rinv, int lane) {
    const f32x4* xr = (const f32x4*)xrow + lane;
    f32x4 v[4]; float s = 0.f;
#pragma unroll
    for (int j = 0; j < 4; ++j) { v[j] = xr[64 * j]; s += (v[j].x * v[j].x + v[j].y * v[j].y) + (v[j].z * v[j].z + v[j].w * v[j].w); }
    const float ms = wave_sum(s) * (1.f / D_) + EPS; const float rstd = rsqrtf(ms);
    if (lane == 0) *rinv = ms * rstd;
    unsigned long long* o8 = (unsigned long long*)orow + lane;
#pragma unroll
    for (int j = 0; j < 4; ++j) o8[64 * j] = (unsigned long long)pg8::pkh(v[j].x * rstd, v[j].y * rstd) | ((unsigned long long)pg8::pkh(v[j].z * rstd, v[j].w * rstd) << 32);
}

struct Args {
    const float* x; const float* norm_mix; const float* w_in; const float* pe_k; const float* w1_k; const float* w2_k; const float* pe_v; const float* w1_v; const float* w2_v;
    const float* rel_bias; const float* w_ba; const float* w_bb; const float* w_out; const float* norm_mlp; const float* w_mi; const float* w_mo; const float* norm_final;
    float* out; unsigned char* ws;
};
constexpr size_t MiB = 1u << 20;
constexpr size_t WS_PCNT = 32768, WS_XBUF = 524288;
constexpr size_t WS_ROWSQ = 65536, WS_ROWSQ2 = 196608;
constexpr size_t WS_CTL = 0, WS_WIN = 1 * MiB, WS_WBA = 10 * MiB, WS_WBB = 11 * MiB, WS_WOUT = 12 * MiB, WS_WMI = 14 * MiB, WS_WMO = 22 * MiB, WS_CW = 30 * MiB,
                 WS_KCMP = 32 * MiB, WS_VCMP = 33 * MiB, WS_H = 34 * MiB, WS_PROJ = 98 * MiB, WS_MIX = 370 * MiB, WS_KIC = 434 * MiB, WS_OAB = 436 * MiB, WS_RINV = 500 * MiB, WS_END = 501 * MiB;

__device__ __forceinline__ void prologue_body(const Args& a, unsigned char* lds) {
    const int tid = threadIdx.x, lane = tid & 63, wave = tid >> 6;
    float* scr = (float*)(lds + wave * 8704);
    const int gw = blockIdx.x * 8 + wave, NGW = gridDim.x * 8;
    constexpr int I_IN = (D_ / 64) * (PW / 32), I_BA = (512 / 64) * (D_ / 32), I_OUT = (D_ / 64) * (D_ / 32), I_MI = (D_ / 64) * (DFF / 32), I_MO = (DFF / 64) * (D_ / 32);
    constexpr int I_C1 = (2048 / 64) * (128 / 32), I_C2 = (128 / 64) * (64 / 32);
    constexpr int NITEMS = I_IN + 2 * I_BA + I_OUT + 2 * I_C1 + 2 * I_C2;
    for (int it = gw; it < NITEMS; it += NGW) {
        int r = it;
        if (r < I_IN) { transpose_item<true>(a.w_in, D_, DIN, PW, (_Float16*)(a.ws + WS_WIN), a.norm_mix, scr, r, lane); continue; } r -= I_IN;
        if (r < I_BA) { transpose_item<false>(a.w_ba, 512, D_, D_, (_Float16*)(a.ws + WS_WBA), nullptr, scr, r, lane, 1024, 0); continue; } r -= I_BA;
        if (r < I_BA) { transpose_item<false>(a.w_bb, 512, D_, D_, (_Float16*)(a.ws + WS_WBA), nullptr, scr, r, lane, 1024, 512); continue; } r -= I_BA;
        if (r < I_OUT) { transpose_item<false>(a.w_out, D_, D_, D_, (_Float16*)(a.ws + WS_WOUT), nullptr, scr, r, lane); continue; } r -= I_OUT;
        if (r < I_C1) { transpose_item<false>(a.w1_k, 2048, 128, 128, (_Float16*)(a.ws + WS_CW), nullptr, scr, r, lane); continue; } r -= I_C1;
        if (r < I_C1) { transpose_item<false>(a.w1_v, 2048, 128, 128, (_Float16*)(a.ws + WS_CW + 512 * 1024), nullptr, scr, r, lane); continue; } r -= I_C1;
        if (r < I_C2) { transpose_item<false>(a.w2_k, 128, 64, 64, (_Float16*)(a.ws + WS_CW + 1024 * 1024), nullptr, scr, r, lane); continue; } r -= I_C2;
        transpose_item<false>(a.w2_v, 128, 64, 64, (_Float16*)(a.ws + WS_CW + 1024 * 1024 + 16384), nullptr, scr, r, lane);
    }
#pragma unroll 4
    for (int m = gw; m < M_; m += NGW) rms_row_to_f16(a.x + (size_t)m * D_, (_Float16*)(a.ws + WS_H) + (size_t)m * D_, (float*)(a.ws + WS_RINV) + m, lane);
}
__device__ __forceinline__ void mlp_weights_body(const Args& a, unsigned char* lds) {
    const int tid = threadIdx.x, lane = tid & 63, wave = tid >> 6;
    float* scr = (float*)(lds + wave * 8704);
    const int gw = ((int)blockIdx.x - 128) * 8 + wave, NGW = 128 * 8;
    constexpr int I_MI = (D_ / 64) * (DFF / 32), I_MO = (DFF / 64) * (D_ / 32);
    for (int it = gw; it < I_MI + I_MO; it += NGW) {
        if (it < I_MI) transpose_item<false>(a.w_mi, D_, DFF, DFF, (_Float16*)(a.ws + WS_WMI), a.norm_mlp, scr, it, lane);
        else transpose_item<false>(a.w_mo, DFF, D_, D_, (_Float16*)(a.ws + WS_WMO), nullptr, scr, it - I_MI, lane);
    }
}
struct EpiAccOut {
    static constexpr bool PERM = true, AFTER_DRAIN = false, MID = false, PRE = false;
    _Float16* x2h; const _Float16* xh; float* rowsq;
    __device__ __forceinline__ void operator()(const f32x4 (&acc)[2][2][4][2], const pg8::Unit& u, int wr, int wc, int fr, int fq) const {
        const int row0 = u.pm * 256 + wr * 64 + fr, col0 = u.pn * 256 + wc * 32 + 8 * fq;
#pragma unroll
        for (int ai = 0; ai < 2; ++ai)
#pragma unroll
            for (int m = 0; m < 4; ++m) { const size_t r = (size_t)(row0 + ai * 128 + m * 16); float sq = 0.f;
#pragma unroll
                for (int bj = 0; bj < 2; ++bj) { const size_t o = r * 1024 + col0 + bj * 128;
                    float p[8]; pg8::unpk8(*(const pg8::u32x4*)(xh + o), p);
                    const f32x4 a0 = acc[ai][bj][m][0], a1 = acc[ai][bj][m][1];
                    const float v[8] = {p[0] + a0[0], p[1] + a0[1], p[2] + a0[2], p[3] + a0[3], p[4] + a1[0], p[5] + a1[1], p[6] + a1[2], p[7] + a1[3]};
                    pg8::u32x4 w; w.x = pg8::pkh(v[0], v[1]); w.y = pg8::pkh(v[2], v[3]); w.z = pg8::pkh(v[4], v[5]); w.w = pg8::pkh(v[6], v[7]);
                    *(pg8::u32x4*)(x2h + o) = w;
                    sq += (v[0] * v[0] + v[1] * v[1]) + (v[2] * v[2] + v[3] * v[3]) + (v[4] * v[4] + v[5] * v[5]) + (v[6] * v[6] + v[7] * v[7]); }
                sq = sum_xor16(sq); sq = sum_xor32(sq);
                if (fq == 0) atomicAdd(rowsq + r, sq); }
    }
};
__device__ __forceinline__ void final_scale_row(const _Float16* __restrict__ xrow, float* __restrict__ orow, const float* __restrict__ g, float rsq, int lane) {
    const float rstd = rsqrtf(rsq * (1.f / D_) + EPS);
#pragma unroll
    for (int j = 0; j < 2; ++j) {
        float p[8]; pg8::unpk8(*((const pg8::u32x4*)xrow + lane + 64 * j), p);
        const f32x4 g0 = *((const f32x4*)g + 2 * (lane + 64 * j)), g1 = *((const f32x4*)g + 2 * (lane + 64 * j) + 1);
        *((f32x4*)orow + 2 * (lane + 64 * j)) = (f32x4){p[0] * rstd * g0.x, p[1] * rstd * g0.y, p[2] * rstd * g0.z, p[3] * rstd * g0.w};
        *((f32x4*)orow + 2 * (lane + 64 * j) + 1) = (f32x4){p[4] * rstd * g1.x, p[5] * rstd * g1.y, p[6] * rstd * g1.z, p[7] * rstd * g1.w};
    }
}

struct SliceOrder {
    pg8::StaticOrder S; int slice;
    __device__ bool next(int i, pg8::Unit& u) const { return i == 0 ? S.next(slice, u) : false; }
    __device__ __forceinline__ void a_ready(const pg8::Unit&) const {}
    __device__ __forceinline__ void done(const pg8::Unit&) const {}
};
struct EpiFinalNorm {
    static constexpr bool PERM = true, AFTER_DRAIN = true, MID = false, PRE = false;
    float* out; const _Float16* xh; const float* g; float* xbuf; unsigned* cnt;
    __device__ __forceinline__ void fused(f32x4 (&acc)[2][2][4][2], const pg8::Unit& u, int wr, int wc, int fr, int fq, PG8_LAS unsigned char* lds, int wid, int lane) const {
        const int rl0 = wr * 64 + fr, col0 = u.pn * 256 + wc * 32 + 8 * fq;
        PG8_LAS float* red = (PG8_LAS float*)lds;
#pragma unroll
        for (int ai = 0; ai < 2; ++ai) {
            pg8::u32x4 xw[4][2];
#pragma unroll
            for (int m = 0; m < 4; ++m)
#pragma unroll
                for (int bj = 0; bj < 2; ++bj) xw[m][bj] = *(const pg8::u32x4*)(xh + (size_t)(u.pm * 256 + rl0 + ai * 128 + m * 16) * 1024 + col0 + bj * 128);
#pragma unroll
            for (int m = 0; m < 4; ++m) { const int rl = rl0 + ai * 128 + m * 16; float sq = 0.f;
#pragma unroll
                for (int bj = 0; bj < 2; ++bj) { float p[8]; pg8::unpk8(xw[m][bj], p);
#pragma unroll
                    for (int i = 0; i < 4; ++i) { acc[ai][bj][m][0][i] += p[i]; acc[ai][bj][m][1][i] += p[4 + i];
                        sq = fmaf(acc[ai][bj][m][0][i], acc[ai][bj][m][0][i], sq); sq = fmaf(acc[ai][bj][m][1][i], acc[ai][bj][m][1][i], sq); } }
                sq = sum_xor16(sq); sq = sum_xor32(sq);
                if (fq == 0) red[wc * 256 + rl] = sq; }
        }
        __syncthreads();
        const int tid = wid * 64 + lane;
        if (tid < 256) { const float tot = (red[tid] + red[256 + tid]) + (red[512 + tid] + red[768 + tid]);
            __hip_atomic_store(xbuf + ((size_t)u.pm * 4 + u.pn) * 256 + tid, tot, __ATOMIC_RELAXED, __HIP_MEMORY_SCOPE_AGENT); }
        asm volatile("s_waitcnt vmcnt(0)" ::: "memory");
        __syncthreads();
        if (tid == 0) { __hip_atomic_fetch_add(cnt + u.pm, 1u, __ATOMIC_RELAXED, __HIP_MEMORY_SCOPE_AGENT);
            unsigned sp = 0; while (__hip_atomic_load(cnt + u.pm, __ATOMIC_RELAXED, __HIP_MEMORY_SCOPE_AGENT) < 4u && ++sp < (1u << 22)) __builtin_amdgcn_s_sleep(1); }
        __syncthreads();
        if (tid < 256) { float tot = 0.f;
#pragma unroll
            for (int q = 0; q < 4; ++q) tot += __hip_atomic_load(xbuf + ((size_t)u.pm * 4 + q) * 256 + tid, __ATOMIC_RELAXED, __HIP_MEMORY_SCOPE_AGENT);
            red[1024 + tid] = rsqrtf(tot * (1.f / 1024.f) + 1e-6f); }
        __syncthreads();
#pragma unroll
        for (int ai = 0; ai < 2; ++ai)
#pragma unroll
            for (int m = 0; m < 4; ++m) { const int rl = rl0 + ai * 128 + m * 16; const size_t r = (size_t)(u.pm * 256 + rl); const float rstd = red[1024 + rl];
#pragma unroll
                for (int bj = 0; bj < 2; ++bj) { const int c = col0 + bj * 128; const f32x4 g0 = *(const f32x4*)(g + c), g1 = *(const f32x4*)(g + c + 4);
                    *(f32x4*)(out + r * 1024 + c) = acc[ai][bj][m][0] * rstd * g0; *(f32x4*)(out + r * 1024 + c + 4) = acc[ai][bj][m][1] * rstd * g1; } }
        __syncthreads();
    }
};

namespace dsa {
typedef _Float16 f16x8 __attribute__((ext_vector_type(8)));
typedef _Float16 f16x4 __attribute__((ext_vector_type(4)));
typedef short s16x4 __attribute__((ext_vector_type(4)));
typedef float f32x4 __attribute__((ext_vector_type(4)));
typedef unsigned u32x4 __attribute__((ext_vector_type(4)));
typedef unsigned u32x2 __attribute__((ext_vector_type(2)));
constexpr int TQ = 16, NBIN = 2048, CANDCAP = 512, VPITCH = 144;
constexpr int L_HIST = 0, L_SEL = 65536, L_SELD = L_SEL + 8192, L_CTL = L_SELD + 8192, L_BIAS = L_CTL + 512, L_VST = L_BIAS + 4096, L_END = L_VST + 8 * 32 * VPITCH;
static_assert(L_END <= 131072, "dsa LDS");

template <bool FIRST>
__device__ __forceinline__ f16x8 relu_pack(const f32x4 lo, const f32x4 hi) {
    unsigned o0, o1, o2, o3;
    const float l0 = lo.x, l1 = lo.y, l2 = lo.z, l3 = lo.w, h0 = hi.x, h1 = hi.y, h2 = hi.z, h3 = hi.w;
    if (FIRST)
        asm volatile("s_nop 7\n\tv_cvt_pk_f16_f32 %0, %4, %5 clamp\n\tv_cvt_pk_f16_f32 %1, %6, %7 clamp\n\tv_cvt_pk_f16_f32 %2, %8, %9 clamp\n\tv_cvt_pk_f16_f32 %3, %10, %11 clamp"
                     : "=&v"(o0), "=&v"(o1), "=&v"(o2), "=&v"(o3) : "v"(l0), "v"(l1), "v"(l2), "v"(l3), "v"(h0), "v"(h1), "v"(h2), "v"(h3));
    else
        asm volatile("v_cvt_pk_f16_f32 %0, %4, %5 clamp\n\tv_cvt_pk_f16_f32 %1, %6, %7 clamp\n\tv_cvt_pk_f16_f32 %2, %8, %9 clamp\n\tv_cvt_pk_f16_f32 %3, %10, %11 clamp\n\ts_nop 1"
                     : "=&v"(o0), "=&v"(o1), "=&v"(o2), "=&v"(o3) : "v"(l0), "v"(l1), "v"(l2), "v"(l3), "v"(h0), "v"(h1), "v"(h2), "v"(h3));
    const u32x4 w = {o0, o1, o2, o3};
    return __builtin_bit_cast(f16x8, w);
}
__device__ __forceinline__ int score_bin(float sc) { int b = (int)sc; b = b < 0 ? 0 : b; return b > NBIN - 1 ? NBIN - 1 : b; }

template <int PASS, bool MASKED>
__device__ __forceinline__ void score_block(LAS unsigned char* lds, const f16x8 bfr, int s, int t0, int kc, const f16x8 (&afr)[4][2], const f16x8 (&wfr)[4], const int (&bst)[4]) {
    LAS unsigned* hist = (LAS unsigned*)(lds + L_HIST);
    LAS unsigned short* sel = (LAS unsigned short*)(lds + L_SEL);
    LAS unsigned short* seld = (LAS unsigned short*)(lds + L_SELD);
    LAS u32x2* cand = (LAS u32x2*)(lds + L_HIST);
    LAS int* ctl = (LAS int*)(lds + L_CTL);
    const f32x4 zero = {0.f, 0.f, 0.f, 0.f};
    const f32x4 off = {1024.f, 1024.f, 1024.f, 1024.f};
    f32x4 a1[4], a2[4];
#pragma unroll
    for (int grp = 0; grp < 4; ++grp) {
        a1[grp] = __builtin_amdgcn_mfma_f32_16x16x32_f16(afr[grp][0], bfr, zero, 0, 0, 0);
        a2[grp] = __builtin_amdgcn_mfma_f32_16x16x32_f16(afr[grp][1], bfr, zero, 0, 0, 0);
    }
    __builtin_amdgcn_sched_barrier(0);
    f16x8 rp[4];
    rp[0] = relu_pack<true>(a1[0], a2[0]); rp[1] = relu_pack<false>(a1[1], a2[1]); rp[2] = relu_pack<false>(a1[2], a2[2]); rp[3] = relu_pack<false>(a1[3], a2[3]);
    __builtin_amdgcn_sched_barrier(0);
    float sc[4];
    { const f32x4 c0 = __builtin_amdgcn_mfma_f32_16x16x32_f16(wfr[0], rp[0], off, 0, 0, 0); const f32x4 c1 = __builtin_amdgcn_mfma_f32_16x16x32_f16(wfr[1], rp[1], off, 0, 0, 0);
      const f32x4 c2 = __builtin_amdgcn_mfma_f32_16x16x32_f16(wfr[2], rp[2], off, 0, 0, 0); const f32x4 c3 = __builtin_amdgcn_mfma_f32_16x16x32_f16(wfr[3], rp[3], off, 0, 0, 0);
      sc[0] = c0.x; sc[1] = c1.y; sc[2] = c2.z; sc[3] = c3.w; }
    int bin[4]; bool ok[4];
#pragma unroll
    for (int grp = 0; grp < 4; ++grp) { bin[grp] = score_bin(sc[grp]); ok[grp] = MASKED ? (s <= t0 + 4 * grp + kc) : true; }
    if (PASS == 1) {
#pragma unroll
        for (int grp = 0; grp < 4; ++grp) { const int row = 4 * grp + kc;
            if (ok[grp]) __hip_atomic_fetch_add(hist + row * 1024 + (bin[grp] >> 1), (bin[grp] & 1) ? 0x10000u : 1u, __ATOMIC_RELAXED, __HIP_MEMORY_SCOPE_WORKGROUP); }
    } else {
        bool sg[4], cg[4]; int pos[4];
#pragma unroll
        for (int grp = 0; grp < 4; ++grp) { sg[grp] = ok[grp] && bin[grp] > bst[grp]; cg[grp] = ok[grp] && bin[grp] == bst[grp]; pos[grp] = 0; }
#pragma unroll
        for (int grp = 0; grp < 4; ++grp) { const int row = 4 * grp + kc;
            if (sg[grp]) pos[grp] = __hip_atomic_fetch_add(ctl + row * 8 + 0, 1, __ATOMIC_RELAXED, __HIP_MEMORY_SCOPE_WORKGROUP); }
#pragma unroll
        for (int grp = 0; grp < 4; ++grp) { const int row = 4 * grp + kc;
            if (sg[grp]) { sel[row * 256 + (pos[grp] & 255)] = (unsigned short)s; const int dd = t0 + row - s; seld[row * 256 + (pos[grp] & 255)] = (unsigned short)((dd > 127 ? 127 : dd) * 32); } }
        if (__any((cg[0] || cg[1]) || (cg[2] || cg[3]))) {
#pragma unroll
            for (int grp = 0; grp < 4; ++grp) { const int row = 4 * grp + kc;
                if (cg[grp]) { const int p = __hip_atomic_fetch_add(ctl + row * 8 + 1, 1, __ATOMIC_RELAXED, __HIP_MEMORY_SCOPE_WORKGROUP);
                    if (p < CANDCAP) { u32x2 e; e.x = __float_as_uint(sc[grp]); e.y = (unsigned)s; cand[row * CANDCAP + p] = e; } } }
        }
    }
}
template <int PASS>
__device__ __forceinline__ void score_pass(LAS unsigned char* lds, const _Float16* __restrict__ proj, int b, int t0, int nkb, int wave, int lane,
                                           const f16x8 (&afr)[4][2], const f16x8 (&wfr)[4]) {
    LAS int* ctl = (LAS int*)(lds + L_CTL);
    const int kc = lane >> 4, n16 = lane & 15;
    int bst[4];
#pragma unroll
    for (int grp = 0; grp < 4; ++grp) bst[grp] = (PASS == 2) ? ctl[(4 * grp + kc) * 8 + 2] : 0;
    const _Float16* kbase = (const _Float16*)((const char*)proj + ((long)WS_KIC - (long)WS_PROJ)) + (size_t)(b * S_ + n16) * 32 + 8 * kc;
    const int klast = nkb - 1;
#define DSA_KLOAD(kk) (*(const f16x8*)(kbase + (size_t)(16 * ((kk) < klast ? (kk) : klast)) * 32))
#define DSA_KSTEP(reg, kk) do { f16x8 bfr_ = reg * (_Float16)0.0625f; asm volatile("" : "+v"(bfr_)); reg = DSA_KLOAD((kk) + 32); if ((kk) < nkb) { const int s_ = 16 * (kk) + n16; \
        if ((kk) != klast) score_block<PASS, false>(lds, bfr_, s_, t0, kc, afr, wfr, bst); else score_block<PASS, true>(lds, bfr_, s_, t0, kc, afr, wfr, bst); } } while (0)
    f16x8 kb0 = DSA_KLOAD(wave); __builtin_amdgcn_sched_barrier(0);
    f16x8 kb1 = DSA_KLOAD(wave + 8); __builtin_amdgcn_sched_barrier(0);
    f16x8 kb2 = DSA_KLOAD(wave + 16); __builtin_amdgcn_sched_barrier(0);
    f16x8 kb3 = DSA_KLOAD(wave + 24); __builtin_amdgcn_sched_barrier(0);
#pragma unroll 1
    for (int kb = wave; kb < nkb; kb += 32) {
        DSA_KSTEP(kb0, kb); DSA_KSTEP(kb1, kb + 8); DSA_KSTEP(kb2, kb + 16); DSA_KSTEP(kb3, kb + 24);
    }
#undef DSA_KSTEP
#undef DSA_KLOAD
}

__device__ __forceinline__ unsigned wave_prefix_incl(unsigned x) {
    int v = (int)x;
    v += __builtin_amdgcn_update_dpp(0, v, 0x111, 0xf, 0xf, true);
    v += __builtin_amdgcn_update_dpp(0, v, 0x112, 0xf, 0xf, true);
    v += __builtin_amdgcn_update_dpp(0, v, 0x114, 0xf, 0xf, true);
    v += __builtin_amdgcn_update_dpp(0, v, 0x118, 0xf, 0xf, true);
    v += __builtin_amdgcn_update_dpp(0, v, 0x142, 0xa, 0xf, false);
    v += __builtin_amdgcn_update_dpp(0, v, 0x143, 0xc, 0xf, false);
    return (unsigned)v;
}
__device__ __forceinline__ unsigned wave_suffix_incl(unsigned x) {
    const unsigned p = wave_prefix_incl(x);
    const unsigned tot = (unsigned)__builtin_amdgcn_readlane((int)p, 63);
    return tot - p + x;
}

__device__ __forceinline__ void dsa_tile(LAS unsigned char* lds, const _Float16* __restrict__ proj, _Float16* __restrict__ o_a, int b, int qt) {
    int tid_ = threadIdx.x; asm volatile("" : "+v"(tid_));
    const int tid = tid_, lane = tid & 63, wave = __builtin_amdgcn_readfirstlane(tid >> 6);
    const int kc = lane >> 4, n16 = lane & 15;
    const int t0 = qt * TQ, nkb = qt + 1;
    LAS unsigned* hist = (LAS unsigned*)(lds + L_HIST);
    LAS unsigned short* sel = (LAS unsigned short*)(lds + L_SEL);
    LAS u32x2* cand = (LAS u32x2*)(lds + L_HIST);
    LAS int* ctl = (LAS int*)(lds + L_CTL);
    LAS float* biaslut = (LAS float*)(lds + L_BIAS);
    for (int i = tid; i < (TQ * 1024 + 4096) / 4; i += 512) ((LAS u32x4*)hist)[i] = (u32x4){0u, 0u, 0u, 0u};
    if (tid < TQ * 8) ctl[tid] = 0;
    f16x8 afr[4][2]; f16x8 wfr[4];
    { const int g = n16 >> 2, r = n16 & 3;
      const _Float16 qs = (_Float16)0.0625f;
#pragma unroll
      for (int grp = 0; grp < 4; ++grp) {
          const _Float16* qrow = proj + (size_t)(b * S_ + t0 + 4 * grp + g) * PW + C_QI;
          afr[grp][0] = *(const f16x8*)(qrow + r * 32 + 8 * kc) * qs;
          afr[grp][1] = *(const f16x8*)(qrow + (4 + r) * 32 + 8 * kc) * qs;
      }
      const f16x8 wv = *(const f16x8*)(proj + (size_t)(b * S_ + t0 + 4 * r + kc) * PW + C_WI);
      float wf[8]; float ss = 0.f;
#pragma unroll
      for (int h = 0; h < 8; ++h) { wf[h] = (float)wv[h] * (1.f / 16.f); ss = fmaf(wf[h], wf[h], ss); }
      const float sc2 = 32.f * 256.f * rsqrtf(ss + 1e-12f);
      f16x8 wrow;
#pragma unroll
      for (int h = 0; h < 8; ++h) wrow[h] = (g == kc) ? (_Float16)(wf[h] * sc2) : (_Float16)0.f;
      const f16x8 z8 = {0, 0, 0, 0, 0, 0, 0, 0};
#pragma unroll
      for (int grp = 0; grp < 4; ++grp) wfr[grp] = (r == grp) ? wrow : z8;
    }
    __syncthreads();
    score_pass<1>(lds, proj, b, t0, nkb, wave, lane, afr, wfr);
    __syncthreads();
#pragma unroll 1
    for (int i = 0; i < 2; ++i) {
        const int row = 2 * wave + i, n = t0 + row + 1;
        if (n <= 256) { if (lane == 0) { ctl[row * 8 + 2] = -1; ctl[row * 8 + 3] = 0; } }
        else {
            const LAS u32x4* hp = (const LAS u32x4*)(hist + row * 1024 + 16 * lane);
            unsigned tot = 0;
#pragma unroll
            for (int q4 = 0; q4 < 4; ++q4) { const u32x4 hv = hp[q4];
                tot += (hv.x & 0xffffu) + (hv.x >> 16) + (hv.y & 0xffffu) + (hv.y >> 16) + (hv.z & 0xffffu) + (hv.z >> 16) + (hv.w & 0xffffu) + (hv.w >> 16); }
            const unsigned suf = wave_suffix_incl(tot);
            const unsigned above_lane = suf - tot;
            const unsigned long long cross = __ballot(above_lane < 256u && suf >= 256u);
            const int lx = __builtin_ctzll(cross);
            const unsigned abovex = (unsigned)__builtin_amdgcn_readlane((int)above_lane, lx);
            const unsigned c2 = lane < 32 ? (unsigned)((const LAS unsigned short*)hist)[row * 2048 + 32 * lx + lane] : 0u;
            const unsigned suf2 = wave_suffix_incl(c2);
            const unsigned above2 = abovex + suf2 - c2;
            if (lane < 32 && above2 < 256u && above2 + c2 >= 256u) {
                const int bs = 32 * lx + lane; const unsigned cum = above2;
                ctl[row * 8 + 2] = bs; ctl[row * 8 + 3] = 256 - (int)cum;
            }
        }
    }
    __syncthreads();
    score_pass<2>(lds, proj, b, t0, nkb, wave, lane, afr, wfr);
    __syncthreads();
#pragma unroll 1
    for (int i = 0; i < 2; ++i) {
        const int row = 2 * wave + i, n = t0 + row + 1;
        const int need = ctl[row * 8 + 3], base = ctl[row * 8 + 0];
        int nc = ctl[row * 8 + 1];
        nc = nc < CANDCAP ? nc : CANDCAP;
        if (lane == 0) { const int nf = base + (need < nc ? need : nc); ctl[row * 8 + 4] = n <= 256 ? n : (nf < 256 ? nf : 256); }
        if (need > 0) {
            for (int c0 = 0; c0 < nc; c0 += 64) {
                const int ci = c0 + lane; const bool act = ci < nc;
                const u32x2 me = cand[row * CANDCAP + (act ? ci : 0)];
                const float msc = __uint_as_float(me.x); int rank = 0;
                for (int j = 0; j < nc; ++j) { const u32x2 ot = cand[row * CANDCAP + j]; const float osc = __uint_as_float(ot.x);
                    rank += (osc > msc || (osc == msc && ot.y < me.y)) ? 1 : 0; }
                if (act && rank < need) { sel[row * 256 + ((base + rank) & 255)] = (unsigned short)me.y; const int dd = t0 + row - (int)me.y; ((LAS unsigned short*)(lds + L_SELD))[row * 256 + ((base + rank) & 255)] = (unsigned short)((dd > 127 ? 127 : dd) * 32); }
            }
        }
    }
    __syncthreads();
    int tq_ = threadIdx.x; asm volatile("" : "+v"(tq_));
    const int lane_a = tq_ & 63;
    LAS unsigned char* vst = lds + L_VST + wave * (32 * VPITCH);
#pragma unroll 1
    for (int i = 0; i < 2; ++i) { const int lane = lane_a, kc = lane >> 4, n16 = lane & 15;
        const int row = 2 * wave + i, t = t0 + row; const int nvalid = ctl[row * 8 + 4];
        const _Float16* qrow = proj + (size_t)(b * S_ + t) * PW + C_QA;
        const int head = n16, hm = head & 7;
        f16x8 qb0, qb1;
        { const f16x8 z = {0, 0, 0, 0, 0, 0, 0, 0}; qb0 = z; qb1 = z;
          if (head < 8) { qb0 = *(const f16x8*)(qrow + head * 64 + 8 * kc); qb1 = *(const f16x8*)(qrow + head * 64 + 32 + 8 * kc); } }
        f32x4 ot[4];
#pragma unroll
        for (int dt = 0; dt < 4; ++dt) ot[dt] = (f32x4){0.f, 0.f, 0.f, 0.f};
        float mrun = -INFINITY, lrun = 0.f;
        const LAS unsigned short* selr = sel + row * 256;
        const LAS unsigned short* seldr = (const LAS unsigned short*)(lds + L_SELD) + row * 256;
        const LAS unsigned char* biasb = lds + L_BIAS + hm * 4;
        const _Float16* pbat = proj + (size_t)(b * S_) * PW;
        LAS unsigned char* kst = lds + L_HIST + wave * (32 * VPITCH);
        u32x4 gk[4], gv[4];
        const char* pbyte = (const char*)pbat;
#define DSA_GATHER(jj) do { unsigned ix_[4]; _Pragma("unroll") for (int i_ = 0; i_ < 4; ++i_) ix_[i_] = (unsigned)selr[32 * (jj) + 8 * i_ + (lane >> 3)]; \
        _Pragma("unroll") for (int i_ = 0; i_ < 4; ++i_) { const int pos_ = 32 * (jj) + 8 * i_ + (lane >> 3); \
            const unsigned idx_ = pos_ < nvalid ? ix_[i_] : 0u; const char* rp_ = pbyte + (size_t)(idx_ * (unsigned)(PW * 2) + (unsigned)(C_KA * 2 + 16 * (lane & 7))); \
            gk[i_] = *(const u32x4*)rp_; gv[i_] = *(const u32x4*)(rp_ + 128); } } while (0)
        DSA_GATHER(0);
        const int nsteps = (nvalid + 31) >> 5;
#pragma unroll 1
        for (int j = 0; j < nsteps; ++j) {
#pragma unroll
            for (int i_ = 0; i_ < 4; ++i_) { const int ro = (8 * i_ + (lane >> 3)) * VPITCH + 16 * (lane & 7);
                *(LAS u32x4*)(kst + ro) = gk[i_]; *(LAS u32x4*)(vst + ro) = gv[i_]; }
            if (j + 1 < nsteps) DSA_GATHER(j + 1);
            asm volatile("s_waitcnt lgkmcnt(0)" ::: "memory");
            const f16x8 ca0 = *(const LAS f16x8*)(kst + n16 * VPITCH + 16 * kc), ca1 = *(const LAS f16x8*)(kst + n16 * VPITCH + 64 + 16 * kc);
            const f16x8 cb0 = *(const LAS f16x8*)(kst + (16 + n16) * VPITCH + 16 * kc), cb1 = *(const LAS f16x8*)(kst + (16 + n16) * VPITCH + 64 + 16 * kc);
            f32x4 sa = {0.f, 0.f, 0.f, 0.f}, sb = {0.f, 0.f, 0.f, 0.f};
            sa = __builtin_amdgcn_mfma_f32_16x16x32_f16(ca0, qb0, sa, 0, 0, 0); sa = __builtin_amdgcn_mfma_f32_16x16x32_f16(ca1, qb1, sa, 0, 0, 0);
            sb = __builtin_amdgcn_mfma_f32_16x16x32_f16(cb0, qb0, sb, 0, 0, 0); sb = __builtin_amdgcn_mfma_f32_16x16x32_f16(cb1, qb1, sb, 0, 0, 0);
            const int p0 = 32 * j + 4 * kc;
            const u32x2 iwa = *(const LAS u32x2*)(seldr + p0), iwb = *(const LAS u32x2*)(seldr + p0 + 16);
            const unsigned wa0 = iwa.x, wa1 = iwa.y, wb0 = iwb.x, wb1 = iwb.y;
            const unsigned bo[8] = {wa0 & 0xffffu, wa0 >> 16, wa1 & 0xffffu, wa1 >> 16, wb0 & 0xffffu, wb0 >> 16, wb1 & 0xffffu, wb1 >> 16};
            float v[8] = {sa.x, sa.y, sa.z, sa.w, sb.x, sb.y, sb.z, sb.w};
            float tm = -INFINITY;
            if (nvalid == 256) {
#pragma unroll
                for (int e = 0; e < 8; ++e) { v[e] = fmaf(v[e], 0.125f, *(const LAS float*)(biasb + bo[e])); tm = fmaxf(tm, v[e]); }
            } else {
#pragma unroll
                for (int e = 0; e < 8; ++e) {
                    const bool ok = (p0 + (e & 3) + 16 * (e >> 2)) < nvalid;
                    const float lg = v[e] * 0.125f + *(const LAS float*)(biasb + bo[e]);
                    v[e] = ok ? lg : -INFINITY; tm = fmaxf(tm, v[e]);
                }
            }
            tm = max_xor16(tm); tm = max_xor32(tm);
            const float mn = fmaxf(mrun, tm);
            const float alpha = __expf(mrun - mn);
            float ps = 0.f;
#pragma unroll
            for (int e = 0; e < 8; ++e) { v[e] = __expf(v[e] - mn); ps += v[e]; }
            lrun = lrun * alpha + ps; mrun = mn;
#pragma unroll
            for (int dt = 0; dt < 4; ++dt) ot[dt] = ot[dt] * alpha;
            const f16x8 pfr = {(_Float16)v[0], (_Float16)v[1], (_Float16)v[2], (_Float16)v[3], (_Float16)v[4], (_Float16)v[5], (_Float16)v[6], (_Float16)v[7]};
            asm volatile("s_waitcnt lgkmcnt(0)" ::: "memory");
            const int q = n16 >> 2, p = n16 & 3;
#pragma unroll
            for (int dt = 0; dt < 4; ++dt) {
                const s16x4 ta = __builtin_amdgcn_ds_read_tr16_b64_v4i16((LAS s16x4*)(vst + (4 * kc + q) * VPITCH + (16 * dt + 4 * p) * 2));
                const s16x4 tb = __builtin_amdgcn_ds_read_tr16_b64_v4i16((LAS s16x4*)(vst + (16 + 4 * kc + q) * VPITCH + (16 * dt + 4 * p) * 2));
                const f16x4 fa = __builtin_bit_cast(f16x4, ta), fb = __builtin_bit_cast(f16x4, tb);
                const f16x8 vfr = {fa.x, fa.y, fa.z, fa.w, fb.x, fb.y, fb.z, fb.w};
                ot[dt] = __builtin_amdgcn_mfma_f32_16x16x32_f16(vfr, pfr, ot[dt], 0, 0, 0);
            }
            asm volatile("s_waitcnt lgkmcnt(0)" ::: "memory");
        }
#undef DSA_GATHER
        lrun = sum_xor16(lrun); lrun = sum_xor32(lrun);
        const float inv = 1.f / fmaxf(lrun, 1e-30f);
        if (head < 8) {
            _Float16* orow = o_a + (size_t)(b * S_ + t) * 1024 + head * 64 + 4 * kc;
#pragma unroll
            for (int dt = 0; dt < 4; ++dt) { u32x2 w; w.x = pg8::pkh(ot[dt].x * inv, ot[dt].y * inv); w.y = pg8::pkh(ot[dt].z * inv, ot[dt].w * inv); *(u32x2*)(orow + 16 * dt) = w; }
        }
    }
    __syncthreads();
}
}


namespace nsa {
typedef _Float16 f16x8 __attribute__((ext_vector_type(8)));
typedef _Float16 f16x4 __attribute__((ext_vector_type(4)));
typedef short s16x4 __attribute__((ext_vector_type(4)));
typedef float f32x4 __attribute__((ext_vector_type(4)));
typedef float f32x16 __attribute__((ext_vector_type(16)));
typedef unsigned u32x4 __attribute__((ext_vector_type(4)));
typedef unsigned u32x2 __attribute__((ext_vector_type(2)));
constexpr int KP = 144, VP = 192;
constexpr int TILE_B = 64 * KP + 64 * VP;
constexpr int L_T0 = 0, L_BIAS = 2 * TILE_B, L_IMPA = L_BIAS + 4096, L_IMPC = L_IMPA + 16384, L_MASK = L_IMPC + 16384, L_END = L_MASK + 512;
static_assert(L_END <= 131072, "nsa LDS");
constexpr float LOG2E = 1.4426950408889634f;
constexpr float SC = 0.125f * LOG2E;
__device__ __forceinline__ float max3f(float a, float b, float c) { float r; asm("v_max3_f32 %0, %1, %2, %3" : "=v"(r) : "v"(a), "v"(b), "v"(c)); return r; }

struct Src { const _Float16* k; const _Float16* v; int pitch; };

struct Stage { u32x4 kr, vr; };
__device__ __forceinline__ void stage_load(Stage& st, const Src& s, int row0, int tid, bool need_v) {
    const int r = tid >> 3, c = tid & 7;
    st.kr = *(const u32x4*)(s.k + (size_t)(row0 + r) * s.pitch + 8 * c);
    if (need_v) st.vr = *(const u32x4*)(s.v + (size_t)(row0 + r) * s.pitch + 8 * c);
}
__device__ __forceinline__ void stage_store(const Stage& st, LAS unsigned char* tb, int tid, bool need_v) {
    const int r = tid >> 3, c = tid & 7;
    *(LAS u32x4*)(tb + r * KP + 16 * c) = st.kr;
    if (need_v) *(LAS u32x4*)(tb + 64 * KP + r * VP + 16 * c) = st.vr;
}

struct RowState { float m; f32x4 lacc; f32x16 o0, o1; };
__device__ __forceinline__ float row_sum(const RowState& rs, int rho) {
    const float a = __shfl(rs.lacc[0], rho & 15), b = __shfl(rs.lacc[1], rho & 15);
    return (rho & 16) ? b : a;
}
__device__ __forceinline__ f16x8 ones_frag() {
    int l = threadIdx.x; asm volatile("" : "+v"(l));
    const int m = l & 15, c = (l >> 4) & 3;
    const _Float16 v = (m < 2 && (c & 1) == m) ? (_Float16)1.f : (_Float16)0.f;
    const f16x8 r = {v, v, v, v, v, v, v, v};
    return r;
}

__device__ __forceinline__ void qk_half(const LAS unsigned char* kt, const f16x8 (&qf)[4], int rho, int hi, int kh, f32x16& s0) {
#pragma unroll
    for (int i = 0; i < 16; ++i) s0[i] = 0.f;
    const LAS unsigned char* kb = kt + (32 * kh + rho) * KP + 16 * hi;
#pragma unroll
    for (int ks = 0; ks < 4; ++ks) {
        const f16x8 a0 = *(const LAS f16x8*)(kb + 32 * ks);
        s0 = __builtin_amdgcn_mfma_f32_32x32x16_f16(a0, qf[ks], s0, 0, 0, 0);
    }
}
__device__ __forceinline__ void logits(f32x16& s0, const LAS float* lut, int hb, int hi, int dbase, int dstep, int dlim, bool bit) {
#pragma unroll
    for (int rg = 0; rg < 16; ++rg) {
        const int kl = (rg & 3) + 8 * (rg >> 2) + 4 * hi;
        const int d = dbase - dstep * kl;
        int dc = d < 0 ? 0 : d; dc = dc > 127 ? 127 : dc;
        const float bias = lut[dc * 8 + hb];
        const bool ok = bit && d >= 0 && d < dlim;
        s0[rg] = ok ? fmaf(s0[rg], SC, bias) : -INFINITY;
    }
}
__device__ __forceinline__ void pv_half(RowState& rs, const f32x16& s0, const LAS unsigned char* vt, int rho, int hi, int kh) {
    const int l16 = rho & 15, g16 = rho >> 4, q = l16 >> 2, p = l16 & 3;
    const LAS unsigned char* vb = vt + (32 * kh + 4 * hi + q) * VP + (16 * g16 + 4 * p) * 2;
#pragma unroll
    for (int sx = 0; sx < 2; ++sx) {
        f16x8 pfr;
#pragma unroll
        for (int j = 0; j < 8; ++j) pfr[j] = (_Float16)s0[8 * sx + j];
#pragma unroll
        for (int dt = 0; dt < 2; ++dt) {
            const s16x4 ta = __builtin_amdgcn_ds_read_tr16_b64_v4i16((LAS s16x4*)(vb + (16 * sx) * VP + 64 * dt));
            const s16x4 tb = __builtin_amdgcn_ds_read_tr16_b64_v4i16((LAS s16x4*)(vb + (16 * sx + 8) * VP + 64 * dt));
            const f16x4 fa = __builtin_bit_cast(f16x4, ta), fb = __builtin_bit_cast(f16x4, tb);
            const f16x8 vfr = {fa.x, fa.y, fa.z, fa.w, fb.x, fb.y, fb.z, fb.w};
            if (dt == 0) rs.o0 = __builtin_amdgcn_mfma_f32_32x32x16_f16(vfr, pfr, rs.o0, 0, 0, 0);
            else rs.o1 = __builtin_amdgcn_mfma_f32_32x32x16_f16(vfr, pfr, rs.o1, 0, 0, 0);
        }
    }
}
__device__ __forceinline__ void rescale_if_needed(RowState& rs, float tmx) {
    if (__any(tmx > rs.m + 8.f)) {
        const float mn = fmaxf(rs.m, tmx);
        const float mu = (mn == -INFINITY) ? 0.f : mn;
        const float alpha = __builtin_amdgcn_exp2f(rs.m - mu);
        { int l_ = threadIdx.x; asm volatile("" : "+v"(l_)); const float a16 = __shfl(alpha, (l_ & 15) + 16); rs.lacc[0] *= alpha; rs.lacc[1] *= a16; } rs.m = mn;
#pragma unroll
        for (int i = 0; i < 16; ++i) { rs.o0[i] *= alpha; rs.o1[i] *= alpha; }
    }
}
__device__ __forceinline__ void tile_fast(RowState& rs, const LAS unsigned char* kt, const LAS unsigned char* vt, const f16x8 (&qf)[4], float c, int rho, int hi) {
    const LAS unsigned char* kb = kt + rho * KP + 16 * hi;
    f16x8 ka[4], kb2[4];
#pragma unroll
    for (int ks = 0; ks < 4; ++ks) { ka[ks] = *(const LAS f16x8*)(kb + 32 * ks); kb2[ks] = *(const LAS f16x8*)(kb + 32 * KP + 32 * ks); }
    const int l16 = rho & 15, g16 = rho >> 4, q = l16 >> 2, p = l16 & 3;
    const LAS unsigned char* vb = vt + (4 * hi + q) * VP + (16 * g16 + 4 * p) * 2;
    s16x4 va[4][2], vc[4][2];
    __builtin_amdgcn_sched_barrier(0);
    f32x16 s0, s1;
#pragma unroll
    for (int i = 0; i < 16; ++i) { s0[i] = 0.f; s1[i] = 0.f; }
#pragma unroll
    for (int ks = 0; ks < 4; ++ks) {
        s0 = __builtin_amdgcn_mfma_f32_32x32x16_f16(ka[ks], qf[ks], s0, 0, 0, 0);
        s1 = __builtin_amdgcn_mfma_f32_32x32x16_f16(kb2[ks], qf[ks], s1, 0, 0, 0);
    }
    __builtin_amdgcn_sched_barrier(0);
#pragma unroll
    for (int st = 0; st < 4; ++st)
#pragma unroll
        for (int dt = 0; dt < 2; ++dt) {
            va[st][dt] = __builtin_amdgcn_ds_read_tr16_b64_v4i16((LAS s16x4*)(vb + (16 * st) * VP + 64 * dt));
            vc[st][dt] = __builtin_amdgcn_ds_read_tr16_b64_v4i16((LAS s16x4*)(vb + (16 * st + 8) * VP + 64 * dt));
        }
    __builtin_amdgcn_sched_barrier(0);
    float tm = max3f(s0[0], s1[0], -INFINITY);
#pragma unroll
    for (int i = 1; i < 16; ++i) tm = max3f(tm, s0[i], s1[i]);
    { const auto r2 = __builtin_amdgcn_permlane32_swap(__float_as_uint(tm), __float_as_uint(tm), false, false); tm = fmaxf(__uint_as_float(r2[0]), __uint_as_float(r2[1])); }
    rescale_if_needed(rs, fmaf(tm, SC, c));
    const float mu = (rs.m == -INFINITY) ? 0.f : rs.m;
    const float cm = c - mu;
#pragma unroll
    for (int i = 0; i < 16; ++i) { s0[i] = __builtin_amdgcn_exp2f(fmaf(s0[i], SC, cm)); s1[i] = __builtin_amdgcn_exp2f(fmaf(s1[i], SC, cm)); }
    const f16x8 onesf = ones_frag();
#pragma unroll
    for (int st = 0; st < 4; ++st) {
        f16x8 pfr;
#pragma unroll
        for (int j = 0; j < 8; ++j) pfr[j] = (_Float16)((st & 2) ? s1[8 * (st & 1) + j] : s0[8 * (st & 1) + j]);
        rs.lacc = __builtin_amdgcn_mfma_f32_16x16x32_f16(onesf, pfr, rs.lacc, 0, 0, 0);
#pragma unroll
        for (int dt = 0; dt < 2; ++dt) {
            const f16x4 fa = __builtin_bit_cast(f16x4, va[st][dt]), fb = __builtin_bit_cast(f16x4, vc[st][dt]);
            const f16x8 vfr = {fa.x, fa.y, fa.z, fa.w, fb.x, fb.y, fb.z, fb.w};
            if (dt == 0) rs.o0 = __builtin_amdgcn_mfma_f32_32x32x16_f16(vfr, pfr, rs.o0, 0, 0, 0);
            else rs.o1 = __builtin_amdgcn_mfma_f32_32x32x16_f16(vfr, pfr, rs.o1, 0, 0, 0);
        }
    }
}
template <bool IMP>
__device__ __forceinline__ void tile_general(RowState& rs, const LAS unsigned char* kt, const LAS unsigned char* vt, const f16x8 (&qf)[4], const LAS float* lut, int hb, int rho, int hi,
                                             int dbase, int dstep, unsigned dlim, float mc, float invl, LAS float* impA, LAS float* impC, int n, bool wr) {
    const LAS unsigned char* kb = kt + rho * KP + 16 * hi;
    f16x8 ka[4], kb2[4];
#pragma unroll
    for (int ks = 0; ks < 4; ++ks) { ka[ks] = *(const LAS f16x8*)(kb + 32 * ks); kb2[ks] = *(const LAS f16x8*)(kb + 32 * KP + 32 * ks); }
    const int d0 = dbase - dstep * 4 * hi;
    __builtin_amdgcn_sched_barrier(0);
    f32x16 s0, s1;
#pragma unroll
    for (int i = 0; i < 16; ++i) { s0[i] = 0.f; s1[i] = 0.f; }
#pragma unroll
    for (int ks = 0; ks < 4; ++ks) {
        s0 = __builtin_amdgcn_mfma_f32_32x32x16_f16(ka[ks], qf[ks], s0, 0, 0, 0);
        s1 = __builtin_amdgcn_mfma_f32_32x32x16_f16(kb2[ks], qf[ks], s1, 0, 0, 0);
    }
    __builtin_amdgcn_sched_barrier(0);
    float b0[16], b1[16];
#pragma unroll
    for (int rg = 0; rg < 16; ++rg) {
        const int kl = (rg & 3) + 8 * (rg >> 2);
        int da = d0 - dstep * kl, db = d0 - dstep * (kl + 32);
        da = da < 0 ? 0 : da; da = da > 127 ? 127 : da; db = db < 0 ? 0 : db; db = db > 127 ? 127 : db;
        b0[rg] = lut[da * 8 + hb]; b1[rg] = lut[db * 8 + hb];
    }
    float tm = -INFINITY;
#pragma unroll
    for (int rg = 0; rg < 16; ++rg) {
        const int kl = (rg & 3) + 8 * (rg >> 2);
        const unsigned da = (unsigned)(d0 - dstep * kl), db = (unsigned)(d0 - dstep * (kl + 32));
        s0[rg] = da < dlim ? fmaf(s0[rg], SC, b0[rg]) : -INFINITY;
        s1[rg] = db < dlim ? fmaf(s1[rg], SC, b1[rg]) : -INFINITY;
        tm = max3f(tm, s0[rg], s1[rg]);
    }
    __builtin_amdgcn_sched_barrier(0);
    const int l16 = rho & 15, g16 = rho >> 4, q = l16 >> 2, p = l16 & 3;
    const LAS unsigned char* vb = vt + (4 * hi + q) * VP + (16 * g16 + 4 * p) * 2;
    s16x4 va[4][2], vc[4][2];
    if (!IMP) {
#pragma unroll
        for (int st = 0; st < 4; ++st)
#pragma unroll
            for (int dt = 0; dt < 2; ++dt) {
                va[st][dt] = __builtin_amdgcn_ds_read_tr16_b64_v4i16((LAS s16x4*)(vb + (16 * st) * VP + 64 * dt));
                vc[st][dt] = __builtin_amdgcn_ds_read_tr16_b64_v4i16((LAS s16x4*)(vb + (16 * st + 8) * VP + 64 * dt));
            }
        __builtin_amdgcn_sched_barrier(0);
    }
    if (!IMP) {
        { const auto r2 = __builtin_amdgcn_permlane32_swap(__float_as_uint(tm), __float_as_uint(tm), false, false); tm = fmaxf(__uint_as_float(r2[0]), __uint_as_float(r2[1])); }
        rescale_if_needed(rs, tm);
        const float mu = (rs.m == -INFINITY) ? 0.f : rs.m;
#pragma unroll
        for (int i = 0; i < 16; ++i) { s0[i] = __builtin_amdgcn_exp2f(s0[i] - mu); s1[i] = __builtin_amdgcn_exp2f(s1[i] - mu); }
        const f16x8 onesf = ones_frag();
#pragma unroll
        for (int st = 0; st < 4; ++st) {
            f16x8 pfr;
#pragma unroll
            for (int j = 0; j < 8; ++j) pfr[j] = (_Float16)((st & 2) ? s1[8 * (st & 1) + j] : s0[8 * (st & 1) + j]);
            rs.lacc = __builtin_amdgcn_mfma_f32_16x16x32_f16(onesf, pfr, rs.lacc, 0, 0, 0);
#pragma unroll
            for (int dt = 0; dt < 2; ++dt) {
                const f16x4 fa = __builtin_bit_cast(f16x4, va[st][dt]), fb = __builtin_bit_cast(f16x4, vc[st][dt]);
                const f16x8 vfr = {fa.x, fa.y, fa.z, fa.w, fb.x, fb.y, fb.z, fb.w};
                if (dt == 0) rs.o0 = __builtin_amdgcn_mfma_f32_32x32x16_f16(vfr, pfr, rs.o0, 0, 0, 0);
                else rs.o1 = __builtin_amdgcn_mfma_f32_32x32x16_f16(vfr, pfr, rs.o1, 0, 0, 0);
            }
        }
    } else {
        const float mu = (mc == -INFINITY) ? 0.f : mc;
#pragma unroll
        for (int kh = 0; kh < 2; ++kh)
#pragma unroll
            for (int ii = 0; ii < 4; ++ii) {
                float pv[4];
#pragma unroll
                for (int e = 0; e < 4; ++e) pv[e] = __builtin_amdgcn_exp2f((kh ? s1[4 * ii + e] : s0[4 * ii + e]) - mu) * invl;
                float a = (pv[0] + pv[1]) + (pv[2] + 0.5f * pv[3]), c = 0.5f * pv[3];
                a += xchg_xor1(a); a += xchg_xor2(a); c += xchg_xor1(c); c += xchg_xor2(c);
                const int nb = 16 * n + 8 * kh + 2 * ii + hi;
                if (wr) { impA[nb] = a; if (nb + 1 < 64) impC[nb + 1] = c; }
            }
    }
}
__device__ __forceinline__ void probs(RowState& rs, f32x16& s0, float sc, float c) {
    float tm = -INFINITY;
#pragma unroll
    for (int i = 0; i < 16; ++i) tm = fmaxf(tm, s0[i]);
    tm = fmaxf(tm, __shfl_xor(tm, 32));
    rescale_if_needed(rs, fmaf(tm, sc, c));
    const float mu = (rs.m == -INFINITY) ? 0.f : rs.m;
    const float cm = c - mu;
    float ps = 0.f;
#pragma unroll
    for (int i = 0; i < 16; ++i) { s0[i] = __builtin_amdgcn_exp2f(fmaf(s0[i], sc, cm)); ps += s0[i]; }
    rs.lacc[0] += ps;
}
__device__ __forceinline__ void rs_init(RowState& rs) { rs.m = -INFINITY; rs.lacc = (f32x4){0.f, 0.f, 0.f, 0.f};
#pragma unroll
    for (int i = 0; i < 16; ++i) { rs.o0[i] = 0.f; rs.o1[i] = 0.f; } }
template <int MODE>
__device__ __forceinline__ void rs_flush(RowState& rs, float gate, LAS unsigned char* accl, _Float16* orow) {
    int lf_ = threadIdx.x; asm volatile("" : "+v"(lf_));
    const float lt = row_sum(rs, lf_ & 31);
    const float w = gate / fmaxf(lt, 1e-30f);
#pragma unroll
    for (int i = 0; i < 4; ++i) {
        float a[8] = {w * rs.o0[4 * i], w * rs.o0[4 * i + 1], w * rs.o0[4 * i + 2], w * rs.o0[4 * i + 3], w * rs.o1[4 * i], w * rs.o1[4 * i + 1], w * rs.o1[4 * i + 2], w * rs.o1[4 * i + 3]};
        LAS unsigned char* ap = accl + (i >> 1) * 16384 + (i & 1) * 1024;
        if (MODE != 0) { float p[8]; pg8::unpk8(*(const LAS u32x4*)ap, p);
#pragma unroll
            for (int e = 0; e < 8; ++e) a[e] += p[e]; }
        u32x4 wv; wv.x = pg8::pkh(a[0], a[1]); wv.y = pg8::pkh(a[2], a[3]); wv.z = pg8::pkh(a[4], a[5]); wv.w = pg8::pkh(a[6], a[7]);
        if (MODE != 2) *(LAS u32x4*)ap = wv;
        else { u32x2 w0; w0.x = wv.x; w0.y = wv.y; u32x2 w1; w1.x = wv.z; w1.y = wv.w; *(u32x2*)(orow + 8 * i) = w0; *(u32x2*)(orow + 32 + 8 * i) = w1; }
    }
}

__device__ __forceinline__ void nsa_unit(LAS unsigned char* lds, const _Float16* __restrict__ proj, const _Float16* __restrict__ kcmp, const _Float16* __restrict__ vcmp,
                                         _Float16* __restrict__ o_b, int b, int g, int qb) {
    const int tid = threadIdx.x, lane = tid & 63, wave = __builtin_amdgcn_readfirstlane(tid >> 6);
    const int rho = lane & 31, hi = lane >> 5, ql = rho >> 2, r = rho & 3, hb = g * 4 + r;
    const int t = 64 * qb + 8 * wave + ql;
    const _Float16* prow = proj + (size_t)(b * S_ + t) * PW;
    f16x8 qf[4];
#pragma unroll
    for (int ks = 0; ks < 4; ++ks) qf[ks] = *(const f16x8*)(prow + C_QB + hb * 64 + 16 * ks + 8 * hi);
    for (int i = tid; i < 2048; i += 512) ((LAS u32x4*)(lds + L_IMPA))[i] = (u32x4){0u, 0u, 0u, 0u};
    RowState rs; rs_init(rs);
    const LAS float* lut = (const LAS float*)(lds + L_BIAS);
    const float bias31 = lut[127 * 8 + hb];
    const _Float16* kc = kcmp + (size_t)(b * 2 + g) * 256 * 64;
    const long vcoff = (vcmp + (size_t)(b * 2 + g) * 256 * 64) - kc;
    const _Float16* pb = proj + (size_t)(b * S_) * PW + C_KVB + g * 64;
    const int ncmp = (4 * qb + 3 + 63) / 64;
    const int wlo = qb - 8 > 0 ? qb - 8 : 0;
    const int e0 = ncmp, e1 = 2 * ncmp, e2 = e1 + qb + 1, NT = e2 + (qb - wlo + 1);
    const int sgrp = wave >> 2, tl = tid & 255, sr = tl >> 2, sq = tl & 3;
    float mc = 0.f, invl = 0.f; unsigned mlo = 0u, mhi = 0u;
    u32x4 sk0 = {0u, 0u, 0u, 0u}, sk1 = sk0, sv0 = sk0, sv1 = sk0;
#define NSA_DECODE(i, br, n) do { if ((i) < e0) { br = 0; n = (i); } else if ((i) < e1) { br = 1; n = (i) - e0; } else if ((i) < e2) { br = 2; n = (i) - e1; } else { br = 3; n = wlo + (i) - e2; } } while (0)
#define NSA_LOAD(i) do { int br_, n_; NSA_DECODE(i, br_, n_); const _Float16* kp_ = (br_ < 2) ? kc : (br_ == 2 ? pb + 2 * 128 : pb + 4 * 128); const int pitch_ = (br_ < 2) ? 64 : PW; \
        const long vo_ = (br_ < 2) ? vcoff : 128; const _Float16* rp_ = kp_ + (size_t)(64 * n_ + sr) * pitch_ + 16 * sq; \
        sk0 = *(const u32x4*)rp_; sk1 = *(const u32x4*)(rp_ + 8); sv0 = *(const u32x4*)(rp_ + vo_); sv1 = *(const u32x4*)(rp_ + vo_ + 8); } while (0)
#define NSA_STORE(buf) do { LAS unsigned char* tb_ = lds + L_T0 + (buf) * TILE_B; *(LAS u32x4*)(tb_ + sr * KP + 32 * sq) = sk0; *(LAS u32x4*)(tb_ + sr * KP + 32 * sq + 16) = sk1; \
        *(LAS u32x4*)(tb_ + 64 * KP + sr * VP + 32 * sq) = sv0; *(LAS u32x4*)(tb_ + 64 * KP + sr * VP + 32 * sq + 16) = sv1; } while (0)
    __syncthreads();
    asm volatile("" :: "v"(qf[0]), "v"(qf[1]), "v"(qf[2]), "v"(qf[3]), "v"(bias31));
    if (sgrp == 0) { NSA_LOAD(0); NSA_STORE(0); if (NT > 2) NSA_LOAD(2); } else if (NT > 1) NSA_LOAD(1);
    __syncthreads();
#pragma unroll 1
    for (int i = 0; i < NT; ++i) {
        int br, n; NSA_DECODE(i, br, n);
        const LAS unsigned char* tb = lds + L_T0 + (i & 1) * TILE_B;
        const bool more = i + 1 < NT;
        bool bit = true; int dbase, dstep = 1, dlim = 1 << 30; bool near = true;
        if (br < 2) { dbase = t - 31 - 1024 * n; dstep = 16; }
        else { dbase = t - 64 * n; near = n >= qb - 2; if (br == 2) bit = (n < 32) ? ((mlo >> n) & 1u) : ((mhi >> (n - 32)) & 1u); else dlim = 512; }
        const bool interior = (br >= 2) && (n <= qb - 3) && !(br == 3 && n == qb - 8);
        const bool skip = (br == 2) && !__any(bit);
        if (!skip) {
            if (interior) tile_fast(rs, tb, tb + 64 * KP, qf, bit ? bias31 : -INFINITY, rho, hi);
            else {
                const unsigned dl = bit ? (unsigned)dlim : 0u;
                int tq = threadIdx.x; asm volatile("" : "+v"(tq));
                LAS float* impA = (LAS float*)(lds + L_IMPA) + ((tq >> 6) * 8 + ((tq & 31) >> 2)) * 64;
                LAS float* impC = (LAS float*)(lds + L_IMPC) + ((tq >> 6) * 8 + ((tq & 31) >> 2)) * 64;
                if (br != 1) tile_general<false>(rs, tb, tb + 64 * KP, qf, lut, hb, rho, hi, dbase, dstep, dl, 0.f, 0.f, impA, impC, n, false);
                else tile_general<true>(rs, tb, tb + 64 * KP, qf, lut, hb, rho, hi, dbase, dstep, dl, mc, invl, impA, impC, n, r == 0);
            }
        }
        if (i + 1 == e0) {
            mc = rs.m; const float lc = row_sum(rs, rho); invl = 1.f / fmaxf(lc, 1e-30f);
        } else if (i + 1 == e1) {
            asm volatile("s_waitcnt lgkmcnt(0)" ::: "memory");
            int tq = threadIdx.x; asm volatile("" : "+v"(tq));
            const int qs = (tq & 63) >> 3, j = tq & 7, wv = tq >> 6;
            LAS float* sA = (LAS float*)(lds + L_IMPA) + (wv * 8 + qs) * 64;
            const LAS float* sC = (const LAS float*)(lds + L_IMPC) + (wv * 8 + qs) * 64;
            float sc[8];
#pragma unroll
            for (int e = 0; e < 8; ++e) { const int nn = 8 * j + e; const bool forced = (nn == 0) || (nn == qb) || (nn == qb - 1);
                sc[e] = (nn <= qb) ? (forced ? 1.0e4f : (sA[nn] + sC[nn])) : -INFINITY; }
            asm volatile("s_waitcnt lgkmcnt(0)" ::: "memory");
#pragma unroll
            for (int e = 0; e < 8; ++e) sA[8 * j + e] = sc[e];
            asm volatile("s_waitcnt lgkmcnt(0)" ::: "memory");
            int rank[8]; unsigned long long ke[8];
#pragma unroll
            for (int e = 0; e < 8; ++e) { rank[e] = 0; ke[e] = ((unsigned long long)__float_as_uint(sc[e]) << 32) | (unsigned)(63 - (8 * j + e)); }
#pragma unroll 1
            for (int m = 0; m <= qb; m += 4) { const f32x4 sv = *(const LAS f32x4*)(sA + m);
                const float sv4[4] = {sv.x, sv.y, sv.z, sv.w};
#pragma unroll
                for (int u = 0; u < 4; ++u) { const int mm = m + u;
                    const unsigned long long km = (mm <= qb) ? (((unsigned long long)__float_as_uint(sv4[u]) << 32) | (unsigned)(63 - mm)) : 0ull;
#pragma unroll
                    for (int e = 0; e < 8; ++e) rank[e] += (km > ke[e]) ? 1 : 0; } }
            unsigned bits = 0;
#pragma unroll
            for (int e = 0; e < 8; ++e) bits |= ((8 * j + e <= qb) && rank[e] < 16) ? (1u << e) : 0u;
            ((LAS unsigned char*)(lds + L_MASK))[(wv * 8 + qs) * 8 + j] = (unsigned char)bits;
            asm volatile("s_waitcnt lgkmcnt(0)" ::: "memory");
            const u32x2 mk = *(const LAS u32x2*)(lds + L_MASK + (wv * 8 + ((tq & 31) >> 2)) * 8);
            mlo = mk.x; mhi = mk.y;
            rs_flush<0>(rs, pg8::sigm((float)prow[C_GB + 0 * 8 + hb]), lds + L_IMPA + (tq >> 6) * 2048 + (tq & 63) * 16, nullptr); rs_init(rs);
        } else if (i + 1 == e2) {
            rs_flush<1>(rs, pg8::sigm((float)prow[C_GB + 1 * 8 + hb]), lds + L_IMPA + wave * 2048 + lane * 16, nullptr); rs_init(rs);
        } else if (i + 1 == NT) {
            rs_flush<2>(rs, pg8::sigm((float)prow[C_GB + 2 * 8 + hb]), lds + L_IMPA + wave * 2048 + lane * 16, o_b + (size_t)(b * S_ + t) * 1024 + hb * 64 + 4 * hi);
        }
        if (sgrp == ((i + 1) & 1)) {
            if (more) NSA_STORE((i + 1) & 1);
            if (i + 3 < NT) NSA_LOAD(i + 3);
        }
        asm volatile("s_waitcnt lgkmcnt(0)" ::: "memory");
        __builtin_amdgcn_s_barrier();
    }
#undef NSA_DECODE
#undef NSA_LOAD
#undef NSA_STORE
}
}


namespace cmpx {
typedef _Float16 f16x8 __attribute__((ext_vector_type(8)));
typedef float f32x4 __attribute__((ext_vector_type(4)));
typedef unsigned u32x4 __attribute__((ext_vector_type(4)));
constexpr int L_PART = 0, L_HID = 65536, HIDP = 272, L_END = L_HID + 2 * 16 * HIDP;
__device__ __forceinline__ void item(LAS unsigned char* lds, const _Float16* __restrict__ proj, const float* __restrict__ pe, const _Float16* __restrict__ w1t, const _Float16* __restrict__ w2t,
                                     _Float16* __restrict__ dst, int b, int g, int kv, int ct) {
    const int tid = threadIdx.x, lane = tid & 63, wave = __builtin_amdgcn_readfirstlane(tid >> 6), kc = lane >> 4, n16 = lane & 15;
    f32x4 acc[8];
#pragma unroll
    for (int nt = 0; nt < 8; ++nt) acc[nt] = (f32x4){0.f, 0.f, 0.f, 0.f};
    const int c = 16 * ct + n16;
#pragma unroll 2
    for (int ks = 0; ks < 8; ++ks) {
        const int k0 = 32 * (8 * wave + ks) + 8 * kc, lt = k0 >> 6, d = k0 & 63;
        int trow = 16 * c + lt; trow = trow > S_ - 1 ? S_ - 1 : trow;
        const f16x8 raw = *(const f16x8*)(proj + (size_t)(b * S_ + trow) * PW + C_KVB + kv * 128 + g * 64 + d);
        const f32x4 p0 = *(const f32x4*)(pe + lt * 64 + d), p1 = *(const f32x4*)(pe + lt * 64 + d + 4);
        f16x8 afr;
        afr[0] = (_Float16)((float)raw[0] + p0.x); afr[1] = (_Float16)((float)raw[1] + p0.y); afr[2] = (_Float16)((float)raw[2] + p0.z); afr[3] = (_Float16)((float)raw[3] + p0.w);
        afr[4] = (_Float16)((float)raw[4] + p1.x); afr[5] = (_Float16)((float)raw[5] + p1.y); afr[6] = (_Float16)((float)raw[6] + p1.z); afr[7] = (_Float16)((float)raw[7] + p1.w);
#pragma unroll
        for (int nt = 0; nt < 8; ++nt) {
            const f16x8 bfr = *(const f16x8*)(w1t + (size_t)(16 * nt + n16) * 2048 + k0);
            acc[nt] = __builtin_amdgcn_mfma_f32_16x16x32_f16(afr, bfr, acc[nt], 0, 0, 0);
        }
    }
    LAS float* part = (LAS float*)(lds + L_PART) + wave * 2048;
#pragma unroll
    for (int nt = 0; nt < 8; ++nt) { part[(4 * kc + 0) * 128 + 16 * nt + n16] = acc[nt].x; part[(4 * kc + 1) * 128 + 16 * nt + n16] = acc[nt].y;
        part[(4 * kc + 2) * 128 + 16 * nt + n16] = acc[nt].z; part[(4 * kc + 3) * 128 + 16 * nt + n16] = acc[nt].w; }
    __syncthreads();
    { const LAS float* pp = (const LAS float*)(lds + L_PART);
#pragma unroll
      for (int e = 0; e < 4; ++e) { const int o = tid + 512 * e; float a = 0.f;
#pragma unroll
          for (int w = 0; w < 8; ++w) a += pp[w * 2048 + o];
          const float z = 0.7978845608028654f * (a + 0.044715f * a * a * a);
          const float th = 1.f - 2.f / (__expf(2.f * z) + 1.f);
          ((LAS _Float16*)(lds + L_HID + (o >> 7) * HIDP))[o & 127] = (_Float16)(0.5f * a * (1.f + th)); } }
    __syncthreads();
    if (wave < 4) {
        f32x4 o = {0.f, 0.f, 0.f, 0.f};
#pragma unroll
        for (int ks = 0; ks < 4; ++ks) {
            const f16x8 afr = *(const LAS f16x8*)(lds + L_HID + n16 * HIDP + (32 * ks + 8 * kc) * 2);
            const f16x8 bfr = *(const f16x8*)(w2t + (size_t)(16 * wave + n16) * 128 + 32 * ks + 8 * kc);
            o = __builtin_amdgcn_mfma_f32_16x16x32_f16(afr, bfr, o, 0, 0, 0);
        }
        const float ov[4] = {o.x, o.y, o.z, o.w};
#pragma unroll
        for (int e = 0; e < 4; ++e) { const int cc = 16 * ct + 4 * kc + e; dst[((size_t)(b * 2 + g) * 256 + cc) * 64 + 16 * wave + n16] = (_Float16)(cc == 255 ? 0.f : ov[e]); }
    }
    __syncthreads();
}
__device__ __forceinline__ void item2(LAS unsigned char* lds, const _Float16* __restrict__ proj, const float* __restrict__ pe, const _Float16* __restrict__ w1t, const _Float16* __restrict__ w2t,
                                      _Float16* __restrict__ dst, int b0, int b1, int g, int kv, int ct) {
    const int tid = threadIdx.x, lane = tid & 63, wave = __builtin_amdgcn_readfirstlane(tid >> 6), kc = lane >> 4, n16 = lane & 15;
    f32x4 acc0[8], acc1[8];
#pragma unroll
    for (int nt = 0; nt < 8; ++nt) { acc0[nt] = (f32x4){0.f, 0.f, 0.f, 0.f}; acc1[nt] = (f32x4){0.f, 0.f, 0.f, 0.f}; }
    const int c = 16 * ct + n16;
#pragma unroll 2
    for (int ks = 0; ks < 8; ++ks) {
        const int k0 = 32 * (8 * wave + ks) + 8 * kc, lt = k0 >> 6, d = k0 & 63;
        int trow = 16 * c + lt; trow = trow > S_ - 1 ? S_ - 1 : trow;
        const f16x8 raw0 = *(const f16x8*)(proj + (size_t)(b0 * S_ + trow) * PW + C_KVB + kv * 128 + g * 64 + d);
        const f16x8 raw1 = *(const f16x8*)(proj + (size_t)(b1 * S_ + trow) * PW + C_KVB + kv * 128 + g * 64 + d);
        const f32x4 p0 = *(const f32x4*)(pe + lt * 64 + d), p1 = *(const f32x4*)(pe + lt * 64 + d + 4);
        const float pv[8] = {p0.x, p0.y, p0.z, p0.w, p1.x, p1.y, p1.z, p1.w};
        f16x8 afr0, afr1;
#pragma unroll
        for (int e = 0; e < 8; ++e) { afr0[e] = (_Float16)((float)raw0[e] + pv[e]); afr1[e] = (_Float16)((float)raw1[e] + pv[e]); }
#pragma unroll
        for (int nt = 0; nt < 8; ++nt) {
            const f16x8 bfr = *(const f16x8*)(w1t + (size_t)(16 * nt + n16) * 2048 + k0);
            acc0[nt] = __builtin_amdgcn_mfma_f32_16x16x32_f16(afr0, bfr, acc0[nt], 0, 0, 0);
            acc1[nt] = __builtin_amdgcn_mfma_f32_16x16x32_f16(afr1, bfr, acc1[nt], 0, 0, 0);
        }
    }
    LAS float* part = (LAS float*)(lds + L_PART) + wave * 2048;
#pragma unroll 1
    for (int it = 0; it < 2; ++it) {
#pragma unroll
        for (int nt = 0; nt < 8; ++nt) { const f32x4 v = it ? acc1[nt] : acc0[nt];
            part[(4 * kc + 0) * 128 + 16 * nt + n16] = v.x; part[(4 * kc + 1) * 128 + 16 * nt + n16] = v.y;
            part[(4 * kc + 2) * 128 + 16 * nt + n16] = v.z; part[(4 * kc + 3) * 128 + 16 * nt + n16] = v.w; }
        __syncthreads();
        { const LAS float* pp = (const LAS float*)(lds + L_PART);
#pragma unroll
          for (int e = 0; e < 4; ++e) { const int o = tid + 512 * e; float a = 0.f;
#pragma unroll
              for (int w = 0; w < 8; ++w) a += pp[w * 2048 + o];
              const float z = 0.7978845608028654f * (a + 0.044715f * a * a * a);
              const float th = 1.f - 2.f / (__expf(2.f * z) + 1.f);
              ((LAS _Float16*)(lds + L_HID + it * 16 * HIDP + (o >> 7) * HIDP))[o & 127] = (_Float16)(0.5f * a * (1.f + th)); } }
        __syncthreads();
    }
    {
        const int it = wave >> 2, wt = wave & 3, b = it ? b1 : b0;
        f32x4 o = {0.f, 0.f, 0.f, 0.f};
#pragma unroll
        for (int ks = 0; ks < 4; ++ks) {
            const f16x8 afr = *(const LAS f16x8*)(lds + L_HID + it * 16 * HIDP + n16 * HIDP + (32 * ks + 8 * kc) * 2);
            const f16x8 bfr = *(const f16x8*)(w2t + (size_t)(16 * wt + n16) * 128 + 32 * ks + 8 * kc);
            o = __builtin_amdgcn_mfma_f32_16x16x32_f16(afr, bfr, o, 0, 0, 0);
        }
        const float ov[4] = {o.x, o.y, o.z, o.w};
#pragma unroll
        for (int e = 0; e < 4; ++e) { const int cc = 16 * ct + 4 * kc + e; dst[((size_t)(b * 2 + g) * 256 + cc) * 64 + 16 * wt + n16] = (_Float16)(cc == 255 ? 0.f : ov[e]); }
    }
    __syncthreads();
}
}


#define XB_TMO      128
#define XB_XCNT(j)  (256  + 64 * (j))
#define XB_XSUB(j)  (1280 + 64 * (j))
#define XB_XGEN(j)  (2304 + 64 * (j))
#define XB_TOP      3328
#define XB_TOPGEN   3392
#define XCD_BAR_WORDS 3456
#define XB_SPIN_CAP (1u << 18)
__device__ __forceinline__ unsigned xb_ld(unsigned* p)              { return __hip_atomic_load(p, __ATOMIC_RELAXED, __HIP_MEMORY_SCOPE_AGENT); }
__device__ __forceinline__ unsigned xb_add(unsigned* p, unsigned v) { return __hip_atomic_fetch_add(p, v, __ATOMIC_RELAXED, __HIP_MEMORY_SCOPE_AGENT); }
__device__ __forceinline__ unsigned xb_xcc_id() { return (unsigned)__builtin_amdgcn_s_getreg((3 << 11) | 20) & 0xFu; }
#define XB_SPIN(cond, bar) do { unsigned _sp = 0; while (cond) { __builtin_amdgcn_s_sleep(1); \
    if ((++_sp & 255u) == 0u) { if (xb_ld(&(bar)[XB_TMO])) break; if (_sp > XB_SPIN_CAP) { atomicAdd(&(bar)[XB_TMO], 1u); break; } } } } while (0)
struct XcdBarrier { unsigned* bar; unsigned x; volatile LAS unsigned* st; };
__device__ __forceinline__ XcdBarrier xcd_barrier_post(unsigned* bar, volatile LAS unsigned* st) {
    XcdBarrier b; b.bar = bar; b.x = xb_xcc_id(); b.st = st;
    if (threadIdx.x == 0) (void)xb_add(&bar[XB_XCNT(b.x)], 1u);
    return b;
}
__device__ __forceinline__ void xcd_barrier_complete(unsigned* bar, unsigned x, unsigned& nloc, unsigned& nx) {
    const unsigned G = gridDim.x * gridDim.y * gridDim.z;
    unsigned sum, cnt, mine, sp = 0u;
    for (;;) {
        sum = 0u; cnt = 0u; mine = 0u;
#pragma unroll
        for (unsigned j = 0; j < 16; ++j) { const unsigned c = xb_ld(&bar[XB_XCNT(j)]); sum += c; cnt += (c > 0u) ? 1u : 0u; mine = (j == x) ? c : mine; }
        if (sum == G) break;
        __builtin_amdgcn_s_sleep(1);
        if ((++sp & 255u) == 0u) { if (xb_ld(&bar[XB_TMO])) break; if (sp > XB_SPIN_CAP) { atomicAdd(&bar[XB_TMO], 1u); break; } }
    }
    nloc = mine > 0u ? mine : 1u; nx = cnt > 0u ? cnt : 1u;
}
__device__ __forceinline__ void xcd_barrier(const XcdBarrier& b) {
    asm volatile("s_waitcnt vmcnt(0)" ::: "memory");
    __syncthreads();
    if (threadIdx.x == 0) {
        unsigned* bar = b.bar;
        __builtin_amdgcn_s_waitcnt(0);
        unsigned nloc = b.st[0], nx = b.st[1];
        if (nloc == 0u) { xcd_barrier_complete(bar, b.x, nloc, nx); b.st[0] = nloc; b.st[1] = nx; }
        const unsigned old = xb_add(&bar[XB_XSUB(b.x)], 1u);
        const unsigned gen = old / nloc;
        if (old + 1u == (gen + 1u) * nloc) {
            __builtin_amdgcn_fence(__ATOMIC_RELEASE, "agent");
            asm volatile("s_waitcnt vmcnt(0)" ::: "memory");
            const unsigned og = xb_add(&bar[XB_TOP], 1u);
            const unsigned tg = og / nx;
            if (og + 1u == (tg + 1u) * nx) xb_add(&bar[XB_TOPGEN], 1u);
            else XB_SPIN(xb_ld(&bar[XB_TOPGEN]) == tg, bar);
            __builtin_amdgcn_fence(__ATOMIC_ACQUIRE, "agent");
            xb_add(&bar[XB_XGEN(b.x)], 1u);
            asm volatile("s_waitcnt vmcnt(0)" ::: "memory");
        } else {
            XB_SPIN(xb_ld(&bar[XB_XGEN(b.x)]) == gen, bar);
            __builtin_amdgcn_fence(__ATOMIC_ACQUIRE, "agent");
            asm volatile("s_waitcnt vmcnt(0)" ::: "memory");
        }
    }
    __syncthreads();
}

constexpr int MEGA_LDS = 131072 + 256;

template <class Epi>
__device__ __forceinline__ void gemm_run(LAS unsigned char* lds, const void* A, const void* Bt, const Epi& E, int M, int N, int K) {
    pg8::Gemm g{(const pg8::bf16_t*)A, (const pg8::bf16_t*)Bt, M, N, K};
    pg8::StaticOrder S; S.init(M, N, (int)gridDim.x, (int)blockIdx.x);
    pg8::gemm_phase<Epi, pg8::StaticOrder, true, true>(lds, g, S, E);
}

__global__ void __launch_bounds__(512, 2) mega_fwd(Args a) {
    extern __shared__ __attribute__((aligned(16))) unsigned char lds_raw[];
    LAS unsigned char* lds = (LAS unsigned char*)lds_raw;
    unsigned char* ws = a.ws;
    if (threadIdx.x == 0) *(LAS dsa::u32x4*)(lds + 131072) = (dsa::u32x4){0u, 0u, 0u, 0u};
    __syncthreads();
    XcdBarrier bar = xcd_barrier_post((unsigned*)(ws + WS_CTL), (volatile LAS unsigned*)(lds + 131072));
    const _Float16* proj = (const _Float16*)(ws + WS_PROJ);
    _Float16* o_a = (_Float16*)(ws + WS_OAB); _Float16* o_b = (_Float16*)(ws + WS_OAB) + 512;
    _Float16* kcmp = (_Float16*)(ws + WS_KCMP); _Float16* vcmp = (_Float16*)(ws + WS_VCMP);

    prologue_body(a, lds_raw);
    xcd_barrier(bar);
    gemm_run(lds, ws + WS_H, ws + WS_WIN, pg8::EpiProj{(_Float16*)(ws + WS_PROJ), (_Float16*)(ws + WS_KIC)}, M_, PW, D_);
    if (blockIdx.x >= 128) mlp_weights_body(a, lds_raw);
    xcd_barrier(bar);
    { const int it = (int)blockIdx.x; const int ct = it & 15, kv = (it >> 4) & 1, g = (it >> 5) & 1, b = it >> 6;
      cmpx::item2(lds, proj, kv ? a.pe_v : a.pe_k, (const _Float16*)(ws + WS_CW + (kv ? 512 * 1024 : 0)), (const _Float16*)(ws + WS_CW + 1024 * 1024 + (kv ? 16384 : 0)), kv ? vcmp : kcmp, b, b + 4, g, kv, ct); }
    { LAS float* biaslut = (LAS float*)(lds + dsa::L_BIAS);
      for (int i = threadIdx.x; i < 1024; i += 512) { const int d = i >> 3, h = i & 7; biaslut[i] = a.rel_bias[t5_bucket(d) * 16 + h]; } }
    __syncthreads();
#pragma unroll 1
    for (int v = blockIdx.x >> 3; v < 256; v += (gridDim.x >> 3)) { const int b = blockIdx.x & 7, j = v & 127;
        dsa::dsa_tile(lds, proj, o_a, b, (v < 128) ? 255 - j : j); }
    xcd_barrier(bar);
    { LAS float* lut = (LAS float*)(lds + nsa::L_BIAS);
      for (int i = threadIdx.x; i < 1024; i += 512) { const int d = i >> 3, h = i & 7; lut[i] = a.rel_bias[t5_bucket(d) * 16 + 8 + h] * nsa::LOG2E; } }
    __syncthreads();
#pragma unroll 1
    for (int v = blockIdx.x >> 3; v < 128; v += (gridDim.x >> 3)) { const int bg = 2 * (blockIdx.x & 7) + (v >> 6), j = v & 31;
        nsa::nsa_unit(lds, proj, kcmp, vcmp, o_b, bg >> 1, bg & 1, (v & 32) ? j : 63 - j);
        __syncthreads(); }
    xcd_barrier(bar);
    gemm_run(lds, ws + WS_OAB, ws + WS_WBA, pg8::EpiMixF{(_Float16*)(ws + WS_MIX), proj}, M_, D_, D_);
    xcd_barrier(bar);
    gemm_run(lds, ws + WS_MIX, ws + WS_WOUT, pg8::EpiResidSq{(const float*)(ws + WS_RINV), (_Float16*)(ws + WS_H), (float*)(ws + WS_ROWSQ)}, M_, D_, D_);
    xcd_barrier(bar);
    gemm_run(lds, ws + WS_H, ws + WS_WMI, pg8::EpiRelu2N{(_Float16*)(ws + WS_PROJ), (const float*)(ws + WS_ROWSQ)}, M_, DFF, D_);
    xcd_barrier(bar);
#pragma unroll 1
    for (int sl = 0; sl < 2; ++sl) {
        pg8::Gemm g{(const pg8::bf16_t*)(ws + WS_PROJ), (const pg8::bf16_t*)(ws + WS_WMO), M_, D_, DFF};
        SliceOrder SO; SO.S.init(M_, D_, (int)gridDim.x, (int)blockIdx.x); SO.slice = sl;
        pg8::gemm_phase<EpiFinalNorm, SliceOrder, false, true>(lds, g, SO, EpiFinalNorm{a.out, (const _Float16*)(ws + WS_H), a.norm_final, (float*)(ws + WS_XBUF), (unsigned*)(ws + WS_PCNT)});
        __syncthreads();
    }
}
}

extern "C" void kernel_launch(void* const* d_in, const int* in_sizes, int n_in, void* d_out, int out_size, void* d_ws, size_t ws_size, hipStream_t stream) {
    if (ws_size < WS_END) { fprintf(stderr, "ws too small: %zu\n", ws_size); return; }
    static int grid = 0;
    if (!grid) {
        int dev = 0, cus = 0, per_cu = 0;
        (void)hipGetDevice(&dev);
        (void)hipDeviceGetAttribute(&cus, hipDeviceAttributeMultiprocessorCount, dev);
        (void)hipFuncSetAttribute((const void*)mega_fwd, hipFuncAttributeMaxDynamicSharedMemorySize, MEGA_LDS);
        (void)hipOccupancyMaxActiveBlocksPerMultiprocessor(&per_cu, (const void*)mega_fwd, 512, MEGA_LDS);
        (void)hipGetLastError();
        grid = cus;
        if (per_cu < 1) fprintf(stderr, "occupancy query says %d blocks/CU\n", per_cu);
        if (cus != 256) { fprintf(stderr, "kernel_launch: built for a 256-CU device (the last GEMM's row-panel exchange needs exactly 256 workgroups); found %d CUs, nothing launched\n", cus); grid = -1; }
    }
    if (grid < 0) return;
    Args a{};
    a.x = (const float*)d_in[0]; a.norm_mix = (const float*)d_in[1]; a.w_in = (const float*)d_in[2];
    a.pe_k = (const float*)d_in[3]; a.w1_k = (const float*)d_in[4]; a.w2_k = (const float*)d_in[5];
    a.pe_v = (const float*)d_in[6]; a.w1_v = (const float*)d_in[7]; a.w2_v = (const float*)d_in[8];
    a.rel_bias = (const float*)d_in[9]; a.w_ba = (const float*)d_in[10]; a.w_bb = (const float*)d_in[11];
    a.w_out = (const float*)d_in[12]; a.norm_mlp = (const float*)d_in[13]; a.w_mi = (const float*)d_in[14];
    a.w_mo = (const float*)d_in[15]; a.norm_final = (const float*)d_in[16];
    a.out = (float*)d_out; a.ws = (unsigned char*)d_ws;
    (void)hipMemsetAsync(d_ws, 0, 327680, stream);
    hipLaunchKernelGGL(mega_fwd, dim3(grid), dim3(512), MEGA_LDS, stream, a);
}
```

```cpp
#include <hip/hip_runtime.h>
#include <hip/hip_fp16.h>
#include <cstdint>
#include <cstdio>

__device__ __forceinline__ float xchg_xor1(float v) { return __int_as_float(__builtin_amdgcn_mov_dpp(__float_as_int(v), 0xB1, 0xf, 0xf, true)); }
__device__ __forceinline__ float xchg_xor2(float v) { return __int_as_float(__builtin_amdgcn_mov_dpp(__float_as_int(v), 0x4E, 0xf, 0xf, true)); }
__device__ __forceinline__ float max_xor16(float v) { const auto r = __builtin_amdgcn_permlane16_swap(__float_as_uint(v), __float_as_uint(v), false, false); return fmaxf(__uint_as_float(r[0]), __uint_as_float(r[1])); }
__device__ __forceinline__ float sum_xor16(float v) { const auto r = __builtin_amdgcn_permlane16_swap(__float_as_uint(v), __float_as_uint(v), false, false); return __uint_as_float(r[0]) + __uint_as_float(r[1]); }
__device__ __forceinline__ float sum_xor32(float v) { const auto r = __builtin_amdgcn_permlane32_swap(__float_as_uint(v), __float_as_uint(v), false, false); return __uint_as_float(r[0]) + __uint_as_float(r[1]); }
__device__ __forceinline__ float max_xor32(float v) { const auto r = __builtin_amdgcn_permlane32_swap(__float_as_uint(v), __float_as_uint(v), false, false); return fmaxf(__uint_as_float(r[0]), __uint_as_float(r[1])); }
namespace pg8 {
#define PG8_LAS __attribute__((address_space(3)))
typedef unsigned short bf16_t;
typedef _Float16 bf16x8 __attribute__((ext_vector_type(8)));
typedef float f32x4 __attribute__((ext_vector_type(4)));
typedef unsigned u32x4 __attribute__((ext_vector_type(4)));
constexpr int BM = 256, BK = 64, HALF = 128, HTB = HALF * BK * 2  , STAGE_BYTES = 8 * HTB, NXCD = 8, WGM = 8;

__host__ __device__ __forceinline__ int lds_byte(int r, int c) { const int st = (r >> 4) * 2 + (c >> 5), rr = r & 15, cc = c & 31, ob = rr * 64 + cc * 2; return st * 1024 + (ob ^ (((ob >> 9) & 1) << 5)); }
__host__ __device__ __forceinline__ void stage_rc(int b, int& R, int& C) { const int st = b / 1024, sb = b % 1024, swz = sb ^ (((sb >> 9) & 1) << 5); R = (st >> 1) * 16 + swz / 64; C = (st & 1) * 32 + (swz % 64) / 2; }
__host__ __device__ __forceinline__ int perm32(int rho) { const int n = rho >> 4, i = rho & 15; return 8 * (i >> 2) + 4 * n + (i & 3); }

struct Unit { int pm, pn; };
struct Gemm { const bf16_t* A; const bf16_t* Bt; int M, N, K; };

struct StaticOrder {
    int nM, nN, nwg, G, c;
    __host__ __device__ void init(int M, int N, int G_, int c_) { nM = M / BM; nN = N / BM; nwg = nM * nN; G = G_; c = c_; }
    __host__ __device__ bool next(int i, Unit& u) const {
        const long L = (long)i * G + c; if (L >= nwg) return false;
        int wgid = (int)L; { const int q = nwg / NXCD, r = nwg % NXCD, xcd = wgid % NXCD, off = wgid / NXCD; wgid = (xcd < r ? xcd * (q + 1) : r * (q + 1) + (xcd - r) * q) + off; }
        const int nig = WGM * nN, gid = wgid / nig, fm = gid * WGM, gsz = (nM - fm) < WGM ? (nM - fm) : WGM;
        u.pm = fm + ((wgid % nig) % gsz); u.pn = (wgid % nig) / gsz; return true;
    }
    __device__ __forceinline__ void a_ready(const Unit&) const {}
    __device__ __forceinline__ void done(const Unit&) const {}
};


typedef unsigned u32x2 __attribute__((ext_vector_type(2)));
typedef float f32x2 __attribute__((ext_vector_type(2)));
typedef _Float16 f16x2 __attribute__((ext_vector_type(2)));
constexpr int PW = 4352;
__device__ __forceinline__ unsigned pkh(float a, float b) { f32x2 v = {a, b}; f16x2 h = __builtin_convertvector(v, f16x2); return __builtin_bit_cast(unsigned, h); }
__device__ __forceinline__ float sigm(float v) { return __builtin_amdgcn_rcpf(1.f + __expf(-v)); }
__device__ __forceinline__ float sigm_gate(float v) { return fmaxf(sigm(v), 6.2e-5f); }
__device__ __forceinline__ void unpk8(const u32x4 w, float (&f)[8]) {
#pragma unroll
    for (int i = 0; i < 4; ++i) { const unsigned wi = (i == 0) ? w.x : (i == 1) ? w.y : (i == 2) ? w.z : w.w; const f16x2 h = __builtin_bit_cast(f16x2, wi); f[2 * i] = (float)h.x; f[2 * i + 1] = (float)h.y; } }

struct EpiProj {
    static constexpr bool PERM = true, AFTER_DRAIN = false, MID = false, PRE = false;
    _Float16* O; _Float16* KI;
    __device__ __forceinline__ void operator()(const f32x4 (&acc)[2][2][4][2], const Unit& u, int wr, int wc, int fr, int fq) const {
        const int row0 = u.pm * BM + wr * 64 + fr, col0 = u.pn * BM + wc * 32 + 8 * fq; const bool sg = u.pn >= 9;
        const bool ki = (u.pn == 8) && (wc == 0);
#pragma unroll
        for (int ai = 0; ai < 2; ++ai)
#pragma unroll
            for (int m = 0; m < 4; ++m) { _Float16* rowp = O + (size_t)(row0 + ai * HALF + m * 16) * PW + col0;
#pragma unroll
                for (int bj = 0; bj < 2; ++bj) { f32x4 v0 = acc[ai][bj][m][0], v1 = acc[ai][bj][m][1];
                    if (sg) {
                        const f32x4 b0 = acc[ai][1][m][0], b1 = acc[ai][1][m][1];
#pragma unroll
                        for (int i = 0; i < 4; ++i) { const float g0 = sigm_gate(b0[i]), g1 = sigm_gate(b1[i]);
                            v0[i] = bj ? g0 : sigm(v0[i]) * __builtin_amdgcn_rcpf(g0); v1[i] = bj ? g1 : sigm(v1[i]) * __builtin_amdgcn_rcpf(g1); } }
                    u32x4 w; w.x = pkh(v0[0], v0[1]); w.y = pkh(v0[2], v0[3]); w.z = pkh(v1[0], v1[1]); w.w = pkh(v1[2], v1[3]);
                    *(u32x4*)(rowp + bj * HALF) = w;
                    if (bj == 1 && ki) *(u32x4*)(KI + (size_t)(row0 + ai * HALF + m * 16) * 32 + 8 * fq) = w; } }
    }
};
struct EpiMixF {
    static constexpr bool PERM = true, AFTER_DRAIN = false, MID = true, PRE = false;
    _Float16* mix; const _Float16* proj;
    __device__ __forceinline__ void mid(f32x4 (&acc)[2][2][4][2], const Unit& u, int wr, int wc, int fr, int fq) const {
        int row0 = u.pm * BM + wr * 64 + fr, col0 = wc * 32 + 8 * fq;
        asm volatile("" : "+v"(row0), "+v"(col0));
#pragma unroll
        for (int ai = 0; ai < 2; ++ai) {
            u32x4 wr4[4][2];
#pragma unroll
            for (int m = 0; m < 4; ++m)
#pragma unroll
                for (int bj = 0; bj < 2; ++bj) wr4[m][bj] = *(const u32x4*)(proj + (size_t)(row0 + ai * HALF + m * 16) * PW + 2304 + 256 * (2 * u.pn + bj) + col0);
            __builtin_amdgcn_sched_barrier(0);
#pragma unroll
            for (int m = 0; m < 4; ++m)
#pragma unroll
                for (int bj = 0; bj < 2; ++bj) { float rr[8]; unpk8(wr4[m][bj], rr);
#pragma unroll
                    for (int i = 0; i < 4; ++i) { acc[ai][bj][m][0][i] *= rr[i]; acc[ai][bj][m][1][i] *= rr[4 + i]; } }
            __builtin_amdgcn_sched_barrier(0);
        }
    }
    __device__ __forceinline__ void operator()(const f32x4 (&acc)[2][2][4][2], const Unit& u, int wr, int wc, int fr, int fq) const {
        const int row0 = u.pm * BM + wr * 64 + fr, col0 = u.pn * BM + wc * 32 + 8 * fq;
#pragma unroll
        for (int ai = 0; ai < 2; ++ai) {
            u32x4 gw[4][2];
#pragma unroll
            for (int m = 0; m < 4; ++m)
#pragma unroll
                for (int bj = 0; bj < 2; ++bj) gw[m][bj] = *(const u32x4*)(proj + (size_t)(row0 + ai * HALF + m * 16) * PW + 2304 + 256 * (2 * u.pn + bj) + 128 + (wc * 32 + 8 * fq));
#pragma unroll
            for (int m = 0; m < 4; ++m) { const size_t r = (size_t)(row0 + ai * HALF + m * 16);
#pragma unroll
                for (int bj = 0; bj < 2; ++bj) { const int c = col0 + bj * HALF;
                    float gb[8]; unpk8(gw[m][bj], gb);
                    const f32x4 v0 = acc[ai][bj][m][0], v1 = acc[ai][bj][m][1];
                    u32x4 w; w.x = pkh(gb[0] * v0[0], gb[1] * v0[1]); w.y = pkh(gb[2] * v0[2], gb[3] * v0[3]); w.z = pkh(gb[4] * v1[0], gb[5] * v1[1]); w.w = pkh(gb[6] * v1[2], gb[7] * v1[3]);
                    *(u32x4*)(mix + r * 1024 + c) = w; } }
        }
    }
};
struct EpiResidSq {
    static constexpr bool PERM = true, AFTER_DRAIN = false, MID = false, PRE = true;
    const float* rinv; _Float16* xh; float* rowsq;
    __device__ __forceinline__ void pre(float (&rp)[8], const Unit& u, int wr, int wc, int fr, int fq) const {
        const int row0 = u.pm * BM + wr * 64 + fr;
#pragma unroll
        for (int ai = 0; ai < 2; ++ai)
#pragma unroll
            for (int m = 0; m < 4; ++m) rp[ai * 4 + m] = rinv[row0 + ai * HALF + m * 16];
    }
    __device__ __forceinline__ void operator()(const f32x4 (&acc)[2][2][4][2], const Unit& u, int wr, int wc, int fr, int fq, const float (&rp)[8]) const {
        const int row0 = u.pm * BM + wr * 64 + fr, col0 = u.pn * BM + wc * 32 + 8 * fq;
#pragma unroll
        for (int ai = 0; ai < 2; ++ai) {
            u32x4 hv[4][2];
#pragma unroll
            for (int m = 0; m < 4; ++m)
#pragma unroll
                for (int bj = 0; bj < 2; ++bj) hv[m][bj] = *(const u32x4*)(xh + (size_t)(row0 + ai * HALF + m * 16) * 1024 + col0 + bj * HALF);
#pragma unroll
            for (int m = 0; m < 4; ++m) { const size_t r = (size_t)(row0 + ai * HALF + m * 16); const float ri = rp[ai * 4 + m]; float sq = 0.f;
#pragma unroll
                for (int bj = 0; bj < 2; ++bj) { const size_t o = r * 1024 + col0 + bj * HALF;
                    float hx[8]; unpk8(hv[m][bj], hx);
                    f32x4 a0 = acc[ai][bj][m][0], a1 = acc[ai][bj][m][1];
#pragma unroll
                    for (int i = 0; i < 4; ++i) { a0[i] = fmaf(hx[i], ri, a0[i]); a1[i] = fmaf(hx[4 + i], ri, a1[i]); }
                    u32x4 w; w.x = pkh(a0[0], a0[1]); w.y = pkh(a0[2], a0[3]); w.z = pkh(a1[0], a1[1]); w.w = pkh(a1[2], a1[3]);
                    *(u32x4*)(xh + o) = w;
                    sq += (a0[0] * a0[0] + a0[1] * a0[1]) + (a0[2] * a0[2] + a0[3] * a0[3]) + (a1[0] * a1[0] + a1[1] * a1[1]) + (a1[2] * a1[2] + a1[3] * a1[3]); }
                sq = sum_xor16(sq); sq = sum_xor32(sq);
                if (fq == 0) atomicAdd(rowsq + r, sq); }
        }
    }
};
struct EpiRelu2N {
    static constexpr bool PERM = true, AFTER_DRAIN = false, MID = false, PRE = true;
    _Float16* U; const float* rowsq;
    __device__ __forceinline__ void pre(float (&rqp)[8], const Unit& u, int wr, int wc, int fr, int fq) const {
        const int row0 = u.pm * BM + wr * 64 + fr;
#pragma unroll
        for (int ai = 0; ai < 2; ++ai)
#pragma unroll
            for (int m = 0; m < 4; ++m) rqp[ai * 4 + m] = rowsq[row0 + ai * HALF + m * 16];
    }
    __device__ __forceinline__ void operator()(const f32x4 (&acc)[2][2][4][2], const Unit& u, int wr, int wc, int fr, int fq, const float (&rqp)[8]) const {
        const int row0 = u.pm * BM + wr * 64 + fr, col0 = u.pn * BM + wc * 32 + 8 * fq;
        float rq[2][4];
#pragma unroll
        for (int ai = 0; ai < 2; ++ai)
#pragma unroll
            for (int m = 0; m < 4; ++m) rq[ai][m] = rqp[ai * 4 + m];
#pragma unroll
        for (int ai = 0; ai < 2; ++ai)
#pragma unroll
            for (int m = 0; m < 4; ++m) { const int r = row0 + ai * HALF + m * 16; _Float16* rowp = U + (size_t)r * 4096 + col0;
                const float inv = 1.f / (rq[ai][m] * (1.f / 1024.f) + 1e-6f);
#pragma unroll
                for (int bj = 0; bj < 2; ++bj) { f32x4 v0 = acc[ai][bj][m][0], v1 = acc[ai][bj][m][1];
#pragma unroll
                    for (int i = 0; i < 4; ++i) { const float a = fmaxf(v0[i], 0.f), b = fmaxf(v1[i], 0.f); v0[i] = a * a * inv; v1[i] = b * b * inv; }
                    u32x4 w; w.x = pkh(v0[0], v0[1]); w.y = pkh(v0[2], v0[3]); w.z = pkh(v1[0], v1[1]); w.w = pkh(v1[2], v1[3]);
                    *(u32x4*)(rowp + bj * HALF) = w; } }
    }
};
template <class Epi, class Sched, bool ALIGN_EPI = false, bool SP2 = false>
__device__ __forceinline__ void gemm_phase(PG8_LAS unsigned char* lds, const Gemm g, const Sched& S, const Epi& E) {
    int tid_ = threadIdx.x; asm volatile("" : "+v"(tid_));
    const int tid = tid_, wid = __builtin_amdgcn_readfirstlane(tid >> 6), lane = tid & 63, wr = wid >> 2, wc = wid & 3, fr = lane & 15, fq = lane >> 4;
    const int K = g.K, nt = K / BK;
    unsigned voffA[2], voffB[2];
#pragma unroll
    for (int i = 0; i < 2; ++i) { int R, C; stage_rc(tid * 16 + i * 8192, R, C); const int Rb = Epi::PERM ? ((R & ~31) + perm32(R & 31)) : R;
        voffA[i] = (unsigned)(R * K + C) * 2u; voffB[i] = (unsigned)(Rb * K + C) * 2u; }
    const size_t kstep = (size_t)(BK * 2);
    const size_t hstep = (size_t)HALF * K * 2;
    const size_t tstep = 2 * hstep;
    const unsigned ldsw = (unsigned)wid * 1024u;
    const int aoff = lds_byte(wr * 64 + fr, fq * 8), boff = lds_byte(wc * 32 + fr, fq * 8);
#define PG8_SA(b, h) (((b) * 2 + (h)) * HTB)
#define PG8_SB(b, h) ((4 + (b) * 2 + (h)) * HTB)
#define PG8_STAGE(bufoff, gbase, voff) do { _Pragma("unroll") for (int _i = 0; _i < 2; ++_i) \
        __builtin_amdgcn_global_load_lds((const unsigned*)((const char*)(gbase) + (voff)[_i]), (PG8_LAS unsigned*)(lds + (bufoff) + ldsw + _i * 8192), 16, 0, 0); } while (0)
#define PG8_LDA(dst, b, h) do { _Pragma("unroll") for (int m = 0; m < 4; ++m) _Pragma("unroll") for (int k = 0; k < 2; ++k) dst[m][k] = *(const PG8_LAS bf16x8*)(lds + PG8_SA(b, h) + aoff + m * 2048 + k * 1024); } while (0)
#define PG8_LDB(dst, b, h) do { _Pragma("unroll") for (int n = 0; n < 2; ++n) _Pragma("unroll") for (int k = 0; k < 2; ++k) dst[n][k] = *(const PG8_LAS bf16x8*)(lds + PG8_SB(b, h) + boff + n * 2048 + k * 1024); } while (0)
#define PG8_MMA(ai, bj, At, Bt) do { __builtin_amdgcn_s_setprio(1); _Pragma("unroll") for (int m = 0; m < 4; ++m) _Pragma("unroll") for (int n = 0; n < 2; ++n) _Pragma("unroll") for (int k = 0; k < 2; ++k) \
        acc[ai][bj][m][n] = __builtin_amdgcn_mfma_f32_16x16x32_f16(Bt[n][k], At[m][k], acc[ai][bj][m][n], 0, 0, 0); __builtin_amdgcn_s_setprio(0); } while (0)
#define PG8_WAIT_V(n) asm volatile("s_waitcnt vmcnt(" #n ")" ::: "memory")
#define PG8_WAIT_L(n) asm volatile("s_waitcnt lgkmcnt(" #n ")" ::: "memory")
#define PG8_BAR __builtin_amdgcn_s_barrier()
#define PG8_SCHED __builtin_amdgcn_sched_barrier(0)
    Unit cur, nxt; int ui = 0;
    if (!S.next(0, cur)) return;
    float epre[8];
    if constexpr (Epi::PRE) E.pre(epre, cur, wr, wc, fr, fq);
    f32x4 acc[2][2][4][2];
#pragma unroll
    for (int a = 0; a < 2; ++a)
#pragma unroll
        for (int b = 0; b < 2; ++b)
#pragma unroll
            for (int m = 0; m < 4; ++m)
#pragma unroll
                for (int n = 0; n < 2; ++n) acc[a][b][m][n] = (f32x4){0.f, 0.f, 0.f, 0.f};
    bf16x8 At[4][2], B0[2][2], B1[2][2];
    const char* cA = (const char*)g.A + (size_t)cur.pm * tstep; const char* cB = (const char*)g.Bt + (size_t)cur.pn * tstep;
    S.a_ready(cur);
    if constexpr (SP2) {
        PG8_STAGE(PG8_SB(0, 0), cB, voffB); PG8_STAGE(PG8_SB(0, 1), cB + hstep, voffB); PG8_STAGE(PG8_SA(0, 0), cA, voffA); PG8_STAGE(PG8_SA(0, 1), cA + hstep, voffA);
        if (wr == 1) PG8_BAR;
        PG8_WAIT_V(2); PG8_BAR;
        PG8_STAGE(PG8_SB(1, 0), cB + kstep, voffB); PG8_STAGE(PG8_SA(1, 0), cA + kstep, voffA); PG8_STAGE(PG8_SB(1, 1), cB + hstep + kstep, voffB);
        PG8_WAIT_V(6); PG8_BAR;
    } else {
        PG8_STAGE(PG8_SB(0, 0), cB, voffB); PG8_STAGE(PG8_SA(0, 0), cA, voffA); PG8_STAGE(PG8_SB(0, 1), cB + hstep, voffB); PG8_STAGE(PG8_SA(0, 1), cA + hstep, voffA);
        if (wr == 1) PG8_BAR;
        PG8_WAIT_V(4); PG8_BAR;
        PG8_STAGE(PG8_SB(1, 0), cB + kstep, voffB); PG8_STAGE(PG8_SA(1, 0), cA + kstep, voffA); PG8_STAGE(PG8_SB(1, 1), cB + hstep + kstep, voffB);
        PG8_WAIT_V(6); PG8_BAR;
    }
    for (;;) {
        const bool has_next = S.next(ui + 1, nxt);
        const char* nA = has_next ? (const char*)g.A + (size_t)nxt.pm * tstep : cA; const char* nB = has_next ? (const char*)g.Bt + (size_t)nxt.pn * tstep : cB;
        for (int t = 0; t < nt; t += 2) {
            if constexpr (Epi::MID) { if (t == nt / 2) E.mid(acc, cur, wr, wc, fr, fq); }
            const bool last = (t == nt - 2);
            const char* a1 = cA + (size_t)(t + 1) * kstep;
            const char* a2 = last ? nA : cA + (size_t)(t + 2) * kstep; const char* b2 = last ? nB : cB + (size_t)(t + 2) * kstep;
            const char* a3 = a2 + kstep; const char* b3 = b2 + kstep;
            if (last && has_next) S.a_ready(nxt);
            if constexpr (SP2) {
            PG8_LDB(B0, 0, 0); PG8_LDB(B1, 0, 1); PG8_SCHED; PG8_LDA(At, 0, 0); PG8_STAGE(PG8_SA(1, 1), a1 + hstep, voffA);
            PG8_WAIT_V(8); PG8_WAIT_L(0); PG8_BAR; PG8_MMA(0, 0, At, B0); PG8_MMA(0, 1, At, B1); PG8_BAR; PG8_SCHED;
            PG8_LDA(At, 0, 1); PG8_STAGE(PG8_SB(0, 0), b2, voffB); PG8_STAGE(PG8_SB(0, 1), b2 + hstep, voffB); PG8_STAGE(PG8_SA(0, 0), a2, voffA);
            PG8_WAIT_V(8); PG8_WAIT_L(0); PG8_BAR; PG8_MMA(1, 0, At, B0); PG8_MMA(1, 1, At, B1); PG8_BAR; PG8_SCHED;
            PG8_LDB(B0, 1, 0); PG8_LDB(B1, 1, 1); PG8_SCHED; PG8_LDA(At, 1, 0); PG8_STAGE(PG8_SA(0, 1), a2 + hstep, voffA);
            PG8_WAIT_V(8); PG8_WAIT_L(0); PG8_BAR; PG8_MMA(0, 0, At, B0); PG8_MMA(0, 1, At, B1); PG8_BAR; PG8_SCHED;
            PG8_LDA(At, 1, 1); PG8_STAGE(PG8_SB(1, 0), b3, voffB); PG8_STAGE(PG8_SB(1, 1), b3 + hstep, voffB); PG8_STAGE(PG8_SA(1, 0), a3, voffA);
            PG8_WAIT_V(8); PG8_WAIT_L(0); PG8_BAR; PG8_MMA(1, 0, At, B0); PG8_MMA(1, 1, At, B1); PG8_BAR; PG8_SCHED;
            } else {
            PG8_LDB(B0, 0, 0); PG8_SCHED; PG8_LDA(At, 0, 0); PG8_STAGE(PG8_SA(1, 1), a1 + hstep, voffA);
            PG8_WAIT_L(8); PG8_BAR; PG8_WAIT_L(0); PG8_MMA(0, 0, At, B0); PG8_BAR; PG8_SCHED;
            PG8_LDB(B1, 0, 1); PG8_STAGE(PG8_SB(0, 0), b2, voffB);
            PG8_BAR; PG8_WAIT_L(0); PG8_MMA(0, 1, At, B1); PG8_BAR;
            PG8_LDA(At, 0, 1); PG8_STAGE(PG8_SA(0, 0), a2, voffA);
            PG8_BAR; PG8_WAIT_L(0); PG8_MMA(1, 0, At, B0); PG8_BAR; PG8_SCHED;
            PG8_STAGE(PG8_SB(0, 1), b2 + hstep, voffB);
            PG8_WAIT_V(6); PG8_BAR; PG8_MMA(1, 1, At, B1); PG8_BAR;
            PG8_LDB(B0, 1, 0); PG8_SCHED; PG8_LDA(At, 1, 0); PG8_STAGE(PG8_SA(0, 1), a2 + hstep, voffA);
            PG8_WAIT_L(8); PG8_BAR; PG8_WAIT_L(0); PG8_MMA(0, 0, At, B0); PG8_BAR; PG8_SCHED;
            PG8_LDB(B1, 1, 1); PG8_STAGE(PG8_SB(1, 0), b3, voffB);
            PG8_BAR; PG8_WAIT_L(0); PG8_MMA(0, 1, At, B1); PG8_BAR;
            PG8_LDA(At, 1, 1); PG8_STAGE(PG8_SA(1, 0), a3, voffA);
            PG8_BAR; PG8_WAIT_L(0); PG8_MMA(1, 0, At, B0); PG8_BAR; PG8_SCHED;
            PG8_STAGE(PG8_SB(1, 1), b3 + hstep, voffB);
            PG8_WAIT_V(6); PG8_BAR; PG8_MMA(1, 1, At, B1); PG8_BAR;
            }
        }
        if constexpr (ALIGN_EPI) { if (wr == 0) PG8_BAR; }
        if constexpr (!Epi::AFTER_DRAIN) { if constexpr (Epi::PRE) E(acc, cur, wr, wc, fr, fq, epre); else E(acc, cur, wr, wc, fr, fq); S.done(cur); }
        if (!has_next) break;
#pragma unroll
        for (int a = 0; a < 2; ++a)
#pragma unroll
            for (int b = 0; b < 2; ++b)
#pragma unroll
                for (int m = 0; m < 4; ++m)
#pragma unroll
                    for (int n = 0; n < 2; ++n) acc[a][b][m][n] = (f32x4){0.f, 0.f, 0.f, 0.f};
        cur = nxt; cA = nA; cB = nB; ++ui;
        if constexpr (Epi::PRE) E.pre(epre, cur, wr, wc, fr, fq);
        if constexpr (ALIGN_EPI) { if (wr == 1) PG8_BAR; }
    }
    PG8_WAIT_V(0);
    if constexpr (!ALIGN_EPI) { if (wr == 0) PG8_BAR; }
    PG8_BAR;
    if constexpr (Epi::AFTER_DRAIN) { E.fused(acc, cur, wr, wc, fr, fq, lds, wid, lane); S.done(cur); }
#undef PG8_SA
#undef PG8_SB
#undef PG8_STAGE
#undef PG8_LDA
#undef PG8_LDB
#undef PG8_MMA
#undef PG8_WAIT_V
#undef PG8_WAIT_L
#undef PG8_BAR
#undef PG8_SCHED
}
}


namespace {
constexpr int B_ = 8, S_ = 4096, M_ = B_ * S_, D_ = 1024, DIN = 4288, DFF = 4096;
constexpr int C_QA = 0, C_QB = 512, C_QI = 1024, C_KVB = 1280, C_KA = 2048, C_VA = 2112, C_KI = 2176, C_WI = 2208, C_GB = 2216, C_GATE = 2304;
constexpr int NC = 255;
constexpr float EPS = 1e-6f;
using pg8::PW;
#define GAS __attribute__((address_space(1)))
#define LAS __attribute__((address_space(3)))
typedef unsigned v4u __attribute__((ext_vector_type(4)));
typedef float f32x4 __attribute__((ext_vector_type(4)));

__device__ __forceinline__ int t5_bucket(int n) {
    if (n < 16) return n < 0 ? 0 : n;
    float nf = (float)n;
    int large = 16 + (int)(logf(nf / 16.f) / logf(8.f) * 16.f);
    return large < 31 ? large : 31;
}


__device__ __forceinline__ int win_src_col(int n) {
    if (n < 512) return n;
    if (n < 1024) return 936 + (n - 512);
    if (n < 1280) return 640 + (n - 1024);
    if (n < 2048) return 1448 + (n - 1280);
    if (n < 2112) return 512 + (n - 2048);
    if (n < 2176) return 576 + (n - 2112);
    if (n < 2208) return 896 + (n - 2176);
    if (n < 2216) return 928 + (n - 2208);
    if (n < 2240) return n;
    if (n < 2304) return -1;
    { const int q = n - 2304, j = q >> 8, w = q & 255;
      return (w < 128) ? 2240 + 128 * j + w : 3264 + 128 * j + (w - 128); }
}
__device__ __forceinline__ float wave_sum(float v) {
    v += xchg_xor1(v); v += xchg_xor2(v);
    v += __int_as_float(__builtin_amdgcn_mov_dpp(__float_as_int(v), 0x124, 0xf, 0xf, true));
    v += __int_as_float(__builtin_amdgcn_mov_dpp(__float_as_int(v), 0x128, 0xf, 0xf, true));
    v = sum_xor16(v); v = sum_xor32(v);
    return v;
}
template <bool MAP, bool GAIN>
__device__ __forceinline__ void transpose_item(const float* __restrict__ W, int K, int Nsrc, int Ndst, _Float16* __restrict__ WT, const float* __restrict__ gain, float* scr, int item, int lane, int dpitch = 0, int koff = 0) {
    const int nblk = Ndst / 32, kb = item / nblk, nb = item % nblk, k0 = 64 * kb, n0 = 32 * nb;
    const int c4 = lane & 7, nd = n0 + 4 * c4; const int ns = MAP ? win_src_col(nd) : nd;
    const int nsc = ns >= 0 ? ns : 0;
    f32x4 v[8]; float gv[8];
#pragma unroll
    for (int i = 0; i < 8; ++i) { const int kk = 8 * i + (lane >> 3); v[i] = *(const f32x4*)(W + (size_t)(k0 + kk) * Nsrc + nsc); gv[i] = GAIN ? gain[k0 + kk] : 1.f; }
#pragma unroll
    for (int i = 0; i < 8; ++i) { const int kk = 8 * i + (lane >> 3); f32x4 x = v[i]; if (GAIN) x = x * gv[i]; if (MAP) { if (ns < 0) x = (f32x4){0.f, 0.f, 0.f, 0.f}; }
        float* sp = scr + kk * 33 + 4 * c4; sp[0] = x.x; sp[1] = x.y; sp[2] = x.z; sp[3] = x.w; }
    __builtin_amdgcn_s_waitcnt(0xc07f); asm volatile("" ::: "memory");
    const int c = lane & 7;
#pragma unroll
    for (int j = 0; j < 4; ++j) { const int n = (lane >> 3) + 8 * j; const float* s = scr + (8 * c) * 33 + n;
        v4u o; o.x = pg8::pkh(s[0 * 33], s[1 * 33]); o.y = pg8::pkh(s[2 * 33], s[3 * 33]); o.z = pg8::pkh(s[4 * 33], s[5 * 33]); o.w = pg8::pkh(s[6 * 33], s[7 * 33]);
        *(v4u*)(WT + (size_t)(n0 + n) * (dpitch ? dpitch : K) + koff + k0 + 8 * c) = o; }
    __builtin_amdgcn_s_waitcnt(0xc07f); asm volatile("" ::: "memory");
}
template <int NI>
__device__ __forceinline__ void transpose_win(const float* __restrict__ W, _Float16* __restrict__ WT, const float* __restrict__ gain, float* scr, int item0, int istride, int lane) {
    constexpr int nblk = PW / 32;
    const int c4 = lane & 7;
    f32x4 v[NI][8]; float gv[NI][8]; int nsv[NI], k0v[NI], n0v[NI];
#pragma unroll
    for (int q = 0; q < NI; ++q) { const int item = item0 + q * istride, kb = item / nblk, nb = item % nblk; k0v[q] = 64 * kb; n0v[q] = 32 * nb;
        nsv[q] = win_src_col(n0v[q] + 4 * c4); const int nsc = nsv[q] >= 0 ? nsv[q] : 0;
#pragma unroll
        for (int i = 0; i < 8; ++i) { const int kk = 8 * i + (lane >> 3); v[q][i] = *(const f32x4*)(W + (size_t)(k0v[q] + kk) * DIN + nsc); gv[q][i] = gain[k0v[q] + kk]; } }
#pragma unroll
    for (int q = 0; q < NI; ++q) {
#pragma unroll
        for (int i = 0; i < 8; ++i) { const int kk = 8 * i + (lane >> 3); f32x4 x = v[q][i] * gv[q][i]; if (nsv[q] < 0) x = (f32x4){0.f, 0.f, 0.f, 0.f};
            float* sp = scr + kk * 33 + 4 * c4; sp[0] = x.x; sp[1] = x.y; sp[2] = x.z; sp[3] = x.w; }
        __builtin_amdgcn_s_waitcnt(0xc07f); asm volatile("" ::: "memory");
        const int c = lane & 7;
#pragma unroll
        for (int j = 0; j < 4; ++j) { const int n = (lane >> 3) + 8 * j; const float* sq = scr + (8 * c) * 33 + n;
            v4u o; o.x = pg8::pkh(sq[0 * 33], sq[1 * 33]); o.y = pg8::pkh(sq[2 * 33], sq[3 * 33]); o.z = pg8::pkh(sq[4 * 33], sq[5 * 33]); o.w = pg8::pkh(sq[6 * 33], sq[7 * 33]);
            *(v4u*)(WT + (size_t)(n0v[q] + n) * D_ + k0v[q] + 8 * c) = o; }
        __builtin_amdgcn_s_waitcnt(0xc07f); asm volatile("" ::: "memory");
    }
}
__device__ __forceinline__ void rms_row_to_f16(const float* __restrict__ xrow, _Float16* __restrict__ orow, float* __restrict__ rinv, int lane) {
    const f32x4* xr = (const f32x4*)xrow + lane;
    f32x4 v[4]; float s = 0.f;
#pragma unroll
    for (int j = 0; j < 4; ++j) { v[j] = xr[64 * j]; s += (v[j].x * v[j].x + v[j].y * v[j].y) + (v[j].z * v[j].z + v[j].w * v[j].w); }
    const float ms = wave_sum(s) * (1.f / D_) + EPS; const float rstd = rsqrtf(ms);
    if (lane == 0) *rinv = ms * rstd;
    unsigned long long* o8 = (unsigned long long*)orow + lane;
#pragma unroll
    for (int j = 0; j < 4; ++j) o8[64 * j] = (unsigned long long)pg8::pkh(v[j].x * rstd, v[j].y * rstd) | ((unsigned long long)pg8::pkh(v[j].z * rstd, v[j].w * rstd) << 32);
}

struct Args {
    const float* x; const float* norm_mix; const float* w_in; const float* pe_k; const float* w1_k; const float* w2_k; const float* pe_v; const float* w1_v; const float* w2_v;
    const float* rel_bias; const float* w_ba; const float* w_bb; const float* w_out; const float* norm_mlp; const float* w_mi; const float* w_mo; const float* norm_final;
    float* out; unsigned char* ws;
};
constexpr size_t MiB = 1u << 20;
constexpr size_t WS_PCNT = 32768, WS_DQ = 49152, WS_XBUF = 524288;
constexpr size_t WS_ROWSQ = 65536, WS_ROWSQ2 = 196608;
constexpr size_t WS_CTL = 0, WS_WIN = 1 * MiB, WS_WBA = 10 * MiB, WS_WBB = 11 * MiB, WS_WOUT = 12 * MiB, WS_WMI = 14 * MiB, WS_WMO = 22 * MiB, WS_CW = 30 * MiB,
                 WS_KCMP = 32 * MiB, WS_VCMP = 33 * MiB, WS_H = 34 * MiB, WS_PROJ = 98 * MiB, WS_MIX = 370 * MiB, WS_KIC = 434 * MiB, WS_OAB = 436 * MiB, WS_RINV = 500 * MiB, WS_END = 501 * MiB;

template <bool tail>
__device__ __forceinline__ void prologue_body(const Args& a, unsigned char* lds) {
    const int tid = threadIdx.x, lane = tid & 63, wave = tid >> 6;
    float* scr = (float*)(lds + wave * 8704);
    const int gw = tail ? ((int)blockIdx.x - 128) * 8 + wave : blockIdx.x * 8 + wave, NGW = tail ? 128 * 8 : gridDim.x * 8;
    constexpr int I_IN = (D_ / 64) * (PW / 32), I_BA = (512 / 64) * (D_ / 32), I_OUT = (D_ / 64) * (D_ / 32), I_MI = (D_ / 64) * (DFF / 32), I_MO = (DFF / 64) * (D_ / 32);
    constexpr int I_C1 = (2048 / 64) * (128 / 32), I_C2 = (128 / 64) * (64 / 32);
    constexpr int NITEMS = I_IN + 2 * I_BA + I_OUT + 2 * I_C1 + 2 * I_C2;
    if (!tail) {
        const int xb = blockIdx.x & 7, wl = (blockIdx.x >> 3) * 8 + wave, wstride = (gridDim.x >> 3) * 8;
        for (int r = wl; r < M_ / 8; r += wstride) { const int m = xb * (M_ / 8) + r;
            rms_row_to_f16(a.x + (size_t)m * D_, (_Float16*)(a.ws + WS_H) + (size_t)m * D_, (float*)(a.ws + WS_RINV) + m, lane); }
    }
    int it0 = gw + (tail ? I_IN : 0);
    if (!tail) {
        if (it0 + NGW < I_IN) { transpose_win<2>(a.w_in, (_Float16*)(a.ws + WS_WIN), a.norm_mix, scr, it0, NGW, lane); it0 += 2 * NGW; }
        else if (it0 < I_IN) { transpose_win<1>(a.w_in, (_Float16*)(a.ws + WS_WIN), a.norm_mix, scr, it0, NGW, lane); it0 += NGW; }
    }
    for (int it = it0; it < (tail ? NITEMS : I_IN); it += NGW) {
        int r = it;
        if (r < I_IN) { transpose_item<true, true>(a.w_in, D_, DIN, PW, (_Float16*)(a.ws + WS_WIN), a.norm_mix, scr, r, lane); continue; } r -= I_IN;
        if (r < I_BA) { transpose_item<false, false>(a.w_ba, 512, D_, D_, (_Float16*)(a.ws + WS_WBA), nullptr, scr, r, lane, 1024, 0); continue; } r -= I_BA;
        if (r < I_BA) { transpose_item<false, false>(a.w_bb, 512, D_, D_, (_Float16*)(a.ws + WS_WBA), nullptr, scr, r, lane, 1024, 512); continue; } r -= I_BA;
        if (r < I_OUT) { transpose_item<false, false>(a.w_out, D_, D_, D_, (_Float16*)(a.ws + WS_WOUT), nullptr, scr, r, lane); continue; } r -= I_OUT;
        if (r < I_C1) { transpose_item<false, false>(a.w1_k, 2048, 128, 128, (_Float16*)(a.ws + WS_CW), nullptr, scr, r, lane); continue; } r -= I_C1;
        if (r < I_C1) { transpose_item<false, false>(a.w1_v, 2048, 128, 128, (_Float16*)(a.ws + WS_CW + 512 * 1024), nullptr, scr, r, lane); continue; } r -= I_C1;
        if (r < I_C2) { transpose_item<false, false>(a.w2_k, 128, 64, 64, (_Float16*)(a.ws + WS_CW + 1024 * 1024), nullptr, scr, r, lane); continue; } r -= I_C2;
        transpose_item<false, false>(a.w2_v, 128, 64, 64, (_Float16*)(a.ws + WS_CW + 1024 * 1024 + 16384), nullptr, scr, r, lane);
    }
}
__device__ __forceinline__ void mlp_weights_body(const Args& a, unsigned char* lds) {
    const int tid = threadIdx.x, lane = tid & 63, wave = tid >> 6;
    float* scr = (float*)(lds + wave * 8704);
    const int gw = ((int)blockIdx.x - 128) * 8 + wave, NGW = 128 * 8;
    constexpr int I_MI = (D_ / 64) * (DFF / 32), I_MO = (DFF / 64) * (D_ / 32);
    for (int it = gw; it < I_MI + I_MO; it += NGW) {
        if (it < I_MI) transpose_item<false, true>(a.w_mi, D_, DFF, DFF, (_Float16*)(a.ws + WS_WMI), a.norm_mlp, scr, it, lane);
        else transpose_item<false, false>(a.w_mo, DFF, D_, D_, (_Float16*)(a.ws + WS_WMO), nullptr, scr, it - I_MI, lane);
    }
}
struct EpiAccOut {
    static constexpr bool PERM = true, AFTER_DRAIN = false, MID = false, PRE = false;
    _Float16* x2h; const _Float16* xh; float* rowsq;
    __device__ __forceinline__ void operator()(const f32x4 (&acc)[2][2][4][2], const pg8::Unit& u, int wr, int wc, int fr, int fq) const {
        const int row0 = u.pm * 256 + wr * 64 + fr, col0 = u.pn * 256 + wc * 32 + 8 * fq;
#pragma unroll
        for (int ai = 0; ai < 2; ++ai)
#pragma unroll
            for (int m = 0; m < 4; ++m) { const size_t r = (size_t)(row0 + ai * 128 + m * 16); float sq = 0.f;
#pragma unroll
                for (int bj = 0; bj < 2; ++bj) { const size_t o = r * 1024 + col0 + bj * 128;
                    float p[8]; pg8::unpk8(*(const pg8::u32x4*)(xh + o), p);
                    const f32x4 a0 = acc[ai][bj][m][0], a1 = acc[ai][bj][m][1];
                    const float v[8] = {p[0] + a0[0], p[1] + a0[1], p[2] + a0[2], p[3] + a0[3], p[4] + a1[0], p[5] + a1[1], p[6] + a1[2], p[7] + a1[3]};
                    pg8::u32x4 w; w.x = pg8::pkh(v[0], v[1]); w.y = pg8::pkh(v[2], v[3]); w.z = pg8::pkh(v[4], v[5]); w.w = pg8::pkh(v[6], v[7]);
                    *(pg8::u32x4*)(x2h + o) = w;
                    sq += (v[0] * v[0] + v[1] * v[1]) + (v[2] * v[2] + v[3] * v[3]) + (v[4] * v[4] + v[5] * v[5]) + (v[6] * v[6] + v[7] * v[7]); }
                sq = sum_xor16(sq); sq = sum_xor32(sq);
                if (fq == 0) atomicAdd(rowsq + r, sq); }
    }
};
__device__ __forceinline__ void final_scale_row(const _Float16* __restrict__ xrow, float* __restrict__ orow, const float* __restrict__ g, float rsq, int lane) {
    const float rstd = rsqrtf(rsq * (1.f / D_) + EPS);
#pragma unroll
    for (int j = 0; j < 2; ++j) {
        float p[8]; pg8::unpk8(*((const pg8::u32x4*)xrow + lane + 64 * j), p);
        const f32x4 g0 = *((const f32x4*)g + 2 * (lane + 64 * j)), g1 = *((const f32x4*)g + 2 * (lane + 64 * j) + 1);
        *((f32x4*)orow + 2 * (lane + 64 * j)) = (f32x4){p[0] * rstd * g0.x, p[1] * rstd * g0.y, p[2] * rstd * g0.z, p[3] * rstd * g0.w};
        *((f32x4*)orow + 2 * (lane + 64 * j) + 1) = (f32x4){p[4] * rstd * g1.x, p[5] * rstd * g1.y, p[6] * rstd * g1.z, p[7] * rstd * g1.w};
    }
}

struct SliceOrder {
    pg8::StaticOrder S; int slice;
    __device__ bool next(int i, pg8::Unit& u) const { return i == 0 ? S.next(slice, u) : false; }
    __device__ __forceinline__ void a_ready(const pg8::Unit&) const {}
    __device__ __forceinline__ void done(const pg8::Unit&) const {}
};
struct EpiFinalNorm {
    static constexpr bool PERM = true, AFTER_DRAIN = true, MID = false, PRE = false;
    float* out; const _Float16* xh; const float* g; float* xbuf; unsigned* cnt;
    __device__ __forceinline__ void fused(f32x4 (&acc)[2][2][4][2], const pg8::Unit& u, int wr, int wc, int fr, int fq, PG8_LAS unsigned char* lds, int wid, int lane) const {
        const int rl0 = wr * 64 + fr, col0 = u.pn * 256 + wc * 32 + 8 * fq;
        PG8_LAS float* red = (PG8_LAS float*)lds;
#pragma unroll
        for (int ai = 0; ai < 2; ++ai) {
            pg8::u32x4 xw[4][2];
#pragma unroll
            for (int m = 0; m < 4; ++m)
#pragma unroll
                for (int bj = 0; bj < 2; ++bj) xw[m][bj] = *(const pg8::u32x4*)(xh + (size_t)(u.pm * 256 + rl0 + ai * 128 + m * 16) * 1024 + col0 + bj * 128);
#pragma unroll
            for (int m = 0; m < 4; ++m) { const int rl = rl0 + ai * 128 + m * 16; float sq = 0.f;
#pragma unroll
                for (int bj = 0; bj < 2; ++bj) { float p[8]; pg8::unpk8(xw[m][bj], p);
#pragma unroll
                    for (int i = 0; i < 4; ++i) { acc[ai][bj][m][0][i] += p[i]; acc[ai][bj][m][1][i] += p[4 + i];
                        sq = fmaf(acc[ai][bj][m][0][i], acc[ai][bj][m][0][i], sq); sq = fmaf(acc[ai][bj][m][1][i], acc[ai][bj][m][1][i], sq); } }
                sq = sum_xor16(sq); sq = sum_xor32(sq);
                if (fq == 0) red[wc * 256 + rl] = sq; }
        }
        __syncthreads();
        f32x4 gv[2][2];
#pragma unroll
        for (int bj = 0; bj < 2; ++bj) { gv[bj][0] = *(const f32x4*)(g + col0 + bj * 128); gv[bj][1] = *(const f32x4*)(g + col0 + bj * 128 + 4); }
        const int tid = wid * 64 + lane;
        if (tid < 256) { const float tot = (red[tid] + red[256 + tid]) + (red[512 + tid] + red[768 + tid]);
            __hip_atomic_store(xbuf + ((size_t)u.pm * 4 + u.pn) * 256 + tid, tot, __ATOMIC_RELAXED, __HIP_MEMORY_SCOPE_AGENT); }
        asm volatile("s_waitcnt vmcnt(0)" ::: "memory");
        __syncthreads();
        if (tid == 0) { __hip_atomic_fetch_add(cnt + u.pm, 1u, __ATOMIC_RELAXED, __HIP_MEMORY_SCOPE_AGENT);
            unsigned sp = 0; while (__hip_atomic_load(cnt + u.pm, __ATOMIC_RELAXED, __HIP_MEMORY_SCOPE_AGENT) < 4u && ++sp < (1u << 22)) __builtin_amdgcn_s_sleep(1); }
        __syncthreads();
        if (tid < 256) { float tot = 0.f;
#pragma unroll
            for (int q = 0; q < 4; ++q) tot += __hip_atomic_load(xbuf + ((size_t)u.pm * 4 + q) * 256 + tid, __ATOMIC_RELAXED, __HIP_MEMORY_SCOPE_AGENT);
            red[1024 + tid] = rsqrtf(tot * (1.f / 1024.f) + 1e-6f); }
        __syncthreads();
#pragma unroll
        for (int ai = 0; ai < 2; ++ai)
#pragma unroll
            for (int m = 0; m < 4; ++m) { const int rl = rl0 + ai * 128 + m * 16; const size_t r = (size_t)(u.pm * 256 + rl); const float rstd = red[1024 + rl];
#pragma unroll
                for (int bj = 0; bj < 2; ++bj) { const int c = col0 + bj * 128;
                    *(f32x4*)(out + r * 1024 + c) = acc[ai][bj][m][0] * rstd * gv[bj][0]; *(f32x4*)(out + r * 1024 + c + 4) = acc[ai][bj][m][1] * rstd * gv[bj][1]; } }
        __syncthreads();
    }
};

namespace dsa {
typedef _Float16 f16x8 __attribute__((ext_vector_type(8)));
typedef _Float16 f16x4 __attribute__((ext_vector_type(4)));
typedef short s16x4 __attribute__((ext_vector_type(4)));
typedef float f32x4 __attribute__((ext_vector_type(4)));
typedef unsigned u32x4 __attribute__((ext_vector_type(4)));
typedef unsigned u32x2 __attribute__((ext_vector_type(2)));
constexpr int TQ = 16, NBIN = 2048, CANDCAP = 512, VPITCH = 144;
constexpr int L_HIST = 0, L_SEL = 65536, L_SELD = L_SEL + 8192, L_CTL = L_SELD + 8192, L_BIAS = L_CTL + 512, L_VST = L_BIAS + 4096, L_END = L_VST + 8 * 32 * VPITCH;
static_assert(L_END <= 131072, "dsa LDS");

template <bool FIRST>
__device__ __forceinline__ f16x8 relu_pack(const f32x4 lo, const f32x4 hi) {
    unsigned o0, o1, o2, o3;
    const float l0 = lo.x, l1 = lo.y, l2 = lo.z, l3 = lo.w, h0 = hi.x, h1 = hi.y, h2 = hi.z, h3 = hi.w;
    if (FIRST)
        asm volatile("s_nop 7\n\tv_cvt_pk_f16_f32 %0, %4, %5 clamp\n\tv_cvt_pk_f16_f32 %1, %6, %7 clamp\n\tv_cvt_pk_f16_f32 %2, %8, %9 clamp\n\tv_cvt_pk_f16_f32 %3, %10, %11 clamp"
                     : "=&v"(o0), "=&v"(o1), "=&v"(o2), "=&v"(o3) : "v"(l0), "v"(l1), "v"(l2), "v"(l3), "v"(h0), "v"(h1), "v"(h2), "v"(h3));
    else
        asm volatile("v_cvt_pk_f16_f32 %0, %4, %5 clamp\n\tv_cvt_pk_f16_f32 %1, %6, %7 clamp\n\tv_cvt_pk_f16_f32 %2, %8, %9 clamp\n\tv_cvt_pk_f16_f32 %3, %10, %11 clamp\n\ts_nop 1"
                     : "=&v"(o0), "=&v"(o1), "=&v"(o2), "=&v"(o3) : "v"(l0), "v"(l1), "v"(l2), "v"(l3), "v"(h0), "v"(h1), "v"(h2), "v"(h3));
    const u32x4 w = {o0, o1, o2, o3};
    return __builtin_bit_cast(f16x8, w);
}
__device__ __forceinline__ int score_bin(float sc) { int b = (int)sc; b = b < 0 ? 0 : b; return b > NBIN - 1 ? NBIN - 1 : b; }

template <int PASS, bool MASKED>
__device__ __forceinline__ void score_block(LAS unsigned char* lds, const f16x8 bfr, int s, int t0, int kc, const f16x8 (&afr)[4][2], const f16x8 (&wfr)[4], const int (&bst)[4]) {
    LAS unsigned* hist = (LAS unsigned*)(lds + L_HIST);
    LAS unsigned short* sel = (LAS unsigned short*)(lds + L_SEL);
    LAS unsigned short* seld = (LAS unsigned short*)(lds + L_SELD);
    LAS u32x2* cand = (LAS u32x2*)(lds + L_HIST);
    LAS int* ctl = (LAS int*)(lds + L_CTL);
    const f32x4 zero = {0.f, 0.f, 0.f, 0.f};
    const f32x4 off = {1024.f, 1024.f, 1024.f, 1024.f};
    f32x4 a1[4], a2[4];
#pragma unroll
    for (int grp = 0; grp < 4; ++grp) {
        a1[grp] = __builtin_amdgcn_mfma_f32_16x16x32_f16(afr[grp][0], bfr, zero, 0, 0, 0);
        a2[grp] = __builtin_amdgcn_mfma_f32_16x16x32_f16(afr[grp][1], bfr, zero, 0, 0, 0);
    }
    __builtin_amdgcn_sched_barrier(0);
    f16x8 rp[4];
    rp[0] = relu_pack<true>(a1[0], a2[0]); rp[1] = relu_pack<false>(a1[1], a2[1]); rp[2] = relu_pack<false>(a1[2], a2[2]); rp[3] = relu_pack<false>(a1[3], a2[3]);
    __builtin_amdgcn_sched_barrier(0);
    float sc[4];
    { const f32x4 c0 = __builtin_amdgcn_mfma_f32_16x16x32_f16(wfr[0], rp[0], off, 0, 0, 0); const f32x4 c1 = __builtin_amdgcn_mfma_f32_16x16x32_f16(wfr[1], rp[1], off, 0, 0, 0);
      const f32x4 c2 = __builtin_amdgcn_mfma_f32_16x16x32_f16(wfr[2], rp[2], off, 0, 0, 0); const f32x4 c3 = __builtin_amdgcn_mfma_f32_16x16x32_f16(wfr[3], rp[3], off, 0, 0, 0);
      sc[0] = c0.x; sc[1] = c1.y; sc[2] = c2.z; sc[3] = c3.w; }
    int bin[4]; bool ok[4];
#pragma unroll
    for (int grp = 0; grp < 4; ++grp) { bin[grp] = score_bin(sc[grp]); ok[grp] = MASKED ? (s <= t0 + 4 * grp + kc) : true; }
    if (PASS == 1) {
#pragma unroll
        for (int grp = 0; grp < 4; ++grp) { const int row = 4 * grp + kc;
            if (ok[grp]) __hip_atomic_fetch_add(hist + row * 1024 + (bin[grp] >> 1), (bin[grp] & 1) ? 0x10000u : 1u, __ATOMIC_RELAXED, __HIP_MEMORY_SCOPE_WORKGROUP); }
    } else {
        bool sg[4], cg[4]; int pos[4];
#pragma unroll
        for (int grp = 0; grp < 4; ++grp) { sg[grp] = ok[grp] && bin[grp] > bst[grp]; cg[grp] = ok[grp] && bin[grp] == bst[grp]; pos[grp] = 0; }
#pragma unroll
        for (int grp = 0; grp < 4; ++grp) { const int row = 4 * grp + kc;
            if (sg[grp]) pos[grp] = __hip_atomic_fetch_add(ctl + row * 8 + 0, 1, __ATOMIC_RELAXED, __HIP_MEMORY_SCOPE_WORKGROUP); }
#pragma unroll
        for (int grp = 0; grp < 4; ++grp) { const int row = 4 * grp + kc;
            if (sg[grp]) { sel[row * 256 + (pos[grp] & 255)] = (unsigned short)s; const int dd = t0 + row - s; seld[row * 256 + (pos[grp] & 255)] = (unsigned short)((dd > 127 ? 127 : dd) * 32); } }
        if (__any((cg[0] || cg[1]) || (cg[2] || cg[3]))) {
#pragma unroll
            for (int grp = 0; grp < 4; ++grp) { const int row = 4 * grp + kc;
                if (cg[grp]) { const int p = __hip_atomic_fetch_add(ctl + row * 8 + 1, 1, __ATOMIC_RELAXED, __HIP_MEMORY_SCOPE_WORKGROUP);
                    if (p < CANDCAP) { u32x2 e; e.x = __float_as_uint(sc[grp]); e.y = (unsigned)s; cand[row * CANDCAP + p] = e; } } }
        }
    }
}
template <int PASS>
__device__ __forceinline__ void score_pass(LAS unsigned char* lds, const _Float16* __restrict__ proj, int b, int t0, int nkb, int wave, int lane,
                                           const f16x8 (&afr)[4][2], const f16x8 (&wfr)[4]) {
    LAS int* ctl = (LAS int*)(lds + L_CTL);
    const int kc = lane >> 4, n16 = lane & 15;
    int bst[4];
#pragma unroll
    for (int grp = 0; grp < 4; ++grp) bst[grp] = (PASS == 2) ? ctl[(4 * grp + kc) * 8 + 2] : 0;
    const _Float16* kbase = (const _Float16*)((const char*)proj + ((long)WS_KIC - (long)WS_PROJ)) + (size_t)(b * S_ + n16) * 32 + 8 * kc;
    const int klast = nkb - 1;
#define DSA_KLOAD(kk) (*(const f16x8*)(kbase + (size_t)(16 * ((kk) < klast ? (kk) : klast)) * 32))
#define DSA_KSTEP(reg, kk) do { f16x8 bfr_ = reg * (_Float16)0.0625f; asm volatile("" : "+v"(bfr_)); reg = DSA_KLOAD((kk) + 32); if ((kk) < nkb) { const int s_ = 16 * (kk) + n16; \
        if ((kk) != klast) score_block<PASS, false>(lds, bfr_, s_, t0, kc, afr, wfr, bst); else score_block<PASS, true>(lds, bfr_, s_, t0, kc, afr, wfr, bst); } } while (0)
    f16x8 kb0 = DSA_KLOAD(wave); __builtin_amdgcn_sched_barrier(0);
    f16x8 kb1 = DSA_KLOAD(wave + 8); __builtin_amdgcn_sched_barrier(0);
    f16x8 kb2 = DSA_KLOAD(wave + 16); __builtin_amdgcn_sched_barrier(0);
    f16x8 kb3 = DSA_KLOAD(wave + 24); __builtin_amdgcn_sched_barrier(0);
#pragma unroll 1
    for (int kb = wave; kb < nkb; kb += 32) {
        DSA_KSTEP(kb0, kb); DSA_KSTEP(kb1, kb + 8); DSA_KSTEP(kb2, kb + 16); DSA_KSTEP(kb3, kb + 24);
    }
#undef DSA_KSTEP
#undef DSA_KLOAD
}

__device__ __forceinline__ unsigned wave_prefix_incl(unsigned x) {
    int v = (int)x;
    v += __builtin_amdgcn_update_dpp(0, v, 0x111, 0xf, 0xf, true);
    v += __builtin_amdgcn_update_dpp(0, v, 0x112, 0xf, 0xf, true);
    v += __builtin_amdgcn_update_dpp(0, v, 0x114, 0xf, 0xf, true);
    v += __builtin_amdgcn_update_dpp(0, v, 0x118, 0xf, 0xf, true);
    v += __builtin_amdgcn_update_dpp(0, v, 0x142, 0xa, 0xf, false);
    v += __builtin_amdgcn_update_dpp(0, v, 0x143, 0xc, 0xf, false);
    return (unsigned)v;
}
__device__ __forceinline__ unsigned wave_suffix_incl(unsigned x) {
    const unsigned p = wave_prefix_incl(x);
    const unsigned tot = (unsigned)__builtin_amdgcn_readlane((int)p, 63);
    return tot - p + x;
}

__device__ __forceinline__ void dsa_tile(LAS unsigned char* lds, const _Float16* __restrict__ proj, _Float16* __restrict__ o_a, int b, int qt) {
    int tid_ = threadIdx.x; asm volatile("" : "+v"(tid_));
    const int tid = tid_, lane = tid & 63, wave = __builtin_amdgcn_readfirstlane(tid >> 6);
    const int kc = lane >> 4, n16 = lane & 15;
    const int t0 = qt * TQ, nkb = qt + 1;
    LAS unsigned* hist = (LAS unsigned*)(lds + L_HIST);
    LAS unsigned short* sel = (LAS unsigned short*)(lds + L_SEL);
    LAS u32x2* cand = (LAS u32x2*)(lds + L_HIST);
    LAS int* ctl = (LAS int*)(lds + L_CTL);
    LAS float* biaslut = (LAS float*)(lds + L_BIAS);
    for (int i = tid; i < (TQ * 1024 + 4096) / 4; i += 512) ((LAS u32x4*)hist)[i] = (u32x4){0u, 0u, 0u, 0u};
    if (tid < TQ * 8) ctl[tid] = 0;
    f16x8 afr[4][2]; f16x8 wfr[4];
    { const int g = n16 >> 2, r = n16 & 3;
      const _Float16 qs = (_Float16)0.0625f;
#pragma unroll
      for (int grp = 0; grp < 4; ++grp) {
          const _Float16* qrow = proj + (size_t)(b * S_ + t0 + 4 * grp + g) * PW + C_QI;
          afr[grp][0] = *(const f16x8*)(qrow + r * 32 + 8 * kc) * qs;
          afr[grp][1] = *(const f16x8*)(qrow + (4 + r) * 32 + 8 * kc) * qs;
      }
      const f16x8 wv = *(const f16x8*)(proj + (size_t)(b * S_ + t0 + 4 * r + kc) * PW + C_WI);
      float wf[8]; float ss = 0.f;
#pragma unroll
      for (int h = 0; h < 8; ++h) { wf[h] = (float)wv[h] * (1.f / 16.f); ss = fmaf(wf[h], wf[h], ss); }
      const float sc2 = 32.f * 256.f * rsqrtf(ss + 1e-12f);
      f16x8 wrow;
#pragma unroll
      for (int h = 0; h < 8; ++h) wrow[h] = (g == kc) ? (_Float16)(wf[h] * sc2) : (_Float16)0.f;
      const f16x8 z8 = {0, 0, 0, 0, 0, 0, 0, 0};
#pragma unroll
      for (int grp = 0; grp < 4; ++grp) wfr[grp] = (r == grp) ? wrow : z8;
    }
    __syncthreads();
    score_pass<1>(lds, proj, b, t0, nkb, wave, lane, afr, wfr);
    __syncthreads();
#pragma unroll 1
    for (int i = 0; i < 2; ++i) {
        const int row = 2 * wave + i, n = t0 + row + 1;
        if (n <= 256) { if (lane == 0) { ctl[row * 8 + 2] = -1; ctl[row * 8 + 3] = 0; } }
        else {
            const LAS u32x4* hp = (const LAS u32x4*)(hist + row * 1024 + 16 * lane);
            unsigned tot = 0;
#pragma unroll
            for (int q4 = 0; q4 < 4; ++q4) { const u32x4 hv = hp[q4];
                tot += (hv.x & 0xffffu) + (hv.x >> 16) + (hv.y & 0xffffu) + (hv.y >> 16) + (hv.z & 0xffffu) + (hv.z >> 16) + (hv.w & 0xffffu) + (hv.w >> 16); }
            const unsigned suf = wave_suffix_incl(tot);
            const unsigned above_lane = suf - tot;
            const unsigned long long cross = __ballot(above_lane < 256u && suf >= 256u);
            const int lx = __builtin_ctzll(cross);
            const unsigned abovex = (unsigned)__builtin_amdgcn_readlane((int)above_lane, lx);
            const unsigned c2 = lane < 32 ? (unsigned)((const LAS unsigned short*)hist)[row * 2048 + 32 * lx + lane] : 0u;
            const unsigned suf2 = wave_suffix_incl(c2);
            const unsigned above2 = abovex + suf2 - c2;
            if (lane < 32 && above2 < 256u && above2 + c2 >= 256u) {
                const int bs = 32 * lx + lane; const unsigned cum = above2;
                ctl[row * 8 + 2] = bs; ctl[row * 8 + 3] = 256 - (int)cum;
            }
        }
    }
    __syncthreads();
    score_pass<2>(lds, proj, b, t0, nkb, wave, lane, afr, wfr);
    __syncthreads();
#pragma unroll 1
    for (int i = 0; i < 2; ++i) {
        const int row = 2 * wave + i, n = t0 + row + 1;
        const int need = ctl[row * 8 + 3], base = ctl[row * 8 + 0];
        int nc = ctl[row * 8 + 1];
        nc = nc < CANDCAP ? nc : CANDCAP;
        if (lane == 0) { const int nf = base + (need < nc ? need : nc); ctl[row * 8 + 4] = n <= 256 ? n : (nf < 256 ? nf : 256); }
        if (need > 0) {
            for (int c0 = 0; c0 < nc; c0 += 64) {
                const int ci = c0 + lane; const bool act = ci < nc;
                const u32x2 me = cand[row * CANDCAP + (act ? ci : 0)];
                const float msc = __uint_as_float(me.x); int rank = 0;
                for (int j = 0; j < nc; ++j) { const u32x2 ot = cand[row * CANDCAP + j]; const float osc = __uint_as_float(ot.x);
                    rank += (osc > msc || (osc == msc && ot.y < me.y)) ? 1 : 0; }
                if (act && rank < need) { sel[row * 256 + ((base + rank) & 255)] = (unsigned short)me.y; const int dd = t0 + row - (int)me.y; ((LAS unsigned short*)(lds + L_SELD))[row * 256 + ((base + rank) & 255)] = (unsigned short)((dd > 127 ? 127 : dd) * 32); }
            }
        }
    }
    __syncthreads();
    int tq_ = threadIdx.x; asm volatile("" : "+v"(tq_));
    const int lane_a = tq_ & 63;
    LAS unsigned char* vst = lds + L_VST + wave * (32 * VPITCH);
#pragma unroll 1
    for (int i = 0; i < 2; ++i) { const int lane = lane_a, kc = lane >> 4, n16 = lane & 15;
        const int row = 2 * wave + i, t = t0 + row; const int nvalid = ctl[row * 8 + 4];
        const _Float16* qrow = proj + (size_t)(b * S_ + t) * PW + C_QA;
        const int head = n16, hm = head & 7;
        f16x8 qb0, qb1;
        { const f16x8 z = {0, 0, 0, 0, 0, 0, 0, 0}; qb0 = z; qb1 = z;
          if (head < 8) { qb0 = *(const f16x8*)(qrow + head * 64 + 8 * kc); qb1 = *(const f16x8*)(qrow + head * 64 + 32 + 8 * kc); } }
        f32x4 ot[4];
#pragma unroll
        for (int dt = 0; dt < 4; ++dt) ot[dt] = (f32x4){0.f, 0.f, 0.f, 0.f};
        float mrun = -INFINITY, lrun = 0.f;
        const LAS unsigned short* selr = sel + row * 256;
        const LAS unsigned short* seldr = (const LAS unsigned short*)(lds + L_SELD) + row * 256;
        const LAS unsigned char* biasb = lds + L_BIAS + hm * 4;
        const _Float16* pbat = proj + (size_t)(b * S_) * PW;
        LAS unsigned char* kst = lds + L_HIST + wave * (32 * VPITCH);
        u32x4 gk[4], gv[4];
        const char* pbyte = (const char*)pbat;
#define DSA_GATHER(jj) do { unsigned ix_[4]; _Pragma("unroll") for (int i_ = 0; i_ < 4; ++i_) ix_[i_] = (unsigned)selr[32 * (jj) + 8 * i_ + (lane >> 3)]; \
        _Pragma("unroll") for (int i_ = 0; i_ < 4; ++i_) { const int pos_ = 32 * (jj) + 8 * i_ + (lane >> 3); \
            const unsigned idx_ = pos_ < nvalid ? ix_[i_] : 0u; const char* rp_ = pbyte + (size_t)(idx_ * (unsigned)(PW * 2) + (unsigned)(C_KA * 2 + 16 * (lane & 7))); \
            gk[i_] = *(const u32x4*)rp_; gv[i_] = *(const u32x4*)(rp_ + 128); } } while (0)
        DSA_GATHER(0);
        const int nsteps = (nvalid + 31) >> 5;
#pragma unroll 1
        for (int j = 0; j < nsteps; ++j) {
#pragma unroll
            for (int i_ = 0; i_ < 4; ++i_) { const int ro = (8 * i_ + (lane >> 3)) * VPITCH + 16 * (lane & 7);
                *(LAS u32x4*)(kst + ro) = gk[i_]; *(LAS u32x4*)(vst + ro) = gv[i_]; }
            if (j + 1 < nsteps) DSA_GATHER(j + 1);
            asm volatile("s_waitcnt lgkmcnt(0)" ::: "memory");
            const f16x8 ca0 = *(const LAS f16x8*)(kst + n16 * VPITCH + 16 * kc), ca1 = *(const LAS f16x8*)(kst + n16 * VPITCH + 64 + 16 * kc);
            const f16x8 cb0 = *(const LAS f16x8*)(kst + (16 + n16) * VPITCH + 16 * kc), cb1 = *(const LAS f16x8*)(kst + (16 + n16) * VPITCH + 64 + 16 * kc);
            f32x4 sa = {0.f, 0.f, 0.f, 0.f}, sb = {0.f, 0.f, 0.f, 0.f};
            sa = __builtin_amdgcn_mfma_f32_16x16x32_f16(ca0, qb0, sa, 0, 0, 0); sa = __builtin_amdgcn_mfma_f32_16x16x32_f16(ca1, qb1, sa, 0, 0, 0);
            sb = __builtin_amdgcn_mfma_f32_16x16x32_f16(cb0, qb0, sb, 0, 0, 0); sb = __builtin_amdgcn_mfma_f32_16x16x32_f16(cb1, qb1, sb, 0, 0, 0);
            const int p0 = 32 * j + 4 * kc;
            const u32x2 iwa = *(const LAS u32x2*)(seldr + p0), iwb = *(const LAS u32x2*)(seldr + p0 + 16);
            const unsigned wa0 = iwa.x, wa1 = iwa.y, wb0 = iwb.x, wb1 = iwb.y;
            const unsigned bo[8] = {wa0 & 0xffffu, wa0 >> 16, wa1 & 0xffffu, wa1 >> 16, wb0 & 0xffffu, wb0 >> 16, wb1 & 0xffffu, wb1 >> 16};
            float v[8] = {sa.x, sa.y, sa.z, sa.w, sb.x, sb.y, sb.z, sb.w};
            float tm = -INFINITY;
            if (nvalid == 256) {
#pragma unroll
                for (int e = 0; e < 8; ++e) { v[e] = fmaf(v[e], 0.125f, *(const LAS float*)(biasb + bo[e])); tm = fmaxf(tm, v[e]); }
            } else {
#pragma unroll
                for (int e = 0; e < 8; ++e) {
                    const bool ok = (p0 + (e & 3) + 16 * (e >> 2)) < nvalid;
                    const float lg = v[e] * 0.125f + *(const LAS float*)(biasb + bo[e]);
                    v[e] = ok ? lg : -INFINITY; tm = fmaxf(tm, v[e]);
                }
            }
            tm = max_xor16(tm); tm = max_xor32(tm);
            const float mn = fmaxf(mrun, tm);
            const float alpha = __expf(mrun - mn);
            float ps = 0.f;
#pragma unroll
            for (int e = 0; e < 8; ++e) { v[e] = __expf(v[e] - mn); ps += v[e]; }
            lrun = lrun * alpha + ps; mrun = mn;
#pragma unroll
            for (int dt = 0; dt < 4; ++dt) ot[dt] = ot[dt] * alpha;
            const f16x8 pfr = {(_Float16)v[0], (_Float16)v[1], (_Float16)v[2], (_Float16)v[3], (_Float16)v[4], (_Float16)v[5], (_Float16)v[6], (_Float16)v[7]};
            asm volatile("s_waitcnt lgkmcnt(0)" ::: "memory");
            const int q = n16 >> 2, p = n16 & 3;
#pragma unroll
            for (int dt = 0; dt < 4; ++dt) {
                const s16x4 ta = __builtin_amdgcn_ds_read_tr16_b64_v4i16((LAS s16x4*)(vst + (4 * kc + q) * VPITCH + (16 * dt + 4 * p) * 2));
                const s16x4 tb = __builtin_amdgcn_ds_read_tr16_b64_v4i16((LAS s16x4*)(vst + (16 + 4 * kc + q) * VPITCH + (16 * dt + 4 * p) * 2));
                const f16x4 fa = __builtin_bit_cast(f16x4, ta), fb = __builtin_bit_cast(f16x4, tb);
                const f16x8 vfr = {fa.x, fa.y, fa.z, fa.w, fb.x, fb.y, fb.z, fb.w};
                ot[dt] = __builtin_amdgcn_mfma_f32_16x16x32_f16(vfr, pfr, ot[dt], 0, 0, 0);
            }
            asm volatile("s_waitcnt lgkmcnt(0)" ::: "memory");
        }
#undef DSA_GATHER
        lrun = sum_xor16(lrun); lrun = sum_xor32(lrun);
        const float inv = 1.f / fmaxf(lrun, 1e-30f);
        if (head < 8) {
            _Float16* orow = o_a + (size_t)(b * S_ + t) * 1024 + head * 64 + 4 * kc;
#pragma unroll
            for (int dt = 0; dt < 4; ++dt) { u32x2 w; w.x = pg8::pkh(ot[dt].x * inv, ot[dt].y * inv); w.y = pg8::pkh(ot[dt].z * inv, ot[dt].w * inv); *(u32x2*)(orow + 16 * dt) = w; }
        }
    }
    __syncthreads();
}
}


namespace nsa {
typedef _Float16 f16x8 __attribute__((ext_vector_type(8)));
typedef _Float16 f16x4 __attribute__((ext_vector_type(4)));
typedef short s16x4 __attribute__((ext_vector_type(4)));
typedef float f32x4 __attribute__((ext_vector_type(4)));
typedef float f32x16 __attribute__((ext_vector_type(16)));
typedef unsigned u32x4 __attribute__((ext_vector_type(4)));
typedef unsigned u32x2 __attribute__((ext_vector_type(2)));
constexpr int KP = 144, VP = 192;
constexpr int TILE_B = 64 * KP + 64 * VP;
constexpr int L_T0 = 0, L_BIAS = 2 * TILE_B, L_IMPA = L_BIAS + 4096, L_IMPC = L_IMPA + 16384, L_MASK = L_IMPC + 16384, L_END = L_MASK + 512;
static_assert(L_END <= 131072, "nsa LDS");
constexpr float LOG2E = 1.4426950408889634f;
constexpr float SC = 0.125f * LOG2E;
__device__ __forceinline__ float max3f(float a, float b, float c) { float r; asm("v_max3_f32 %0, %1, %2, %3" : "=v"(r) : "v"(a), "v"(b), "v"(c)); return r; }

struct Src { const _Float16* k; const _Float16* v; int pitch; };

struct Stage { u32x4 kr, vr; };
__device__ __forceinline__ void stage_load(Stage& st, const Src& s, int row0, int tid, bool need_v) {
    const int r = tid >> 3, c = tid & 7;
    st.kr = *(const u32x4*)(s.k + (size_t)(row0 + r) * s.pitch + 8 * c);
    if (need_v) st.vr = *(const u32x4*)(s.v + (size_t)(row0 + r) * s.pitch + 8 * c);
}
__device__ __forceinline__ void stage_store(const Stage& st, LAS unsigned char* tb, int tid, bool need_v) {
    const int r = tid >> 3, c = tid & 7;
    *(LAS u32x4*)(tb + r * KP + 16 * c) = st.kr;
    if (need_v) *(LAS u32x4*)(tb + 64 * KP + r * VP + 16 * c) = st.vr;
}

struct RowState { float m; f32x4 lacc; f32x16 o0, o1; };
__device__ __forceinline__ float row_sum(const RowState& rs, int rho) {
    const float a = __shfl(rs.lacc[0], rho & 15), b = __shfl(rs.lacc[1], rho & 15);
    return (rho & 16) ? b : a;
}
__device__ __forceinline__ f16x8 ones_frag() {
    int l = threadIdx.x; asm volatile("" : "+v"(l));
    const int m = l & 15, c = (l >> 4) & 3;
    const _Float16 v = (m < 2 && (c & 1) == m) ? (_Float16)1.f : (_Float16)0.f;
    const f16x8 r = {v, v, v, v, v, v, v, v};
    return r;
}

__device__ __forceinline__ void qk_half(const LAS unsigned char* kt, const f16x8 (&qf)[4], int rho, int hi, int kh, f32x16& s0) {
#pragma unroll
    for (int i = 0; i < 16; ++i) s0[i] = 0.f;
    const LAS unsigned char* kb = kt + (32 * kh + rho) * KP + 16 * hi;
#pragma unroll
    for (int ks = 0; ks < 4; ++ks) {
        const f16x8 a0 = *(const LAS f16x8*)(kb + 32 * ks);
        s0 = __builtin_amdgcn_mfma_f32_32x32x16_f16(a0, qf[ks], s0, 0, 0, 0);
    }
}
__device__ __forceinline__ void logits(f32x16& s0, const LAS float* lut, int hb, int hi, int dbase, int dstep, int dlim, bool bit) {
#pragma unroll
    for (int rg = 0; rg < 16; ++rg) {
        const int kl = (rg & 3) + 8 * (rg >> 2) + 4 * hi;
        const int d = dbase - dstep * kl;
        int dc = d < 0 ? 0 : d; dc = dc > 127 ? 127 : dc;
        const float bias = lut[dc * 8 + hb];
        const bool ok = bit && d >= 0 && d < dlim;
        s0[rg] = ok ? fmaf(s0[rg], SC, bias) : -INFINITY;
    }
}
__device__ __forceinline__ void pv_half(RowState& rs, const f32x16& s0, const LAS unsigned char* vt, int rho, int hi, int kh) {
    const int l16 = rho & 15, g16 = rho >> 4, q = l16 >> 2, p = l16 & 3;
    const LAS unsigned char* vb = vt + (32 * kh + 4 * hi + q) * VP + (16 * g16 + 4 * p) * 2;
#pragma unroll
    for (int sx = 0; sx < 2; ++sx) {
        f16x8 pfr;
#pragma unroll
        for (int j = 0; j < 8; ++j) pfr[j] = (_Float16)s0[8 * sx + j];
#pragma unroll
        for (int dt = 0; dt < 2; ++dt) {
            const s16x4 ta = __builtin_amdgcn_ds_read_tr16_b64_v4i16((LAS s16x4*)(vb + (16 * sx) * VP + 64 * dt));
            const s16x4 tb = __builtin_amdgcn_ds_read_tr16_b64_v4i16((LAS s16x4*)(vb + (16 * sx + 8) * VP + 64 * dt));
            const f16x4 fa = __builtin_bit_cast(f16x4, ta), fb = __builtin_bit_cast(f16x4, tb);
            const f16x8 vfr = {fa.x, fa.y, fa.z, fa.w, fb.x, fb.y, fb.z, fb.w};
            if (dt == 0) rs.o0 = __builtin_amdgcn_mfma_f32_32x32x16_f16(vfr, pfr, rs.o0, 0, 0, 0);
            else rs.o1 = __builtin_amdgcn_mfma_f32_32x32x16_f16(vfr, pfr, rs.o1, 0, 0, 0);
        }
    }
}
__device__ __forceinline__ void rescale_if_needed(RowState& rs, float tmx) {
    if (__any(tmx > rs.m + 8.f)) {
        const float mn = fmaxf(rs.m, tmx);
        const float mu = (mn == -INFINITY) ? 0.f : mn;
        const float alpha = __builtin_amdgcn_exp2f(rs.m - mu);
        { int l_ = threadIdx.x; asm volatile("" : "+v"(l_)); const float a16 = __shfl(alpha, (l_ & 15) + 16); rs.lacc[0] *= alpha; rs.lacc[1] *= a16; } rs.m = mn;
#pragma unroll
        for (int i = 0; i < 16; ++i) { rs.o0[i] *= alpha; rs.o1[i] *= alpha; }
    }
}
__device__ __forceinline__ void tile_fast(RowState& rs, const LAS unsigned char* kt, const LAS unsigned char* vt, const f16x8 (&qf)[4], float c, int rho, int hi) {
    const LAS unsigned char* kb = kt + rho * KP + 16 * hi;
    f16x8 ka[4], kb2[4];
#pragma unroll
    for (int ks = 0; ks < 4; ++ks) { ka[ks] = *(const LAS f16x8*)(kb + 32 * ks); kb2[ks] = *(const LAS f16x8*)(kb + 32 * KP + 32 * ks); }
    const int l16 = rho & 15, g16 = rho >> 4, q = l16 >> 2, p = l16 & 3;
    const LAS unsigned char* vb = vt + (4 * hi + q) * VP + (16 * g16 + 4 * p) * 2;
    s16x4 va[4][2], vc[4][2];
    __builtin_amdgcn_sched_barrier(0);
    f32x16 s0, s1;
#pragma unroll
    for (int i = 0; i < 16; ++i) { s0[i] = 0.f; s1[i] = 0.f; }
#pragma unroll
    for (int ks = 0; ks < 4; ++ks) {
        s0 = __builtin_amdgcn_mfma_f32_32x32x16_f16(ka[ks], qf[ks], s0, 0, 0, 0);
        s1 = __builtin_amdgcn_mfma_f32_32x32x16_f16(kb2[ks], qf[ks], s1, 0, 0, 0);
    }
    __builtin_amdgcn_sched_barrier(0);
#pragma unroll
    for (int st = 0; st < 4; ++st)
#pragma unroll
        for (int dt = 0; dt < 2; ++dt) {
            va[st][dt] = __builtin_amdgcn_ds_read_tr16_b64_v4i16((LAS s16x4*)(vb + (16 * st) * VP + 64 * dt));
            vc[st][dt] = __builtin_amdgcn_ds_read_tr16_b64_v4i16((LAS s16x4*)(vb + (16 * st + 8) * VP + 64 * dt));
        }
    __builtin_amdgcn_sched_barrier(0);
    float tm = max3f(s0[0], s1[0], -INFINITY);
#pragma unroll
    for (int i = 1; i < 16; ++i) tm = max3f(tm, s0[i], s1[i]);
    { const auto r2 = __builtin_amdgcn_permlane32_swap(__float_as_uint(tm), __float_as_uint(tm), false, false); tm = fmaxf(__uint_as_float(r2[0]), __uint_as_float(r2[1])); }
    rescale_if_needed(rs, fmaf(tm, SC, c));
    const float mu = (rs.m == -INFINITY) ? 0.f : rs.m;
    const float cm = c - mu;
#pragma unroll
    for (int i = 0; i < 16; ++i) { s0[i] = __builtin_amdgcn_exp2f(fmaf(s0[i], SC, cm)); s1[i] = __builtin_amdgcn_exp2f(fmaf(s1[i], SC, cm)); }
    const f16x8 onesf = ones_frag();
#pragma unroll
    for (int st = 0; st < 4; ++st) {
        f16x8 pfr;
#pragma unroll
        for (int j = 0; j < 8; ++j) pfr[j] = (_Float16)((st & 2) ? s1[8 * (st & 1) + j] : s0[8 * (st & 1) + j]);
        rs.lacc = __builtin_amdgcn_mfma_f32_16x16x32_f16(onesf, pfr, rs.lacc, 0, 0, 0);
#pragma unroll
        for (int dt = 0; dt < 2; ++dt) {
            const f16x4 fa = __builtin_bit_cast(f16x4, va[st][dt]), fb = __builtin_bit_cast(f16x4, vc[st][dt]);
            const f16x8 vfr = {fa.x, fa.y, fa.z, fa.w, fb.x, fb.y, fb.z, fb.w};
            if (dt == 0) rs.o0 = __builtin_amdgcn_mfma_f32_32x32x16_f16(vfr, pfr, rs.o0, 0, 0, 0);
            else rs.o1 = __builtin_amdgcn_mfma_f32_32x32x16_f16(vfr, pfr, rs.o1, 0, 0, 0);
        }
    }
}
template <bool IMP>
__device__ __forceinline__ void tile_general(RowState& rs, const LAS unsigned char* kt, const LAS unsigned char* vt, const f16x8 (&qf)[4], const LAS float* lut, int hb, int rho, int hi,
                                             int dbase, int dstep, unsigned dlim, float mc, float invl, LAS float* impA, LAS float* impC, int n, bool wr) {
    const LAS unsigned char* kb = kt + rho * KP + 16 * hi;
    f16x8 ka[4], kb2[4];
#pragma unroll
    for (int ks = 0; ks < 4; ++ks) { ka[ks] = *(const LAS f16x8*)(kb + 32 * ks); kb2[ks] = *(const LAS f16x8*)(kb + 32 * KP + 32 * ks); }
    const int d0 = dbase - dstep * 4 * hi;
    __builtin_amdgcn_sched_barrier(0);
    f32x16 s0, s1;
#pragma unroll
    for (int i = 0; i < 16; ++i) { s0[i] = 0.f; s1[i] = 0.f; }
#pragma unroll
    for (int ks = 0; ks < 4; ++ks) {
        s0 = __builtin_amdgcn_mfma_f32_32x32x16_f16(ka[ks], qf[ks], s0, 0, 0, 0);
        s1 = __builtin_amdgcn_mfma_f32_32x32x16_f16(kb2[ks], qf[ks], s1, 0, 0, 0);
    }
    __builtin_amdgcn_sched_barrier(0);
    float b0[16], b1[16];
#pragma unroll
    for (int rg = 0; rg < 16; ++rg) {
        const int kl = (rg & 3) + 8 * (rg >> 2);
        int da = d0 - dstep * kl, db = d0 - dstep * (kl + 32);
        da = da < 0 ? 0 : da; da = da > 127 ? 127 : da; db = db < 0 ? 0 : db; db = db > 127 ? 127 : db;
        b0[rg] = lut[da * 8 + hb]; b1[rg] = lut[db * 8 + hb];
    }
    float tm = -INFINITY;
#pragma unroll
    for (int rg = 0; rg < 16; ++rg) {
        const int kl = (rg & 3) + 8 * (rg >> 2);
        const unsigned da = (unsigned)(d0 - dstep * kl), db = (unsigned)(d0 - dstep * (kl + 32));
        s0[rg] = da < dlim ? fmaf(s0[rg], SC, b0[rg]) : -INFINITY;
        s1[rg] = db < dlim ? fmaf(s1[rg], SC, b1[rg]) : -INFINITY;
        tm = max3f(tm, s0[rg], s1[rg]);
    }
    __builtin_amdgcn_sched_barrier(0);
    const int l16 = rho & 15, g16 = rho >> 4, q = l16 >> 2, p = l16 & 3;
    const LAS unsigned char* vb = vt + (4 * hi + q) * VP + (16 * g16 + 4 * p) * 2;
    s16x4 va[4][2], vc[4][2];
    if (!IMP) {
#pragma unroll
        for (int st = 0; st < 4; ++st)
#pragma unroll
            for (int dt = 0; dt < 2; ++dt) {
                va[st][dt] = __builtin_amdgcn_ds_read_tr16_b64_v4i16((LAS s16x4*)(vb + (16 * st) * VP + 64 * dt));
                vc[st][dt] = __builtin_amdgcn_ds_read_tr16_b64_v4i16((LAS s16x4*)(vb + (16 * st + 8) * VP + 64 * dt));
            }
        __builtin_amdgcn_sched_barrier(0);
    }
    if (!IMP) {
        { const auto r2 = __builtin_amdgcn_permlane32_swap(__float_as_uint(tm), __float_as_uint(tm), false, false); tm = fmaxf(__uint_as_float(r2[0]), __uint_as_float(r2[1])); }
        rescale_if_needed(rs, tm);
        const float mu = (rs.m == -INFINITY) ? 0.f : rs.m;
#pragma unroll
        for (int i = 0; i < 16; ++i) { s0[i] = __builtin_amdgcn_exp2f(s0[i] - mu); s1[i] = __builtin_amdgcn_exp2f(s1[i] - mu); }
        const f16x8 onesf = ones_frag();
#pragma unroll
        for (int st = 0; st < 4; ++st) {
            f16x8 pfr;
#pragma unroll
            for (int j = 0; j < 8; ++j) pfr[j] = (_Float16)((st & 2) ? s1[8 * (st & 1) + j] : s0[8 * (st & 1) + j]);
            rs.lacc = __builtin_amdgcn_mfma_f32_16x16x32_f16(onesf, pfr, rs.lacc, 0, 0, 0);
#pragma unroll
            for (int dt = 0; dt < 2; ++dt) {
                const f16x4 fa = __builtin_bit_cast(f16x4, va[st][dt]), fb = __builtin_bit_cast(f16x4, vc[st][dt]);
                const f16x8 vfr = {fa.x, fa.y, fa.z, fa.w, fb.x, fb.y, fb.z, fb.w};
                if (dt == 0) rs.o0 = __builtin_amdgcn_mfma_f32_32x32x16_f16(vfr, pfr, rs.o0, 0, 0, 0);
                else rs.o1 = __builtin_amdgcn_mfma_f32_32x32x16_f16(vfr, pfr, rs.o1, 0, 0, 0);
            }
        }
    } else {
        const float mu = (mc == -INFINITY) ? 0.f : mc;
#pragma unroll
        for (int kh = 0; kh < 2; ++kh)
#pragma unroll
            for (int ii = 0; ii < 4; ++ii) {
                float pv[4];
#pragma unroll
                for (int e = 0; e < 4; ++e) pv[e] = __builtin_amdgcn_exp2f((kh ? s1[4 * ii + e] : s0[4 * ii + e]) - mu) * invl;
                float a = (pv[0] + pv[1]) + (pv[2] + 0.5f * pv[3]), c = 0.5f * pv[3];
                a += xchg_xor1(a); a += xchg_xor2(a); c += xchg_xor1(c); c += xchg_xor2(c);
                const int nb = 16 * n + 8 * kh + 2 * ii + hi;
                if (wr) { impA[nb] = a; if (nb + 1 < 64) impC[nb + 1] = c; }
            }
    }
}
__device__ __forceinline__ void probs(RowState& rs, f32x16& s0, float sc, float c) {
    float tm = -INFINITY;
#pragma unroll
    for (int i = 0; i < 16; ++i) tm = fmaxf(tm, s0[i]);
    tm = fmaxf(tm, __shfl_xor(tm, 32));
    rescale_if_needed(rs, fmaf(tm, sc, c));
    const float mu = (rs.m == -INFINITY) ? 0.f : rs.m;
    const float cm = c - mu;
    float ps = 0.f;
#pragma unroll
    for (int i = 0; i < 16; ++i) { s0[i] = __builtin_amdgcn_exp2f(fmaf(s0[i], sc, cm)); ps += s0[i]; }
    rs.lacc[0] += ps;
}
__device__ __forceinline__ void rs_init(RowState& rs) { rs.m = -INFINITY; rs.lacc = (f32x4){0.f, 0.f, 0.f, 0.f};
#pragma unroll
    for (int i = 0; i < 16; ++i) { rs.o0[i] = 0.f; rs.o1[i] = 0.f; } }
template <int MODE>
__device__ __forceinline__ void rs_flush(RowState& rs, float gate, LAS unsigned char* accl, _Float16* orow) {
    int lf_ = threadIdx.x; asm volatile("" : "+v"(lf_));
    const float lt = row_sum(rs, lf_ & 31);
    const float w = gate / fmaxf(lt, 1e-30f);
#pragma unroll
    for (int i = 0; i < 4; ++i) {
        float a[8] = {w * rs.o0[4 * i], w * rs.o0[4 * i + 1], w * rs.o0[4 * i + 2], w * rs.o0[4 * i + 3], w * rs.o1[4 * i], w * rs.o1[4 * i + 1], w * rs.o1[4 * i + 2], w * rs.o1[4 * i + 3]};
        LAS unsigned char* ap = accl + (i >> 1) * 16384 + (i & 1) * 1024;
        if (MODE != 0) { float p[8]; pg8::unpk8(*(const LAS u32x4*)ap, p);
#pragma unroll
            for (int e = 0; e < 8; ++e) a[e] += p[e]; }
        u32x4 wv; wv.x = pg8::pkh(a[0], a[1]); wv.y = pg8::pkh(a[2], a[3]); wv.z = pg8::pkh(a[4], a[5]); wv.w = pg8::pkh(a[6], a[7]);
        if (MODE != 2) *(LAS u32x4*)ap = wv;
        else { u32x2 w0; w0.x = wv.x; w0.y = wv.y; u32x2 w1; w1.x = wv.z; w1.y = wv.w; *(u32x2*)(orow + 8 * i) = w0; *(u32x2*)(orow + 32 + 8 * i) = w1; }
    }
}

__device__ __forceinline__ void nsa_unit(LAS unsigned char* lds, const _Float16* __restrict__ proj, const _Float16* __restrict__ kcmp, const _Float16* __restrict__ vcmp,
                                         _Float16* __restrict__ o_b, int b, int g, int qb) {
    const int tid = threadIdx.x, lane = tid & 63, wave = __builtin_amdgcn_readfirstlane(tid >> 6);
    const int rho = lane & 31, hi = lane >> 5, ql = rho >> 2, r = rho & 3, hb = g * 4 + r;
    const int t = 64 * qb + 8 * wave + ql;
    const _Float16* prow = proj + (size_t)(b * S_ + t) * PW;
    f16x8 qf[4];
#pragma unroll
    for (int ks = 0; ks < 4; ++ks) qf[ks] = *(const f16x8*)(prow + C_QB + hb * 64 + 16 * ks + 8 * hi);
    for (int i = tid; i < 2048; i += 512) ((LAS u32x4*)(lds + L_IMPA))[i] = (u32x4){0u, 0u, 0u, 0u};
    RowState rs; rs_init(rs);
    const _Float16 gh0 = prow[C_GB + 0 * 8 + hb], gh1 = prow[C_GB + 1 * 8 + hb], gh2 = prow[C_GB + 2 * 8 + hb];
    const LAS float* lut = (const LAS float*)(lds + L_BIAS);
    const float bias31 = lut[127 * 8 + hb];
    const _Float16* kc = kcmp + (size_t)(b * 2 + g) * 256 * 64;
    const long vcoff = (vcmp + (size_t)(b * 2 + g) * 256 * 64) - kc;
    const _Float16* pb = proj + (size_t)(b * S_) * PW + C_KVB + g * 64;
    const int ncmp = (4 * qb + 3 + 63) / 64;
    const int wlo = qb - 8 > 0 ? qb - 8 : 0;
    const int e0 = ncmp, e1 = 2 * ncmp, e2 = e1 + qb + 1, NT = e2 + (qb - wlo + 1);
    const int sgrp = wave >> 2, tl = tid & 255, sr = tl >> 2, sq = tl & 3;
    float mc = 0.f, invl = 0.f; unsigned mlo = 0u, mhi = 0u;
    u32x4 sk0 = {0u, 0u, 0u, 0u}, sk1 = sk0, sv0 = sk0, sv1 = sk0;
#define NSA_DECODE(i, br, n) do { if ((i) < e0) { br = 0; n = (i); } else if ((i) < e1) { br = 1; n = (i) - e0; } else if ((i) < e2) { br = 2; n = (i) - e1; } else { br = 3; n = wlo + (i) - e2; } } while (0)
#define NSA_LOAD(i) do { int br_, n_; NSA_DECODE(i, br_, n_); const _Float16* kp_ = (br_ < 2) ? kc : (br_ == 2 ? pb + 2 * 128 : pb + 4 * 128); const int pitch_ = (br_ < 2) ? 64 : PW; \
        const long vo_ = (br_ < 2) ? vcoff : 128; const _Float16* rp_ = kp_ + (size_t)(64 * n_ + sr) * pitch_ + 16 * sq; \
        sk0 = *(const u32x4*)rp_; sk1 = *(const u32x4*)(rp_ + 8); sv0 = *(const u32x4*)(rp_ + vo_); sv1 = *(const u32x4*)(rp_ + vo_ + 8); } while (0)
#define NSA_STORE(buf) do { LAS unsigned char* tb_ = lds + L_T0 + (buf) * TILE_B; *(LAS u32x4*)(tb_ + sr * KP + 32 * sq) = sk0; *(LAS u32x4*)(tb_ + sr * KP + 32 * sq + 16) = sk1; \
        *(LAS u32x4*)(tb_ + 64 * KP + sr * VP + 32 * sq) = sv0; *(LAS u32x4*)(tb_ + 64 * KP + sr * VP + 32 * sq + 16) = sv1; } while (0)
    __syncthreads();
    asm volatile("" :: "v"(qf[0]), "v"(qf[1]), "v"(qf[2]), "v"(qf[3]), "v"(bias31));
    if (sgrp == 0) { NSA_LOAD(0); NSA_STORE(0); if (NT > 2) NSA_LOAD(2); } else if (NT > 1) NSA_LOAD(1);
    __syncthreads();
#pragma unroll 1
    for (int i = 0; i < NT; ++i) {
        int br, n; NSA_DECODE(i, br, n);
        const LAS unsigned char* tb = lds + L_T0 + (i & 1) * TILE_B;
        const bool more = i + 1 < NT;
        bool bit = true; int dbase, dstep = 1, dlim = 1 << 30; bool near = true;
        if (br < 2) { dbase = t - 31 - 1024 * n; dstep = 16; }
        else { dbase = t - 64 * n; near = n >= qb - 2; if (br == 2) bit = (n < 32) ? ((mlo >> n) & 1u) : ((mhi >> (n - 32)) & 1u); else dlim = 512; }
        const bool interior = (br >= 2) && (n <= qb - 3) && !(br == 3 && n == qb - 8);
        const bool skip = (br == 2) && !__any(bit);
        if (!skip) {
            if (interior) tile_fast(rs, tb, tb + 64 * KP, qf, bit ? bias31 : -INFINITY, rho, hi);
            else {
                const unsigned dl = bit ? (unsigned)dlim : 0u;
                int tq = threadIdx.x; asm volatile("" : "+v"(tq));
                LAS float* impA = (LAS float*)(lds + L_IMPA) + ((tq >> 6) * 8 + ((tq & 31) >> 2)) * 64;
                LAS float* impC = (LAS float*)(lds + L_IMPC) + ((tq >> 6) * 8 + ((tq & 31) >> 2)) * 64;
                if (br != 1) tile_general<false>(rs, tb, tb + 64 * KP, qf, lut, hb, rho, hi, dbase, dstep, dl, 0.f, 0.f, impA, impC, n, false);
                else tile_general<true>(rs, tb, tb + 64 * KP, qf, lut, hb, rho, hi, dbase, dstep, dl, mc, invl, impA, impC, n, r == 0);
            }
        }
        if (i + 1 == e0) {
            mc = rs.m; const float lc = row_sum(rs, rho); invl = 1.f / fmaxf(lc, 1e-30f);
        } else if (i + 1 == e1) {
            asm volatile("s_waitcnt lgkmcnt(0)" ::: "memory");
            int tq = threadIdx.x; asm volatile("" : "+v"(tq));
            const int qs = (tq & 63) >> 3, j = tq & 7, wv = tq >> 6;
            LAS float* sA = (LAS float*)(lds + L_IMPA) + (wv * 8 + qs) * 64;
            const LAS float* sC = (const LAS float*)(lds + L_IMPC) + (wv * 8 + qs) * 64;
            float sc[8];
#pragma unroll
            for (int e = 0; e < 8; ++e) { const int nn = 8 * j + e; const bool forced = (nn == 0) || (nn == qb) || (nn == qb - 1);
                sc[e] = (nn <= qb) ? (forced ? 1.0e4f : (sA[nn] + sC[nn])) : -INFINITY; }
            asm volatile("s_waitcnt lgkmcnt(0)" ::: "memory");
#pragma unroll
            for (int e = 0; e < 8; ++e) sA[8 * j + e] = sc[e];
            asm volatile("s_waitcnt lgkmcnt(0)" ::: "memory");
            int rank[8]; unsigned long long ke[8];
#pragma unroll
            for (int e = 0; e < 8; ++e) { rank[e] = 0; ke[e] = ((unsigned long long)__float_as_uint(sc[e]) << 32) | (unsigned)(63 - (8 * j + e)); }
#pragma unroll 1
            for (int m = 0; m <= qb; m += 4) { const f32x4 sv = *(const LAS f32x4*)(sA + m);
                const float sv4[4] = {sv.x, sv.y, sv.z, sv.w};
#pragma unroll
                for (int u = 0; u < 4; ++u) { const int mm = m + u;
                    const unsigned long long km = (mm <= qb) ? (((unsigned long long)__float_as_uint(sv4[u]) << 32) | (unsigned)(63 - mm)) : 0ull;
#pragma unroll
                    for (int e = 0; e < 8; ++e) rank[e] += (km > ke[e]) ? 1 : 0; } }
            unsigned bits = 0;
#pragma unroll
            for (int e = 0; e < 8; ++e) bits |= ((8 * j + e <= qb) && rank[e] < 16) ? (1u << e) : 0u;
            ((LAS unsigned char*)(lds + L_MASK))[(wv * 8 + qs) * 8 + j] = (unsigned char)bits;
            asm volatile("s_waitcnt lgkmcnt(0)" ::: "memory");
            const u32x2 mk = *(const LAS u32x2*)(lds + L_MASK + (wv * 8 + ((tq & 31) >> 2)) * 8);
            mlo = mk.x; mhi = mk.y;
            rs_flush<0>(rs, pg8::sigm((float)gh0), lds + L_IMPA + (tq >> 6) * 2048 + (tq & 63) * 16, nullptr); rs_init(rs);
        } else if (i + 1 == e2) {
            rs_flush<1>(rs, pg8::sigm((float)gh1), lds + L_IMPA + wave * 2048 + lane * 16, nullptr); rs_init(rs);
        } else if (i + 1 == NT) {
            rs_flush<2>(rs, pg8::sigm((float)gh2), lds + L_IMPA + wave * 2048 + lane * 16, o_b + (size_t)(b * S_ + t) * 1024 + hb * 64 + 4 * hi);
        }
        if (sgrp == ((i + 1) & 1)) {
            if (more) NSA_STORE((i + 1) & 1);
            if (i + 3 < NT) NSA_LOAD(i + 3);
        }
        asm volatile("s_waitcnt lgkmcnt(0)" ::: "memory");
        __builtin_amdgcn_s_barrier();
    }
#undef NSA_DECODE
#undef NSA_LOAD
#undef NSA_STORE
}
}


namespace cmpx {
typedef _Float16 f16x8 __attribute__((ext_vector_type(8)));
typedef float f32x4 __attribute__((ext_vector_type(4)));
typedef unsigned u32x4 __attribute__((ext_vector_type(4)));
constexpr int L_PART = 0, L_HID = 65536, HIDP = 272, L_END = L_HID + 2 * 16 * HIDP;
__device__ __forceinline__ void item(LAS unsigned char* lds, const _Float16* __restrict__ proj, const float* __restrict__ pe, const _Float16* __restrict__ w1t, const _Float16* __restrict__ w2t,
                                     _Float16* __restrict__ dst, int b, int g, int kv, int ct) {
    const int tid = threadIdx.x, lane = tid & 63, wave = __builtin_amdgcn_readfirstlane(tid >> 6), kc = lane >> 4, n16 = lane & 15;
    f32x4 acc[8];
#pragma unroll
    for (int nt = 0; nt < 8; ++nt) acc[nt] = (f32x4){0.f, 0.f, 0.f, 0.f};
    const int c = 16 * ct + n16;
#pragma unroll 2
    for (int ks = 0; ks < 8; ++ks) {
        const int k0 = 32 * (8 * wave + ks) + 8 * kc, lt = k0 >> 6, d = k0 & 63;
        int trow = 16 * c + lt; trow = trow > S_ - 1 ? S_ - 1 : trow;
        const f16x8 raw = *(const f16x8*)(proj + (size_t)(b * S_ + trow) * PW + C_KVB + kv * 128 + g * 64 + d);
        const f32x4 p0 = *(const f32x4*)(pe + lt * 64 + d), p1 = *(const f32x4*)(pe + lt * 64 + d + 4);
        f16x8 afr;
        afr[0] = (_Float16)((float)raw[0] + p0.x); afr[1] = (_Float16)((float)raw[1] + p0.y); afr[2] = (_Float16)((float)raw[2] + p0.z); afr[3] = (_Float16)((float)raw[3] + p0.w);
        afr[4] = (_Float16)((float)raw[4] + p1.x); afr[5] = (_Float16)((float)raw[5] + p1.y); afr[6] = (_Float16)((float)raw[6] + p1.z); afr[7] = (_Float16)((float)raw[7] + p1.w);
#pragma unroll
        for (int nt = 0; nt < 8; ++nt) {
            const f16x8 bfr = *(const f16x8*)(w1t + (size_t)(16 * nt + n16) * 2048 + k0);
            acc[nt] = __builtin_amdgcn_mfma_f32_16x16x32_f16(afr, bfr, acc[nt], 0, 0, 0);
        }
    }
    LAS float* part = (LAS float*)(lds + L_PART) + wave * 2048;
#pragma unroll
    for (int nt = 0; nt < 8; ++nt) { part[(4 * kc + 0) * 128 + 16 * nt + n16] = acc[nt].x; part[(4 * kc + 1) * 128 + 16 * nt + n16] = acc[nt].y;
        part[(4 * kc + 2) * 128 + 16 * nt + n16] = acc[nt].z; part[(4 * kc + 3) * 128 + 16 * nt + n16] = acc[nt].w; }
    __syncthreads();
    { const LAS float* pp = (const LAS float*)(lds + L_PART);
#pragma unroll
      for (int e = 0; e < 4; ++e) { const int o = tid + 512 * e; float a = 0.f;
#pragma unroll
          for (int w = 0; w < 8; ++w) a += pp[w * 2048 + o];
          const float z = 0.7978845608028654f * (a + 0.044715f * a * a * a);
          const float th = 1.f - 2.f / (__expf(2.f * z) + 1.f);
          ((LAS _Float16*)(lds + L_HID + (o >> 7) * HIDP))[o & 127] = (_Float16)(0.5f * a * (1.f + th)); } }
    __syncthreads();
    if (wave < 4) {
        f32x4 o = {0.f, 0.f, 0.f, 0.f};
#pragma unroll
        for (int ks = 0; ks < 4; ++ks) {
            const f16x8 afr = *(const LAS f16x8*)(lds + L_HID + n16 * HIDP + (32 * ks + 8 * kc) * 2);
            const f16x8 bfr = *(const f16x8*)(w2t + (size_t)(16 * wave + n16) * 128 + 32 * ks + 8 * kc);
            o = __builtin_amdgcn_mfma_f32_16x16x32_f16(afr, bfr, o, 0, 0, 0);
        }
        const float ov[4] = {o.x, o.y, o.z, o.w};
#pragma unroll
        for (int e = 0; e < 4; ++e) { const int cc = 16 * ct + 4 * kc + e; dst[((size_t)(b * 2 + g) * 256 + cc) * 64 + 16 * wave + n16] = (_Float16)(cc == 255 ? 0.f : ov[e]); }
    }
    __syncthreads();
}
__device__ __forceinline__ void item2(LAS unsigned char* lds, const _Float16* __restrict__ proj, const float* __restrict__ pe, const _Float16* __restrict__ w1t, const _Float16* __restrict__ w2t,
                                      _Float16* __restrict__ dst, int b0, int b1, int g, int kv, int ct) {
    const int tid = threadIdx.x, lane = tid & 63, wave = __builtin_amdgcn_readfirstlane(tid >> 6), kc = lane >> 4, n16 = lane & 15;
    f32x4 acc0[8], acc1[8];
#pragma unroll
    for (int nt = 0; nt < 8; ++nt) { acc0[nt] = (f32x4){0.f, 0.f, 0.f, 0.f}; acc1[nt] = (f32x4){0.f, 0.f, 0.f, 0.f}; }
    const int c = 16 * ct + n16;
    f16x8 afr0[8], afr1[8];
    { f16x8 raw0[8], raw1[8]; f32x4 pA[8], pB[8];
#pragma unroll
      for (int ks = 0; ks < 8; ++ks) {
          const int k0 = 32 * (8 * wave + ks) + 8 * kc, lt = k0 >> 6, d = k0 & 63;
          int trow = 16 * c + lt; trow = trow > S_ - 1 ? S_ - 1 : trow;
          raw0[ks] = *(const f16x8*)(proj + (size_t)(b0 * S_ + trow) * PW + C_KVB + kv * 128 + g * 64 + d);
          raw1[ks] = *(const f16x8*)(proj + (size_t)(b1 * S_ + trow) * PW + C_KVB + kv * 128 + g * 64 + d);
          pA[ks] = *(const f32x4*)(pe + lt * 64 + d); pB[ks] = *(const f32x4*)(pe + lt * 64 + d + 4); }
      __builtin_amdgcn_sched_barrier(0);
#pragma unroll
      for (int ks = 0; ks < 8; ++ks) {
          const float pv[8] = {pA[ks].x, pA[ks].y, pA[ks].z, pA[ks].w, pB[ks].x, pB[ks].y, pB[ks].z, pB[ks].w};
#pragma unroll
          for (int e = 0; e < 8; ++e) { afr0[ks][e] = (_Float16)((float)raw0[ks][e] + pv[e]); afr1[ks][e] = (_Float16)((float)raw1[ks][e] + pv[e]); } } }
#pragma unroll
    for (int ks = 0; ks < 8; ++ks) {
        const int k0 = 32 * (8 * wave + ks) + 8 * kc;
        f16x8 bfr[8];
#pragma unroll
        for (int nt = 0; nt < 8; ++nt) bfr[nt] = *(const f16x8*)(w1t + (size_t)(16 * nt + n16) * 2048 + k0);
#pragma unroll
        for (int nt = 0; nt < 8; ++nt) {
            acc0[nt] = __builtin_amdgcn_mfma_f32_16x16x32_f16(afr0[ks], bfr[nt], acc0[nt], 0, 0, 0);
            acc1[nt] = __builtin_amdgcn_mfma_f32_16x16x32_f16(afr1[ks], bfr[nt], acc1[nt], 0, 0, 0);
        }
    }
    LAS float* part = (LAS float*)(lds + L_PART) + wave * 2048;
#pragma unroll 1
    for (int it = 0; it < 2; ++it) {
#pragma unroll
        for (int nt = 0; nt < 8; ++nt) { const f32x4 v = it ? acc1[nt] : acc0[nt];
            part[(4 * kc + 0) * 128 + 16 * nt + n16] = v.x; part[(4 * kc + 1) * 128 + 16 * nt + n16] = v.y;
            part[(4 * kc + 2) * 128 + 16 * nt + n16] = v.z; part[(4 * kc + 3) * 128 + 16 * nt + n16] = v.w; }
        __syncthreads();
        { const LAS float* pp = (const LAS float*)(lds + L_PART);
#pragma unroll
          for (int e = 0; e < 4; ++e) { const int o = tid + 512 * e; float a = 0.f;
#pragma unroll
              for (int w = 0; w < 8; ++w) a += pp[w * 2048 + o];
              const float z = 0.7978845608028654f * (a + 0.044715f * a * a * a);
              const float th = 1.f - 2.f / (__expf(2.f * z) + 1.f);
              ((LAS _Float16*)(lds + L_HID + it * 16 * HIDP + (o >> 7) * HIDP))[o & 127] = (_Float16)(0.5f * a * (1.f + th)); } }
        __syncthreads();
    }
    {
        const int it = wave >> 2, wt = wave & 3, b = it ? b1 : b0;
        f32x4 o = {0.f, 0.f, 0.f, 0.f};
#pragma unroll
        for (int ks = 0; ks < 4; ++ks) {
            const f16x8 afr = *(const LAS f16x8*)(lds + L_HID + it * 16 * HIDP + n16 * HIDP + (32 * ks + 8 * kc) * 2);
            const f16x8 bfr = *(const f16x8*)(w2t + (size_t)(16 * wt + n16) * 128 + 32 * ks + 8 * kc);
            o = __builtin_amdgcn_mfma_f32_16x16x32_f16(afr, bfr, o, 0, 0, 0);
        }
        const float ov[4] = {o.x, o.y, o.z, o.w};
#pragma unroll
        for (int e = 0; e < 4; ++e) { const int cc = 16 * ct + 4 * kc + e; dst[((size_t)(b * 2 + g) * 256 + cc) * 64 + 16 * wt + n16] = (_Float16)(cc == 255 ? 0.f : ov[e]); }
    }
    __syncthreads();
}
}


#define XB_TMO      128
#define XB_XCNT(j)  (256  + 64 * (j))
#define XB_XSUB(j)  (1280 + 64 * (j))
#define XB_XGEN(j)  (2304 + 64 * (j))
#define XB_TOP      3328
#define XB_TOPGEN   3392
#define XCD_BAR_WORDS 3456
#define XB_SPIN_CAP (1u << 18)
__device__ __forceinline__ unsigned xb_ld(unsigned* p)              { return __hip_atomic_load(p, __ATOMIC_RELAXED, __HIP_MEMORY_SCOPE_AGENT); }
__device__ __forceinline__ unsigned xb_add(unsigned* p, unsigned v) { return __hip_atomic_fetch_add(p, v, __ATOMIC_RELAXED, __HIP_MEMORY_SCOPE_AGENT); }
__device__ __forceinline__ unsigned xb_xcc_id() { return (unsigned)__builtin_amdgcn_s_getreg((3 << 11) | 20) & 0xFu; }
#define XB_SPIN(cond, bar) do { unsigned _sp = 0; while (cond) { __builtin_amdgcn_s_sleep(1); \
    if ((++_sp & 255u) == 0u) { if (xb_ld(&(bar)[XB_TMO])) break; if (_sp > XB_SPIN_CAP) { atomicAdd(&(bar)[XB_TMO], 1u); break; } } } } while (0)
struct XcdBarrier { unsigned* bar; unsigned x; volatile LAS unsigned* st; };
__device__ __forceinline__ XcdBarrier xcd_barrier_post(unsigned* bar, volatile LAS unsigned* st) {
    XcdBarrier b; b.bar = bar; b.x = xb_xcc_id(); b.st = st;
    if (threadIdx.x == 0) (void)xb_add(&bar[XB_XCNT(b.x)], 1u);
    return b;
}
__device__ __forceinline__ void xcd_barrier_complete(unsigned* bar, unsigned x, unsigned& nloc, unsigned& nx) {
    const unsigned G = gridDim.x * gridDim.y * gridDim.z;
    unsigned sum, cnt, mine, sp = 0u;
    for (;;) {
        sum = 0u; cnt = 0u; mine = 0u;
#pragma unroll
        for (unsigned j = 0; j < 16; ++j) { const unsigned c = xb_ld(&bar[XB_XCNT(j)]); sum += c; cnt += (c > 0u) ? 1u : 0u; mine = (j == x) ? c : mine; }
        if (sum == G) break;
        __builtin_amdgcn_s_sleep(1);
        if ((++sp & 255u) == 0u) { if (xb_ld(&bar[XB_TMO])) break; if (sp > XB_SPIN_CAP) { atomicAdd(&bar[XB_TMO], 1u); break; } }
    }
    nloc = mine > 0u ? mine : 1u; nx = cnt > 0u ? cnt : 1u;
}
__device__ __forceinline__ void xcd_barrier(const XcdBarrier& b) {
    asm volatile("s_waitcnt vmcnt(0)" ::: "memory");
    __syncthreads();
    if (threadIdx.x == 0) {
        unsigned* bar = b.bar;
        __builtin_amdgcn_s_waitcnt(0);
        unsigned nloc = b.st[0], nx = b.st[1];
        if (nloc == 0u) { xcd_barrier_complete(bar, b.x, nloc, nx); b.st[0] = nloc; b.st[1] = nx; }
        const unsigned old = xb_add(&bar[XB_XSUB(b.x)], 1u);
        const unsigned gen = old / nloc;
        if (old + 1u == (gen + 1u) * nloc) {
            __builtin_amdgcn_fence(__ATOMIC_RELEASE, "agent");
            asm volatile("s_waitcnt vmcnt(0)" ::: "memory");
            const unsigned og = xb_add(&bar[XB_TOP], 1u);
            const unsigned tg = og / nx;
            if (og + 1u == (tg + 1u) * nx) xb_add(&bar[XB_TOPGEN], 1u);
            else XB_SPIN(xb_ld(&bar[XB_TOPGEN]) == tg, bar);
            __builtin_amdgcn_fence(__ATOMIC_ACQUIRE, "agent");
            xb_add(&bar[XB_XGEN(b.x)], 1u);
            asm volatile("s_waitcnt vmcnt(0)" ::: "memory");
        } else {
            XB_SPIN(xb_ld(&bar[XB_XGEN(b.x)]) == gen, bar);
            __builtin_amdgcn_fence(__ATOMIC_ACQUIRE, "agent");
            asm volatile("s_waitcnt vmcnt(0)" ::: "memory");
        }
    }
    __syncthreads();
}

constexpr int MEGA_LDS = 131072 + 256;

template <class Epi>
__device__ __forceinline__ void gemm_run(LAS unsigned char* lds, const void* A, const void* Bt, const Epi& E, int M, int N, int K) {
    pg8::Gemm g{(const pg8::bf16_t*)A, (const pg8::bf16_t*)Bt, M, N, K};
    pg8::StaticOrder S; S.init(M, N, (int)gridDim.x, (int)blockIdx.x);
    pg8::gemm_phase<Epi, pg8::StaticOrder, true, true>(lds, g, S, E);
}

__global__ void __launch_bounds__(512, 2) mega_fwd(Args a) {
    extern __shared__ __attribute__((aligned(16))) unsigned char lds_raw[];
    LAS unsigned char* lds = (LAS unsigned char*)lds_raw;
    unsigned char* ws = a.ws;
    if (threadIdx.x == 0) *(LAS dsa::u32x4*)(lds + 131072) = (dsa::u32x4){0u, 0u, 0u, 0u};
    __syncthreads();
    XcdBarrier bar = xcd_barrier_post((unsigned*)(ws + WS_CTL), (volatile LAS unsigned*)(lds + 131072));
    const _Float16* proj = (const _Float16*)(ws + WS_PROJ);
    _Float16* o_a = (_Float16*)(ws + WS_OAB); _Float16* o_b = (_Float16*)(ws + WS_OAB) + 512;
    _Float16* kcmp = (_Float16*)(ws + WS_KCMP); _Float16* vcmp = (_Float16*)(ws + WS_VCMP);

    prologue_body<false>(a, lds_raw);
    xcd_barrier(bar);
    gemm_run(lds, ws + WS_H, ws + WS_WIN, pg8::EpiProj{(_Float16*)(ws + WS_PROJ), (_Float16*)(ws + WS_KIC)}, M_, PW, D_);
    if (blockIdx.x >= 128) { prologue_body<true>(a, lds_raw); mlp_weights_body(a, lds_raw); }
    xcd_barrier(bar);
    { const int it = (int)blockIdx.x; const int ct = it & 15, kv = (it >> 4) & 1, g = (it >> 5) & 1, b = it >> 6;
      cmpx::item2(lds, proj, kv ? a.pe_v : a.pe_k, (const _Float16*)(ws + WS_CW + (kv ? 512 * 1024 : 0)), (const _Float16*)(ws + WS_CW + 1024 * 1024 + (kv ? 16384 : 0)), kv ? vcmp : kcmp, b, b + 4, g, kv, ct); }
    unsigned first_ticket = 0u;
    if (threadIdx.x == 0) first_ticket = __hip_atomic_fetch_add((unsigned*)(ws + WS_DQ) + (blockIdx.x & 7) * 16, 1u, __ATOMIC_RELAXED, __HIP_MEMORY_SCOPE_AGENT);
    static_assert(dsa::L_BIAS >= nsa::L_END && dsa::L_BIAS >= cmpx::L_END, "the DSA bias table must survive the NSA units");
    { LAS float* lut = (LAS float*)(lds + nsa::L_BIAS); LAS float* biaslut = (LAS float*)(lds + dsa::L_BIAS);
      float v0[2], v1[2];
#pragma unroll
      for (int k = 0; k < 2; ++k) { const int i = threadIdx.x + 512 * k, d = i >> 3, h = i & 7; v0[k] = a.rel_bias[t5_bucket(d) * 16 + 8 + h]; v1[k] = a.rel_bias[t5_bucket(d) * 16 + h]; }
#pragma unroll
      for (int k = 0; k < 2; ++k) { const int i = threadIdx.x + 512 * k; lut[i] = v0[k] * nsa::LOG2E; biaslut[i] = v1[k]; } }
    xcd_barrier(bar);
    { const int b = blockIdx.x & 7; unsigned* head = (unsigned*)(ws + WS_DQ) + b * 16; volatile LAS int* tk = (volatile LAS int*)(lds + 131072 + 8);
      if (threadIdx.x == 0) tk[0] = (int)first_ticket;
      __syncthreads();
      int cur = tk[0], slot = 1;
#pragma unroll 1
      while (cur < 384) {
          unsigned nxt = 0u;
          if (threadIdx.x == 0) nxt = __hip_atomic_fetch_add(head, 1u, __ATOMIC_RELAXED, __HIP_MEMORY_SCOPE_AGENT);
          if (cur < 128) nsa::nsa_unit(lds, proj, kcmp, vcmp, o_b, b, cur & 1, 63 - (cur >> 1));
          else {
              dsa::dsa_tile(lds, proj, o_a, b, 383 - cur); }
          if (threadIdx.x == 0) tk[slot] = (int)nxt;
          __syncthreads();
          cur = tk[slot]; slot ^= 1;
      } }
    xcd_barrier(bar);
    gemm_run(lds, ws + WS_OAB, ws + WS_WBA, pg8::EpiMixF{(_Float16*)(ws + WS_MIX), proj}, M_, D_, D_);
    xcd_barrier(bar);
    gemm_run(lds, ws + WS_MIX, ws + WS_WOUT, pg8::EpiResidSq{(const float*)(ws + WS_RINV), (_Float16*)(ws + WS_H), (float*)(ws + WS_ROWSQ)}, M_, D_, D_);
    xcd_barrier(bar);
    gemm_run(lds, ws + WS_H, ws + WS_WMI, pg8::EpiRelu2N{(_Float16*)(ws + WS_PROJ), (const float*)(ws + WS_ROWSQ)}, M_, DFF, D_);
    xcd_barrier(bar);
#pragma unroll 1
    for (int sl = 0; sl < 2; ++sl) {
        pg8::Gemm g{(const pg8::bf16_t*)(ws + WS_PROJ), (const pg8::bf16_t*)(ws + WS_WMO), M_, D_, DFF};
        SliceOrder SO; SO.S.init(M_, D_, (int)gridDim.x, (int)blockIdx.x); SO.slice = sl;
        pg8::gemm_phase<EpiFinalNorm, SliceOrder, false, true>(lds, g, SO, EpiFinalNorm{a.out, (const _Float16*)(ws + WS_H), a.norm_final, (float*)(ws + WS_XBUF), (unsigned*)(ws + WS_PCNT)});
        __syncthreads();
    }
}
}

extern "C" void kernel_launch(void* const* d_in, const int* in_sizes, int n_in, void* d_out, int out_size, void* d_ws, size_t ws_size, hipStream_t stream) {
    if (ws_size < WS_END) { fprintf(stderr, "ws too small: %zu\n", ws_size); return; }
    static int grid = 0;
    if (!grid) {
        int dev = 0, cus = 0, per_cu = 0;
        (void)hipGetDevice(&dev);
        (void)hipDeviceGetAttribute(&cus, hipDeviceAttributeMultiprocessorCount, dev);
        (void)hipFuncSetAttribute((const void*)mega_fwd, hipFuncAttributeMaxDynamicSharedMemorySize, MEGA_LDS);
        (void)hipOccupancyMaxActiveBlocksPerMultiprocessor(&per_cu, (const void*)mega_fwd, 512, MEGA_LDS);
        (void)hipGetLastError();
        grid = cus;
        if (per_cu < 1) fprintf(stderr, "occupancy query says %d blocks/CU\n", per_cu);
        if (cus != 256) { fprintf(stderr, "kernel_launch: built for a 256-CU device (the last GEMM's row-panel exchange needs exactly 256 workgroups); found %d CUs, nothing launched\n", cus); grid = -1; }
    }
    if (grid < 0) return;
    Args a{};
    a.x = (const float*)d_in[0]; a.norm_mix = (const float*)d_in[1]; a.w_in = (const float*)d_in[2];
    a.pe_k = (const float*)d_in[3]; a.w1_k = (const float*)d_in[4]; a.w2_k = (const float*)d_in[5];
    a.pe_v = (const float*)d_in[6]; a.w1_v = (const float*)d_in[7]; a.w2_v = (const float*)d_in[8];
    a.rel_bias = (const float*)d_in[9]; a.w_ba = (const float*)d_in[10]; a.w_bb = (const float*)d_in[11];
    a.w_out = (const float*)d_in[12]; a.norm_mlp = (const float*)d_in[13]; a.w_mi = (const float*)d_in[14];
    a.w_mo = (const float*)d_in[15]; a.norm_final = (const float*)d_in[16];
    a.out = (float*)d_out; a.ws = (unsigned char*)d_ws;
    (void)hipMemsetAsync(d_ws, 0, 327680, stream);
    hipLaunchKernelGGL(mega_fwd, dim3(grid), dim3(512), MEGA_LDS, stream, a);
}
```
